# Optimizing an MI355X kernel written in HIP

```python
import math
import jax, jax.numpy as jnp
from jax import lax
import numpy as np

D_MODEL = 1024
BATCH = 2
SEQ = 8192
DEPTH = 2

GRID_W = 64
CTX_LEN = 256
N_EVEN = (DEPTH + 1) // 2
N_ODD = DEPTH // 2
NORM_EPS = 1e-6
ROPE_THETA = 10000.0
Q_BLOCK = 128
N_MOD = 6
S5_WIDTH = D_MODEL // 2
S5_GROUP_DIM = 16
S5_GROUPS = S5_WIDTH // S5_GROUP_DIM
S5_STATE = 64
S5_DT_MIN = 1e-3
S5_DT_MAX = 1e-1
MLA_HEADS = 4
MLA_NOPE = 128
MLA_ROPE = 64
MLA_QK_DIM = MLA_NOPE + MLA_ROPE
MLA_V = 128
MLA_Q_RANK = 384
MLA_KV_RANK = 256
MLA_SCALE = MLA_QK_DIM ** -0.5
A_IN_WIDTH = S5_WIDTH + MLA_Q_RANK + MLA_KV_RANK + MLA_ROPE
A_OUT_WIDTH = S5_WIDTH + MLA_HEADS * MLA_V
WIN_HEADS = 16
WIN_KV_HEADS = 4
WIN_GROUP = WIN_HEADS // WIN_KV_HEADS
WIN_HEAD_DIM = 64
WINDOW = 128
WIN_SCALE = WIN_HEAD_DIM ** -0.5
C_IN_WIDTH = (WIN_HEADS + 2 * WIN_KV_HEADS) * WIN_HEAD_DIM
C_OUT_WIDTH = WIN_HEADS * WIN_HEAD_DIM
FFN_HIDDEN = -(-8 * D_MODEL // (3 * 256)) * 256

kernel_name = 'hybrid_s5_mla_window_dit_prefix'


def rms_norm(x, gain):
    xf = x.astype(jnp.float32)
    y = xf * lax.rsqrt(jnp.mean(xf * xf, axis=-1, keepdims=True) + NORM_EPS)
    return (y * gain.astype(jnp.float32)).astype(x.dtype)


def ada_modulation(cond, w, b):
    m = (jax.nn.silu(cond) @ w + b)[..., None, :]
    return jnp.split(m, N_MOD, axis=-1)


def modulate(x, gain, shift, scale):
    return rms_norm(x, gain) * (1 + scale) + shift


def grid_rope_tables(rows, rot_dim):
    row = jnp.repeat(jnp.arange(rows, dtype=jnp.int32), GRID_W)
    col = jnp.tile(jnp.arange(GRID_W, dtype=jnp.int32), rows)
    n_freq = rot_dim // 4
    inv_freq = ROPE_THETA ** (-jnp.arange(n_freq, dtype=jnp.float32) / n_freq)
    ang_r = row.astype(jnp.float32)[:, None] * inv_freq
    ang_c = col.astype(jnp.float32)[:, None] * inv_freq
    ang = jnp.concatenate([ang_r, ang_r, ang_c, ang_c], axis=-1)
    return jnp.cos(ang), jnp.sin(ang)


def apply_axial_rope(x, cos, sin):
    x1, x2, x3, x4 = jnp.split(x, 4, axis=-1)
    rot = jnp.concatenate([-x2, x1, -x4, x3], axis=-1)
    return x * cos[:, None, :].astype(x.dtype) + rot * sin[:, None, :].astype(x.dtype)


def swiglu(h, w_gate, w_up, w_down):
    return (jax.nn.silu(h @ w_gate) * (h @ w_up)) @ w_down


def zoh_discretize(lam_re, lam_im, log_step, b_re, b_im):
    lam = lax.complex(lam_re.astype(jnp.float32), lam_im.astype(jnp.float32))
    step = jnp.exp(log_step.astype(jnp.float32))[:, None]
    lam_bar = jnp.exp(lam * step)
    b = lax.complex(b_re.astype(jnp.float32), b_im.astype(jnp.float32))
    b_bar = ((lam_bar - 1.0) / lam)[..., None] * b
    return lam_bar, b_bar


def diag_scan(lam_bar, bu, h0):
    if h0 is not None:
        bu = bu.at[:, 0].add(lam_bar * h0)
    a = jnp.broadcast_to(lam_bar, (1, bu.shape[1]) + lam_bar.shape)

    def combine(left, right):
        a_l, b_l = left
        a_r, b_r = right
        return a_l * a_r, a_r * b_l + b_r

    _, h = lax.associative_scan(combine, (a, bu), axis=1)
    return h


def s5_bidirectional(u_ctx, u_lat, lam_re, lam_im, log_step, b_re, b_im, c_re, c_im,
                     d_skip, w_glu, b_glu, need_ctx):
    def grouped(u):
        return u.reshape(u.shape[0], u.shape[1], S5_GROUPS, S5_GROUP_DIM)

    uc, ul = grouped(u_ctx), grouped(u_lat)
    d = d_skip.reshape(S5_GROUPS, S5_GROUP_DIM).astype(jnp.float32)
    y_lat = ul.astype(jnp.float32) * d
    y_ctx = uc.astype(jnp.float32) * d if need_ctx else None
    for direction in range(2):
        rev = direction == 1
        lam_bar, b_bar = zoh_discretize(lam_re[direction], lam_im[direction], log_step[direction],
                                        b_re[direction], b_im[direction])
        c_mat = lax.complex(c_re[direction].astype(jnp.float32), c_im[direction].astype(jnp.float32))

        def drive(u):
            u = jnp.flip(u, axis=1) if rev else u
            return jnp.einsum('btgs,gps->btgp', u.astype(jnp.complex64), b_bar)

        def readout(h):
            y = jnp.real(jnp.einsum('btgp,gsp->btgs', h, c_mat))
            return jnp.flip(y, axis=1) if rev else y

        h_c = diag_scan(lam_bar, drive(uc), None)
        h_l = diag_scan(lam_bar, drive(ul), h_c[:, -1])
        y_lat = y_lat + readout(h_l)
        if need_ctx:
            y_ctx = y_ctx + readout(h_c)

    def glu(y):
        y = jax.nn.gelu(y.reshape(y.shape[0], y.shape[1], S5_WIDTH))
        return (y * jax.nn.sigmoid(y @ w_glu + b_glu)).astype(u_lat.dtype)

    return (glu(y_ctx) if need_ctx else None), glu(y_lat)


def mla_queries(cq, qa_norm, w_q_b, q_norm, cos, sin):
    b, t, _ = cq.shape
    q = (rms_norm(cq, qa_norm) @ w_q_b).reshape(b, t, MLA_HEADS, MLA_QK_DIM)
    q = rms_norm(q, q_norm)
    if cos is not None:
        q = jnp.concatenate([q[..., :MLA_NOPE], apply_axial_rope(q[..., MLA_NOPE:], cos, sin)], axis=-1)
    return q


def mla_keys_values(ckv, k_rope, kva_norm, w_kv_b, k_norm, cos, sin):
    b, t, _ = ckv.shape
    kv = (rms_norm(ckv, kva_norm) @ w_kv_b).reshape(b, t, MLA_HEADS, MLA_NOPE + MLA_V)
    k_nope, v = kv[..., :MLA_NOPE], kv[..., MLA_NOPE:]
    k_pe = jnp.broadcast_to(k_rope[:, :, None, :], (b, t, MLA_HEADS, MLA_ROPE))
    k = rms_norm(jnp.concatenate([k_nope, k_pe], axis=-1), k_norm)
    if cos is not None:
        k = jnp.concatenate([k[..., :MLA_NOPE], apply_axial_rope(k[..., MLA_NOPE:], cos, sin)], axis=-1)
    return k, v


def full_attention(q, k, v, scale):
    s = jnp.einsum('bqhd,bkhd->bhqk', q, k).astype(jnp.float32) * scale
    p = jax.nn.softmax(s, axis=-1).astype(v.dtype)
    return jnp.einsum('bhqk,bkhd->bqhd', p, v)


def blocked_dense_attention(q, k, v, scale):
    b, n, h, dq = q.shape
    nb = n // Q_BLOCK
    qb = q.reshape(b, nb, Q_BLOCK, h, dq).swapaxes(0, 1)
    out = lax.map(lambda q_blk: full_attention(q_blk, k, v, scale), qb)
    return out.swapaxes(0, 1).reshape(b, n, h * v.shape[-1])


def ssm_mla_mixer(h_ctx, h_lat, w_in, w_out, lam_re, lam_im, log_step, b_re, b_im, c_re, c_im,
                  d_skip, w_glu, b_glu, qa_norm, w_q_b, kva_norm, w_kv_b, q_norm, k_norm,
                  cos, sin, need_ctx):
    cuts = [S5_WIDTH, S5_WIDTH + MLA_Q_RANK, S5_WIDTH + MLA_Q_RANK + MLA_KV_RANK]
    u_c, cq_c, ckv_c, kr_c = jnp.split(h_ctx @ w_in, cuts, axis=-1)
    u_l, cq_l, ckv_l, kr_l = jnp.split(h_lat @ w_in, cuts, axis=-1)
    b, n, _ = h_lat.shape
    s5_c, s5_l = s5_bidirectional(u_c, u_l, lam_re, lam_im, log_step, b_re, b_im, c_re, c_im,
                                  d_skip, w_glu, b_glu, need_ctx)
    k_c, v_c = mla_keys_values(ckv_c, kr_c, kva_norm, w_kv_b, k_norm, None, None)
    k_l, v_l = mla_keys_values(ckv_l, kr_l, kva_norm, w_kv_b, k_norm, cos, sin)
    q_l = mla_queries(cq_l, qa_norm, w_q_b, q_norm, cos, sin)
    o_l = blocked_dense_attention(q_l, jnp.concatenate([k_c, k_l], axis=1),
                                  jnp.concatenate([v_c, v_l], axis=1), MLA_SCALE)
    out_l = jnp.concatenate([s5_l, o_l], axis=-1) @ w_out
    out_c = None
    if need_ctx:
        q_c = mla_queries(cq_c, qa_norm, w_q_b, q_norm, None, None)
        o_c = full_attention(q_c, k_c, v_c, MLA_SCALE)
        o_c = o_c.reshape(b, o_c.shape[1], MLA_HEADS * MLA_V)
        out_c = jnp.concatenate([s5_c, o_c], axis=-1) @ w_out
    return out_c, out_l


def sink_softmax(s, sink_logit):
    m = jnp.maximum(jnp.max(s, axis=-1, keepdims=True), sink_logit)
    p = jnp.exp(s - m)
    return p / (jnp.sum(p, axis=-1, keepdims=True) + jnp.exp(sink_logit - m))


def context_sink_attention(q, k, v, sink_l):
    s = jnp.einsum('bqkgd,bjkd->bkgqj', q, k).astype(jnp.float32) * WIN_SCALE
    w = sink_softmax(s, sink_l).astype(v.dtype)
    return jnp.einsum('bkgqj,bjkd->bqkgd', w, v)


def banded_sink_attention(q, k, v, k_ctx, v_ctx, sink_l):
    b, n = q.shape[0], q.shape[1]
    nb = n // Q_BLOCK
    band = 3 * Q_BLOCK
    qb = q.reshape(b, nb, Q_BLOCK, WIN_KV_HEADS, WIN_GROUP, WIN_HEAD_DIM).swapaxes(0, 1)
    pad = ((0, 0), (Q_BLOCK, Q_BLOCK), (0, 0), (0, 0))
    k_pad, v_pad = jnp.pad(k, pad), jnp.pad(v, pad)
    rel = (jnp.arange(band)[None, :] - Q_BLOCK) - jnp.arange(Q_BLOCK)[:, None]
    in_window = jnp.abs(rel) <= WINDOW

    def block(args):
        i, q_blk = args
        start = i * Q_BLOCK
        k_blk = lax.dynamic_slice_in_dim(k_pad, start, band, axis=1)
        v_blk = lax.dynamic_slice_in_dim(v_pad, start, band, axis=1)
        key_pos = start - Q_BLOCK + jnp.arange(band)
        valid = in_window & ((key_pos >= 0) & (key_pos < n))[None, :]
        s_loc = jnp.einsum('bqkgd,bjkd->bkgqj', q_blk, k_blk).astype(jnp.float32) * WIN_SCALE
        s_loc = jnp.where(valid, s_loc, -jnp.inf)
        s_ctx = jnp.einsum('bqkgd,bjkd->bkgqj', q_blk, k_ctx).astype(jnp.float32) * WIN_SCALE
        w = sink_softmax(jnp.concatenate([s_ctx, s_loc], axis=-1), sink_l).astype(v.dtype)
        return jnp.einsum('bkgqj,bjkd->bqkgd', w, jnp.concatenate([v_ctx, v_blk], axis=1))

    out = lax.map(block, (jnp.arange(nb), qb))
    return out.swapaxes(0, 1).reshape(b, n, C_OUT_WIDTH)


def window_gqa_mixer(h_ctx, h_lat, w_in, w_out, q_norm, k_norm, sink, cos, sin, need_ctx):
    q_w = WIN_HEADS * WIN_HEAD_DIM
    kv_w = WIN_KV_HEADS * WIN_HEAD_DIM
    sink_l = sink.astype(jnp.float32).reshape(WIN_KV_HEADS, WIN_GROUP)[None, :, :, None, None]

    def project(h, rope_cos, rope_sin):
        bb, t, _ = h.shape
        q, k, v = jnp.split(h @ w_in, [q_w, q_w + kv_w], axis=-1)
        k = rms_norm(k.reshape(bb, t, WIN_KV_HEADS, WIN_HEAD_DIM), k_norm)
        v = v.reshape(bb, t, WIN_KV_HEADS, WIN_HEAD_DIM)
        if rope_cos is not None:
            k = apply_axial_rope(k, rope_cos, rope_sin)
        return q, k, v

    def prep_queries(q, rope_cos, rope_sin):
        bb, t, _ = q.shape
        q = rms_norm(q.reshape(bb, t, WIN_HEADS, WIN_HEAD_DIM), q_norm)
        if rope_cos is not None:
            q = apply_axial_rope(q, rope_cos, rope_sin)
        return q.reshape(bb, t, WIN_KV_HEADS, WIN_GROUP, WIN_HEAD_DIM)

    q_c, k_c, v_c = project(h_ctx, None, None)
    q_l, k_l, v_l = project(h_lat, cos, sin)
    o_l = banded_sink_attention(prep_queries(q_l, cos, sin), k_l, v_l, k_c, v_c, sink_l)
    out_l = o_l @ w_out
    out_c = None
    if need_ctx:
        o_c = context_sink_attention(prep_queries(q_c, None, None), k_c, v_c, sink_l)
        out_c = o_c.reshape(o_c.shape[0], o_c.shape[1], C_OUT_WIDTH) @ w_out
    return out_c, out_l


def setup_inputs(seed: int = 0) -> dict:
    key = jax.random.key(seed)
    ks = list(jax.random.split(key, 48))

    def nrm(shape, scale):
        return jax.random.normal(ks.pop(), shape, jnp.float32) * scale

    def gain(shape):
        return 1.0 + nrm(shape, 0.05)

    G, P, S, W = S5_GROUPS, S5_STATE, S5_GROUP_DIM, S5_WIDTH
    lam_im_base = jnp.pi * jnp.arange(P, dtype=jnp.float32)
    return {
        'x': nrm((BATCH, SEQ, D_MODEL), 1.0),
        'c': nrm((BATCH, D_MODEL), 1.0),
        'ctx': nrm((BATCH, CTX_LEN, D_MODEL), 1.0),
        'c_ctx': nrm((D_MODEL,), 1.0),
        'ada_w': nrm((DEPTH, D_MODEL, N_MOD * D_MODEL), 0.5 * D_MODEL ** -0.5),
        'ada_b': nrm((DEPTH, N_MOD * D_MODEL), 0.02),
        'norm_mix': gain((DEPTH, D_MODEL)),
        'norm_ffn': gain((DEPTH, D_MODEL)),
        'ffn_w_gate': nrm((DEPTH, D_MODEL, FFN_HIDDEN), D_MODEL ** -0.5),
        'ffn_w_up': nrm((DEPTH, D_MODEL, FFN_HIDDEN), D_MODEL ** -0.5),
        'ffn_w_down': nrm((DEPTH, FFN_HIDDEN, D_MODEL), FFN_HIDDEN ** -0.5),
        'a_w_in': nrm((N_EVEN, D_MODEL, A_IN_WIDTH), D_MODEL ** -0.5),
        'a_w_out': nrm((N_EVEN, A_OUT_WIDTH, D_MODEL), A_OUT_WIDTH ** -0.5),
        's5_lam_re': -0.5 + nrm((N_EVEN, 2, G, P), 0.01),
        's5_lam_im': lam_im_base + nrm((N_EVEN, 2, G, P), 0.01),
        's5_log_step': jax.random.uniform(ks.pop(), (N_EVEN, 2, G), jnp.float32,
                                          math.log(S5_DT_MIN), math.log(S5_DT_MAX)),
        's5_b_re': nrm((N_EVEN, 2, G, P, S), (2 * S) ** -0.5),
        's5_b_im': nrm((N_EVEN, 2, G, P, S), (2 * S) ** -0.5),
        's5_c_re': nrm((N_EVEN, 2, G, S, P), (2 * P) ** -0.5),
        's5_c_im': nrm((N_EVEN, 2, G, S, P), (2 * P) ** -0.5),
        's5_d': nrm((N_EVEN, W), 1.0),
        's5_w_glu': nrm((N_EVEN, W, W), W ** -0.5),
        's5_b_glu': nrm((N_EVEN, W), 0.02),
        'mla_qa_norm': gain((N_EVEN, MLA_Q_RANK)),
        'mla_w_q_b': nrm((N_EVEN, MLA_Q_RANK, MLA_HEADS * MLA_QK_DIM), MLA_Q_RANK ** -0.5),
        'mla_kva_norm': gain((N_EVEN, MLA_KV_RANK)),
        'mla_w_kv_b': nrm((N_EVEN, MLA_KV_RANK, MLA_HEADS * (MLA_NOPE + MLA_V)), MLA_KV_RANK ** -0.5),
        'mla_q_norm': gain((N_EVEN, MLA_QK_DIM)),
        'mla_k_norm': gain((N_EVEN, MLA_QK_DIM)),
        'c_w_in': nrm((N_ODD, D_MODEL, C_IN_WIDTH), D_MODEL ** -0.5),
        'c_w_out': nrm((N_ODD, C_OUT_WIDTH, D_MODEL), C_OUT_WIDTH ** -0.5),
        'c_q_norm': gain((N_ODD, WIN_HEAD_DIM)),
        'c_k_norm': gain((N_ODD, WIN_HEAD_DIM)),
        'c_sink': nrm((N_ODD, WIN_HEADS), 0.5),
    }


def reference(x, c, ctx, c_ctx, ada_w, ada_b, norm_mix, norm_ffn, ffn_w_gate, ffn_w_up, ffn_w_down,
              a_w_in, a_w_out, s5_lam_re, s5_lam_im, s5_log_step, s5_b_re, s5_b_im, s5_c_re, s5_c_im,
              s5_d, s5_w_glu, s5_b_glu, mla_qa_norm, mla_w_q_b, mla_kva_norm, mla_w_kv_b,
              mla_q_norm, mla_k_norm, c_w_in, c_w_out, c_q_norm, c_k_norm, c_sink):
    rows = x.shape[1] // GRID_W
    cos_a, sin_a = grid_rope_tables(rows, MLA_ROPE)
    cos_c, sin_c = grid_rope_tables(rows, WIN_HEAD_DIM)
    h_ctx, h_lat = ctx, x
    for i in range(DEPTH):
        need_ctx = i < DEPTH - 1
        j = i // 2
        sh_l, sc_l, g_l, sh2_l, sc2_l, g2_l = ada_modulation(c, ada_w[i], ada_b[i])
        sh_c, sc_c, g_c, sh2_c, sc2_c, g2_c = ada_modulation(c_ctx, ada_w[i], ada_b[i])
        a_l = modulate(h_lat, norm_mix[i], sh_l, sc_l)
        a_c = modulate(h_ctx, norm_mix[i], sh_c, sc_c)
        if i % 2 == 0:
            o_c, o_l = ssm_mla_mixer(a_c, a_l, a_w_in[j], a_w_out[j], s5_lam_re[j], s5_lam_im[j],
                                     s5_log_step[j], s5_b_re[j], s5_b_im[j], s5_c_re[j], s5_c_im[j],
                                     s5_d[j], s5_w_glu[j], s5_b_glu[j], mla_qa_norm[j], mla_w_q_b[j],
                                     mla_kva_norm[j], mla_w_kv_b[j], mla_q_norm[j], mla_k_norm[j],
                                     cos_a, sin_a, need_ctx)
        else:
            o_c, o_l = window_gqa_mixer(a_c, a_l, c_w_in[j], c_w_out[j], c_q_norm[j], c_k_norm[j],
                                        c_sink[j], cos_c, sin_c, need_ctx)
        h_lat = h_lat + g_l * o_l
        h_lat = h_lat + g2_l * swiglu(modulate(h_lat, norm_ffn[i], sh2_l, sc2_l),
                                      ffn_w_gate[i], ffn_w_up[i], ffn_w_down[i])
        if need_ctx:
            h_ctx = h_ctx + g_c * o_c
            h_ctx = h_ctx + g2_c * swiglu(modulate(h_ctx, norm_ffn[i], sh2_c, sc2_c),
                                          ffn_w_gate[i], ffn_w_up[i], ffn_w_down[i])
    return h_lat
```

```cpp
#include <hip/hip_runtime.h>
#include <hip/hip_cooperative_groups.h>
#include <cstdio>
#include <cstdint>
namespace cg = cooperative_groups;

#define DI __device__ __forceinline__
typedef unsigned short bf16_t;
typedef short bf16x8 __attribute__((ext_vector_type(8)));
typedef short s16x4 __attribute__((ext_vector_type(4)));
typedef float f32x4 __attribute__((ext_vector_type(4)));
typedef float f32x2 __attribute__((ext_vector_type(2)));
typedef float f32x16 __attribute__((ext_vector_type(16)));
typedef unsigned u32x4 __attribute__((ext_vector_type(4)));
typedef unsigned u32x2 __attribute__((ext_vector_type(2)));
typedef __bf16 bf16v2 __attribute__((ext_vector_type(2)));

constexpr int DM = 1024, NBATCH = 2, SEQ = 8192, CTX = 256;
constexpr int NCTX = NBATCH * CTX;
constexpr int NLAT = NBATCH * SEQ;
constexpr int NR = NCTX + NLAT;
constexpr int TK = CTX + SEQ;
constexpr int FH = 2816;
constexpr int NCH = TK / 64;
constexpr float LOG2E = 1.4426950408889634f;
constexpr int LDS_BYTES = 65536;
constexpr int NTHREADS = 256;

constexpr size_t W_IN0 = 0;
constexpr size_t W_QB = W_IN0 + (size_t)1280 * 1024;
constexpr size_t W_KVB = W_QB + (size_t)768 * 384;
constexpr size_t W_GLU = W_KVB + (size_t)1024 * 256;
constexpr size_t W_OUT0 = W_GLU + (size_t)512 * 512;
constexpr size_t W_GU0 = W_OUT0 + (size_t)1024 * 1024;
constexpr size_t W_D0 = W_GU0 + (size_t)5632 * 1024;
constexpr size_t W_IN1 = W_D0 + (size_t)1024 * 2816;
constexpr size_t W_OUT1 = W_IN1 + (size_t)1536 * 1024;
constexpr size_t W_GU1 = W_OUT1 + (size_t)1024 * 1024;
constexpr size_t W_D1 = W_GU1 + (size_t)5632 * 1024;
constexpr size_t W_END = W_D1 + (size_t)1024 * 2816;
constexpr size_t OFF_TAB = W_END * 2;
constexpr size_t T_MOD = OFF_TAB;
constexpr size_t T_ROPE = T_MOD + 2 * 3 * 6144 * 4;
constexpr size_t T_LAMB = T_ROPE + 128 * 16 * 2 * 4;
constexpr size_t T_LAM64 = T_LAMB + 2 * 32 * 64 * 8;
constexpr size_t T_BBAR = T_LAM64 + 2 * 32 * 64 * 8;
constexpr size_t OFF_H = OFF_TAB + (1u << 20);
constexpr size_t OFF_A0 = OFF_H + (size_t)NR * 1024 * 4;
constexpr size_t OFF_S = OFF_A0 + (size_t)NR * 1024 * 2;
constexpr size_t WS_NEED = OFF_S + (size_t)108134400;
static_assert(WS_NEED <= ((size_t)256 << 20) && OFF_S + (size_t)NR * FH * 2 <= WS_NEED, "workspace");
constexpr size_t H_U32 = OFF_H;
constexpr size_t H_KR = H_U32 + (size_t)NR * 512 * 4;
constexpr size_t H_E = H_KR + (size_t)NR * 64 * 4;
constexpr size_t H_CIN = H_E + (size_t)2 * 2 * 32 * NCH * 64 * 8;
static_assert(H_CIN + (size_t)2 * 2 * 32 * NCH * 64 * 8 <= OFF_A0, "H region overflow");
constexpr size_t S_CQN = OFF_S;
constexpr size_t S_CKVN = S_CQN + (size_t)NR * 384 * 2;
constexpr size_t S_YG = OFF_S;
constexpr size_t S_X = S_CKVN + (size_t)NR * 256 * 2;
constexpr size_t S_CQKV = S_X;
constexpr size_t S_QRAW = S_X;
constexpr size_t S_KNOPE = S_QRAW + (size_t)NR * 768 * 2;
constexpr size_t S_VT = S_KNOPE + (size_t)NR * 512 * 2;
constexpr size_t S_KA = S_VT + (size_t)2 * 4 * 128 * TK * 2;
static_assert(S_CQKV + (size_t)NR * 640 * 4 <= S_VT, "CQKV overlaps VT");
static_assert(S_KA + (size_t)2 * 4 * TK * 192 * 2 <= WS_NEED, "scratch overflow");
constexpr size_t S_HID = OFF_S;
constexpr size_t S1_Q = OFF_S;
constexpr size_t S1_KRAW = S1_Q + (size_t)NR * 1024 * 2;
constexpr size_t S1_K = S1_KRAW + (size_t)NR * 256 * 4;
constexpr size_t S1_VT = S1_K + (size_t)2 * 4 * TK * 64 * 2;

struct Job { const float* a; const float* b; unsigned long long dst; int K, ld, ntk, ntn, tile0, mode; };
struct Params {
    const float* in[34];
    float* out;
    char* ws;
    Job jobs[11];
    int njobtiles;
    int pad;
};

DI int get_tid() { int t = threadIdx.x; asm volatile("" : "+v"(t)); return t; }
DI unsigned pk2(float lo, float hi) { f32x2 v = {lo, hi}; return __builtin_bit_cast(unsigned, __builtin_convertvector(v, bf16v2)); }
DI float bf2f(unsigned short b) { return __uint_as_float(((unsigned)b) << 16); }
DI float wave_sum(float v) {
#pragma unroll
    for (int o = 32; o > 0; o >>= 1) v += __shfl_xor(v, o);
    return v;
}
DI int row_vec(int r) { return r < NCTX ? 2 : (r - NCTX) / SEQ; }
DI int row_batch(int r) { return r < NCTX ? r / CTX : (r - NCTX) / SEQ; }
DI int row_tpos(int r) { return r < NCTX ? r % CTX : CTX + (r - NCTX) % SEQ; }
DI float sigmoidf_(float x) { return 1.f / (1.f + __expf(-x)); }
DI float siluf_(float x) { return x / (1.f + __expf(-x)); }
DI float gelu_tanh(float y) { const float z = 0.7978845608028654f * (y + 0.044715f * y * y * y); const float t = 1.f - 2.f / (1.f + __expf(2.f * z)); return 0.5f * y * (1.f + t); }
DI void my_sincos(float x, float& s, float& c) {
    const float q = rintf(x * 0.636619772367581f);
    float r = fmaf(-q, 1.5703125f, x);
    r = fmaf(-q, 4.837512969970703125e-4f, r);
    r = fmaf(-q, 7.54978995489188216e-8f, r);
    const int qi = (int)q;
    const float r2 = r * r;
    const float sp = r + r * r2 * (-1.6666654611e-1f + r2 * (8.3321608736e-3f + r2 * (-1.9515295891e-4f)));
    const float cp = 1.0f - 0.5f * r2 + r2 * r2 * (4.166664568298827e-2f + r2 * (-1.388731625493765e-3f + r2 * 2.443315711809948e-5f));
    const int k = qi & 3;
    s = (k == 0) ? sp : (k == 1) ? cp : (k == 2) ? -sp : -cp;
    c = (k == 0) ? cp : (k == 1) ? -sp : (k == 2) ? -cp : sp;
}

DI void transpose_tile(char* lds, char* ws, const Job& jb, int lt) {
    float (*tile)[65] = (float (*)[65])lds;
    const int tid = get_tid();
    const int tk = lt % jb.ntk, tn = lt / jb.ntk;
    const int k0 = tk * 64, n0 = tn * 64;
    const int j = tid & 63, kq = tid >> 6;
    const float* src; int col; bool valid = true;
    if (jb.mode == 0) { src = jb.a; col = n0 + j; valid = col < jb.ld; }
    else { const int nsub = j >> 4, i = j & 15; src = (nsub & 1) ? jb.b : jb.a; col = tn * 32 + (nsub >> 1) * 16 + i; }
#pragma unroll
    for (int kk = 0; kk < 16; ++kk) { const int k = kk * 4 + kq; tile[k][j] = valid ? src[(size_t)(k0 + k) * jb.ld + col] : 0.f; }
    __syncthreads();
    const int r = tid >> 2, ks = (tid & 3) * 16;
    unsigned w[8];
#pragma unroll
    for (int q = 0; q < 8; ++q) w[q] = pk2(tile[ks + 2 * q][r], tile[ks + 2 * q + 1][r]);
    bf16_t* d = (bf16_t*)(ws) + jb.dst + (size_t)(n0 + r) * jb.K + k0 + ks;
    *(u32x4*)d = (u32x4){w[0], w[1], w[2], w[3]};
    *(u32x4*)(d + 8) = (u32x4){w[4], w[5], w[6], w[7]};
    __syncthreads();
}

DI void ada_item(char* lds, const Params& p, int it) {
    float* sil = (float*)lds;
    float* red = sil + 3072;
    float* MOD = (float*)(p.ws + T_MOD);
    const int tid = get_tid(), layer = it / 96, n0 = (it % 96) * 64;
    for (int i = tid; i < 3072; i += 256) { const int v = i >> 10, k = i & 1023; const float x = v < 2 ? p.in[1][v * 1024 + k] : p.in[3][k]; sil[i] = siluf_(x); }
    __syncthreads();
    const int j = tid & 63, kq = tid >> 6;
    const float* W = p.in[4] + (size_t)layer * 1024 * 6144 + n0 + j;
    float a0 = 0.f, a1 = 0.f, a2 = 0.f;
#pragma unroll 8
    for (int k = kq * 256; k < kq * 256 + 256; ++k) { const float w = W[(size_t)k * 6144]; a0 += sil[k] * w; a1 += sil[1024 + k] * w; a2 += sil[2048 + k] * w; }
    red[(kq * 3 + 0) * 64 + j] = a0; red[(kq * 3 + 1) * 64 + j] = a1; red[(kq * 3 + 2) * 64 + j] = a2;
    __syncthreads();
    if (tid < 192) { const int v = tid >> 6, jj = tid & 63;
        const float s = red[(0 * 3 + v) * 64 + jj] + red[(1 * 3 + v) * 64 + jj] + red[(2 * 3 + v) * 64 + jj] + red[(3 * 3 + v) * 64 + jj] + p.in[5][layer * 6144 + n0 + jj];
        MOD[(layer * 3 + v) * 6144 + n0 + jj] = s; }
    __syncthreads();
}

DI void tables_item(const Params& p, int it) {
    const int tid = get_tid();
    if (it < 8) {
        const int e = it * 256 + tid, pos = e >> 4, i = e & 15;
        const float inv = exp2f(-(float)i * (13.287712379549449f / 16.f));
        float s, c; my_sincos((float)pos * inv, s, c);
        float* ROPE = (float*)(p.ws + T_ROPE); ROPE[e * 2] = c; ROPE[e * 2 + 1] = s;
    } else {
        const int e = (it - 8) * 256 + tid;
        const int dg = e >> 6;
        const float lr = p.in[13][e], li = p.in[14][e], step = expf(p.in[15][dg]);
        const float a = lr * step, b = li * step;
        const float ea = expf(a);
        float sb, cb; my_sincos(b, sb, cb);
        float sh, ch; my_sincos(0.5f * b, sh, ch);
        const float em1 = a * (1.f + a * 0.5f * (1.f + a * (1.f / 3.f) * (1.f + a * 0.25f * (1.f + a * 0.2f * (1.f + a * (1.f / 6.f))))));
        const float lbr = ea * cb, lbi = ea * sb;
        const float nr = em1 * cb - 2.f * sh * sh, ni = ea * sb;
        const float den = lr * lr + li * li;
        const float qr = (nr * lr + ni * li) / den, qi = (ni * lr - nr * li) / den;
        f32x2* BB = (f32x2*)(p.ws + T_BBAR);
#pragma unroll
        for (int s = 0; s < 16; ++s) { const float br = p.in[16][e * 16 + s], bi = p.in[17][e * 16 + s]; BB[e * 16 + s] = (f32x2){qr * br - qi * bi, qr * bi + qi * br}; }
        ((f32x2*)(p.ws + T_LAMB))[e] = (f32x2){lbr, lbi};
        float pr = lbr, pi = lbi;
#pragma unroll
        for (int q = 0; q < 6; ++q) { const float nr2 = pr * pr - pi * pi, ni2 = 2.f * pr * pi; pr = nr2; pi = ni2; }
        ((f32x2*)(p.ws + T_LAM64))[e] = (f32x2){pr, pi};
    }
}

DI void modulate_rows(const Params& p, int layer, int which, bool from_inputs, int r0) {
    const int tid_ = get_tid(); const int lane = tid_ & 63, wid = tid_ >> 6;
    const float* gain = p.in[which ? 7 : 6] + layer * 1024;
    const float* modl = (const float*)(p.ws + T_MOD) + layer * 3 * 6144 + (which ? 3072 : 0);
    const float* H = (const float*)(p.ws + OFF_H);
    bf16_t* dst = (bf16_t*)(p.ws + OFF_A0);
    for (int r = r0 + blockIdx.x * 4 + wid; r < NR; r += gridDim.x * 4) {
        const float* src = from_inputs ? (r < NCTX ? p.in[2] + (size_t)r * 1024 : p.in[0] + (size_t)(r - NCTX) * 1024) : H + (size_t)r * 1024;
        const float* mv = modl + row_vec(r) * 6144;
        f32x4 x[4]; float ss = 0.f;
#pragma unroll
        for (int i = 0; i < 4; ++i) { x[i] = *(const f32x4*)(src + i * 256 + lane * 4); ss += x[i][0] * x[i][0] + x[i][1] * x[i][1] + x[i][2] * x[i][2] + x[i][3] * x[i][3]; }
        ss = wave_sum(ss);
        const float rstd = rsqrtf(ss * (1.f / 1024.f) + 1e-6f);
#pragma unroll
        for (int i = 0; i < 4; ++i) { const int c = i * 256 + lane * 4;
            const f32x4 g = *(const f32x4*)(gain + c), sh = *(const f32x4*)(mv + c), sc = *(const f32x4*)(mv + 1024 + c);
            const f32x4 y = x[i] * rstd * g * (1.f + sc) + sh;
            *(u32x2*)(dst + (size_t)r * 1024 + c) = (u32x2){pk2(y[0], y[1]), pk2(y[2], y[3])}; }
    }
}

template <class Epi>
DI void gemm_phase(char* lds, const bf16_t* A, int lda, const bf16_t* Bt, int K, int mt0, int nmt, int nnt, const Epi& epi) {
    const int tid = get_tid(), lane = tid & 63, wid = tid >> 6, wr = wid >> 1, wc = wid & 1, fr = lane & 15, fq = lane >> 4;
    bf16_t* As = (bf16_t*)lds; bf16_t* Bs = As + 128 * 72;
    const int nk = K >> 6;
    const int lrow = tid >> 3, lkc = (tid & 7) * 8;
    for (int t = blockIdx.x; t < nmt * nnt; t += gridDim.x) {
        const int tn = t % nnt, tm = t / nnt;
        const int m0 = (mt0 + tm) * 128, n0 = tn * 128;
        const bf16_t* Ag = A + (size_t)(m0 + lrow) * lda + lkc;
        const bf16_t* Bg = Bt + (size_t)(n0 + lrow) * K + lkc;
        f32x4 acc[4][4];
#pragma unroll
        for (int m = 0; m < 4; ++m)
#pragma unroll
            for (int n = 0; n < 4; ++n) acc[m][n] = (f32x4){0.f, 0.f, 0.f, 0.f};
        u32x4 ra[4], rb[4];
#pragma unroll
        for (int i = 0; i < 4; ++i) { ra[i] = *(const u32x4*)(Ag + (size_t)i * 32 * lda); rb[i] = *(const u32x4*)(Bg + (size_t)i * 32 * K); }
        for (int kt = 0; kt < nk; ++kt) {
            __syncthreads();
#pragma unroll
            for (int i = 0; i < 4; ++i) { *(u32x4*)(As + (lrow + 32 * i) * 72 + lkc) = ra[i]; *(u32x4*)(Bs + (lrow + 32 * i) * 72 + lkc) = rb[i]; }
            __syncthreads();
            if (kt + 1 < nk) {
#pragma unroll
                for (int i = 0; i < 4; ++i) { ra[i] = *(const u32x4*)(Ag + (size_t)i * 32 * lda + (kt + 1) * 64); rb[i] = *(const u32x4*)(Bg + (size_t)i * 32 * K + (kt + 1) * 64); }
            }
#pragma unroll
            for (int ks = 0; ks < 2; ++ks) {
                bf16x8 a[4], b[4];
#pragma unroll
                for (int m = 0; m < 4; ++m) a[m] = *(const bf16x8*)(As + (wr * 64 + m * 16 + fr) * 72 + ks * 32 + fq * 8);
#pragma unroll
                for (int n = 0; n < 4; ++n) b[n] = *(const bf16x8*)(Bs + (wc * 64 + n * 16 + fr) * 72 + ks * 32 + fq * 8);
#pragma unroll
                for (int m = 0; m < 4; ++m)
#pragma unroll
                    for (int n = 0; n < 4; ++n) acc[m][n] = __builtin_amdgcn_mfma_f32_16x16x32_bf16(b[n], a[m], acc[m][n], 0, 0, 0);
            }
        }
        epi(acc, m0 + wr * 64 + fr, n0 + wc * 64 + fq * 4);
    }
}

struct EpiWin0 {
    float* U32; float* CQKV; float* KR;
    DI void operator()(const f32x4 (&acc)[4][4], int row0, int col0) const {
#pragma unroll
        for (int m = 0; m < 4; ++m) { const size_t r = row0 + m * 16;
#pragma unroll
            for (int n = 0; n < 4; ++n) { const int c = col0 + n * 16;
                if (c < 512) *(f32x4*)(U32 + r * 512 + c) = acc[m][n];
                else if (c < 1152) *(f32x4*)(CQKV + r * 640 + (c - 512)) = acc[m][n];
                else if (c < 1216) *(f32x4*)(KR + r * 64 + (c - 1152)) = acc[m][n]; } }
    }
};
struct EpiBf16 {
    bf16_t* O; int ldo;
    DI void operator()(const f32x4 (&acc)[4][4], int row0, int col0) const {
#pragma unroll
        for (int m = 0; m < 4; ++m) { const size_t r = row0 + m * 16;
#pragma unroll
            for (int n = 0; n < 4; ++n) { const int c = col0 + n * 16; const f32x4 v = acc[m][n];
                *(u32x2*)(O + r * ldo + c) = (u32x2){pk2(v[0], v[1]), pk2(v[2], v[3])}; } }
    }
};
struct EpiKV {
    bf16_t* KNOPE; bf16_t* VT;
    DI void operator()(const f32x4 (&acc)[4][4], int row0, int col0) const {
#pragma unroll
        for (int m = 0; m < 4; ++m) { const int r = row0 + m * 16; const int b = row_batch(r), tp = row_tpos(r);
#pragma unroll
            for (int n = 0; n < 4; ++n) { const int c = col0 + n * 16; const int h = c >> 8, w = c & 255; const f32x4 v = acc[m][n];
                if (w < 128) *(u32x2*)(KNOPE + (size_t)r * 512 + h * 128 + w) = (u32x2){pk2(v[0], v[1]), pk2(v[2], v[3])};
                else { bf16_t* d = VT + ((size_t)(b * 4 + h) * 128 + (w - 128)) * TK + tp; const unsigned p0 = pk2(v[0], v[1]), p1 = pk2(v[2], v[3]);
                    d[0] = (bf16_t)(p0 & 0xffff); d[TK] = (bf16_t)(p0 >> 16); d[2 * TK] = (bf16_t)(p1 & 0xffff); d[3 * TK] = (bf16_t)(p1 >> 16); } } }
    }
};
struct EpiGLU {
    const bf16_t* YG; const float* bias; bf16_t* CAT;
    DI void operator()(const f32x4 (&acc)[4][4], int row0, int col0) const {
#pragma unroll
        for (int m = 0; m < 4; ++m) { const size_t r = row0 + m * 16;
#pragma unroll
            for (int n = 0; n < 4; ++n) { const int c = col0 + n * 16; const f32x4 v = acc[m][n]; const f32x4 bv = *(const f32x4*)(bias + c);
                const u32x2 yy = *(const u32x2*)(YG + r * 512 + c);
                const float y0 = __uint_as_float(yy[0] << 16), y1 = __uint_as_float(yy[0] & 0xffff0000u), y2 = __uint_as_float(yy[1] << 16), y3 = __uint_as_float(yy[1] & 0xffff0000u);
                const float o0 = y0 * sigmoidf_(v[0] + bv[0]), o1 = y1 * sigmoidf_(v[1] + bv[1]), o2 = y2 * sigmoidf_(v[2] + bv[2]), o3 = y3 * sigmoidf_(v[3] + bv[3]);
                *(u32x2*)(CAT + r * 1024 + c) = (u32x2){pk2(o0, o1), pk2(o2, o3)}; } }
    }
};
struct EpiRes {
    const float* res_ctx; const float* res_lat; float* dst_ctx; float* dst_lat; const float* gate;
    DI void operator()(const f32x4 (&acc)[4][4], int row0, int col0) const {
#pragma unroll
        for (int m = 0; m < 4; ++m) { const int r = row0 + m * 16;
            const float* rs = r < NCTX ? res_ctx + (size_t)r * 1024 : res_lat + (size_t)(r - NCTX) * 1024;
            float* ds = r < NCTX ? dst_ctx + (size_t)r * 1024 : dst_lat + (size_t)(r - NCTX) * 1024;
            if (r < NCTX && dst_ctx == nullptr) continue;
            const float* gv = gate + row_vec(r) * 6144;
#pragma unroll
            for (int n = 0; n < 4; ++n) { const int c = col0 + n * 16; const f32x4 g = *(const f32x4*)(gv + c), x = *(const f32x4*)(rs + c);
                *(f32x4*)(ds + c) = x + g * acc[m][n]; } }
    }
};
struct EpiSwiGLU {
    bf16_t* HID;
    DI void operator()(const f32x4 (&acc)[4][4], int row0, int col0) const {
        const int n0 = col0 & ~127, wc = (col0 >> 6) & 1, fq4 = col0 & 15;
        const int hc = (n0 >> 1) + wc * 32 + fq4;
#pragma unroll
        for (int m = 0; m < 4; ++m) { const size_t r = row0 + m * 16;
#pragma unroll
            for (int q = 0; q < 2; ++q) { const f32x4 g = acc[m][2 * q], u = acc[m][2 * q + 1];
                const float o0 = siluf_(g[0]) * u[0], o1 = siluf_(g[1]) * u[1], o2 = siluf_(g[2]) * u[2], o3 = siluf_(g[3]) * u[3];
                *(u32x2*)(HID + r * FH + hc + q * 16) = (u32x2){pk2(o0, o1), pk2(o2, o3)}; } }
    }
};
struct EpiWin1 {
    bf16_t* Q; float* KRAW; bf16_t* VT;
    DI void operator()(const f32x4 (&acc)[4][4], int row0, int col0) const {
#pragma unroll
        for (int m = 0; m < 4; ++m) { const int r = row0 + m * 16; const int b = row_batch(r), tp = row_tpos(r);
#pragma unroll
            for (int n = 0; n < 4; ++n) { const int c = col0 + n * 16; const f32x4 v = acc[m][n];
                if (c < 1024) *(u32x2*)(Q + (size_t)r * 1024 + c) = (u32x2){pk2(v[0], v[1]), pk2(v[2], v[3])};
                else if (c < 1280) *(f32x4*)(KRAW + (size_t)r * 256 + (c - 1024)) = v;
                else { const int cc = c - 1280, h = cc >> 6, d0 = cc & 63; bf16_t* d = VT + ((size_t)(b * 4 + h) * 64 + d0) * TK + tp; const unsigned p0 = pk2(v[0], v[1]), p1 = pk2(v[2], v[3]);
                    d[0] = (bf16_t)(p0 & 0xffff); d[TK] = (bf16_t)(p0 >> 16); d[2 * TK] = (bf16_t)(p1 & 0xffff); d[3 * TK] = (bf16_t)(p1 >> 16); } } }
    }
};

template <int DQK, int DV, bool WIN>
DI void attn_item(char* lds, const bf16_t* Q, int qstride, const bf16_t* Kb, const bf16_t* VTb, int ta0, int ta1, int tb0, int tb1,
                  float m_init, float l_init, bf16_t* O, int ostride, int qpos0) {
    constexpr int NKS = DQK / 16, NDT = DV / 32, KSTR = DQK + 8, VSTR = 68;
    constexpr int KCH = 64 * DQK / 8 / 256, VCH = DV * 8 / 256;
    bf16_t* Ks = (bf16_t*)lds; bf16_t* Vs = Ks + 64 * KSTR;
    const int tid = get_tid(), lane = tid & 63, wid = tid >> 6, r = lane & 31, h2 = lane >> 5;
    bf16x8 qf[NKS];
    { const bf16_t* qrow = Q + (size_t)(wid * 32 + r) * qstride + 8 * h2;
#pragma unroll
      for (int ks = 0; ks < NKS; ++ks) qf[ks] = *(const bf16x8*)(qrow + 16 * ks); }
    f32x16 o[NDT];
#pragma unroll
    for (int dt = 0; dt < NDT; ++dt)
#pragma unroll
        for (int i = 0; i < 16; ++i) o[dt][i] = 0.f;
    float mrun = m_init, lrun = (h2 == 0) ? l_init : 0.f;
    const int na = ta1 - ta0, ntot = na + (tb1 - tb0);
    u32x4 kr[KCH], vr[VCH];
    constexpr int KTPR = (DQK / 8) / KCH;
    constexpr int VTPR = 8 / VCH;
    const int krow = tid / KTPR, kcol = (tid % KTPR) * (KCH * 8);
    const int vrow = tid / VTPR, vcol = (tid % VTPR) * (VCH * 8);
    const bf16_t* kgp = Kb + (size_t)krow * DQK + kcol;
    const bf16_t* vgp = VTb + (size_t)vrow * TK + vcol;
    bf16_t* ksp = Ks + krow * KSTR + kcol;
    bf16_t* vsp = Vs + vrow * VSTR + vcol;
    { const int T = (0 < na) ? ta0 : tb0;
      const bf16_t* kg = kgp + (size_t)T * 64 * DQK; const bf16_t* vg = vgp + T * 64;
#pragma unroll
      for (int i = 0; i < KCH; ++i) kr[i] = *(const u32x4*)(kg + i * 8);
#pragma unroll
      for (int i = 0; i < VCH; ++i) vr[i] = *(const u32x4*)(vg + i * 8); }
    for (int it = 0; it < ntot; ++it) {
        const int T = (it < na) ? ta0 + it : tb0 + (it - na);
        __syncthreads();
#pragma unroll
        for (int i = 0; i < KCH; ++i) *(u32x4*)(ksp + i * 8) = kr[i];
#pragma unroll
        for (int i = 0; i < VCH; ++i) { *(u32x2*)(vsp + i * 8) = (u32x2){vr[i][0], vr[i][1]}; *(u32x2*)(vsp + i * 8 + 4) = (u32x2){vr[i][2], vr[i][3]}; }
        __syncthreads();
        if (it + 1 < ntot) {
            const int Tn = (it + 1 < na) ? ta0 + it + 1 : tb0 + (it + 1 - na);
            const bf16_t* kg = kgp + (size_t)Tn * 64 * DQK; const bf16_t* vg = vgp + Tn * 64;
#pragma unroll
            for (int i = 0; i < KCH; ++i) kr[i] = *(const u32x4*)(kg + i * 8);
#pragma unroll
            for (int i = 0; i < VCH; ++i) vr[i] = *(const u32x4*)(vg + i * 8);
        }
#pragma unroll
        for (int kt2 = 0; kt2 < 2; ++kt2) {
            f32x16 s0;
#pragma unroll
            for (int i = 0; i < 16; ++i) s0[i] = 0.f;
#pragma unroll
            for (int ks = 0; ks < NKS; ++ks) {
                const bf16x8 k0 = *(const bf16x8*)(Ks + (32 * kt2 + r) * KSTR + 16 * ks + 8 * h2);
                s0 = __builtin_amdgcn_mfma_f32_32x32x16_bf16(k0, qf[ks], s0, 0, 0, 0);
            }
            if (WIN && T >= 4) {
                const int qp = qpos0 + wid * 32 + r, kp0 = (T - 4) * 64 + 32 * kt2 + 4 * h2;
#pragma unroll
                for (int i = 0; i < 16; ++i) { const int d0 = kp0 + (i & 3) + 8 * (i >> 2) - qp;
                    if (d0 > 128 || d0 < -128) s0[i] = -1e30f; }
            }
            float mx = s0[0];
#pragma unroll
            for (int i = 1; i < 16; ++i) mx = fmaxf(mx, s0[i]);
            mx = fmaxf(mx, __shfl_xor(mx, 32));
            const float mn = fmaxf(mrun, mx);
            const float alpha = __builtin_amdgcn_exp2f(mrun - mn);
            mrun = mn;
            float rs = 0.f;
#pragma unroll
            for (int i = 0; i < 16; ++i) { s0[i] = __builtin_amdgcn_exp2f(s0[i] - mn); rs += s0[i]; }
            lrun = lrun * alpha + rs;
#pragma unroll
            for (int dt = 0; dt < NDT; ++dt)
#pragma unroll
                for (int i = 0; i < 16; ++i) o[dt][i] *= alpha;
#pragma unroll
            for (int st = 0; st < 2; ++st) {
                u32x4 pw;
                pw[0] = pk2(s0[8 * st + 0], s0[8 * st + 1]); pw[1] = pk2(s0[8 * st + 2], s0[8 * st + 3]); pw[2] = pk2(s0[8 * st + 4], s0[8 * st + 5]); pw[3] = pk2(s0[8 * st + 6], s0[8 * st + 7]);
                const bf16x8 pf = __builtin_bit_cast(bf16x8, pw);
#pragma unroll
                for (int dt = 0; dt < NDT; ++dt) {
                    const bf16_t* vp = Vs + (32 * dt + r) * VSTR + 32 * kt2 + 16 * st + 4 * h2;
                    const s16x4 lo = *(const s16x4*)vp, hi = *(const s16x4*)(vp + 8);
                    const bf16x8 vf = __builtin_shufflevector(lo, hi, 0, 1, 2, 3, 4, 5, 6, 7);
                    o[dt] = __builtin_amdgcn_mfma_f32_32x32x16_bf16(vf, pf, o[dt], 0, 0, 0);
                }
            }
        }
    }
    lrun += __shfl_xor(lrun, 32);
    const float inv = 1.f / lrun;
    bf16_t* orow = O + (size_t)(wid * 32 + r) * ostride;
#pragma unroll
    for (int dt = 0; dt < NDT; ++dt)
#pragma unroll
        for (int g = 0; g < 4; ++g)
            *(u32x2*)(orow + 32 * dt + 8 * g + 4 * h2) = (u32x2){pk2(o[dt][4 * g] * inv, o[dt][4 * g + 1] * inv), pk2(o[dt][4 * g + 2] * inv, o[dt][4 * g + 3] * inv)};
    __syncthreads();
}

DI int s5_row(int b, int dir, int pos) {
    if (pos < CTX) return b * CTX + (dir ? CTX - 1 - pos : pos);
    const int t = pos - CTX; return NCTX + b * SEQ + (dir ? SEQ - 1 - t : t);
}
DI int tok_row(int b, int pos) { return pos < CTX ? b * CTX + pos : NCTX + b * SEQ + (pos - CTX); }

DI void s5a_phase(char* lds, const Params& p) {
    const int tid_ = get_tid(); const int lane = tid_ & 63, wid = tid_ >> 6;
    float* ubuf = (float*)(lds + wid * 4096);
    const float* U32 = (const float*)(p.ws + H_U32);
    const f32x2* LAMB = (const f32x2*)(p.ws + T_LAMB); const f32x2* BB = (const f32x2*)(p.ws + T_BBAR);
    f32x2* E = (f32x2*)(p.ws + H_E);
    const int nitems = 2 * 2 * 32 * NCH;
    for (int it0 = blockIdx.x * 4; it0 < nitems; it0 += gridDim.x * 4) {
        const int it = it0 + wid;
        const int c = it % NCH, dgb = it / NCH, g = dgb & 31, dir = (dgb >> 5) & 1, b = dgb >> 6;
        const int e = (dir * 32 + g) * 64 + lane;
        const f32x2 lam = LAMB[e];
        float bbr[16], bbi[16];
#pragma unroll
        for (int s = 0; s < 16; ++s) { const f32x2 v = BB[e * 16 + s]; bbr[s] = v[0]; bbi[s] = v[1]; }
        __syncthreads();
#pragma unroll
        for (int i = 0; i < 4; ++i) { const int j = i * 16 + (lane >> 2), part = lane & 3; const int row = s5_row(b, dir, c * 64 + j);
            *(f32x4*)(ubuf + j * 16 + part * 4) = *(const f32x4*)(U32 + (size_t)row * 512 + g * 16 + part * 4); }
        __syncthreads();
        float hr = 0.f, hi = 0.f;
        for (int j = 0; j < 64; ++j) {
            float br = 0.f, bi = 0.f;
#pragma unroll
            for (int q = 0; q < 4; ++q) { const f32x4 u = *(const f32x4*)(ubuf + j * 16 + q * 4);
#pragma unroll
                for (int s = 0; s < 4; ++s) { br = fmaf(u[s], bbr[q * 4 + s], br); bi = fmaf(u[s], bbi[q * 4 + s], bi); } }
            const float nr = lam[0] * hr - lam[1] * hi + br, ni = lam[0] * hi + lam[1] * hr + bi;
            hr = nr; hi = ni;
        }
        E[(size_t)it * 64 + lane] = (f32x2){hr, hi};
    }
}
DI void s5b_phase(const Params& p) {
    const int tid_ = get_tid(); const int lane = tid_ & 63, wid = tid_ >> 6;
    const f32x2* LAM64 = (const f32x2*)(p.ws + T_LAM64);
    const f32x2* E = (const f32x2*)(p.ws + H_E); f32x2* CIN = (f32x2*)(p.ws + H_CIN);
    for (int it = blockIdx.x * 4 + wid; it < 2 * 2 * 32; it += gridDim.x * 4) {
        const int g = it & 31, dir = (it >> 5) & 1;
        const f32x2 l64 = LAM64[(dir * 32 + g) * 64 + lane];
        float cr = 0.f, ci = 0.f;
        const size_t base = (size_t)it * NCH * 64 + lane;
#pragma unroll 4
        for (int c = 0; c < NCH; ++c) {
            CIN[base + (size_t)c * 64] = (f32x2){cr, ci};
            const f32x2 ev = E[base + (size_t)c * 64];
            const float nr = l64[0] * cr - l64[1] * ci + ev[0], ni = l64[0] * ci + l64[1] * cr + ev[1];
            cr = nr; ci = ni;
        }
    }
}
DI void s5c_phase(char* lds, const Params& p) {
    const int tid = get_tid(), lane = tid & 63, wid = tid >> 6, dir = wid & 1, half = wid >> 1;
    float* ubuf = (float*)(lds) + half * 1024;
    f32x2* hb = (f32x2*)(lds + 8192) + wid * (8 * 65);
    f32x2* cb = (f32x2*)(lds + 8192 + 16640);
    float* ybuf = (float*)(lds + 8192 + 2 * 16640);
    const float* U32 = (const float*)(p.ws + H_U32);
    const f32x2* LAMB = (const f32x2*)(p.ws + T_LAMB); const f32x2* BB = (const f32x2*)(p.ws + T_BBAR);
    const f32x2* CIN = (const f32x2*)(p.ws + H_CIN);
    bf16_t* YG = (bf16_t*)(p.ws + S_YG);
    const int nitems = 2 * 32 * (NCH / 2);
    for (int it = blockIdx.x; it < nitems; it += gridDim.x) {
        const int cp = it % (NCH / 2), bg = it / (NCH / 2), g = bg & 31, b = bg >> 5;
        const int tc = 2 * cp + half;
        const int sc = dir ? (tc < 4 ? 3 - tc : 4 + 127 - (tc - 4)) : tc;
        const int e = (dir * 32 + g) * 64 + lane;
        const f32x2 lam = LAMB[e];
        float bbr[16], bbi[16];
#pragma unroll
        for (int s = 0; s < 16; ++s) { const f32x2 v = BB[e * 16 + s]; bbr[s] = v[0]; bbi[s] = v[1]; }
        const f32x2 cin = CIN[((size_t)((b * 2 + dir) * 32 + g) * NCH + sc) * 64 + lane];
        __syncthreads();
#pragma unroll
        for (int i = 0; i < 2; ++i) { const int tl = dir * 32 + i * 16 + (lane >> 2), part = lane & 3; const int row = tok_row(b, tc * 64 + tl);
            *(f32x4*)(ubuf + tl * 16 + part * 4) = *(const f32x4*)(U32 + (size_t)row * 512 + g * 16 + part * 4); }
        for (int i = tid; i < 2 * 16 * 64; i += 256) { const int pp = i & 63, s = (i >> 6) & 15, d = i >> 10; const int src = ((d * 32 + g) * 16 + s) * 64 + pp;
            cb[(d * 16 + s) * 65 + pp] = (f32x2){p.in[18][src], p.in[19][src]}; }
        __syncthreads();
        float hr = cin[0], hi = cin[1];
        float* yb = ybuf + wid * 1024;
        const f32x2* cbd = cb + dir * 16 * 65;
        for (int bi = 0; bi < 8; ++bi) {
            for (int jj = 0; jj < 8; ++jj) {
                const int j = bi * 8 + jj; const int tl = dir ? 63 - j : j;
                float br = 0.f, bim = 0.f;
#pragma unroll
                for (int q = 0; q < 4; ++q) { const f32x4 u = *(const f32x4*)(ubuf + tl * 16 + q * 4);
#pragma unroll
                    for (int s = 0; s < 4; ++s) { br = fmaf(u[s], bbr[q * 4 + s], br); bim = fmaf(u[s], bbi[q * 4 + s], bim); } }
                const float nr = lam[0] * hr - lam[1] * hi + br, ni = lam[0] * hi + lam[1] * hr + bim;
                hr = nr; hi = ni;
                hb[jj * 65 + lane] = (f32x2){hr, hi};
            }
            __builtin_amdgcn_fence(__ATOMIC_RELEASE, "workgroup"); __builtin_amdgcn_wave_barrier(); __builtin_amdgcn_fence(__ATOMIC_ACQUIRE, "workgroup");
            { const int jj = lane >> 3, s0 = (lane & 7) * 2;
              float y0 = 0.f, y1 = 0.f;
#pragma unroll 8
              for (int pp = 0; pp < 64; ++pp) { const f32x2 h = hb[jj * 65 + pp]; const f32x2 c0 = cbd[s0 * 65 + pp], c1 = cbd[(s0 + 1) * 65 + pp];
                  y0 = fmaf(h[0], c0[0], y0); y0 = fmaf(-h[1], c0[1], y0); y1 = fmaf(h[0], c1[0], y1); y1 = fmaf(-h[1], c1[1], y1); }
              const int j = bi * 8 + jj; const int tl = dir ? 63 - j : j;
              *(f32x2*)(yb + tl * 16 + s0) = (f32x2){y0, y1}; }
            __builtin_amdgcn_fence(__ATOMIC_RELEASE, "workgroup"); __builtin_amdgcn_wave_barrier(); __builtin_amdgcn_fence(__ATOMIC_ACQUIRE, "workgroup");
        }
        __syncthreads();
        { const int pt = dir * 64 + lane; const float* ya = ybuf + (half * 2) * 1024; const float* ybb = ya + 1024;
#pragma unroll
          for (int q = 0; q < 8; ++q) { const int oidx = pt + 128 * q, tl = oidx >> 4, s = oidx & 15;
              const float y = ya[oidx] + ybb[oidx] + ubuf[tl * 16 + s] * p.in[20][g * 16 + s];
              const float yg = gelu_tanh(y);
              const int row = tok_row(b, tc * 64 + tl);
              YG[(size_t)row * 512 + g * 16 + s] = (bf16_t)(pk2(yg, 0.f) & 0xffff); } }
    }
    __syncthreads();
}

DI void qkvnorm_phase(const Params& p) {
    const int tid_ = get_tid(); const int lane = tid_ & 63, wid = tid_ >> 6;
    const float* CQKV = (const float*)(p.ws + S_CQKV);
    bf16_t* CQN = (bf16_t*)(p.ws + S_CQN); bf16_t* CKVN = (bf16_t*)(p.ws + S_CKVN);
    for (int r = blockIdx.x * 4 + wid; r < NR; r += gridDim.x * 4) {
        const float* src = CQKV + (size_t)r * 640;
        float a[6], k[4]; float sa = 0.f, sk = 0.f;
#pragma unroll
        for (int i = 0; i < 6; ++i) { a[i] = src[lane + 64 * i]; sa += a[i] * a[i]; }
#pragma unroll
        for (int i = 0; i < 4; ++i) { k[i] = src[384 + lane + 64 * i]; sk += k[i] * k[i]; }
        sa = wave_sum(sa); sk = wave_sum(sk);
        const float ra = rsqrtf(sa * (1.f / 384.f) + 1e-6f), rk = rsqrtf(sk * (1.f / 256.f) + 1e-6f);
#pragma unroll
        for (int i = 0; i < 6; ++i) CQN[(size_t)r * 384 + lane + 64 * i] = (bf16_t)(pk2(a[i] * ra * p.in[23][lane + 64 * i], 0.f) & 0xffff);
#pragma unroll
        for (int i = 0; i < 4; ++i) CKVN[(size_t)r * 256 + lane + 64 * i] = (bf16_t)(pk2(k[i] * rk * p.in[25][lane + 64 * i], 0.f) & 0xffff);
    }
}
DI float rope64(float x, int lane, const float* ROPE, int rpos, int cpos) {
    const float partner = __shfl_xor(x, 16);
    const int i = lane & 15; const int pos = lane < 32 ? rpos : cpos;
    const float c = ROPE[(pos * 16 + i) * 2], s = ROPE[(pos * 16 + i) * 2 + 1];
    return (lane & 16) ? x * c + partner * s : x * c - partner * s;
}
DI void mla_prep_phase(const Params& p) {
    const int tid_ = get_tid(); const int lane = tid_ & 63, wid = tid_ >> 6;
    bf16_t* QR = (bf16_t*)(p.ws + S_QRAW); const bf16_t* KN = (const bf16_t*)(p.ws + S_KNOPE); const float* KR = (const float*)(p.ws + H_KR);
    bf16_t* KA = (bf16_t*)(p.ws + S_KA); const float* ROPE = (const float*)(p.ws + T_ROPE);
    const float qsc = 0.07216878364870323f * LOG2E;
    const float qg0 = p.in[27][lane], qg1 = p.in[27][64 + lane], qg2 = p.in[27][128 + lane];
    const float kg0 = p.in[28][lane], kg1 = p.in[28][64 + lane], kg2 = p.in[28][128 + lane];
    for (int r = blockIdx.x * 4 + wid; r < NR; r += gridDim.x * 4) {
        const bool lat = r >= NCTX; const int b = row_batch(r), tp = row_tpos(r); const int t = tp - CTX;
        const int rpos = lat ? (t >> 6) : 0, cpos = lat ? (t & 63) : 0;
        const float krv = KR[(size_t)r * 64 + lane];
#pragma unroll
        for (int h = 0; h < 4; ++h) {
            bf16_t* q = QR + (size_t)r * 768 + h * 192;
            float x0 = bf2f(q[lane]), x1 = bf2f(q[64 + lane]), x2 = bf2f(q[128 + lane]);
            float ss = wave_sum(x0 * x0 + x1 * x1 + x2 * x2);
            float rs = rsqrtf(ss * (1.f / 192.f) + 1e-6f);
            x0 *= rs * qg0; x1 *= rs * qg1; x2 *= rs * qg2;
            if (lat) x2 = rope64(x2, lane, ROPE, rpos, cpos);
            q[lane] = (bf16_t)(pk2(x0 * qsc, 0.f) & 0xffff); q[64 + lane] = (bf16_t)(pk2(x1 * qsc, 0.f) & 0xffff); q[128 + lane] = (bf16_t)(pk2(x2 * qsc, 0.f) & 0xffff);
            const bf16_t* kn = KN + (size_t)r * 512 + h * 128;
            float k0 = bf2f(kn[lane]), k1 = bf2f(kn[64 + lane]), k2 = krv;
            ss = wave_sum(k0 * k0 + k1 * k1 + k2 * k2);
            rs = rsqrtf(ss * (1.f / 192.f) + 1e-6f);
            k0 *= rs * kg0; k1 *= rs * kg1; k2 *= rs * kg2;
            if (lat) k2 = rope64(k2, lane, ROPE, rpos, cpos);
            bf16_t* kd = KA + ((size_t)(b * 4 + h) * TK + tp) * 192;
            kd[lane] = (bf16_t)(pk2(k0, 0.f) & 0xffff); kd[64 + lane] = (bf16_t)(pk2(k1, 0.f) & 0xffff); kd[128 + lane] = (bf16_t)(pk2(k2, 0.f) & 0xffff);
        }
    }
}
DI void win_prep_phase(const Params& p) {
    const int tid_ = get_tid(); const int lane = tid_ & 63, wid = tid_ >> 6;
    bf16_t* Q = (bf16_t*)(p.ws + S1_Q); const float* KRAW = (const float*)(p.ws + S1_KRAW); bf16_t* K1 = (bf16_t*)(p.ws + S1_K);
    const float* ROPE = (const float*)(p.ws + T_ROPE);
    const float qsc = 0.125f * LOG2E;
    const float qg = p.in[31][lane], kg = p.in[32][lane];
    for (int r = blockIdx.x * 4 + wid; r < NR; r += gridDim.x * 4) {
        const bool lat = r >= NCTX; const int b = row_batch(r), tp = row_tpos(r); const int t = tp - CTX;
        const int rpos = lat ? (t >> 6) : 0, cpos = lat ? (t & 63) : 0;
        if (lat) {
#pragma unroll 4
            for (int h = 0; h < 16; ++h) { bf16_t* q = Q + (size_t)r * 1024 + h * 64;
                float x = bf2f(q[lane]); const float ss = wave_sum(x * x); x *= rsqrtf(ss * (1.f / 64.f) + 1e-6f) * qg;
                x = rope64(x, lane, ROPE, rpos, cpos);
                q[lane] = (bf16_t)(pk2(x * qsc, 0.f) & 0xffff); }
        }
#pragma unroll
        for (int h = 0; h < 4; ++h) { float x = KRAW[(size_t)r * 256 + h * 64 + lane]; const float ss = wave_sum(x * x); x *= rsqrtf(ss * (1.f / 64.f) + 1e-6f) * kg;
            if (lat) x = rope64(x, lane, ROPE, rpos, cpos);
            K1[((size_t)(b * 4 + h) * TK + tp) * 64 + lane] = (bf16_t)(pk2(x, 0.f) & 0xffff); }
    }
}

__global__ void __launch_bounds__(NTHREADS, 2) fwd_kernel(Params p) {
    extern __shared__ __attribute__((aligned(16))) char lds[];
    cg::grid_group grid = cg::this_grid();
    char* ws = p.ws;
    const bf16_t* WB = (const bf16_t*)ws;
    const float* MOD = (const float*)(ws + T_MOD);
    float* H = (float*)(ws + OFF_H);
    bf16_t* A0 = (bf16_t*)(ws + OFF_A0);
    const int bid = blockIdx.x, nb = gridDim.x;

    { const int nit = 192 + 24 + p.njobtiles;
      for (int it = bid; it < nit; it += nb) {
          if (it < 192) ada_item(lds, p, it);
          else if (it < 216) tables_item(p, it - 192);
          else { const int lt = it - 216; int j = 0;
#pragma unroll
              for (int q = 1; q < 11; ++q) if (lt >= p.jobs[q].tile0) j = q;
              transpose_tile(lds, ws, p.jobs[j], lt - p.jobs[j].tile0); } } }
    grid.sync();
    modulate_rows(p, 0, 0, true, 0);
    grid.sync();
    { EpiWin0 e{(float*)(ws + H_U32), (float*)(ws + S_CQKV), (float*)(ws + H_KR)};
      gemm_phase(lds, A0, 1024, WB + W_IN0, 1024, 0, NR / 128, 10, e); }
    grid.sync();
    qkvnorm_phase(p);
    s5a_phase(lds, p);
    grid.sync();
    s5b_phase(p);
    { EpiBf16 e{(bf16_t*)(ws + S_QRAW), 768};
      gemm_phase(lds, (const bf16_t*)(ws + S_CQN), 384, WB + W_QB, 384, 0, NR / 128, 6, e); }
    { EpiKV e{(bf16_t*)(ws + S_KNOPE), (bf16_t*)(ws + S_VT)};
      gemm_phase(lds, (const bf16_t*)(ws + S_CKVN), 256, WB + W_KVB, 256, 0, NR / 128, 8, e); }
    grid.sync();
    s5c_phase(lds, p);
    mla_prep_phase(p);
    grid.sync();
    { const bf16_t* QR = (const bf16_t*)(ws + S_QRAW); const bf16_t* KA = (const bf16_t*)(ws + S_KA); const bf16_t* VT = (const bf16_t*)(ws + S_VT);
      const int nlat = 2 * 4 * 64, nall = nlat + 2 * 4 * 2;
#ifndef NOMLA
      for (int it = bid; it < nall; it += nb) {
          if (it < nlat) { const int qb = it & 63, h = (it >> 6) & 3, b = it >> 8; const size_t row = NCTX + (size_t)b * SEQ + qb * 128;
              attn_item<192, 128, false>(lds, QR + row * 768 + h * 192, 768, KA + (size_t)(b * 4 + h) * TK * 192, VT + (size_t)(b * 4 + h) * 128 * TK, 0, NCH, 0, 0, -1e30f, 0.f,
                                         A0 + row * 1024 + 512 + h * 128, 1024, 0); }
          else { const int j = it - nlat; const int qb = j & 1, h = (j >> 1) & 3, b = j >> 3; const size_t row = (size_t)b * CTX + qb * 128;
              attn_item<192, 128, false>(lds, QR + row * 768 + h * 192, 768, KA + (size_t)(b * 4 + h) * TK * 192, VT + (size_t)(b * 4 + h) * 128 * TK, 0, 4, 0, 0, -1e30f, 0.f,
                                         A0 + row * 1024 + 512 + h * 128, 1024, 0); } }
#endif
      EpiGLU e{(const bf16_t*)(ws + S_YG), p.in[22], A0};
      gemm_phase(lds, (const bf16_t*)(ws + S_YG), 512, WB + W_GLU, 512, 0, NR / 128, 4, e); }
    grid.sync();
    { EpiRes e{p.in[2], p.in[0], H, H + (size_t)NCTX * 1024, MOD + 0 * 3 * 6144 + 2048};
      gemm_phase(lds, A0, 1024, WB + W_OUT0, 1024, 0, NR / 128, 8, e); }
    grid.sync();
    modulate_rows(p, 0, 1, false, 0);
    grid.sync();
    { EpiSwiGLU e{(bf16_t*)(ws + S_HID)};
      gemm_phase(lds, A0, 1024, WB + W_GU0, 1024, 0, NR / 128, 44, e); }
    grid.sync();
    { EpiRes e{H, H + (size_t)NCTX * 1024, H, H + (size_t)NCTX * 1024, MOD + 0 * 3 * 6144 + 5120};
      gemm_phase(lds, (const bf16_t*)(ws + S_HID), FH, WB + W_D0, FH, 0, NR / 128, 8, e); }
    grid.sync();
    modulate_rows(p, 1, 0, false, 0);
    grid.sync();
    { EpiWin1 e{(bf16_t*)(ws + S1_Q), (float*)(ws + S1_KRAW), (bf16_t*)(ws + S1_VT)};
      gemm_phase(lds, A0, 1024, WB + W_IN1, 1024, 0, NR / 128, 12, e); }
    grid.sync();
    win_prep_phase(p);
    grid.sync();
    { const bf16_t* Q = (const bf16_t*)(ws + S1_Q); const bf16_t* K1 = (const bf16_t*)(ws + S1_K); const bf16_t* VT = (const bf16_t*)(ws + S1_VT);
      const int nit = 2 * 16 * 64;
      for (int it = bid; it < nit; it += nb) { const int g = it & 3, i = (it >> 2) & 63, kvh = (it >> 8) & 3, b = it >> 10; const int hq = kvh * 4 + g;
          const size_t row = NCTX + (size_t)b * SEQ + i * 128;
          const int l0 = (2 * i - 2) < 0 ? 0 : (2 * i - 2), l1 = (2 * i + 4) > 128 ? 128 : (2 * i + 4);
          attn_item<64, 64, true>(lds, Q + row * 1024 + hq * 64, 1024, K1 + (size_t)(b * 4 + kvh) * TK * 64, VT + (size_t)(b * 4 + kvh) * 64 * TK, 0, 4, 4 + l0, 4 + l1,
                                  p.in[33][hq] * LOG2E, 1.f, A0 + row * 1024 + hq * 64, 1024, i * 128); } }
    grid.sync();
    { EpiRes e{H, H + (size_t)NCTX * 1024, nullptr, H + (size_t)NCTX * 1024, MOD + 1 * 3 * 6144 + 2048};
      gemm_phase(lds, A0, 1024, WB + W_OUT1, 1024, 4, NLAT / 128, 8, e); }
    grid.sync();
    modulate_rows(p, 1, 1, false, NCTX);
    grid.sync();
    { EpiSwiGLU e{(bf16_t*)(ws + S_HID)};
      gemm_phase(lds, A0, 1024, WB + W_GU1, 1024, 4, NLAT / 128, 44, e); }
    grid.sync();
    { EpiRes e{H, H + (size_t)NCTX * 1024, nullptr, p.out, MOD + 1 * 3 * 6144 + 5120};
      gemm_phase(lds, (const bf16_t*)(ws + S_HID), FH, WB + W_D1, FH, 4, NLAT / 128, 8, e); }
}

extern "C" void kernel_launch(void* const* d_in, const int* in_sizes, int n_in, void* d_out, int out_size, void* d_ws, size_t ws_size, hipStream_t stream) {
    static int grid_blocks = 0;
    if (grid_blocks == 0) {
        if (n_in != 34 || ws_size < WS_NEED) { fprintf(stderr, "kernel_launch: unexpected n_in %d / ws %zu (need %zu)\n", n_in, ws_size, (size_t)WS_NEED); grid_blocks = -1; return; }
        int dev = 0, cus = 0, per_cu = 0;
        (void)hipGetDevice(&dev);
        (void)hipDeviceGetAttribute(&cus, hipDeviceAttributeMultiprocessorCount, dev);
        (void)hipFuncSetAttribute((const void*)fwd_kernel, hipFuncAttributeMaxDynamicSharedMemorySize, LDS_BYTES);
        (void)hipOccupancyMaxActiveBlocksPerMultiprocessor(&per_cu, (const void*)fwd_kernel, NTHREADS, LDS_BYTES);
        if (per_cu < 1) { fprintf(stderr, "kernel_launch: occupancy query returned %d\n", per_cu); grid_blocks = -1; return; }
        if (per_cu > 2) per_cu = 2;
        grid_blocks = cus * per_cu;
        fprintf(stderr, "kernel_launch: grid %d (%d CUs x %d)\n", grid_blocks, cus, per_cu);
    }
    if (grid_blocks < 0) return;
    Params p{};
    for (int i = 0; i < 34; ++i) p.in[i] = (const float*)d_in[i];
    p.out = (float*)d_out; p.ws = (char*)d_ws;
    const float* fg = p.in[8]; const float* fu = p.in[9]; const float* fd = p.in[10];
    const size_t FW = (size_t)1024 * FH;
    int t0 = 0;
    auto mk = [&](int idx, const float* a, const float* b, size_t dst, int K, int ld, int npad, int mode) {
        Job& j = p.jobs[idx]; j.a = a; j.b = b; j.dst = dst; j.K = K; j.ld = ld; j.ntk = K / 64; j.ntn = npad / 64; j.tile0 = t0; j.mode = mode; t0 += j.ntk * j.ntn; };
    mk(0, p.in[11], nullptr, W_IN0, 1024, 1216, 1280, 0);
    mk(1, p.in[24], nullptr, W_QB, 384, 768, 768, 0);
    mk(2, p.in[26], nullptr, W_KVB, 256, 1024, 1024, 0);
    mk(3, p.in[21], nullptr, W_GLU, 512, 512, 512, 0);
    mk(4, p.in[12], nullptr, W_OUT0, 1024, 1024, 1024, 0);
    mk(5, fg, fu, W_GU0, 1024, FH, 5632, 1);
    mk(6, fd, nullptr, W_D0, FH, 1024, 1024, 0);
    mk(7, p.in[29], nullptr, W_IN1, 1024, 1536, 1536, 0);
    mk(8, p.in[30], nullptr, W_OUT1, 1024, 1024, 1024, 0);
    mk(9, fg + FW, fu + FW, W_GU1, 1024, FH, 5632, 1);
    mk(10, fd + FW, nullptr, W_D1, FH, 1024, 1024, 0);
    p.njobtiles = t0;
    void* args[] = {&p};
    hipError_t e = hipLaunchCooperativeKernel((const void*)fwd_kernel, dim3(grid_blocks), dim3(NTHREADS), args, LDS_BYTES, stream);
    if (e != hipSuccess) fprintf(stderr, "cooperative launch failed: %s (grid %d)\n", hipGetErrorString(e), grid_blocks);
}
```

```cpp
#include <hip/hip_runtime.h>
#include <hip/hip_cooperative_groups.h>
#include <cstdio>
#include <cstdint>
namespace cg = cooperative_groups;

#define DI __device__ __forceinline__
typedef unsigned short bf16_t;
typedef short bf16x8 __attribute__((ext_vector_type(8)));
typedef short s16x4 __attribute__((ext_vector_type(4)));
typedef float f32x4 __attribute__((ext_vector_type(4)));
typedef float f32x2 __attribute__((ext_vector_type(2)));
typedef float f32x16 __attribute__((ext_vector_type(16)));
typedef unsigned u32x4 __attribute__((ext_vector_type(4)));
typedef unsigned u32x2 __attribute__((ext_vector_type(2)));
typedef __bf16 bf16v2 __attribute__((ext_vector_type(2)));

constexpr int DM = 1024, NBATCH = 2, SEQ = 8192, CTX = 256;
constexpr int NCTX = NBATCH * CTX;
constexpr int NLAT = NBATCH * SEQ;
constexpr int NR = NCTX + NLAT;
constexpr int TK = CTX + SEQ;
constexpr int FH = 2816;
constexpr int NCH = TK / 64;
constexpr float LOG2E = 1.4426950408889634f;
constexpr int LDS_BYTES = 65536;
constexpr int NTHREADS = 256;

constexpr size_t W_IN0 = 0;
constexpr size_t W_QB = W_IN0 + (size_t)1280 * 1024;
constexpr size_t W_KVB = W_QB + (size_t)768 * 384;
constexpr size_t W_GLU = W_KVB + (size_t)1024 * 256;
constexpr size_t W_OUT0 = W_GLU + (size_t)512 * 512;
constexpr size_t W_GU0 = W_OUT0 + (size_t)1024 * 1024;
constexpr size_t W_D0 = W_GU0 + (size_t)5632 * 1024;
constexpr size_t W_IN1 = W_D0 + (size_t)1024 * 2816;
constexpr size_t W_OUT1 = W_IN1 + (size_t)1536 * 1024;
constexpr size_t W_GU1 = W_OUT1 + (size_t)1024 * 1024;
constexpr size_t W_D1 = W_GU1 + (size_t)5632 * 1024;
constexpr size_t W_END = W_D1 + (size_t)1024 * 2816;
constexpr size_t OFF_TAB = W_END * 2;
constexpr size_t T_MOD = OFF_TAB;
constexpr size_t T_ROPE = T_MOD + 2 * 3 * 6144 * 4;
constexpr size_t T_LAMB = T_ROPE + 128 * 16 * 2 * 4;
constexpr size_t T_LAM64 = T_LAMB + 2 * 32 * 64 * 8;
constexpr size_t T_BBAR = T_LAM64 + 2 * 32 * 64 * 8;
constexpr size_t T_BAR = T_BBAR + (size_t)2 * 32 * 64 * 16 * 8;
constexpr size_t OFF_H = OFF_TAB + (1u << 20);
constexpr size_t OFF_A0 = OFF_H + (size_t)NR * 1024 * 4;
constexpr size_t OFF_S = OFF_A0 + (size_t)NR * 1024 * 2;
constexpr size_t WS_NEED = OFF_S + (size_t)108134400;
static_assert(WS_NEED <= ((size_t)256 << 20) && OFF_S + (size_t)NR * FH * 2 <= WS_NEED, "workspace");
constexpr size_t H_U32 = OFF_H;
constexpr size_t H_KR = H_U32 + (size_t)NR * 512 * 4;
constexpr size_t H_E = H_KR + (size_t)NR * 64 * 4;
constexpr size_t H_CIN = H_E + (size_t)2 * 2 * 32 * NCH * 64 * 8;
static_assert(H_CIN + (size_t)2 * 2 * 32 * NCH * 64 * 8 <= OFF_A0, "H region overflow");
constexpr size_t S_CQN = OFF_S;
constexpr size_t S_CKVN = S_CQN + (size_t)NR * 384 * 2;
constexpr size_t S_YG = OFF_S;
constexpr size_t S_X = S_CKVN + (size_t)NR * 256 * 2;
constexpr size_t S_CQKV = S_X;
constexpr size_t S_QRAW = S_X;
constexpr size_t S_KNOPE = S_QRAW + (size_t)NR * 768 * 2;
constexpr size_t S_VT = S_KNOPE + (size_t)NR * 512 * 2;
constexpr size_t S_KA = S_VT + (size_t)2 * 4 * 128 * TK * 2;
static_assert(S_CQKV + (size_t)NR * 640 * 4 <= S_VT, "CQKV overlaps VT");
static_assert(S_KA + (size_t)2 * 4 * TK * 192 * 2 <= WS_NEED, "scratch overflow");
constexpr size_t S_HID = OFF_S;
constexpr size_t S1_Q = OFF_S;
constexpr size_t S1_KRAW = S1_Q + (size_t)NR * 1024 * 2;
constexpr size_t S1_K = S1_KRAW + (size_t)NR * 256 * 4;
constexpr size_t S1_VT = S1_K + (size_t)2 * 4 * TK * 64 * 2;

struct Job { const float* a; const float* b; unsigned long long dst; int K, ld, ntk, ntn, tile0, mode; };
struct Params {
    const float* in[34];
    float* out;
    char* ws;
    Job jobs[11];
    int njobtiles;
    int pad;
};

DI int get_tid() { int t = threadIdx.x; asm volatile("" : "+v"(t)); return t; }
DI unsigned pk2(float lo, float hi) { f32x2 v = {lo, hi}; return __builtin_bit_cast(unsigned, __builtin_convertvector(v, bf16v2)); }
DI float bf2f(unsigned short b) { return __uint_as_float(((unsigned)b) << 16); }
DI float wave_sum(float v) {
#pragma unroll
    for (int o = 32; o > 0; o >>= 1) v += __shfl_xor(v, o);
    return v;
}
DI int row_vec(int r) { return r < NCTX ? 2 : (r - NCTX) / SEQ; }
DI int row_batch(int r) { return r < NCTX ? r / CTX : (r - NCTX) / SEQ; }
DI int row_tpos(int r) { return r < NCTX ? r % CTX : CTX + (r - NCTX) % SEQ; }
DI float sigmoidf_(float x) { return 1.f / (1.f + __expf(-x)); }
DI float siluf_(float x) { return x / (1.f + __expf(-x)); }
DI float gelu_tanh(float y) { const float z = 0.7978845608028654f * (y + 0.044715f * y * y * y); const float t = 1.f - 2.f / (1.f + __expf(2.f * z)); return 0.5f * y * (1.f + t); }
DI void my_sincos(float x, float& s, float& c) {
    const float q = rintf(x * 0.636619772367581f);
    float r = fmaf(-q, 1.5703125f, x);
    r = fmaf(-q, 4.837512969970703125e-4f, r);
    r = fmaf(-q, 7.54978995489188216e-8f, r);
    const int qi = (int)q;
    const float r2 = r * r;
    const float sp = r + r * r2 * (-1.6666654611e-1f + r2 * (8.3321608736e-3f + r2 * (-1.9515295891e-4f)));
    const float cp = 1.0f - 0.5f * r2 + r2 * r2 * (4.166664568298827e-2f + r2 * (-1.388731625493765e-3f + r2 * 2.443315711809948e-5f));
    const int k = qi & 3;
    s = (k == 0) ? sp : (k == 1) ? cp : (k == 2) ? -sp : -cp;
    c = (k == 0) ? cp : (k == 1) ? -sp : (k == 2) ? -cp : sp;
}


#define XB_TMO      128
#define XB_XCNT(j)  (256  + 64 * (j))
#define XB_XSUB(j)  (1280 + 64 * (j))
#define XB_XGEN(j)  (2304 + 64 * (j))
#define XB_TOP      3328
#define XB_TOPGEN   3392
#define XCD_BAR_WORDS 3456
#define XB_SPIN_CAP (1u << 22)
#define LAS __attribute__((address_space(3)))
DI unsigned xb_ld(unsigned* p) { return __hip_atomic_load(p, __ATOMIC_RELAXED, __HIP_MEMORY_SCOPE_AGENT); }
DI unsigned xb_add(unsigned* p, unsigned v) { return __hip_atomic_fetch_add(p, v, __ATOMIC_RELAXED, __HIP_MEMORY_SCOPE_AGENT); }
DI unsigned xb_xcc_id() { return (unsigned)__builtin_amdgcn_s_getreg((3 << 11) | 20) & 0xFu; }
#define XB_SPIN(cond, bar) do { unsigned _sp = 0; while (cond) { __builtin_amdgcn_s_sleep(1); \
    if ((++_sp & 255u) == 0u) { if (xb_ld(&(bar)[XB_TMO])) break; if (_sp > XB_SPIN_CAP) { atomicAdd(&(bar)[XB_TMO], 1u); break; } } } } while (0)
struct XcdBarrier { unsigned* bar; unsigned x; volatile LAS unsigned* st; };
DI XcdBarrier xcd_barrier_post(unsigned* bar, volatile LAS unsigned* st) {
    XcdBarrier b; b.bar = bar; b.x = xb_xcc_id(); b.st = st;
    if (threadIdx.x == 0) (void)xb_add(&bar[XB_XCNT(b.x)], 1u);
    return b;
}
DI void xcd_barrier_complete(unsigned* bar, unsigned x, unsigned& nloc, unsigned& nx) {
    const unsigned G = gridDim.x * gridDim.y * gridDim.z;
    unsigned sum, cnt, mine, sp = 0u;
    for (;;) {
        sum = 0u; cnt = 0u; mine = 0u;
#pragma unroll
        for (unsigned j = 0; j < 16; ++j) { const unsigned c = xb_ld(&bar[XB_XCNT(j)]); sum += c; cnt += (c > 0u) ? 1u : 0u; mine = (j == x) ? c : mine; }
        if (sum == G) break;
        __builtin_amdgcn_s_sleep(1);
        if ((++sp & 255u) == 0u) { if (xb_ld(&bar[XB_TMO])) break; if (sp > XB_SPIN_CAP) { atomicAdd(&bar[XB_TMO], 1u); break; } }
    }
    nloc = mine > 0u ? mine : 1u; nx = cnt > 0u ? cnt : 1u;
}
DI void xcd_barrier(const XcdBarrier& b) {
    asm volatile("s_waitcnt vmcnt(0)" ::: "memory");
    __syncthreads();
    if (threadIdx.x == 0) {
        unsigned* bar = b.bar;
        __builtin_amdgcn_s_waitcnt(0);
        unsigned nloc = b.st[0], nx = b.st[1];
        if (nloc == 0u) { xcd_barrier_complete(bar, b.x, nloc, nx); b.st[0] = nloc; b.st[1] = nx; }
        const unsigned old = xb_add(&bar[XB_XSUB(b.x)], 1u);
        const unsigned gen = old / nloc;
        if (old + 1u == (gen + 1u) * nloc) {
            __builtin_amdgcn_fence(__ATOMIC_RELEASE, "agent");
            asm volatile("s_waitcnt vmcnt(0)" ::: "memory");
            const unsigned og = xb_add(&bar[XB_TOP], 1u);
            const unsigned tg = og / nx;
            if (og + 1u == (tg + 1u) * nx) xb_add(&bar[XB_TOPGEN], 1u);
            else XB_SPIN(xb_ld(&bar[XB_TOPGEN]) == tg, bar);
            __builtin_amdgcn_fence(__ATOMIC_ACQUIRE, "agent");
            xb_add(&bar[XB_XGEN(b.x)], 1u);
            asm volatile("s_waitcnt vmcnt(0)" ::: "memory");
        } else {
            XB_SPIN(xb_ld(&bar[XB_XGEN(b.x)]) == gen, bar);
            __builtin_amdgcn_fence(__ATOMIC_ACQUIRE, "agent");
            asm volatile("s_waitcnt vmcnt(0)" ::: "memory");
        }
    }
    __syncthreads();
}

DI void transpose_tile(char* lds, char* ws, const Job& jb, int lt) {
    float (*tile)[65] = (float (*)[65])lds;
    const int tid = get_tid();
    const int tk = lt % jb.ntk, tn = lt / jb.ntk;
    const int k0 = tk * 64, n0 = tn * 64;
    const int j = tid & 63, kq = tid >> 6;
    const float* src; int col; bool valid = true;
    if (jb.mode == 0) { src = jb.a; col = n0 + j; valid = col < jb.ld; }
    else { const int nsub = j >> 4, i = j & 15; src = (nsub & 1) ? jb.b : jb.a; col = tn * 32 + (nsub >> 1) * 16 + i; }
#pragma unroll
    for (int kk = 0; kk < 16; ++kk) { const int k = kk * 4 + kq; tile[k][j] = valid ? src[(size_t)(k0 + k) * jb.ld + col] : 0.f; }
    __syncthreads();
    const int r = tid >> 2, ks = (tid & 3) * 16;
    unsigned w[8];
#pragma unroll
    for (int q = 0; q < 8; ++q) w[q] = pk2(tile[ks + 2 * q][r], tile[ks + 2 * q + 1][r]);
    bf16_t* d = (bf16_t*)(ws) + jb.dst + (size_t)(n0 + r) * jb.K + k0 + ks;
    *(u32x4*)d = (u32x4){w[0], w[1], w[2], w[3]};
    *(u32x4*)(d + 8) = (u32x4){w[4], w[5], w[6], w[7]};
    __syncthreads();
}

DI void ada_item(char* lds, const Params& p, int it) {
    float* sil = (float*)lds;
    float* red = sil + 3072;
    float* MOD = (float*)(p.ws + T_MOD);
    const int tid = get_tid(), layer = it / 96, n0 = (it % 96) * 64;
    for (int i = tid; i < 3072; i += 256) { const int v = i >> 10, k = i & 1023; const float x = v < 2 ? p.in[1][v * 1024 + k] : p.in[3][k]; sil[i] = siluf_(x); }
    __syncthreads();
    const int j = tid & 63, kq = tid >> 6;
    const float* W = p.in[4] + (size_t)layer * 1024 * 6144 + n0 + j;
    float a0 = 0.f, a1 = 0.f, a2 = 0.f;
#pragma unroll 8
    for (int k = kq * 256; k < kq * 256 + 256; ++k) { const float w = W[(size_t)k * 6144]; a0 += sil[k] * w; a1 += sil[1024 + k] * w; a2 += sil[2048 + k] * w; }
    red[(kq * 3 + 0) * 64 + j] = a0; red[(kq * 3 + 1) * 64 + j] = a1; red[(kq * 3 + 2) * 64 + j] = a2;
    __syncthreads();
    if (tid < 192) { const int v = tid >> 6, jj = tid & 63;
        const float s = red[(0 * 3 + v) * 64 + jj] + red[(1 * 3 + v) * 64 + jj] + red[(2 * 3 + v) * 64 + jj] + red[(3 * 3 + v) * 64 + jj] + p.in[5][layer * 6144 + n0 + jj];
        MOD[(layer * 3 + v) * 6144 + n0 + jj] = s; }
    __syncthreads();
}

DI void tables_item(const Params& p, int it) {
    const int tid = get_tid();
    if (it < 8) {
        const int e = it * 256 + tid, pos = e >> 4, i = e & 15;
        const float inv = exp2f(-(float)i * (13.287712379549449f / 16.f));
        float s, c; my_sincos((float)pos * inv, s, c);
        float* ROPE = (float*)(p.ws + T_ROPE); ROPE[e * 2] = c; ROPE[e * 2 + 1] = s;
    } else {
        const int e = (it - 8) * 256 + tid;
        const int dg = e >> 6;
        const float lr = p.in[13][e], li = p.in[14][e], step = expf(p.in[15][dg]);
        const float a = lr * step, b = li * step;
        const float ea = expf(a);
        float sb, cb; my_sincos(b, sb, cb);
        float sh, ch; my_sincos(0.5f * b, sh, ch);
        const float em1 = a * (1.f + a * 0.5f * (1.f + a * (1.f / 3.f) * (1.f + a * 0.25f * (1.f + a * 0.2f * (1.f + a * (1.f / 6.f))))));
        const float lbr = ea * cb, lbi = ea * sb;
        const float nr = em1 * cb - 2.f * sh * sh, ni = ea * sb;
        const float den = lr * lr + li * li;
        const float qr = (nr * lr + ni * li) / den, qi = (ni * lr - nr * li) / den;
        f32x2* BB = (f32x2*)(p.ws + T_BBAR);
#pragma unroll
        for (int s = 0; s < 16; ++s) { const float br = p.in[16][e * 16 + s], bi = p.in[17][e * 16 + s]; BB[e * 16 + s] = (f32x2){qr * br - qi * bi, qr * bi + qi * br}; }
        ((f32x2*)(p.ws + T_LAMB))[e] = (f32x2){lbr, lbi};
        float pr = lbr, pi = lbi;
#pragma unroll
        for (int q = 0; q < 6; ++q) { const float nr2 = pr * pr - pi * pi, ni2 = 2.f * pr * pi; pr = nr2; pi = ni2; }
        ((f32x2*)(p.ws + T_LAM64))[e] = (f32x2){pr, pi};
    }
}

DI void modulate_rows(const Params& p, int layer, int which, bool from_inputs, int r0) {
    const int tid_ = get_tid(); const int lane = tid_ & 63, wid = tid_ >> 6;
    const float* gain = p.in[which ? 7 : 6] + layer * 1024;
    const float* modl = (const float*)(p.ws + T_MOD) + layer * 3 * 6144 + (which ? 3072 : 0);
    const float* H = (const float*)(p.ws + OFF_H);
    bf16_t* dst = (bf16_t*)(p.ws + OFF_A0);
    for (int r = r0 + blockIdx.x * 4 + wid; r < NR; r += gridDim.x * 4) {
        const float* src = from_inputs ? (r < NCTX ? p.in[2] + (size_t)r * 1024 : p.in[0] + (size_t)(r - NCTX) * 1024) : H + (size_t)r * 1024;
        const float* mv = modl + row_vec(r) * 6144;
        f32x4 x[4]; float ss = 0.f;
#pragma unroll
        for (int i = 0; i < 4; ++i) { x[i] = *(const f32x4*)(src + i * 256 + lane * 4); ss += x[i][0] * x[i][0] + x[i][1] * x[i][1] + x[i][2] * x[i][2] + x[i][3] * x[i][3]; }
        ss = wave_sum(ss);
        const float rstd = rsqrtf(ss * (1.f / 1024.f) + 1e-6f);
#pragma unroll
        for (int i = 0; i < 4; ++i) { const int c = i * 256 + lane * 4;
            const f32x4 g = *(const f32x4*)(gain + c), sh = *(const f32x4*)(mv + c), sc = *(const f32x4*)(mv + 1024 + c);
            const f32x4 y = x[i] * rstd * g * (1.f + sc) + sh;
            *(u32x2*)(dst + (size_t)r * 1024 + c) = (u32x2){pk2(y[0], y[1]), pk2(y[2], y[3])}; }
    }
}

template <class Epi>
DI void gemm_phase(char* lds, const bf16_t* A, int lda, const bf16_t* Bt, int K, int mt0, int nmt, int nnt, const Epi& epi) {
    const int tid = get_tid(), lane = tid & 63, wid = tid >> 6, wr = wid >> 1, wc = wid & 1, fr = lane & 15, fq = lane >> 4;
    bf16_t* As = (bf16_t*)lds; bf16_t* Bs = As + 128 * 72;
    const int nk = K >> 6;
    const int lrow = tid >> 3, lkc = (tid & 7) * 8;
    for (int t = blockIdx.x; t < nmt * nnt; t += gridDim.x) {
        const int tn = t % nnt, tm = t / nnt;
        const int m0 = (mt0 + tm) * 128, n0 = tn * 128;
        const bf16_t* Ag = A + (size_t)(m0 + lrow) * lda + lkc;
        const bf16_t* Bg = Bt + (size_t)(n0 + lrow) * K + lkc;
        f32x4 acc[4][4];
#pragma unroll
        for (int m = 0; m < 4; ++m)
#pragma unroll
            for (int n = 0; n < 4; ++n) acc[m][n] = (f32x4){0.f, 0.f, 0.f, 0.f};
        u32x4 ra[4], rb[4];
#pragma unroll
        for (int i = 0; i < 4; ++i) { ra[i] = *(const u32x4*)(Ag + (size_t)i * 32 * lda); rb[i] = *(const u32x4*)(Bg + (size_t)i * 32 * K); }
        for (int kt = 0; kt < nk; ++kt) {
            __syncthreads();
#pragma unroll
            for (int i = 0; i < 4; ++i) { *(u32x4*)(As + (lrow + 32 * i) * 72 + lkc) = ra[i]; *(u32x4*)(Bs + (lrow + 32 * i) * 72 + lkc) = rb[i]; }
            __syncthreads();
            if (kt + 1 < nk) {
#pragma unroll
                for (int i = 0; i < 4; ++i) { ra[i] = *(const u32x4*)(Ag + (size_t)i * 32 * lda + (kt + 1) * 64); rb[i] = *(const u32x4*)(Bg + (size_t)i * 32 * K + (kt + 1) * 64); }
            }
#pragma unroll
            for (int ks = 0; ks < 2; ++ks) {
                bf16x8 a[4], b[4];
#pragma unroll
                for (int m = 0; m < 4; ++m) a[m] = *(const bf16x8*)(As + (wr * 64 + m * 16 + fr) * 72 + ks * 32 + fq * 8);
#pragma unroll
                for (int n = 0; n < 4; ++n) b[n] = *(const bf16x8*)(Bs + (wc * 64 + n * 16 + fr) * 72 + ks * 32 + fq * 8);
#pragma unroll
                for (int m = 0; m < 4; ++m)
#pragma unroll
                    for (int n = 0; n < 4; ++n) acc[m][n] = __builtin_amdgcn_mfma_f32_16x16x32_bf16(b[n], a[m], acc[m][n], 0, 0, 0);
            }
        }
        epi(acc, m0 + wr * 64 + fr, n0 + wc * 64 + fq * 4);
    }
}

struct EpiWin0 {
    float* U32; float* CQKV; float* KR;
    DI void operator()(const f32x4 (&acc)[4][4], int row0, int col0) const {
#pragma unroll
        for (int m = 0; m < 4; ++m) { const size_t r = row0 + m * 16;
#pragma unroll
            for (int n = 0; n < 4; ++n) { const int c = col0 + n * 16;
                if (c < 512) *(f32x4*)(U32 + r * 512 + c) = acc[m][n];
                else if (c < 1152) *(f32x4*)(CQKV + r * 640 + (c - 512)) = acc[m][n];
                else if (c < 1216) *(f32x4*)(KR + r * 64 + (c - 1152)) = acc[m][n]; } }
    }
};
struct EpiBf16 {
    bf16_t* O; int ldo;
    DI void operator()(const f32x4 (&acc)[4][4], int row0, int col0) const {
#pragma unroll
        for (int m = 0; m < 4; ++m) { const size_t r = row0 + m * 16;
#pragma unroll
            for (int n = 0; n < 4; ++n) { const int c = col0 + n * 16; const f32x4 v = acc[m][n];
                *(u32x2*)(O + r * ldo + c) = (u32x2){pk2(v[0], v[1]), pk2(v[2], v[3])}; } }
    }
};
struct EpiKV {
    bf16_t* KNOPE; bf16_t* VT;
    DI void operator()(const f32x4 (&acc)[4][4], int row0, int col0) const {
#pragma unroll
        for (int m = 0; m < 4; ++m) { const int r = row0 + m * 16; const int b = row_batch(r), tp = row_tpos(r);
#pragma unroll
            for (int n = 0; n < 4; ++n) { const int c = col0 + n * 16; const int h = c >> 8, w = c & 255; const f32x4 v = acc[m][n];
                if (w < 128) *(u32x2*)(KNOPE + (size_t)r * 512 + h * 128 + w) = (u32x2){pk2(v[0], v[1]), pk2(v[2], v[3])};
                else { bf16_t* d = VT + ((size_t)(b * 4 + h) * 128 + (w - 128)) * TK + tp; const unsigned p0 = pk2(v[0], v[1]), p1 = pk2(v[2], v[3]);
                    d[0] = (bf16_t)(p0 & 0xffff); d[TK] = (bf16_t)(p0 >> 16); d[2 * TK] = (bf16_t)(p1 & 0xffff); d[3 * TK] = (bf16_t)(p1 >> 16); } } }
    }
};
struct EpiGLU {
    const bf16_t* YG; const float* bias; bf16_t* CAT;
    DI void operator()(const f32x4 (&acc)[4][4], int row0, int col0) const {
#pragma unroll
        for (int m = 0; m < 4; ++m) { const size_t r = row0 + m * 16;
#pragma unroll
            for (int n = 0; n < 4; ++n) { const int c = col0 + n * 16; const f32x4 v = acc[m][n]; const f32x4 bv = *(const f32x4*)(bias + c);
                const u32x2 yy = *(const u32x2*)(YG + r * 512 + c);
                const float y0 = __uint_as_float(yy[0] << 16), y1 = __uint_as_float(yy[0] & 0xffff0000u), y2 = __uint_as_float(yy[1] << 16), y3 = __uint_as_float(yy[1] & 0xffff0000u);
                const float o0 = y0 * sigmoidf_(v[0] + bv[0]), o1 = y1 * sigmoidf_(v[1] + bv[1]), o2 = y2 * sigmoidf_(v[2] + bv[2]), o3 = y3 * sigmoidf_(v[3] + bv[3]);
                *(u32x2*)(CAT + r * 1024 + c) = (u32x2){pk2(o0, o1), pk2(o2, o3)}; } }
    }
};
struct EpiRes {
    const float* res_ctx; const float* res_lat; float* dst_ctx; float* dst_lat; const float* gate;
    DI void operator()(const f32x4 (&acc)[4][4], int row0, int col0) const {
#pragma unroll
        for (int m = 0; m < 4; ++m) { const int r = row0 + m * 16;
            const float* rs = r < NCTX ? res_ctx + (size_t)r * 1024 : res_lat + (size_t)(r - NCTX) * 1024;
            float* ds = r < NCTX ? dst_ctx + (size_t)r * 1024 : dst_lat + (size_t)(r - NCTX) * 1024;
            if (r < NCTX && dst_ctx == nullptr) continue;
            const float* gv = gate + row_vec(r) * 6144;
#pragma unroll
            for (int n = 0; n < 4; ++n) { const int c = col0 + n * 16; const f32x4 g = *(const f32x4*)(gv + c), x = *(const f32x4*)(rs + c);
                *(f32x4*)(ds + c) = x + g * acc[m][n]; } }
    }
};
struct EpiSwiGLU {
    bf16_t* HID;
    DI void operator()(const f32x4 (&acc)[4][4], int row0, int col0) const {
        const int n0 = col0 & ~127, wc = (col0 >> 6) & 1, fq4 = col0 & 15;
        const int hc = (n0 >> 1) + wc * 32 + fq4;
#pragma unroll
        for (int m = 0; m < 4; ++m) { const size_t r = row0 + m * 16;
#pragma unroll
            for (int q = 0; q < 2; ++q) { const f32x4 g = acc[m][2 * q], u = acc[m][2 * q + 1];
                const float o0 = siluf_(g[0]) * u[0], o1 = siluf_(g[1]) * u[1], o2 = siluf_(g[2]) * u[2], o3 = siluf_(g[3]) * u[3];
                *(u32x2*)(HID + r * FH + hc + q * 16) = (u32x2){pk2(o0, o1), pk2(o2, o3)}; } }
    }
};
struct EpiWin1 {
    bf16_t* Q; float* KRAW; bf16_t* VT;
    DI void operator()(const f32x4 (&acc)[4][4], int row0, int col0) const {
#pragma unroll
        for (int m = 0; m < 4; ++m) { const int r = row0 + m * 16; const int b = row_batch(r), tp = row_tpos(r);
#pragma unroll
            for (int n = 0; n < 4; ++n) { const int c = col0 + n * 16; const f32x4 v = acc[m][n];
                if (c < 1024) *(u32x2*)(Q + (size_t)r * 1024 + c) = (u32x2){pk2(v[0], v[1]), pk2(v[2], v[3])};
                else if (c < 1280) *(f32x4*)(KRAW + (size_t)r * 256 + (c - 1024)) = v;
                else { const int cc = c - 1280, h = cc >> 6, d0 = cc & 63; bf16_t* d = VT + ((size_t)(b * 4 + h) * 64 + d0) * TK + tp; const unsigned p0 = pk2(v[0], v[1]), p1 = pk2(v[2], v[3]);
                    d[0] = (bf16_t)(p0 & 0xffff); d[TK] = (bf16_t)(p0 >> 16); d[2 * TK] = (bf16_t)(p1 & 0xffff); d[3 * TK] = (bf16_t)(p1 >> 16); } } }
    }
};

template <int DQK, int DV, bool WIN>
DI void attn_item(char* lds, const bf16_t* Q, int qstride, const bf16_t* Kb, const bf16_t* VTb, int ta0, int ta1, int tb0, int tb1,
                  float m_init, float l_init, bf16_t* O, int ostride, int qpos0) {
    constexpr int NKS = DQK / 16, NDT = DV / 32, KSTR = DQK + 8, VSTR = 68;
    constexpr int KCH = 64 * DQK / 8 / 256, VCH = DV * 8 / 256;
    bf16_t* Ks = (bf16_t*)lds; bf16_t* Vs = Ks + 64 * KSTR;
    const int tid = get_tid(), lane = tid & 63, wid = tid >> 6, r = lane & 31, h2 = lane >> 5;
    bf16x8 qf[NKS];
    { const bf16_t* qrow = Q + (size_t)(wid * 32 + r) * qstride + 8 * h2;
#pragma unroll
      for (int ks = 0; ks < NKS; ++ks) qf[ks] = *(const bf16x8*)(qrow + 16 * ks); }
    f32x16 o[NDT];
#pragma unroll
    for (int dt = 0; dt < NDT; ++dt)
#pragma unroll
        for (int i = 0; i < 16; ++i) o[dt][i] = 0.f;
    float mrun = m_init, lrun = (h2 == 0) ? l_init : 0.f;
    const int na = ta1 - ta0, ntot = na + (tb1 - tb0);
    u32x4 kr[KCH], vr[VCH];
    constexpr int KTPR = (DQK / 8) / KCH;
    constexpr int VTPR = 8 / VCH;
    const int krow = tid / KTPR, kcol = (tid % KTPR) * (KCH * 8);
    const int vrow = tid / VTPR, vcol = (tid % VTPR) * (VCH * 8);
    const bf16_t* kgp = Kb + (size_t)krow * DQK + kcol;
    const bf16_t* vgp = VTb + (size_t)vrow * TK + vcol;
    bf16_t* ksp = Ks + krow * KSTR + kcol;
    bf16_t* vsp = Vs + vrow * VSTR + vcol;
    { const int T = (0 < na) ? ta0 : tb0;
      const bf16_t* kg = kgp + (size_t)T * 64 * DQK; const bf16_t* vg = vgp + T * 64;
#pragma unroll
      for (int i = 0; i < KCH; ++i) kr[i] = *(const u32x4*)(kg + i * 8);
#pragma unroll
      for (int i = 0; i < VCH; ++i) vr[i] = *(const u32x4*)(vg + i * 8); }
    for (int it = 0; it < ntot; ++it) {
        const int T = (it < na) ? ta0 + it : tb0 + (it - na);
        __syncthreads();
#pragma unroll
        for (int i = 0; i < KCH; ++i) *(u32x4*)(ksp + i * 8) = kr[i];
#pragma unroll
        for (int i = 0; i < VCH; ++i) { *(u32x2*)(vsp + i * 8) = (u32x2){vr[i][0], vr[i][1]}; *(u32x2*)(vsp + i * 8 + 4) = (u32x2){vr[i][2], vr[i][3]}; }
        __syncthreads();
        if (it + 1 < ntot) {
            const int Tn = (it + 1 < na) ? ta0 + it + 1 : tb0 + (it + 1 - na);
            const bf16_t* kg = kgp + (size_t)Tn * 64 * DQK; const bf16_t* vg = vgp + Tn * 64;
#pragma unroll
            for (int i = 0; i < KCH; ++i) kr[i] = *(const u32x4*)(kg + i * 8);
#pragma unroll
            for (int i = 0; i < VCH; ++i) vr[i] = *(const u32x4*)(vg + i * 8);
        }
#pragma unroll
        for (int kt2 = 0; kt2 < 2; ++kt2) {
            f32x16 s0;
#pragma unroll
            for (int i = 0; i < 16; ++i) s0[i] = 0.f;
#pragma unroll
            for (int ks = 0; ks < NKS; ++ks) {
                const bf16x8 k0 = *(const bf16x8*)(Ks + (32 * kt2 + r) * KSTR + 16 * ks + 8 * h2);
                s0 = __builtin_amdgcn_mfma_f32_32x32x16_bf16(k0, qf[ks], s0, 0, 0, 0);
            }
            if (WIN && T >= 4) {
                const int qp = qpos0 + wid * 32 + r, kp0 = (T - 4) * 64 + 32 * kt2 + 4 * h2;
#pragma unroll
                for (int i = 0; i < 16; ++i) { const int d0 = kp0 + (i & 3) + 8 * (i >> 2) - qp;
                    if (d0 > 128 || d0 < -128) s0[i] = -1e30f; }
            }
            float mx = s0[0];
#pragma unroll
            for (int i = 1; i < 16; ++i) mx = fmaxf(mx, s0[i]);
            mx = fmaxf(mx, __shfl_xor(mx, 32));
            const float mn = fmaxf(mrun, mx);
            const float alpha = __builtin_amdgcn_exp2f(mrun - mn);
            mrun = mn;
            float rs = 0.f;
#pragma unroll
            for (int i = 0; i < 16; ++i) { s0[i] = __builtin_amdgcn_exp2f(s0[i] - mn); rs += s0[i]; }
            lrun = lrun * alpha + rs;
#pragma unroll
            for (int dt = 0; dt < NDT; ++dt)
#pragma unroll
                for (int i = 0; i < 16; ++i) o[dt][i] *= alpha;
#pragma unroll
            for (int st = 0; st < 2; ++st) {
                u32x4 pw;
                pw[0] = pk2(s0[8 * st + 0], s0[8 * st + 1]); pw[1] = pk2(s0[8 * st + 2], s0[8 * st + 3]); pw[2] = pk2(s0[8 * st + 4], s0[8 * st + 5]); pw[3] = pk2(s0[8 * st + 6], s0[8 * st + 7]);
                const bf16x8 pf = __builtin_bit_cast(bf16x8, pw);
#pragma unroll
                for (int dt = 0; dt < NDT; ++dt) {
                    const bf16_t* vp = Vs + (32 * dt + r) * VSTR + 32 * kt2 + 16 * st + 4 * h2;
                    const s16x4 lo = *(const s16x4*)vp, hi = *(const s16x4*)(vp + 8);
                    const bf16x8 vf = __builtin_shufflevector(lo, hi, 0, 1, 2, 3, 4, 5, 6, 7);
                    o[dt] = __builtin_amdgcn_mfma_f32_32x32x16_bf16(vf, pf, o[dt], 0, 0, 0);
                }
            }
        }
    }
    lrun += __shfl_xor(lrun, 32);
    const float inv = 1.f / lrun;
    bf16_t* orow = O + (size_t)(wid * 32 + r) * ostride;
#pragma unroll
    for (int dt = 0; dt < NDT; ++dt)
#pragma unroll
        for (int g = 0; g < 4; ++g)
            *(u32x2*)(orow + 32 * dt + 8 * g + 4 * h2) = (u32x2){pk2(o[dt][4 * g] * inv, o[dt][4 * g + 1] * inv), pk2(o[dt][4 * g + 2] * inv, o[dt][4 * g + 3] * inv)};
    __syncthreads();
}

DI int s5_row(int b, int dir, int pos) {
    if (pos < CTX) return b * CTX + (dir ? CTX - 1 - pos : pos);
    const int t = pos - CTX; return NCTX + b * SEQ + (dir ? SEQ - 1 - t : t);
}
DI int tok_row(int b, int pos) { return pos < CTX ? b * CTX + pos : NCTX + b * SEQ + (pos - CTX); }

DI void s5a_phase(char* lds, const Params& p) {
    const int tid_ = get_tid(); const int lane = tid_ & 63, wid = tid_ >> 6;
    float* ubuf = (float*)(lds + wid * 4096);
    const float* U32 = (const float*)(p.ws + H_U32);
    const f32x2* LAMB = (const f32x2*)(p.ws + T_LAMB); const f32x2* BB = (const f32x2*)(p.ws + T_BBAR);
    f32x2* E = (f32x2*)(p.ws + H_E);
    const int nitems = 2 * 2 * 32 * NCH;
    for (int it0 = blockIdx.x * 4; it0 < nitems; it0 += gridDim.x * 4) {
        const int it = it0 + wid;
        const int c = it % NCH, dgb = it / NCH, g = dgb & 31, dir = (dgb >> 5) & 1, b = dgb >> 6;
        const int e = (dir * 32 + g) * 64 + lane;
        const f32x2 lam = LAMB[e];
        float bbr[16], bbi[16];
#pragma unroll
        for (int s = 0; s < 16; ++s) { const f32x2 v = BB[e * 16 + s]; bbr[s] = v[0]; bbi[s] = v[1]; }
        __syncthreads();
#pragma unroll
        for (int i = 0; i < 4; ++i) { const int j = i * 16 + (lane >> 2), part = lane & 3; const int row = s5_row(b, dir, c * 64 + j);
            *(f32x4*)(ubuf + j * 16 + part * 4) = *(const f32x4*)(U32 + (size_t)row * 512 + g * 16 + part * 4); }
        __syncthreads();
        float hr = 0.f, hi = 0.f;
        for (int j = 0; j < 64; ++j) {
            float br = 0.f, bi = 0.f;
#pragma unroll
            for (int q = 0; q < 4; ++q) { const f32x4 u = *(const f32x4*)(ubuf + j * 16 + q * 4);
#pragma unroll
                for (int s = 0; s < 4; ++s) { br = fmaf(u[s], bbr[q * 4 + s], br); bi = fmaf(u[s], bbi[q * 4 + s], bi); } }
            const float nr = lam[0] * hr - lam[1] * hi + br, ni = lam[0] * hi + lam[1] * hr + bi;
            hr = nr; hi = ni;
        }
        E[(size_t)it * 64 + lane] = (f32x2){hr, hi};
    }
}
DI void s5b_phase(const Params& p) {
    const int tid_ = get_tid(); const int lane = tid_ & 63, wid = tid_ >> 6;
    const f32x2* LAM64 = (const f32x2*)(p.ws + T_LAM64);
    const f32x2* E = (const f32x2*)(p.ws + H_E); f32x2* CIN = (f32x2*)(p.ws + H_CIN);
    for (int it = blockIdx.x * 4 + wid; it < 2 * 2 * 32; it += gridDim.x * 4) {
        const int g = it & 31, dir = (it >> 5) & 1;
        const f32x2 l64 = LAM64[(dir * 32 + g) * 64 + lane];
        float cr = 0.f, ci = 0.f;
        const size_t base = (size_t)it * NCH * 64 + lane;
#pragma unroll 4
        for (int c = 0; c < NCH; ++c) {
            CIN[base + (size_t)c * 64] = (f32x2){cr, ci};
            const f32x2 ev = E[base + (size_t)c * 64];
            const float nr = l64[0] * cr - l64[1] * ci + ev[0], ni = l64[0] * ci + l64[1] * cr + ev[1];
            cr = nr; ci = ni;
        }
    }
}
DI void s5c_phase(char* lds, const Params& p) {
    const int tid = get_tid(), lane = tid & 63, wid = tid >> 6, dir = wid & 1, half = wid >> 1;
    float* ubuf = (float*)(lds) + half * 1024;
    f32x2* hb = (f32x2*)(lds + 8192) + wid * (8 * 65);
    f32x2* cb = (f32x2*)(lds + 8192 + 16640);
    float* ybuf = (float*)(lds + 8192 + 2 * 16640);
    const float* U32 = (const float*)(p.ws + H_U32);
    const f32x2* LAMB = (const f32x2*)(p.ws + T_LAMB); const f32x2* BB = (const f32x2*)(p.ws + T_BBAR);
    const f32x2* CIN = (const f32x2*)(p.ws + H_CIN);
    bf16_t* YG = (bf16_t*)(p.ws + S_YG);
    const int nitems = 2 * 32 * (NCH / 2);
    for (int it = blockIdx.x; it < nitems; it += gridDim.x) {
        const int cp = it % (NCH / 2), bg = it / (NCH / 2), g = bg & 31, b = bg >> 5;
        const int tc = 2 * cp + half;
        const int sc = dir ? (tc < 4 ? 3 - tc : 4 + 127 - (tc - 4)) : tc;
        const int e = (dir * 32 + g) * 64 + lane;
        const f32x2 lam = LAMB[e];
        float bbr[16], bbi[16];
#pragma unroll
        for (int s = 0; s < 16; ++s) { const f32x2 v = BB[e * 16 + s]; bbr[s] = v[0]; bbi[s] = v[1]; }
        const f32x2 cin = CIN[((size_t)((b * 2 + dir) * 32 + g) * NCH + sc) * 64 + lane];
        __syncthreads();
#pragma unroll
        for (int i = 0; i < 2; ++i) { const int tl = dir * 32 + i * 16 + (lane >> 2), part = lane & 3; const int row = tok_row(b, tc * 64 + tl);
            *(f32x4*)(ubuf + tl * 16 + part * 4) = *(const f32x4*)(U32 + (size_t)row * 512 + g * 16 + part * 4); }
        for (int i = tid; i < 2 * 16 * 64; i += 256) { const int pp = i & 63, s = (i >> 6) & 15, d = i >> 10; const int src = ((d * 32 + g) * 16 + s) * 64 + pp;
            cb[(d * 16 + s) * 65 + pp] = (f32x2){p.in[18][src], p.in[19][src]}; }
        __syncthreads();
        float hr = cin[0], hi = cin[1];
        float* yb = ybuf + wid * 1024;
        const f32x2* cbd = cb + dir * 16 * 65;
        for (int bi = 0; bi < 8; ++bi) {
            for (int jj = 0; jj < 8; ++jj) {
                const int j = bi * 8 + jj; const int tl = dir ? 63 - j : j;
                float br = 0.f, bim = 0.f;
#pragma unroll
                for (int q = 0; q < 4; ++q) { const f32x4 u = *(const f32x4*)(ubuf + tl * 16 + q * 4);
#pragma unroll
                    for (int s = 0; s < 4; ++s) { br = fmaf(u[s], bbr[q * 4 + s], br); bim = fmaf(u[s], bbi[q * 4 + s], bim); } }
                const float nr = lam[0] * hr - lam[1] * hi + br, ni = lam[0] * hi + lam[1] * hr + bim;
                hr = nr; hi = ni;
                hb[jj * 65 + lane] = (f32x2){hr, hi};
            }
            __builtin_amdgcn_fence(__ATOMIC_RELEASE, "workgroup"); __builtin_amdgcn_wave_barrier(); __builtin_amdgcn_fence(__ATOMIC_ACQUIRE, "workgroup");
            { const int jj = lane >> 3, s0 = (lane & 7) * 2;
              float y0 = 0.f, y1 = 0.f;
#pragma unroll 8
              for (int pp = 0; pp < 64; ++pp) { const f32x2 h = hb[jj * 65 + pp]; const f32x2 c0 = cbd[s0 * 65 + pp], c1 = cbd[(s0 + 1) * 65 + pp];
                  y0 = fmaf(h[0], c0[0], y0); y0 = fmaf(-h[1], c0[1], y0); y1 = fmaf(h[0], c1[0], y1); y1 = fmaf(-h[1], c1[1], y1); }
              const int j = bi * 8 + jj; const int tl = dir ? 63 - j : j;
              *(f32x2*)(yb + tl * 16 + s0) = (f32x2){y0, y1}; }
            __builtin_amdgcn_fence(__ATOMIC_RELEASE, "workgroup"); __builtin_amdgcn_wave_barrier(); __builtin_amdgcn_fence(__ATOMIC_ACQUIRE, "workgroup");
        }
        __syncthreads();
        { const int pt = dir * 64 + lane; const float* ya = ybuf + (half * 2) * 1024; const float* ybb = ya + 1024;
#pragma unroll
          for (int q = 0; q < 8; ++q) { const int oidx = pt + 128 * q, tl = oidx >> 4, s = oidx & 15;
              const float y = ya[oidx] + ybb[oidx] + ubuf[tl * 16 + s] * p.in[20][g * 16 + s];
              const float yg = gelu_tanh(y);
              const int row = tok_row(b, tc * 64 + tl);
              YG[(size_t)row * 512 + g * 16 + s] = (bf16_t)(pk2(yg, 0.f) & 0xffff); } }
    }
    __syncthreads();
}

DI void qkvnorm_phase(const Params& p) {
    const int tid_ = get_tid(); const int lane = tid_ & 63, wid = tid_ >> 6;
    const float* CQKV = (const float*)(p.ws + S_CQKV);
    bf16_t* CQN = (bf16_t*)(p.ws + S_CQN); bf16_t* CKVN = (bf16_t*)(p.ws + S_CKVN);
    for (int r = blockIdx.x * 4 + wid; r < NR; r += gridDim.x * 4) {
        const float* src = CQKV + (size_t)r * 640;
        float a[6], k[4]; float sa = 0.f, sk = 0.f;
#pragma unroll
        for (int i = 0; i < 6; ++i) { a[i] = src[lane + 64 * i]; sa += a[i] * a[i]; }
#pragma unroll
        for (int i = 0; i < 4; ++i) { k[i] = src[384 + lane + 64 * i]; sk += k[i] * k[i]; }
        sa = wave_sum(sa); sk = wave_sum(sk);
        const float ra = rsqrtf(sa * (1.f / 384.f) + 1e-6f), rk = rsqrtf(sk * (1.f / 256.f) + 1e-6f);
#pragma unroll
        for (int i = 0; i < 6; ++i) CQN[(size_t)r * 384 + lane + 64 * i] = (bf16_t)(pk2(a[i] * ra * p.in[23][lane + 64 * i], 0.f) & 0xffff);
#pragma unroll
        for (int i = 0; i < 4; ++i) CKVN[(size_t)r * 256 + lane + 64 * i] = (bf16_t)(pk2(k[i] * rk * p.in[25][lane + 64 * i], 0.f) & 0xffff);
    }
}
DI float rope64(float x, int lane, const float* ROPE, int rpos, int cpos) {
    const float partner = __shfl_xor(x, 16);
    const int i = lane & 15; const int pos = lane < 32 ? rpos : cpos;
    const float c = ROPE[(pos * 16 + i) * 2], s = ROPE[(pos * 16 + i) * 2 + 1];
    return (lane & 16) ? x * c + partner * s : x * c - partner * s;
}
DI void mla_prep_phase(const Params& p) {
    const int tid_ = get_tid(); const int lane = tid_ & 63, wid = tid_ >> 6;
    bf16_t* QR = (bf16_t*)(p.ws + S_QRAW); const bf16_t* KN = (const bf16_t*)(p.ws + S_KNOPE); const float* KR = (const float*)(p.ws + H_KR);
    bf16_t* KA = (bf16_t*)(p.ws + S_KA); const float* ROPE = (const float*)(p.ws + T_ROPE);
    const float qsc = 0.07216878364870323f * LOG2E;
    const float qg0 = p.in[27][lane], qg1 = p.in[27][64 + lane], qg2 = p.in[27][128 + lane];
    const float kg0 = p.in[28][lane], kg1 = p.in[28][64 + lane], kg2 = p.in[28][128 + lane];
    for (int r = blockIdx.x * 4 + wid; r < NR; r += gridDim.x * 4) {
        const bool lat = r >= NCTX; const int b = row_batch(r), tp = row_tpos(r); const int t = tp - CTX;
        const int rpos = lat ? (t >> 6) : 0, cpos = lat ? (t & 63) : 0;
        const float krv = KR[(size_t)r * 64 + lane];
#pragma unroll
        for (int h = 0; h < 4; ++h) {
            bf16_t* q = QR + (size_t)r * 768 + h * 192;
            float x0 = bf2f(q[lane]), x1 = bf2f(q[64 + lane]), x2 = bf2f(q[128 + lane]);
            float ss = wave_sum(x0 * x0 + x1 * x1 + x2 * x2);
            float rs = rsqrtf(ss * (1.f / 192.f) + 1e-6f);
            x0 *= rs * qg0; x1 *= rs * qg1; x2 *= rs * qg2;
            if (lat) x2 = rope64(x2, lane, ROPE, rpos, cpos);
            q[lane] = (bf16_t)(pk2(x0 * qsc, 0.f) & 0xffff); q[64 + lane] = (bf16_t)(pk2(x1 * qsc, 0.f) & 0xffff); q[128 + lane] = (bf16_t)(pk2(x2 * qsc, 0.f) & 0xffff);
            const bf16_t* kn = KN + (size_t)r * 512 + h * 128;
            float k0 = bf2f(kn[lane]), k1 = bf2f(kn[64 + lane]), k2 = krv;
            ss = wave_sum(k0 * k0 + k1 * k1 + k2 * k2);
            rs = rsqrtf(ss * (1.f / 192.f) + 1e-6f);
            k0 *= rs * kg0; k1 *= rs * kg1; k2 *= rs * kg2;
            if (lat) k2 = rope64(k2, lane, ROPE, rpos, cpos);
            bf16_t* kd = KA + ((size_t)(b * 4 + h) * TK + tp) * 192;
            kd[lane] = (bf16_t)(pk2(k0, 0.f) & 0xffff); kd[64 + lane] = (bf16_t)(pk2(k1, 0.f) & 0xffff); kd[128 + lane] = (bf16_t)(pk2(k2, 0.f) & 0xffff);
        }
    }
}
DI void win_prep_phase(const Params& p) {
    const int tid_ = get_tid(); const int lane = tid_ & 63, wid = tid_ >> 6;
    bf16_t* Q = (bf16_t*)(p.ws + S1_Q); const float* KRAW = (const float*)(p.ws + S1_KRAW); bf16_t* K1 = (bf16_t*)(p.ws + S1_K);
    const float* ROPE = (const float*)(p.ws + T_ROPE);
    const float qsc = 0.125f * LOG2E;
    const float qg = p.in[31][lane], kg = p.in[32][lane];
    for (int r = blockIdx.x * 4 + wid; r < NR; r += gridDim.x * 4) {
        const bool lat = r >= NCTX; const int b = row_batch(r), tp = row_tpos(r); const int t = tp - CTX;
        const int rpos = lat ? (t >> 6) : 0, cpos = lat ? (t & 63) : 0;
        if (lat) {
#pragma unroll 4
            for (int h = 0; h < 16; ++h) { bf16_t* q = Q + (size_t)r * 1024 + h * 64;
                float x = bf2f(q[lane]); const float ss = wave_sum(x * x); x *= rsqrtf(ss * (1.f / 64.f) + 1e-6f) * qg;
                x = rope64(x, lane, ROPE, rpos, cpos);
                q[lane] = (bf16_t)(pk2(x * qsc, 0.f) & 0xffff); }
        }
#pragma unroll
        for (int h = 0; h < 4; ++h) { float x = KRAW[(size_t)r * 256 + h * 64 + lane]; const float ss = wave_sum(x * x); x *= rsqrtf(ss * (1.f / 64.f) + 1e-6f) * kg;
            if (lat) x = rope64(x, lane, ROPE, rpos, cpos);
            K1[((size_t)(b * 4 + h) * TK + tp) * 64 + lane] = (bf16_t)(pk2(x, 0.f) & 0xffff); }
    }
}

__global__ void __launch_bounds__(NTHREADS, 2) fwd_kernel(Params p) {
    extern __shared__ __attribute__((aligned(16))) char lds[];
    cg::grid_group grid = cg::this_grid();
    char* ws = p.ws;
    const bf16_t* WB = (const bf16_t*)ws;
    const float* MOD = (const float*)(ws + T_MOD);
    float* H = (float*)(ws + OFF_H);
    bf16_t* A0 = (bf16_t*)(ws + OFF_A0);
    const int bid = blockIdx.x, nb = gridDim.x;
    volatile LAS unsigned* xst = (volatile LAS unsigned*)(lds + (LDS_BYTES - 16));
    if (threadIdx.x == 0) { xst[0] = 0u; xst[1] = 0u; }
    __syncthreads();
    const XcdBarrier xb = xcd_barrier_post((unsigned*)(ws + T_BAR), xst);
    if (p.pad == 0x7fffffff) grid.sync();
#define GRID_SYNC() xcd_barrier(xb)

    { const int nit = 192 + 24 + p.njobtiles;
      for (int it = bid; it < nit; it += nb) {
          if (it < 192) ada_item(lds, p, it);
          else if (it < 216) tables_item(p, it - 192);
          else { const int lt = it - 216; int j = 0;
#pragma unroll
              for (int q = 1; q < 11; ++q) if (lt >= p.jobs[q].tile0) j = q;
              transpose_tile(lds, ws, p.jobs[j], lt - p.jobs[j].tile0); } } }
    GRID_SYNC();
    modulate_rows(p, 0, 0, true, 0);
    GRID_SYNC();
    { EpiWin0 e{(float*)(ws + H_U32), (float*)(ws + S_CQKV), (float*)(ws + H_KR)};
      gemm_phase(lds, A0, 1024, WB + W_IN0, 1024, 0, NR / 128, 10, e); }
    GRID_SYNC();
    qkvnorm_phase(p);
    s5a_phase(lds, p);
    GRID_SYNC();
    s5b_phase(p);
    { EpiBf16 e{(bf16_t*)(ws + S_QRAW), 768};
      gemm_phase(lds, (const bf16_t*)(ws + S_CQN), 384, WB + W_QB, 384, 0, NR / 128, 6, e); }
    { EpiKV e{(bf16_t*)(ws + S_KNOPE), (bf16_t*)(ws + S_VT)};
      gemm_phase(lds, (const bf16_t*)(ws + S_CKVN), 256, WB + W_KVB, 256, 0, NR / 128, 8, e); }
    GRID_SYNC();
    s5c_phase(lds, p);
    mla_prep_phase(p);
    GRID_SYNC();
    { const bf16_t* QR = (const bf16_t*)(ws + S_QRAW); const bf16_t* KA = (const bf16_t*)(ws + S_KA); const bf16_t* VT = (const bf16_t*)(ws + S_VT);
      const int nlat = 2 * 4 * 64, nall = nlat + 2 * 4 * 2;
#ifndef NOMLA
      for (int it = bid; it < nall; it += nb) {
          if (it < nlat) { const int qb = it & 63, h = (it >> 6) & 3, b = it >> 8; const size_t row = NCTX + (size_t)b * SEQ + qb * 128;
              attn_item<192, 128, false>(lds, QR + row * 768 + h * 192, 768, KA + (size_t)(b * 4 + h) * TK * 192, VT + (size_t)(b * 4 + h) * 128 * TK, 0, NCH, 0, 0, -1e30f, 0.f,
                                         A0 + row * 1024 + 512 + h * 128, 1024, 0); }
          else { const int j = it - nlat; const int qb = j & 1, h = (j >> 1) & 3, b = j >> 3; const size_t row = (size_t)b * CTX + qb * 128;
              attn_item<192, 128, false>(lds, QR + row * 768 + h * 192, 768, KA + (size_t)(b * 4 + h) * TK * 192, VT + (size_t)(b * 4 + h) * 128 * TK, 0, 4, 0, 0, -1e30f, 0.f,
                                         A0 + row * 1024 + 512 + h * 128, 1024, 0); } }
#endif
      EpiGLU e{(const bf16_t*)(ws + S_YG), p.in[22], A0};
      gemm_phase(lds, (const bf16_t*)(ws + S_YG), 512, WB + W_GLU, 512, 0, NR / 128, 4, e); }
    GRID_SYNC();
    { EpiRes e{p.in[2], p.in[0], H, H + (size_t)NCTX * 1024, MOD + 0 * 3 * 6144 + 2048};
      gemm_phase(lds, A0, 1024, WB + W_OUT0, 1024, 0, NR / 128, 8, e); }
    GRID_SYNC();
    modulate_rows(p, 0, 1, false, 0);
    GRID_SYNC();
    { EpiSwiGLU e{(bf16_t*)(ws + S_HID)};
      gemm_phase(lds, A0, 1024, WB + W_GU0, 1024, 0, NR / 128, 44, e); }
    GRID_SYNC();
    { EpiRes e{H, H + (size_t)NCTX * 1024, H, H + (size_t)NCTX * 1024, MOD + 0 * 3 * 6144 + 5120};
      gemm_phase(lds, (const bf16_t*)(ws + S_HID), FH, WB + W_D0, FH, 0, NR / 128, 8, e); }
    GRID_SYNC();
    modulate_rows(p, 1, 0, false, 0);
    GRID_SYNC();
    { EpiWin1 e{(bf16_t*)(ws + S1_Q), (float*)(ws + S1_KRAW), (bf16_t*)(ws + S1_VT)};
      gemm_phase(lds, A0, 1024, WB + W_IN1, 1024, 0, NR / 128, 12, e); }
    GRID_SYNC();
    win_prep_phase(p);
    GRID_SYNC();
    { const bf16_t* Q = (const bf16_t*)(ws + S1_Q); const bf16_t* K1 = (const bf16_t*)(ws + S1_K); const bf16_t* VT = (const bf16_t*)(ws + S1_VT);
      const int nit = 2 * 16 * 64;
      for (int it = bid; it < nit; it += nb) { const int g = it & 3, i = (it >> 2) & 63, kvh = (it >> 8) & 3, b = it >> 10; const int hq = kvh * 4 + g;
          const size_t row = NCTX + (size_t)b * SEQ + i * 128;
          const int l0 = (2 * i - 2) < 0 ? 0 : (2 * i - 2), l1 = (2 * i + 4) > 128 ? 128 : (2 * i + 4);
          attn_item<64, 64, true>(lds, Q + row * 1024 + hq * 64, 1024, K1 + (size_t)(b * 4 + kvh) * TK * 64, VT + (size_t)(b * 4 + kvh) * 64 * TK, 0, 4, 4 + l0, 4 + l1,
                                  p.in[33][hq] * LOG2E, 1.f, A0 + row * 1024 + hq * 64, 1024, i * 128); } }
    GRID_SYNC();
    { EpiRes e{H, H + (size_t)NCTX * 1024, nullptr, H + (size_t)NCTX * 1024, MOD + 1 * 3 * 6144 + 2048};
      gemm_phase(lds, A0, 1024, WB + W_OUT1, 1024, 4, NLAT / 128, 8, e); }
    GRID_SYNC();
    modulate_rows(p, 1, 1, false, NCTX);
    GRID_SYNC();
    { EpiSwiGLU e{(bf16_t*)(ws + S_HID)};
      gemm_phase(lds, A0, 1024, WB + W_GU1, 1024, 4, NLAT / 128, 44, e); }
    GRID_SYNC();
    { EpiRes e{H, H + (size_t)NCTX * 1024, nullptr, p.out, MOD + 1 * 3 * 6144 + 5120};
      gemm_phase(lds, (const bf16_t*)(ws + S_HID), FH, WB + W_D1, FH, 4, NLAT / 128, 8, e); }
}

extern "C" void kernel_launch(void* const* d_in, const int* in_sizes, int n_in, void* d_out, int out_size, void* d_ws, size_t ws_size, hipStream_t stream) {
    static int grid_blocks = 0;
    if (grid_blocks == 0) {
        if (n_in != 34 || ws_size < WS_NEED) { fprintf(stderr, "kernel_launch: unexpected n_in %d / ws %zu (need %zu)\n", n_in, ws_size, (size_t)WS_NEED); grid_blocks = -1; return; }
        int dev = 0, cus = 0, per_cu = 0;
        (void)hipGetDevice(&dev);
        (void)hipDeviceGetAttribute(&cus, hipDeviceAttributeMultiprocessorCount, dev);
        (void)hipFuncSetAttribute((const void*)fwd_kernel, hipFuncAttributeMaxDynamicSharedMemorySize, LDS_BYTES);
        (void)hipOccupancyMaxActiveBlocksPerMultiprocessor(&per_cu, (const void*)fwd_kernel, NTHREADS, LDS_BYTES);
        if (per_cu < 1) { fprintf(stderr, "kernel_launch: occupancy query returned %d\n", per_cu); grid_blocks = -1; return; }
        if (per_cu > 2) per_cu = 2;
        grid_blocks = cus * per_cu;
        fprintf(stderr, "kernel_launch: grid %d (%d CUs x %d)\n", grid_blocks, cus, per_cu);
    }
    if (grid_blocks < 0) return;
    Params p{};
    for (int i = 0; i < 34; ++i) p.in[i] = (const float*)d_in[i];
    p.out = (float*)d_out; p.ws = (char*)d_ws;
    const float* fg = p.in[8]; const float* fu = p.in[9]; const float* fd = p.in[10];
    const size_t FW = (size_t)1024 * FH;
    int t0 = 0;
    auto mk = [&](int idx, const float* a, const float* b, size_t dst, int K, int ld, int npad, int mode) {
        Job& j = p.jobs[idx]; j.a = a; j.b = b; j.dst = dst; j.K = K; j.ld = ld; j.ntk = K / 64; j.ntn = npad / 64; j.tile0 = t0; j.mode = mode; t0 += j.ntk * j.ntn; };
    mk(0, p.in[11], nullptr, W_IN0, 1024, 1216, 1280, 0);
    mk(1, p.in[24], nullptr, W_QB, 384, 768, 768, 0);
    mk(2, p.in[26], nullptr, W_KVB, 256, 1024, 1024, 0);
    mk(3, p.in[21], nullptr, W_GLU, 512, 512, 512, 0);
    mk(4, p.in[12], nullptr, W_OUT0, 1024, 1024, 1024, 0);
    mk(5, fg, fu, W_GU0, 1024, FH, 5632, 1);
    mk(6, fd, nullptr, W_D0, FH, 1024, 1024, 0);
    mk(7, p.in[29], nullptr, W_IN1, 1024, 1536, 1536, 0);
    mk(8, p.in[30], nullptr, W_OUT1, 1024, 1024, 1024, 0);
    mk(9, fg + FW, fu + FW, W_GU1, 1024, FH, 5632, 1);
    mk(10, fd + FW, nullptr, W_D1, FH, 1024, 1024, 0);
    p.njobtiles = t0;
    if (hipMemsetAsync((char*)d_ws + T_BAR, 0, XCD_BAR_WORDS * 4, stream) != hipSuccess) { fprintf(stderr, "kernel_launch: memset failed\n"); return; }
    void* args[] = {&p};
    hipError_t e = hipLaunchCooperativeKernel((const void*)fwd_kernel, dim3(grid_blocks), dim3(NTHREADS), args, LDS_BYTES, stream);
    if (e != hipSuccess) fprintf(stderr, "cooperative launch failed: %s (grid %d)\n", hipGetErrorString(e), grid_blocks);
}
```

```cpp
#include <hip/hip_runtime.h>
#include <hip/hip_cooperative_groups.h>
#include <cstdio>
#include <cstdint>
namespace cg = cooperative_groups;

#define DI __device__ __forceinline__
typedef unsigned short bf16_t;
typedef short bf16x8 __attribute__((ext_vector_type(8)));
typedef short s16x4 __attribute__((ext_vector_type(4)));
typedef float f32x4 __attribute__((ext_vector_type(4)));
typedef float f32x2 __attribute__((ext_vector_type(2)));
typedef float f32x16 __attribute__((ext_vector_type(16)));
typedef unsigned u32x4 __attribute__((ext_vector_type(4)));
typedef unsigned u32x2 __attribute__((ext_vector_type(2)));
typedef __bf16 bf16v2 __attribute__((ext_vector_type(2)));

constexpr int DM = 1024, NBATCH = 2, SEQ = 8192, CTX = 256;
constexpr int NCTX = NBATCH * CTX;
constexpr int NLAT = NBATCH * SEQ;
constexpr int NR = NCTX + NLAT;
constexpr int TK = CTX + SEQ;
constexpr int FH = 2816;
constexpr int NCH = TK / 64;
constexpr float LOG2E = 1.4426950408889634f;
constexpr int LDS_BYTES = 65536 + 64;
constexpr int NTHREADS = 256;

constexpr size_t W_IN0 = 0;
constexpr size_t W_QB = W_IN0 + (size_t)1280 * 1024;
constexpr size_t W_KVB = W_QB + (size_t)768 * 384;
constexpr size_t W_GLU = W_KVB + (size_t)1024 * 256;
constexpr size_t W_OUT0 = W_GLU + (size_t)512 * 512;
constexpr size_t W_GU0 = W_OUT0 + (size_t)1024 * 1024;
constexpr size_t W_D0 = W_GU0 + (size_t)5632 * 1024;
constexpr size_t W_IN1 = W_D0 + (size_t)1024 * 2816;
constexpr size_t W_OUT1 = W_IN1 + (size_t)1536 * 1024;
constexpr size_t W_GU1 = W_OUT1 + (size_t)1024 * 1024;
constexpr size_t W_D1 = W_GU1 + (size_t)5632 * 1024;
constexpr size_t W_END = W_D1 + (size_t)1024 * 2816;
constexpr size_t OFF_TAB = W_END * 2;
constexpr size_t T_MOD = OFF_TAB;
constexpr size_t T_ROPE = T_MOD + 2 * 3 * 6144 * 4;
constexpr size_t T_LAMB = T_ROPE + 128 * 16 * 2 * 4;
constexpr size_t T_LAM64 = T_LAMB + 2 * 32 * 64 * 8;
constexpr size_t T_BBAR = T_LAM64 + 2 * 32 * 64 * 8;
constexpr size_t T_BAR = T_BBAR + (size_t)2 * 32 * 64 * 16 * 8;
constexpr size_t OFF_H = OFF_TAB + (1u << 20);
constexpr size_t OFF_A0 = OFF_H + (size_t)NR * 1024 * 4;
constexpr size_t OFF_S = OFF_A0 + (size_t)NR * 1024 * 2;
constexpr size_t WS_NEED = OFF_S + (size_t)108134400;
static_assert(WS_NEED <= ((size_t)256 << 20) && OFF_S + (size_t)NR * FH * 2 <= WS_NEED, "workspace");
constexpr int SL = 32;
constexpr int NCK = TK / SL;
constexpr int CHR = NBATCH * NCK;
constexpr size_t H_UA = OFF_H;
constexpr size_t H_KR = H_UA + (size_t)(32 * CHR + 128) * 768 * 2;
constexpr size_t H_E = H_KR + (size_t)NR * 64 * 4;
constexpr size_t H_KK = H_E + (size_t)32 * CHR * 256 * 4;
constexpr size_t H_POW = H_KK + (size_t)32 * 2 * 32 * 256 * 4;
constexpr size_t H_W1A = H_POW + (size_t)4096 * 33 * 8;
static_assert(H_W1A + (size_t)32 * 256 * 512 * 2 <= OFF_A0, "H region overflow");
constexpr size_t A_W1B = OFF_A0;
constexpr size_t S_CQN = OFF_S;
constexpr size_t S_CKVN = S_CQN + (size_t)NR * 384 * 2;
constexpr size_t S_YG = OFF_S;
constexpr size_t S_X = S_CKVN + (size_t)NR * 256 * 2;
constexpr size_t S_CQKV = S_X;
constexpr size_t S_QRAW = S_X;
constexpr size_t S_KNOPE = S_QRAW + (size_t)NR * 768 * 2;
constexpr size_t S_VT = S_KNOPE + (size_t)NR * 512 * 2;
constexpr size_t S_KA = S_VT + (size_t)2 * 4 * 128 * TK * 2;
static_assert(S_CQKV + (size_t)NR * 640 * 4 <= S_VT, "CQKV overlaps VT");
static_assert(S_KA + (size_t)2 * 4 * TK * 192 * 2 <= WS_NEED, "scratch overflow");
constexpr size_t S_HID = OFF_S;
constexpr size_t S1_Q = OFF_S;
constexpr size_t S1_KRAW = S1_Q + (size_t)NR * 1024 * 2;
constexpr size_t S1_K = S1_KRAW + (size_t)NR * 256 * 4;
constexpr size_t S1_VT = S1_K + (size_t)2 * 4 * TK * 64 * 2;

struct Job { const float* a; const float* b; unsigned long long dst; int K, ld, ntk, ntn, tile0, mode; };
struct Params {
    const float* in[34];
    float* out;
    char* ws;
    Job jobs[11];
    int njobtiles;
    int pad;
};

DI int get_tid() { int t = threadIdx.x; asm volatile("" : "+v"(t)); return t; }
DI unsigned pk2(float lo, float hi) { f32x2 v = {lo, hi}; return __builtin_bit_cast(unsigned, __builtin_convertvector(v, bf16v2)); }
DI float bf2f(unsigned short b) { return __uint_as_float(((unsigned)b) << 16); }
DI float wave_sum(float v) {
#pragma unroll
    for (int o = 32; o > 0; o >>= 1) v += __shfl_xor(v, o);
    return v;
}
DI int row_vec(int r) { return r < NCTX ? 2 : (r - NCTX) / SEQ; }
DI int row_batch(int r) { return r < NCTX ? r / CTX : (r - NCTX) / SEQ; }
DI int row_tpos(int r) { return r < NCTX ? r % CTX : CTX + (r - NCTX) % SEQ; }
DI float sigmoidf_(float x) { return 1.f / (1.f + __expf(-x)); }
DI float siluf_(float x) { return x / (1.f + __expf(-x)); }
DI float gelu_tanh(float y) { const float z = 0.7978845608028654f * (y + 0.044715f * y * y * y); const float t = 1.f - 2.f / (1.f + __expf(2.f * z)); return 0.5f * y * (1.f + t); }
DI void my_sincos(float x, float& s, float& c) {
    const float q = rintf(x * 0.636619772367581f);
    float r = fmaf(-q, 1.5703125f, x);
    r = fmaf(-q, 4.837512969970703125e-4f, r);
    r = fmaf(-q, 7.54978995489188216e-8f, r);
    const int qi = (int)q;
    const float r2 = r * r;
    const float sp = r + r * r2 * (-1.6666654611e-1f + r2 * (8.3321608736e-3f + r2 * (-1.9515295891e-4f)));
    const float cp = 1.0f - 0.5f * r2 + r2 * r2 * (4.166664568298827e-2f + r2 * (-1.388731625493765e-3f + r2 * 2.443315711809948e-5f));
    const int k = qi & 3;
    s = (k == 0) ? sp : (k == 1) ? cp : (k == 2) ? -sp : -cp;
    c = (k == 0) ? cp : (k == 1) ? -sp : (k == 2) ? -cp : sp;
}


#define XB_TMO      128
#define XB_XCNT(j)  (256  + 64 * (j))
#define XB_XSUB(j)  (1280 + 64 * (j))
#define XB_XGEN(j)  (2304 + 64 * (j))
#define XB_TOP      3328
#define XB_TOPGEN   3392
#define XCD_BAR_WORDS 3456
#define XB_SPIN_CAP (1u << 22)
#define LAS __attribute__((address_space(3)))
DI unsigned xb_ld(unsigned* p) { return __hip_atomic_load(p, __ATOMIC_RELAXED, __HIP_MEMORY_SCOPE_AGENT); }
DI unsigned xb_add(unsigned* p, unsigned v) { return __hip_atomic_fetch_add(p, v, __ATOMIC_RELAXED, __HIP_MEMORY_SCOPE_AGENT); }
DI unsigned xb_xcc_id() { return (unsigned)__builtin_amdgcn_s_getreg((3 << 11) | 20) & 0xFu; }
#define XB_SPIN(cond, bar) do { unsigned _sp = 0; while (cond) { __builtin_amdgcn_s_sleep(1); \
    if ((++_sp & 255u) == 0u) { if (xb_ld(&(bar)[XB_TMO])) break; if (_sp > XB_SPIN_CAP) { atomicAdd(&(bar)[XB_TMO], 1u); break; } } } } while (0)
struct XcdBarrier { unsigned* bar; unsigned x; volatile LAS unsigned* st; };
DI XcdBarrier xcd_barrier_post(unsigned* bar, volatile LAS unsigned* st) {
    XcdBarrier b; b.bar = bar; b.x = xb_xcc_id(); b.st = st;
    if (threadIdx.x == 0) (void)xb_add(&bar[XB_XCNT(b.x)], 1u);
    return b;
}
DI void xcd_barrier_complete(unsigned* bar, unsigned x, unsigned& nloc, unsigned& nx) {
    const unsigned G = gridDim.x * gridDim.y * gridDim.z;
    unsigned sum, cnt, mine, sp = 0u;
    for (;;) {
        sum = 0u; cnt = 0u; mine = 0u;
#pragma unroll
        for (unsigned j = 0; j < 16; ++j) { const unsigned c = xb_ld(&bar[XB_XCNT(j)]); sum += c; cnt += (c > 0u) ? 1u : 0u; mine = (j == x) ? c : mine; }
        if (sum == G) break;
        __builtin_amdgcn_s_sleep(1);
        if ((++sp & 255u) == 0u) { if (xb_ld(&bar[XB_TMO])) break; if (sp > XB_SPIN_CAP) { atomicAdd(&bar[XB_TMO], 1u); break; } }
    }
    nloc = mine > 0u ? mine : 1u; nx = cnt > 0u ? cnt : 1u;
}
DI void xcd_barrier(const XcdBarrier& b) {
    asm volatile("s_waitcnt vmcnt(0)" ::: "memory");
    __syncthreads();
    if (threadIdx.x == 0) {
        unsigned* bar = b.bar;
        __builtin_amdgcn_s_waitcnt(0);
        unsigned nloc = b.st[0], nx = b.st[1];
        if (nloc == 0u) { xcd_barrier_complete(bar, b.x, nloc, nx); b.st[0] = nloc; b.st[1] = nx; }
        const unsigned old = xb_add(&bar[XB_XSUB(b.x)], 1u);
        const unsigned gen = old / nloc;
        if (old + 1u == (gen + 1u) * nloc) {
            __builtin_amdgcn_fence(__ATOMIC_RELEASE, "agent");
            asm volatile("s_waitcnt vmcnt(0)" ::: "memory");
            const unsigned og = xb_add(&bar[XB_TOP], 1u);
            const unsigned tg = og / nx;
            if (og + 1u == (tg + 1u) * nx) xb_add(&bar[XB_TOPGEN], 1u);
            else XB_SPIN(xb_ld(&bar[XB_TOPGEN]) == tg, bar);
            __builtin_amdgcn_fence(__ATOMIC_ACQUIRE, "agent");
            xb_add(&bar[XB_XGEN(b.x)], 1u);
            asm volatile("s_waitcnt vmcnt(0)" ::: "memory");
        } else {
            XB_SPIN(xb_ld(&bar[XB_XGEN(b.x)]) == gen, bar);
            __builtin_amdgcn_fence(__ATOMIC_ACQUIRE, "agent");
            asm volatile("s_waitcnt vmcnt(0)" ::: "memory");
        }
    }
    __syncthreads();
}

DI void transpose_tile(char* lds, char* ws, const Job& jb, int lt) {
    float (*tile)[65] = (float (*)[65])lds;
    const int tid = get_tid();
    const int tk = lt % jb.ntk, tn = lt / jb.ntk;
    const int k0 = tk * 64, n0 = tn * 64;
    const int j = tid & 63, kq = tid >> 6;
    const float* src; int col; bool valid = true;
    if (jb.mode == 0) { src = jb.a; col = n0 + j; valid = col < jb.ld; }
    else { const int nsub = j >> 4, i = j & 15; src = (nsub & 1) ? jb.b : jb.a; col = tn * 32 + (nsub >> 1) * 16 + i; }
#pragma unroll
    for (int kk = 0; kk < 16; ++kk) { const int k = kk * 4 + kq; tile[k][j] = valid ? src[(size_t)(k0 + k) * jb.ld + col] : 0.f; }
    __syncthreads();
    const int r = tid >> 2, ks = (tid & 3) * 16;
    unsigned w[8];
#pragma unroll
    for (int q = 0; q < 8; ++q) w[q] = pk2(tile[ks + 2 * q][r], tile[ks + 2 * q + 1][r]);
    bf16_t* d = (bf16_t*)(ws) + jb.dst + (size_t)(n0 + r) * jb.K + k0 + ks;
    *(u32x4*)d = (u32x4){w[0], w[1], w[2], w[3]};
    *(u32x4*)(d + 8) = (u32x4){w[4], w[5], w[6], w[7]};
    __syncthreads();
}

DI void ada_item(char* lds, const Params& p, int it) {
    float* sil = (float*)lds;
    float* red = sil + 3072;
    float* MOD = (float*)(p.ws + T_MOD);
    const int tid = get_tid(), layer = it / 96, n0 = (it % 96) * 64;
    for (int i = tid; i < 3072; i += 256) { const int v = i >> 10, k = i & 1023; const float x = v < 2 ? p.in[1][v * 1024 + k] : p.in[3][k]; sil[i] = siluf_(x); }
    __syncthreads();
    const int j = tid & 63, kq = tid >> 6;
    const float* W = p.in[4] + (size_t)layer * 1024 * 6144 + n0 + j;
    float a0 = 0.f, a1 = 0.f, a2 = 0.f;
#pragma unroll 8
    for (int k = kq * 256; k < kq * 256 + 256; ++k) { const float w = W[(size_t)k * 6144]; a0 += sil[k] * w; a1 += sil[1024 + k] * w; a2 += sil[2048 + k] * w; }
    red[(kq * 3 + 0) * 64 + j] = a0; red[(kq * 3 + 1) * 64 + j] = a1; red[(kq * 3 + 2) * 64 + j] = a2;
    __syncthreads();
    if (tid < 192) { const int v = tid >> 6, jj = tid & 63;
        const float s = red[(0 * 3 + v) * 64 + jj] + red[(1 * 3 + v) * 64 + jj] + red[(2 * 3 + v) * 64 + jj] + red[(3 * 3 + v) * 64 + jj] + p.in[5][layer * 6144 + n0 + jj];
        MOD[(layer * 3 + v) * 6144 + n0 + jj] = s; }
    __syncthreads();
}

DI void tables_item(const Params& p, int it) {
    const int tid = get_tid();
    if (it < 8) {
        const int e = it * 256 + tid, pos = e >> 4, i = e & 15;
        const float inv = exp2f(-(float)i * (13.287712379549449f / 16.f));
        float s, c; my_sincos((float)pos * inv, s, c);
        float* ROPE = (float*)(p.ws + T_ROPE); ROPE[e * 2] = c; ROPE[e * 2 + 1] = s;
    } else {
        const int e = (it - 8) * 256 + tid;
        const int dg = e >> 6;
        const float lr = p.in[13][e], li = p.in[14][e], step = expf(p.in[15][dg]);
        const float a = lr * step, b = li * step;
        const float ea = expf(a);
        float sb, cb; my_sincos(b, sb, cb);
        float sh, ch; my_sincos(0.5f * b, sh, ch);
        const float em1 = a * (1.f + a * 0.5f * (1.f + a * (1.f / 3.f) * (1.f + a * 0.25f * (1.f + a * 0.2f * (1.f + a * (1.f / 6.f))))));
        const float lbr = ea * cb, lbi = ea * sb;
        const float nr = em1 * cb - 2.f * sh * sh, ni = ea * sb;
        const float den = lr * lr + li * li;
        const float qr = (nr * lr + ni * li) / den, qi = (ni * lr - nr * li) / den;
        f32x2* BB = (f32x2*)(p.ws + T_BBAR);
#pragma unroll
        for (int s = 0; s < 16; ++s) { const float br = p.in[16][e * 16 + s], bi = p.in[17][e * 16 + s]; BB[e * 16 + s] = (f32x2){qr * br - qi * bi, qr * bi + qi * br}; }
        f32x2* POW = (f32x2*)(p.ws + H_POW) + (size_t)e * 33;
        float pr = 1.f, pi = 0.f;
        for (int q = 0; q <= 32; ++q) { POW[q] = (f32x2){pr, pi}; const float nr2 = pr * lbr - pi * lbi, ni2 = pr * lbi + pi * lbr; pr = nr2; pi = ni2; }
    }
}

DI void modulate_rows(const Params& p, int layer, int which, bool from_inputs, int r0) {
    const int tid_ = get_tid(); const int lane = tid_ & 63, wid = tid_ >> 6;
    const float* gain = p.in[which ? 7 : 6] + layer * 1024;
    const float* modl = (const float*)(p.ws + T_MOD) + layer * 3 * 6144 + (which ? 3072 : 0);
    const float* H = (const float*)(p.ws + OFF_H);
    bf16_t* dst = (bf16_t*)(p.ws + OFF_A0);
    for (int r = r0 + blockIdx.x * 4 + wid; r < NR; r += gridDim.x * 4) {
        const float* src = from_inputs ? (r < NCTX ? p.in[2] + (size_t)r * 1024 : p.in[0] + (size_t)(r - NCTX) * 1024) : H + (size_t)r * 1024;
        const float* mv = modl + row_vec(r) * 6144;
        f32x4 x[4]; float ss = 0.f;
#pragma unroll
        for (int i = 0; i < 4; ++i) { x[i] = *(const f32x4*)(src + i * 256 + lane * 4); ss += x[i][0] * x[i][0] + x[i][1] * x[i][1] + x[i][2] * x[i][2] + x[i][3] * x[i][3]; }
        ss = wave_sum(ss);
        const float rstd = rsqrtf(ss * (1.f / 1024.f) + 1e-6f);
#pragma unroll
        for (int i = 0; i < 4; ++i) { const int c = i * 256 + lane * 4;
            const f32x4 g = *(const f32x4*)(gain + c), sh = *(const f32x4*)(mv + c), sc = *(const f32x4*)(mv + 1024 + c);
            const f32x4 y = x[i] * rstd * g * (1.f + sc) + sh;
            *(u32x2*)(dst + (size_t)r * 1024 + c) = (u32x2){pk2(y[0], y[1]), pk2(y[2], y[3])}; }
    }
}

template <class Epi>
DI void gemm_phase(char* lds, const bf16_t* A0_, int lda, const bf16_t* Bt0_, int K, int mt0, int nmt, int nnt, const Epi& epi, int nbatch = 1, size_t sA = 0, size_t sB = 0) {
    const int tid = get_tid(), lane = tid & 63, wid = tid >> 6, wr = wid >> 1, wc = wid & 1, fr = lane & 15, fq = lane >> 4;
    const int nk = K >> 6;
    const int lrow = tid >> 3, lc = tid & 7, lkc = lc * 8;
    const int woff = lrow * 128 + ((lc ^ ((lrow >> 1) & 7)) << 4);
    const int ra0 = (wr * 64 + fr) * 128 + ((fq ^ (fr >> 1)) << 4);
    const int ra1 = (wr * 64 + fr) * 128 + (((4 + fq) ^ (fr >> 1)) << 4);
    const int rb0 = 16384 + (wc * 64 + fr) * 128 + ((fq ^ (fr >> 1)) << 4);
    const int rb1 = 16384 + (wc * 64 + fr) * 128 + (((4 + fq) ^ (fr >> 1)) << 4);
    for (int t = blockIdx.x; t < nbatch * nmt * nnt; t += gridDim.x) {
        const int gb = t / (nmt * nnt), tr = t % (nmt * nnt);
        const bf16_t* A = A0_ + (size_t)gb * sA; const bf16_t* Bt = Bt0_ + (size_t)gb * sB;
        const int tn = tr % nnt, tm = tr / nnt;
        const int m0 = (mt0 + tm) * 128, n0 = tn * 128;
        const bf16_t* Ag = A + (size_t)(m0 + lrow) * lda + lkc;
        const bf16_t* Bg = Bt + (size_t)(n0 + lrow) * K + lkc;
        f32x4 acc[4][4];
#pragma unroll
        for (int m = 0; m < 4; ++m)
#pragma unroll
            for (int n = 0; n < 4; ++n) acc[m][n] = (f32x4){0.f, 0.f, 0.f, 0.f};
        u32x4 ra[4], rb[4];
#pragma unroll
        for (int i = 0; i < 4; ++i) { ra[i] = *(const u32x4*)(Ag + (size_t)i * 32 * lda); rb[i] = *(const u32x4*)(Bg + (size_t)i * 32 * K); }
        __syncthreads();
#pragma unroll
        for (int i = 0; i < 4; ++i) { *(u32x4*)(lds + woff + i * 4096) = ra[i]; *(u32x4*)(lds + 16384 + woff + i * 4096) = rb[i]; }
        if (nk > 1) {
#pragma unroll
            for (int i = 0; i < 4; ++i) { ra[i] = *(const u32x4*)(Ag + (size_t)i * 32 * lda + 64); rb[i] = *(const u32x4*)(Bg + (size_t)i * 32 * K + 64); }
        }
        __syncthreads();
        for (int kt = 0; kt < nk; ++kt) {
            const char* cur = lds + (kt & 1) * 32768;
            char* nxt = lds + ((kt & 1) ^ 1) * 32768;
#pragma unroll
            for (int ks = 0; ks < 2; ++ks) {
                bf16x8 a[4], b[4];
#pragma unroll
                for (int m = 0; m < 4; ++m) a[m] = *(const bf16x8*)(cur + (ks ? ra1 : ra0) + m * 2048);
#pragma unroll
                for (int n = 0; n < 4; ++n) b[n] = *(const bf16x8*)(cur + (ks ? rb1 : rb0) + n * 2048);
#pragma unroll
                for (int m = 0; m < 4; ++m)
#pragma unroll
                    for (int n = 0; n < 4; ++n) acc[m][n] = __builtin_amdgcn_mfma_f32_16x16x32_bf16(b[n], a[m], acc[m][n], 0, 0, 0);
            }
            if (kt + 1 < nk) {
#pragma unroll
                for (int i = 0; i < 4; ++i) { *(u32x4*)(nxt + woff + i * 4096) = ra[i]; *(u32x4*)(nxt + 16384 + woff + i * 4096) = rb[i]; }
                if (kt + 2 < nk) {
#pragma unroll
                    for (int i = 0; i < 4; ++i) { ra[i] = *(const u32x4*)(Ag + (size_t)i * 32 * lda + (kt + 2) * 64); rb[i] = *(const u32x4*)(Bg + (size_t)i * 32 * K + (kt + 2) * 64); }
                }
            }
            __syncthreads();
        }
        epi(acc, m0 + wr * 64 + fr, n0 + wc * 64 + fq * 4, gb);
    }
}

struct EpiWin0 {
    bf16_t* UA; float* CQKV; float* KR;
    DI void operator()(const f32x4 (&acc)[4][4], int row0, int col0, int gb) const {
#pragma unroll
        for (int m = 0; m < 4; ++m) { const int ri = row0 + m * 16; const size_t r = ri; const int b = row_batch(ri), tp = row_tpos(ri);
#pragma unroll
            for (int n = 0; n < 4; ++n) { const int c = col0 + n * 16; const f32x4 v = acc[m][n];
                if (c < 512) { const int g = c >> 4, s0 = c & 15;
                    *(u32x2*)(UA + ((size_t)g * CHR + b * NCK + (tp >> 5)) * 768 + (tp & 31) * 16 + s0) = (u32x2){pk2(v[0], v[1]), pk2(v[2], v[3])}; }
                else if (c < 1152) *(f32x4*)(CQKV + r * 640 + (c - 512)) = v;
                else if (c < 1216) *(f32x4*)(KR + r * 64 + (c - 1152)) = v; } }
    }
};
struct EpiS1a {
    float* E;
    DI void operator()(const f32x4 (&acc)[4][4], int row0, int col0, int gb) const {
#pragma unroll
        for (int m = 0; m < 4; ++m) { const int r = row0 + m * 16; if (r >= CHR) continue;
#pragma unroll
            for (int n = 0; n < 4; ++n) *(f32x4*)(E + ((size_t)gb * CHR + r) * 256 + col0 + n * 16) = acc[m][n]; }
    }
};
struct EpiS1b {
    bf16_t* YG;
    DI void operator()(const f32x4 (&acc)[4][4], int row0, int col0, int gb) const {
#pragma unroll
        for (int m = 0; m < 4; ++m) { const int r = row0 + m * 16; if (r >= CHR) continue; const int b = r / NCK, c = r % NCK;
#pragma unroll
            for (int n = 0; n < 4; ++n) { const int cc = col0 + n * 16; const int tl = cc >> 4, s0 = cc & 15; const f32x4 v = acc[m][n];
                const int tp = c * SL + tl; const size_t row = tp < CTX ? (size_t)b * CTX + tp : (size_t)NCTX + (size_t)b * SEQ + (tp - CTX);
                *(u32x2*)(YG + row * 512 + gb * 16 + s0) = (u32x2){pk2(gelu_tanh(v[0]), gelu_tanh(v[1])), pk2(gelu_tanh(v[2]), gelu_tanh(v[3]))}; } }
    }
};
struct EpiBf16 {
    bf16_t* O; int ldo;
    DI void operator()(const f32x4 (&acc)[4][4], int row0, int col0, int gb) const {
#pragma unroll
        for (int m = 0; m < 4; ++m) { const size_t r = row0 + m * 16;
#pragma unroll
            for (int n = 0; n < 4; ++n) { const int c = col0 + n * 16; const f32x4 v = acc[m][n];
                *(u32x2*)(O + r * ldo + c) = (u32x2){pk2(v[0], v[1]), pk2(v[2], v[3])}; } }
    }
};
struct EpiKV {
    bf16_t* KNOPE; bf16_t* VT;
    DI void operator()(const f32x4 (&acc)[4][4], int row0, int col0, int gb) const {
#pragma unroll
        for (int m = 0; m < 4; ++m) { const int r = row0 + m * 16; const int b = row_batch(r), tp = row_tpos(r);
#pragma unroll
            for (int n = 0; n < 4; ++n) { const int c = col0 + n * 16; const int h = c >> 8, w = c & 255; const f32x4 v = acc[m][n];
                if (w < 128) *(u32x2*)(KNOPE + (size_t)r * 512 + h * 128 + w) = (u32x2){pk2(v[0], v[1]), pk2(v[2], v[3])};
                else { bf16_t* d = VT + ((size_t)(b * 4 + h) * 128 + (w - 128)) * TK + tp; const unsigned p0 = pk2(v[0], v[1]), p1 = pk2(v[2], v[3]);
                    d[0] = (bf16_t)(p0 & 0xffff); d[TK] = (bf16_t)(p0 >> 16); d[2 * TK] = (bf16_t)(p1 & 0xffff); d[3 * TK] = (bf16_t)(p1 >> 16); } } }
    }
};
struct EpiGLU {
    const bf16_t* YG; const float* bias; bf16_t* CAT;
    DI void operator()(const f32x4 (&acc)[4][4], int row0, int col0, int gb) const {
#pragma unroll
        for (int m = 0; m < 4; ++m) { const size_t r = row0 + m * 16;
#pragma unroll
            for (int n = 0; n < 4; ++n) { const int c = col0 + n * 16; const f32x4 v = acc[m][n]; const f32x4 bv = *(const f32x4*)(bias + c);
                const u32x2 yy = *(const u32x2*)(YG + r * 512 + c);
                const float y0 = __uint_as_float(yy[0] << 16), y1 = __uint_as_float(yy[0] & 0xffff0000u), y2 = __uint_as_float(yy[1] << 16), y3 = __uint_as_float(yy[1] & 0xffff0000u);
                const float o0 = y0 * sigmoidf_(v[0] + bv[0]), o1 = y1 * sigmoidf_(v[1] + bv[1]), o2 = y2 * sigmoidf_(v[2] + bv[2]), o3 = y3 * sigmoidf_(v[3] + bv[3]);
                *(u32x2*)(CAT + r * 1024 + c) = (u32x2){pk2(o0, o1), pk2(o2, o3)}; } }
    }
};
struct EpiRes {
    const float* res_ctx; const float* res_lat; float* dst_ctx; float* dst_lat; const float* gate;
    DI void operator()(const f32x4 (&acc)[4][4], int row0, int col0, int gb) const {
#pragma unroll
        for (int m = 0; m < 4; ++m) { const int r = row0 + m * 16;
            const float* rs = r < NCTX ? res_ctx + (size_t)r * 1024 : res_lat + (size_t)(r - NCTX) * 1024;
            float* ds = r < NCTX ? dst_ctx + (size_t)r * 1024 : dst_lat + (size_t)(r - NCTX) * 1024;
            if (r < NCTX && dst_ctx == nullptr) continue;
            const float* gv = gate + row_vec(r) * 6144;
#pragma unroll
            for (int n = 0; n < 4; ++n) { const int c = col0 + n * 16; const f32x4 g = *(const f32x4*)(gv + c), x = *(const f32x4*)(rs + c);
                *(f32x4*)(ds + c) = x + g * acc[m][n]; } }
    }
};
struct EpiSwiGLU {
    bf16_t* HID;
    DI void operator()(const f32x4 (&acc)[4][4], int row0, int col0, int gb) const {
        const int n0 = col0 & ~127, wc = (col0 >> 6) & 1, fq4 = col0 & 15;
        const int hc = (n0 >> 1) + wc * 32 + fq4;
#pragma unroll
        for (int m = 0; m < 4; ++m) { const size_t r = row0 + m * 16;
#pragma unroll
            for (int q = 0; q < 2; ++q) { const f32x4 g = acc[m][2 * q], u = acc[m][2 * q + 1];
                const float o0 = siluf_(g[0]) * u[0], o1 = siluf_(g[1]) * u[1], o2 = siluf_(g[2]) * u[2], o3 = siluf_(g[3]) * u[3];
                *(u32x2*)(HID + r * FH + hc + q * 16) = (u32x2){pk2(o0, o1), pk2(o2, o3)}; } }
    }
};
struct EpiWin1 {
    bf16_t* Q; float* KRAW; bf16_t* VT;
    DI void operator()(const f32x4 (&acc)[4][4], int row0, int col0, int gb) const {
#pragma unroll
        for (int m = 0; m < 4; ++m) { const int r = row0 + m * 16; const int b = row_batch(r), tp = row_tpos(r);
#pragma unroll
            for (int n = 0; n < 4; ++n) { const int c = col0 + n * 16; const f32x4 v = acc[m][n];
                if (c < 1024) *(u32x2*)(Q + (size_t)r * 1024 + c) = (u32x2){pk2(v[0], v[1]), pk2(v[2], v[3])};
                else if (c < 1280) *(f32x4*)(KRAW + (size_t)r * 256 + (c - 1024)) = v;
                else { const int cc = c - 1280, h = cc >> 6, d0 = cc & 63; bf16_t* d = VT + ((size_t)(b * 4 + h) * 64 + d0) * TK + tp; const unsigned p0 = pk2(v[0], v[1]), p1 = pk2(v[2], v[3]);
                    d[0] = (bf16_t)(p0 & 0xffff); d[TK] = (bf16_t)(p0 >> 16); d[2 * TK] = (bf16_t)(p1 & 0xffff); d[3 * TK] = (bf16_t)(p1 >> 16); } } }
    }
};

template <int DQK, int DV, bool WIN>
DI void attn_item(char* lds, const bf16_t* Q, int qstride, const bf16_t* Kb, const bf16_t* VTb, int ta0, int ta1, int tb0, int tb1,
                  float m_init, float l_init, bf16_t* O, int ostride, int qpos0) {
    constexpr int NKS = DQK / 16, NDT = DV / 32, KSTR = DQK + 8, VSTR = 68;
    constexpr int KCH = 64 * DQK / 8 / 256, VCH = DV * 8 / 256;
    bf16_t* Ks = (bf16_t*)lds; bf16_t* Vs = Ks + 64 * KSTR;
    const int tid = get_tid(), lane = tid & 63, wid = tid >> 6, r = lane & 31, h2 = lane >> 5;
    bf16x8 qf[NKS];
    { const bf16_t* qrow = Q + (size_t)(wid * 32 + r) * qstride + 8 * h2;
#pragma unroll
      for (int ks = 0; ks < NKS; ++ks) qf[ks] = *(const bf16x8*)(qrow + 16 * ks); }
    f32x16 o[NDT];
#pragma unroll
    for (int dt = 0; dt < NDT; ++dt)
#pragma unroll
        for (int i = 0; i < 16; ++i) o[dt][i] = 0.f;
    float mrun = m_init, lrun = (h2 == 0) ? l_init : 0.f;
    const int na = ta1 - ta0, ntot = na + (tb1 - tb0);
    u32x4 kr[KCH], vr[VCH];
    constexpr int KTPR = (DQK / 8) / KCH;
    constexpr int VTPR = 8 / VCH;
    const int krow = tid / KTPR, kcol = (tid % KTPR) * (KCH * 8);
    const int vrow = tid / VTPR, vcol = (tid % VTPR) * (VCH * 8);
    const bf16_t* kgp = Kb + (size_t)krow * DQK + kcol;
    const bf16_t* vgp = VTb + (size_t)vrow * TK + vcol;
    bf16_t* ksp = Ks + krow * KSTR + kcol;
    bf16_t* vsp = Vs + vrow * VSTR + vcol;
    { const int T = (0 < na) ? ta0 : tb0;
      const bf16_t* kg = kgp + (size_t)T * 64 * DQK; const bf16_t* vg = vgp + T * 64;
#pragma unroll
      for (int i = 0; i < KCH; ++i) kr[i] = *(const u32x4*)(kg + i * 8);
#pragma unroll
      for (int i = 0; i < VCH; ++i) vr[i] = *(const u32x4*)(vg + i * 8); }
    for (int it = 0; it < ntot; ++it) {
        const int T = (it < na) ? ta0 + it : tb0 + (it - na);
        __syncthreads();
#pragma unroll
        for (int i = 0; i < KCH; ++i) *(u32x4*)(ksp + i * 8) = kr[i];
#pragma unroll
        for (int i = 0; i < VCH; ++i) { *(u32x2*)(vsp + i * 8) = (u32x2){vr[i][0], vr[i][1]}; *(u32x2*)(vsp + i * 8 + 4) = (u32x2){vr[i][2], vr[i][3]}; }
        __syncthreads();
        if (it + 1 < ntot) {
            const int Tn = (it + 1 < na) ? ta0 + it + 1 : tb0 + (it + 1 - na);
            const bf16_t* kg = kgp + (size_t)Tn * 64 * DQK; const bf16_t* vg = vgp + Tn * 64;
#pragma unroll
            for (int i = 0; i < KCH; ++i) kr[i] = *(const u32x4*)(kg + i * 8);
#pragma unroll
            for (int i = 0; i < VCH; ++i) vr[i] = *(const u32x4*)(vg + i * 8);
        }
#pragma unroll
        for (int kt2 = 0; kt2 < 2; ++kt2) {
            f32x16 s0;
#pragma unroll
            for (int i = 0; i < 16; ++i) s0[i] = 0.f;
#pragma unroll
            for (int ks = 0; ks < NKS; ++ks) {
                const bf16x8 k0 = *(const bf16x8*)(Ks + (32 * kt2 + r) * KSTR + 16 * ks + 8 * h2);
                s0 = __builtin_amdgcn_mfma_f32_32x32x16_bf16(k0, qf[ks], s0, 0, 0, 0);
            }
            if (WIN && T >= 4) {
                const int qp = qpos0 + wid * 32 + r, kp0 = (T - 4) * 64 + 32 * kt2 + 4 * h2;
#pragma unroll
                for (int i = 0; i < 16; ++i) { const int d0 = kp0 + (i & 3) + 8 * (i >> 2) - qp;
                    if (d0 > 128 || d0 < -128) s0[i] = -1e30f; }
            }
            float mx = s0[0];
#pragma unroll
            for (int i = 1; i < 16; ++i) mx = fmaxf(mx, s0[i]);
            mx = fmaxf(mx, __shfl_xor(mx, 32));
            const float mn = fmaxf(mrun, mx);
            const float alpha = __builtin_amdgcn_exp2f(mrun - mn);
            mrun = mn;
            float rs = 0.f;
#pragma unroll
            for (int i = 0; i < 16; ++i) { s0[i] = __builtin_amdgcn_exp2f(s0[i] - mn); rs += s0[i]; }
            lrun = lrun * alpha + rs;
#pragma unroll
            for (int dt = 0; dt < NDT; ++dt)
#pragma unroll
                for (int i = 0; i < 16; ++i) o[dt][i] *= alpha;
#pragma unroll
            for (int st = 0; st < 2; ++st) {
                u32x4 pw;
                pw[0] = pk2(s0[8 * st + 0], s0[8 * st + 1]); pw[1] = pk2(s0[8 * st + 2], s0[8 * st + 3]); pw[2] = pk2(s0[8 * st + 4], s0[8 * st + 5]); pw[3] = pk2(s0[8 * st + 6], s0[8 * st + 7]);
                const bf16x8 pf = __builtin_bit_cast(bf16x8, pw);
#pragma unroll
                for (int dt = 0; dt < NDT; ++dt) {
                    const bf16_t* vp = Vs + (32 * dt + r) * VSTR + 32 * kt2 + 16 * st + 4 * h2;
                    const s16x4 lo = *(const s16x4*)vp, hi = *(const s16x4*)(vp + 8);
                    const bf16x8 vf = __builtin_shufflevector(lo, hi, 0, 1, 2, 3, 4, 5, 6, 7);
                    o[dt] = __builtin_amdgcn_mfma_f32_32x32x16_bf16(vf, pf, o[dt], 0, 0, 0);
                }
            }
        }
    }
    lrun += __shfl_xor(lrun, 32);
    const float inv = 1.f / lrun;
    bf16_t* orow = O + (size_t)(wid * 32 + r) * ostride;
#pragma unroll
    for (int dt = 0; dt < NDT; ++dt)
#pragma unroll
        for (int g = 0; g < 4; ++g)
            *(u32x2*)(orow + 32 * dt + 8 * g + 4 * h2) = (u32x2){pk2(o[dt][4 * g] * inv, o[dt][4 * g + 1] * inv), pk2(o[dt][4 * g + 2] * inv, o[dt][4 * g + 3] * inv)};
    __syncthreads();
}

DI void s5_kk_phase(const Params& p) {
    const int tid = get_tid(), s = tid >> 4, sp = tid & 15;
    const f32x2* POW = (const f32x2*)(p.ws + H_POW); const f32x2* BB = (const f32x2*)(p.ws + T_BBAR); float* KK = (float*)(p.ws + H_KK);
    for (int it = blockIdx.x; it < 32 * 2 * 32; it += gridDim.x) {
        const int d = it & 31, dir = (it >> 5) & 1, g = it >> 6;
        const int e0 = (dir * 32 + g) * 64; const float* cre = p.in[18] + ((size_t)(dir * 32 + g) * 16 + s) * 64; const float* cim = p.in[19] + ((size_t)(dir * 32 + g) * 16 + s) * 64;
        float acc = 0.f;
#pragma unroll 8
        for (int pp = 0; pp < 64; ++pp) { const f32x2 pw = POW[(size_t)(e0 + pp) * 33 + d], bb = BB[(e0 + pp) * 16 + sp];
            const float zr = pw[0] * bb[0] - pw[1] * bb[1], zi = pw[0] * bb[1] + pw[1] * bb[0];
            acc += cre[pp] * zr - cim[pp] * zi; }
        KK[(size_t)((g * 2 + dir) * 32 + d) * 256 + tid] = acc;
    }
}
DI void s5_w1a_phase(const Params& p) {
    const int tid = get_tid();
    const f32x2* POW = (const f32x2*)(p.ws + H_POW); const f32x2* BB = (const f32x2*)(p.ws + T_BBAR); bf16_t* W = (bf16_t*)(p.ws + H_W1A);
    for (int it = blockIdx.x; it < 2048; it += gridDim.x) {
        const int idx = it * 256 + tid; const int kq = idx & 63, n = (idx >> 6) & 255, g = idx >> 14;
        const int dir = n >> 7, ri = (n >> 6) & 1, pp = n & 63; const int e = (dir * 32 + g) * 64 + pp; const int tl = kq >> 1, s0 = (kq & 1) * 8;
        const f32x2 pw = POW[(size_t)e * 33 + (dir ? tl : 31 - tl)];
        float v[8];
#pragma unroll
        for (int j = 0; j < 8; ++j) { const f32x2 bb = BB[e * 16 + s0 + j]; v[j] = ri ? pw[0] * bb[1] + pw[1] * bb[0] : pw[0] * bb[0] - pw[1] * bb[1]; }
        *(u32x4*)(W + ((size_t)g * 256 + n) * 512 + kq * 8) = (u32x4){pk2(v[0], v[1]), pk2(v[2], v[3]), pk2(v[4], v[5]), pk2(v[6], v[7])};
    }
}
DI void s5_w1b_phase(const Params& p) {
    const int tid = get_tid();
    const f32x2* POW = (const f32x2*)(p.ws + H_POW); const float* KK = (const float*)(p.ws + H_KK); bf16_t* W = (bf16_t*)(p.ws + A_W1B);
    for (int it = blockIdx.x; it < 6144; it += gridDim.x) {
        const int idx = it * 256 + tid; const int kq = idx % 96, n = (idx / 96) & 511, g = idx / (96 * 512);
        const int tl = n >> 4, s = n & 15;
        float v[8];
        if (kq < 64) { const int tl2 = kq >> 1, s0 = (kq & 1) * 8;
#pragma unroll
            for (int j = 0; j < 8; ++j) { float x = 0.f;
                if (tl2 <= tl) x += KK[(size_t)((g * 2 + 0) * 32 + (tl - tl2)) * 256 + s * 16 + s0 + j];
                if (tl2 >= tl) x += KK[(size_t)((g * 2 + 1) * 32 + (tl2 - tl)) * 256 + s * 16 + s0 + j];
                if (tl2 == tl && s0 + j == s) x += p.in[20][g * 16 + s];
                v[j] = x; }
        } else { const int k2 = (kq - 64) * 8; const int dir = k2 >> 7, ri = (k2 >> 6) & 1, p0 = k2 & 63;
            const float* cre = p.in[18] + ((size_t)(dir * 32 + g) * 16 + s) * 64; const float* cim = p.in[19] + ((size_t)(dir * 32 + g) * 16 + s) * 64;
#pragma unroll
            for (int j = 0; j < 8; ++j) { const int pp = p0 + j; const f32x2 pw = POW[(size_t)((dir * 32 + g) * 64 + pp) * 33 + (dir ? 32 - tl : tl + 1)];
                const float cr = cre[pp], ci = cim[pp];
                v[j] = ri ? -(cr * pw[1] + ci * pw[0]) : cr * pw[0] - ci * pw[1]; }
        }
        *(u32x4*)(W + ((size_t)g * 512 + n) * 768 + kq * 8) = (u32x4){pk2(v[0], v[1]), pk2(v[2], v[3]), pk2(v[4], v[5]), pk2(v[6], v[7])};
    }
}
DI void s5_carry_phase(const Params& p) {
    const int tid_ = get_tid(); const int lane = tid_ & 63, wid = tid_ >> 6;
    const f32x2* POW = (const f32x2*)(p.ws + H_POW); const float* E = (const float*)(p.ws + H_E); bf16_t* UA = (bf16_t*)(p.ws + H_UA);
    for (int it = blockIdx.x * 4 + wid; it < 2 * 2 * 32; it += gridDim.x * 4) {
        const int g = it & 31, dir = (it >> 5) & 1, b = it >> 6;
        const f32x2 l32 = POW[(size_t)((dir * 32 + g) * 64 + lane) * 33 + 32];
        float hr = 0.f, hi = 0.f;
#pragma unroll 4
        for (int i = 0; i < NCK; ++i) {
            const int c = dir ? (i < 8 ? 7 - i : NCK - 1 - (i - 8)) : i;
            const size_t m = (size_t)g * CHR + b * NCK + c;
            bf16_t* u = UA + m * 768 + 512 + dir * 128 + lane;
            u[0] = (bf16_t)(pk2(hr, 0.f) & 0xffff); u[64] = (bf16_t)(pk2(hi, 0.f) & 0xffff);
            const float er = E[m * 256 + dir * 128 + lane], ei = E[m * 256 + dir * 128 + 64 + lane];
            const float nr = l32[0] * hr - l32[1] * hi + er, ni = l32[0] * hi + l32[1] * hr + ei;
            hr = nr; hi = ni;
        }
    }
}

DI void qkvnorm_phase(const Params& p) {
    const int tid_ = get_tid(); const int lane = tid_ & 63, wid = tid_ >> 6;
    const float* CQKV = (const float*)(p.ws + S_CQKV);
    bf16_t* CQN = (bf16_t*)(p.ws + S_CQN); bf16_t* CKVN = (bf16_t*)(p.ws + S_CKVN);
    for (int r = blockIdx.x * 4 + wid; r < NR; r += gridDim.x * 4) {
        const float* src = CQKV + (size_t)r * 640;
        float a[6], k[4]; float sa = 0.f, sk = 0.f;
#pragma unroll
        for (int i = 0; i < 6; ++i) { a[i] = src[lane + 64 * i]; sa += a[i] * a[i]; }
#pragma unroll
        for (int i = 0; i < 4; ++i) { k[i] = src[384 + lane + 64 * i]; sk += k[i] * k[i]; }
        sa = wave_sum(sa); sk = wave_sum(sk);
        const float ra = rsqrtf(sa * (1.f / 384.f) + 1e-6f), rk = rsqrtf(sk * (1.f / 256.f) + 1e-6f);
#pragma unroll
        for (int i = 0; i < 6; ++i) CQN[(size_t)r * 384 + lane + 64 * i] = (bf16_t)(pk2(a[i] * ra * p.in[23][lane + 64 * i], 0.f) & 0xffff);
#pragma unroll
        for (int i = 0; i < 4; ++i) CKVN[(size_t)r * 256 + lane + 64 * i] = (bf16_t)(pk2(k[i] * rk * p.in[25][lane + 64 * i], 0.f) & 0xffff);
    }
}
DI float rope64(float x, int lane, const float* ROPE, int rpos, int cpos) {
    const float partner = __shfl_xor(x, 16);
    const int i = lane & 15; const int pos = lane < 32 ? rpos : cpos;
    const float c = ROPE[(pos * 16 + i) * 2], s = ROPE[(pos * 16 + i) * 2 + 1];
    return (lane & 16) ? x * c + partner * s : x * c - partner * s;
}
DI void mla_prep_phase(const Params& p) {
    const int tid_ = get_tid(); const int lane = tid_ & 63, wid = tid_ >> 6;
    bf16_t* QR = (bf16_t*)(p.ws + S_QRAW); const bf16_t* KN = (const bf16_t*)(p.ws + S_KNOPE); const float* KR = (const float*)(p.ws + H_KR);
    bf16_t* KA = (bf16_t*)(p.ws + S_KA); const float* ROPE = (const float*)(p.ws + T_ROPE);
    const float qsc = 0.07216878364870323f * LOG2E;
    const float qg0 = p.in[27][lane], qg1 = p.in[27][64 + lane], qg2 = p.in[27][128 + lane];
    const float kg0 = p.in[28][lane], kg1 = p.in[28][64 + lane], kg2 = p.in[28][128 + lane];
    for (int r = blockIdx.x * 4 + wid; r < NR; r += gridDim.x * 4) {
        const bool lat = r >= NCTX; const int b = row_batch(r), tp = row_tpos(r); const int t = tp - CTX;
        const int rpos = lat ? (t >> 6) : 0, cpos = lat ? (t & 63) : 0;
        const float krv = KR[(size_t)r * 64 + lane];
#pragma unroll
        for (int h = 0; h < 4; ++h) {
            bf16_t* q = QR + (size_t)r * 768 + h * 192;
            float x0 = bf2f(q[lane]), x1 = bf2f(q[64 + lane]), x2 = bf2f(q[128 + lane]);
            float ss = wave_sum(x0 * x0 + x1 * x1 + x2 * x2);
            float rs = rsqrtf(ss * (1.f / 192.f) + 1e-6f);
            x0 *= rs * qg0; x1 *= rs * qg1; x2 *= rs * qg2;
            if (lat) x2 = rope64(x2, lane, ROPE, rpos, cpos);
            q[lane] = (bf16_t)(pk2(x0 * qsc, 0.f) & 0xffff); q[64 + lane] = (bf16_t)(pk2(x1 * qsc, 0.f) & 0xffff); q[128 + lane] = (bf16_t)(pk2(x2 * qsc, 0.f) & 0xffff);
            const bf16_t* kn = KN + (size_t)r * 512 + h * 128;
            float k0 = bf2f(kn[lane]), k1 = bf2f(kn[64 + lane]), k2 = krv;
            ss = wave_sum(k0 * k0 + k1 * k1 + k2 * k2);
            rs = rsqrtf(ss * (1.f / 192.f) + 1e-6f);
            k0 *= rs * kg0; k1 *= rs * kg1; k2 *= rs * kg2;
            if (lat) k2 = rope64(k2, lane, ROPE, rpos, cpos);
            bf16_t* kd = KA + ((size_t)(b * 4 + h) * TK + tp) * 192;
            kd[lane] = (bf16_t)(pk2(k0, 0.f) & 0xffff); kd[64 + lane] = (bf16_t)(pk2(k1, 0.f) & 0xffff); kd[128 + lane] = (bf16_t)(pk2(k2, 0.f) & 0xffff);
        }
    }
}
DI void win_prep_phase(const Params& p) {
    const int tid_ = get_tid(); const int lane = tid_ & 63, wid = tid_ >> 6;
    bf16_t* Q = (bf16_t*)(p.ws + S1_Q); const float* KRAW = (const float*)(p.ws + S1_KRAW); bf16_t* K1 = (bf16_t*)(p.ws + S1_K);
    const float* ROPE = (const float*)(p.ws + T_ROPE);
    const float qsc = 0.125f * LOG2E;
    const float qg = p.in[31][lane], kg = p.in[32][lane];
    for (int r = blockIdx.x * 4 + wid; r < NR; r += gridDim.x * 4) {
        const bool lat = r >= NCTX; const int b = row_batch(r), tp = row_tpos(r); const int t = tp - CTX;
        const int rpos = lat ? (t >> 6) : 0, cpos = lat ? (t & 63) : 0;
        if (lat) {
#pragma unroll 4
            for (int h = 0; h < 16; ++h) { bf16_t* q = Q + (size_t)r * 1024 + h * 64;
                float x = bf2f(q[lane]); const float ss = wave_sum(x * x); x *= rsqrtf(ss * (1.f / 64.f) + 1e-6f) * qg;
                x = rope64(x, lane, ROPE, rpos, cpos);
                q[lane] = (bf16_t)(pk2(x * qsc, 0.f) & 0xffff); }
        }
#pragma unroll
        for (int h = 0; h < 4; ++h) { float x = KRAW[(size_t)r * 256 + h * 64 + lane]; const float ss = wave_sum(x * x); x *= rsqrtf(ss * (1.f / 64.f) + 1e-6f) * kg;
            if (lat) x = rope64(x, lane, ROPE, rpos, cpos);
            K1[((size_t)(b * 4 + h) * TK + tp) * 64 + lane] = (bf16_t)(pk2(x, 0.f) & 0xffff); }
    }
}

__global__ void __launch_bounds__(NTHREADS, 2) fwd_kernel(Params p) {
    extern __shared__ __attribute__((aligned(16))) char lds[];
    cg::grid_group grid = cg::this_grid();
    char* ws = p.ws;
    const bf16_t* WB = (const bf16_t*)ws;
    const float* MOD = (const float*)(ws + T_MOD);
    float* H = (float*)(ws + OFF_H);
    bf16_t* A0 = (bf16_t*)(ws + OFF_A0);
    const int bid = blockIdx.x, nb = gridDim.x;
    volatile LAS unsigned* xst = (volatile LAS unsigned*)(lds + (LDS_BYTES - 16));
    if (threadIdx.x == 0) { xst[0] = 0u; xst[1] = 0u; }
    __syncthreads();
    const XcdBarrier xb = xcd_barrier_post((unsigned*)(ws + T_BAR), xst);
    if (p.pad == 0x7fffffff) grid.sync();
#define GRID_SYNC() xcd_barrier(xb)

    { const int nit = 192 + 24 + p.njobtiles;
      for (int it = bid; it < nit; it += nb) {
          if (it < 192) ada_item(lds, p, it);
          else if (it < 216) tables_item(p, it - 192);
          else { const int lt = it - 216; int j = 0;
#pragma unroll
              for (int q = 1; q < 11; ++q) if (lt >= p.jobs[q].tile0) j = q;
              transpose_tile(lds, ws, p.jobs[j], lt - p.jobs[j].tile0); } } }
    GRID_SYNC();
    modulate_rows(p, 0, 0, true, 0);
    s5_kk_phase(p);
    GRID_SYNC();
    { EpiWin0 e{(bf16_t*)(ws + H_UA), (float*)(ws + S_CQKV), (float*)(ws + H_KR)};
      gemm_phase(lds, A0, 1024, WB + W_IN0, 1024, 0, NR / 128, 10, e); }
    s5_w1a_phase(p);
    GRID_SYNC();
    qkvnorm_phase(p);
    s5_w1b_phase(p);
    { EpiS1a e{(float*)(ws + H_E)};
      gemm_phase(lds, (const bf16_t*)(ws + H_UA), 768, (const bf16_t*)(ws + H_W1A), 512, 0, 5, 2, e, 32, (size_t)CHR * 768, (size_t)256 * 512); }
    GRID_SYNC();
    s5_carry_phase(p);
    { EpiBf16 e{(bf16_t*)(ws + S_QRAW), 768};
      gemm_phase(lds, (const bf16_t*)(ws + S_CQN), 384, WB + W_QB, 384, 0, NR / 128, 6, e); }
    { EpiKV e{(bf16_t*)(ws + S_KNOPE), (bf16_t*)(ws + S_VT)};
      gemm_phase(lds, (const bf16_t*)(ws + S_CKVN), 256, WB + W_KVB, 256, 0, NR / 128, 8, e); }
    GRID_SYNC();
    { EpiS1b e{(bf16_t*)(ws + S_YG)};
      gemm_phase(lds, (const bf16_t*)(ws + H_UA), 768, (const bf16_t*)(ws + A_W1B), 768, 0, 5, 4, e, 32, (size_t)CHR * 768, (size_t)512 * 768); }
    mla_prep_phase(p);
    GRID_SYNC();
    { const bf16_t* QR = (const bf16_t*)(ws + S_QRAW); const bf16_t* KA = (const bf16_t*)(ws + S_KA); const bf16_t* VT = (const bf16_t*)(ws + S_VT);
      const int nlat = 2 * 4 * 64, nall = nlat + 2 * 4 * 2;
#ifndef NOMLA
      for (int it = bid; it < nall; it += nb) {
          if (it < nlat) { const int qb = it & 63, h = (it >> 6) & 3, b = it >> 8; const size_t row = NCTX + (size_t)b * SEQ + qb * 128;
              attn_item<192, 128, false>(lds, QR + row * 768 + h * 192, 768, KA + (size_t)(b * 4 + h) * TK * 192, VT + (size_t)(b * 4 + h) * 128 * TK, 0, NCH, 0, 0, -1e30f, 0.f,
                                         A0 + row * 1024 + 512 + h * 128, 1024, 0); }
          else { const int j = it - nlat; const int qb = j & 1, h = (j >> 1) & 3, b = j >> 3; const size_t row = (size_t)b * CTX + qb * 128;
              attn_item<192, 128, false>(lds, QR + row * 768 + h * 192, 768, KA + (size_t)(b * 4 + h) * TK * 192, VT + (size_t)(b * 4 + h) * 128 * TK, 0, 4, 0, 0, -1e30f, 0.f,
                                         A0 + row * 1024 + 512 + h * 128, 1024, 0); } }
#endif
      EpiGLU e{(const bf16_t*)(ws + S_YG), p.in[22], A0};
      gemm_phase(lds, (const bf16_t*)(ws + S_YG), 512, WB + W_GLU, 512, 0, NR / 128, 4, e); }
    GRID_SYNC();
    { EpiRes e{p.in[2], p.in[0], H, H + (size_t)NCTX * 1024, MOD + 0 * 3 * 6144 + 2048};
      gemm_phase(lds, A0, 1024, WB + W_OUT0, 1024, 0, NR / 128, 8, e); }
    GRID_SYNC();
    modulate_rows(p, 0, 1, false, 0);
    GRID_SYNC();
    { EpiSwiGLU e{(bf16_t*)(ws + S_HID)};
      gemm_phase(lds, A0, 1024, WB + W_GU0, 1024, 0, NR / 128, 44, e); }
    GRID_SYNC();
    { EpiRes e{H, H + (size_t)NCTX * 1024, H, H + (size_t)NCTX * 1024, MOD + 0 * 3 * 6144 + 5120};
      gemm_phase(lds, (const bf16_t*)(ws + S_HID), FH, WB + W_D0, FH, 0, NR / 128, 8, e); }
    GRID_SYNC();
    modulate_rows(p, 1, 0, false, 0);
    GRID_SYNC();
    { EpiWin1 e{(bf16_t*)(ws + S1_Q), (float*)(ws + S1_KRAW), (bf16_t*)(ws + S1_VT)};
      gemm_phase(lds, A0, 1024, WB + W_IN1, 1024, 0, NR / 128, 12, e); }
    GRID_SYNC();
    win_prep_phase(p);
    GRID_SYNC();
    { const bf16_t* Q = (const bf16_t*)(ws + S1_Q); const bf16_t* K1 = (const bf16_t*)(ws + S1_K); const bf16_t* VT = (const bf16_t*)(ws + S1_VT);
      const int nit = 2 * 16 * 64;
      for (int it = bid; it < nit; it += nb) { const int g = it & 3, i = (it >> 2) & 63, kvh = (it >> 8) & 3, b = it >> 10; const int hq = kvh * 4 + g;
          const size_t row = NCTX + (size_t)b * SEQ + i * 128;
          const int l0 = (2 * i - 2) < 0 ? 0 : (2 * i - 2), l1 = (2 * i + 4) > 128 ? 128 : (2 * i + 4);
          attn_item<64, 64, true>(lds, Q + row * 1024 + hq * 64, 1024, K1 + (size_t)(b * 4 + kvh) * TK * 64, VT + (size_t)(b * 4 + kvh) * 64 * TK, 0, 4, 4 + l0, 4 + l1,
                                  p.in[33][hq] * LOG2E, 1.f, A0 + row * 1024 + hq * 64, 1024, i * 128); } }
    GRID_SYNC();
    { EpiRes e{H, H + (size_t)NCTX * 1024, nullptr, H + (size_t)NCTX * 1024, MOD + 1 * 3 * 6144 + 2048};
      gemm_phase(lds, A0, 1024, WB + W_OUT1, 1024, 4, NLAT / 128, 8, e); }
    GRID_SYNC();
    modulate_rows(p, 1, 1, false, NCTX);
    GRID_SYNC();
    { EpiSwiGLU e{(bf16_t*)(ws + S_HID)};
      gemm_phase(lds, A0, 1024, WB + W_GU1, 1024, 4, NLAT / 128, 44, e); }
    GRID_SYNC();
    { EpiRes e{H, H + (size_t)NCTX * 1024, nullptr, p.out, MOD + 1 * 3 * 6144 + 5120};
      gemm_phase(lds, (const bf16_t*)(ws + S_HID), FH, WB + W_D1, FH, 4, NLAT / 128, 8, e); }
}

extern "C" void kernel_launch(void* const* d_in, const int* in_sizes, int n_in, void* d_out, int out_size, void* d_ws, size_t ws_size, hipStream_t stream) {
    static int grid_blocks = 0;
    if (grid_blocks == 0) {
        if (n_in != 34 || ws_size < WS_NEED) { fprintf(stderr, "kernel_launch: unexpected n_in %d / ws %zu (need %zu)\n", n_in, ws_size, (size_t)WS_NEED); grid_blocks = -1; return; }
        int dev = 0, cus = 0, per_cu = 0;
        (void)hipGetDevice(&dev);
        (void)hipDeviceGetAttribute(&cus, hipDeviceAttributeMultiprocessorCount, dev);
        (void)hipFuncSetAttribute((const void*)fwd_kernel, hipFuncAttributeMaxDynamicSharedMemorySize, LDS_BYTES);
        (void)hipOccupancyMaxActiveBlocksPerMultiprocessor(&per_cu, (const void*)fwd_kernel, NTHREADS, LDS_BYTES);
        if (per_cu < 1) { fprintf(stderr, "kernel_launch: occupancy query returned %d\n", per_cu); grid_blocks = -1; return; }
        if (per_cu > 2) per_cu = 2;
        grid_blocks = cus * per_cu;
        fprintf(stderr, "kernel_launch: grid %d (%d CUs x %d)\n", grid_blocks, cus, per_cu);
    }
    if (grid_blocks < 0) return;
    Params p{};
    for (int i = 0; i < 34; ++i) p.in[i] = (const float*)d_in[i];
    p.out = (float*)d_out; p.ws = (char*)d_ws;
    const float* fg = p.in[8]; const float* fu = p.in[9]; const float* fd = p.in[10];
    const size_t FW = (size_t)1024 * FH;
    int t0 = 0;
    auto mk = [&](int idx, const float* a, const float* b, size_t dst, int K, int ld, int npad, int mode) {
        Job& j = p.jobs[idx]; j.a = a; j.b = b; j.dst = dst; j.K = K; j.ld = ld; j.ntk = K / 64; j.ntn = npad / 64; j.tile0 = t0; j.mode = mode; t0 += j.ntk * j.ntn; };
    mk(0, p.in[11], nullptr, W_IN0, 1024, 1216, 1280, 0);
    mk(1, p.in[24], nullptr, W_QB, 384, 768, 768, 0);
    mk(2, p.in[26], nullptr, W_KVB, 256, 1024, 1024, 0);
    mk(3, p.in[21], nullptr, W_GLU, 512, 512, 512, 0);
    mk(4, p.in[12], nullptr, W_OUT0, 1024, 1024, 1024, 0);
    mk(5, fg, fu, W_GU0, 1024, FH, 5632, 1);
    mk(6, fd, nullptr, W_D0, FH, 1024, 1024, 0);
    mk(7, p.in[29], nullptr, W_IN1, 1024, 1536, 1536, 0);
    mk(8, p.in[30], nullptr, W_OUT1, 1024, 1024, 1024, 0);
    mk(9, fg + FW, fu + FW, W_GU1, 1024, FH, 5632, 1);
    mk(10, fd + FW, nullptr, W_D1, FH, 1024, 1024, 0);
    p.njobtiles = t0;
    if (hipMemsetAsync((char*)d_ws + T_BAR, 0, XCD_BAR_WORDS * 4, stream) != hipSuccess) { fprintf(stderr, "kernel_launch: memset failed\n"); return; }
    void* args[] = {&p};
    hipError_t e = hipLaunchCooperativeKernel((const void*)fwd_kernel, dim3(grid_blocks), dim3(NTHREADS), args, LDS_BYTES, stream);
    if (e != hipSuccess) fprintf(stderr, "cooperative launch failed: %s (grid %d)\n", hipGetErrorString(e), grid_blocks);
}
```

```cpp
#include <hip/hip_runtime.h>
#include <hip/hip_cooperative_groups.h>
#include <cstdio>
#include <cstdint>
namespace cg = cooperative_groups;

#define DI __device__ __forceinline__
typedef unsigned short bf16_t;
typedef short bf16x8 __attribute__((ext_vector_type(8)));
typedef short s16x4 __attribute__((ext_vector_type(4)));
typedef float f32x4 __attribute__((ext_vector_type(4)));
typedef float f32x2 __attribute__((ext_vector_type(2)));
typedef float f32x16 __attribute__((ext_vector_type(16)));
typedef unsigned u32x4 __attribute__((ext_vector_type(4)));
typedef unsigned u32x2 __attribute__((ext_vector_type(2)));
typedef __bf16 bf16v2 __attribute__((ext_vector_type(2)));

constexpr int DM = 1024, NBATCH = 2, SEQ = 8192, CTX = 256;
constexpr int NCTX = NBATCH * CTX;
constexpr int NLAT = NBATCH * SEQ;
constexpr int NR = NCTX + NLAT;
constexpr int TK = CTX + SEQ;
constexpr int FH = 2816;
constexpr int NCH = TK / 64;
constexpr float LOG2E = 1.4426950408889634f;
constexpr int LDS_BYTES = 131072 + 64;
constexpr int NTHREADS = 512, NWV = 8;

constexpr size_t W_IN0 = 0;
constexpr size_t W_QB = W_IN0 + (size_t)1280 * 1024;
constexpr size_t W_KVB = W_QB + (size_t)768 * 384;
constexpr size_t W_GLU = W_KVB + (size_t)1024 * 256;
constexpr size_t W_OUT0 = W_GLU + (size_t)512 * 512;
constexpr size_t W_GU0 = W_OUT0 + (size_t)1024 * 1024;
constexpr size_t W_D0 = W_GU0 + (size_t)5632 * 1024;
constexpr size_t W_IN1 = W_D0 + (size_t)1024 * 2816;
constexpr size_t W_OUT1 = W_IN1 + (size_t)1536 * 1024;
constexpr size_t W_GU1 = W_OUT1 + (size_t)1024 * 1024;
constexpr size_t W_D1 = W_GU1 + (size_t)5632 * 1024;
constexpr size_t W_END = W_D1 + (size_t)1024 * 2816;
constexpr size_t OFF_TAB = W_END * 2;
constexpr size_t T_MOD = OFF_TAB;
constexpr size_t T_ROPE = T_MOD + 2 * 3 * 6144 * 4;
constexpr size_t T_LAMB = T_ROPE + 128 * 16 * 2 * 4;
constexpr size_t T_LAM64 = T_LAMB + 2 * 32 * 64 * 8;
constexpr size_t T_BBAR = T_LAM64 + 2 * 32 * 64 * 8;
constexpr size_t T_BAR = T_BBAR + (size_t)2 * 32 * 64 * 16 * 8;
constexpr size_t OFF_H = OFF_TAB + (1u << 20);
constexpr size_t OFF_A0 = OFF_H + (size_t)NR * 1024 * 4;
constexpr size_t OFF_S = OFF_A0 + (size_t)NR * 1024 * 2;
constexpr size_t WS_NEED = OFF_S + (size_t)108134400;
static_assert(WS_NEED <= ((size_t)256 << 20) && OFF_S + (size_t)NR * FH * 2 <= WS_NEED, "workspace");
constexpr int SL = 32;
constexpr int NCK = TK / SL;
constexpr int CHR = NBATCH * NCK;
constexpr size_t H_UA = OFF_H;
constexpr size_t H_KR = H_UA + (size_t)(32 * CHR + 256) * 768 * 2;
constexpr size_t H_E = H_KR + (size_t)NR * 64 * 4;
constexpr size_t H_KK = H_E + (size_t)32 * CHR * 256 * 4;
constexpr size_t H_POW = H_KK + (size_t)32 * 2 * 32 * 256 * 4;
constexpr size_t H_W1A = H_POW + (size_t)4096 * 33 * 8;
static_assert(H_W1A + (size_t)32 * 256 * 512 * 2 <= OFF_A0, "H region overflow");
constexpr size_t A_W1B = OFF_A0;
constexpr size_t S_CQN = OFF_S;
constexpr size_t S_CKVN = S_CQN + (size_t)NR * 384 * 2;
constexpr size_t S_YG = OFF_S;
constexpr size_t S_X = S_CKVN + (size_t)NR * 256 * 2;
constexpr size_t S_CQKV = S_X;
constexpr size_t S_QRAW = S_X;
constexpr size_t S_KNOPE = S_QRAW + (size_t)NR * 768 * 2;
constexpr size_t S_VT = S_KNOPE + (size_t)NR * 512 * 2;
constexpr size_t S_KA = S_VT + (size_t)2 * 4 * 128 * TK * 2;
static_assert(S_CQKV + (size_t)NR * 640 * 4 <= S_VT, "CQKV overlaps VT");
static_assert(S_KA + (size_t)2 * 4 * TK * 192 * 2 <= WS_NEED, "scratch overflow");
constexpr size_t S_HID = OFF_S;
constexpr size_t S1_Q = OFF_S;
constexpr size_t S1_KRAW = S1_Q + (size_t)NR * 1024 * 2;
constexpr size_t S1_K = S1_KRAW + (size_t)NR * 256 * 4;
constexpr size_t S1_VT = S1_K + (size_t)2 * 4 * TK * 64 * 2;

struct Job { const float* a; const float* b; unsigned long long dst; int K, ld, ntk, ntn, tile0, mode; };
struct Params {
    const float* in[34];
    float* out;
    char* ws;
    Job jobs[11];
    int njobtiles;
    int pad;
};

DI int get_tid() { int t = threadIdx.x; asm volatile("" : "+v"(t)); return t; }
DI unsigned pk2(float lo, float hi) { f32x2 v = {lo, hi}; return __builtin_bit_cast(unsigned, __builtin_convertvector(v, bf16v2)); }
DI float bf2f(unsigned short b) { return __uint_as_float(((unsigned)b) << 16); }
DI float wave_sum(float v) {
#pragma unroll
    for (int o = 32; o > 0; o >>= 1) v += __shfl_xor(v, o);
    return v;
}
DI int row_vec(int r) { return r < NCTX ? 2 : (r - NCTX) / SEQ; }
DI int row_batch(int r) { return r < NCTX ? r / CTX : (r - NCTX) / SEQ; }
DI int row_tpos(int r) { return r < NCTX ? r % CTX : CTX + (r - NCTX) % SEQ; }
DI float sigmoidf_(float x) { return 1.f / (1.f + __expf(-x)); }
DI float siluf_(float x) { return x / (1.f + __expf(-x)); }
DI float gelu_tanh(float y) { const float z = 0.7978845608028654f * (y + 0.044715f * y * y * y); const float t = 1.f - 2.f / (1.f + __expf(2.f * z)); return 0.5f * y * (1.f + t); }
DI void my_sincos(float x, float& s, float& c) {
    const float q = rintf(x * 0.636619772367581f);
    float r = fmaf(-q, 1.5703125f, x);
    r = fmaf(-q, 4.837512969970703125e-4f, r);
    r = fmaf(-q, 7.54978995489188216e-8f, r);
    const int qi = (int)q;
    const float r2 = r * r;
    const float sp = r + r * r2 * (-1.6666654611e-1f + r2 * (8.3321608736e-3f + r2 * (-1.9515295891e-4f)));
    const float cp = 1.0f - 0.5f * r2 + r2 * r2 * (4.166664568298827e-2f + r2 * (-1.388731625493765e-3f + r2 * 2.443315711809948e-5f));
    const int k = qi & 3;
    s = (k == 0) ? sp : (k == 1) ? cp : (k == 2) ? -sp : -cp;
    c = (k == 0) ? cp : (k == 1) ? -sp : (k == 2) ? -cp : sp;
}


#define XB_TMO      128
#define XB_XCNT(j)  (256  + 64 * (j))
#define XB_XSUB(j)  (1280 + 64 * (j))
#define XB_XGEN(j)  (2304 + 64 * (j))
#define XB_TOP      3328
#define XB_TOPGEN   3392
#define XCD_BAR_WORDS 3456
#define XB_SPIN_CAP (1u << 22)
#define LAS __attribute__((address_space(3)))
DI unsigned xb_ld(unsigned* p) { return __hip_atomic_load(p, __ATOMIC_RELAXED, __HIP_MEMORY_SCOPE_AGENT); }
DI unsigned xb_add(unsigned* p, unsigned v) { return __hip_atomic_fetch_add(p, v, __ATOMIC_RELAXED, __HIP_MEMORY_SCOPE_AGENT); }
DI unsigned xb_xcc_id() { return (unsigned)__builtin_amdgcn_s_getreg((3 << 11) | 20) & 0xFu; }
#define XB_SPIN(cond, bar) do { unsigned _sp = 0; while (cond) { __builtin_amdgcn_s_sleep(1); \
    if ((++_sp & 255u) == 0u) { if (xb_ld(&(bar)[XB_TMO])) break; if (_sp > XB_SPIN_CAP) { atomicAdd(&(bar)[XB_TMO], 1u); break; } } } } while (0)
struct XcdBarrier { unsigned* bar; unsigned x; volatile LAS unsigned* st; };
DI XcdBarrier xcd_barrier_post(unsigned* bar, volatile LAS unsigned* st) {
    XcdBarrier b; b.bar = bar; b.x = xb_xcc_id(); b.st = st;
    if (threadIdx.x == 0) (void)xb_add(&bar[XB_XCNT(b.x)], 1u);
    return b;
}
DI void xcd_barrier_complete(unsigned* bar, unsigned x, unsigned& nloc, unsigned& nx) {
    const unsigned G = gridDim.x * gridDim.y * gridDim.z;
    unsigned sum, cnt, mine, sp = 0u;
    for (;;) {
        sum = 0u; cnt = 0u; mine = 0u;
#pragma unroll
        for (unsigned j = 0; j < 16; ++j) { const unsigned c = xb_ld(&bar[XB_XCNT(j)]); sum += c; cnt += (c > 0u) ? 1u : 0u; mine = (j == x) ? c : mine; }
        if (sum == G) break;
        __builtin_amdgcn_s_sleep(1);
        if ((++sp & 255u) == 0u) { if (xb_ld(&bar[XB_TMO])) break; if (sp > XB_SPIN_CAP) { atomicAdd(&bar[XB_TMO], 1u); break; } }
    }
    nloc = mine > 0u ? mine : 1u; nx = cnt > 0u ? cnt : 1u;
}
DI void xcd_barrier(const XcdBarrier& b) {
    asm volatile("s_waitcnt vmcnt(0)" ::: "memory");
    __syncthreads();
    if (threadIdx.x == 0) {
        unsigned* bar = b.bar;
        __builtin_amdgcn_s_waitcnt(0);
        unsigned nloc = b.st[0], nx = b.st[1];
        if (nloc == 0u) { xcd_barrier_complete(bar, b.x, nloc, nx); b.st[0] = nloc; b.st[1] = nx; }
        const unsigned old = xb_add(&bar[XB_XSUB(b.x)], 1u);
        const unsigned gen = old / nloc;
        if (old + 1u == (gen + 1u) * nloc) {
            __builtin_amdgcn_fence(__ATOMIC_RELEASE, "agent");
            asm volatile("s_waitcnt vmcnt(0)" ::: "memory");
            const unsigned og = xb_add(&bar[XB_TOP], 1u);
            const unsigned tg = og / nx;
            if (og + 1u == (tg + 1u) * nx) xb_add(&bar[XB_TOPGEN], 1u);
            else XB_SPIN(xb_ld(&bar[XB_TOPGEN]) == tg, bar);
            __builtin_amdgcn_fence(__ATOMIC_ACQUIRE, "agent");
            xb_add(&bar[XB_XGEN(b.x)], 1u);
            asm volatile("s_waitcnt vmcnt(0)" ::: "memory");
        } else {
            XB_SPIN(xb_ld(&bar[XB_XGEN(b.x)]) == gen, bar);
            __builtin_amdgcn_fence(__ATOMIC_ACQUIRE, "agent");
            asm volatile("s_waitcnt vmcnt(0)" ::: "memory");
        }
    }
    __syncthreads();
}

DI void transpose_tile(char* lds, char* ws, const Job& jb, int lt, bool live) {
    const int tid512 = get_tid(); const int tid = tid512 & 255;
    float (*tile)[65] = (float (*)[65])(lds + (tid512 >> 8) * 17408);
    const int tk = lt % jb.ntk, tn = lt / jb.ntk;
    const int k0 = tk * 64, n0 = tn * 64;
    const int j = tid & 63, kq = tid >> 6;
    const float* src; int col; bool valid = true;
    if (jb.mode == 0) { src = jb.a; col = n0 + j; valid = live && col < jb.ld; }
    else { const int nsub = j >> 4, i = j & 15; src = (nsub & 1) ? jb.b : jb.a; col = tn * 32 + (nsub >> 1) * 16 + i; valid = live; }
#pragma unroll
    for (int kk = 0; kk < 16; ++kk) { const int k = kk * 4 + kq; tile[k][j] = valid ? src[(size_t)(k0 + k) * jb.ld + col] : 0.f; }
    __syncthreads();
    const int r = tid >> 2, ks = (tid & 3) * 16;
    unsigned w[8];
#pragma unroll
    for (int q = 0; q < 8; ++q) w[q] = pk2(tile[ks + 2 * q][r], tile[ks + 2 * q + 1][r]);
    bf16_t* d = (bf16_t*)(ws) + jb.dst + (size_t)(n0 + r) * jb.K + k0 + ks;
    if (live) { *(u32x4*)d = (u32x4){w[0], w[1], w[2], w[3]};
    *(u32x4*)(d + 8) = (u32x4){w[4], w[5], w[6], w[7]}; }
    __syncthreads();
}

DI void ada_item(char* lds, const Params& p, int it) {
    float* sil = (float*)lds;
    float* red = sil + 3072;
    float* MOD = (float*)(p.ws + T_MOD);
    const int tid = get_tid(), layer = it / 96, n0 = (it % 96) * 64;
    for (int i = tid; i < 3072; i += NTHREADS) { const int v = i >> 10, k = i & 1023; const float x = v < 2 ? p.in[1][v * 1024 + k] : p.in[3][k]; sil[i] = siluf_(x); }
    __syncthreads();
    const int j = tid & 63, kq = tid >> 6;
    const float* W = p.in[4] + (size_t)layer * 1024 * 6144 + n0 + j;
    float a0 = 0.f, a1 = 0.f, a2 = 0.f;
#pragma unroll 8
    for (int k = kq * 128; k < kq * 128 + 128; ++k) { const float w = W[(size_t)k * 6144]; a0 += sil[k] * w; a1 += sil[1024 + k] * w; a2 += sil[2048 + k] * w; }
    red[(kq * 3 + 0) * 64 + j] = a0; red[(kq * 3 + 1) * 64 + j] = a1; red[(kq * 3 + 2) * 64 + j] = a2;
    __syncthreads();
    if (tid < 192) { const int v = tid >> 6, jj = tid & 63;
        float s = p.in[5][layer * 6144 + n0 + jj];
#pragma unroll
        for (int q = 0; q < 8; ++q) s += red[(q * 3 + v) * 64 + jj];
        MOD[(layer * 3 + v) * 6144 + n0 + jj] = s; }
    __syncthreads();
}

DI void tables_item(const Params& p, int it) {
    const int tid = get_tid();
    if (it < 4) {
        const int e = it * 512 + tid, pos = e >> 4, i = e & 15;
        const float inv = exp2f(-(float)i * (13.287712379549449f / 16.f));
        float s, c; my_sincos((float)pos * inv, s, c);
        float* ROPE = (float*)(p.ws + T_ROPE); ROPE[e * 2] = c; ROPE[e * 2 + 1] = s;
    } else {
        const int e = (it - 4) * 512 + tid;
        const int dg = e >> 6;
        const float lr = p.in[13][e], li = p.in[14][e], step = expf(p.in[15][dg]);
        const float a = lr * step, b = li * step;
        const float ea = expf(a);
        float sb, cb; my_sincos(b, sb, cb);
        float sh, ch; my_sincos(0.5f * b, sh, ch);
        const float em1 = a * (1.f + a * 0.5f * (1.f + a * (1.f / 3.f) * (1.f + a * 0.25f * (1.f + a * 0.2f * (1.f + a * (1.f / 6.f))))));
        const float lbr = ea * cb, lbi = ea * sb;
        const float nr = em1 * cb - 2.f * sh * sh, ni = ea * sb;
        const float den = lr * lr + li * li;
        const float qr = (nr * lr + ni * li) / den, qi = (ni * lr - nr * li) / den;
        f32x2* BB = (f32x2*)(p.ws + T_BBAR);
#pragma unroll
        for (int s = 0; s < 16; ++s) { const float br = p.in[16][e * 16 + s], bi = p.in[17][e * 16 + s]; BB[e * 16 + s] = (f32x2){qr * br - qi * bi, qr * bi + qi * br}; }
        f32x2* POW = (f32x2*)(p.ws + H_POW) + (size_t)e * 33;
        float pr = 1.f, pi = 0.f;
        for (int q = 0; q <= 32; ++q) { POW[q] = (f32x2){pr, pi}; const float nr2 = pr * lbr - pi * lbi, ni2 = pr * lbi + pi * lbr; pr = nr2; pi = ni2; }
    }
}

DI void modulate_rows(const Params& p, int layer, int which, bool from_inputs, int r0) {
    const int tid_ = get_tid(); const int lane = tid_ & 63, wid = tid_ >> 6;
    const float* gain = p.in[which ? 7 : 6] + layer * 1024;
    const float* modl = (const float*)(p.ws + T_MOD) + layer * 3 * 6144 + (which ? 3072 : 0);
    const float* H = (const float*)(p.ws + OFF_H);
    bf16_t* dst = (bf16_t*)(p.ws + OFF_A0);
    for (int r = r0 + blockIdx.x * NWV + wid; r < NR; r += gridDim.x * NWV) {
        const float* src = from_inputs ? (r < NCTX ? p.in[2] + (size_t)r * 1024 : p.in[0] + (size_t)(r - NCTX) * 1024) : H + (size_t)r * 1024;
        const float* mv = modl + row_vec(r) * 6144;
        f32x4 x[4]; float ss = 0.f;
#pragma unroll
        for (int i = 0; i < 4; ++i) { x[i] = *(const f32x4*)(src + i * 256 + lane * 4); ss += x[i][0] * x[i][0] + x[i][1] * x[i][1] + x[i][2] * x[i][2] + x[i][3] * x[i][3]; }
        ss = wave_sum(ss);
        const float rstd = rsqrtf(ss * (1.f / 1024.f) + 1e-6f);
#pragma unroll
        for (int i = 0; i < 4; ++i) { const int c = i * 256 + lane * 4;
            const f32x4 g = *(const f32x4*)(gain + c), sh = *(const f32x4*)(mv + c), sc = *(const f32x4*)(mv + 1024 + c);
            const f32x4 y = x[i] * rstd * g * (1.f + sc) + sh;
            *(u32x2*)(dst + (size_t)r * 1024 + c) = (u32x2){pk2(y[0], y[1]), pk2(y[2], y[3])}; }
    }
}

template <class Epi>
DI void gemm_phase(char* lds, const bf16_t* A0_, int lda, const bf16_t* Bt0_, int K, int mt0, int nmt, int nnt, const Epi& epi, int nbatch = 1, size_t sA = 0, size_t sB = 0, int ksplit = 1) {
    const int tid = get_tid(), lane = tid & 63, wid = tid >> 6, wr = wid >> 2, wc = wid & 3, fr = lane & 15, fq = lane >> 4;
    const int nk = (K >> 6) / ksplit;
    const int lrow = tid >> 3, lc = tid & 7, lkc = lc * 8;
    const int woff = lrow * 128 + ((lc ^ ((lrow >> 1) & 7)) << 4);
    const int ra0 = (wr * 128 + fr) * 128 + ((fq ^ (fr >> 1)) << 4);
    const int ra1 = (wr * 128 + fr) * 128 + (((4 + fq) ^ (fr >> 1)) << 4);
    const int rb0 = 32768 + (wc * 64 + fr) * 128 + ((fq ^ (fr >> 1)) << 4);
    const int rb1 = 32768 + (wc * 64 + fr) * 128 + (((4 + fq) ^ (fr >> 1)) << 4);
    const int per = nmt * nnt, ntile = nbatch * per * ksplit;
    const int myn = ((int)blockIdx.x < ntile) ? (ntile - (int)blockIdx.x + (int)gridDim.x - 1) / (int)gridDim.x : 0;
    const int total = myn * nk;
    f32x4 acc[8][4];
#pragma unroll
    for (int m = 0; m < 8; ++m)
#pragma unroll
        for (int n = 0; n < 4; ++n) acc[m][n] = (f32x4){0.f, 0.f, 0.f, 0.f};
    u32x4 sa[4], sb[4];
    int iti = 0, ikt = 0;
    const bf16_t* Ag = A0_; const bf16_t* Bg = Bt0_;
#define G_ISSUE() do { if (ikt == 0) { const int u_ = blockIdx.x + iti * gridDim.x; const int t_ = u_ / ksplit, sl_ = u_ - t_ * ksplit; const int gb_ = t_ / per, tr_ = t_ - gb_ * per; const int tm_ = tr_ / nnt, tn_ = tr_ - tm_ * nnt; \
            Ag = A0_ + (size_t)gb_ * sA + (size_t)((mt0 + tm_) * 256 + lrow) * lda + lkc + sl_ * nk * 64; Bg = Bt0_ + (size_t)gb_ * sB + (size_t)(tn_ * 256 + lrow) * K + lkc + sl_ * nk * 64; } \
        _Pragma("unroll") for (int i = 0; i < 4; ++i) { sa[i] = *(const u32x4*)(Ag + (size_t)i * 64 * lda + ikt * 64); sb[i] = *(const u32x4*)(Bg + (size_t)i * 64 * K + ikt * 64); } \
        if (++ikt == nk) { ikt = 0; ++iti; } } while (0)
#define G_WRITE(bufoff) do { _Pragma("unroll") for (int i = 0; i < 4; ++i) { *(u32x4*)(lds + (bufoff) + woff + i * 8192) = sa[i]; *(u32x4*)(lds + (bufoff) + 32768 + woff + i * 8192) = sb[i]; } } while (0)
#define G_COMPUTE(bufoff) do { _Pragma("unroll") for (int ks = 0; ks < 2; ++ks) { bf16x8 a[8], b[4]; \
        _Pragma("unroll") for (int m = 0; m < 8; ++m) a[m] = *(const bf16x8*)(lds + (bufoff) + (ks ? ra1 : ra0) + m * 2048); \
        _Pragma("unroll") for (int n = 0; n < 4; ++n) b[n] = *(const bf16x8*)(lds + (bufoff) + (ks ? rb1 : rb0) + n * 2048); \
        _Pragma("unroll") for (int m = 0; m < 8; ++m) _Pragma("unroll") for (int n = 0; n < 4; ++n) acc[m][n] = __builtin_amdgcn_mfma_f32_16x16x32_bf16(b[n], a[m], acc[m][n], 0, 0, 0); } } while (0)
    __syncthreads();
    if (total > 0) {
        G_ISSUE(); G_WRITE(0);
        if (total > 1) G_ISSUE();
    }
    __syncthreads();
    int cti = 0, ckt = 0;
    for (int q = 0; q < total; ++q) {
        const int cur = (q & 1) * 65536;
        if (q + 1 < total) G_WRITE(cur ^ 65536);
        if (q + 2 < total) G_ISSUE();
        G_COMPUTE(cur);
        __syncthreads();
        if (++ckt == nk) {
            const int u_ = blockIdx.x + cti * gridDim.x; const int t_ = u_ / ksplit; const int gb_ = t_ / per, tr_ = t_ - gb_ * per; const int tm_ = tr_ / nnt, tn_ = tr_ - tm_ * nnt;
            epi(acc, (mt0 + tm_) * 256 + wr * 128 + fr, tn_ * 256 + wc * 64 + fq * 4, gb_);
#pragma unroll
            for (int m = 0; m < 8; ++m)
#pragma unroll
                for (int n = 0; n < 4; ++n) acc[m][n] = (f32x4){0.f, 0.f, 0.f, 0.f};
            ckt = 0; ++cti;
        }
    }
#undef G_ISSUE
#undef G_WRITE
#undef G_COMPUTE
}

struct EpiWin0 {
    bf16_t* UA; float* CQKV; float* KR;
    DI void operator()(const f32x4 (&acc)[8][4], int row0, int col0, int gb) const {
#pragma unroll
        for (int m = 0; m < 8; ++m) { const int ri = row0 + m * 16; const size_t r = ri; const int b = row_batch(ri), tp = row_tpos(ri);
#pragma unroll
            for (int n = 0; n < 4; ++n) { const int c = col0 + n * 16; const f32x4 v = acc[m][n];
                if (c < 512) { const int g = c >> 4, s0 = c & 15;
                    *(u32x2*)(UA + ((size_t)g * CHR + b * NCK + (tp >> 5)) * 768 + (tp & 31) * 16 + s0) = (u32x2){pk2(v[0], v[1]), pk2(v[2], v[3])}; }
                else if (c < 1152) *(f32x4*)(CQKV + r * 640 + (c - 512)) = v;
                else if (c < 1216) *(f32x4*)(KR + r * 64 + (c - 1152)) = v; } }
    }
};
struct EpiS1a {
    float* E;
    DI void operator()(const f32x4 (&acc)[8][4], int row0, int col0, int gb) const {
#pragma unroll
        for (int m = 0; m < 8; ++m) { const int r = row0 + m * 16; if (r >= CHR) continue;
#pragma unroll
            for (int n = 0; n < 4; ++n) *(f32x4*)(E + ((size_t)gb * CHR + r) * 256 + col0 + n * 16) = acc[m][n]; }
    }
};
struct EpiS1b {
    bf16_t* YG;
    DI void operator()(const f32x4 (&acc)[8][4], int row0, int col0, int gb) const {
#pragma unroll
        for (int m = 0; m < 8; ++m) { const int r = row0 + m * 16; if (r >= CHR) continue; const int b = r / NCK, c = r % NCK;
#pragma unroll
            for (int n = 0; n < 4; ++n) { const int cc = col0 + n * 16; const int tl = cc >> 4, s0 = cc & 15; const f32x4 v = acc[m][n];
                const int tp = c * SL + tl; const size_t row = tp < CTX ? (size_t)b * CTX + tp : (size_t)NCTX + (size_t)b * SEQ + (tp - CTX);
                *(u32x2*)(YG + row * 512 + gb * 16 + s0) = (u32x2){pk2(gelu_tanh(v[0]), gelu_tanh(v[1])), pk2(gelu_tanh(v[2]), gelu_tanh(v[3]))}; } }
    }
};
struct EpiBf16 {
    bf16_t* O; int ldo;
    DI void operator()(const f32x4 (&acc)[8][4], int row0, int col0, int gb) const {
#pragma unroll
        for (int m = 0; m < 8; ++m) { const size_t r = row0 + m * 16;
#pragma unroll
            for (int n = 0; n < 4; ++n) { const int c = col0 + n * 16; const f32x4 v = acc[m][n];
                *(u32x2*)(O + r * ldo + c) = (u32x2){pk2(v[0], v[1]), pk2(v[2], v[3])}; } }
    }
};
struct EpiKV {
    bf16_t* KNOPE; bf16_t* VT;
    DI void operator()(const f32x4 (&acc)[8][4], int row0, int col0, int gb) const {
#pragma unroll
        for (int m = 0; m < 8; ++m) { const int r = row0 + m * 16; const int b = row_batch(r), tp = row_tpos(r);
#pragma unroll
            for (int n = 0; n < 4; ++n) { const int c = col0 + n * 16; const int h = c >> 8, w = c & 255; const f32x4 v = acc[m][n];
                if (w < 128) *(u32x2*)(KNOPE + (size_t)r * 512 + h * 128 + w) = (u32x2){pk2(v[0], v[1]), pk2(v[2], v[3])};
                else { bf16_t* d = VT + ((size_t)(b * 4 + h) * 128 + (w - 128)) * TK + tp; const unsigned p0 = pk2(v[0], v[1]), p1 = pk2(v[2], v[3]);
                    d[0] = (bf16_t)(p0 & 0xffff); d[TK] = (bf16_t)(p0 >> 16); d[2 * TK] = (bf16_t)(p1 & 0xffff); d[3 * TK] = (bf16_t)(p1 >> 16); } } }
    }
};
struct EpiGLU {
    const bf16_t* YG; const float* bias; bf16_t* CAT;
    DI void operator()(const f32x4 (&acc)[8][4], int row0, int col0, int gb) const {
#pragma unroll
        for (int m = 0; m < 8; ++m) { const size_t r = row0 + m * 16;
#pragma unroll
            for (int n = 0; n < 4; ++n) { const int c = col0 + n * 16; const f32x4 v = acc[m][n]; const f32x4 bv = *(const f32x4*)(bias + c);
                const u32x2 yy = *(const u32x2*)(YG + r * 512 + c);
                const float y0 = __uint_as_float(yy[0] << 16), y1 = __uint_as_float(yy[0] & 0xffff0000u), y2 = __uint_as_float(yy[1] << 16), y3 = __uint_as_float(yy[1] & 0xffff0000u);
                const float o0 = y0 * sigmoidf_(v[0] + bv[0]), o1 = y1 * sigmoidf_(v[1] + bv[1]), o2 = y2 * sigmoidf_(v[2] + bv[2]), o3 = y3 * sigmoidf_(v[3] + bv[3]);
                *(u32x2*)(CAT + r * 1024 + c) = (u32x2){pk2(o0, o1), pk2(o2, o3)}; } }
    }
};
struct EpiRes {
    const float* res_ctx; const float* res_lat; float* dst_ctx; float* dst_lat; const float* gate; int atomic;
    DI void operator()(const f32x4 (&acc)[8][4], int row0, int col0, int gb) const {
#pragma unroll
        for (int m = 0; m < 8; ++m) { const int r = row0 + m * 16;
            const float* rs = r < NCTX ? res_ctx + (size_t)r * 1024 : res_lat + (size_t)(r - NCTX) * 1024;
            float* ds = r < NCTX ? dst_ctx + (size_t)r * 1024 : dst_lat + (size_t)(r - NCTX) * 1024;
            if (r < NCTX && dst_ctx == nullptr) continue;
            const float* gv = gate + row_vec(r) * 6144;
#pragma unroll
            for (int n = 0; n < 4; ++n) { const int c = col0 + n * 16; const f32x4 g = *(const f32x4*)(gv + c);
                if (atomic) { const f32x4 v = g * acc[m][n];
#pragma unroll
                    for (int j = 0; j < 4; ++j) (void)__hip_atomic_fetch_add(ds + c + j, v[j], __ATOMIC_RELAXED, __HIP_MEMORY_SCOPE_AGENT); }
                else { const f32x4 x = *(const f32x4*)(rs + c); *(f32x4*)(ds + c) = x + g * acc[m][n]; } } }
    }
};
struct EpiSwiGLU {
    bf16_t* HID;
    DI void operator()(const f32x4 (&acc)[8][4], int row0, int col0, int gb) const {
        const int hc = (col0 >> 6) * 32 + (col0 & 15);
#pragma unroll
        for (int m = 0; m < 8; ++m) { const size_t r = row0 + m * 16;
#pragma unroll
            for (int q = 0; q < 2; ++q) { const f32x4 g = acc[m][2 * q], u = acc[m][2 * q + 1];
                const float o0 = siluf_(g[0]) * u[0], o1 = siluf_(g[1]) * u[1], o2 = siluf_(g[2]) * u[2], o3 = siluf_(g[3]) * u[3];
                *(u32x2*)(HID + r * FH + hc + q * 16) = (u32x2){pk2(o0, o1), pk2(o2, o3)}; } }
    }
};
struct EpiWin1 {
    bf16_t* Q; bf16_t* K1; bf16_t* VT; const float* qn; const float* kn; const float* ROPE;
    DI void operator()(const f32x4 (&acc)[8][4], int row0, int col0, int gb) const {
        const int cw = col0 & ~63, i0 = col0 & 15;
        if (cw >= 1280) {
#pragma unroll
            for (int m = 0; m < 8; ++m) { const int r = row0 + m * 16; const int b = row_batch(r), tp = row_tpos(r);
#pragma unroll
                for (int n = 0; n < 4; ++n) { const int cc = col0 + n * 16 - 1280, h = cc >> 6, d0 = cc & 63; const f32x4 v = acc[m][n];
                    bf16_t* d = VT + ((size_t)(b * 4 + h) * 64 + d0) * TK + tp; const unsigned p0 = pk2(v[0], v[1]), p1 = pk2(v[2], v[3]);
                    d[0] = (bf16_t)(p0 & 0xffff); d[TK] = (bf16_t)(p0 >> 16); d[2 * TK] = (bf16_t)(p1 & 0xffff); d[3 * TK] = (bf16_t)(p1 >> 16); } }
            return;
        }
        const bool isq = cw < 1024;
        const float* gn = isq ? qn : kn;
        f32x4 g[4];
#pragma unroll
        for (int n = 0; n < 4; ++n) g[n] = *(const f32x4*)(gn + n * 16 + i0);
        const float osc = isq ? 0.125f * LOG2E : 1.f;
#pragma unroll
        for (int m = 0; m < 8; ++m) { const int r = row0 + m * 16; const bool lat = r >= NCTX;
            if (isq && !lat) continue;
            const int b = row_batch(r), tp = row_tpos(r), t = tp - CTX;
            float ss = 0.f;
#pragma unroll
            for (int n = 0; n < 4; ++n) { const f32x4 v = acc[m][n]; ss += v[0] * v[0] + v[1] * v[1] + v[2] * v[2] + v[3] * v[3]; }
            ss += __shfl_xor(ss, 16); ss += __shfl_xor(ss, 32);
            const float rstd = rsqrtf(ss * (1.f / 64.f) + 1e-6f);
            f32x4 y[4];
#pragma unroll
            for (int n = 0; n < 4; ++n) y[n] = acc[m][n] * rstd * g[n];
            if (lat) { const float* rr = ROPE + ((t >> 6) * 16 + i0) * 2; const float* rc = ROPE + ((t & 63) * 16 + i0) * 2;
#pragma unroll
                for (int j = 0; j < 4; ++j) { const float c0 = rr[2 * j], s0 = rr[2 * j + 1], c1 = rc[2 * j], s1 = rc[2 * j + 1];
                    const float a0 = y[0][j], a1 = y[1][j], a2 = y[2][j], a3 = y[3][j];
                    y[0][j] = a0 * c0 - a1 * s0; y[1][j] = a1 * c0 + a0 * s0; y[2][j] = a2 * c1 - a3 * s1; y[3][j] = a3 * c1 + a2 * s1; } }
            bf16_t* dst = isq ? Q + (size_t)r * 1024 + cw + i0 : K1 + ((size_t)(b * 4 + ((cw - 1024) >> 6)) * TK + tp) * 64 + i0;
#pragma unroll
            for (int n = 0; n < 4; ++n) *(u32x2*)(dst + n * 16) = (u32x2){pk2(y[n][0] * osc, y[n][1] * osc), pk2(y[n][2] * osc, y[n][3] * osc)};
        }
    }
};

template <int DQK, int DV, bool WIN>
DI void attn_item(char* lds, const bf16_t* Q, int qstride, const bf16_t* Kb, const bf16_t* VTb, int ta0, int ta1, int tb0, int tb1,
                  float m_init, float l_init, bf16_t* O, int ostride, int qpos0) {
    constexpr int NKS = DQK / 16, NDT = DV / 32, KSTR = DQK + 8, VSTR = 68;
    constexpr int KCH = 64 * DQK / 8 / NTHREADS, VCH = DV * 8 / NTHREADS;
    bf16_t* Ks = (bf16_t*)lds; bf16_t* Vs = Ks + 64 * KSTR;
    const int tid = get_tid(), lane = tid & 63, wid = tid >> 6, r = lane & 31, h2 = lane >> 5;
    bf16x8 qf[NKS];
    { const bf16_t* qrow = Q + (size_t)(wid * 32 + r) * qstride + 8 * h2;
#pragma unroll
      for (int ks = 0; ks < NKS; ++ks) qf[ks] = *(const bf16x8*)(qrow + 16 * ks); }
    f32x16 o[NDT];
#pragma unroll
    for (int dt = 0; dt < NDT; ++dt)
#pragma unroll
        for (int i = 0; i < 16; ++i) o[dt][i] = 0.f;
    float mrun = m_init, lrun = (h2 == 0) ? l_init : 0.f;
    const int na = ta1 - ta0, ntot = na + (tb1 - tb0);
    u32x4 kr[KCH], vr[VCH];
    constexpr int KTPR = (DQK / 8) / KCH;
    constexpr int VTPR = 8 / VCH;
    const int krow = tid / KTPR, kcol = (tid % KTPR) * (KCH * 8);
    const int vrow = tid / VTPR, vcol = (tid % VTPR) * (VCH * 8);
    const bf16_t* kgp = Kb + (size_t)krow * DQK + kcol;
    const bf16_t* vgp = VTb + (size_t)vrow * TK + vcol;
    bf16_t* ksp = Ks + krow * KSTR + kcol;
    bf16_t* vsp = Vs + vrow * VSTR + vcol;
    { const int T = (0 < na) ? ta0 : tb0;
      const bf16_t* kg = kgp + (size_t)T * 64 * DQK; const bf16_t* vg = vgp + T * 64;
#pragma unroll
      for (int i = 0; i < KCH; ++i) kr[i] = *(const u32x4*)(kg + i * 8);
#pragma unroll
      for (int i = 0; i < VCH; ++i) vr[i] = *(const u32x4*)(vg + i * 8); }
    for (int it = 0; it < ntot; ++it) {
        const int T = (it < na) ? ta0 + it : tb0 + (it - na);
        __syncthreads();
#pragma unroll
        for (int i = 0; i < KCH; ++i) *(u32x4*)(ksp + i * 8) = kr[i];
#pragma unroll
        for (int i = 0; i < VCH; ++i) { *(u32x2*)(vsp + i * 8) = (u32x2){vr[i][0], vr[i][1]}; *(u32x2*)(vsp + i * 8 + 4) = (u32x2){vr[i][2], vr[i][3]}; }
        __syncthreads();
        if (it + 1 < ntot) {
            const int Tn = (it + 1 < na) ? ta0 + it + 1 : tb0 + (it + 1 - na);
            const bf16_t* kg = kgp + (size_t)Tn * 64 * DQK; const bf16_t* vg = vgp + Tn * 64;
#pragma unroll
            for (int i = 0; i < KCH; ++i) kr[i] = *(const u32x4*)(kg + i * 8);
#pragma unroll
            for (int i = 0; i < VCH; ++i) vr[i] = *(const u32x4*)(vg + i * 8);
        }
        if (WIN && T >= 4) {
            const int klo = (T - 4) * 64, qlo = qpos0 + wid * 32;
            if (klo > qlo + 31 + 128 || klo + 63 < qlo - 128) continue;
        }
        f32x16 s0, s1;
#pragma unroll
        for (int i = 0; i < 16; ++i) { s0[i] = 0.f; s1[i] = 0.f; }
#pragma unroll
        for (int ks = 0; ks < NKS; ++ks) {
            const bf16x8 k0 = *(const bf16x8*)(Ks + r * KSTR + 16 * ks + 8 * h2);
            const bf16x8 k1 = *(const bf16x8*)(Ks + (32 + r) * KSTR + 16 * ks + 8 * h2);
            s0 = __builtin_amdgcn_mfma_f32_32x32x16_bf16(k0, qf[ks], s0, 0, 0, 0);
            s1 = __builtin_amdgcn_mfma_f32_32x32x16_bf16(k1, qf[ks], s1, 0, 0, 0);
        }
        if (WIN && T >= 4) {
            const int qp = qpos0 + wid * 32 + r, kp0 = (T - 4) * 64 + 4 * h2;
#pragma unroll
            for (int i = 0; i < 16; ++i) { const int d0 = kp0 + (i & 3) + 8 * (i >> 2) - qp, d1 = d0 + 32;
                if (d0 > 128 || d0 < -128) s0[i] = -1e30f;
                if (d1 > 128 || d1 < -128) s1[i] = -1e30f; }
        }
        float mx = fmaxf(s0[0], s1[0]);
#pragma unroll
        for (int i = 1; i < 16; ++i) mx = fmaxf(mx, fmaxf(s0[i], s1[i]));
        mx = fmaxf(mx, __shfl_xor(mx, 32));
        if (__builtin_amdgcn_ballot_w64(mx > mrun + 8.f) != 0ull) {
            const float mn = fmaxf(mrun, mx);
            const float alpha = __builtin_amdgcn_exp2f(mrun - mn);
            mrun = mn; lrun *= alpha;
#pragma unroll
            for (int dt = 0; dt < NDT; ++dt)
#pragma unroll
                for (int i = 0; i < 16; ++i) o[dt][i] *= alpha;
        }
        float rs = 0.f;
#pragma unroll
        for (int i = 0; i < 16; ++i) { s0[i] = __builtin_amdgcn_exp2f(s0[i] - mrun); s1[i] = __builtin_amdgcn_exp2f(s1[i] - mrun); rs += s0[i] + s1[i]; }
        lrun += rs;
#pragma unroll
        for (int kt2 = 0; kt2 < 2; ++kt2)
#pragma unroll
            for (int st = 0; st < 2; ++st) {
                u32x4 pw;
                if (kt2 == 0) { pw[0] = pk2(s0[8 * st + 0], s0[8 * st + 1]); pw[1] = pk2(s0[8 * st + 2], s0[8 * st + 3]); pw[2] = pk2(s0[8 * st + 4], s0[8 * st + 5]); pw[3] = pk2(s0[8 * st + 6], s0[8 * st + 7]); }
                else { pw[0] = pk2(s1[8 * st + 0], s1[8 * st + 1]); pw[1] = pk2(s1[8 * st + 2], s1[8 * st + 3]); pw[2] = pk2(s1[8 * st + 4], s1[8 * st + 5]); pw[3] = pk2(s1[8 * st + 6], s1[8 * st + 7]); }
                const bf16x8 pf = __builtin_bit_cast(bf16x8, pw);
#pragma unroll
                for (int dt = 0; dt < NDT; ++dt) {
                    const bf16_t* vp = Vs + (32 * dt + r) * VSTR + 32 * kt2 + 16 * st + 4 * h2;
                    const s16x4 lo = *(const s16x4*)vp, hi = *(const s16x4*)(vp + 8);
                    const bf16x8 vf = __builtin_shufflevector(lo, hi, 0, 1, 2, 3, 4, 5, 6, 7);
                    o[dt] = __builtin_amdgcn_mfma_f32_32x32x16_bf16(vf, pf, o[dt], 0, 0, 0);
                }
            }
    }
    lrun += __shfl_xor(lrun, 32);
    const float inv = 1.f / lrun;
    bf16_t* orow = O + (size_t)(wid * 32 + r) * ostride;
#pragma unroll
    for (int dt = 0; dt < NDT; ++dt)
#pragma unroll
        for (int g = 0; g < 4; ++g)
            *(u32x2*)(orow + 32 * dt + 8 * g + 4 * h2) = (u32x2){pk2(o[dt][4 * g] * inv, o[dt][4 * g + 1] * inv), pk2(o[dt][4 * g + 2] * inv, o[dt][4 * g + 3] * inv)};
    __syncthreads();
}

DI void s5_kk_phase(const Params& p) {
    const int tid512 = get_tid(); const int tid = tid512 & 255, s = tid >> 4, sp = tid & 15;
    const f32x2* POW = (const f32x2*)(p.ws + H_POW); const f32x2* BB = (const f32x2*)(p.ws + T_BBAR); float* KK = (float*)(p.ws + H_KK);
    for (int it = blockIdx.x * 2 + (tid512 >> 8); it < 32 * 2 * 32; it += gridDim.x * 2) {
        const int d = it & 31, dir = (it >> 5) & 1, g = it >> 6;
        const int e0 = (dir * 32 + g) * 64; const float* cre = p.in[18] + ((size_t)(dir * 32 + g) * 16 + s) * 64; const float* cim = p.in[19] + ((size_t)(dir * 32 + g) * 16 + s) * 64;
        float acc = 0.f;
#pragma unroll 8
        for (int pp = 0; pp < 64; ++pp) { const f32x2 pw = POW[(size_t)(e0 + pp) * 33 + d], bb = BB[(e0 + pp) * 16 + sp];
            const float zr = pw[0] * bb[0] - pw[1] * bb[1], zi = pw[0] * bb[1] + pw[1] * bb[0];
            acc += cre[pp] * zr - cim[pp] * zi; }
        KK[(size_t)((g * 2 + dir) * 32 + d) * 256 + tid] = acc;
    }
}
DI void s5_w1a_phase(const Params& p) {
    const int tid = get_tid();
    const f32x2* POW = (const f32x2*)(p.ws + H_POW); const f32x2* BB = (const f32x2*)(p.ws + T_BBAR); bf16_t* W = (bf16_t*)(p.ws + H_W1A);
    for (int idx = blockIdx.x * NTHREADS + tid; idx < 2048 * 256; idx += gridDim.x * NTHREADS) {
        const int kq = idx & 63, n = (idx >> 6) & 255, g = idx >> 14;
        const int dir = n >> 7, ri = (n >> 6) & 1, pp = n & 63; const int e = (dir * 32 + g) * 64 + pp; const int tl = kq >> 1, s0 = (kq & 1) * 8;
        const f32x2 pw = POW[(size_t)e * 33 + (dir ? tl : 31 - tl)];
        float v[8];
#pragma unroll
        for (int j = 0; j < 8; ++j) { const f32x2 bb = BB[e * 16 + s0 + j]; v[j] = ri ? pw[0] * bb[1] + pw[1] * bb[0] : pw[0] * bb[0] - pw[1] * bb[1]; }
        *(u32x4*)(W + ((size_t)g * 256 + n) * 512 + kq * 8) = (u32x4){pk2(v[0], v[1]), pk2(v[2], v[3]), pk2(v[4], v[5]), pk2(v[6], v[7])};
    }
}
DI void s5_w1b_phase(const Params& p) {
    const int tid = get_tid();
    const f32x2* POW = (const f32x2*)(p.ws + H_POW); const float* KK = (const float*)(p.ws + H_KK); bf16_t* W = (bf16_t*)(p.ws + A_W1B);
    for (int idx = blockIdx.x * NTHREADS + tid; idx < 6144 * 256; idx += gridDim.x * NTHREADS) {
        const int kq = idx % 96, n = (idx / 96) & 511, g = idx / (96 * 512);
        const int tl = n >> 4, s = n & 15;
        float v[8];
        if (kq < 64) { const int tl2 = kq >> 1, s0 = (kq & 1) * 8;
#pragma unroll
            for (int j = 0; j < 8; ++j) { float x = 0.f;
                if (tl2 <= tl) x += KK[(size_t)((g * 2 + 0) * 32 + (tl - tl2)) * 256 + s * 16 + s0 + j];
                if (tl2 >= tl) x += KK[(size_t)((g * 2 + 1) * 32 + (tl2 - tl)) * 256 + s * 16 + s0 + j];
                if (tl2 == tl && s0 + j == s) x += p.in[20][g * 16 + s];
                v[j] = x; }
        } else { const int k2 = (kq - 64) * 8; const int dir = k2 >> 7, ri = (k2 >> 6) & 1, p0 = k2 & 63;
            const float* cre = p.in[18] + ((size_t)(dir * 32 + g) * 16 + s) * 64; const float* cim = p.in[19] + ((size_t)(dir * 32 + g) * 16 + s) * 64;
#pragma unroll
            for (int j = 0; j < 8; ++j) { const int pp = p0 + j; const f32x2 pw = POW[(size_t)((dir * 32 + g) * 64 + pp) * 33 + (dir ? 32 - tl : tl + 1)];
                const float cr = cre[pp], ci = cim[pp];
                v[j] = ri ? -(cr * pw[1] + ci * pw[0]) : cr * pw[0] - ci * pw[1]; }
        }
        *(u32x4*)(W + ((size_t)g * 512 + n) * 768 + kq * 8) = (u32x4){pk2(v[0], v[1]), pk2(v[2], v[3]), pk2(v[4], v[5]), pk2(v[6], v[7])};
    }
}
DI void s5_carry_phase(const Params& p) {
    const int tid_ = get_tid(); const int lane = tid_ & 63, wid = tid_ >> 6;
    const f32x2* POW = (const f32x2*)(p.ws + H_POW); const float* E = (const float*)(p.ws + H_E); bf16_t* UA = (bf16_t*)(p.ws + H_UA);
    for (int it = blockIdx.x * NWV + wid; it < 2 * 2 * 32; it += gridDim.x * NWV) {
        const int g = it & 31, dir = (it >> 5) & 1, b = it >> 6;
        const f32x2 l32 = POW[(size_t)((dir * 32 + g) * 64 + lane) * 33 + 32];
        float hr = 0.f, hi = 0.f;
        for (int i0 = 0; i0 < NCK; i0 += 8) {
            float er[8], ei[8];
#pragma unroll
            for (int j = 0; j < 8; ++j) { const int i = i0 + j; const int c = dir ? (i < 8 ? 7 - i : NCK - 1 - (i - 8)) : i;
                const size_t m = (size_t)g * CHR + b * NCK + c;
                er[j] = E[m * 256 + dir * 128 + lane]; ei[j] = E[m * 256 + dir * 128 + 64 + lane]; }
#pragma unroll
            for (int j = 0; j < 8; ++j) { const int i = i0 + j; const int c = dir ? (i < 8 ? 7 - i : NCK - 1 - (i - 8)) : i;
                const size_t m = (size_t)g * CHR + b * NCK + c;
                bf16_t* u = UA + m * 768 + 512 + dir * 128 + lane;
                u[0] = (bf16_t)(pk2(hr, 0.f) & 0xffff); u[64] = (bf16_t)(pk2(hi, 0.f) & 0xffff);
                const float nr = l32[0] * hr - l32[1] * hi + er[j], ni = l32[0] * hi + l32[1] * hr + ei[j];
                hr = nr; hi = ni; }
        }
    }
}

DI void qkvnorm_phase(const Params& p) {
    const int tid_ = get_tid(); const int lane = tid_ & 63, wid = tid_ >> 6;
    const float* CQKV = (const float*)(p.ws + S_CQKV);
    bf16_t* CQN = (bf16_t*)(p.ws + S_CQN); bf16_t* CKVN = (bf16_t*)(p.ws + S_CKVN);
    for (int r = blockIdx.x * NWV + wid; r < NR; r += gridDim.x * NWV) {
        const float* src = CQKV + (size_t)r * 640;
        float a[6], k[4]; float sa = 0.f, sk = 0.f;
#pragma unroll
        for (int i = 0; i < 6; ++i) { a[i] = src[lane + 64 * i]; sa += a[i] * a[i]; }
#pragma unroll
        for (int i = 0; i < 4; ++i) { k[i] = src[384 + lane + 64 * i]; sk += k[i] * k[i]; }
        sa = wave_sum(sa); sk = wave_sum(sk);
        const float ra = rsqrtf(sa * (1.f / 384.f) + 1e-6f), rk = rsqrtf(sk * (1.f / 256.f) + 1e-6f);
#pragma unroll
        for (int i = 0; i < 6; ++i) CQN[(size_t)r * 384 + lane + 64 * i] = (bf16_t)(pk2(a[i] * ra * p.in[23][lane + 64 * i], 0.f) & 0xffff);
#pragma unroll
        for (int i = 0; i < 4; ++i) CKVN[(size_t)r * 256 + lane + 64 * i] = (bf16_t)(pk2(k[i] * rk * p.in[25][lane + 64 * i], 0.f) & 0xffff);
    }
}
DI float rope64(float x, int lane, const float* ROPE, int rpos, int cpos) {
    const float partner = __shfl_xor(x, 16);
    const int i = lane & 15; const int pos = lane < 32 ? rpos : cpos;
    const float c = ROPE[(pos * 16 + i) * 2], s = ROPE[(pos * 16 + i) * 2 + 1];
    return (lane & 16) ? x * c + partner * s : x * c - partner * s;
}
DI void mla_prep_phase(const Params& p) {
    const int tid_ = get_tid(); const int lane = tid_ & 63, wid = tid_ >> 6;
    bf16_t* QR = (bf16_t*)(p.ws + S_QRAW); const bf16_t* KN = (const bf16_t*)(p.ws + S_KNOPE); const float* KR = (const float*)(p.ws + H_KR);
    bf16_t* KA = (bf16_t*)(p.ws + S_KA); const float* ROPE = (const float*)(p.ws + T_ROPE);
    const float qsc = 0.07216878364870323f * LOG2E;
    const float qg0 = p.in[27][lane], qg1 = p.in[27][64 + lane], qg2 = p.in[27][128 + lane];
    const float kg0 = p.in[28][lane], kg1 = p.in[28][64 + lane], kg2 = p.in[28][128 + lane];
    for (int r = blockIdx.x * NWV + wid; r < NR; r += gridDim.x * NWV) {
        const bool lat = r >= NCTX; const int b = row_batch(r), tp = row_tpos(r); const int t = tp - CTX;
        const int rpos = lat ? (t >> 6) : 0, cpos = lat ? (t & 63) : 0;
        const float krv = KR[(size_t)r * 64 + lane];
#pragma unroll
        for (int h = 0; h < 4; ++h) {
            bf16_t* q = QR + (size_t)r * 768 + h * 192;
            float x0 = bf2f(q[lane]), x1 = bf2f(q[64 + lane]), x2 = bf2f(q[128 + lane]);
            float ss = wave_sum(x0 * x0 + x1 * x1 + x2 * x2);
            float rs = rsqrtf(ss * (1.f / 192.f) + 1e-6f);
            x0 *= rs * qg0; x1 *= rs * qg1; x2 *= rs * qg2;
            if (lat) x2 = rope64(x2, lane, ROPE, rpos, cpos);
            q[lane] = (bf16_t)(pk2(x0 * qsc, 0.f) & 0xffff); q[64 + lane] = (bf16_t)(pk2(x1 * qsc, 0.f) & 0xffff); q[128 + lane] = (bf16_t)(pk2(x2 * qsc, 0.f) & 0xffff);
            const bf16_t* kn = KN + (size_t)r * 512 + h * 128;
            float k0 = bf2f(kn[lane]), k1 = bf2f(kn[64 + lane]), k2 = krv;
            ss = wave_sum(k0 * k0 + k1 * k1 + k2 * k2);
            rs = rsqrtf(ss * (1.f / 192.f) + 1e-6f);
            k0 *= rs * kg0; k1 *= rs * kg1; k2 *= rs * kg2;
            if (lat) k2 = rope64(k2, lane, ROPE, rpos, cpos);
            bf16_t* kd = KA + ((size_t)(b * 4 + h) * TK + tp) * 192;
            kd[lane] = (bf16_t)(pk2(k0, 0.f) & 0xffff); kd[64 + lane] = (bf16_t)(pk2(k1, 0.f) & 0xffff); kd[128 + lane] = (bf16_t)(pk2(k2, 0.f) & 0xffff);
        }
    }
}
DI void win_prep_phase(const Params& p) {
    const int tid_ = get_tid(); const int lane = tid_ & 63, wid = tid_ >> 6;
    bf16_t* Q = (bf16_t*)(p.ws + S1_Q); const float* KRAW = (const float*)(p.ws + S1_KRAW); bf16_t* K1 = (bf16_t*)(p.ws + S1_K);
    const float* ROPE = (const float*)(p.ws + T_ROPE);
    const float qsc = 0.125f * LOG2E;
    const float qg = p.in[31][lane], kg = p.in[32][lane];
    for (int r = blockIdx.x * NWV + wid; r < NR; r += gridDim.x * NWV) {
        const bool lat = r >= NCTX; const int b = row_batch(r), tp = row_tpos(r); const int t = tp - CTX;
        const int rpos = lat ? (t >> 6) : 0, cpos = lat ? (t & 63) : 0;
        if (lat) {
#pragma unroll 4
            for (int h = 0; h < 16; ++h) { bf16_t* q = Q + (size_t)r * 1024 + h * 64;
                float x = bf2f(q[lane]); const float ss = wave_sum(x * x); x *= rsqrtf(ss * (1.f / 64.f) + 1e-6f) * qg;
                x = rope64(x, lane, ROPE, rpos, cpos);
                q[lane] = (bf16_t)(pk2(x * qsc, 0.f) & 0xffff); }
        }
#pragma unroll
        for (int h = 0; h < 4; ++h) { float x = KRAW[(size_t)r * 256 + h * 64 + lane]; const float ss = wave_sum(x * x); x *= rsqrtf(ss * (1.f / 64.f) + 1e-6f) * kg;
            if (lat) x = rope64(x, lane, ROPE, rpos, cpos);
            K1[((size_t)(b * 4 + h) * TK + tp) * 64 + lane] = (bf16_t)(pk2(x, 0.f) & 0xffff); }
    }
}

__global__ void __launch_bounds__(NTHREADS, 2) fwd_kernel(Params p) {
    extern __shared__ __attribute__((aligned(16))) char lds[];
    cg::grid_group grid = cg::this_grid();
    char* ws = p.ws;
    const bf16_t* WB = (const bf16_t*)ws;
    const float* MOD = (const float*)(ws + T_MOD);
    float* H = (float*)(ws + OFF_H);
    bf16_t* A0 = (bf16_t*)(ws + OFF_A0);
    const int bid = blockIdx.x, nb = gridDim.x;
    volatile LAS unsigned* xst = (volatile LAS unsigned*)(lds + (LDS_BYTES - 16));
    if (threadIdx.x == 0) { xst[0] = 0u; xst[1] = 0u; }
    __syncthreads();
    const XcdBarrier xb = xcd_barrier_post((unsigned*)(ws + T_BAR), xst);
    if (p.pad == 0x7fffffff) grid.sync();
#define GRID_SYNC() xcd_barrier(xb)

    { const int npair = (p.njobtiles + 1) >> 1, nit = 192 + 12 + npair;
      for (int it = bid; it < nit; it += nb) {
          if (it < 192) ada_item(lds, p, it);
          else if (it < 204) tables_item(p, it - 192);
          else { const int lt0 = (it - 204) * 2 + (int)(threadIdx.x >> 8); const bool live = lt0 < p.njobtiles; const int lt = live ? lt0 : 0; int j = 0;
#pragma unroll
              for (int q = 1; q < 11; ++q) if (lt >= p.jobs[q].tile0) j = q;
              transpose_tile(lds, ws, p.jobs[j], lt - p.jobs[j].tile0, live); } } }
    GRID_SYNC();
    modulate_rows(p, 0, 0, true, 0);
    s5_kk_phase(p);
    GRID_SYNC();
    { EpiWin0 e{(bf16_t*)(ws + H_UA), (float*)(ws + S_CQKV), (float*)(ws + H_KR)};
      gemm_phase(lds, A0, 1024, WB + W_IN0, 1024, 0, NR / 256, 5, e); }
    s5_w1a_phase(p);
    GRID_SYNC();
    qkvnorm_phase(p);
    s5_w1b_phase(p);
    { EpiS1a e{(float*)(ws + H_E)};
      gemm_phase(lds, (const bf16_t*)(ws + H_UA), 768, (const bf16_t*)(ws + H_W1A), 512, 0, 3, 1, e, 32, (size_t)CHR * 768, (size_t)256 * 512); }
    GRID_SYNC();
    s5_carry_phase(p);
    { EpiBf16 e{(bf16_t*)(ws + S_QRAW), 768};
      gemm_phase(lds, (const bf16_t*)(ws + S_CQN), 384, WB + W_QB, 384, 0, NR / 256, 3, e); }
    { EpiKV e{(bf16_t*)(ws + S_KNOPE), (bf16_t*)(ws + S_VT)};
      gemm_phase(lds, (const bf16_t*)(ws + S_CKVN), 256, WB + W_KVB, 256, 0, NR / 256, 4, e); }
    GRID_SYNC();
    { EpiS1b e{(bf16_t*)(ws + S_YG)};
      gemm_phase(lds, (const bf16_t*)(ws + H_UA), 768, (const bf16_t*)(ws + A_W1B), 768, 0, 3, 2, e, 32, (size_t)CHR * 768, (size_t)512 * 768); }
    mla_prep_phase(p);
    GRID_SYNC();
    { const bf16_t* QR = (const bf16_t*)(ws + S_QRAW); const bf16_t* KA = (const bf16_t*)(ws + S_KA); const bf16_t* VT = (const bf16_t*)(ws + S_VT);
      const int nlat = 2 * 4 * 32, nall = nlat + 2 * 4;
      for (int it = bid; it < nall; it += nb) {
          if (it < nlat) { const int qb = it & 31, h = (it >> 5) & 3, b = it >> 7; const size_t row = NCTX + (size_t)b * SEQ + qb * 256;
              attn_item<192, 128, false>(lds, QR + row * 768 + h * 192, 768, KA + (size_t)(b * 4 + h) * TK * 192, VT + (size_t)(b * 4 + h) * 128 * TK, 0, TK / 64, 0, 0, -1e30f, 0.f,
                                         A0 + row * 1024 + 512 + h * 128, 1024, 0); }
          else { const int j = it - nlat; const int h = j & 3, b = j >> 2; const size_t row = (size_t)b * CTX;
              attn_item<192, 128, false>(lds, QR + row * 768 + h * 192, 768, KA + (size_t)(b * 4 + h) * TK * 192, VT + (size_t)(b * 4 + h) * 128 * TK, 0, 4, 0, 0, -1e30f, 0.f,
                                         A0 + row * 1024 + 512 + h * 128, 1024, 0); } }
      for (int i = bid * NTHREADS + (int)threadIdx.x; i < NCTX * 1024 / 4; i += nb * NTHREADS) ((f32x4*)H)[i] = ((const f32x4*)p.in[2])[i];
      EpiGLU e{(const bf16_t*)(ws + S_YG), p.in[22], A0};
      gemm_phase(lds, (const bf16_t*)(ws + S_YG), 512, WB + W_GLU, 512, 0, NR / 256, 2, e); }
    GRID_SYNC();
    { EpiRes e{p.in[2], p.in[0], H, H + (size_t)NCTX * 1024, MOD + 0 * 3 * 6144 + 2048, 0};
      gemm_phase(lds, A0, 1024, WB + W_OUT0, 1024, 2, NLAT / 256, 4, e);
      EpiRes ea{H, H, H, H, MOD + 0 * 3 * 6144 + 2048, 1};
      gemm_phase(lds, A0, 1024, WB + W_OUT0, 1024, 0, 2, 4, ea, 1, 0, 0, 16); }
    GRID_SYNC();
    modulate_rows(p, 0, 1, false, 0);
    GRID_SYNC();
    { EpiSwiGLU e{(bf16_t*)(ws + S_HID)};
      gemm_phase(lds, A0, 1024, WB + W_GU0, 1024, 0, NR / 256, 22, e); }
    GRID_SYNC();
    { EpiRes e{H, H + (size_t)NCTX * 1024, H, H + (size_t)NCTX * 1024, MOD + 0 * 3 * 6144 + 5120, 0};
      gemm_phase(lds, (const bf16_t*)(ws + S_HID), FH, WB + W_D0, FH, 2, NLAT / 256, 4, e);
      EpiRes ea{H, H, H, H, MOD + 0 * 3 * 6144 + 5120, 1};
      gemm_phase(lds, (const bf16_t*)(ws + S_HID), FH, WB + W_D0, FH, 0, 2, 4, ea, 1, 0, 0, 22); }
    GRID_SYNC();
    modulate_rows(p, 1, 0, false, 0);
    GRID_SYNC();
    { EpiWin1 e{(bf16_t*)(ws + S1_Q), (bf16_t*)(ws + S1_K), (bf16_t*)(ws + S1_VT), p.in[31], p.in[32], (const float*)(ws + T_ROPE)};
      gemm_phase(lds, A0, 1024, WB + W_IN1, 1024, 0, NR / 256, 6, e); }
    GRID_SYNC();
    { const bf16_t* Q = (const bf16_t*)(ws + S1_Q); const bf16_t* K1 = (const bf16_t*)(ws + S1_K); const bf16_t* VT = (const bf16_t*)(ws + S1_VT);
      const int nit = 2 * 16 * 32;
      for (int it = bid; it < nit; it += nb) { const int g = it & 3, i = (it >> 2) & 31, kvh = (it >> 7) & 3, b = it >> 9; const int hq = kvh * 4 + g;
          const size_t row = NCTX + (size_t)b * SEQ + i * 256;
          const int l0 = (4 * i - 2) < 0 ? 0 : (4 * i - 2), l1 = (4 * i + 6) > 128 ? 128 : (4 * i + 6);
          attn_item<64, 64, true>(lds, Q + row * 1024 + hq * 64, 1024, K1 + (size_t)(b * 4 + kvh) * TK * 64, VT + (size_t)(b * 4 + kvh) * 64 * TK, 0, 4, 4 + l0, 4 + l1,
                                  p.in[33][hq] * LOG2E, 1.f, A0 + row * 1024 + hq * 64, 1024, i * 256); } }
    GRID_SYNC();
    { EpiRes e{H, H + (size_t)NCTX * 1024, nullptr, H + (size_t)NCTX * 1024, MOD + 1 * 3 * 6144 + 2048, 0};
      gemm_phase(lds, A0, 1024, WB + W_OUT1, 1024, 2, NLAT / 256, 4, e); }
    GRID_SYNC();
    modulate_rows(p, 1, 1, false, NCTX);
    GRID_SYNC();
    { EpiSwiGLU e{(bf16_t*)(ws + S_HID)};
      gemm_phase(lds, A0, 1024, WB + W_GU1, 1024, 2, NLAT / 256, 22, e); }
    GRID_SYNC();
    { EpiRes e{H, H + (size_t)NCTX * 1024, nullptr, p.out, MOD + 1 * 3 * 6144 + 5120, 0};
      gemm_phase(lds, (const bf16_t*)(ws + S_HID), FH, WB + W_D1, FH, 2, NLAT / 256, 4, e); }
}

extern "C" void kernel_launch(void* const* d_in, const int* in_sizes, int n_in, void* d_out, int out_size, void* d_ws, size_t ws_size, hipStream_t stream) {
    static int grid_blocks = 0;
    if (grid_blocks == 0) {
        if (n_in != 34 || ws_size < WS_NEED) { fprintf(stderr, "kernel_launch: unexpected n_in %d / ws %zu (need %zu)\n", n_in, ws_size, (size_t)WS_NEED); grid_blocks = -1; return; }
        int dev = 0, cus = 0, per_cu = 0;
        (void)hipGetDevice(&dev);
        (void)hipDeviceGetAttribute(&cus, hipDeviceAttributeMultiprocessorCount, dev);
        (void)hipFuncSetAttribute((const void*)fwd_kernel, hipFuncAttributeMaxDynamicSharedMemorySize, LDS_BYTES);
        (void)hipOccupancyMaxActiveBlocksPerMultiprocessor(&per_cu, (const void*)fwd_kernel, NTHREADS, LDS_BYTES);
        if (per_cu < 1) { fprintf(stderr, "kernel_launch: occupancy query returned %d\n", per_cu); grid_blocks = -1; return; }
        if (per_cu > 1) per_cu = 1;
        grid_blocks = cus * per_cu;
        fprintf(stderr, "kernel_launch: grid %d (%d CUs x %d)\n", grid_blocks, cus, per_cu);
    }
    if (grid_blocks < 0) return;
    Params p{};
    for (int i = 0; i < 34; ++i) p.in[i] = (const float*)d_in[i];
    p.out = (float*)d_out; p.ws = (char*)d_ws;
    const float* fg = p.in[8]; const float* fu = p.in[9]; const float* fd = p.in[10];
    const size_t FW = (size_t)1024 * FH;
    int t0 = 0;
    auto mk = [&](int idx, const float* a, const float* b, size_t dst, int K, int ld, int npad, int mode) {
        Job& j = p.jobs[idx]; j.a = a; j.b = b; j.dst = dst; j.K = K; j.ld = ld; j.ntk = K / 64; j.ntn = npad / 64; j.tile0 = t0; j.mode = mode; t0 += j.ntk * j.ntn; };
    mk(0, p.in[11], nullptr, W_IN0, 1024, 1216, 1280, 0);
    mk(1, p.in[24], nullptr, W_QB, 384, 768, 768, 0);
    mk(2, p.in[26], nullptr, W_KVB, 256, 1024, 1024, 0);
    mk(3, p.in[21], nullptr, W_GLU, 512, 512, 512, 0);
    mk(4, p.in[12], nullptr, W_OUT0, 1024, 1024, 1024, 0);
    mk(5, fg, fu, W_GU0, 1024, FH, 5632, 1);
    mk(6, fd, nullptr, W_D0, FH, 1024, 1024, 0);
    mk(7, p.in[29], nullptr, W_IN1, 1024, 1536, 1536, 0);
    mk(8, p.in[30], nullptr, W_OUT1, 1024, 1024, 1024, 0);
    mk(9, fg + FW, fu + FW, W_GU1, 1024, FH, 5632, 1);
    mk(10, fd + FW, nullptr, W_D1, FH, 1024, 1024, 0);
    p.njobtiles = t0;
    if (hipMemsetAsync((char*)d_ws + T_BAR, 0, XCD_BAR_WORDS * 4, stream) != hipSuccess) { fprintf(stderr, "kernel_launch: memset failed\n"); return; }
    void* args[] = {&p};
    hipError_t e = hipLaunchCooperativeKernel((const void*)fwd_kernel, dim3(grid_blocks), dim3(NTHREADS), args, LDS_BYTES, stream);
    if (e != hipSuccess) fprintf(stderr, "cooperative launch failed: %s (grid %d)\n", hipGetErrorString(e), grid_blocks);
}
```

```cpp
#include <hip/hip_runtime.h>
#include <hip/hip_cooperative_groups.h>
#include <cstdio>
#include <cstdint>
namespace cg = cooperative_groups;

#define DI __device__ __forceinline__
typedef unsigned short bf16_t;
typedef short bf16x8 __attribute__((ext_vector_type(8)));
typedef short s16x4 __attribute__((ext_vector_type(4)));
typedef float f32x4 __attribute__((ext_vector_type(4)));
typedef float f32x2 __attribute__((ext_vector_type(2)));
typedef float f32x16 __attribute__((ext_vector_type(16)));
typedef unsigned u32x4 __attribute__((ext_vector_type(4)));
typedef unsigned u32x2 __attribute__((ext_vector_type(2)));
typedef __bf16 bf16v2 __attribute__((ext_vector_type(2)));

constexpr int DM = 1024, NBATCH = 2, SEQ = 8192, CTX = 256;
constexpr int NCTX = NBATCH * CTX;
constexpr int NLAT = NBATCH * SEQ;
constexpr int NR = NCTX + NLAT;
constexpr int TK = CTX + SEQ;
constexpr int FH = 2816;
constexpr int NCH = TK / 64;
constexpr float LOG2E = 1.4426950408889634f;
constexpr int LDS_BYTES = 131072 + 64;
constexpr int NTHREADS = 512, NWV = 8;

constexpr size_t W_IN0 = 0;
constexpr size_t W_QB = W_IN0 + (size_t)1280 * 1024;
constexpr size_t W_KVB = W_QB + (size_t)768 * 384;
constexpr size_t W_GLU = W_KVB + (size_t)1024 * 256;
constexpr size_t W_OUT0 = W_GLU + (size_t)512 * 512;
constexpr size_t W_GU0 = W_OUT0 + (size_t)1024 * 1024;
constexpr size_t W_D0 = W_GU0 + (size_t)5632 * 1024;
constexpr size_t W_IN1 = W_D0 + (size_t)1024 * 2816;
constexpr size_t W_OUT1 = W_IN1 + (size_t)1536 * 1024;
constexpr size_t W_GU1 = W_OUT1 + (size_t)1024 * 1024;
constexpr size_t W_D1 = W_GU1 + (size_t)5632 * 1024;
constexpr size_t W_END = W_D1 + (size_t)1024 * 2816;
constexpr size_t OFF_TAB = W_END * 2;
constexpr size_t T_MOD = OFF_TAB;
constexpr size_t T_ROPE = T_MOD + 2 * 3 * 6144 * 4;
constexpr size_t T_LAMB = T_ROPE + 128 * 16 * 2 * 4;
constexpr size_t T_LAM64 = T_LAMB + 2 * 32 * 64 * 8;
constexpr size_t T_BBAR = T_LAM64 + 2 * 32 * 64 * 8;
constexpr size_t T_BAR = T_BBAR + (size_t)2 * 32 * 64 * 16 * 8;
constexpr size_t OFF_H = OFF_TAB + (1u << 20);
constexpr size_t OFF_A0 = OFF_H + (size_t)NR * 1024 * 4;
constexpr size_t OFF_S = OFF_A0 + (size_t)NR * 1024 * 2;
constexpr size_t WS_NEED = OFF_S + (size_t)108134400;
static_assert(WS_NEED <= ((size_t)256 << 20) && OFF_S + (size_t)NR * FH * 2 <= WS_NEED, "workspace");
constexpr int SL = 32;
constexpr int NCK = TK / SL;
constexpr int CHR = NBATCH * NCK;
constexpr size_t H_UA = OFF_H;
constexpr size_t H_KR = H_UA + (size_t)(32 * CHR + 256) * 768 * 2;
constexpr size_t H_E = H_KR + (size_t)NR * 64 * 4;
constexpr size_t H_KK = H_E + (size_t)32 * CHR * 256 * 4;
constexpr size_t H_POW = H_KK + (size_t)32 * 2 * 32 * 256 * 4;
constexpr size_t H_W1A = H_POW + (size_t)4096 * 33 * 8;
static_assert(H_W1A + (size_t)32 * 256 * 512 * 2 <= OFF_A0, "H region overflow");
constexpr size_t A_W1B = OFF_A0;
constexpr size_t S_CQN = OFF_S;
constexpr size_t S_CKVN = S_CQN + (size_t)NR * 384 * 2;
constexpr size_t S_YG = OFF_S;
constexpr size_t S_X = S_CKVN + (size_t)NR * 256 * 2;
constexpr size_t S_CQKV = S_X;
constexpr size_t S_QRAW = S_X;
constexpr size_t S_KNOPE = S_QRAW + (size_t)NR * 768 * 2;
constexpr size_t S_VT = S_KNOPE + (size_t)NR * 512 * 2;
constexpr size_t S_KA = S_VT + (size_t)2 * 4 * 128 * TK * 2;
static_assert(S_CQKV + (size_t)NR * 640 * 4 <= S_VT, "CQKV overlaps VT");
static_assert(S_KA + (size_t)2 * 4 * TK * 192 * 2 <= WS_NEED, "scratch overflow");
constexpr size_t S_HID = OFF_S;
constexpr size_t S1_Q = OFF_S;
constexpr size_t S1_KRAW = S1_Q + (size_t)NR * 1024 * 2;
constexpr size_t S1_K = S1_KRAW + (size_t)NR * 256 * 4;
constexpr size_t S1_VT = S1_K + (size_t)2 * 4 * TK * 64 * 2;

struct Job { const float* a; const float* b; unsigned long long dst; int K, ld, ntk, ntn, tile0, mode; };
struct Params {
    const float* in[34];
    float* out;
    char* ws;
    Job jobs[11];
    int njobtiles;
    int pad;
};

DI int get_tid() { int t = threadIdx.x; asm volatile("" : "+v"(t)); return t; }
DI unsigned pk2(float lo, float hi) { f32x2 v = {lo, hi}; return __builtin_bit_cast(unsigned, __builtin_convertvector(v, bf16v2)); }
DI float bf2f(unsigned short b) { return __uint_as_float(((unsigned)b) << 16); }
DI float wave_sum(float v) {
#pragma unroll
    for (int o = 32; o > 0; o >>= 1) v += __shfl_xor(v, o);
    return v;
}
DI int row_vec(int r) { return r < NCTX ? 2 : (r - NCTX) / SEQ; }
DI int row_batch(int r) { return r < NCTX ? r / CTX : (r - NCTX) / SEQ; }
DI int row_tpos(int r) { return r < NCTX ? r % CTX : CTX + (r - NCTX) % SEQ; }
DI float sigmoidf_(float x) { return 1.f / (1.f + __expf(-x)); }
DI float siluf_(float x) { return x / (1.f + __expf(-x)); }
DI float gelu_tanh(float y) { const float z = 0.7978845608028654f * (y + 0.044715f * y * y * y); const float t = 1.f - 2.f / (1.f + __expf(2.f * z)); return 0.5f * y * (1.f + t); }
DI void my_sincos(float x, float& s, float& c) {
    const float q = rintf(x * 0.636619772367581f);
    float r = fmaf(-q, 1.5703125f, x);
    r = fmaf(-q, 4.837512969970703125e-4f, r);
    r = fmaf(-q, 7.54978995489188216e-8f, r);
    const int qi = (int)q;
    const float r2 = r * r;
    const float sp = r + r * r2 * (-1.6666654611e-1f + r2 * (8.3321608736e-3f + r2 * (-1.9515295891e-4f)));
    const float cp = 1.0f - 0.5f * r2 + r2 * r2 * (4.166664568298827e-2f + r2 * (-1.388731625493765e-3f + r2 * 2.443315711809948e-5f));
    const int k = qi & 3;
    s = (k == 0) ? sp : (k == 1) ? cp : (k == 2) ? -sp : -cp;
    c = (k == 0) ? cp : (k == 1) ? -sp : (k == 2) ? -cp : sp;
}


#define XB_TMO      128
#define XB_XCNT(j)  (256  + 64 * (j))
#define XB_XSUB(j)  (1280 + 64 * (j))
#define XB_XGEN(j)  (2304 + 64 * (j))
#define XB_TOP      3328
#define XB_TOPGEN   3392
#define XCD_BAR_WORDS 3456
#define XB_SPIN_CAP (1u << 22)
#define LAS __attribute__((address_space(3)))
DI unsigned xb_ld(unsigned* p) { return __hip_atomic_load(p, __ATOMIC_RELAXED, __HIP_MEMORY_SCOPE_AGENT); }
DI unsigned xb_add(unsigned* p, unsigned v) { return __hip_atomic_fetch_add(p, v, __ATOMIC_RELAXED, __HIP_MEMORY_SCOPE_AGENT); }
DI unsigned xb_xcc_id() { return (unsigned)__builtin_amdgcn_s_getreg((3 << 11) | 20) & 0xFu; }
#define XB_SPIN(cond, bar) do { unsigned _sp = 0; while (cond) { __builtin_amdgcn_s_sleep(1); \
    if ((++_sp & 255u) == 0u) { if (xb_ld(&(bar)[XB_TMO])) break; if (_sp > XB_SPIN_CAP) { atomicAdd(&(bar)[XB_TMO], 1u); break; } } } } while (0)
struct XcdBarrier { unsigned* bar; unsigned x; volatile LAS unsigned* st; };
DI XcdBarrier xcd_barrier_post(unsigned* bar, volatile LAS unsigned* st) {
    XcdBarrier b; b.bar = bar; b.x = xb_xcc_id(); b.st = st;
    if (threadIdx.x == 0) (void)xb_add(&bar[XB_XCNT(b.x)], 1u);
    return b;
}
DI void xcd_barrier_complete(unsigned* bar, unsigned x, unsigned& nloc, unsigned& nx) {
    const unsigned G = gridDim.x * gridDim.y * gridDim.z;
    unsigned sum, cnt, mine, sp = 0u;
    for (;;) {
        sum = 0u; cnt = 0u; mine = 0u;
#pragma unroll
        for (unsigned j = 0; j < 16; ++j) { const unsigned c = xb_ld(&bar[XB_XCNT(j)]); sum += c; cnt += (c > 0u) ? 1u : 0u; mine = (j == x) ? c : mine; }
        if (sum == G) break;
        __builtin_amdgcn_s_sleep(1);
        if ((++sp & 255u) == 0u) { if (xb_ld(&bar[XB_TMO])) break; if (sp > XB_SPIN_CAP) { atomicAdd(&bar[XB_TMO], 1u); break; } }
    }
    nloc = mine > 0u ? mine : 1u; nx = cnt > 0u ? cnt : 1u;
}
DI void xcd_barrier(const XcdBarrier& b) {
    asm volatile("s_waitcnt vmcnt(0)" ::: "memory");
    __syncthreads();
    if (threadIdx.x == 0) {
        unsigned* bar = b.bar;
        __builtin_amdgcn_s_waitcnt(0);
        unsigned nloc = b.st[0], nx = b.st[1];
        if (nloc == 0u) { xcd_barrier_complete(bar, b.x, nloc, nx); b.st[0] = nloc; b.st[1] = nx; }
        const unsigned old = xb_add(&bar[XB_XSUB(b.x)], 1u);
        const unsigned gen = old / nloc;
        if (old + 1u == (gen + 1u) * nloc) {
            __builtin_amdgcn_fence(__ATOMIC_RELEASE, "agent");
            asm volatile("s_waitcnt vmcnt(0)" ::: "memory");
            const unsigned og = xb_add(&bar[XB_TOP], 1u);
            const unsigned tg = og / nx;
            if (og + 1u == (tg + 1u) * nx) xb_add(&bar[XB_TOPGEN], 1u);
            else XB_SPIN(xb_ld(&bar[XB_TOPGEN]) == tg, bar);
            __builtin_amdgcn_fence(__ATOMIC_ACQUIRE, "agent");
            xb_add(&bar[XB_XGEN(b.x)], 1u);
            asm volatile("s_waitcnt vmcnt(0)" ::: "memory");
        } else {
            XB_SPIN(xb_ld(&bar[XB_XGEN(b.x)]) == gen, bar);
            __builtin_amdgcn_fence(__ATOMIC_ACQUIRE, "agent");
            asm volatile("s_waitcnt vmcnt(0)" ::: "memory");
        }
    }
    __syncthreads();
}

DI void transpose_tile(char* lds, char* ws, const Job& jb, int lt, bool live) {
    const int tid512 = get_tid(); const int tid = tid512 & 255;
    float (*tile)[65] = (float (*)[65])(lds + (tid512 >> 8) * 17408);
    const int tk = lt % jb.ntk, tn = lt / jb.ntk;
    const int k0 = tk * 64, n0 = tn * 64;
    const int j = tid & 63, kq = tid >> 6;
    const float* src; int col; bool valid = true;
    if (jb.mode == 0) { src = jb.a; col = n0 + j; valid = live && col < jb.ld; }
    else { const int nsub = j >> 4, i = j & 15; src = (nsub & 1) ? jb.b : jb.a; col = tn * 32 + (nsub >> 1) * 16 + i; valid = live; }
#pragma unroll
    for (int kk = 0; kk < 16; ++kk) { const int k = kk * 4 + kq; tile[k][j] = valid ? src[(size_t)(k0 + k) * jb.ld + col] : 0.f; }
    __syncthreads();
    const int r = tid >> 2, ks = (tid & 3) * 16;
    unsigned w[8];
#pragma unroll
    for (int q = 0; q < 8; ++q) w[q] = pk2(tile[ks + 2 * q][r], tile[ks + 2 * q + 1][r]);
    bf16_t* d = (bf16_t*)(ws) + jb.dst + (size_t)(n0 + r) * jb.K + k0 + ks;
    if (live) { *(u32x4*)d = (u32x4){w[0], w[1], w[2], w[3]};
    *(u32x4*)(d + 8) = (u32x4){w[4], w[5], w[6], w[7]}; }
    __syncthreads();
}

DI void ada_item(char* lds, const Params& p, int it) {
    float* sil = (float*)lds;
    float* red = sil + 3072;
    float* MOD = (float*)(p.ws + T_MOD);
    const int tid = get_tid(), layer = it / 96, n0 = (it % 96) * 64;
    for (int i = tid; i < 3072; i += NTHREADS) { const int v = i >> 10, k = i & 1023; const float x = v < 2 ? p.in[1][v * 1024 + k] : p.in[3][k]; sil[i] = siluf_(x); }
    __syncthreads();
    const int j = tid & 63, kq = tid >> 6;
    const float* W = p.in[4] + (size_t)layer * 1024 * 6144 + n0 + j;
    float a0 = 0.f, a1 = 0.f, a2 = 0.f;
#pragma unroll 8
    for (int k = kq * 128; k < kq * 128 + 128; ++k) { const float w = W[(size_t)k * 6144]; a0 += sil[k] * w; a1 += sil[1024 + k] * w; a2 += sil[2048 + k] * w; }
    red[(kq * 3 + 0) * 64 + j] = a0; red[(kq * 3 + 1) * 64 + j] = a1; red[(kq * 3 + 2) * 64 + j] = a2;
    __syncthreads();
    if (tid < 192) { const int v = tid >> 6, jj = tid & 63;
        float s = p.in[5][layer * 6144 + n0 + jj];
#pragma unroll
        for (int q = 0; q < 8; ++q) s += red[(q * 3 + v) * 64 + jj];
        MOD[(layer * 3 + v) * 6144 + n0 + jj] = s; }
    __syncthreads();
}

DI void tables_item(const Params& p, int it) {
    const int tid = get_tid();
    if (it < 4) {
        const int e = it * 512 + tid, pos = e >> 4, i = e & 15;
        const float inv = exp2f(-(float)i * (13.287712379549449f / 16.f));
        float s, c; my_sincos((float)pos * inv, s, c);
        float* ROPE = (float*)(p.ws + T_ROPE); ROPE[e * 2] = c; ROPE[e * 2 + 1] = s;
    } else {
        const int e = (it - 4) * 512 + tid;
        const int dg = e >> 6;
        const float lr = p.in[13][e], li = p.in[14][e], step = expf(p.in[15][dg]);
        const float a = lr * step, b = li * step;
        const float ea = expf(a);
        float sb, cb; my_sincos(b, sb, cb);
        float sh, ch; my_sincos(0.5f * b, sh, ch);
        const float em1 = a * (1.f + a * 0.5f * (1.f + a * (1.f / 3.f) * (1.f + a * 0.25f * (1.f + a * 0.2f * (1.f + a * (1.f / 6.f))))));
        const float lbr = ea * cb, lbi = ea * sb;
        const float nr = em1 * cb - 2.f * sh * sh, ni = ea * sb;
        const float den = lr * lr + li * li;
        const float qr = (nr * lr + ni * li) / den, qi = (ni * lr - nr * li) / den;
        f32x2* BB = (f32x2*)(p.ws + T_BBAR);
#pragma unroll
        for (int s = 0; s < 16; ++s) { const float br = p.in[16][e * 16 + s], bi = p.in[17][e * 16 + s]; BB[e * 16 + s] = (f32x2){qr * br - qi * bi, qr * bi + qi * br}; }
        f32x2* POW = (f32x2*)(p.ws + H_POW) + (size_t)e * 33;
        float pr = 1.f, pi = 0.f;
        for (int q = 0; q <= 32; ++q) { POW[q] = (f32x2){pr, pi}; const float nr2 = pr * lbr - pi * lbi, ni2 = pr * lbi + pi * lbr; pr = nr2; pi = ni2; }
    }
}

DI void modulate_rows(const Params& p, int layer, int which, bool from_inputs, int r0) {
    const int tid_ = get_tid(); const int lane = tid_ & 63, wid = tid_ >> 6;
    const float* gain = p.in[which ? 7 : 6] + layer * 1024;
    const float* modl = (const float*)(p.ws + T_MOD) + layer * 3 * 6144 + (which ? 3072 : 0);
    const float* H = (const float*)(p.ws + OFF_H);
    bf16_t* dst = (bf16_t*)(p.ws + OFF_A0);
    for (int r = r0 + blockIdx.x * NWV + wid; r < NR; r += gridDim.x * NWV) {
        const float* src = from_inputs ? (r < NCTX ? p.in[2] + (size_t)r * 1024 : p.in[0] + (size_t)(r - NCTX) * 1024) : H + (size_t)r * 1024;
        const float* mv = modl + row_vec(r) * 6144;
        f32x4 x[4]; float ss = 0.f;
#pragma unroll
        for (int i = 0; i < 4; ++i) { x[i] = *(const f32x4*)(src + i * 256 + lane * 4); ss += x[i][0] * x[i][0] + x[i][1] * x[i][1] + x[i][2] * x[i][2] + x[i][3] * x[i][3]; }
        ss = wave_sum(ss);
        const float rstd = rsqrtf(ss * (1.f / 1024.f) + 1e-6f);
#pragma unroll
        for (int i = 0; i < 4; ++i) { const int c = i * 256 + lane * 4;
            const f32x4 g = *(const f32x4*)(gain + c), sh = *(const f32x4*)(mv + c), sc = *(const f32x4*)(mv + 1024 + c);
            const f32x4 y = x[i] * rstd * g * (1.f + sc) + sh;
            *(u32x2*)(dst + (size_t)r * 1024 + c) = (u32x2){pk2(y[0], y[1]), pk2(y[2], y[3])}; }
    }
}

template <class Epi>
DI void gemm_phase(char* lds, const bf16_t* A0_, int lda, const bf16_t* Bt0_, int K, int mt0, int nmt, int nnt, const Epi& epi, int nbatch = 1, size_t sA = 0, size_t sB = 0, int ksplit = 1) {
    const int tid = get_tid(), lane = tid & 63, wid = tid >> 6, wr = wid >> 2, wc = wid & 3, fr = lane & 15, fq = lane >> 4;
    const int nk = (K >> 6) / ksplit;
    const int lrow = tid >> 3, lc = tid & 7, lkc = lc * 8;
    const int woff = lrow * 128 + ((lc ^ ((lrow >> 1) & 7)) << 4);
    const int ra0 = (wr * 128 + fr) * 128 + ((fq ^ (fr >> 1)) << 4);
    const int ra1 = (wr * 128 + fr) * 128 + (((4 + fq) ^ (fr >> 1)) << 4);
    const int rb0 = 32768 + (wc * 64 + fr) * 128 + ((fq ^ (fr >> 1)) << 4);
    const int rb1 = 32768 + (wc * 64 + fr) * 128 + (((4 + fq) ^ (fr >> 1)) << 4);
    const int per = nmt * nnt, ntile = nbatch * per * ksplit;
    const int myn = ((int)blockIdx.x < ntile) ? (ntile - (int)blockIdx.x + (int)gridDim.x - 1) / (int)gridDim.x : 0;
    const int total = myn * nk;
    f32x4 acc[8][4];
#pragma unroll
    for (int m = 0; m < 8; ++m)
#pragma unroll
        for (int n = 0; n < 4; ++n) acc[m][n] = (f32x4){0.f, 0.f, 0.f, 0.f};
    u32x4 sa[4], sb[4];
    int iti = 0, ikt = 0;
    const bf16_t* Ag = A0_; const bf16_t* Bg = Bt0_;
#define G_ISSUE() do { if (ikt == 0) { const int u_ = blockIdx.x + iti * gridDim.x; const int t_ = u_ / ksplit, sl_ = u_ - t_ * ksplit; const int gb_ = t_ / per, tr_ = t_ - gb_ * per; const int tm_ = tr_ / nnt, tn_ = tr_ - tm_ * nnt; \
            Ag = A0_ + (size_t)gb_ * sA + (size_t)((mt0 + tm_) * 256 + lrow) * lda + lkc + sl_ * nk * 64; Bg = Bt0_ + (size_t)gb_ * sB + (size_t)(tn_ * 256 + lrow) * K + lkc + sl_ * nk * 64; } \
        _Pragma("unroll") for (int i = 0; i < 4; ++i) { sa[i] = *(const u32x4*)(Ag + (size_t)i * 64 * lda + ikt * 64); sb[i] = *(const u32x4*)(Bg + (size_t)i * 64 * K + ikt * 64); } \
        if (++ikt == nk) { ikt = 0; ++iti; } } while (0)
#define G_WRITE(bufoff) do { _Pragma("unroll") for (int i = 0; i < 4; ++i) { *(u32x4*)(lds + (bufoff) + woff + i * 8192) = sa[i]; *(u32x4*)(lds + (bufoff) + 32768 + woff + i * 8192) = sb[i]; } } while (0)
#define G_COMPUTE(bufoff) do { _Pragma("unroll") for (int ks = 0; ks < 2; ++ks) { bf16x8 a[8], b[4]; \
        _Pragma("unroll") for (int m = 0; m < 8; ++m) a[m] = *(const bf16x8*)(lds + (bufoff) + (ks ? ra1 : ra0) + m * 2048); \
        _Pragma("unroll") for (int n = 0; n < 4; ++n) b[n] = *(const bf16x8*)(lds + (bufoff) + (ks ? rb1 : rb0) + n * 2048); \
        _Pragma("unroll") for (int m = 0; m < 8; ++m) _Pragma("unroll") for (int n = 0; n < 4; ++n) acc[m][n] = __builtin_amdgcn_mfma_f32_16x16x32_bf16(b[n], a[m], acc[m][n], 0, 0, 0); } } while (0)
    __syncthreads();
    if (total > 0) {
        G_ISSUE(); G_WRITE(0);
        if (total > 1) G_ISSUE();
    }
    __syncthreads();
    int cti = 0, ckt = 0;
    for (int q = 0; q < total; ++q) {
        const int cur = (q & 1) * 65536;
        if (q + 1 < total) G_WRITE(cur ^ 65536);
        if (q + 2 < total) G_ISSUE();
        G_COMPUTE(cur);
        __syncthreads();
        if (++ckt == nk) {
            const int u_ = blockIdx.x + cti * gridDim.x; const int t_ = u_ / ksplit; const int gb_ = t_ / per, tr_ = t_ - gb_ * per; const int tm_ = tr_ / nnt, tn_ = tr_ - tm_ * nnt;
            epi(acc, (mt0 + tm_) * 256 + wr * 128 + fr, tn_ * 256 + wc * 64 + fq * 4, gb_);
#pragma unroll
            for (int m = 0; m < 8; ++m)
#pragma unroll
                for (int n = 0; n < 4; ++n) acc[m][n] = (f32x4){0.f, 0.f, 0.f, 0.f};
            ckt = 0; ++cti;
        }
    }
#undef G_ISSUE
#undef G_WRITE
#undef G_COMPUTE
}

template <int KSP>
DI void thin_gemm_ctx(char* lds, const bf16_t* A, int lda, const bf16_t* Bt, int K, const float* res, float* dst, const float* gate) {
    const int tid = get_tid(), lane = tid & 63, wid = tid >> 6, fr = lane & 15, fq = lane >> 4;
    float* part = (float*)lds;
    for (int t = blockIdx.x; t < 256; t += gridDim.x) {
        const int m0 = (t >> 5) * 64, n0 = (t & 31) * 32;
        f32x4 acc[4][2];
#pragma unroll
        for (int m = 0; m < 4; ++m) { acc[m][0] = (f32x4){0.f, 0.f, 0.f, 0.f}; acc[m][1] = (f32x4){0.f, 0.f, 0.f, 0.f}; }
        const bf16_t* Ap = A + (size_t)(m0 + fr) * lda + wid * (KSP * 32) + fq * 8;
        const bf16_t* Bp = Bt + (size_t)(n0 + fr) * K + wid * (KSP * 32) + fq * 8;
#pragma unroll
        for (int k = 0; k < KSP; ++k) {
            bf16x8 a[4], b[2];
#pragma unroll
            for (int m = 0; m < 4; ++m) a[m] = *(const bf16x8*)(Ap + (size_t)m * 16 * lda + k * 32);
#pragma unroll
            for (int n = 0; n < 2; ++n) b[n] = *(const bf16x8*)(Bp + (size_t)n * 16 * K + k * 32);
#pragma unroll
            for (int m = 0; m < 4; ++m)
#pragma unroll
                for (int n = 0; n < 2; ++n) acc[m][n] = __builtin_amdgcn_mfma_f32_16x16x32_bf16(b[n], a[m], acc[m][n], 0, 0, 0);
        }
        __syncthreads();
#pragma unroll
        for (int m = 0; m < 4; ++m)
#pragma unroll
            for (int n = 0; n < 2; ++n) *(f32x4*)(part + ((wid * 64 + m * 16 + fr) * 32 + n * 16 + fq * 4)) = acc[m][n];
        __syncthreads();
        { const int row = tid >> 3, c4 = (tid & 7) * 4; f32x4 sum = (f32x4){0.f, 0.f, 0.f, 0.f};
#pragma unroll
          for (int w = 0; w < 8; ++w) sum += *(const f32x4*)(part + ((w * 64 + row) * 32 + c4));
          const size_t off = (size_t)(m0 + row) * 1024 + n0 + c4;
          const f32x4 g = *(const f32x4*)(gate + 2 * 6144 + n0 + c4), x = *(const f32x4*)(res + off);
          *(f32x4*)(dst + off) = x + g * sum; }
    }
    __syncthreads();
}

struct EpiWin0 {
    bf16_t* UA; float* CQKV; float* KR;
    DI void operator()(const f32x4 (&acc)[8][4], int row0, int col0, int gb) const {
#pragma unroll
        for (int m = 0; m < 8; ++m) { const int ri = row0 + m * 16; const size_t r = ri; const int b = row_batch(ri), tp = row_tpos(ri);
#pragma unroll
            for (int n = 0; n < 4; ++n) { const int c = col0 + n * 16; const f32x4 v = acc[m][n];
                if (c < 512) { const int g = c >> 4, s0 = c & 15;
                    *(u32x2*)(UA + ((size_t)g * CHR + b * NCK + (tp >> 5)) * 768 + (tp & 31) * 16 + s0) = (u32x2){pk2(v[0], v[1]), pk2(v[2], v[3])}; }
                else if (c < 1152) *(f32x4*)(CQKV + r * 640 + (c - 512)) = v;
                else if (c < 1216) *(f32x4*)(KR + r * 64 + (c - 1152)) = v; } }
    }
};
struct EpiS1a {
    float* E;
    DI void operator()(const f32x4 (&acc)[8][4], int row0, int col0, int gb) const {
#pragma unroll
        for (int m = 0; m < 8; ++m) { const int r = row0 + m * 16; if (r >= CHR) continue;
#pragma unroll
            for (int n = 0; n < 4; ++n) *(f32x4*)(E + ((size_t)gb * CHR + r) * 256 + col0 + n * 16) = acc[m][n]; }
    }
};
struct EpiS1b {
    bf16_t* YG;
    DI void operator()(const f32x4 (&acc)[8][4], int row0, int col0, int gb) const {
#pragma unroll
        for (int m = 0; m < 8; ++m) { const int r = row0 + m * 16; if (r >= CHR) continue; const int b = r / NCK, c = r % NCK;
#pragma unroll
            for (int n = 0; n < 4; ++n) { const int cc = col0 + n * 16; const int tl = cc >> 4, s0 = cc & 15; const f32x4 v = acc[m][n];
                const int tp = c * SL + tl; const size_t row = tp < CTX ? (size_t)b * CTX + tp : (size_t)NCTX + (size_t)b * SEQ + (tp - CTX);
                *(u32x2*)(YG + row * 512 + gb * 16 + s0) = (u32x2){pk2(gelu_tanh(v[0]), gelu_tanh(v[1])), pk2(gelu_tanh(v[2]), gelu_tanh(v[3]))}; } }
    }
};
struct EpiBf16 {
    bf16_t* O; int ldo;
    DI void operator()(const f32x4 (&acc)[8][4], int row0, int col0, int gb) const {
#pragma unroll
        for (int m = 0; m < 8; ++m) { const size_t r = row0 + m * 16;
#pragma unroll
            for (int n = 0; n < 4; ++n) { const int c = col0 + n * 16; const f32x4 v = acc[m][n];
                *(u32x2*)(O + r * ldo + c) = (u32x2){pk2(v[0], v[1]), pk2(v[2], v[3])}; } }
    }
};
struct EpiKV {
    bf16_t* KNOPE; bf16_t* VT;
    DI void operator()(const f32x4 (&acc)[8][4], int row0, int col0, int gb) const {
#pragma unroll
        for (int m = 0; m < 8; ++m) { const int r = row0 + m * 16; const int b = row_batch(r), tp = row_tpos(r);
#pragma unroll
            for (int n = 0; n < 4; ++n) { const int c = col0 + n * 16; const int h = c >> 8, w = c & 255; const f32x4 v = acc[m][n];
                if (w < 128) *(u32x2*)(KNOPE + (size_t)r * 512 + h * 128 + w) = (u32x2){pk2(v[0], v[1]), pk2(v[2], v[3])};
                else { bf16_t* d = VT + ((size_t)(b * 4 + h) * 128 + (w - 128)) * TK + tp; const unsigned p0 = pk2(v[0], v[1]), p1 = pk2(v[2], v[3]);
                    d[0] = (bf16_t)(p0 & 0xffff); d[TK] = (bf16_t)(p0 >> 16); d[2 * TK] = (bf16_t)(p1 & 0xffff); d[3 * TK] = (bf16_t)(p1 >> 16); } } }
    }
};
struct EpiGLU {
    const bf16_t* YG; const float* bias; bf16_t* CAT;
    DI void operator()(const f32x4 (&acc)[8][4], int row0, int col0, int gb) const {
#pragma unroll
        for (int m = 0; m < 8; ++m) { const size_t r = row0 + m * 16;
#pragma unroll
            for (int n = 0; n < 4; ++n) { const int c = col0 + n * 16; const f32x4 v = acc[m][n]; const f32x4 bv = *(const f32x4*)(bias + c);
                const u32x2 yy = *(const u32x2*)(YG + r * 512 + c);
                const float y0 = __uint_as_float(yy[0] << 16), y1 = __uint_as_float(yy[0] & 0xffff0000u), y2 = __uint_as_float(yy[1] << 16), y3 = __uint_as_float(yy[1] & 0xffff0000u);
                const float o0 = y0 * sigmoidf_(v[0] + bv[0]), o1 = y1 * sigmoidf_(v[1] + bv[1]), o2 = y2 * sigmoidf_(v[2] + bv[2]), o3 = y3 * sigmoidf_(v[3] + bv[3]);
                *(u32x2*)(CAT + r * 1024 + c) = (u32x2){pk2(o0, o1), pk2(o2, o3)}; } }
    }
};
struct EpiRes {
    const float* res_ctx; const float* res_lat; float* dst_ctx; float* dst_lat; const float* gate; int atomic;
    DI void operator()(const f32x4 (&acc)[8][4], int row0, int col0, int gb) const {
#pragma unroll
        for (int m = 0; m < 8; ++m) { const int r = row0 + m * 16;
            const float* rs = r < NCTX ? res_ctx + (size_t)r * 1024 : res_lat + (size_t)(r - NCTX) * 1024;
            float* ds = r < NCTX ? dst_ctx + (size_t)r * 1024 : dst_lat + (size_t)(r - NCTX) * 1024;
            if (r < NCTX && dst_ctx == nullptr) continue;
            const float* gv = gate + row_vec(r) * 6144;
#pragma unroll
            for (int n = 0; n < 4; ++n) { const int c = col0 + n * 16; const f32x4 g = *(const f32x4*)(gv + c);
                if (atomic) { const f32x4 v = g * acc[m][n];
#pragma unroll
                    for (int j = 0; j < 4; ++j) (void)__hip_atomic_fetch_add(ds + c + j, v[j], __ATOMIC_RELAXED, __HIP_MEMORY_SCOPE_AGENT); }
                else { const f32x4 x = *(const f32x4*)(rs + c); *(f32x4*)(ds + c) = x + g * acc[m][n]; } } }
    }
};
struct EpiSwiGLU {
    bf16_t* HID;
    DI void operator()(const f32x4 (&acc)[8][4], int row0, int col0, int gb) const {
        const int hc = (col0 >> 6) * 32 + (col0 & 15);
#pragma unroll
        for (int m = 0; m < 8; ++m) { const size_t r = row0 + m * 16;
#pragma unroll
            for (int q = 0; q < 2; ++q) { const f32x4 g = acc[m][2 * q], u = acc[m][2 * q + 1];
                const float o0 = siluf_(g[0]) * u[0], o1 = siluf_(g[1]) * u[1], o2 = siluf_(g[2]) * u[2], o3 = siluf_(g[3]) * u[3];
                *(u32x2*)(HID + r * FH + hc + q * 16) = (u32x2){pk2(o0, o1), pk2(o2, o3)}; } }
    }
};
struct EpiWin1 {
    bf16_t* Q; bf16_t* K1; bf16_t* VT; const float* qn; const float* kn; const float* ROPE;
    DI void operator()(const f32x4 (&acc)[8][4], int row0, int col0, int gb) const {
        const int cw = col0 & ~63, i0 = col0 & 15;
        if (cw >= 1280) {
#pragma unroll
            for (int m = 0; m < 8; ++m) { const int r = row0 + m * 16; const int b = row_batch(r), tp = row_tpos(r);
#pragma unroll
                for (int n = 0; n < 4; ++n) { const int cc = col0 + n * 16 - 1280, h = cc >> 6, d0 = cc & 63; const f32x4 v = acc[m][n];
                    bf16_t* d = VT + ((size_t)(b * 4 + h) * 64 + d0) * TK + tp; const unsigned p0 = pk2(v[0], v[1]), p1 = pk2(v[2], v[3]);
                    d[0] = (bf16_t)(p0 & 0xffff); d[TK] = (bf16_t)(p0 >> 16); d[2 * TK] = (bf16_t)(p1 & 0xffff); d[3 * TK] = (bf16_t)(p1 >> 16); } }
            return;
        }
        const bool isq = cw < 1024;
        const float* gn = isq ? qn : kn;
        f32x4 g[4];
#pragma unroll
        for (int n = 0; n < 4; ++n) g[n] = *(const f32x4*)(gn + n * 16 + i0);
        const float osc = isq ? 0.125f * LOG2E : 1.f;
#pragma unroll
        for (int m = 0; m < 8; ++m) { const int r = row0 + m * 16; const bool lat = r >= NCTX;
            if (isq && !lat) continue;
            const int b = row_batch(r), tp = row_tpos(r), t = tp - CTX;
            float ss = 0.f;
#pragma unroll
            for (int n = 0; n < 4; ++n) { const f32x4 v = acc[m][n]; ss += v[0] * v[0] + v[1] * v[1] + v[2] * v[2] + v[3] * v[3]; }
            ss += __shfl_xor(ss, 16); ss += __shfl_xor(ss, 32);
            const float rstd = rsqrtf(ss * (1.f / 64.f) + 1e-6f);
            f32x4 y[4];
#pragma unroll
            for (int n = 0; n < 4; ++n) y[n] = acc[m][n] * rstd * g[n];
            if (lat) { const float* rr = ROPE + ((t >> 6) * 16 + i0) * 2; const float* rc = ROPE + ((t & 63) * 16 + i0) * 2;
#pragma unroll
                for (int j = 0; j < 4; ++j) { const float c0 = rr[2 * j], s0 = rr[2 * j + 1], c1 = rc[2 * j], s1 = rc[2 * j + 1];
                    const float a0 = y[0][j], a1 = y[1][j], a2 = y[2][j], a3 = y[3][j];
                    y[0][j] = a0 * c0 - a1 * s0; y[1][j] = a1 * c0 + a0 * s0; y[2][j] = a2 * c1 - a3 * s1; y[3][j] = a3 * c1 + a2 * s1; } }
            bf16_t* dst = isq ? Q + (size_t)r * 1024 + cw + i0 : K1 + ((size_t)(b * 4 + ((cw - 1024) >> 6)) * TK + tp) * 64 + i0;
#pragma unroll
            for (int n = 0; n < 4; ++n) *(u32x2*)(dst + n * 16) = (u32x2){pk2(y[n][0] * osc, y[n][1] * osc), pk2(y[n][2] * osc, y[n][3] * osc)};
        }
    }
};

template <int DQK, int DV, bool WIN>
DI void attn_item(char* lds, const bf16_t* Q, int qstride, const bf16_t* Kb, const bf16_t* VTb, int ta0, int ta1, int tb0, int tb1,
                  float m_init, float l_init, bf16_t* O, int ostride, int qpos0) {
    constexpr int NKS = DQK / 16, NDT = DV / 32, KSTR = DQK + 8, VSTR = 68;
    constexpr int KCH = 64 * DQK / 8 / NTHREADS, VCH = DV * 8 / NTHREADS;
    bf16_t* Ks = (bf16_t*)lds; bf16_t* Vs = Ks + 64 * KSTR;
    const int tid = get_tid(), lane = tid & 63, wid = tid >> 6, r = lane & 31, h2 = lane >> 5;
    bf16x8 qf[NKS];
    { const bf16_t* qrow = Q + (size_t)(wid * 32 + r) * qstride + 8 * h2;
#pragma unroll
      for (int ks = 0; ks < NKS; ++ks) qf[ks] = *(const bf16x8*)(qrow + 16 * ks); }
    f32x16 o[NDT];
#pragma unroll
    for (int dt = 0; dt < NDT; ++dt)
#pragma unroll
        for (int i = 0; i < 16; ++i) o[dt][i] = 0.f;
    float mrun = m_init, lrun = (h2 == 0) ? l_init : 0.f;
    const int na = ta1 - ta0, ntot = na + (tb1 - tb0);
    u32x4 kr[KCH], vr[VCH];
    constexpr int KTPR = (DQK / 8) / KCH;
    constexpr int VTPR = 8 / VCH;
    const int krow = tid / KTPR, kcol = (tid % KTPR) * (KCH * 8);
    const int vrow = tid / VTPR, vcol = (tid % VTPR) * (VCH * 8);
    const bf16_t* kgp = Kb + (size_t)krow * DQK + kcol;
    const bf16_t* vgp = VTb + (size_t)vrow * TK + vcol;
    bf16_t* ksp = Ks + krow * KSTR + kcol;
    bf16_t* vsp = Vs + vrow * VSTR + vcol;
    constexpr int KVB = 64 * KSTR + DV * VSTR;
#define A_LOAD(Tv) do { const bf16_t* kg = kgp + (size_t)(Tv) * 64 * DQK; const bf16_t* vg = vgp + (Tv) * 64; \
        _Pragma("unroll") for (int i = 0; i < KCH; ++i) kr[i] = *(const u32x4*)(kg + i * 8); \
        _Pragma("unroll") for (int i = 0; i < VCH; ++i) vr[i] = *(const u32x4*)(vg + i * 8); } while (0)
#define A_WRITE(bo) do { _Pragma("unroll") for (int i = 0; i < KCH; ++i) *(u32x4*)(ksp + (bo) + i * 8) = kr[i]; \
        _Pragma("unroll") for (int i = 0; i < VCH; ++i) { *(u32x2*)(vsp + (bo) + i * 8) = (u32x2){vr[i][0], vr[i][1]}; *(u32x2*)(vsp + (bo) + i * 8 + 4) = (u32x2){vr[i][2], vr[i][3]}; } } while (0)
#define A_TILE(itv) (((itv) < na) ? ta0 + (itv) : tb0 + ((itv) - na))
    __syncthreads();
    A_LOAD(A_TILE(0)); A_WRITE(0);
    if (1 < ntot) A_LOAD(A_TILE(1));
    __syncthreads();
    for (int it = 0; it < ntot; ++it) {
        const int T = A_TILE(it);
        const int cb = (it & 1) * KVB;
        if (it + 1 < ntot) A_WRITE(KVB - cb);
        if (it + 2 < ntot) A_LOAD(A_TILE(it + 2));
        bool active = true;
        if (WIN && T >= 4) {
            const int klo = (T - 4) * 64, qlo = qpos0 + wid * 32;
            if (klo > qlo + 31 + 128 || klo + 63 < qlo - 128) active = false;
        }
        if (active) {
        const bf16_t* Ksc = Ks + cb; const bf16_t* Vsc = Vs + cb;
        f32x16 s0, s1;
#pragma unroll
        for (int i = 0; i < 16; ++i) { s0[i] = 0.f; s1[i] = 0.f; }
        {
            constexpr int NG = NKS / 2;
            bf16x8 kf[2][4];
            const bf16_t* kb0 = Ksc + r * KSTR + 8 * h2; const bf16_t* kb1 = Ksc + (32 + r) * KSTR + 8 * h2;
            kf[0][0] = *(const bf16x8*)(kb0); kf[0][1] = *(const bf16x8*)(kb1); kf[0][2] = *(const bf16x8*)(kb0 + 16); kf[0][3] = *(const bf16x8*)(kb1 + 16);
#pragma unroll
            for (int g = 0; g < NG; ++g) {
                if (g + 1 < NG) { kf[(g + 1) & 1][0] = *(const bf16x8*)(kb0 + 32 * (g + 1)); kf[(g + 1) & 1][1] = *(const bf16x8*)(kb1 + 32 * (g + 1));
                                  kf[(g + 1) & 1][2] = *(const bf16x8*)(kb0 + 32 * (g + 1) + 16); kf[(g + 1) & 1][3] = *(const bf16x8*)(kb1 + 32 * (g + 1) + 16); }
                __builtin_amdgcn_sched_barrier(0);
                s0 = __builtin_amdgcn_mfma_f32_32x32x16_bf16(kf[g & 1][0], qf[2 * g], s0, 0, 0, 0);
                s1 = __builtin_amdgcn_mfma_f32_32x32x16_bf16(kf[g & 1][1], qf[2 * g], s1, 0, 0, 0);
                s0 = __builtin_amdgcn_mfma_f32_32x32x16_bf16(kf[g & 1][2], qf[2 * g + 1], s0, 0, 0, 0);
                s1 = __builtin_amdgcn_mfma_f32_32x32x16_bf16(kf[g & 1][3], qf[2 * g + 1], s1, 0, 0, 0);
                __builtin_amdgcn_sched_barrier(0);
            }
        }
        if (WIN && T >= 4) {
            const int qp = qpos0 + wid * 32 + r, kp0 = (T - 4) * 64 + 4 * h2;
#pragma unroll
            for (int i = 0; i < 16; ++i) { const int d0 = kp0 + (i & 3) + 8 * (i >> 2) - qp, d1 = d0 + 32;
                if (d0 > 128 || d0 < -128) s0[i] = -1e30f;
                if (d1 > 128 || d1 < -128) s1[i] = -1e30f; }
        }
        float mx = fmaxf(s0[0], s1[0]);
#pragma unroll
        for (int i = 1; i < 16; ++i) mx = fmaxf(mx, fmaxf(s0[i], s1[i]));
        mx = fmaxf(mx, __shfl_xor(mx, 32));
        if (__builtin_amdgcn_ballot_w64(mx > mrun + 8.f) != 0ull) {
            const float mn = fmaxf(mrun, mx);
            const float alpha = __builtin_amdgcn_exp2f(mrun - mn);
            mrun = mn; lrun *= alpha;
#pragma unroll
            for (int dt = 0; dt < NDT; ++dt)
#pragma unroll
                for (int i = 0; i < 16; ++i) o[dt][i] *= alpha;
        }
        float rs = 0.f;
#pragma unroll
        for (int i = 0; i < 16; ++i) { s0[i] = __builtin_amdgcn_exp2f(s0[i] - mrun); s1[i] = __builtin_amdgcn_exp2f(s1[i] - mrun); rs += s0[i] + s1[i]; }
        lrun += rs;
        {
            bf16x8 vf[2][NDT];
#define V_LOAD(dstv, q_) do { _Pragma("unroll") for (int dt = 0; dt < NDT; ++dt) { const bf16_t* vp = Vsc + (32 * dt + r) * VSTR + 16 * (q_) + 4 * h2; \
                const s16x4 lo = *(const s16x4*)vp, hi = *(const s16x4*)(vp + 8); dstv[dt] = __builtin_shufflevector(lo, hi, 0, 1, 2, 3, 4, 5, 6, 7); } } while (0)
            V_LOAD(vf[0], 0);
#pragma unroll
            for (int q = 0; q < 4; ++q) {
                if (q + 1 < 4) V_LOAD(vf[(q + 1) & 1], q + 1);
                const int st = q & 1;
                u32x4 pw;
                if (q < 2) { pw[0] = pk2(s0[8 * st + 0], s0[8 * st + 1]); pw[1] = pk2(s0[8 * st + 2], s0[8 * st + 3]); pw[2] = pk2(s0[8 * st + 4], s0[8 * st + 5]); pw[3] = pk2(s0[8 * st + 6], s0[8 * st + 7]); }
                else { pw[0] = pk2(s1[8 * st + 0], s1[8 * st + 1]); pw[1] = pk2(s1[8 * st + 2], s1[8 * st + 3]); pw[2] = pk2(s1[8 * st + 4], s1[8 * st + 5]); pw[3] = pk2(s1[8 * st + 6], s1[8 * st + 7]); }
                const bf16x8 pf = __builtin_bit_cast(bf16x8, pw);
                __builtin_amdgcn_sched_barrier(0);
#pragma unroll
                for (int dt = 0; dt < NDT; ++dt) o[dt] = __builtin_amdgcn_mfma_f32_32x32x16_bf16(vf[q & 1][dt], pf, o[dt], 0, 0, 0);
                __builtin_amdgcn_sched_barrier(0);
            }
#undef V_LOAD
        }
        }
        __syncthreads();
    }
#undef A_LOAD
#undef A_WRITE
#undef A_TILE
    lrun += __shfl_xor(lrun, 32);
    const float inv = 1.f / lrun;
    bf16_t* orow = O + (size_t)(wid * 32 + r) * ostride;
#pragma unroll
    for (int dt = 0; dt < NDT; ++dt)
#pragma unroll
        for (int g = 0; g < 4; ++g)
            *(u32x2*)(orow + 32 * dt + 8 * g + 4 * h2) = (u32x2){pk2(o[dt][4 * g] * inv, o[dt][4 * g + 1] * inv), pk2(o[dt][4 * g + 2] * inv, o[dt][4 * g + 3] * inv)};
    __syncthreads();
}

DI void s5_kk_phase(const Params& p) {
    const int tid512 = get_tid(); const int tid = tid512 & 255, s = tid >> 4, sp = tid & 15;
    const f32x2* POW = (const f32x2*)(p.ws + H_POW); const f32x2* BB = (const f32x2*)(p.ws + T_BBAR); float* KK = (float*)(p.ws + H_KK);
    for (int it = blockIdx.x * 2 + (tid512 >> 8); it < 32 * 2 * 32; it += gridDim.x * 2) {
        const int d = it & 31, dir = (it >> 5) & 1, g = it >> 6;
        const int e0 = (dir * 32 + g) * 64; const float* cre = p.in[18] + ((size_t)(dir * 32 + g) * 16 + s) * 64; const float* cim = p.in[19] + ((size_t)(dir * 32 + g) * 16 + s) * 64;
        float acc = 0.f;
#pragma unroll 8
        for (int pp = 0; pp < 64; ++pp) { const f32x2 pw = POW[(size_t)(e0 + pp) * 33 + d], bb = BB[(e0 + pp) * 16 + sp];
            const float zr = pw[0] * bb[0] - pw[1] * bb[1], zi = pw[0] * bb[1] + pw[1] * bb[0];
            acc += cre[pp] * zr - cim[pp] * zi; }
        KK[(size_t)((g * 2 + dir) * 32 + d) * 256 + tid] = acc;
    }
}
DI void s5_w1a_phase(const Params& p) {
    const int tid = get_tid();
    const f32x2* POW = (const f32x2*)(p.ws + H_POW); const f32x2* BB = (const f32x2*)(p.ws + T_BBAR); bf16_t* W = (bf16_t*)(p.ws + H_W1A);
    for (int idx = blockIdx.x * NTHREADS + tid; idx < 2048 * 256; idx += gridDim.x * NTHREADS) {
        const int kq = idx & 63, n = (idx >> 6) & 255, g = idx >> 14;
        const int dir = n >> 7, ri = (n >> 6) & 1, pp = n & 63; const int e = (dir * 32 + g) * 64 + pp; const int tl = kq >> 1, s0 = (kq & 1) * 8;
        const f32x2 pw = POW[(size_t)e * 33 + (dir ? tl : 31 - tl)];
        float v[8];
#pragma unroll
        for (int j = 0; j < 8; ++j) { const f32x2 bb = BB[e * 16 + s0 + j]; v[j] = ri ? pw[0] * bb[1] + pw[1] * bb[0] : pw[0] * bb[0] - pw[1] * bb[1]; }
        *(u32x4*)(W + ((size_t)g * 256 + n) * 512 + kq * 8) = (u32x4){pk2(v[0], v[1]), pk2(v[2], v[3]), pk2(v[4], v[5]), pk2(v[6], v[7])};
    }
}
DI void s5_w1b_phase(const Params& p) {
    const int tid = get_tid();
    const f32x2* POW = (const f32x2*)(p.ws + H_POW); const float* KK = (const float*)(p.ws + H_KK); bf16_t* W = (bf16_t*)(p.ws + A_W1B);
    for (int idx = blockIdx.x * NTHREADS + tid; idx < 6144 * 256; idx += gridDim.x * NTHREADS) {
        const int kq = idx % 96, n = (idx / 96) & 511, g = idx / (96 * 512);
        const int tl = n >> 4, s = n & 15;
        float v[8];
        if (kq < 64) { const int tl2 = kq >> 1, s0 = (kq & 1) * 8;
#pragma unroll
            for (int j = 0; j < 8; ++j) { float x = 0.f;
                if (tl2 <= tl) x += KK[(size_t)((g * 2 + 0) * 32 + (tl - tl2)) * 256 + s * 16 + s0 + j];
                if (tl2 >= tl) x += KK[(size_t)((g * 2 + 1) * 32 + (tl2 - tl)) * 256 + s * 16 + s0 + j];
                if (tl2 == tl && s0 + j == s) x += p.in[20][g * 16 + s];
                v[j] = x; }
        } else { const int k2 = (kq - 64) * 8; const int dir = k2 >> 7, ri = (k2 >> 6) & 1, p0 = k2 & 63;
            const float* cre = p.in[18] + ((size_t)(dir * 32 + g) * 16 + s) * 64; const float* cim = p.in[19] + ((size_t)(dir * 32 + g) * 16 + s) * 64;
#pragma unroll
            for (int j = 0; j < 8; ++j) { const int pp = p0 + j; const f32x2 pw = POW[(size_t)((dir * 32 + g) * 64 + pp) * 33 + (dir ? 32 - tl : tl + 1)];
                const float cr = cre[pp], ci = cim[pp];
                v[j] = ri ? -(cr * pw[1] + ci * pw[0]) : cr * pw[0] - ci * pw[1]; }
        }
        *(u32x4*)(W + ((size_t)g * 512 + n) * 768 + kq * 8) = (u32x4){pk2(v[0], v[1]), pk2(v[2], v[3]), pk2(v[4], v[5]), pk2(v[6], v[7])};
    }
}
DI void s5_carry_phase(const Params& p) {
    const int tid_ = get_tid(); const int lane = tid_ & 63, wid = tid_ >> 6;
    const f32x2* POW = (const f32x2*)(p.ws + H_POW); const float* E = (const float*)(p.ws + H_E); bf16_t* UA = (bf16_t*)(p.ws + H_UA);
    for (int it = blockIdx.x * NWV + wid; it < 2 * 2 * 32; it += gridDim.x * NWV) {
        const int g = it & 31, dir = (it >> 5) & 1, b = it >> 6;
        const f32x2 l32 = POW[(size_t)((dir * 32 + g) * 64 + lane) * 33 + 32];
        float hr = 0.f, hi = 0.f;
        for (int i0 = 0; i0 < NCK; i0 += 8) {
            float er[8], ei[8];
#pragma unroll
            for (int j = 0; j < 8; ++j) { const int i = i0 + j; const int c = dir ? (i < 8 ? 7 - i : NCK - 1 - (i - 8)) : i;
                const size_t m = (size_t)g * CHR + b * NCK + c;
                er[j] = E[m * 256 + dir * 128 + lane]; ei[j] = E[m * 256 + dir * 128 + 64 + lane]; }
#pragma unroll
            for (int j = 0; j < 8; ++j) { const int i = i0 + j; const int c = dir ? (i < 8 ? 7 - i : NCK - 1 - (i - 8)) : i;
                const size_t m = (size_t)g * CHR + b * NCK + c;
                bf16_t* u = UA + m * 768 + 512 + dir * 128 + lane;
                u[0] = (bf16_t)(pk2(hr, 0.f) & 0xffff); u[64] = (bf16_t)(pk2(hi, 0.f) & 0xffff);
                const float nr = l32[0] * hr - l32[1] * hi + er[j], ni = l32[0] * hi + l32[1] * hr + ei[j];
                hr = nr; hi = ni; }
        }
    }
}

DI void qkvnorm_phase(const Params& p) {
    const int tid_ = get_tid(); const int lane = tid_ & 63, wid = tid_ >> 6;
    const float* CQKV = (const float*)(p.ws + S_CQKV);
    bf16_t* CQN = (bf16_t*)(p.ws + S_CQN); bf16_t* CKVN = (bf16_t*)(p.ws + S_CKVN);
    for (int r = blockIdx.x * NWV + wid; r < NR; r += gridDim.x * NWV) {
        const float* src = CQKV + (size_t)r * 640;
        float a[6], k[4]; float sa = 0.f, sk = 0.f;
#pragma unroll
        for (int i = 0; i < 6; ++i) { a[i] = src[lane + 64 * i]; sa += a[i] * a[i]; }
#pragma unroll
        for (int i = 0; i < 4; ++i) { k[i] = src[384 + lane + 64 * i]; sk += k[i] * k[i]; }
        sa = wave_sum(sa); sk = wave_sum(sk);
        const float ra = rsqrtf(sa * (1.f / 384.f) + 1e-6f), rk = rsqrtf(sk * (1.f / 256.f) + 1e-6f);
#pragma unroll
        for (int i = 0; i < 6; ++i) CQN[(size_t)r * 384 + lane + 64 * i] = (bf16_t)(pk2(a[i] * ra * p.in[23][lane + 64 * i], 0.f) & 0xffff);
#pragma unroll
        for (int i = 0; i < 4; ++i) CKVN[(size_t)r * 256 + lane + 64 * i] = (bf16_t)(pk2(k[i] * rk * p.in[25][lane + 64 * i], 0.f) & 0xffff);
    }
}
DI float rope64(float x, int lane, const float* ROPE, int rpos, int cpos) {
    const float partner = __shfl_xor(x, 16);
    const int i = lane & 15; const int pos = lane < 32 ? rpos : cpos;
    const float c = ROPE[(pos * 16 + i) * 2], s = ROPE[(pos * 16 + i) * 2 + 1];
    return (lane & 16) ? x * c + partner * s : x * c - partner * s;
}
DI void mla_prep_phase(const Params& p) {
    const int tid_ = get_tid(); const int lane = tid_ & 63, wid = tid_ >> 6;
    bf16_t* QR = (bf16_t*)(p.ws + S_QRAW); const bf16_t* KN = (const bf16_t*)(p.ws + S_KNOPE); const float* KR = (const float*)(p.ws + H_KR);
    bf16_t* KA = (bf16_t*)(p.ws + S_KA); const float* ROPE = (const float*)(p.ws + T_ROPE);
    const float qsc = 0.07216878364870323f * LOG2E;
    const float qg0 = p.in[27][lane], qg1 = p.in[27][64 + lane], qg2 = p.in[27][128 + lane];
    const float kg0 = p.in[28][lane], kg1 = p.in[28][64 + lane], kg2 = p.in[28][128 + lane];
    for (int r = blockIdx.x * NWV + wid; r < NR; r += gridDim.x * NWV) {
        const bool lat = r >= NCTX; const int b = row_batch(r), tp = row_tpos(r); const int t = tp - CTX;
        const int rpos = lat ? (t >> 6) : 0, cpos = lat ? (t & 63) : 0;
        const float krv = KR[(size_t)r * 64 + lane];
#pragma unroll
        for (int h = 0; h < 4; ++h) {
            bf16_t* q = QR + (size_t)r * 768 + h * 192;
            float x0 = bf2f(q[lane]), x1 = bf2f(q[64 + lane]), x2 = bf2f(q[128 + lane]);
            float ss = wave_sum(x0 * x0 + x1 * x1 + x2 * x2);
            float rs = rsqrtf(ss * (1.f / 192.f) + 1e-6f);
            x0 *= rs * qg0; x1 *= rs * qg1; x2 *= rs * qg2;
            if (lat) x2 = rope64(x2, lane, ROPE, rpos, cpos);
            q[lane] = (bf16_t)(pk2(x0 * qsc, 0.f) & 0xffff); q[64 + lane] = (bf16_t)(pk2(x1 * qsc, 0.f) & 0xffff); q[128 + lane] = (bf16_t)(pk2(x2 * qsc, 0.f) & 0xffff);
            const bf16_t* kn = KN + (size_t)r * 512 + h * 128;
            float k0 = bf2f(kn[lane]), k1 = bf2f(kn[64 + lane]), k2 = krv;
            ss = wave_sum(k0 * k0 + k1 * k1 + k2 * k2);
            rs = rsqrtf(ss * (1.f / 192.f) + 1e-6f);
            k0 *= rs * kg0; k1 *= rs * kg1; k2 *= rs * kg2;
            if (lat) k2 = rope64(k2, lane, ROPE, rpos, cpos);
            bf16_t* kd = KA + ((size_t)(b * 4 + h) * TK + tp) * 192;
            kd[lane] = (bf16_t)(pk2(k0, 0.f) & 0xffff); kd[64 + lane] = (bf16_t)(pk2(k1, 0.f) & 0xffff); kd[128 + lane] = (bf16_t)(pk2(k2, 0.f) & 0xffff);
        }
    }
}
DI void win_prep_phase(const Params& p) {
    const int tid_ = get_tid(); const int lane = tid_ & 63, wid = tid_ >> 6;
    bf16_t* Q = (bf16_t*)(p.ws + S1_Q); const float* KRAW = (const float*)(p.ws + S1_KRAW); bf16_t* K1 = (bf16_t*)(p.ws + S1_K);
    const float* ROPE = (const float*)(p.ws + T_ROPE);
    const float qsc = 0.125f * LOG2E;
    const float qg = p.in[31][lane], kg = p.in[32][lane];
    for (int r = blockIdx.x * NWV + wid; r < NR; r += gridDim.x * NWV) {
        const bool lat = r >= NCTX; const int b = row_batch(r), tp = row_tpos(r); const int t = tp - CTX;
        const int rpos = lat ? (t >> 6) : 0, cpos = lat ? (t & 63) : 0;
        if (lat) {
#pragma unroll 4
            for (int h = 0; h < 16; ++h) { bf16_t* q = Q + (size_t)r * 1024 + h * 64;
                float x = bf2f(q[lane]); const float ss = wave_sum(x * x); x *= rsqrtf(ss * (1.f / 64.f) + 1e-6f) * qg;
                x = rope64(x, lane, ROPE, rpos, cpos);
                q[lane] = (bf16_t)(pk2(x * qsc, 0.f) & 0xffff); }
        }
#pragma unroll
        for (int h = 0; h < 4; ++h) { float x = KRAW[(size_t)r * 256 + h * 64 + lane]; const float ss = wave_sum(x * x); x *= rsqrtf(ss * (1.f / 64.f) + 1e-6f) * kg;
            if (lat) x = rope64(x, lane, ROPE, rpos, cpos);
            K1[((size_t)(b * 4 + h) * TK + tp) * 64 + lane] = (bf16_t)(pk2(x, 0.f) & 0xffff); }
    }
}

__global__ void __launch_bounds__(NTHREADS, 2) fwd_kernel(Params p) {
    extern __shared__ __attribute__((aligned(16))) char lds[];
    cg::grid_group grid = cg::this_grid();
    char* ws = p.ws;
    const bf16_t* WB = (const bf16_t*)ws;
    const float* MOD = (const float*)(ws + T_MOD);
    float* H = (float*)(ws + OFF_H);
    bf16_t* A0 = (bf16_t*)(ws + OFF_A0);
    const int bid = blockIdx.x, nb = gridDim.x;
    volatile LAS unsigned* xst = (volatile LAS unsigned*)(lds + (LDS_BYTES - 16));
    if (threadIdx.x == 0) { xst[0] = 0u; xst[1] = 0u; }
    __syncthreads();
    const XcdBarrier xb = xcd_barrier_post((unsigned*)(ws + T_BAR), xst);
    if (p.pad == 0x7fffffff) grid.sync();
#define GRID_SYNC() xcd_barrier(xb)

    { const int npair = (p.njobtiles + 1) >> 1, nit = 192 + 12 + npair;
      for (int it = bid; it < nit; it += nb) {
          if (it < 192) ada_item(lds, p, it);
          else if (it < 204) tables_item(p, it - 192);
          else { const int lt0 = (it - 204) * 2 + (int)(threadIdx.x >> 8); const bool live = lt0 < p.njobtiles; const int lt = live ? lt0 : 0; int j = 0;
#pragma unroll
              for (int q = 1; q < 11; ++q) if (lt >= p.jobs[q].tile0) j = q;
              transpose_tile(lds, ws, p.jobs[j], lt - p.jobs[j].tile0, live); } } }
    GRID_SYNC();
    modulate_rows(p, 0, 0, true, 0);
    s5_kk_phase(p);
    GRID_SYNC();
    { EpiWin0 e{(bf16_t*)(ws + H_UA), (float*)(ws + S_CQKV), (float*)(ws + H_KR)};
      gemm_phase(lds, A0, 1024, WB + W_IN0, 1024, 0, NR / 256, 5, e); }
    s5_w1a_phase(p);
    GRID_SYNC();
    qkvnorm_phase(p);
    s5_w1b_phase(p);
    { EpiS1a e{(float*)(ws + H_E)};
      gemm_phase(lds, (const bf16_t*)(ws + H_UA), 768, (const bf16_t*)(ws + H_W1A), 512, 0, 3, 1, e, 32, (size_t)CHR * 768, (size_t)256 * 512); }
    GRID_SYNC();
    s5_carry_phase(p);
    { EpiBf16 e{(bf16_t*)(ws + S_QRAW), 768};
      gemm_phase(lds, (const bf16_t*)(ws + S_CQN), 384, WB + W_QB, 384, 0, NR / 256, 3, e); }
    { EpiKV e{(bf16_t*)(ws + S_KNOPE), (bf16_t*)(ws + S_VT)};
      gemm_phase(lds, (const bf16_t*)(ws + S_CKVN), 256, WB + W_KVB, 256, 0, NR / 256, 4, e); }
    GRID_SYNC();
    { EpiS1b e{(bf16_t*)(ws + S_YG)};
      gemm_phase(lds, (const bf16_t*)(ws + H_UA), 768, (const bf16_t*)(ws + A_W1B), 768, 0, 3, 2, e, 32, (size_t)CHR * 768, (size_t)512 * 768); }
    mla_prep_phase(p);
    GRID_SYNC();
    { const bf16_t* QR = (const bf16_t*)(ws + S_QRAW); const bf16_t* KA = (const bf16_t*)(ws + S_KA); const bf16_t* VT = (const bf16_t*)(ws + S_VT);
      const int nlat = 2 * 4 * 32, nall = nlat + 2 * 4;
      for (int it = bid; it < nall; it += nb) {
          if (it < nlat) { const int qb = it & 31, h = (it >> 5) & 3, b = it >> 7; const size_t row = NCTX + (size_t)b * SEQ + qb * 256;
              attn_item<192, 128, false>(lds, QR + row * 768 + h * 192, 768, KA + (size_t)(b * 4 + h) * TK * 192, VT + (size_t)(b * 4 + h) * 128 * TK, 0, TK / 64, 0, 0, -1e30f, 0.f,
                                         A0 + row * 1024 + 512 + h * 128, 1024, 0); }
          else { const int j = it - nlat; const int h = j & 3, b = j >> 2; const size_t row = (size_t)b * CTX;
              attn_item<192, 128, false>(lds, QR + row * 768 + h * 192, 768, KA + (size_t)(b * 4 + h) * TK * 192, VT + (size_t)(b * 4 + h) * 128 * TK, 0, 4, 0, 0, -1e30f, 0.f,
                                         A0 + row * 1024 + 512 + h * 128, 1024, 0); } }
      EpiGLU e{(const bf16_t*)(ws + S_YG), p.in[22], A0};
      gemm_phase(lds, (const bf16_t*)(ws + S_YG), 512, WB + W_GLU, 512, 0, NR / 256, 2, e); }
    GRID_SYNC();
    { EpiRes e{p.in[2], p.in[0], H, H + (size_t)NCTX * 1024, MOD + 0 * 3 * 6144 + 2048, 0};
      gemm_phase(lds, A0, 1024, WB + W_OUT0, 1024, 2, NLAT / 256, 4, e);
      thin_gemm_ctx<4>(lds, A0, 1024, WB + W_OUT0, 1024, p.in[2], H, MOD + 0 * 3 * 6144 + 2048); }
    GRID_SYNC();
    modulate_rows(p, 0, 1, false, 0);
    GRID_SYNC();
    { EpiSwiGLU e{(bf16_t*)(ws + S_HID)};
      gemm_phase(lds, A0, 1024, WB + W_GU0, 1024, 0, NR / 256, 22, e); }
    GRID_SYNC();
    { EpiRes e{H, H + (size_t)NCTX * 1024, H, H + (size_t)NCTX * 1024, MOD + 0 * 3 * 6144 + 5120, 0};
      gemm_phase(lds, (const bf16_t*)(ws + S_HID), FH, WB + W_D0, FH, 2, NLAT / 256, 4, e);
      thin_gemm_ctx<11>(lds, (const bf16_t*)(ws + S_HID), FH, WB + W_D0, FH, H, H, MOD + 0 * 3 * 6144 + 5120); }
    GRID_SYNC();
    modulate_rows(p, 1, 0, false, 0);
    GRID_SYNC();
    { EpiWin1 e{(bf16_t*)(ws + S1_Q), (bf16_t*)(ws + S1_K), (bf16_t*)(ws + S1_VT), p.in[31], p.in[32], (const float*)(ws + T_ROPE)};
      gemm_phase(lds, A0, 1024, WB + W_IN1, 1024, 0, NR / 256, 6, e); }
    GRID_SYNC();
    { const bf16_t* Q = (const bf16_t*)(ws + S1_Q); const bf16_t* K1 = (const bf16_t*)(ws + S1_K); const bf16_t* VT = (const bf16_t*)(ws + S1_VT);
      const int nit = 2 * 16 * 32;
      for (int it = bid; it < nit; it += nb) { const int g = it & 3, i = (it >> 2) & 31, kvh = (it >> 7) & 3, b = it >> 9; const int hq = kvh * 4 + g;
          const size_t row = NCTX + (size_t)b * SEQ + i * 256;
          const int l0 = (4 * i - 2) < 0 ? 0 : (4 * i - 2), l1 = (4 * i + 6) > 128 ? 128 : (4 * i + 6);
          attn_item<64, 64, true>(lds, Q + row * 1024 + hq * 64, 1024, K1 + (size_t)(b * 4 + kvh) * TK * 64, VT + (size_t)(b * 4 + kvh) * 64 * TK, 0, 4, 4 + l0, 4 + l1,
                                  p.in[33][hq] * LOG2E, 1.f, A0 + row * 1024 + hq * 64, 1024, i * 256); } }
    GRID_SYNC();
    { EpiRes e{H, H + (size_t)NCTX * 1024, nullptr, H + (size_t)NCTX * 1024, MOD + 1 * 3 * 6144 + 2048, 0};
      gemm_phase(lds, A0, 1024, WB + W_OUT1, 1024, 2, NLAT / 256, 4, e); }
    GRID_SYNC();
    modulate_rows(p, 1, 1, false, NCTX);
    GRID_SYNC();
    { EpiSwiGLU e{(bf16_t*)(ws + S_HID)};
      gemm_phase(lds, A0, 1024, WB + W_GU1, 1024, 2, NLAT / 256, 22, e); }
    GRID_SYNC();
    { EpiRes e{H, H + (size_t)NCTX * 1024, nullptr, p.out, MOD + 1 * 3 * 6144 + 5120, 0};
      gemm_phase(lds, (const bf16_t*)(ws + S_HID), FH, WB + W_D1, FH, 2, NLAT / 256, 4, e); }
}

extern "C" void kernel_launch(void* const* d_in, const int* in_sizes, int n_in, void* d_out, int out_size, void* d_ws, size_t ws_size, hipStream_t stream) {
    static int grid_blocks = 0;
    if (grid_blocks == 0) {
        if (n_in != 34 || ws_size < WS_NEED) { fprintf(stderr, "kernel_launch: unexpected n_in %d / ws %zu (need %zu)\n", n_in, ws_size, (size_t)WS_NEED); grid_blocks = -1; return; }
        int dev = 0, cus = 0, per_cu = 0;
        (void)hipGetDevice(&dev);
        (void)hipDeviceGetAttribute(&cus, hipDeviceAttributeMultiprocessorCount, dev);
        (void)hipFuncSetAttribute((const void*)fwd_kernel, hipFuncAttributeMaxDynamicSharedMemorySize, LDS_BYTES);
        (void)hipOccupancyMaxActiveBlocksPerMultiprocessor(&per_cu, (const void*)fwd_kernel, NTHREADS, LDS_BYTES);
        if (per_cu < 1) { fprintf(stderr, "kernel_launch: occupancy query returned %d\n", per_cu); grid_blocks = -1; return; }
        if (per_cu > 1) per_cu = 1;
        grid_blocks = cus * per_cu;
        fprintf(stderr, "kernel_launch: grid %d (%d CUs x %d)\n", grid_blocks, cus, per_cu);
    }
    if (grid_blocks < 0) return;
    Params p{};
    for (int i = 0; i < 34; ++i) p.in[i] = (const float*)d_in[i];
    p.out = (float*)d_out; p.ws = (char*)d_ws;
    const float* fg = p.in[8]; const float* fu = p.in[9]; const float* fd = p.in[10];
    const size_t FW = (size_t)1024 * FH;
    int t0 = 0;
    auto mk = [&](int idx, const float* a, const float* b, size_t dst, int K, int ld, int npad, int mode) {
        Job& j = p.jobs[idx]; j.a = a; j.b = b; j.dst = dst; j.K = K; j.ld = ld; j.ntk = K / 64; j.ntn = npad / 64; j.tile0 = t0; j.mode = mode; t0 += j.ntk * j.ntn; };
    mk(0, p.in[11], nullptr, W_IN0, 1024, 1216, 1280, 0);
    mk(1, p.in[24], nullptr, W_QB, 384, 768, 768, 0);
    mk(2, p.in[26], nullptr, W_KVB, 256, 1024, 1024, 0);
    mk(3, p.in[21], nullptr, W_GLU, 512, 512, 512, 0);
    mk(4, p.in[12], nullptr, W_OUT0, 1024, 1024, 1024, 0);
    mk(5, fg, fu, W_GU0, 1024, FH, 5632, 1);
    mk(6, fd, nullptr, W_D0, FH, 1024, 1024, 0);
    mk(7, p.in[29], nullptr, W_IN1, 1024, 1536, 1536, 0);
    mk(8, p.in[30], nullptr, W_OUT1, 1024, 1024, 1024, 0);
    mk(9, fg + FW, fu + FW, W_GU1, 1024, FH, 5632, 1);
    mk(10, fd + FW, nullptr, W_D1, FH, 1024, 1024, 0);
    p.njobtiles = t0;
    if (hipMemsetAsync((char*)d_ws + T_BAR, 0, XCD_BAR_WORDS * 4, stream) != hipSuccess) { fprintf(stderr, "kernel_launch: memset failed\n"); return; }
    void* args[] = {&p};
    hipError_t e = hipLaunchCooperativeKernel((const void*)fwd_kernel, dim3(grid_blocks), dim3(NTHREADS), args, LDS_BYTES, stream);
    if (e != hipSuccess) fprintf(stderr, "cooperative launch failed: %s (grid %d)\n", hipGetErrorString(e), grid_blocks);
}
```

```cpp
#include <hip/hip_runtime.h>
#include <hip/hip_cooperative_groups.h>
#include <cstdio>
#include <cstdint>
namespace cg = cooperative_groups;

#define DI __device__ __forceinline__
typedef unsigned short bf16_t;
typedef short bf16x8 __attribute__((ext_vector_type(8)));
typedef short s16x4 __attribute__((ext_vector_type(4)));
typedef float f32x4 __attribute__((ext_vector_type(4)));
typedef float f32x2 __attribute__((ext_vector_type(2)));
typedef float f32x16 __attribute__((ext_vector_type(16)));
typedef unsigned u32x4 __attribute__((ext_vector_type(4)));
typedef unsigned u32x2 __attribute__((ext_vector_type(2)));
typedef __bf16 bf16v2 __attribute__((ext_vector_type(2)));

constexpr int DM = 1024, NBATCH = 2, SEQ = 8192, CTX = 256;
constexpr int NCTX = NBATCH * CTX;
constexpr int NLAT = NBATCH * SEQ;
constexpr int NR = NCTX + NLAT;
constexpr int TK = CTX + SEQ;
constexpr int FH = 2816;
constexpr int NCH = TK / 64;
constexpr float LOG2E = 1.4426950408889634f;
constexpr int LDS_BYTES = 131072 + 64;
constexpr int NTHREADS = 512, NWV = 8;

constexpr size_t W_IN0 = 0;
constexpr size_t W_QB = W_IN0 + (size_t)1280 * 1024;
constexpr size_t W_KVB = W_QB + (size_t)768 * 384;
constexpr size_t W_GLU = W_KVB + (size_t)1024 * 256;
constexpr size_t W_OUT0 = W_GLU + (size_t)512 * 512;
constexpr size_t W_GU0 = W_OUT0 + (size_t)1024 * 1024;
constexpr size_t W_D0 = W_GU0 + (size_t)5632 * 1024;
constexpr size_t W_IN1 = W_D0 + (size_t)1024 * 2816;
constexpr size_t W_OUT1 = W_IN1 + (size_t)1536 * 1024;
constexpr size_t W_GU1 = W_OUT1 + (size_t)1024 * 1024;
constexpr size_t W_D1 = W_GU1 + (size_t)5632 * 1024;
constexpr size_t W_END = W_D1 + (size_t)1024 * 2816;
constexpr size_t OFF_TAB = W_END * 2;
constexpr size_t T_MOD = OFF_TAB;
constexpr size_t T_ROPE = T_MOD + 2 * 3 * 6144 * 4;
constexpr size_t T_LAMB = T_ROPE + 128 * 16 * 2 * 4;
constexpr size_t T_LAM64 = T_LAMB + 2 * 32 * 64 * 8;
constexpr size_t T_BBAR = T_LAM64 + 2 * 32 * 64 * 8;
constexpr size_t T_BAR = T_BBAR + (size_t)2 * 32 * 64 * 16 * 8;
constexpr size_t OFF_H = OFF_TAB + (1u << 20);
constexpr size_t OFF_A0 = OFF_H + (size_t)NR * 1024 * 4;
constexpr size_t OFF_S = OFF_A0 + (size_t)NR * 1024 * 2;
constexpr size_t WS_NEED = OFF_S + (size_t)108134400;
static_assert(WS_NEED <= ((size_t)256 << 20) && OFF_S + (size_t)NR * FH * 2 <= WS_NEED, "workspace");
constexpr int SL = 32;
constexpr int NCK = TK / SL;
constexpr int CHR = NBATCH * NCK;
constexpr size_t H_UA = OFF_H;
constexpr size_t H_KR = H_UA + (size_t)(32 * CHR + 256) * 768 * 2;
constexpr size_t H_E = H_KR + (size_t)NR * 64 * 4;
constexpr size_t H_KK = H_E + (size_t)32 * CHR * 256 * 4;
constexpr size_t H_POW = H_KK + (size_t)32 * 2 * 32 * 256 * 4;
constexpr size_t H_W1A = H_POW + (size_t)4096 * 33 * 8;
static_assert(H_W1A + (size_t)32 * 256 * 512 * 2 <= OFF_A0, "H region overflow");
constexpr size_t A_W1B = OFF_A0;
constexpr size_t S_CQN = OFF_S;
constexpr size_t S_CKVN = S_CQN + (size_t)NR * 384 * 2;
constexpr size_t S_YG = OFF_S;
constexpr size_t S_X = S_CKVN + (size_t)NR * 256 * 2;
constexpr size_t S_CQKV = S_X;
constexpr size_t S_QRAW = S_X;
constexpr size_t S_KNOPE = S_QRAW + (size_t)NR * 768 * 2;
constexpr size_t S_VT = S_KNOPE + (size_t)NR * 512 * 2;
constexpr size_t S_KA = S_VT + (size_t)2 * 4 * 128 * TK * 2;
static_assert(S_CQKV + (size_t)NR * 640 * 4 <= S_VT, "CQKV overlaps VT");
static_assert(S_KA + (size_t)2 * 4 * TK * 192 * 2 <= WS_NEED, "scratch overflow");
constexpr size_t S_HID = OFF_S;
constexpr size_t S1_Q = OFF_S;
constexpr size_t S1_KRAW = S1_Q + (size_t)NR * 1024 * 2;
constexpr size_t S1_K = S1_KRAW + (size_t)NR * 256 * 4;
constexpr size_t S1_VT = S1_K + (size_t)2 * 4 * TK * 64 * 2;

struct Job { const float* a; const float* b; unsigned long long dst; int K, ld, ntk, ntn, tile0, mode; };
struct Params {
    const float* in[34];
    float* out;
    char* ws;
    Job jobs[11];
    int njobtiles;
    int pad;
};

DI int get_tid() { int t = threadIdx.x; asm volatile("" : "+v"(t)); return t; }
DI unsigned pk2(float lo, float hi) { f32x2 v = {lo, hi}; return __builtin_bit_cast(unsigned, __builtin_convertvector(v, bf16v2)); }
DI float bf2f(unsigned short b) { return __uint_as_float(((unsigned)b) << 16); }
DI float wave_sum(float v) {
#pragma unroll
    for (int o = 32; o > 0; o >>= 1) v += __shfl_xor(v, o);
    return v;
}
DI int row_vec(int r) { return r < NCTX ? 2 : (r - NCTX) / SEQ; }
DI int row_batch(int r) { return r < NCTX ? r / CTX : (r - NCTX) / SEQ; }
DI int row_tpos(int r) { return r < NCTX ? r % CTX : CTX + (r - NCTX) % SEQ; }
DI float sigmoidf_(float x) { return 1.f / (1.f + __expf(-x)); }
DI float siluf_(float x) { return x / (1.f + __expf(-x)); }
DI float gelu_tanh(float y) { const float z = 0.7978845608028654f * (y + 0.044715f * y * y * y); const float t = 1.f - 2.f / (1.f + __expf(2.f * z)); return 0.5f * y * (1.f + t); }
DI void my_sincos(float x, float& s, float& c) {
    const float q = rintf(x * 0.636619772367581f);
    float r = fmaf(-q, 1.5703125f, x);
    r = fmaf(-q, 4.837512969970703125e-4f, r);
    r = fmaf(-q, 7.54978995489188216e-8f, r);
    const int qi = (int)q;
    const float r2 = r * r;
    const float sp = r + r * r2 * (-1.6666654611e-1f + r2 * (8.3321608736e-3f + r2 * (-1.9515295891e-4f)));
    const float cp = 1.0f - 0.5f * r2 + r2 * r2 * (4.166664568298827e-2f + r2 * (-1.388731625493765e-3f + r2 * 2.443315711809948e-5f));
    const int k = qi & 3;
    s = (k == 0) ? sp : (k == 1) ? cp : (k == 2) ? -sp : -cp;
    c = (k == 0) ? cp : (k == 1) ? -sp : (k == 2) ? -cp : sp;
}


#define XB_TMO      128
#define XB_XCNT(j)  (256  + 64 * (j))
#define XB_XSUB(j)  (1280 + 64 * (j))
#define XB_XGEN(j)  (2304 + 64 * (j))
#define XB_TOP      3328
#define XB_TOPGEN   3392
#define XCD_BAR_WORDS 3456
#define XB_SPIN_CAP (1u << 22)
#define LAS __attribute__((address_space(3)))
DI unsigned xb_ld(unsigned* p) { return __hip_atomic_load(p, __ATOMIC_RELAXED, __HIP_MEMORY_SCOPE_AGENT); }
DI unsigned xb_add(unsigned* p, unsigned v) { return __hip_atomic_fetch_add(p, v, __ATOMIC_RELAXED, __HIP_MEMORY_SCOPE_AGENT); }
DI unsigned xb_xcc_id() { return (unsigned)__builtin_amdgcn_s_getreg((3 << 11) | 20) & 0xFu; }
#define XB_SPIN(cond, bar) do { unsigned _sp = 0; while (cond) { __builtin_amdgcn_s_sleep(1); \
    if ((++_sp & 255u) == 0u) { if (xb_ld(&(bar)[XB_TMO])) break; if (_sp > XB_SPIN_CAP) { atomicAdd(&(bar)[XB_TMO], 1u); break; } } } } while (0)
struct XcdBarrier { unsigned* bar; unsigned x; volatile LAS unsigned* st; };
DI XcdBarrier xcd_barrier_post(unsigned* bar, volatile LAS unsigned* st) {
    XcdBarrier b; b.bar = bar; b.x = xb_xcc_id(); b.st = st;
    if (threadIdx.x == 0) (void)xb_add(&bar[XB_XCNT(b.x)], 1u);
    return b;
}
DI void xcd_barrier_complete(unsigned* bar, unsigned x, unsigned& nloc, unsigned& nx) {
    const unsigned G = gridDim.x * gridDim.y * gridDim.z;
    unsigned sum, cnt, mine, sp = 0u;
    for (;;) {
        sum = 0u; cnt = 0u; mine = 0u;
#pragma unroll
        for (unsigned j = 0; j < 16; ++j) { const unsigned c = xb_ld(&bar[XB_XCNT(j)]); sum += c; cnt += (c > 0u) ? 1u : 0u; mine = (j == x) ? c : mine; }
        if (sum == G) break;
        __builtin_amdgcn_s_sleep(1);
        if ((++sp & 255u) == 0u) { if (xb_ld(&bar[XB_TMO])) break; if (sp > XB_SPIN_CAP) { atomicAdd(&bar[XB_TMO], 1u); break; } }
    }
    nloc = mine > 0u ? mine : 1u; nx = cnt > 0u ? cnt : 1u;
}
DI void xcd_barrier(const XcdBarrier& b) {
    asm volatile("s_waitcnt vmcnt(0)" ::: "memory");
    __syncthreads();
    if (threadIdx.x == 0) {
        unsigned* bar = b.bar;
        __builtin_amdgcn_s_waitcnt(0);
        unsigned nloc = b.st[0], nx = b.st[1];
        if (nloc == 0u) { xcd_barrier_complete(bar, b.x, nloc, nx); b.st[0] = nloc; b.st[1] = nx; }
        const unsigned old = xb_add(&bar[XB_XSUB(b.x)], 1u);
        const unsigned gen = old / nloc;
        if (old + 1u == (gen + 1u) * nloc) {
            __builtin_amdgcn_fence(__ATOMIC_RELEASE, "agent");
            asm volatile("s_waitcnt vmcnt(0)" ::: "memory");
            const unsigned og = xb_add(&bar[XB_TOP], 1u);
            const unsigned tg = og / nx;
            if (og + 1u == (tg + 1u) * nx) xb_add(&bar[XB_TOPGEN], 1u);
            else XB_SPIN(xb_ld(&bar[XB_TOPGEN]) == tg, bar);
            __builtin_amdgcn_fence(__ATOMIC_ACQUIRE, "agent");
            xb_add(&bar[XB_XGEN(b.x)], 1u);
            asm volatile("s_waitcnt vmcnt(0)" ::: "memory");
        } else {
            XB_SPIN(xb_ld(&bar[XB_XGEN(b.x)]) == gen, bar);
            __builtin_amdgcn_fence(__ATOMIC_ACQUIRE, "agent");
            asm volatile("s_waitcnt vmcnt(0)" ::: "memory");
        }
    }
    __syncthreads();
}

DI void transpose_tile(char* lds, char* ws, const Job& jb, int lt, bool live) {
    const int tid512 = get_tid(); const int tid = tid512 & 255;
    float (*tile)[65] = (float (*)[65])(lds + (tid512 >> 8) * 17408);
    const int tk = lt % jb.ntk, tn = lt / jb.ntk;
    const int k0 = tk * 64, n0 = tn * 64;
    const int c4 = (tid & 15) * 4, rq = tid >> 4;
    const float* src; int col; bool valid = live;
    if (jb.mode == 0) { src = jb.a; col = n0 + c4; valid = live && col < jb.ld; }
    else { const int nsub = c4 >> 4, i = c4 & 15; src = (nsub & 1) ? jb.b : jb.a; col = tn * 32 + (nsub >> 1) * 16 + i; }
#pragma unroll
    for (int kk = 0; kk < 4; ++kk) { const int k = kk * 16 + rq; const f32x4 v = valid ? *(const f32x4*)(src + (size_t)(k0 + k) * jb.ld + col) : (f32x4){0.f, 0.f, 0.f, 0.f};
        tile[k][c4] = v[0]; tile[k][c4 + 1] = v[1]; tile[k][c4 + 2] = v[2]; tile[k][c4 + 3] = v[3]; }
    __syncthreads();
    const int r = tid >> 2, ks = (tid & 3) * 16;
    unsigned w[8];
#pragma unroll
    for (int q = 0; q < 8; ++q) w[q] = pk2(tile[ks + 2 * q][r], tile[ks + 2 * q + 1][r]);
    bf16_t* d = (bf16_t*)(ws) + jb.dst + (size_t)(n0 + r) * jb.K + k0 + ks;
    if (live) { *(u32x4*)d = (u32x4){w[0], w[1], w[2], w[3]};
    *(u32x4*)(d + 8) = (u32x4){w[4], w[5], w[6], w[7]}; }
    __syncthreads();
}

DI void ada_item(char* lds, const Params& p, int it) {
    float* sil = (float*)lds;
    float* red = sil + 3072;
    float* MOD = (float*)(p.ws + T_MOD);
    const int tid = get_tid(), layer = it / 96, n0 = (it % 96) * 64;
    for (int i = tid; i < 3072; i += NTHREADS) { const int v = i >> 10, k = i & 1023; const float x = v < 2 ? p.in[1][v * 1024 + k] : p.in[3][k]; sil[i] = siluf_(x); }
    __syncthreads();
    const int j4 = (tid & 15) * 4, kg = tid >> 4;
    const float* W = p.in[4] + (size_t)layer * 1024 * 6144 + n0 + j4;
    f32x4 a0 = {0.f, 0.f, 0.f, 0.f}, a1 = a0, a2 = a0;
#pragma unroll 8
    for (int k = kg * 32; k < kg * 32 + 32; ++k) { const f32x4 w = *(const f32x4*)(W + (size_t)k * 6144); a0 += sil[k] * w; a1 += sil[1024 + k] * w; a2 += sil[2048 + k] * w; }
    *(f32x4*)(red + (kg * 3 + 0) * 64 + j4) = a0; *(f32x4*)(red + (kg * 3 + 1) * 64 + j4) = a1; *(f32x4*)(red + (kg * 3 + 2) * 64 + j4) = a2;
    __syncthreads();
    if (tid < 192) { const int v = tid >> 6, jj = tid & 63;
        float s = p.in[5][layer * 6144 + n0 + jj];
#pragma unroll 8
        for (int q = 0; q < 32; ++q) s += red[(q * 3 + v) * 64 + jj];
        MOD[(layer * 3 + v) * 6144 + n0 + jj] = s; }
    __syncthreads();
}

DI void tables_item(const Params& p, int it) {
    const int tid = get_tid();
    if (it < 4) {
        const int e = it * 512 + tid, pos = e >> 4, i = e & 15;
        const float inv = exp2f(-(float)i * (13.287712379549449f / 16.f));
        float s, c; my_sincos((float)pos * inv, s, c);
        float* ROPE = (float*)(p.ws + T_ROPE); ROPE[e * 2] = c; ROPE[e * 2 + 1] = s;
    } else {
        const int e = (it - 4) * 512 + tid;
        const int dg = e >> 6;
        const float lr = p.in[13][e], li = p.in[14][e], step = expf(p.in[15][dg]);
        const float a = lr * step, b = li * step;
        const float ea = expf(a);
        float sb, cb; my_sincos(b, sb, cb);
        float sh, ch; my_sincos(0.5f * b, sh, ch);
        const float em1 = a * (1.f + a * 0.5f * (1.f + a * (1.f / 3.f) * (1.f + a * 0.25f * (1.f + a * 0.2f * (1.f + a * (1.f / 6.f))))));
        const float lbr = ea * cb, lbi = ea * sb;
        const float nr = em1 * cb - 2.f * sh * sh, ni = ea * sb;
        const float den = lr * lr + li * li;
        const float qr = (nr * lr + ni * li) / den, qi = (ni * lr - nr * li) / den;
        f32x2* BB = (f32x2*)(p.ws + T_BBAR);
#pragma unroll
        for (int s = 0; s < 16; ++s) { const float br = p.in[16][e * 16 + s], bi = p.in[17][e * 16 + s]; BB[e * 16 + s] = (f32x2){qr * br - qi * bi, qr * bi + qi * br}; }
        f32x2* POW = (f32x2*)(p.ws + H_POW) + (size_t)dg * 33 * 64 + (e & 63);
        float pr = 1.f, pi = 0.f;
        for (int q = 0; q <= 32; ++q) { POW[q * 64] = (f32x2){pr, pi}; const float nr2 = pr * lbr - pi * lbi, ni2 = pr * lbi + pi * lbr; pr = nr2; pi = ni2; }
    }
}

DI void modulate_rows(const Params& p, int layer, int which, bool from_inputs, int r0) {
    const int tid_ = get_tid(); const int lane = tid_ & 63, wid = tid_ >> 6;
    const float* gain = p.in[which ? 7 : 6] + layer * 1024;
    const float* modl = (const float*)(p.ws + T_MOD) + layer * 3 * 6144 + (which ? 3072 : 0);
    const float* H = (const float*)(p.ws + OFF_H);
    bf16_t* dst = (bf16_t*)(p.ws + OFF_A0);
    const int stride = gridDim.x * NWV;
    for (int ra = r0 + blockIdx.x * NWV + wid; ra < NR; ra += 2 * stride) {
        const int rb = ra + stride; const bool hb = rb < NR; const int rbb = hb ? rb : ra;
        const float* srca = from_inputs ? (ra < NCTX ? p.in[2] + (size_t)ra * 1024 : p.in[0] + (size_t)(ra - NCTX) * 1024) : H + (size_t)ra * 1024;
        const float* srcb = from_inputs ? (rbb < NCTX ? p.in[2] + (size_t)rbb * 1024 : p.in[0] + (size_t)(rbb - NCTX) * 1024) : H + (size_t)rbb * 1024;
        f32x4 xa[4], xb[4]; float sa = 0.f, sb = 0.f;
#pragma unroll
        for (int i = 0; i < 4; ++i) { xa[i] = *(const f32x4*)(srca + i * 256 + lane * 4); xb[i] = *(const f32x4*)(srcb + i * 256 + lane * 4); }
#pragma unroll
        for (int i = 0; i < 4; ++i) { sa += xa[i][0] * xa[i][0] + xa[i][1] * xa[i][1] + xa[i][2] * xa[i][2] + xa[i][3] * xa[i][3];
                                      sb += xb[i][0] * xb[i][0] + xb[i][1] * xb[i][1] + xb[i][2] * xb[i][2] + xb[i][3] * xb[i][3]; }
        sa = wave_sum(sa); sb = wave_sum(sb);
        const float rsa = rsqrtf(sa * (1.f / 1024.f) + 1e-6f), rsb = rsqrtf(sb * (1.f / 1024.f) + 1e-6f);
        const float* mva = modl + row_vec(ra) * 6144; const float* mvb = modl + row_vec(rbb) * 6144;
#pragma unroll
        for (int i = 0; i < 4; ++i) { const int c = i * 256 + lane * 4;
            const f32x4 g = *(const f32x4*)(gain + c);
            { const f32x4 sh = *(const f32x4*)(mva + c), sc = *(const f32x4*)(mva + 1024 + c); const f32x4 y = xa[i] * rsa * g * (1.f + sc) + sh;
              *(u32x2*)(dst + (size_t)ra * 1024 + c) = (u32x2){pk2(y[0], y[1]), pk2(y[2], y[3])}; }
            if (hb) { const f32x4 sh = *(const f32x4*)(mvb + c), sc = *(const f32x4*)(mvb + 1024 + c); const f32x4 y = xb[i] * rsb * g * (1.f + sc) + sh;
              *(u32x2*)(dst + (size_t)rb * 1024 + c) = (u32x2){pk2(y[0], y[1]), pk2(y[2], y[3])}; } }
    }
}

template <class Epi>
DI void gemm_phase(char* lds, const bf16_t* A0_, int lda, const bf16_t* Bt0_, int K, int mt0, int nmt, int nnt, const Epi& epi, int nbatch = 1, size_t sA = 0, size_t sB = 0, int ksplit = 1) {
    const int tid = get_tid(), lane = tid & 63, wid = tid >> 6, wr = wid >> 2, wc = wid & 3, fr = lane & 15, fq = lane >> 4;
    const int nk = (K >> 6) / ksplit;
    const int lrow = tid >> 3, lc = tid & 7, lkc = lc * 8;
    const int woff = lrow * 128 + ((lc ^ ((lrow >> 1) & 7)) << 4);
    const int ra0 = (wr * 128 + fr) * 128 + ((fq ^ (fr >> 1)) << 4);
    const int ra1 = (wr * 128 + fr) * 128 + (((4 + fq) ^ (fr >> 1)) << 4);
    const int rb0 = 32768 + (wc * 64 + fr) * 128 + ((fq ^ (fr >> 1)) << 4);
    const int rb1 = 32768 + (wc * 64 + fr) * 128 + (((4 + fq) ^ (fr >> 1)) << 4);
    const int per = nmt * nnt, ntile = nbatch * per * ksplit;
    const int myn = ((int)blockIdx.x < ntile) ? (ntile - (int)blockIdx.x + (int)gridDim.x - 1) / (int)gridDim.x : 0;
    const int total = myn * nk;
    f32x4 acc[8][4];
#pragma unroll
    for (int m = 0; m < 8; ++m)
#pragma unroll
        for (int n = 0; n < 4; ++n) acc[m][n] = (f32x4){0.f, 0.f, 0.f, 0.f};
    u32x4 sa[4], sb[4];
    int iti = 0, ikt = 0;
    const bf16_t* Ag = A0_; const bf16_t* Bg = Bt0_;
#define G_ISSUE() do { if (ikt == 0) { const int u_ = blockIdx.x + iti * gridDim.x; const int t_ = u_ / ksplit, sl_ = u_ - t_ * ksplit; const int gb_ = t_ / per, tr_ = t_ - gb_ * per; const int tm_ = tr_ / nnt, tn_ = tr_ - tm_ * nnt; \
            Ag = A0_ + (size_t)gb_ * sA + (size_t)((mt0 + tm_) * 256 + lrow) * lda + lkc + sl_ * nk * 64; Bg = Bt0_ + (size_t)gb_ * sB + (size_t)(tn_ * 256 + lrow) * K + lkc + sl_ * nk * 64; } \
        _Pragma("unroll") for (int i = 0; i < 4; ++i) { sa[i] = *(const u32x4*)(Ag + (size_t)i * 64 * lda + ikt * 64); sb[i] = *(const u32x4*)(Bg + (size_t)i * 64 * K + ikt * 64); } \
        if (++ikt == nk) { ikt = 0; ++iti; } } while (0)
#define G_WRITE(bufoff) do { _Pragma("unroll") for (int i = 0; i < 4; ++i) { *(u32x4*)(lds + (bufoff) + woff + i * 8192) = sa[i]; *(u32x4*)(lds + (bufoff) + 32768 + woff + i * 8192) = sb[i]; } } while (0)
#define G_COMPUTE(bufoff) do { _Pragma("unroll") for (int ks = 0; ks < 2; ++ks) { bf16x8 a[8], b[4]; \
        _Pragma("unroll") for (int m = 0; m < 8; ++m) a[m] = *(const bf16x8*)(lds + (bufoff) + (ks ? ra1 : ra0) + m * 2048); \
        _Pragma("unroll") for (int n = 0; n < 4; ++n) b[n] = *(const bf16x8*)(lds + (bufoff) + (ks ? rb1 : rb0) + n * 2048); \
        _Pragma("unroll") for (int m = 0; m < 8; ++m) _Pragma("unroll") for (int n = 0; n < 4; ++n) acc[m][n] = __builtin_amdgcn_mfma_f32_16x16x32_bf16(b[n], a[m], acc[m][n], 0, 0, 0); } } while (0)
    __syncthreads();
    if (total > 0) {
        G_ISSUE(); G_WRITE(0);
        if (total > 1) G_ISSUE();
    }
    __syncthreads();
    int cti = 0, ckt = 0;
    for (int q = 0; q < total; ++q) {
        const int cur = (q & 1) * 65536;
        if (q + 1 < total) G_WRITE(cur ^ 65536);
        if (q + 2 < total) G_ISSUE();
        G_COMPUTE(cur);
        __syncthreads();
        if (++ckt == nk) {
            const int u_ = blockIdx.x + cti * gridDim.x; const int t_ = u_ / ksplit; const int gb_ = t_ / per, tr_ = t_ - gb_ * per; const int tm_ = tr_ / nnt, tn_ = tr_ - tm_ * nnt;
            epi(acc, (mt0 + tm_) * 256 + wr * 128 + fr, tn_ * 256 + wc * 64 + fq * 4, gb_);
#pragma unroll
            for (int m = 0; m < 8; ++m)
#pragma unroll
                for (int n = 0; n < 4; ++n) acc[m][n] = (f32x4){0.f, 0.f, 0.f, 0.f};
            ckt = 0; ++cti;
        }
    }
#undef G_ISSUE
#undef G_WRITE
#undef G_COMPUTE
}

template <int KSP>
DI void thin_gemm_ctx(char* lds, const bf16_t* A, int lda, const bf16_t* Bt, int K, const float* res, float* dst, const float* gate) {
    const int tid = get_tid(), lane = tid & 63, wid = tid >> 6, fr = lane & 15, fq = lane >> 4;
    float* part = (float*)lds;
    for (int t = blockIdx.x; t < 256; t += gridDim.x) {
        const int m0 = (t >> 5) * 64, n0 = (t & 31) * 32;
        f32x4 acc[4][2];
#pragma unroll
        for (int m = 0; m < 4; ++m) { acc[m][0] = (f32x4){0.f, 0.f, 0.f, 0.f}; acc[m][1] = (f32x4){0.f, 0.f, 0.f, 0.f}; }
        const bf16_t* Ap = A + (size_t)(m0 + fr) * lda + wid * (KSP * 32) + fq * 8;
        const bf16_t* Bp = Bt + (size_t)(n0 + fr) * K + wid * (KSP * 32) + fq * 8;
#pragma unroll
        for (int k = 0; k < KSP; ++k) {
            bf16x8 a[4], b[2];
#pragma unroll
            for (int m = 0; m < 4; ++m) a[m] = *(const bf16x8*)(Ap + (size_t)m * 16 * lda + k * 32);
#pragma unroll
            for (int n = 0; n < 2; ++n) b[n] = *(const bf16x8*)(Bp + (size_t)n * 16 * K + k * 32);
#pragma unroll
            for (int m = 0; m < 4; ++m)
#pragma unroll
                for (int n = 0; n < 2; ++n) acc[m][n] = __builtin_amdgcn_mfma_f32_16x16x32_bf16(b[n], a[m], acc[m][n], 0, 0, 0);
        }
        __syncthreads();
#pragma unroll
        for (int m = 0; m < 4; ++m)
#pragma unroll
            for (int n = 0; n < 2; ++n) *(f32x4*)(part + ((wid * 64 + m * 16 + fr) * 32 + n * 16 + fq * 4)) = acc[m][n];
        __syncthreads();
        { const int row = tid >> 3, c4 = (tid & 7) * 4; f32x4 sum = (f32x4){0.f, 0.f, 0.f, 0.f};
#pragma unroll
          for (int w = 0; w < 8; ++w) sum += *(const f32x4*)(part + ((w * 64 + row) * 32 + c4));
          const size_t off = (size_t)(m0 + row) * 1024 + n0 + c4;
          const f32x4 g = *(const f32x4*)(gate + 2 * 6144 + n0 + c4), x = *(const f32x4*)(res + off);
          *(f32x4*)(dst + off) = x + g * sum; }
    }
    __syncthreads();
}

struct EpiWin0 {
    bf16_t* UA; float* CQKV; float* KR;
    DI void operator()(const f32x4 (&acc)[8][4], int row0, int col0, int gb) const {
#pragma unroll
        for (int m = 0; m < 8; ++m) { const int ri = row0 + m * 16; const size_t r = ri; const int b = row_batch(ri), tp = row_tpos(ri);
#pragma unroll
            for (int n = 0; n < 4; ++n) { const int c = col0 + n * 16; const f32x4 v = acc[m][n];
                if (c < 512) { const int g = c >> 4, s0 = c & 15;
                    *(u32x2*)(UA + ((size_t)g * CHR + b * NCK + (tp >> 5)) * 768 + (tp & 31) * 16 + s0) = (u32x2){pk2(v[0], v[1]), pk2(v[2], v[3])}; }
                else if (c < 1152) *(f32x4*)(CQKV + r * 640 + (c - 512)) = v;
                else if (c < 1216) *(f32x4*)(KR + r * 64 + (c - 1152)) = v; } }
    }
};
struct EpiS1a {
    float* E;
    DI void operator()(const f32x4 (&acc)[8][4], int row0, int col0, int gb) const {
#pragma unroll
        for (int m = 0; m < 8; ++m) { const int r = row0 + m * 16; if (r >= CHR) continue;
#pragma unroll
            for (int n = 0; n < 4; ++n) *(f32x4*)(E + ((size_t)gb * CHR + r) * 256 + col0 + n * 16) = acc[m][n]; }
    }
};
struct EpiS1b {
    bf16_t* YG;
    DI void operator()(const f32x4 (&acc)[8][4], int row0, int col0, int gb) const {
#pragma unroll
        for (int m = 0; m < 8; ++m) { const int r = row0 + m * 16; if (r >= CHR) continue; const int b = r / NCK, c = r % NCK;
#pragma unroll
            for (int n = 0; n < 4; ++n) { const int cc = col0 + n * 16; const int tl = cc >> 4, s0 = cc & 15; const f32x4 v = acc[m][n];
                const int tp = c * SL + tl; const size_t row = tp < CTX ? (size_t)b * CTX + tp : (size_t)NCTX + (size_t)b * SEQ + (tp - CTX);
                *(u32x2*)(YG + row * 512 + gb * 16 + s0) = (u32x2){pk2(gelu_tanh(v[0]), gelu_tanh(v[1])), pk2(gelu_tanh(v[2]), gelu_tanh(v[3]))}; } }
    }
};
struct EpiBf16 {
    bf16_t* O; int ldo;
    DI void operator()(const f32x4 (&acc)[8][4], int row0, int col0, int gb) const {
#pragma unroll
        for (int m = 0; m < 8; ++m) { const size_t r = row0 + m * 16;
#pragma unroll
            for (int n = 0; n < 4; ++n) { const int c = col0 + n * 16; const f32x4 v = acc[m][n];
                *(u32x2*)(O + r * ldo + c) = (u32x2){pk2(v[0], v[1]), pk2(v[2], v[3])}; } }
    }
};
struct EpiKV {
    bf16_t* KNOPE; bf16_t* VT;
    DI void operator()(const f32x4 (&acc)[8][4], int row0, int col0, int gb) const {
#pragma unroll
        for (int m = 0; m < 8; ++m) { const int r = row0 + m * 16; const int b = row_batch(r), tp = row_tpos(r);
#pragma unroll
            for (int n = 0; n < 4; ++n) { const int c = col0 + n * 16; const int h = c >> 8, w = c & 255; const f32x4 v = acc[m][n];
                if (w < 128) *(u32x2*)(KNOPE + (size_t)r * 512 + h * 128 + w) = (u32x2){pk2(v[0], v[1]), pk2(v[2], v[3])};
                else { bf16_t* d = VT + ((size_t)(b * 4 + h) * 128 + (w - 128)) * TK + tp; const unsigned p0 = pk2(v[0], v[1]), p1 = pk2(v[2], v[3]);
                    d[0] = (bf16_t)(p0 & 0xffff); d[TK] = (bf16_t)(p0 >> 16); d[2 * TK] = (bf16_t)(p1 & 0xffff); d[3 * TK] = (bf16_t)(p1 >> 16); } } }
    }
};
struct EpiGLU {
    const bf16_t* YG; const float* bias; bf16_t* CAT;
    DI void operator()(const f32x4 (&acc)[8][4], int row0, int col0, int gb) const {
#pragma unroll
        for (int m = 0; m < 8; ++m) { const size_t r = row0 + m * 16;
#pragma unroll
            for (int n = 0; n < 4; ++n) { const int c = col0 + n * 16; const f32x4 v = acc[m][n]; const f32x4 bv = *(const f32x4*)(bias + c);
                const u32x2 yy = *(const u32x2*)(YG + r * 512 + c);
                const float y0 = __uint_as_float(yy[0] << 16), y1 = __uint_as_float(yy[0] & 0xffff0000u), y2 = __uint_as_float(yy[1] << 16), y3 = __uint_as_float(yy[1] & 0xffff0000u);
                const float o0 = y0 * sigmoidf_(v[0] + bv[0]), o1 = y1 * sigmoidf_(v[1] + bv[1]), o2 = y2 * sigmoidf_(v[2] + bv[2]), o3 = y3 * sigmoidf_(v[3] + bv[3]);
                *(u32x2*)(CAT + r * 1024 + c) = (u32x2){pk2(o0, o1), pk2(o2, o3)}; } }
    }
};
struct EpiRes {
    const float* res_ctx; const float* res_lat; float* dst_ctx; float* dst_lat; const float* gate; int atomic;
    DI void operator()(const f32x4 (&acc)[8][4], int row0, int col0, int gb) const {
#pragma unroll
        for (int m = 0; m < 8; ++m) { const int r = row0 + m * 16;
            const float* rs = r < NCTX ? res_ctx + (size_t)r * 1024 : res_lat + (size_t)(r - NCTX) * 1024;
            float* ds = r < NCTX ? dst_ctx + (size_t)r * 1024 : dst_lat + (size_t)(r - NCTX) * 1024;
            if (r < NCTX && dst_ctx == nullptr) continue;
            const float* gv = gate + row_vec(r) * 6144;
#pragma unroll
            for (int n = 0; n < 4; ++n) { const int c = col0 + n * 16; const f32x4 g = *(const f32x4*)(gv + c);
                if (atomic) { const f32x4 v = g * acc[m][n];
#pragma unroll
                    for (int j = 0; j < 4; ++j) (void)__hip_atomic_fetch_add(ds + c + j, v[j], __ATOMIC_RELAXED, __HIP_MEMORY_SCOPE_AGENT); }
                else { const f32x4 x = *(const f32x4*)(rs + c); *(f32x4*)(ds + c) = x + g * acc[m][n]; } } }
    }
};
struct EpiSwiGLU {
    bf16_t* HID;
    DI void operator()(const f32x4 (&acc)[8][4], int row0, int col0, int gb) const {
        const int hc = (col0 >> 6) * 32 + (col0 & 15);
#pragma unroll
        for (int m = 0; m < 8; ++m) { const size_t r = row0 + m * 16;
#pragma unroll
            for (int q = 0; q < 2; ++q) { const f32x4 g = acc[m][2 * q], u = acc[m][2 * q + 1];
                const float o0 = siluf_(g[0]) * u[0], o1 = siluf_(g[1]) * u[1], o2 = siluf_(g[2]) * u[2], o3 = siluf_(g[3]) * u[3];
                *(u32x2*)(HID + r * FH + hc + q * 16) = (u32x2){pk2(o0, o1), pk2(o2, o3)}; } }
    }
};
struct EpiWin1 {
    bf16_t* Q; bf16_t* K1; bf16_t* VT; const float* qn; const float* kn; const float* ROPE;
    DI void operator()(const f32x4 (&acc)[8][4], int row0, int col0, int gb) const {
        const int cw = col0 & ~63, i0 = col0 & 15;
        if (cw >= 1280) {
#pragma unroll
            for (int m = 0; m < 8; ++m) { const int r = row0 + m * 16; const int b = row_batch(r), tp = row_tpos(r);
#pragma unroll
                for (int n = 0; n < 4; ++n) { const int cc = col0 + n * 16 - 1280, h = cc >> 6, d0 = cc & 63; const f32x4 v = acc[m][n];
                    bf16_t* d = VT + ((size_t)(b * 4 + h) * 64 + d0) * TK + tp; const unsigned p0 = pk2(v[0], v[1]), p1 = pk2(v[2], v[3]);
                    d[0] = (bf16_t)(p0 & 0xffff); d[TK] = (bf16_t)(p0 >> 16); d[2 * TK] = (bf16_t)(p1 & 0xffff); d[3 * TK] = (bf16_t)(p1 >> 16); } }
            return;
        }
        const bool isq = cw < 1024;
        const float* gn = isq ? qn : kn;
        f32x4 g[4];
#pragma unroll
        for (int n = 0; n < 4; ++n) g[n] = *(const f32x4*)(gn + n * 16 + i0);
        const float osc = isq ? 0.125f * LOG2E : 1.f;
#pragma unroll
        for (int m = 0; m < 8; ++m) { const int r = row0 + m * 16; const bool lat = r >= NCTX;
            if (isq && !lat) continue;
            const int b = row_batch(r), tp = row_tpos(r), t = tp - CTX;
            float ss = 0.f;
#pragma unroll
            for (int n = 0; n < 4; ++n) { const f32x4 v = acc[m][n]; ss += v[0] * v[0] + v[1] * v[1] + v[2] * v[2] + v[3] * v[3]; }
            ss += __shfl_xor(ss, 16); ss += __shfl_xor(ss, 32);
            const float rstd = rsqrtf(ss * (1.f / 64.f) + 1e-6f);
            f32x4 y[4];
#pragma unroll
            for (int n = 0; n < 4; ++n) y[n] = acc[m][n] * rstd * g[n];
            if (lat) { const float* rr = ROPE + ((t >> 6) * 16 + i0) * 2; const float* rc = ROPE + ((t & 63) * 16 + i0) * 2;
#pragma unroll
                for (int j = 0; j < 4; ++j) { const float c0 = rr[2 * j], s0 = rr[2 * j + 1], c1 = rc[2 * j], s1 = rc[2 * j + 1];
                    const float a0 = y[0][j], a1 = y[1][j], a2 = y[2][j], a3 = y[3][j];
                    y[0][j] = a0 * c0 - a1 * s0; y[1][j] = a1 * c0 + a0 * s0; y[2][j] = a2 * c1 - a3 * s1; y[3][j] = a3 * c1 + a2 * s1; } }
            bf16_t* dst = isq ? Q + (size_t)r * 1024 + cw + i0 : K1 + ((size_t)(b * 4 + ((cw - 1024) >> 6)) * TK + tp) * 64 + i0;
#pragma unroll
            for (int n = 0; n < 4; ++n) *(u32x2*)(dst + n * 16) = (u32x2){pk2(y[n][0] * osc, y[n][1] * osc), pk2(y[n][2] * osc, y[n][3] * osc)};
        }
    }
};

template <int DQK, int DV, bool WIN>
DI void attn_item(char* lds, const bf16_t* Q, int qstride, const bf16_t* Kb, const bf16_t* VTb, int ta0, int ta1, int tb0, int tb1,
                  float m_init, float l_init, bf16_t* O, int ostride, int qpos0) {
    constexpr int NKS = DQK / 16, NDT = DV / 32, KSTR = DQK + 8, VSTR = 68;
    constexpr int KCH = 64 * DQK / 8 / NTHREADS, VCH = DV * 8 / NTHREADS;
    bf16_t* Ks = (bf16_t*)lds; bf16_t* Vs = Ks + 64 * KSTR;
    const int tid = get_tid(), lane = tid & 63, wid = tid >> 6, r = lane & 31, h2 = lane >> 5;
    bf16x8 qf[NKS];
    { const bf16_t* qrow = Q + (size_t)(wid * 32 + r) * qstride + 8 * h2;
#pragma unroll
      for (int ks = 0; ks < NKS; ++ks) qf[ks] = *(const bf16x8*)(qrow + 16 * ks); }
    f32x16 o[NDT];
#pragma unroll
    for (int dt = 0; dt < NDT; ++dt)
#pragma unroll
        for (int i = 0; i < 16; ++i) o[dt][i] = 0.f;
    float mrun = m_init, lrun = (h2 == 0) ? l_init : 0.f;
    const int na = ta1 - ta0, ntot = na + (tb1 - tb0);
    u32x4 kr[KCH], vr[VCH];
    constexpr int KTPR = (DQK / 8) / KCH;
    constexpr int VTPR = 8 / VCH;
    const int krow = tid / KTPR, kcol = (tid % KTPR) * (KCH * 8);
    const int vrow = tid / VTPR, vcol = (tid % VTPR) * (VCH * 8);
    const bf16_t* kgp = Kb + (size_t)krow * DQK + kcol;
    const bf16_t* vgp = VTb + (size_t)vrow * TK + vcol;
    bf16_t* ksp = Ks + krow * KSTR + kcol;
    bf16_t* vsp = Vs + vrow * VSTR + vcol;
    constexpr int KVB = 64 * KSTR + DV * VSTR;
#define A_LOAD(Tv) do { const bf16_t* kg = kgp + (size_t)(Tv) * 64 * DQK; const bf16_t* vg = vgp + (Tv) * 64; \
        _Pragma("unroll") for (int i = 0; i < KCH; ++i) kr[i] = *(const u32x4*)(kg + i * 8); \
        _Pragma("unroll") for (int i = 0; i < VCH; ++i) vr[i] = *(const u32x4*)(vg + i * 8); } while (0)
#define A_WRITE(bo) do { _Pragma("unroll") for (int i = 0; i < KCH; ++i) *(u32x4*)(ksp + (bo) + i * 8) = kr[i]; \
        _Pragma("unroll") for (int i = 0; i < VCH; ++i) { *(u32x2*)(vsp + (bo) + i * 8) = (u32x2){vr[i][0], vr[i][1]}; *(u32x2*)(vsp + (bo) + i * 8 + 4) = (u32x2){vr[i][2], vr[i][3]}; } } while (0)
#define A_TILE(itv) (((itv) < na) ? ta0 + (itv) : tb0 + ((itv) - na))
    __syncthreads();
    A_LOAD(A_TILE(0)); A_WRITE(0);
    if (1 < ntot) A_LOAD(A_TILE(1));
    __syncthreads();
    for (int it = 0; it < ntot; ++it) {
        const int T = A_TILE(it);
        const int cb = (it & 1) * KVB;
        if (it + 1 < ntot) A_WRITE(KVB - cb);
        if (it + 2 < ntot) A_LOAD(A_TILE(it + 2));
        bool active = true;
        if (WIN && T >= 4) {
            const int klo = (T - 4) * 64, qlo = qpos0 + wid * 32;
            if (klo > qlo + 31 + 128 || klo + 63 < qlo - 128) active = false;
        }
        if (active) {
        const bf16_t* Ksc = Ks + cb; const bf16_t* Vsc = Vs + cb;
        f32x16 s0, s1;
#pragma unroll
        for (int i = 0; i < 16; ++i) { s0[i] = 0.f; s1[i] = 0.f; }
        {
            constexpr int NG = NKS / 2;
            bf16x8 kf[2][4];
            const bf16_t* kb0 = Ksc + r * KSTR + 8 * h2; const bf16_t* kb1 = Ksc + (32 + r) * KSTR + 8 * h2;
            kf[0][0] = *(const bf16x8*)(kb0); kf[0][1] = *(const bf16x8*)(kb1); kf[0][2] = *(const bf16x8*)(kb0 + 16); kf[0][3] = *(const bf16x8*)(kb1 + 16);
#pragma unroll
            for (int g = 0; g < NG; ++g) {
                if (g + 1 < NG) { kf[(g + 1) & 1][0] = *(const bf16x8*)(kb0 + 32 * (g + 1)); kf[(g + 1) & 1][1] = *(const bf16x8*)(kb1 + 32 * (g + 1));
                                  kf[(g + 1) & 1][2] = *(const bf16x8*)(kb0 + 32 * (g + 1) + 16); kf[(g + 1) & 1][3] = *(const bf16x8*)(kb1 + 32 * (g + 1) + 16); }
                __builtin_amdgcn_sched_barrier(0);
                s0 = __builtin_amdgcn_mfma_f32_32x32x16_bf16(kf[g & 1][0], qf[2 * g], s0, 0, 0, 0);
                s1 = __builtin_amdgcn_mfma_f32_32x32x16_bf16(kf[g & 1][1], qf[2 * g], s1, 0, 0, 0);
                s0 = __builtin_amdgcn_mfma_f32_32x32x16_bf16(kf[g & 1][2], qf[2 * g + 1], s0, 0, 0, 0);
                s1 = __builtin_amdgcn_mfma_f32_32x32x16_bf16(kf[g & 1][3], qf[2 * g + 1], s1, 0, 0, 0);
                __builtin_amdgcn_sched_barrier(0);
            }
        }
        if (WIN && T >= 4) {
            const int qp = qpos0 + wid * 32 + r, kp0 = (T - 4) * 64 + 4 * h2;
#pragma unroll
            for (int i = 0; i < 16; ++i) { const int d0 = kp0 + (i & 3) + 8 * (i >> 2) - qp, d1 = d0 + 32;
                if (d0 > 128 || d0 < -128) s0[i] = -1e30f;
                if (d1 > 128 || d1 < -128) s1[i] = -1e30f; }
        }
        float mx = fmaxf(s0[0], s1[0]);
#pragma unroll
        for (int i = 1; i < 16; ++i) mx = fmaxf(mx, fmaxf(s0[i], s1[i]));
        mx = fmaxf(mx, __shfl_xor(mx, 32));
        if (__builtin_amdgcn_ballot_w64(mx > mrun + 8.f) != 0ull) {
            const float mn = fmaxf(mrun, mx);
            const float alpha = __builtin_amdgcn_exp2f(mrun - mn);
            mrun = mn; lrun *= alpha;
#pragma unroll
            for (int dt = 0; dt < NDT; ++dt)
#pragma unroll
                for (int i = 0; i < 16; ++i) o[dt][i] *= alpha;
        }
        float rs = 0.f;
#pragma unroll
        for (int i = 0; i < 16; ++i) { s0[i] = __builtin_amdgcn_exp2f(s0[i] - mrun); s1[i] = __builtin_amdgcn_exp2f(s1[i] - mrun); rs += s0[i] + s1[i]; }
        lrun += rs;
        {
            bf16x8 vf[2][NDT];
#define V_LOAD(dstv, q_) do { _Pragma("unroll") for (int dt = 0; dt < NDT; ++dt) { const bf16_t* vp = Vsc + (32 * dt + r) * VSTR + 16 * (q_) + 4 * h2; \
                const s16x4 lo = *(const s16x4*)vp, hi = *(const s16x4*)(vp + 8); dstv[dt] = __builtin_shufflevector(lo, hi, 0, 1, 2, 3, 4, 5, 6, 7); } } while (0)
            V_LOAD(vf[0], 0);
#pragma unroll
            for (int q = 0; q < 4; ++q) {
                if (q + 1 < 4) V_LOAD(vf[(q + 1) & 1], q + 1);
                const int st = q & 1;
                u32x4 pw;
                if (q < 2) { pw[0] = pk2(s0[8 * st + 0], s0[8 * st + 1]); pw[1] = pk2(s0[8 * st + 2], s0[8 * st + 3]); pw[2] = pk2(s0[8 * st + 4], s0[8 * st + 5]); pw[3] = pk2(s0[8 * st + 6], s0[8 * st + 7]); }
                else { pw[0] = pk2(s1[8 * st + 0], s1[8 * st + 1]); pw[1] = pk2(s1[8 * st + 2], s1[8 * st + 3]); pw[2] = pk2(s1[8 * st + 4], s1[8 * st + 5]); pw[3] = pk2(s1[8 * st + 6], s1[8 * st + 7]); }
                const bf16x8 pf = __builtin_bit_cast(bf16x8, pw);
                __builtin_amdgcn_sched_barrier(0);
#pragma unroll
                for (int dt = 0; dt < NDT; ++dt) o[dt] = __builtin_amdgcn_mfma_f32_32x32x16_bf16(vf[q & 1][dt], pf, o[dt], 0, 0, 0);
                __builtin_amdgcn_sched_barrier(0);
            }
#undef V_LOAD
        }
        }
        __syncthreads();
    }
#undef A_LOAD
#undef A_WRITE
#undef A_TILE
    lrun += __shfl_xor(lrun, 32);
    const float inv = 1.f / lrun;
    bf16_t* orow = O + (size_t)(wid * 32 + r) * ostride;
#pragma unroll
    for (int dt = 0; dt < NDT; ++dt)
#pragma unroll
        for (int g = 0; g < 4; ++g)
            *(u32x2*)(orow + 32 * dt + 8 * g + 4 * h2) = (u32x2){pk2(o[dt][4 * g] * inv, o[dt][4 * g + 1] * inv), pk2(o[dt][4 * g + 2] * inv, o[dt][4 * g + 3] * inv)};
    __syncthreads();
}

DI void s5_kk_phase(char* lds, const Params& p) {
    const int tid512 = get_tid(); const int tid = tid512 & 255, s = tid >> 4, sp = tid & 15, dh = tid512 >> 8;
    f32x2* sbb = (f32x2*)lds;
    f32x2* scc = sbb + 1024;
    f32x2* spw = scc + 1024;
    const f32x2* POW = (const f32x2*)(p.ws + H_POW); const f32x2* BB = (const f32x2*)(p.ws + T_BBAR); float* KK = (float*)(p.ws + H_KK);
    for (int it = blockIdx.x; it < 32 * 2 * 4; it += gridDim.x) {
        const int dq = it & 3, dir = (it >> 2) & 1, g = it >> 3; const int dg = dir * 32 + g;
        __syncthreads();
        for (int i = tid512; i < 1024; i += NTHREADS) { sbb[i] = BB[(size_t)dg * 1024 + i]; scc[i] = (f32x2){p.in[18][(size_t)dg * 1024 + i], p.in[19][(size_t)dg * 1024 + i]}; }
        { const int i = tid512; spw[i] = POW[((size_t)dg * 33 + dq * 8 + (i >> 6)) * 64 + (i & 63)]; }
        __syncthreads();
        float acc[4] = {0.f, 0.f, 0.f, 0.f};
#pragma unroll 4
        for (int pp = 0; pp < 64; ++pp) { const f32x2 bb = sbb[pp * 16 + sp], cc = scc[s * 64 + pp];
#pragma unroll
            for (int q = 0; q < 4; ++q) { const f32x2 pw = spw[(dh * 4 + q) * 64 + pp];
                const float zr = pw[0] * bb[0] - pw[1] * bb[1], zi = pw[0] * bb[1] + pw[1] * bb[0];
                acc[q] += cc[0] * zr - cc[1] * zi; } }
#pragma unroll
        for (int q = 0; q < 4; ++q) KK[(size_t)((g * 2 + dir) * 32 + dq * 8 + dh * 4 + q) * 256 + tid] = acc[q];
    }
    __syncthreads();
}
DI void s5_w1a_phase(const Params& p) {
    const int tid = get_tid();
    const f32x2* POW = (const f32x2*)(p.ws + H_POW); const f32x2* BB = (const f32x2*)(p.ws + T_BBAR); bf16_t* W = (bf16_t*)(p.ws + H_W1A);
    for (int idx = blockIdx.x * NTHREADS + tid; idx < 2048 * 256; idx += gridDim.x * NTHREADS) {
        const int kq = idx & 63, n = (idx >> 6) & 255, g = idx >> 14;
        const int dir = n >> 7, ri = (n >> 6) & 1, pp = n & 63; const int e = (dir * 32 + g) * 64 + pp; const int tl = kq >> 1, s0 = (kq & 1) * 8;
        const f32x2 pw = POW[((size_t)(dir * 32 + g) * 33 + (dir ? tl : 31 - tl)) * 64 + pp];
        float v[8];
#pragma unroll
        for (int j = 0; j < 8; ++j) { const f32x2 bb = BB[e * 16 + s0 + j]; v[j] = ri ? pw[0] * bb[1] + pw[1] * bb[0] : pw[0] * bb[0] - pw[1] * bb[1]; }
        *(u32x4*)(W + ((size_t)g * 256 + n) * 512 + kq * 8) = (u32x4){pk2(v[0], v[1]), pk2(v[2], v[3]), pk2(v[4], v[5]), pk2(v[6], v[7])};
    }
}
DI void s5_w1b_phase(const Params& p) {
    const int tid = get_tid();
    const f32x2* POW = (const f32x2*)(p.ws + H_POW); const float* KK = (const float*)(p.ws + H_KK); bf16_t* W = (bf16_t*)(p.ws + A_W1B);
    for (int idx = blockIdx.x * NTHREADS + tid; idx < 6144 * 256; idx += gridDim.x * NTHREADS) {
        const int kq = idx % 96, n = (idx / 96) & 511, g = idx / (96 * 512);
        const int tl = n >> 4, s = n & 15;
        float v[8];
        if (kq < 64) { const int tl2 = kq >> 1, s0 = (kq & 1) * 8;
            f32x4 x0 = {0.f, 0.f, 0.f, 0.f}, x1 = x0;
            if (tl2 <= tl) { const float* k0 = KK + (size_t)((g * 2 + 0) * 32 + (tl - tl2)) * 256 + s * 16 + s0; x0 += *(const f32x4*)k0; x1 += *(const f32x4*)(k0 + 4); }
            if (tl2 >= tl) { const float* k1 = KK + (size_t)((g * 2 + 1) * 32 + (tl2 - tl)) * 256 + s * 16 + s0; x0 += *(const f32x4*)k1; x1 += *(const f32x4*)(k1 + 4); }
#pragma unroll
            for (int j = 0; j < 4; ++j) { v[j] = x0[j]; v[4 + j] = x1[j]; }
            if (tl2 == tl && (s >> 3) == (kq & 1)) { const float dv = p.in[20][g * 16 + s];
#pragma unroll
                for (int j = 0; j < 8; ++j) if (j == (s & 7)) v[j] += dv; }
        } else { const int k2 = (kq - 64) * 8; const int dir = k2 >> 7, ri = (k2 >> 6) & 1, p0 = k2 & 63;
            const float* cre = p.in[18] + ((size_t)(dir * 32 + g) * 16 + s) * 64 + p0; const float* cim = p.in[19] + ((size_t)(dir * 32 + g) * 16 + s) * 64 + p0;
            const f32x2* pwp = POW + ((size_t)(dir * 32 + g) * 33 + (dir ? 32 - tl : tl + 1)) * 64 + p0;
            const f32x4 cr0 = *(const f32x4*)cre, cr1 = *(const f32x4*)(cre + 4), ci0 = *(const f32x4*)cim, ci1 = *(const f32x4*)(cim + 4);
#pragma unroll
            for (int j = 0; j < 8; ++j) { const f32x2 pw = pwp[j];
                const float cr = j < 4 ? cr0[j & 3] : cr1[j & 3], ci = j < 4 ? ci0[j & 3] : ci1[j & 3];
                v[j] = ri ? -(cr * pw[1] + ci * pw[0]) : cr * pw[0] - ci * pw[1]; }
        }
        *(u32x4*)(W + ((size_t)g * 512 + n) * 768 + kq * 8) = (u32x4){pk2(v[0], v[1]), pk2(v[2], v[3]), pk2(v[4], v[5]), pk2(v[6], v[7])};
    }
}
DI void s5_carry_phase(const Params& p) {
    const int tid_ = get_tid(); const int lane = tid_ & 63, wid = tid_ >> 6;
    const f32x2* POW = (const f32x2*)(p.ws + H_POW); const float* E = (const float*)(p.ws + H_E); bf16_t* UA = (bf16_t*)(p.ws + H_UA);
    for (int it = blockIdx.x * NWV + wid; it < 2 * 2 * 32; it += gridDim.x * NWV) {
        const int g = it & 31, dir = (it >> 5) & 1, b = it >> 6;
        const f32x2 l32 = POW[((size_t)(dir * 32 + g) * 33 + 32) * 64 + lane];
        float hr = 0.f, hi = 0.f;
        for (int i0 = 0; i0 < NCK; i0 += 8) {
            float er[8], ei[8];
#pragma unroll
            for (int j = 0; j < 8; ++j) { const int i = i0 + j; const int c = dir ? (i < 8 ? 7 - i : NCK - 1 - (i - 8)) : i;
                const size_t m = (size_t)g * CHR + b * NCK + c;
                er[j] = E[m * 256 + dir * 128 + lane]; ei[j] = E[m * 256 + dir * 128 + 64 + lane]; }
#pragma unroll
            for (int j = 0; j < 8; ++j) { const int i = i0 + j; const int c = dir ? (i < 8 ? 7 - i : NCK - 1 - (i - 8)) : i;
                const size_t m = (size_t)g * CHR + b * NCK + c;
                bf16_t* u = UA + m * 768 + 512 + dir * 128 + lane;
                u[0] = (bf16_t)(pk2(hr, 0.f) & 0xffff); u[64] = (bf16_t)(pk2(hi, 0.f) & 0xffff);
                const float nr = l32[0] * hr - l32[1] * hi + er[j], ni = l32[0] * hi + l32[1] * hr + ei[j];
                hr = nr; hi = ni; }
        }
    }
}

DI void qkvnorm_phase(const Params& p) {
    const int tid_ = get_tid(); const int lane = tid_ & 63, wid = tid_ >> 6;
    const float* CQKV = (const float*)(p.ws + S_CQKV);
    bf16_t* CQN = (bf16_t*)(p.ws + S_CQN); bf16_t* CKVN = (bf16_t*)(p.ws + S_CKVN);
    for (int r = blockIdx.x * NWV + wid; r < NR; r += gridDim.x * NWV) {
        const float* src = CQKV + (size_t)r * 640;
        float a[6], k[4]; float sa = 0.f, sk = 0.f;
#pragma unroll
        for (int i = 0; i < 6; ++i) { a[i] = src[lane + 64 * i]; sa += a[i] * a[i]; }
#pragma unroll
        for (int i = 0; i < 4; ++i) { k[i] = src[384 + lane + 64 * i]; sk += k[i] * k[i]; }
        sa = wave_sum(sa); sk = wave_sum(sk);
        const float ra = rsqrtf(sa * (1.f / 384.f) + 1e-6f), rk = rsqrtf(sk * (1.f / 256.f) + 1e-6f);
#pragma unroll
        for (int i = 0; i < 6; ++i) CQN[(size_t)r * 384 + lane + 64 * i] = (bf16_t)(pk2(a[i] * ra * p.in[23][lane + 64 * i], 0.f) & 0xffff);
#pragma unroll
        for (int i = 0; i < 4; ++i) CKVN[(size_t)r * 256 + lane + 64 * i] = (bf16_t)(pk2(k[i] * rk * p.in[25][lane + 64 * i], 0.f) & 0xffff);
    }
}
DI float rope64(float x, int lane, const float* ROPE, int rpos, int cpos) {
    const float partner = __shfl_xor(x, 16);
    const int i = lane & 15; const int pos = lane < 32 ? rpos : cpos;
    const float c = ROPE[(pos * 16 + i) * 2], s = ROPE[(pos * 16 + i) * 2 + 1];
    return (lane & 16) ? x * c + partner * s : x * c - partner * s;
}
DI void mla_prep_phase(const Params& p) {
    const int tid_ = get_tid(); const int lane = tid_ & 63, wid = tid_ >> 6;
    bf16_t* QR = (bf16_t*)(p.ws + S_QRAW); const bf16_t* KN = (const bf16_t*)(p.ws + S_KNOPE); const float* KR = (const float*)(p.ws + H_KR);
    bf16_t* KA = (bf16_t*)(p.ws + S_KA); const float* ROPE = (const float*)(p.ws + T_ROPE);
    const float qsc = 0.07216878364870323f * LOG2E;
    const float qg0 = p.in[27][lane], qg1 = p.in[27][64 + lane], qg2 = p.in[27][128 + lane];
    const float kg0 = p.in[28][lane], kg1 = p.in[28][64 + lane], kg2 = p.in[28][128 + lane];
    for (int r = blockIdx.x * NWV + wid; r < NR; r += gridDim.x * NWV) {
        const bool lat = r >= NCTX; const int b = row_batch(r), tp = row_tpos(r); const int t = tp - CTX;
        const int rpos = lat ? (t >> 6) : 0, cpos = lat ? (t & 63) : 0;
        const float krv = KR[(size_t)r * 64 + lane];
#pragma unroll
        for (int h = 0; h < 4; ++h) {
            bf16_t* q = QR + (size_t)r * 768 + h * 192;
            float x0 = bf2f(q[lane]), x1 = bf2f(q[64 + lane]), x2 = bf2f(q[128 + lane]);
            float ss = wave_sum(x0 * x0 + x1 * x1 + x2 * x2);
            float rs = rsqrtf(ss * (1.f / 192.f) + 1e-6f);
            x0 *= rs * qg0; x1 *= rs * qg1; x2 *= rs * qg2;
            if (lat) x2 = rope64(x2, lane, ROPE, rpos, cpos);
            q[lane] = (bf16_t)(pk2(x0 * qsc, 0.f) & 0xffff); q[64 + lane] = (bf16_t)(pk2(x1 * qsc, 0.f) & 0xffff); q[128 + lane] = (bf16_t)(pk2(x2 * qsc, 0.f) & 0xffff);
            const bf16_t* kn = KN + (size_t)r * 512 + h * 128;
            float k0 = bf2f(kn[lane]), k1 = bf2f(kn[64 + lane]), k2 = krv;
            ss = wave_sum(k0 * k0 + k1 * k1 + k2 * k2);
            rs = rsqrtf(ss * (1.f / 192.f) + 1e-6f);
            k0 *= rs * kg0; k1 *= rs * kg1; k2 *= rs * kg2;
            if (lat) k2 = rope64(k2, lane, ROPE, rpos, cpos);
            bf16_t* kd = KA + ((size_t)(b * 4 + h) * TK + tp) * 192;
            kd[lane] = (bf16_t)(pk2(k0, 0.f) & 0xffff); kd[64 + lane] = (bf16_t)(pk2(k1, 0.f) & 0xffff); kd[128 + lane] = (bf16_t)(pk2(k2, 0.f) & 0xffff);
        }
    }
}
DI void win_prep_phase(const Params& p) {
    const int tid_ = get_tid(); const int lane = tid_ & 63, wid = tid_ >> 6;
    bf16_t* Q = (bf16_t*)(p.ws + S1_Q); const float* KRAW = (const float*)(p.ws + S1_KRAW); bf16_t* K1 = (bf16_t*)(p.ws + S1_K);
    const float* ROPE = (const float*)(p.ws + T_ROPE);
    const float qsc = 0.125f * LOG2E;
    const float qg = p.in[31][lane], kg = p.in[32][lane];
    for (int r = blockIdx.x * NWV + wid; r < NR; r += gridDim.x * NWV) {
        const bool lat = r >= NCTX; const int b = row_batch(r), tp = row_tpos(r); const int t = tp - CTX;
        const int rpos = lat ? (t >> 6) : 0, cpos = lat ? (t & 63) : 0;
        if (lat) {
#pragma unroll 4
            for (int h = 0; h < 16; ++h) { bf16_t* q = Q + (size_t)r * 1024 + h * 64;
                float x = bf2f(q[lane]); const float ss = wave_sum(x * x); x *= rsqrtf(ss * (1.f / 64.f) + 1e-6f) * qg;
                x = rope64(x, lane, ROPE, rpos, cpos);
                q[lane] = (bf16_t)(pk2(x * qsc, 0.f) & 0xffff); }
        }
#pragma unroll
        for (int h = 0; h < 4; ++h) { float x = KRAW[(size_t)r * 256 + h * 64 + lane]; const float ss = wave_sum(x * x); x *= rsqrtf(ss * (1.f / 64.f) + 1e-6f) * kg;
            if (lat) x = rope64(x, lane, ROPE, rpos, cpos);
            K1[((size_t)(b * 4 + h) * TK + tp) * 64 + lane] = (bf16_t)(pk2(x, 0.f) & 0xffff); }
    }
}

__global__ void __launch_bounds__(NTHREADS, 2) fwd_kernel(Params p) {
    extern __shared__ __attribute__((aligned(16))) char lds[];
    cg::grid_group grid = cg::this_grid();
    char* ws = p.ws;
    const bf16_t* WB = (const bf16_t*)ws;
    const float* MOD = (const float*)(ws + T_MOD);
    float* H = (float*)(ws + OFF_H);
    bf16_t* A0 = (bf16_t*)(ws + OFF_A0);
    const int bid = blockIdx.x, nb = gridDim.x;
    volatile LAS unsigned* xst = (volatile LAS unsigned*)(lds + (LDS_BYTES - 16));
    if (threadIdx.x == 0) { xst[0] = 0u; xst[1] = 0u; }
    __syncthreads();
    const XcdBarrier xb = xcd_barrier_post((unsigned*)(ws + T_BAR), xst);
    if (p.pad == 0x7fffffff) grid.sync();
#define GRID_SYNC() xcd_barrier(xb)

    { const int npair = (p.njobtiles + 1) >> 1, nit = 192 + 12 + npair;
      for (int it = bid; it < nit; it += nb) {
          if (it < 192) ada_item(lds, p, it);
          else if (it < 204) tables_item(p, it - 192);
          else { const int lt0 = (it - 204) * 2 + (int)(threadIdx.x >> 8); const bool live = lt0 < p.njobtiles; const int lt = live ? lt0 : 0; int j = 0;
#pragma unroll
              for (int q = 1; q < 11; ++q) if (lt >= p.jobs[q].tile0) j = q;
              transpose_tile(lds, ws, p.jobs[j], lt - p.jobs[j].tile0, live); } } }
    GRID_SYNC();
    modulate_rows(p, 0, 0, true, 0);
    s5_kk_phase(lds, p);
    GRID_SYNC();
    { EpiWin0 e{(bf16_t*)(ws + H_UA), (float*)(ws + S_CQKV), (float*)(ws + H_KR)};
      gemm_phase(lds, A0, 1024, WB + W_IN0, 1024, 0, NR / 256, 5, e); }
    s5_w1a_phase(p);
    GRID_SYNC();
    qkvnorm_phase(p);
    s5_w1b_phase(p);
    { EpiS1a e{(float*)(ws + H_E)};
      gemm_phase(lds, (const bf16_t*)(ws + H_UA), 768, (const bf16_t*)(ws + H_W1A), 512, 0, 3, 1, e, 32, (size_t)CHR * 768, (size_t)256 * 512); }
    GRID_SYNC();
    s5_carry_phase(p);
    { EpiBf16 e{(bf16_t*)(ws + S_QRAW), 768};
      gemm_phase(lds, (const bf16_t*)(ws + S_CQN), 384, WB + W_QB, 384, 0, NR / 256, 3, e); }
    { EpiKV e{(bf16_t*)(ws + S_KNOPE), (bf16_t*)(ws + S_VT)};
      gemm_phase(lds, (const bf16_t*)(ws + S_CKVN), 256, WB + W_KVB, 256, 0, NR / 256, 4, e); }
    GRID_SYNC();
    { EpiS1b e{(bf16_t*)(ws + S_YG)};
      gemm_phase(lds, (const bf16_t*)(ws + H_UA), 768, (const bf16_t*)(ws + A_W1B), 768, 0, 3, 2, e, 32, (size_t)CHR * 768, (size_t)512 * 768); }
    mla_prep_phase(p);
    GRID_SYNC();
    { const bf16_t* QR = (const bf16_t*)(ws + S_QRAW); const bf16_t* KA = (const bf16_t*)(ws + S_KA); const bf16_t* VT = (const bf16_t*)(ws + S_VT);
      const int nlat = 2 * 4 * 32, nall = nlat + 2 * 4;
      for (int it = bid; it < nall; it += nb) {
          if (it < nlat) { const int qb = it & 31, h = (it >> 5) & 3, b = it >> 7; const size_t row = NCTX + (size_t)b * SEQ + qb * 256;
              attn_item<192, 128, false>(lds, QR + row * 768 + h * 192, 768, KA + (size_t)(b * 4 + h) * TK * 192, VT + (size_t)(b * 4 + h) * 128 * TK, 0, TK / 64, 0, 0, -1e30f, 0.f,
                                         A0 + row * 1024 + 512 + h * 128, 1024, 0); }
          else { const int j = it - nlat; const int h = j & 3, b = j >> 2; const size_t row = (size_t)b * CTX;
              attn_item<192, 128, false>(lds, QR + row * 768 + h * 192, 768, KA + (size_t)(b * 4 + h) * TK * 192, VT + (size_t)(b * 4 + h) * 128 * TK, 0, 4, 0, 0, -1e30f, 0.f,
                                         A0 + row * 1024 + 512 + h * 128, 1024, 0); } }
      EpiGLU e{(const bf16_t*)(ws + S_YG), p.in[22], A0};
      gemm_phase(lds, (const bf16_t*)(ws + S_YG), 512, WB + W_GLU, 512, 0, NR / 256, 2, e); }
    GRID_SYNC();
    { EpiRes e{p.in[2], p.in[0], H, H + (size_t)NCTX * 1024, MOD + 0 * 3 * 6144 + 2048, 0};
      gemm_phase(lds, A0, 1024, WB + W_OUT0, 1024, 2, NLAT / 256, 4, e);
      thin_gemm_ctx<4>(lds, A0, 1024, WB + W_OUT0, 1024, p.in[2], H, MOD + 0 * 3 * 6144 + 2048); }
    GRID_SYNC();
    modulate_rows(p, 0, 1, false, 0);
    GRID_SYNC();
    { EpiSwiGLU e{(bf16_t*)(ws + S_HID)};
      gemm_phase(lds, A0, 1024, WB + W_GU0, 1024, 0, NR / 256, 22, e); }
    GRID_SYNC();
    { EpiRes e{H, H + (size_t)NCTX * 1024, H, H + (size_t)NCTX * 1024, MOD + 0 * 3 * 6144 + 5120, 0};
      gemm_phase(lds, (const bf16_t*)(ws + S_HID), FH, WB + W_D0, FH, 2, NLAT / 256, 4, e);
      thin_gemm_ctx<11>(lds, (const bf16_t*)(ws + S_HID), FH, WB + W_D0, FH, H, H, MOD + 0 * 3 * 6144 + 5120); }
    GRID_SYNC();
    modulate_rows(p, 1, 0, false, 0);
    GRID_SYNC();
    { EpiWin1 e{(bf16_t*)(ws + S1_Q), (bf16_t*)(ws + S1_K), (bf16_t*)(ws + S1_VT), p.in[31], p.in[32], (const float*)(ws + T_ROPE)};
      gemm_phase(lds, A0, 1024, WB + W_IN1, 1024, 0, NR / 256, 6, e); }
    GRID_SYNC();
    { const bf16_t* Q = (const bf16_t*)(ws + S1_Q); const bf16_t* K1 = (const bf16_t*)(ws + S1_K); const bf16_t* VT = (const bf16_t*)(ws + S1_VT);
      const int nit = 2 * 16 * 32;
      for (int it = bid; it < nit; it += nb) { const int g = it & 3, i = (it >> 2) & 31, kvh = (it >> 7) & 3, b = it >> 9; const int hq = kvh * 4 + g;
          const size_t row = NCTX + (size_t)b * SEQ + i * 256;
          const int l0 = (4 * i - 2) < 0 ? 0 : (4 * i - 2), l1 = (4 * i + 6) > 128 ? 128 : (4 * i + 6);
          attn_item<64, 64, true>(lds, Q + row * 1024 + hq * 64, 1024, K1 + (size_t)(b * 4 + kvh) * TK * 64, VT + (size_t)(b * 4 + kvh) * 64 * TK, 0, 4, 4 + l0, 4 + l1,
                                  p.in[33][hq] * LOG2E, 1.f, A0 + row * 1024 + hq * 64, 1024, i * 256); } }
    GRID_SYNC();
    { EpiRes e{H, H + (size_t)NCTX * 1024, nullptr, H + (size_t)NCTX * 1024, MOD + 1 * 3 * 6144 + 2048, 0};
      gemm_phase(lds, A0, 1024, WB + W_OUT1, 1024, 2, NLAT / 256, 4, e); }
    GRID_SYNC();
    modulate_rows(p, 1, 1, false, NCTX);
    GRID_SYNC();
    { EpiSwiGLU e{(bf16_t*)(ws + S_HID)};
      gemm_phase(lds, A0, 1024, WB + W_GU1, 1024, 2, NLAT / 256, 22, e); }
    GRID_SYNC();
    { EpiRes e{H, H + (size_t)NCTX * 1024, nullptr, p.out, MOD + 1 * 3 * 6144 + 5120, 0};
      gemm_phase(lds, (const bf16_t*)(ws + S_HID), FH, WB + W_D1, FH, 2, NLAT / 256, 4, e); }
}

extern "C" void kernel_launch(void* const* d_in, const int* in_sizes, int n_in, void* d_out, int out_size, void* d_ws, size_t ws_size, hipStream_t stream) {
    static int grid_blocks = 0;
    if (grid_blocks == 0) {
        if (n_in != 34 || ws_size < WS_NEED) { fprintf(stderr, "kernel_launch: unexpected n_in %d / ws %zu (need %zu)\n", n_in, ws_size, (size_t)WS_NEED); grid_blocks = -1; return; }
        int dev = 0, cus = 0, per_cu = 0;
        (void)hipGetDevice(&dev);
        (void)hipDeviceGetAttribute(&cus, hipDeviceAttributeMultiprocessorCount, dev);
        (void)hipFuncSetAttribute((const void*)fwd_kernel, hipFuncAttributeMaxDynamicSharedMemorySize, LDS_BYTES);
        (void)hipOccupancyMaxActiveBlocksPerMultiprocessor(&per_cu, (const void*)fwd_kernel, NTHREADS, LDS_BYTES);
        if (per_cu < 1) { fprintf(stderr, "kernel_launch: occupancy query returned %d\n", per_cu); grid_blocks = -1; return; }
        if (per_cu > 1) per_cu = 1;
        grid_blocks = cus * per_cu;
        fprintf(stderr, "kernel_launch: grid %d (%d CUs x %d)\n", grid_blocks, cus, per_cu);
    }
    if (grid_blocks < 0) return;
    Params p{};
    for (int i = 0; i < 34; ++i) p.in[i] = (const float*)d_in[i];
    p.out = (float*)d_out; p.ws = (char*)d_ws;
    const float* fg = p.in[8]; const float* fu = p.in[9]; const float* fd = p.in[10];
    const size_t FW = (size_t)1024 * FH;
    int t0 = 0;
    auto mk = [&](int idx, const float* a, const float* b, size_t dst, int K, int ld, int npad, int mode) {
        Job& j = p.jobs[idx]; j.a = a; j.b = b; j.dst = dst; j.K = K; j.ld = ld; j.ntk = K / 64; j.ntn = npad / 64; j.tile0 = t0; j.mode = mode; t0 += j.ntk * j.ntn; };
    mk(0, p.in[11], nullptr, W_IN0, 1024, 1216, 1280, 0);
    mk(1, p.in[24], nullptr, W_QB, 384, 768, 768, 0);
    mk(2, p.in[26], nullptr, W_KVB, 256, 1024, 1024, 0);
    mk(3, p.in[21], nullptr, W_GLU, 512, 512, 512, 0);
    mk(4, p.in[12], nullptr, W_OUT0, 1024, 1024, 1024, 0);
    mk(5, fg, fu, W_GU0, 1024, FH, 5632, 1);
    mk(6, fd, nullptr, W_D0, FH, 1024, 1024, 0);
    mk(7, p.in[29], nullptr, W_IN1, 1024, 1536, 1536, 0);
    mk(8, p.in[30], nullptr, W_OUT1, 1024, 1024, 1024, 0);
    mk(9, fg + FW, fu + FW, W_GU1, 1024, FH, 5632, 1);
    mk(10, fd + FW, nullptr, W_D1, FH, 1024, 1024, 0);
    p.njobtiles = t0;
    if (hipMemsetAsync((char*)d_ws + T_BAR, 0, XCD_BAR_WORDS * 4, stream) != hipSuccess) { fprintf(stderr, "kernel_launch: memset failed\n"); return; }
    void* args[] = {&p};
    hipError_t e = hipLaunchCooperativeKernel((const void*)fwd_kernel, dim3(grid_blocks), dim3(NTHREADS), args, LDS_BYTES, stream);
    if (e != hipSuccess) fprintf(stderr, "cooperative launch failed: %s (grid %d)\n", hipGetErrorString(e), grid_blocks);
}
```

```cpp
#include <hip/hip_runtime.h>
#include <hip/hip_cooperative_groups.h>
#include <cstdio>
#include <cstdint>
namespace cg = cooperative_groups;

#define DI __device__ __forceinline__
typedef unsigned short bf16_t;
typedef short bf16x8 __attribute__((ext_vector_type(8)));
typedef short s16x4 __attribute__((ext_vector_type(4)));
typedef float f32x4 __attribute__((ext_vector_type(4)));
typedef float f32x2 __attribute__((ext_vector_type(2)));
typedef float f32x16 __attribute__((ext_vector_type(16)));
typedef unsigned u32x4 __attribute__((ext_vector_type(4)));
typedef unsigned u32x2 __attribute__((ext_vector_type(2)));
typedef __bf16 bf16v2 __attribute__((ext_vector_type(2)));

constexpr int DM = 1024, NBATCH = 2, SEQ = 8192, CTX = 256;
constexpr int NCTX = NBATCH * CTX;
constexpr int NLAT = NBATCH * SEQ;
constexpr int NR = NCTX + NLAT;
constexpr int TK = CTX + SEQ;
constexpr int FH = 2816;
constexpr int NCH = TK / 64;
constexpr float LOG2E = 1.4426950408889634f;
constexpr int LDS_BYTES = 131072 + 64;
constexpr int NTHREADS = 512, NWV = 8;

constexpr size_t W_IN0 = 0;
constexpr size_t W_QB = W_IN0 + (size_t)1280 * 1024;
constexpr size_t W_KVB = W_QB + (size_t)768 * 384;
constexpr size_t W_GLU = W_KVB + (size_t)1024 * 256;
constexpr size_t W_OUT0 = W_GLU + (size_t)512 * 512;
constexpr size_t W_GU0 = W_OUT0 + (size_t)1024 * 1024;
constexpr size_t W_D0 = W_GU0 + (size_t)5632 * 1024;
constexpr size_t W_IN1 = W_D0 + (size_t)1024 * 2816;
constexpr size_t W_OUT1 = W_IN1 + (size_t)1536 * 1024;
constexpr size_t W_GU1 = W_OUT1 + (size_t)1024 * 1024;
constexpr size_t W_D1 = W_GU1 + (size_t)5632 * 1024;
constexpr size_t W_END = W_D1 + (size_t)1024 * 2816;
constexpr size_t OFF_TAB = W_END * 2;
constexpr size_t T_MOD = OFF_TAB;
constexpr size_t T_ROPE = T_MOD + 2 * 3 * 6144 * 4;
constexpr size_t T_LAMB = T_ROPE + 128 * 16 * 2 * 4;
constexpr size_t T_LAM64 = T_LAMB + 2 * 32 * 64 * 8;
constexpr size_t T_BBAR = T_LAM64 + 2 * 32 * 64 * 8;
constexpr size_t T_BAR = T_BBAR + (size_t)2 * 32 * 64 * 16 * 8;
constexpr size_t OFF_H = OFF_TAB + (1u << 20);
constexpr size_t OFF_A0 = OFF_H + (size_t)NR * 1024 * 4;
constexpr size_t OFF_S = OFF_A0 + (size_t)NR * 1024 * 2;
constexpr size_t WS_NEED = OFF_S + (size_t)108134400;
static_assert(WS_NEED <= ((size_t)256 << 20) && OFF_S + (size_t)NR * FH * 2 <= WS_NEED, "workspace");
constexpr int SL = 32;
constexpr int NCK = TK / SL;
constexpr int CHR = NBATCH * NCK;
constexpr size_t H_UA = OFF_H;
constexpr size_t H_KR = H_UA + (size_t)(32 * CHR + 256) * 768 * 2;
constexpr size_t H_E = H_KR + (size_t)NR * 64 * 4;
constexpr size_t H_KK = H_E + (size_t)32 * CHR * 256 * 4;
constexpr size_t H_POW = H_KK + (size_t)32 * 2 * 32 * 256 * 4;
constexpr size_t H_W1A = H_POW + (size_t)4096 * 33 * 8;
static_assert(H_W1A + (size_t)32 * 256 * 512 * 2 <= OFF_A0, "H region overflow");
constexpr size_t A_W1B = OFF_A0;
constexpr size_t S_CQN = OFF_S;
constexpr size_t S_CKVN = S_CQN + (size_t)NR * 384 * 2;
constexpr size_t S_YG = OFF_S;
constexpr size_t S_X = S_CKVN + (size_t)NR * 256 * 2;
constexpr size_t S_CQKV = S_X;
constexpr size_t S_QRAW = S_X;
constexpr size_t S_KNOPE = S_QRAW + (size_t)NR * 768 * 2;
constexpr size_t S_VT = S_KNOPE + (size_t)NR * 512 * 2;
constexpr size_t S_KA = S_VT + (size_t)2 * 4 * 128 * TK * 2;
static_assert(S_CQKV + (size_t)NR * 640 * 4 <= S_VT, "CQKV overlaps VT");
static_assert(S_KA + (size_t)2 * 4 * TK * 192 * 2 <= WS_NEED, "scratch overflow");
constexpr size_t S_HID = OFF_S;
constexpr size_t S1_Q = OFF_S;
constexpr size_t S1_KRAW = S1_Q + (size_t)NR * 1024 * 2;
constexpr size_t S1_K = S1_KRAW + (size_t)NR * 256 * 4;
constexpr size_t S1_VT = S1_K + (size_t)2 * 4 * TK * 64 * 2;

struct Job { const float* a; const float* b; unsigned long long dst; int K, ld, ntk, ntn, tile0, mode; };
struct Params {
    const float* in[34];
    float* out;
    char* ws;
    Job jobs[11];
    int njobtiles;
    int pad;
};

DI int get_tid() { int t = threadIdx.x; asm volatile("" : "+v"(t)); return t; }
DI unsigned pk2(float lo, float hi) { f32x2 v = {lo, hi}; return __builtin_bit_cast(unsigned, __builtin_convertvector(v, bf16v2)); }
DI float bf2f(unsigned short b) { return __uint_as_float(((unsigned)b) << 16); }
DI float wave_sum(float v) {
#pragma unroll
    for (int o = 32; o > 0; o >>= 1) v += __shfl_xor(v, o);
    return v;
}
DI int row_vec(int r) { return r < NCTX ? 2 : (r - NCTX) / SEQ; }
DI int row_batch(int r) { return r < NCTX ? r / CTX : (r - NCTX) / SEQ; }
DI int row_tpos(int r) { return r < NCTX ? r % CTX : CTX + (r - NCTX) % SEQ; }
DI float sigmoidf_(float x) { return 1.f / (1.f + __expf(-x)); }
DI float siluf_(float x) { return x / (1.f + __expf(-x)); }
DI float gelu_tanh(float y) { const float z = 0.7978845608028654f * (y + 0.044715f * y * y * y); const float t = 1.f - 2.f / (1.f + __expf(2.f * z)); return 0.5f * y * (1.f + t); }
DI void my_sincos(float x, float& s, float& c) {
    const float q = rintf(x * 0.636619772367581f);
    float r = fmaf(-q, 1.5703125f, x);
    r = fmaf(-q, 4.837512969970703125e-4f, r);
    r = fmaf(-q, 7.54978995489188216e-8f, r);
    const int qi = (int)q;
    const float r2 = r * r;
    const float sp = r + r * r2 * (-1.6666654611e-1f + r2 * (8.3321608736e-3f + r2 * (-1.9515295891e-4f)));
    const float cp = 1.0f - 0.5f * r2 + r2 * r2 * (4.166664568298827e-2f + r2 * (-1.388731625493765e-3f + r2 * 2.443315711809948e-5f));
    const int k = qi & 3;
    s = (k == 0) ? sp : (k == 1) ? cp : (k == 2) ? -sp : -cp;
    c = (k == 0) ? cp : (k == 1) ? -sp : (k == 2) ? -cp : sp;
}


#define XB_TMO      128
#define XB_XCNT(j)  (256  + 64 * (j))
#define XB_XSUB(j)  (1280 + 64 * (j))
#define XB_XGEN(j)  (2304 + 64 * (j))
#define XB_TOP      3328
#define XB_TOPGEN   3392
#define XCD_BAR_WORDS 3456
#define XB_SPIN_CAP (1u << 22)
#define LAS __attribute__((address_space(3)))
DI unsigned xb_ld(unsigned* p) { return __hip_atomic_load(p, __ATOMIC_RELAXED, __HIP_MEMORY_SCOPE_AGENT); }
DI unsigned xb_add(unsigned* p, unsigned v) { return __hip_atomic_fetch_add(p, v, __ATOMIC_RELAXED, __HIP_MEMORY_SCOPE_AGENT); }
DI unsigned xb_xcc_id() { return (unsigned)__builtin_amdgcn_s_getreg((3 << 11) | 20) & 0xFu; }
#define XB_SPIN(cond, bar) do { unsigned _sp = 0; while (cond) { __builtin_amdgcn_s_sleep(1); \
    if ((++_sp & 255u) == 0u) { if (xb_ld(&(bar)[XB_TMO])) break; if (_sp > XB_SPIN_CAP) { atomicAdd(&(bar)[XB_TMO], 1u); break; } } } } while (0)
struct XcdBarrier { unsigned* bar; unsigned x; volatile LAS unsigned* st; };
DI XcdBarrier xcd_barrier_post(unsigned* bar, volatile LAS unsigned* st) {
    XcdBarrier b; b.bar = bar; b.x = xb_xcc_id(); b.st = st;
    if (threadIdx.x == 0) (void)xb_add(&bar[XB_XCNT(b.x)], 1u);
    return b;
}
DI void xcd_barrier_complete(unsigned* bar, unsigned x, unsigned& nloc, unsigned& nx) {
    const unsigned G = gridDim.x * gridDim.y * gridDim.z;
    unsigned sum, cnt, mine, sp = 0u;
    for (;;) {
        sum = 0u; cnt = 0u; mine = 0u;
#pragma unroll
        for (unsigned j = 0; j < 16; ++j) { const unsigned c = xb_ld(&bar[XB_XCNT(j)]); sum += c; cnt += (c > 0u) ? 1u : 0u; mine = (j == x) ? c : mine; }
        if (sum == G) break;
        __builtin_amdgcn_s_sleep(1);
        if ((++sp & 255u) == 0u) { if (xb_ld(&bar[XB_TMO])) break; if (sp > XB_SPIN_CAP) { atomicAdd(&bar[XB_TMO], 1u); break; } }
    }
    nloc = mine > 0u ? mine : 1u; nx = cnt > 0u ? cnt : 1u;
}
DI void xcd_barrier(const XcdBarrier& b) {
    asm volatile("s_waitcnt vmcnt(0)" ::: "memory");
    __syncthreads();
    if (threadIdx.x == 0) {
        unsigned* bar = b.bar;
        __builtin_amdgcn_s_waitcnt(0);
        unsigned nloc = b.st[0], nx = b.st[1];
        if (nloc == 0u) { xcd_barrier_complete(bar, b.x, nloc, nx); b.st[0] = nloc; b.st[1] = nx; }
        const unsigned old = xb_add(&bar[XB_XSUB(b.x)], 1u);
        const unsigned gen = old / nloc;
        if (old + 1u == (gen + 1u) * nloc) {
            __builtin_amdgcn_fence(__ATOMIC_RELEASE, "agent");
            asm volatile("s_waitcnt vmcnt(0)" ::: "memory");
            const unsigned og = xb_add(&bar[XB_TOP], 1u);
            const unsigned tg = og / nx;
            if (og + 1u == (tg + 1u) * nx) xb_add(&bar[XB_TOPGEN], 1u);
            else XB_SPIN(xb_ld(&bar[XB_TOPGEN]) == tg, bar);
            __builtin_amdgcn_fence(__ATOMIC_ACQUIRE, "agent");
            xb_add(&bar[XB_XGEN(b.x)], 1u);
            asm volatile("s_waitcnt vmcnt(0)" ::: "memory");
        } else {
            XB_SPIN(xb_ld(&bar[XB_XGEN(b.x)]) == gen, bar);
            __builtin_amdgcn_fence(__ATOMIC_ACQUIRE, "agent");
            asm volatile("s_waitcnt vmcnt(0)" ::: "memory");
        }
    }
    __syncthreads();
}

DI void transpose_tile(char* lds, char* ws, const Job& jb, int lt, bool live) {
    const int tid512 = get_tid(); const int tid = tid512 & 255;
    float (*tile)[65] = (float (*)[65])(lds + (tid512 >> 8) * 17408);
    const int tk = lt % jb.ntk, tn = lt / jb.ntk;
    const int k0 = tk * 64, n0 = tn * 64;
    const int c4 = (tid & 15) * 4, rq = tid >> 4;
    const float* src; int col; bool valid = live;
    if (jb.mode == 0) { src = jb.a; col = n0 + c4; valid = live && col < jb.ld; }
    else { const int nsub = c4 >> 4, i = c4 & 15; src = (nsub & 1) ? jb.b : jb.a; col = tn * 32 + (nsub >> 1) * 16 + i; }
#pragma unroll
    for (int kk = 0; kk < 4; ++kk) { const int k = kk * 16 + rq; const f32x4 v = valid ? *(const f32x4*)(src + (size_t)(k0 + k) * jb.ld + col) : (f32x4){0.f, 0.f, 0.f, 0.f};
        tile[k][c4] = v[0]; tile[k][c4 + 1] = v[1]; tile[k][c4 + 2] = v[2]; tile[k][c4 + 3] = v[3]; }
    __syncthreads();
    const int r = tid >> 2, ks = (tid & 3) * 16;
    unsigned w[8];
#pragma unroll
    for (int q = 0; q < 8; ++q) w[q] = pk2(tile[ks + 2 * q][r], tile[ks + 2 * q + 1][r]);
    bf16_t* d = (bf16_t*)(ws) + jb.dst + (size_t)(n0 + r) * jb.K + k0 + ks;
    if (live) { *(u32x4*)d = (u32x4){w[0], w[1], w[2], w[3]};
    *(u32x4*)(d + 8) = (u32x4){w[4], w[5], w[6], w[7]}; }
    __syncthreads();
}

DI void transpose_range(char* lds, char* ws, const Params& p, int t_begin, int t_end, int rank, int nranks) {
    if (rank < 0) return;
    for (int pr = (t_begin >> 1) + rank; pr < (t_end >> 1); pr += nranks) {
        const int lt = pr * 2 + (int)(threadIdx.x >> 8); int j = 0;
#pragma unroll
        for (int q = 1; q < 11; ++q) if (lt >= p.jobs[q].tile0) j = q;
        transpose_tile(lds, ws, p.jobs[j], lt - p.jobs[j].tile0, true);
    }
}
DI void slack_rank(int ntile, int& rank, int& nranks) { const int rem = ntile % (int)gridDim.x; if (rem == 0) { rank = blockIdx.x; nranks = gridDim.x; } else { rank = (int)blockIdx.x - rem; nranks = (int)gridDim.x - rem; } }

DI void ada_item(char* lds, const Params& p, int it) {
    float* sil = (float*)lds;
    float* red = sil + 3072;
    float* MOD = (float*)(p.ws + T_MOD);
    const int tid = get_tid(), layer = it / 96, n0 = (it % 96) * 64;
    for (int i = tid; i < 3072; i += NTHREADS) { const int v = i >> 10, k = i & 1023; const float x = v < 2 ? p.in[1][v * 1024 + k] : p.in[3][k]; sil[i] = siluf_(x); }
    __syncthreads();
    const int j4 = (tid & 15) * 4, kg = tid >> 4;
    const float* W = p.in[4] + (size_t)layer * 1024 * 6144 + n0 + j4;
    f32x4 a0 = {0.f, 0.f, 0.f, 0.f}, a1 = a0, a2 = a0;
#pragma unroll 8
    for (int k = kg * 32; k < kg * 32 + 32; ++k) { const f32x4 w = *(const f32x4*)(W + (size_t)k * 6144); a0 += sil[k] * w; a1 += sil[1024 + k] * w; a2 += sil[2048 + k] * w; }
    *(f32x4*)(red + (kg * 3 + 0) * 64 + j4) = a0; *(f32x4*)(red + (kg * 3 + 1) * 64 + j4) = a1; *(f32x4*)(red + (kg * 3 + 2) * 64 + j4) = a2;
    __syncthreads();
    if (tid < 192) { const int v = tid >> 6, jj = tid & 63;
        float s = p.in[5][layer * 6144 + n0 + jj];
#pragma unroll 8
        for (int q = 0; q < 32; ++q) s += red[(q * 3 + v) * 64 + jj];
        MOD[(layer * 3 + v) * 6144 + n0 + jj] = s; }
    __syncthreads();
}

DI void tables_item(const Params& p, int it) {
    const int tid = get_tid();
    if (it < 4) {
        const int e = it * 512 + tid, pos = e >> 4, i = e & 15;
        const float inv = exp2f(-(float)i * (13.287712379549449f / 16.f));
        float s, c; my_sincos((float)pos * inv, s, c);
        float* ROPE = (float*)(p.ws + T_ROPE); ROPE[e * 2] = c; ROPE[e * 2 + 1] = s;
    } else {
        const int e = (it - 4) * 512 + tid;
        const int dg = e >> 6;
        const float lr = p.in[13][e], li = p.in[14][e], step = expf(p.in[15][dg]);
        const float a = lr * step, b = li * step;
        const float ea = expf(a);
        float sb, cb; my_sincos(b, sb, cb);
        float sh, ch; my_sincos(0.5f * b, sh, ch);
        const float em1 = a * (1.f + a * 0.5f * (1.f + a * (1.f / 3.f) * (1.f + a * 0.25f * (1.f + a * 0.2f * (1.f + a * (1.f / 6.f))))));
        const float lbr = ea * cb, lbi = ea * sb;
        const float nr = em1 * cb - 2.f * sh * sh, ni = ea * sb;
        const float den = lr * lr + li * li;
        const float qr = (nr * lr + ni * li) / den, qi = (ni * lr - nr * li) / den;
        f32x2* BB = (f32x2*)(p.ws + T_BBAR);
#pragma unroll
        for (int s = 0; s < 16; ++s) { const float br = p.in[16][e * 16 + s], bi = p.in[17][e * 16 + s]; BB[e * 16 + s] = (f32x2){qr * br - qi * bi, qr * bi + qi * br}; }
        f32x2* POW = (f32x2*)(p.ws + H_POW) + (size_t)dg * 33 * 64 + (e & 63);
        float pr = 1.f, pi = 0.f;
        for (int q = 0; q <= 32; ++q) { POW[q * 64] = (f32x2){pr, pi}; const float nr2 = pr * lbr - pi * lbi, ni2 = pr * lbi + pi * lbr; pr = nr2; pi = ni2; }
    }
}

DI void modulate_rows(const Params& p, int layer, int which, bool from_inputs, int r0) {
    const int tid_ = get_tid(); const int lane = tid_ & 63, wid = tid_ >> 6;
    const float* gain = p.in[which ? 7 : 6] + layer * 1024;
    const float* modl = (const float*)(p.ws + T_MOD) + layer * 3 * 6144 + (which ? 3072 : 0);
    const float* H = (const float*)(p.ws + OFF_H);
    bf16_t* dst = (bf16_t*)(p.ws + OFF_A0);
    const int stride = gridDim.x * NWV;
    for (int ra = r0 + blockIdx.x * NWV + wid; ra < NR; ra += 2 * stride) {
        const int rb = ra + stride; const bool hb = rb < NR; const int rbb = hb ? rb : ra;
        const float* srca = from_inputs ? (ra < NCTX ? p.in[2] + (size_t)ra * 1024 : p.in[0] + (size_t)(ra - NCTX) * 1024) : H + (size_t)ra * 1024;
        const float* srcb = from_inputs ? (rbb < NCTX ? p.in[2] + (size_t)rbb * 1024 : p.in[0] + (size_t)(rbb - NCTX) * 1024) : H + (size_t)rbb * 1024;
        f32x4 xa[4], xb[4]; float sa = 0.f, sb = 0.f;
#pragma unroll
        for (int i = 0; i < 4; ++i) { xa[i] = *(const f32x4*)(srca + i * 256 + lane * 4); xb[i] = *(const f32x4*)(srcb + i * 256 + lane * 4); }
#pragma unroll
        for (int i = 0; i < 4; ++i) { sa += xa[i][0] * xa[i][0] + xa[i][1] * xa[i][1] + xa[i][2] * xa[i][2] + xa[i][3] * xa[i][3];
                                      sb += xb[i][0] * xb[i][0] + xb[i][1] * xb[i][1] + xb[i][2] * xb[i][2] + xb[i][3] * xb[i][3]; }
        sa = wave_sum(sa); sb = wave_sum(sb);
        const float rsa = rsqrtf(sa * (1.f / 1024.f) + 1e-6f), rsb = rsqrtf(sb * (1.f / 1024.f) + 1e-6f);
        const float* mva = modl + row_vec(ra) * 6144; const float* mvb = modl + row_vec(rbb) * 6144;
#pragma unroll
        for (int i = 0; i < 4; ++i) { const int c = i * 256 + lane * 4;
            const f32x4 g = *(const f32x4*)(gain + c);
            { const f32x4 sh = *(const f32x4*)(mva + c), sc = *(const f32x4*)(mva + 1024 + c); const f32x4 y = xa[i] * rsa * g * (1.f + sc) + sh;
              *(u32x2*)(dst + (size_t)ra * 1024 + c) = (u32x2){pk2(y[0], y[1]), pk2(y[2], y[3])}; }
            if (hb) { const f32x4 sh = *(const f32x4*)(mvb + c), sc = *(const f32x4*)(mvb + 1024 + c); const f32x4 y = xb[i] * rsb * g * (1.f + sc) + sh;
              *(u32x2*)(dst + (size_t)rb * 1024 + c) = (u32x2){pk2(y[0], y[1]), pk2(y[2], y[3])}; } }
    }
}

template <class Epi>
DI void gemm_phase(char* lds, const bf16_t* A0_, int lda, const bf16_t* Bt0_, int K, int mt0, int nmt, int nnt, const Epi& epi, int nbatch = 1, size_t sA = 0, size_t sB = 0, int ksplit = 1) {
    const int tid = get_tid(), lane = tid & 63, wid = tid >> 6, wr = wid >> 2, wc = wid & 3, fr = lane & 15, fq = lane >> 4;
    const int nk = (K >> 6) / ksplit;
    const int lrow = tid >> 3, lc = tid & 7, lkc = lc * 8;
    const int woff = lrow * 128 + ((lc ^ ((lrow >> 1) & 7)) << 4);
    const int ra0 = (wr * 128 + fr) * 128 + ((fq ^ (fr >> 1)) << 4);
    const int ra1 = (wr * 128 + fr) * 128 + (((4 + fq) ^ (fr >> 1)) << 4);
    const int rb0 = 32768 + (wc * 64 + fr) * 128 + ((fq ^ (fr >> 1)) << 4);
    const int rb1 = 32768 + (wc * 64 + fr) * 128 + (((4 + fq) ^ (fr >> 1)) << 4);
    const int per = nmt * nnt, ntile = nbatch * per * ksplit;
    const int myn = ((int)blockIdx.x < ntile) ? (ntile - (int)blockIdx.x + (int)gridDim.x - 1) / (int)gridDim.x : 0;
    const int total = myn * nk;
    f32x4 acc[8][4];
#pragma unroll
    for (int m = 0; m < 8; ++m)
#pragma unroll
        for (int n = 0; n < 4; ++n) acc[m][n] = (f32x4){0.f, 0.f, 0.f, 0.f};
    u32x4 sa[4], sb[4];
    int iti = 0, ikt = 0;
    const bf16_t* Ag = A0_; const bf16_t* Bg = Bt0_;
#define G_ISSUE() do { if (ikt == 0) { const int u_ = blockIdx.x + iti * gridDim.x; const int t_ = u_ / ksplit, sl_ = u_ - t_ * ksplit; const int gb_ = t_ / per, tr_ = t_ - gb_ * per; const int tm_ = tr_ / nnt, tn_ = tr_ - tm_ * nnt; \
            Ag = A0_ + (size_t)gb_ * sA + (size_t)((mt0 + tm_) * 256 + lrow) * lda + lkc + sl_ * nk * 64; Bg = Bt0_ + (size_t)gb_ * sB + (size_t)(tn_ * 256 + lrow) * K + lkc + sl_ * nk * 64; } \
        _Pragma("unroll") for (int i = 0; i < 4; ++i) { sa[i] = *(const u32x4*)(Ag + (size_t)i * 64 * lda + ikt * 64); sb[i] = *(const u32x4*)(Bg + (size_t)i * 64 * K + ikt * 64); } \
        if (++ikt == nk) { ikt = 0; ++iti; } } while (0)
#define G_WRITE(bufoff) do { _Pragma("unroll") for (int i = 0; i < 4; ++i) { *(u32x4*)(lds + (bufoff) + woff + i * 8192) = sa[i]; *(u32x4*)(lds + (bufoff) + 32768 + woff + i * 8192) = sb[i]; } } while (0)
#define G_COMPUTE(bufoff) do { _Pragma("unroll") for (int ks = 0; ks < 2; ++ks) { bf16x8 a[8], b[4]; \
        _Pragma("unroll") for (int m = 0; m < 8; ++m) a[m] = *(const bf16x8*)(lds + (bufoff) + (ks ? ra1 : ra0) + m * 2048); \
        _Pragma("unroll") for (int n = 0; n < 4; ++n) b[n] = *(const bf16x8*)(lds + (bufoff) + (ks ? rb1 : rb0) + n * 2048); \
        _Pragma("unroll") for (int m = 0; m < 8; ++m) _Pragma("unroll") for (int n = 0; n < 4; ++n) acc[m][n] = __builtin_amdgcn_mfma_f32_16x16x32_bf16(b[n], a[m], acc[m][n], 0, 0, 0); } } while (0)
    __syncthreads();
    if (total > 0) {
        G_ISSUE(); G_WRITE(0);
        if (total > 1) G_ISSUE();
    }
    __syncthreads();
    int cti = 0, ckt = 0;
    for (int q = 0; q < total; ++q) {
        const int cur = (q & 1) * 65536;
        if (q + 1 < total) G_WRITE(cur ^ 65536);
        if (q + 2 < total) G_ISSUE();
        G_COMPUTE(cur);
        __syncthreads();
        if (++ckt == nk) {
            const int u_ = blockIdx.x + cti * gridDim.x; const int t_ = u_ / ksplit; const int gb_ = t_ / per, tr_ = t_ - gb_ * per; const int tm_ = tr_ / nnt, tn_ = tr_ - tm_ * nnt;
            epi(acc, (mt0 + tm_) * 256 + wr * 128 + fr, tn_ * 256 + wc * 64 + fq * 4, gb_);
#pragma unroll
            for (int m = 0; m < 8; ++m)
#pragma unroll
                for (int n = 0; n < 4; ++n) acc[m][n] = (f32x4){0.f, 0.f, 0.f, 0.f};
            ckt = 0; ++cti;
        }
    }
#undef G_ISSUE
#undef G_WRITE
#undef G_COMPUTE
}

template <int KSP>
DI void thin_gemm_ctx(char* lds, const bf16_t* A, int lda, const bf16_t* Bt, int K, const float* res, float* dst, const float* gate) {
    const int tid = get_tid(), lane = tid & 63, wid = tid >> 6, fr = lane & 15, fq = lane >> 4;
    float* part = (float*)lds;
    for (int t = blockIdx.x; t < 256; t += gridDim.x) {
        const int m0 = (t >> 5) * 64, n0 = (t & 31) * 32;
        f32x4 acc[4][2];
#pragma unroll
        for (int m = 0; m < 4; ++m) { acc[m][0] = (f32x4){0.f, 0.f, 0.f, 0.f}; acc[m][1] = (f32x4){0.f, 0.f, 0.f, 0.f}; }
        const bf16_t* Ap = A + (size_t)(m0 + fr) * lda + wid * (KSP * 32) + fq * 8;
        const bf16_t* Bp = Bt + (size_t)(n0 + fr) * K + wid * (KSP * 32) + fq * 8;
#pragma unroll
        for (int k = 0; k < KSP; ++k) {
            bf16x8 a[4], b[2];
#pragma unroll
            for (int m = 0; m < 4; ++m) a[m] = *(const bf16x8*)(Ap + (size_t)m * 16 * lda + k * 32);
#pragma unroll
            for (int n = 0; n < 2; ++n) b[n] = *(const bf16x8*)(Bp + (size_t)n * 16 * K + k * 32);
#pragma unroll
            for (int m = 0; m < 4; ++m)
#pragma unroll
                for (int n = 0; n < 2; ++n) acc[m][n] = __builtin_amdgcn_mfma_f32_16x16x32_bf16(b[n], a[m], acc[m][n], 0, 0, 0);
        }
        __syncthreads();
#pragma unroll
        for (int m = 0; m < 4; ++m)
#pragma unroll
            for (int n = 0; n < 2; ++n) *(f32x4*)(part + ((wid * 64 + m * 16 + fr) * 32 + n * 16 + fq * 4)) = acc[m][n];
        __syncthreads();
        { const int row = tid >> 3, c4 = (tid & 7) * 4; f32x4 sum = (f32x4){0.f, 0.f, 0.f, 0.f};
#pragma unroll
          for (int w = 0; w < 8; ++w) sum += *(const f32x4*)(part + ((w * 64 + row) * 32 + c4));
          const size_t off = (size_t)(m0 + row) * 1024 + n0 + c4;
          const f32x4 g = *(const f32x4*)(gate + 2 * 6144 + n0 + c4), x = *(const f32x4*)(res + off);
          *(f32x4*)(dst + off) = x + g * sum; }
    }
    __syncthreads();
}

struct EpiWin0 {
    bf16_t* UA; float* CQKV; float* KR;
    DI void operator()(const f32x4 (&acc)[8][4], int row0, int col0, int gb) const {
#pragma unroll
        for (int m = 0; m < 8; ++m) { const int ri = row0 + m * 16; const size_t r = ri; const int b = row_batch(ri), tp = row_tpos(ri);
#pragma unroll
            for (int n = 0; n < 4; ++n) { const int c = col0 + n * 16; const f32x4 v = acc[m][n];
                if (c < 512) { const int g = c >> 4, s0 = c & 15;
                    *(u32x2*)(UA + ((size_t)g * CHR + b * NCK + (tp >> 5)) * 768 + (tp & 31) * 16 + s0) = (u32x2){pk2(v[0], v[1]), pk2(v[2], v[3])}; }
                else if (c < 1152) *(f32x4*)(CQKV + r * 640 + (c - 512)) = v;
                else if (c < 1216) *(f32x4*)(KR + r * 64 + (c - 1152)) = v; } }
    }
};
struct EpiS1a {
    float* E;
    DI void operator()(const f32x4 (&acc)[8][4], int row0, int col0, int gb) const {
#pragma unroll
        for (int m = 0; m < 8; ++m) { const int r = row0 + m * 16; if (r >= CHR) continue;
#pragma unroll
            for (int n = 0; n < 4; ++n) *(f32x4*)(E + ((size_t)gb * CHR + r) * 256 + col0 + n * 16) = acc[m][n]; }
    }
};
struct EpiS1b {
    bf16_t* YG;
    DI void operator()(const f32x4 (&acc)[8][4], int row0, int col0, int gb) const {
#pragma unroll
        for (int m = 0; m < 8; ++m) { const int r = row0 + m * 16; if (r >= CHR) continue; const int b = r / NCK, c = r % NCK;
#pragma unroll
            for (int n = 0; n < 4; ++n) { const int cc = col0 + n * 16; const int tl = cc >> 4, s0 = cc & 15; const f32x4 v = acc[m][n];
                const int tp = c * SL + tl; const size_t row = tp < CTX ? (size_t)b * CTX + tp : (size_t)NCTX + (size_t)b * SEQ + (tp - CTX);
                *(u32x2*)(YG + row * 512 + gb * 16 + s0) = (u32x2){pk2(gelu_tanh(v[0]), gelu_tanh(v[1])), pk2(gelu_tanh(v[2]), gelu_tanh(v[3]))}; } }
    }
};
struct EpiBf16 {
    bf16_t* O; int ldo;
    DI void operator()(const f32x4 (&acc)[8][4], int row0, int col0, int gb) const {
#pragma unroll
        for (int m = 0; m < 8; ++m) { const size_t r = row0 + m * 16;
#pragma unroll
            for (int n = 0; n < 4; ++n) { const int c = col0 + n * 16; const f32x4 v = acc[m][n];
                *(u32x2*)(O + r * ldo + c) = (u32x2){pk2(v[0], v[1]), pk2(v[2], v[3])}; } }
    }
};
struct EpiKV {
    bf16_t* KNOPE; bf16_t* VT;
    DI void operator()(const f32x4 (&acc)[8][4], int row0, int col0, int gb) const {
#pragma unroll
        for (int m = 0; m < 8; ++m) { const int r = row0 + m * 16; const int b = row_batch(r), tp = row_tpos(r);
#pragma unroll
            for (int n = 0; n < 4; ++n) { const int c = col0 + n * 16; const int h = c >> 8, w = c & 255; const f32x4 v = acc[m][n];
                if (w < 128) *(u32x2*)(KNOPE + (size_t)r * 512 + h * 128 + w) = (u32x2){pk2(v[0], v[1]), pk2(v[2], v[3])};
                else { bf16_t* d = VT + ((size_t)(b * 4 + h) * 128 + (w - 128)) * TK + tp; const unsigned p0 = pk2(v[0], v[1]), p1 = pk2(v[2], v[3]);
                    d[0] = (bf16_t)(p0 & 0xffff); d[TK] = (bf16_t)(p0 >> 16); d[2 * TK] = (bf16_t)(p1 & 0xffff); d[3 * TK] = (bf16_t)(p1 >> 16); } } }
    }
};
struct EpiGLU {
    const bf16_t* YG; const float* bias; bf16_t* CAT;
    DI void operator()(const f32x4 (&acc)[8][4], int row0, int col0, int gb) const {
#pragma unroll
        for (int m = 0; m < 8; ++m) { const size_t r = row0 + m * 16;
#pragma unroll
            for (int n = 0; n < 4; ++n) { const int c = col0 + n * 16; const f32x4 v = acc[m][n]; const f32x4 bv = *(const f32x4*)(bias + c);
                const u32x2 yy = *(const u32x2*)(YG + r * 512 + c);
                const float y0 = __uint_as_float(yy[0] << 16), y1 = __uint_as_float(yy[0] & 0xffff0000u), y2 = __uint_as_float(yy[1] << 16), y3 = __uint_as_float(yy[1] & 0xffff0000u);
                const float o0 = y0 * sigmoidf_(v[0] + bv[0]), o1 = y1 * sigmoidf_(v[1] + bv[1]), o2 = y2 * sigmoidf_(v[2] + bv[2]), o3 = y3 * sigmoidf_(v[3] + bv[3]);
                *(u32x2*)(CAT + r * 1024 + c) = (u32x2){pk2(o0, o1), pk2(o2, o3)}; } }
    }
};
struct EpiRes {
    const float* res_ctx; const float* res_lat; float* dst_ctx; float* dst_lat; const float* gate; int atomic;
    DI void operator()(const f32x4 (&acc)[8][4], int row0, int col0, int gb) const {
#pragma unroll
        for (int m = 0; m < 8; ++m) { const int r = row0 + m * 16;
            const float* rs = r < NCTX ? res_ctx + (size_t)r * 1024 : res_lat + (size_t)(r - NCTX) * 1024;
            float* ds = r < NCTX ? dst_ctx + (size_t)r * 1024 : dst_lat + (size_t)(r - NCTX) * 1024;
            if (r < NCTX && dst_ctx == nullptr) continue;
            const float* gv = gate + row_vec(r) * 6144;
#pragma unroll
            for (int n = 0; n < 4; ++n) { const int c = col0 + n * 16; const f32x4 g = *(const f32x4*)(gv + c);
                if (atomic) { const f32x4 v = g * acc[m][n];
#pragma unroll
                    for (int j = 0; j < 4; ++j) (void)__hip_atomic_fetch_add(ds + c + j, v[j], __ATOMIC_RELAXED, __HIP_MEMORY_SCOPE_AGENT); }
                else { const f32x4 x = *(const f32x4*)(rs + c); *(f32x4*)(ds + c) = x + g * acc[m][n]; } } }
    }
};
struct EpiSwiGLU {
    bf16_t* HID;
    DI void operator()(const f32x4 (&acc)[8][4], int row0, int col0, int gb) const {
        const int hc = (col0 >> 6) * 32 + (col0 & 15);
#pragma unroll
        for (int m = 0; m < 8; ++m) { const size_t r = row0 + m * 16;
#pragma unroll
            for (int q = 0; q < 2; ++q) { const f32x4 g = acc[m][2 * q], u = acc[m][2 * q + 1];
                const float o0 = siluf_(g[0]) * u[0], o1 = siluf_(g[1]) * u[1], o2 = siluf_(g[2]) * u[2], o3 = siluf_(g[3]) * u[3];
                *(u32x2*)(HID + r * FH + hc + q * 16) = (u32x2){pk2(o0, o1), pk2(o2, o3)}; } }
    }
};
struct EpiWin1 {
    bf16_t* Q; bf16_t* K1; bf16_t* VT; const float* qn; const float* kn; const float* ROPE;
    DI void operator()(const f32x4 (&acc)[8][4], int row0, int col0, int gb) const {
        const int cw = col0 & ~63, i0 = col0 & 15;
        if (cw >= 1280) {
#pragma unroll
            for (int m = 0; m < 8; ++m) { const int r = row0 + m * 16; const int b = row_batch(r), tp = row_tpos(r);
#pragma unroll
                for (int n = 0; n < 4; ++n) { const int cc = col0 + n * 16 - 1280, h = cc >> 6, d0 = cc & 63; const f32x4 v = acc[m][n];
                    bf16_t* d = VT + ((size_t)(b * 4 + h) * 64 + d0) * TK + tp; const unsigned p0 = pk2(v[0], v[1]), p1 = pk2(v[2], v[3]);
                    d[0] = (bf16_t)(p0 & 0xffff); d[TK] = (bf16_t)(p0 >> 16); d[2 * TK] = (bf16_t)(p1 & 0xffff); d[3 * TK] = (bf16_t)(p1 >> 16); } }
            return;
        }
        const bool isq = cw < 1024;
        const float* gn = isq ? qn : kn;
        f32x4 g[4];
#pragma unroll
        for (int n = 0; n < 4; ++n) g[n] = *(const f32x4*)(gn + n * 16 + i0);
        const float osc = isq ? 0.125f * LOG2E : 1.f;
#pragma unroll
        for (int m = 0; m < 8; ++m) { const int r = row0 + m * 16; const bool lat = r >= NCTX;
            if (isq && !lat) continue;
            const int b = row_batch(r), tp = row_tpos(r), t = tp - CTX;
            float ss = 0.f;
#pragma unroll
            for (int n = 0; n < 4; ++n) { const f32x4 v = acc[m][n]; ss += v[0] * v[0] + v[1] * v[1] + v[2] * v[2] + v[3] * v[3]; }
            ss += __shfl_xor(ss, 16); ss += __shfl_xor(ss, 32);
            const float rstd = rsqrtf(ss * (1.f / 64.f) + 1e-6f);
            f32x4 y[4];
#pragma unroll
            for (int n = 0; n < 4; ++n) y[n] = acc[m][n] * rstd * g[n];
            if (lat) { const float* rr = ROPE + ((t >> 6) * 16 + i0) * 2; const float* rc = ROPE + ((t & 63) * 16 + i0) * 2;
#pragma unroll
                for (int j = 0; j < 4; ++j) { const float c0 = rr[2 * j], s0 = rr[2 * j + 1], c1 = rc[2 * j], s1 = rc[2 * j + 1];
                    const float a0 = y[0][j], a1 = y[1][j], a2 = y[2][j], a3 = y[3][j];
                    y[0][j] = a0 * c0 - a1 * s0; y[1][j] = a1 * c0 + a0 * s0; y[2][j] = a2 * c1 - a3 * s1; y[3][j] = a3 * c1 + a2 * s1; } }
            bf16_t* dst = isq ? Q + (size_t)r * 1024 + cw + i0 : K1 + ((size_t)(b * 4 + ((cw - 1024) >> 6)) * TK + tp) * 64 + i0;
#pragma unroll
            for (int n = 0; n < 4; ++n) *(u32x2*)(dst + n * 16) = (u32x2){pk2(y[n][0] * osc, y[n][1] * osc), pk2(y[n][2] * osc, y[n][3] * osc)};
        }
    }
};

template <int DQK, int DV, bool WIN>
DI void attn_item(char* lds, const bf16_t* Q, int qstride, const bf16_t* Kb, const bf16_t* VTb, int ta0, int ta1, int tb0, int tb1,
                  float mref, float l_init, bf16_t* O, int ostride, int qpos0) {
    constexpr int NKS = DQK / 16, NDT = DV / 32, KSTR = DQK + 8, VSTR = 72, NG = NKS;
    constexpr int KCH = 64 * DQK / 8 / NTHREADS, VCH = DV * 8 / NTHREADS;
    constexpr int KBUF = 64 * KSTR, VBUF = DV * VSTR;
    bf16_t* Ks = (bf16_t*)lds; bf16_t* Vs = Ks + 2 * KBUF;
    const int tid = get_tid(), lane = tid & 63, wid = tid >> 6, r = lane & 31, h2 = lane >> 5;
    bf16x8 qf[NKS];
    { const bf16_t* qrow = Q + (size_t)(wid * 32 + r) * qstride + 8 * h2;
#pragma unroll
      for (int ks = 0; ks < NKS; ++ks) qf[ks] = *(const bf16x8*)(qrow + 16 * ks); }
    f32x16 o[NDT];
#pragma unroll
    for (int dt = 0; dt < NDT; ++dt)
#pragma unroll
        for (int i = 0; i < 16; ++i) o[dt][i] = 0.f;
    float lrun = (h2 == 0) ? l_init : 0.f;
    const int na = ta1 - ta0, ntot = na + (tb1 - tb0);
    u32x4 kr[KCH], vr[VCH];
    constexpr int KTPR = (DQK / 8) / KCH, VTPR = 8 / VCH;
    const int krow = tid / KTPR, kcol = (tid % KTPR) * (KCH * 8);
    const int vrow = tid / VTPR, vcol = (tid % VTPR) * (VCH * 8);
    const bf16_t* kgp = Kb + (size_t)krow * DQK + kcol;
    const bf16_t* vgp = VTb + (size_t)vrow * TK + vcol;
    bf16_t* ksp = Ks + krow * KSTR + kcol;
    bf16_t* vsp = Vs + vrow * VSTR + vcol;
    const bf16_t* kfp = Ks + r * KSTR + 8 * h2;
    const bf16_t* vfp = Vs + r * VSTR + 8 * h2;
#define A_TILE(itv) (((itv) < na) ? ta0 + (itv) : tb0 + ((itv) - na))
#define K_LOAD(itv) do { const bf16_t* kg = kgp + (size_t)A_TILE(itv) * 64 * DQK; _Pragma("unroll") for (int i = 0; i < KCH; ++i) kr[i] = *(const u32x4*)(kg + i * 8); } while (0)
#define V_LOADG(itv) do { const bf16_t* vg = vgp + A_TILE(itv) * 64; _Pragma("unroll") for (int i = 0; i < VCH; ++i) vr[i] = *(const u32x4*)(vg + i * 8); } while (0)
#define K_WRITE(bo) do { _Pragma("unroll") for (int i = 0; i < KCH; ++i) *(u32x4*)(ksp + (bo) + i * 8) = kr[i]; } while (0)
#define V_WRITE(bo) do { _Pragma("unroll") for (int i = 0; i < VCH; ++i) { const int c_ = (vcol >> 3) + i; bf16_t* d_ = vsp - vcol + (bo) + (c_ >> 1) * 16 + (c_ & 1) * 4; \
            *(u32x2*)d_ = (u32x2){vr[i][0], vr[i][1]}; *(u32x2*)(d_ + 8) = (u32x2){vr[i][2], vr[i][3]}; } } while (0)
#define T_ACTIVE(itv) (!(WIN && A_TILE(itv) >= 4 && ((A_TILE(itv) - 4) * 64 > qpos0 + wid * 32 + 31 + 128 || (A_TILE(itv) - 4) * 64 + 63 < qpos0 + wid * 32 - 128)))
#define S_MASK(S0, S1, itv) do { if (WIN && A_TILE(itv) >= 4) { const int qp = qpos0 + wid * 32 + r, kp0 = (A_TILE(itv) - 4) * 64 + 4 * h2; \
        _Pragma("unroll") for (int i = 0; i < 16; ++i) { const int d0 = kp0 + (i & 3) + 8 * (i >> 2) - qp, d1 = d0 + 32; \
            if (d0 > 128 || d0 < -128) S0[i] = -1e30f; if (d1 > 128 || d1 < -128) S1[i] = -1e30f; } } } while (0)
    f32x16 s0, s1;
    __syncthreads();
    K_LOAD(0); K_WRITE(0);
    if (1 < ntot) K_LOAD(1);
    V_LOADG(0);
    __syncthreads();
#pragma unroll
    for (int i = 0; i < 16; ++i) { s0[i] = -mref; s1[i] = -mref; }
#pragma unroll 1
    for (int it = -1; it < ntot; ++it) {
        const int kb_n = ((it + 1) & 1) * KBUF, vb_c = (it & 1) * VBUF;
        if (it + 2 < ntot) K_WRITE((it & 1) * KBUF);
        if (it + 1 < ntot) V_WRITE(((it + 1) & 1) * VBUF);
        __builtin_amdgcn_sched_barrier(0);
        const bool act_c = (it >= 0) && T_ACTIVE(it), act_n = (it + 1 < ntot) && T_ACTIVE(it + 1);
        f32x16 n0, n1;
#pragma unroll
        for (int i = 0; i < 16; ++i) { n0[i] = -mref; n1[i] = -mref; }
        float rs = 0.f;
        unsigned pk[16];
#define P_PAIR(j) do { const float e0_ = __builtin_amdgcn_exp2f((j) < 8 ? s0[2 * ((j) & 7)] : s1[2 * ((j) & 7)]), e1_ = __builtin_amdgcn_exp2f((j) < 8 ? s0[2 * ((j) & 7) + 1] : s1[2 * ((j) & 7) + 1]); rs += e0_ + e1_; pk[j] = pk2(e0_, e1_); } while (0)
        if (act_c && act_n) {
#pragma unroll
            for (int g = 0; g < NG; ++g) {
                const bf16x8 ka = *(const bf16x8*)(kfp + kb_n + 16 * g), kb = *(const bf16x8*)(kfp + kb_n + 32 * KSTR + 16 * g);
                n0 = __builtin_amdgcn_mfma_f32_32x32x16_bf16(ka, qf[g], n0, 0, 0, 0);
                n1 = __builtin_amdgcn_mfma_f32_32x32x16_bf16(kb, qf[g], n1, 0, 0, 0);
#pragma unroll
                for (int j = (16 * g) / NG; j < (16 * (g + 1)) / NG; ++j) P_PAIR(j);
            }
            S_MASK(n0, n1, it + 1);
        } else {
            if (act_n) {
#pragma unroll
                for (int ks = 0; ks < NKS; ++ks) { const bf16x8 k0 = *(const bf16x8*)(kfp + kb_n + 16 * ks), k1 = *(const bf16x8*)(kfp + kb_n + 32 * KSTR + 16 * ks);
                    n0 = __builtin_amdgcn_mfma_f32_32x32x16_bf16(k0, qf[ks], n0, 0, 0, 0); n1 = __builtin_amdgcn_mfma_f32_32x32x16_bf16(k1, qf[ks], n1, 0, 0, 0); }
                S_MASK(n0, n1, it + 1);
            }
            if (act_c) {
#pragma unroll
                for (int j = 0; j < 16; ++j) P_PAIR(j);
            }
        }
#undef P_PAIR
        __builtin_amdgcn_sched_barrier(0);
        if (it + 3 < ntot) K_LOAD(it + 3);
        if (it + 2 < ntot) V_LOADG(it + 2);
        __builtin_amdgcn_sched_barrier(0);
        if (act_c) {
            lrun += rs;
#pragma unroll
            for (int q = 0; q < 4; ++q) {
                const u32x4 pw = {pk[4 * q], pk[4 * q + 1], pk[4 * q + 2], pk[4 * q + 3]};
                const bf16x8 pf = __builtin_bit_cast(bf16x8, pw);
#pragma unroll
                for (int dt = 0; dt < NDT; ++dt) { const bf16x8 vf = *(const bf16x8*)(vfp + vb_c + (32 * dt) * VSTR + 16 * q);
                    o[dt] = __builtin_amdgcn_mfma_f32_32x32x16_bf16(vf, pf, o[dt], 0, 0, 0); }
            }
        }
        s0 = n0; s1 = n1;
        __syncthreads();
    }
#undef A_TILE
#undef K_LOAD
#undef V_LOADG
#undef K_WRITE
#undef V_WRITE
#undef T_ACTIVE
#undef S_MASK
    lrun += __shfl_xor(lrun, 32);
    const float inv = 1.f / lrun;
    bf16_t* orow = O + (size_t)(wid * 32 + r) * ostride;
#pragma unroll
    for (int dt = 0; dt < NDT; ++dt)
#pragma unroll
        for (int g = 0; g < 4; ++g)
            *(u32x2*)(orow + 32 * dt + 8 * g + 4 * h2) = (u32x2){pk2(o[dt][4 * g] * inv, o[dt][4 * g + 1] * inv), pk2(o[dt][4 * g + 2] * inv, o[dt][4 * g + 3] * inv)};
    __syncthreads();
}

DI void s5_kk_phase(char* lds, const Params& p) {
    const int tid512 = get_tid(); const int tid = tid512 & 255, s = tid >> 4, sp = tid & 15, dh = tid512 >> 8;
    f32x2* sbb = (f32x2*)lds;
    f32x2* scc = sbb + 1024;
    f32x2* spw = scc + 1024;
    const f32x2* POW = (const f32x2*)(p.ws + H_POW); const f32x2* BB = (const f32x2*)(p.ws + T_BBAR); float* KK = (float*)(p.ws + H_KK);
    for (int it = blockIdx.x; it < 32 * 2 * 4; it += gridDim.x) {
        const int dq = it & 3, dir = (it >> 2) & 1, g = it >> 3; const int dg = dir * 32 + g;
        __syncthreads();
        for (int i = tid512; i < 1024; i += NTHREADS) { sbb[i] = BB[(size_t)dg * 1024 + i]; scc[i] = (f32x2){p.in[18][(size_t)dg * 1024 + i], p.in[19][(size_t)dg * 1024 + i]}; }
        { const int i = tid512; spw[i] = POW[((size_t)dg * 33 + dq * 8 + (i >> 6)) * 64 + (i & 63)]; }
        __syncthreads();
        float acc[4] = {0.f, 0.f, 0.f, 0.f};
#pragma unroll 4
        for (int pp = 0; pp < 64; ++pp) { const f32x2 bb = sbb[pp * 16 + sp], cc = scc[s * 64 + pp];
#pragma unroll
            for (int q = 0; q < 4; ++q) { const f32x2 pw = spw[(dh * 4 + q) * 64 + pp];
                const float zr = pw[0] * bb[0] - pw[1] * bb[1], zi = pw[0] * bb[1] + pw[1] * bb[0];
                acc[q] += cc[0] * zr - cc[1] * zi; } }
#pragma unroll
        for (int q = 0; q < 4; ++q) KK[(size_t)((g * 2 + dir) * 32 + dq * 8 + dh * 4 + q) * 256 + tid] = acc[q];
    }
    __syncthreads();
}
DI void s5_w1a_phase(const Params& p) {
    const int tid = get_tid();
    const f32x2* POW = (const f32x2*)(p.ws + H_POW); const f32x2* BB = (const f32x2*)(p.ws + T_BBAR); bf16_t* W = (bf16_t*)(p.ws + H_W1A);
    for (int idx = blockIdx.x * NTHREADS + tid; idx < 2048 * 256; idx += gridDim.x * NTHREADS) {
        const int kq = idx & 63, n = (idx >> 6) & 255, g = idx >> 14;
        const int dir = n >> 7, ri = (n >> 6) & 1, pp = n & 63; const int e = (dir * 32 + g) * 64 + pp; const int tl = kq >> 1, s0 = (kq & 1) * 8;
        const f32x2 pw = POW[((size_t)(dir * 32 + g) * 33 + (dir ? tl : 31 - tl)) * 64 + pp];
        float v[8];
#pragma unroll
        for (int j = 0; j < 8; ++j) { const f32x2 bb = BB[e * 16 + s0 + j]; v[j] = ri ? pw[0] * bb[1] + pw[1] * bb[0] : pw[0] * bb[0] - pw[1] * bb[1]; }
        *(u32x4*)(W + ((size_t)g * 256 + n) * 512 + kq * 8) = (u32x4){pk2(v[0], v[1]), pk2(v[2], v[3]), pk2(v[4], v[5]), pk2(v[6], v[7])};
    }
}
DI void s5_w1b_phase(const Params& p) {
    const int tid = get_tid();
    const f32x2* POW = (const f32x2*)(p.ws + H_POW); const float* KK = (const float*)(p.ws + H_KK); bf16_t* W = (bf16_t*)(p.ws + A_W1B);
    for (int idx = blockIdx.x * NTHREADS + tid; idx < 6144 * 256; idx += gridDim.x * NTHREADS) {
        const int kq = idx % 96, n = (idx / 96) & 511, g = idx / (96 * 512);
        const int tl = n >> 4, s = n & 15;
        float v[8];
        if (kq < 64) { const int tl2 = kq >> 1, s0 = (kq & 1) * 8;
            f32x4 x0 = {0.f, 0.f, 0.f, 0.f}, x1 = x0;
            if (tl2 <= tl) { const float* k0 = KK + (size_t)((g * 2 + 0) * 32 + (tl - tl2)) * 256 + s * 16 + s0; x0 += *(const f32x4*)k0; x1 += *(const f32x4*)(k0 + 4); }
            if (tl2 >= tl) { const float* k1 = KK + (size_t)((g * 2 + 1) * 32 + (tl2 - tl)) * 256 + s * 16 + s0; x0 += *(const f32x4*)k1; x1 += *(const f32x4*)(k1 + 4); }
#pragma unroll
            for (int j = 0; j < 4; ++j) { v[j] = x0[j]; v[4 + j] = x1[j]; }
            if (tl2 == tl && (s >> 3) == (kq & 1)) { const float dv = p.in[20][g * 16 + s];
#pragma unroll
                for (int j = 0; j < 8; ++j) if (j == (s & 7)) v[j] += dv; }
        } else { const int k2 = (kq - 64) * 8; const int dir = k2 >> 7, ri = (k2 >> 6) & 1, p0 = k2 & 63;
            const float* cre = p.in[18] + ((size_t)(dir * 32 + g) * 16 + s) * 64 + p0; const float* cim = p.in[19] + ((size_t)(dir * 32 + g) * 16 + s) * 64 + p0;
            const f32x2* pwp = POW + ((size_t)(dir * 32 + g) * 33 + (dir ? 32 - tl : tl + 1)) * 64 + p0;
            const f32x4 cr0 = *(const f32x4*)cre, cr1 = *(const f32x4*)(cre + 4), ci0 = *(const f32x4*)cim, ci1 = *(const f32x4*)(cim + 4);
#pragma unroll
            for (int j = 0; j < 8; ++j) { const f32x2 pw = pwp[j];
                const float cr = j < 4 ? cr0[j & 3] : cr1[j & 3], ci = j < 4 ? ci0[j & 3] : ci1[j & 3];
                v[j] = ri ? -(cr * pw[1] + ci * pw[0]) : cr * pw[0] - ci * pw[1]; }
        }
        *(u32x4*)(W + ((size_t)g * 512 + n) * 768 + kq * 8) = (u32x4){pk2(v[0], v[1]), pk2(v[2], v[3]), pk2(v[4], v[5]), pk2(v[6], v[7])};
    }
}
DI void s5_carry_phase(const Params& p) {
    const int tid_ = get_tid(); const int lane = tid_ & 63, wid = tid_ >> 6;
    const f32x2* POW = (const f32x2*)(p.ws + H_POW); const float* E = (const float*)(p.ws + H_E); bf16_t* UA = (bf16_t*)(p.ws + H_UA);
    for (int it = blockIdx.x * NWV + wid; it < 2 * 2 * 32; it += gridDim.x * NWV) {
        const int g = it & 31, dir = (it >> 5) & 1, b = it >> 6;
        const f32x2 l32 = POW[((size_t)(dir * 32 + g) * 33 + 32) * 64 + lane];
        float hr = 0.f, hi = 0.f;
        for (int i0 = 0; i0 < NCK; i0 += 8) {
            float er[8], ei[8];
#pragma unroll
            for (int j = 0; j < 8; ++j) { const int i = i0 + j; const int c = dir ? (i < 8 ? 7 - i : NCK - 1 - (i - 8)) : i;
                const size_t m = (size_t)g * CHR + b * NCK + c;
                er[j] = E[m * 256 + dir * 128 + lane]; ei[j] = E[m * 256 + dir * 128 + 64 + lane]; }
#pragma unroll
            for (int j = 0; j < 8; ++j) { const int i = i0 + j; const int c = dir ? (i < 8 ? 7 - i : NCK - 1 - (i - 8)) : i;
                const size_t m = (size_t)g * CHR + b * NCK + c;
                bf16_t* u = UA + m * 768 + 512 + dir * 128 + lane;
                u[0] = (bf16_t)(pk2(hr, 0.f) & 0xffff); u[64] = (bf16_t)(pk2(hi, 0.f) & 0xffff);
                const float nr = l32[0] * hr - l32[1] * hi + er[j], ni = l32[0] * hi + l32[1] * hr + ei[j];
                hr = nr; hi = ni; }
        }
    }
}

DI void qkvnorm_phase(const Params& p) {
    const int tid_ = get_tid(); const int lane = tid_ & 63, wid = tid_ >> 6;
    const float* CQKV = (const float*)(p.ws + S_CQKV);
    bf16_t* CQN = (bf16_t*)(p.ws + S_CQN); bf16_t* CKVN = (bf16_t*)(p.ws + S_CKVN);
    for (int r = blockIdx.x * NWV + wid; r < NR; r += gridDim.x * NWV) {
        const float* src = CQKV + (size_t)r * 640;
        float a[6], k[4]; float sa = 0.f, sk = 0.f;
#pragma unroll
        for (int i = 0; i < 6; ++i) { a[i] = src[lane + 64 * i]; sa += a[i] * a[i]; }
#pragma unroll
        for (int i = 0; i < 4; ++i) { k[i] = src[384 + lane + 64 * i]; sk += k[i] * k[i]; }
        sa = wave_sum(sa); sk = wave_sum(sk);
        const float ra = rsqrtf(sa * (1.f / 384.f) + 1e-6f), rk = rsqrtf(sk * (1.f / 256.f) + 1e-6f);
#pragma unroll
        for (int i = 0; i < 6; ++i) CQN[(size_t)r * 384 + lane + 64 * i] = (bf16_t)(pk2(a[i] * ra * p.in[23][lane + 64 * i], 0.f) & 0xffff);
#pragma unroll
        for (int i = 0; i < 4; ++i) CKVN[(size_t)r * 256 + lane + 64 * i] = (bf16_t)(pk2(k[i] * rk * p.in[25][lane + 64 * i], 0.f) & 0xffff);
    }
}
DI float rope64(float x, int lane, const float* ROPE, int rpos, int cpos) {
    const float partner = __shfl_xor(x, 16);
    const int i = lane & 15; const int pos = lane < 32 ? rpos : cpos;
    const float c = ROPE[(pos * 16 + i) * 2], s = ROPE[(pos * 16 + i) * 2 + 1];
    return (lane & 16) ? x * c + partner * s : x * c - partner * s;
}
DI void mla_prep_phase(const Params& p) {
    const int tid_ = get_tid(); const int lane = tid_ & 63, wid = tid_ >> 6;
    bf16_t* QR = (bf16_t*)(p.ws + S_QRAW); const bf16_t* KN = (const bf16_t*)(p.ws + S_KNOPE); const float* KR = (const float*)(p.ws + H_KR);
    bf16_t* KA = (bf16_t*)(p.ws + S_KA); const float* ROPE = (const float*)(p.ws + T_ROPE);
    const float qsc = 0.07216878364870323f * LOG2E;
    const float qg0 = p.in[27][lane], qg1 = p.in[27][64 + lane], qg2 = p.in[27][128 + lane];
    const float kg0 = p.in[28][lane], kg1 = p.in[28][64 + lane], kg2 = p.in[28][128 + lane];
    for (int r = blockIdx.x * NWV + wid; r < NR; r += gridDim.x * NWV) {
        const bool lat = r >= NCTX; const int b = row_batch(r), tp = row_tpos(r); const int t = tp - CTX;
        const int rpos = lat ? (t >> 6) : 0, cpos = lat ? (t & 63) : 0;
        const float krv = KR[(size_t)r * 64 + lane];
#pragma unroll
        for (int h = 0; h < 4; ++h) {
            bf16_t* q = QR + (size_t)r * 768 + h * 192;
            float x0 = bf2f(q[lane]), x1 = bf2f(q[64 + lane]), x2 = bf2f(q[128 + lane]);
            float ss = wave_sum(x0 * x0 + x1 * x1 + x2 * x2);
            float rs = rsqrtf(ss * (1.f / 192.f) + 1e-6f);
            x0 *= rs * qg0; x1 *= rs * qg1; x2 *= rs * qg2;
            if (lat) x2 = rope64(x2, lane, ROPE, rpos, cpos);
            q[lane] = (bf16_t)(pk2(x0 * qsc, 0.f) & 0xffff); q[64 + lane] = (bf16_t)(pk2(x1 * qsc, 0.f) & 0xffff); q[128 + lane] = (bf16_t)(pk2(x2 * qsc, 0.f) & 0xffff);
            const bf16_t* kn = KN + (size_t)r * 512 + h * 128;
            float k0 = bf2f(kn[lane]), k1 = bf2f(kn[64 + lane]), k2 = krv;
            ss = wave_sum(k0 * k0 + k1 * k1 + k2 * k2);
            rs = rsqrtf(ss * (1.f / 192.f) + 1e-6f);
            k0 *= rs * kg0; k1 *= rs * kg1; k2 *= rs * kg2;
            if (lat) k2 = rope64(k2, lane, ROPE, rpos, cpos);
            bf16_t* kd = KA + ((size_t)(b * 4 + h) * TK + tp) * 192;
            kd[lane] = (bf16_t)(pk2(k0, 0.f) & 0xffff); kd[64 + lane] = (bf16_t)(pk2(k1, 0.f) & 0xffff); kd[128 + lane] = (bf16_t)(pk2(k2, 0.f) & 0xffff);
        }
    }
}
DI void win_prep_phase(const Params& p) {
    const int tid_ = get_tid(); const int lane = tid_ & 63, wid = tid_ >> 6;
    bf16_t* Q = (bf16_t*)(p.ws + S1_Q); const float* KRAW = (const float*)(p.ws + S1_KRAW); bf16_t* K1 = (bf16_t*)(p.ws + S1_K);
    const float* ROPE = (const float*)(p.ws + T_ROPE);
    const float qsc = 0.125f * LOG2E;
    const float qg = p.in[31][lane], kg = p.in[32][lane];
    for (int r = blockIdx.x * NWV + wid; r < NR; r += gridDim.x * NWV) {
        const bool lat = r >= NCTX; const int b = row_batch(r), tp = row_tpos(r); const int t = tp - CTX;
        const int rpos = lat ? (t >> 6) : 0, cpos = lat ? (t & 63) : 0;
        if (lat) {
#pragma unroll 4
            for (int h = 0; h < 16; ++h) { bf16_t* q = Q + (size_t)r * 1024 + h * 64;
                float x = bf2f(q[lane]); const float ss = wave_sum(x * x); x *= rsqrtf(ss * (1.f / 64.f) + 1e-6f) * qg;
                x = rope64(x, lane, ROPE, rpos, cpos);
                q[lane] = (bf16_t)(pk2(x * qsc, 0.f) & 0xffff); }
        }
#pragma unroll
        for (int h = 0; h < 4; ++h) { float x = KRAW[(size_t)r * 256 + h * 64 + lane]; const float ss = wave_sum(x * x); x *= rsqrtf(ss * (1.f / 64.f) + 1e-6f) * kg;
            if (lat) x = rope64(x, lane, ROPE, rpos, cpos);
            K1[((size_t)(b * 4 + h) * TK + tp) * 64 + lane] = (bf16_t)(pk2(x, 0.f) & 0xffff); }
    }
}

__global__ void __launch_bounds__(NTHREADS, 2) fwd_kernel(Params p) {
    extern __shared__ __attribute__((aligned(16))) char lds[];
    cg::grid_group grid = cg::this_grid();
    char* ws = p.ws;
    const bf16_t* WB = (const bf16_t*)ws;
    const float* MOD = (const float*)(ws + T_MOD);
    float* H = (float*)(ws + OFF_H);
    bf16_t* A0 = (bf16_t*)(ws + OFF_A0);
    const int bid = blockIdx.x, nb = gridDim.x;
    volatile LAS unsigned* xst = (volatile LAS unsigned*)(lds + (LDS_BYTES - 16));
    if (threadIdx.x == 0) { xst[0] = 0u; xst[1] = 0u; }
    __syncthreads();
    const XcdBarrier xb = xcd_barrier_post((unsigned*)(ws + T_BAR), xst);
    if (p.pad == 0x7fffffff) grid.sync();
#define GRID_SYNC() xcd_barrier(xb)

    { const int npair = p.jobs[4].tile0 >> 1, nit = 192 + 12 + npair;
      for (int it = bid; it < nit; it += nb) {
          if (it < 192) ada_item(lds, p, it);
          else if (it < 204) tables_item(p, it - 192);
          else { const int lt0 = (it - 204) * 2 + (int)(threadIdx.x >> 8); const bool live = lt0 < p.jobs[4].tile0; const int lt = live ? lt0 : 0; int j = 0;
#pragma unroll
              for (int q = 1; q < 11; ++q) if (lt >= p.jobs[q].tile0) j = q;
              transpose_tile(lds, ws, p.jobs[j], lt - p.jobs[j].tile0, live); } } }
    GRID_SYNC();
    modulate_rows(p, 0, 0, true, 0);
    s5_kk_phase(lds, p);
    GRID_SYNC();
    { EpiWin0 e{(bf16_t*)(ws + H_UA), (float*)(ws + S_CQKV), (float*)(ws + H_KR)};
      gemm_phase(lds, A0, 1024, WB + W_IN0, 1024, 0, NR / 256, 5, e); }
    s5_w1a_phase(p);
    { int rk, nrk; slack_rank((NR / 256) * 5, rk, nrk); transpose_range(lds, ws, p, p.jobs[4].tile0, p.jobs[7].tile0, rk, nrk); }
    GRID_SYNC();
    qkvnorm_phase(p);
    s5_w1b_phase(p);
    { EpiS1a e{(float*)(ws + H_E)};
      gemm_phase(lds, (const bf16_t*)(ws + H_UA), 768, (const bf16_t*)(ws + H_W1A), 512, 0, 3, 1, e, 32, (size_t)CHR * 768, (size_t)256 * 512); }
    { int rk, nrk; slack_rank(96, rk, nrk); transpose_range(lds, ws, p, p.jobs[7].tile0, p.jobs[9].tile0, rk, nrk); }
    GRID_SYNC();
    s5_carry_phase(p);
    { EpiBf16 e{(bf16_t*)(ws + S_QRAW), 768};
      gemm_phase(lds, (const bf16_t*)(ws + S_CQN), 384, WB + W_QB, 384, 0, NR / 256, 3, e); }
    { EpiKV e{(bf16_t*)(ws + S_KNOPE), (bf16_t*)(ws + S_VT)};
      gemm_phase(lds, (const bf16_t*)(ws + S_CKVN), 256, WB + W_KVB, 256, 0, NR / 256, 4, e); }
    GRID_SYNC();
    { EpiS1b e{(bf16_t*)(ws + S_YG)};
      gemm_phase(lds, (const bf16_t*)(ws + H_UA), 768, (const bf16_t*)(ws + A_W1B), 768, 0, 3, 2, e, 32, (size_t)CHR * 768, (size_t)512 * 768); }
    mla_prep_phase(p);
    GRID_SYNC();
    { const bf16_t* QR = (const bf16_t*)(ws + S_QRAW); const bf16_t* KA = (const bf16_t*)(ws + S_KA); const bf16_t* VT = (const bf16_t*)(ws + S_VT);
      const int nlat = 2 * 4 * 32, nall = nlat + 2 * 4;
      float mref; { float gq = 0.f, gk = 0.f;
        for (int d_ = 0; d_ < 192; ++d_) { gq = fmaxf(gq, fabsf(p.in[27][d_])); gk = fmaxf(gk, fabsf(p.in[28][d_])); }
        mref = 13.856406f * LOG2E * 1.02f * gq * gk; }
      for (int it = bid; it < nall; it += nb) {
          if (it < nlat) { const int qb = it & 31, h = (it >> 5) & 3, b = it >> 7; const size_t row = NCTX + (size_t)b * SEQ + qb * 256;
              attn_item<192, 128, false>(lds, QR + row * 768 + h * 192, 768, KA + (size_t)(b * 4 + h) * TK * 192, VT + (size_t)(b * 4 + h) * 128 * TK, 0, TK / 64, 0, 0, mref, 0.f,
                                         A0 + row * 1024 + 512 + h * 128, 1024, 0); }
          else { const int j = it - nlat; const int h = j & 3, b = j >> 2; const size_t row = (size_t)b * CTX;
              attn_item<192, 128, false>(lds, QR + row * 768 + h * 192, 768, KA + (size_t)(b * 4 + h) * TK * 192, VT + (size_t)(b * 4 + h) * 128 * TK, 0, 4, 0, 0, mref, 0.f,
                                         A0 + row * 1024 + 512 + h * 128, 1024, 0); } }
      EpiGLU e{(const bf16_t*)(ws + S_YG), p.in[22], A0};
      gemm_phase(lds, (const bf16_t*)(ws + S_YG), 512, WB + W_GLU, 512, 0, NR / 256, 2, e); }
    GRID_SYNC();
    { EpiRes e{p.in[2], p.in[0], H, H + (size_t)NCTX * 1024, MOD + 0 * 3 * 6144 + 2048, 0};
      gemm_phase(lds, A0, 1024, WB + W_OUT0, 1024, 2, NLAT / 256, 4, e);
      thin_gemm_ctx<4>(lds, A0, 1024, WB + W_OUT0, 1024, p.in[2], H, MOD + 0 * 3 * 6144 + 2048); }
    GRID_SYNC();
    modulate_rows(p, 0, 1, false, 0);
    GRID_SYNC();
    { EpiSwiGLU e{(bf16_t*)(ws + S_HID)};
      gemm_phase(lds, A0, 1024, WB + W_GU0, 1024, 0, NR / 256, 22, e); }
    { int rk, nrk; slack_rank((NR / 256) * 22, rk, nrk); transpose_range(lds, ws, p, p.jobs[9].tile0, p.jobs[9].tile0 + 704, rk, nrk); }
    GRID_SYNC();
    { EpiRes e{H, H + (size_t)NCTX * 1024, H, H + (size_t)NCTX * 1024, MOD + 0 * 3 * 6144 + 5120, 0};
      gemm_phase(lds, (const bf16_t*)(ws + S_HID), FH, WB + W_D0, FH, 2, NLAT / 256, 4, e);
      thin_gemm_ctx<11>(lds, (const bf16_t*)(ws + S_HID), FH, WB + W_D0, FH, H, H, MOD + 0 * 3 * 6144 + 5120); }
    GRID_SYNC();
    modulate_rows(p, 1, 0, false, 0);
    GRID_SYNC();
    { EpiWin1 e{(bf16_t*)(ws + S1_Q), (bf16_t*)(ws + S1_K), (bf16_t*)(ws + S1_VT), p.in[31], p.in[32], (const float*)(ws + T_ROPE)};
      gemm_phase(lds, A0, 1024, WB + W_IN1, 1024, 0, NR / 256, 6, e); }
    { int rk, nrk; slack_rank((NR / 256) * 6, rk, nrk); transpose_range(lds, ws, p, p.jobs[9].tile0 + 704, p.njobtiles, rk, nrk); }
    GRID_SYNC();
    { const bf16_t* Q = (const bf16_t*)(ws + S1_Q); const bf16_t* K1 = (const bf16_t*)(ws + S1_K); const bf16_t* VT = (const bf16_t*)(ws + S1_VT);
      const int nit = 2 * 16 * 32;
      float mref; { float gq = 0.f, gk = 0.f;
        for (int d_ = 0; d_ < 64; ++d_) { gq = fmaxf(gq, fabsf(p.in[31][d_])); gk = fmaxf(gk, fabsf(p.in[32][d_])); }
        mref = 8.f * LOG2E * 1.02f * gq * gk; }
      for (int it = bid; it < nit; it += nb) { const int g = it & 3, i = (it >> 2) & 31, kvh = (it >> 7) & 3, b = it >> 9; const int hq = kvh * 4 + g;
          const size_t row = NCTX + (size_t)b * SEQ + i * 256;
          const int l0 = (4 * i - 2) < 0 ? 0 : (4 * i - 2), l1 = (4 * i + 6) > 128 ? 128 : (4 * i + 6);
          attn_item<64, 64, true>(lds, Q + row * 1024 + hq * 64, 1024, K1 + (size_t)(b * 4 + kvh) * TK * 64, VT + (size_t)(b * 4 + kvh) * 64 * TK, 0, 4, 4 + l0, 4 + l1,
                                  mref, __builtin_amdgcn_exp2f(p.in[33][hq] * LOG2E - mref), A0 + row * 1024 + hq * 64, 1024, i * 256); } }
    GRID_SYNC();
    { EpiRes e{H, H + (size_t)NCTX * 1024, nullptr, H + (size_t)NCTX * 1024, MOD + 1 * 3 * 6144 + 2048, 0};
      gemm_phase(lds, A0, 1024, WB + W_OUT1, 1024, 2, NLAT / 256, 4, e); }
    GRID_SYNC();
    modulate_rows(p, 1, 1, false, NCTX);
    GRID_SYNC();
    { EpiSwiGLU e{(bf16_t*)(ws + S_HID)};
      gemm_phase(lds, A0, 1024, WB + W_GU1, 1024, 2, NLAT / 256, 22, e); }
    GRID_SYNC();
    { EpiRes e{H, H + (size_t)NCTX * 1024, nullptr, p.out, MOD + 1 * 3 * 6144 + 5120, 0};
      gemm_phase(lds, (const bf16_t*)(ws + S_HID), FH, WB + W_D1, FH, 2, NLAT / 256, 4, e); }
}

extern "C" void kernel_launch(void* const* d_in, const int* in_sizes, int n_in, void* d_out, int out_size, void* d_ws, size_t ws_size, hipStream_t stream) {
    static int grid_blocks = 0;
    if (grid_blocks == 0) {
        if (n_in != 34 || ws_size < WS_NEED) { fprintf(stderr, "kernel_launch: unexpected n_in %d / ws %zu (need %zu)\n", n_in, ws_size, (size_t)WS_NEED); grid_blocks = -1; return; }
        int dev = 0, cus = 0, per_cu = 0;
        (void)hipGetDevice(&dev);
        (void)hipDeviceGetAttribute(&cus, hipDeviceAttributeMultiprocessorCount, dev);
        (void)hipFuncSetAttribute((const void*)fwd_kernel, hipFuncAttributeMaxDynamicSharedMemorySize, LDS_BYTES);
        (void)hipOccupancyMaxActiveBlocksPerMultiprocessor(&per_cu, (const void*)fwd_kernel, NTHREADS, LDS_BYTES);
        if (per_cu < 1) { fprintf(stderr, "kernel_launch: occupancy query returned %d\n", per_cu); grid_blocks = -1; return; }
        if (per_cu > 1) per_cu = 1;
        grid_blocks = cus * per_cu;
        fprintf(stderr, "kernel_launch: grid %d (%d CUs x %d)\n", grid_blocks, cus, per_cu);
    }
    if (grid_blocks < 0) return;
    Params p{};
    for (int i = 0; i < 34; ++i) p.in[i] = (const float*)d_in[i];
    p.out = (float*)d_out; p.ws = (char*)d_ws;
    const float* fg = p.in[8]; const float* fu = p.in[9]; const float* fd = p.in[10];
    const size_t FW = (size_t)1024 * FH;
    int t0 = 0;
    auto mk = [&](int idx, const float* a, const float* b, size_t dst, int K, int ld, int npad, int mode) {
        Job& j = p.jobs[idx]; j.a = a; j.b = b; j.dst = dst; j.K = K; j.ld = ld; j.ntk = K / 64; j.ntn = npad / 64; j.tile0 = t0; j.mode = mode; t0 += j.ntk * j.ntn; };
    mk(0, p.in[11], nullptr, W_IN0, 1024, 1216, 1280, 0);
    mk(1, p.in[24], nullptr, W_QB, 384, 768, 768, 0);
    mk(2, p.in[26], nullptr, W_KVB, 256, 1024, 1024, 0);
    mk(3, p.in[21], nullptr, W_GLU, 512, 512, 512, 0);
    mk(4, p.in[12], nullptr, W_OUT0, 1024, 1024, 1024, 0);
    mk(5, fg, fu, W_GU0, 1024, FH, 5632, 1);
    mk(6, fd, nullptr, W_D0, FH, 1024, 1024, 0);
    mk(7, p.in[29], nullptr, W_IN1, 1024, 1536, 1536, 0);
    mk(8, p.in[30], nullptr, W_OUT1, 1024, 1024, 1024, 0);
    mk(9, fg + FW, fu + FW, W_GU1, 1024, FH, 5632, 1);
    mk(10, fd + FW, nullptr, W_D1, FH, 1024, 1024, 0);
    p.njobtiles = t0;
    if (hipMemsetAsync((char*)d_ws + T_BAR, 0, XCD_BAR_WORDS * 4, stream) != hipSuccess) { fprintf(stderr, "kernel_launch: memset failed\n"); return; }
    void* args[] = {&p};
    hipError_t e = hipLaunchCooperativeKernel((const void*)fwd_kernel, dim3(grid_blocks), dim3(NTHREADS), args, LDS_BYTES, stream);
    if (e != hipSuccess) fprintf(stderr, "cooperative launch failed: %s (grid %d)\n", hipGetErrorString(e), grid_blocks);
}
```

```cpp
#include <hip/hip_runtime.h>
#include <hip/hip_cooperative_groups.h>
#include <cstdio>
#include <cstdint>
namespace cg = cooperative_groups;

#define DI __device__ __forceinline__
typedef unsigned short bf16_t;
typedef short bf16x8 __attribute__((ext_vector_type(8)));
typedef short s16x4 __attribute__((ext_vector_type(4)));
typedef float f32x4 __attribute__((ext_vector_type(4)));
typedef float f32x2 __attribute__((ext_vector_type(2)));
typedef float f32x16 __attribute__((ext_vector_type(16)));
typedef unsigned u32x4 __attribute__((ext_vector_type(4)));
typedef unsigned u32x2 __attribute__((ext_vector_type(2)));
typedef __bf16 bf16v2 __attribute__((ext_vector_type(2)));

constexpr int DM = 1024, NBATCH = 2, SEQ = 8192, CTX = 256;
constexpr int NCTX = NBATCH * CTX;
constexpr int NLAT = NBATCH * SEQ;
constexpr int NR = NCTX + NLAT;
constexpr int TK = CTX + SEQ;
constexpr int FH = 2816;
constexpr int NCH = TK / 64;
constexpr float LOG2E = 1.4426950408889634f;
constexpr int LDS_BYTES = 131072 + 64;
constexpr int NTHREADS = 512, NWV = 8;

constexpr size_t W_IN0 = 0;
constexpr size_t W_QB = W_IN0 + (size_t)1280 * 1024;
constexpr size_t W_KVB = W_QB + (size_t)768 * 384;
constexpr size_t W_GLU = W_KVB + (size_t)1024 * 256;
constexpr size_t W_OUT0 = W_GLU + (size_t)512 * 512;
constexpr size_t W_GU0 = W_OUT0 + (size_t)1024 * 1024;
constexpr size_t W_D0 = W_GU0 + (size_t)5632 * 1024;
constexpr size_t W_IN1 = W_D0 + (size_t)1024 * 2816;
constexpr size_t W_OUT1 = W_IN1 + (size_t)1536 * 1024;
constexpr size_t W_GU1 = W_OUT1 + (size_t)1024 * 1024;
constexpr size_t W_D1 = W_GU1 + (size_t)5632 * 1024;
constexpr size_t W_END = W_D1 + (size_t)1024 * 2816;
constexpr size_t OFF_TAB = W_END * 2;
constexpr size_t T_MOD = OFF_TAB;
constexpr size_t T_ROPE = T_MOD + 2 * 3 * 6144 * 4;
constexpr size_t T_LAMB = T_ROPE + 128 * 16 * 2 * 4;
constexpr size_t T_LAM64 = T_LAMB + 2 * 32 * 64 * 8;
constexpr size_t T_BBAR = T_LAM64 + 2 * 32 * 64 * 8;
constexpr size_t T_BAR = T_BBAR + (size_t)2 * 32 * 64 * 16 * 8;
constexpr size_t OFF_H = OFF_TAB + (1u << 20);
constexpr size_t OFF_A0 = OFF_H + (size_t)NR * 1024 * 4;
constexpr size_t OFF_S = OFF_A0 + (size_t)NR * 1024 * 2;
constexpr size_t WS_NEED = OFF_S + (size_t)108134400;
constexpr size_t S_SSP = WS_NEED;
constexpr size_t WS_NEED2 = S_SSP + (size_t)NR * 10 * 4;
static_assert(WS_NEED2 <= ((size_t)256 << 20) && OFF_S + (size_t)NR * FH * 2 <= WS_NEED, "workspace");
constexpr int SL = 32;
constexpr int NCK = TK / SL;
constexpr int CHR = NBATCH * NCK;
constexpr size_t H_UA = OFF_H;
constexpr size_t H_KR = H_UA + (size_t)(32 * CHR + 256) * 768 * 2;
constexpr size_t H_E = H_KR + (size_t)NR * 64 * 4;
constexpr size_t H_KK = H_E + (size_t)32 * CHR * 256 * 4;
constexpr size_t H_POW = H_KK + (size_t)32 * 2 * 32 * 256 * 4;
constexpr size_t H_W1A = H_POW + (size_t)4096 * 33 * 8;
static_assert(H_W1A + (size_t)32 * 256 * 512 * 2 <= OFF_A0, "H region overflow");
constexpr size_t A_W1B = OFF_A0;
constexpr size_t S_CQN = OFF_S;
constexpr size_t S_CKVN = S_CQN + (size_t)NR * 384 * 2;
constexpr size_t S_YG = OFF_S;
constexpr size_t S_X = S_CKVN + (size_t)NR * 256 * 2;
constexpr size_t S_CQKV = S_X;
constexpr size_t S_QRAW = S_X;
constexpr size_t S_KNOPE = S_QRAW + (size_t)NR * 768 * 2;
constexpr size_t S_VT = S_KNOPE + (size_t)NR * 512 * 2;
constexpr size_t S_KA = S_VT + (size_t)2 * 4 * 128 * TK * 2;
static_assert(S_CQKV + (size_t)NR * 640 * 4 <= S_VT, "CQKV overlaps VT");
static_assert(S_KA + (size_t)2 * 4 * TK * 192 * 2 <= WS_NEED, "scratch overflow");
constexpr size_t S_HID = OFF_S;
constexpr size_t S1_Q = OFF_S;
constexpr size_t S1_KRAW = S1_Q + (size_t)NR * 1024 * 2;
constexpr size_t S1_K = S1_KRAW + (size_t)NR * 256 * 4;
constexpr size_t S1_VT = S1_K + (size_t)2 * 4 * TK * 64 * 2;

struct Job { const float* a; const float* b; const float* ks; unsigned long long dst; int K, ld, ntk, ntn, tile0, mode; };
struct Params {
    const float* in[34];
    float* out;
    char* ws;
    Job jobs[11];
    int njobtiles;
    int pad;
};

DI int get_tid() { int t = threadIdx.x; asm volatile("" : "+v"(t)); return t; }
DI unsigned pk2(float lo, float hi) { f32x2 v = {lo, hi}; return __builtin_bit_cast(unsigned, __builtin_convertvector(v, bf16v2)); }
DI float bf2f(unsigned short b) { return __uint_as_float(((unsigned)b) << 16); }
DI float wave_sum(float v) {
#pragma unroll
    for (int o = 32; o > 0; o >>= 1) v += __shfl_xor(v, o);
    return v;
}
DI int row_vec(int r) { return r < NCTX ? 2 : (r - NCTX) / SEQ; }
DI int row_batch(int r) { return r < NCTX ? r / CTX : (r - NCTX) / SEQ; }
DI int row_tpos(int r) { return r < NCTX ? r % CTX : CTX + (r - NCTX) % SEQ; }
DI float sigmoidf_(float x) { return 1.f / (1.f + __expf(-x)); }
DI float siluf_(float x) { return x / (1.f + __expf(-x)); }
DI float gelu_tanh(float y) { const float z = 0.7978845608028654f * (y + 0.044715f * y * y * y); const float t = 1.f - 2.f / (1.f + __expf(2.f * z)); return 0.5f * y * (1.f + t); }
DI void my_sincos(float x, float& s, float& c) {
    const float q = rintf(x * 0.636619772367581f);
    float r = fmaf(-q, 1.5703125f, x);
    r = fmaf(-q, 4.837512969970703125e-4f, r);
    r = fmaf(-q, 7.54978995489188216e-8f, r);
    const int qi = (int)q;
    const float r2 = r * r;
    const float sp = r + r * r2 * (-1.6666654611e-1f + r2 * (8.3321608736e-3f + r2 * (-1.9515295891e-4f)));
    const float cp = 1.0f - 0.5f * r2 + r2 * r2 * (4.166664568298827e-2f + r2 * (-1.388731625493765e-3f + r2 * 2.443315711809948e-5f));
    const int k = qi & 3;
    s = (k == 0) ? sp : (k == 1) ? cp : (k == 2) ? -sp : -cp;
    c = (k == 0) ? cp : (k == 1) ? -sp : (k == 2) ? -cp : sp;
}


#define XB_TMO      128
#define XB_XCNT(j)  (256  + 64 * (j))
#define XB_XSUB(j)  (1280 + 64 * (j))
#define XB_XGEN(j)  (2304 + 64 * (j))
#define XB_TOP      3328
#define XB_TOPGEN   3392
#define XCD_BAR_WORDS 3456
#define XB_SPIN_CAP (1u << 22)
#define LAS __attribute__((address_space(3)))
DI unsigned xb_ld(unsigned* p) { return __hip_atomic_load(p, __ATOMIC_RELAXED, __HIP_MEMORY_SCOPE_AGENT); }
DI unsigned xb_add(unsigned* p, unsigned v) { return __hip_atomic_fetch_add(p, v, __ATOMIC_RELAXED, __HIP_MEMORY_SCOPE_AGENT); }
DI unsigned xb_xcc_id() { return (unsigned)__builtin_amdgcn_s_getreg((3 << 11) | 20) & 0xFu; }
#define XB_SPIN(cond, bar) do { unsigned _sp = 0; while (cond) { __builtin_amdgcn_s_sleep(1); \
    if ((++_sp & 255u) == 0u) { if (xb_ld(&(bar)[XB_TMO])) break; if (_sp > XB_SPIN_CAP) { atomicAdd(&(bar)[XB_TMO], 1u); break; } } } } while (0)
struct XcdBarrier { unsigned* bar; unsigned x; volatile LAS unsigned* st; };
DI XcdBarrier xcd_barrier_post(unsigned* bar, volatile LAS unsigned* st) {
    XcdBarrier b; b.bar = bar; b.x = xb_xcc_id(); b.st = st;
    if (threadIdx.x == 0) (void)xb_add(&bar[XB_XCNT(b.x)], 1u);
    return b;
}
DI void xcd_barrier_complete(unsigned* bar, unsigned x, unsigned& nloc, unsigned& nx) {
    const unsigned G = gridDim.x * gridDim.y * gridDim.z;
    unsigned sum, cnt, mine, sp = 0u;
    for (;;) {
        sum = 0u; cnt = 0u; mine = 0u;
#pragma unroll
        for (unsigned j = 0; j < 16; ++j) { const unsigned c = xb_ld(&bar[XB_XCNT(j)]); sum += c; cnt += (c > 0u) ? 1u : 0u; mine = (j == x) ? c : mine; }
        if (sum == G) break;
        __builtin_amdgcn_s_sleep(1);
        if ((++sp & 255u) == 0u) { if (xb_ld(&bar[XB_TMO])) break; if (sp > XB_SPIN_CAP) { atomicAdd(&bar[XB_TMO], 1u); break; } }
    }
    nloc = mine > 0u ? mine : 1u; nx = cnt > 0u ? cnt : 1u;
}
DI void xcd_barrier(const XcdBarrier& b) {
    asm volatile("s_waitcnt vmcnt(0)" ::: "memory");
    __syncthreads();
    if (threadIdx.x == 0) {
        unsigned* bar = b.bar;
        __builtin_amdgcn_s_waitcnt(0);
        unsigned nloc = b.st[0], nx = b.st[1];
        if (nloc == 0u) { xcd_barrier_complete(bar, b.x, nloc, nx); b.st[0] = nloc; b.st[1] = nx; }
        const unsigned old = xb_add(&bar[XB_XSUB(b.x)], 1u);
        const unsigned gen = old / nloc;
        if (old + 1u == (gen + 1u) * nloc) {
            __builtin_amdgcn_fence(__ATOMIC_RELEASE, "agent");
            asm volatile("s_waitcnt vmcnt(0)" ::: "memory");
            const unsigned og = xb_add(&bar[XB_TOP], 1u);
            const unsigned tg = og / nx;
            if (og + 1u == (tg + 1u) * nx) xb_add(&bar[XB_TOPGEN], 1u);
            else XB_SPIN(xb_ld(&bar[XB_TOPGEN]) == tg, bar);
            __builtin_amdgcn_fence(__ATOMIC_ACQUIRE, "agent");
            xb_add(&bar[XB_XGEN(b.x)], 1u);
            asm volatile("s_waitcnt vmcnt(0)" ::: "memory");
        } else {
            XB_SPIN(xb_ld(&bar[XB_XGEN(b.x)]) == gen, bar);
            __builtin_amdgcn_fence(__ATOMIC_ACQUIRE, "agent");
            asm volatile("s_waitcnt vmcnt(0)" ::: "memory");
        }
    }
    __syncthreads();
}

DI void transpose_tile(char* lds, char* ws, const Job& jb, int lt, bool live) {
    const int tid512 = get_tid(); const int tid = tid512 & 255;
    float (*tile)[65] = (float (*)[65])(lds + (tid512 >> 8) * 17408);
    const int tk = lt % jb.ntk, tn = lt / jb.ntk;
    const int k0 = tk * 64, n0 = tn * 64;
    const int c4 = (tid & 15) * 4, rq = tid >> 4;
    const float* src; int col; bool valid = live;
    if (jb.mode == 0) { src = jb.a; col = n0 + c4; valid = live && col < jb.ld; }
    else { const int nsub = c4 >> 4, i = c4 & 15; src = (nsub & 1) ? jb.b : jb.a; col = tn * 32 + (nsub >> 1) * 16 + i; }
#pragma unroll
    for (int kk = 0; kk < 4; ++kk) { const int k = kk * 16 + rq; f32x4 v = valid ? *(const f32x4*)(src + (size_t)(k0 + k) * jb.ld + col) : (f32x4){0.f, 0.f, 0.f, 0.f};
        if (jb.ks) v = v * jb.ks[k0 + k];
        tile[k][c4] = v[0]; tile[k][c4 + 1] = v[1]; tile[k][c4 + 2] = v[2]; tile[k][c4 + 3] = v[3]; }
    __syncthreads();
    const int r = tid >> 2, ks = (tid & 3) * 16;
    unsigned w[8];
#pragma unroll
    for (int q = 0; q < 8; ++q) w[q] = pk2(tile[ks + 2 * q][r], tile[ks + 2 * q + 1][r]);
    bf16_t* d = (bf16_t*)(ws) + jb.dst + (size_t)(n0 + r) * jb.K + k0 + ks;
    if (live) { *(u32x4*)d = (u32x4){w[0], w[1], w[2], w[3]};
    *(u32x4*)(d + 8) = (u32x4){w[4], w[5], w[6], w[7]}; }
    __syncthreads();
}

DI void transpose_range(char* lds, char* ws, const Params& p, int t_begin, int t_end, int rank, int nranks) {
    if (rank < 0) return;
    for (int pr = (t_begin >> 1) + rank; pr < (t_end >> 1); pr += nranks) {
        const int lt = pr * 2 + (int)(threadIdx.x >> 8); int j = 0;
#pragma unroll
        for (int q = 1; q < 11; ++q) if (lt >= p.jobs[q].tile0) j = q;
        transpose_tile(lds, ws, p.jobs[j], lt - p.jobs[j].tile0, true);
    }
}
DI void slack_rank(int ntile, int& rank, int& nranks) { const int rem = ntile % (int)gridDim.x; if (rem == 0) { rank = blockIdx.x; nranks = gridDim.x; } else { rank = (int)blockIdx.x - rem; nranks = (int)gridDim.x - rem; } }

DI void ada_item(char* lds, const Params& p, int it) {
    float* sil = (float*)lds;
    float* red = sil + 3072;
    float* MOD = (float*)(p.ws + T_MOD);
    const int tid = get_tid(), layer = it / 96, n0 = (it % 96) * 64;
    for (int i = tid; i < 3072; i += NTHREADS) { const int v = i >> 10, k = i & 1023; const float x = v < 2 ? p.in[1][v * 1024 + k] : p.in[3][k]; sil[i] = siluf_(x); }
    __syncthreads();
    const int j4 = (tid & 15) * 4, kg = tid >> 4;
    const float* W = p.in[4] + (size_t)layer * 1024 * 6144 + n0 + j4;
    f32x4 a0 = {0.f, 0.f, 0.f, 0.f}, a1 = a0, a2 = a0;
#pragma unroll 8
    for (int k = kg * 32; k < kg * 32 + 32; ++k) { const f32x4 w = *(const f32x4*)(W + (size_t)k * 6144); a0 += sil[k] * w; a1 += sil[1024 + k] * w; a2 += sil[2048 + k] * w; }
    *(f32x4*)(red + (kg * 3 + 0) * 64 + j4) = a0; *(f32x4*)(red + (kg * 3 + 1) * 64 + j4) = a1; *(f32x4*)(red + (kg * 3 + 2) * 64 + j4) = a2;
    __syncthreads();
    if (tid < 192) { const int v = tid >> 6, jj = tid & 63;
        float s = p.in[5][layer * 6144 + n0 + jj];
#pragma unroll 8
        for (int q = 0; q < 32; ++q) s += red[(q * 3 + v) * 64 + jj];
        MOD[(layer * 3 + v) * 6144 + n0 + jj] = s; }
    __syncthreads();
}

DI void tables_item(const Params& p, int it) {
    const int tid = get_tid();
    if (it < 4) {
        const int e = it * 512 + tid, pos = e >> 4, i = e & 15;
        const float inv = exp2f(-(float)i * (13.287712379549449f / 16.f));
        float s, c; my_sincos((float)pos * inv, s, c);
        float* ROPE = (float*)(p.ws + T_ROPE); ROPE[e * 2] = c; ROPE[e * 2 + 1] = s;
    } else {
        const int e = (it - 4) * 512 + tid;
        const int dg = e >> 6;
        const float lr = p.in[13][e], li = p.in[14][e], step = expf(p.in[15][dg]);
        const float a = lr * step, b = li * step;
        const float ea = expf(a);
        float sb, cb; my_sincos(b, sb, cb);
        float sh, ch; my_sincos(0.5f * b, sh, ch);
        const float em1 = a * (1.f + a * 0.5f * (1.f + a * (1.f / 3.f) * (1.f + a * 0.25f * (1.f + a * 0.2f * (1.f + a * (1.f / 6.f))))));
        const float lbr = ea * cb, lbi = ea * sb;
        const float nr = em1 * cb - 2.f * sh * sh, ni = ea * sb;
        const float den = lr * lr + li * li;
        const float qr = (nr * lr + ni * li) / den, qi = (ni * lr - nr * li) / den;
        f32x2* BB = (f32x2*)(p.ws + T_BBAR);
#pragma unroll
        for (int s = 0; s < 16; ++s) { const float br = p.in[16][e * 16 + s], bi = p.in[17][e * 16 + s]; BB[e * 16 + s] = (f32x2){qr * br - qi * bi, qr * bi + qi * br}; }
        f32x2* POW = (f32x2*)(p.ws + H_POW) + (size_t)dg * 33 * 64 + (e & 63);
        float pr = 1.f, pi = 0.f;
        for (int q = 0; q <= 32; ++q) { POW[q * 64] = (f32x2){pr, pi}; const float nr2 = pr * lbr - pi * lbi, ni2 = pr * lbi + pi * lbr; pr = nr2; pi = ni2; }
    }
}

DI void modulate_rows(const Params& p, int layer, int which, bool from_inputs, int r0) {
    const int tid_ = get_tid(); const int lane = tid_ & 63, wid = tid_ >> 6;
    const float* gain = p.in[which ? 7 : 6] + layer * 1024;
    const float* modl = (const float*)(p.ws + T_MOD) + layer * 3 * 6144 + (which ? 3072 : 0);
    const float* H = (const float*)(p.ws + OFF_H);
    bf16_t* dst = (bf16_t*)(p.ws + OFF_A0);
    const int stride = gridDim.x * NWV;
    for (int ra = r0 + blockIdx.x * NWV + wid; ra < NR; ra += 2 * stride) {
        const int rb = ra + stride; const bool hb = rb < NR; const int rbb = hb ? rb : ra;
        const float* srca = from_inputs ? (ra < NCTX ? p.in[2] + (size_t)ra * 1024 : p.in[0] + (size_t)(ra - NCTX) * 1024) : H + (size_t)ra * 1024;
        const float* srcb = from_inputs ? (rbb < NCTX ? p.in[2] + (size_t)rbb * 1024 : p.in[0] + (size_t)(rbb - NCTX) * 1024) : H + (size_t)rbb * 1024;
        f32x4 xa[4], xb[4]; float sa = 0.f, sb = 0.f;
#pragma unroll
        for (int i = 0; i < 4; ++i) { xa[i] = *(const f32x4*)(srca + i * 256 + lane * 4); xb[i] = *(const f32x4*)(srcb + i * 256 + lane * 4); }
#pragma unroll
        for (int i = 0; i < 4; ++i) { sa += xa[i][0] * xa[i][0] + xa[i][1] * xa[i][1] + xa[i][2] * xa[i][2] + xa[i][3] * xa[i][3];
                                      sb += xb[i][0] * xb[i][0] + xb[i][1] * xb[i][1] + xb[i][2] * xb[i][2] + xb[i][3] * xb[i][3]; }
        sa = wave_sum(sa); sb = wave_sum(sb);
        const float rsa = rsqrtf(sa * (1.f / 1024.f) + 1e-6f), rsb = rsqrtf(sb * (1.f / 1024.f) + 1e-6f);
        const float* mva = modl + row_vec(ra) * 6144; const float* mvb = modl + row_vec(rbb) * 6144;
#pragma unroll
        for (int i = 0; i < 4; ++i) { const int c = i * 256 + lane * 4;
            const f32x4 g = *(const f32x4*)(gain + c);
            { const f32x4 sh = *(const f32x4*)(mva + c), sc = *(const f32x4*)(mva + 1024 + c); const f32x4 y = xa[i] * rsa * g * (1.f + sc) + sh;
              *(u32x2*)(dst + (size_t)ra * 1024 + c) = (u32x2){pk2(y[0], y[1]), pk2(y[2], y[3])}; }
            if (hb) { const f32x4 sh = *(const f32x4*)(mvb + c), sc = *(const f32x4*)(mvb + 1024 + c); const f32x4 y = xb[i] * rsb * g * (1.f + sc) + sh;
              *(u32x2*)(dst + (size_t)rb * 1024 + c) = (u32x2){pk2(y[0], y[1]), pk2(y[2], y[3])}; } }
    }
}

template <class Epi>
DI void gemm_phase(char* lds, const bf16_t* A0_, int lda, const bf16_t* Bt0_, int K, int mt0, int nmt, int nnt, const Epi& epi, int nbatch = 1, size_t sA = 0, size_t sB = 0, int ksplit = 1) {
    const int tid = get_tid(), lane = tid & 63, wid = tid >> 6, wr = wid >> 2, wc = wid & 3, fr = lane & 15, fq = lane >> 4;
    const int nk = (K >> 6) / ksplit;
    const int lrow = tid >> 3, lc = tid & 7, lkc = lc * 8;
    const int woff = lrow * 128 + ((lc ^ ((lrow >> 1) & 7)) << 4);
    const int ra0 = (wr * 128 + fr) * 128 + ((fq ^ (fr >> 1)) << 4);
    const int ra1 = (wr * 128 + fr) * 128 + (((4 + fq) ^ (fr >> 1)) << 4);
    const int rb0 = 32768 + (wc * 64 + fr) * 128 + ((fq ^ (fr >> 1)) << 4);
    const int rb1 = 32768 + (wc * 64 + fr) * 128 + (((4 + fq) ^ (fr >> 1)) << 4);
    const int per = nmt * nnt, ntile = nbatch * per * ksplit;
    const int myn = ((int)blockIdx.x < ntile) ? (ntile - (int)blockIdx.x + (int)gridDim.x - 1) / (int)gridDim.x : 0;
    const int total = myn * nk;
    f32x4 acc[8][4];
#pragma unroll
    for (int m = 0; m < 8; ++m)
#pragma unroll
        for (int n = 0; n < 4; ++n) acc[m][n] = (f32x4){0.f, 0.f, 0.f, 0.f};
    u32x4 sa[4], sb[4];
    int iti = 0, ikt = 0;
    const bf16_t* Ag = A0_; const bf16_t* Bg = Bt0_;
#define G_ISSUE() do { if (ikt == 0) { const int u_ = blockIdx.x + iti * gridDim.x; const int t_ = u_ / ksplit, sl_ = u_ - t_ * ksplit; const int gb_ = t_ / per, tr_ = t_ - gb_ * per; const int tm_ = tr_ / nnt, tn_ = tr_ - tm_ * nnt; \
            Ag = A0_ + (size_t)gb_ * sA + (size_t)((mt0 + tm_) * 256 + lrow) * lda + lkc + sl_ * nk * 64; Bg = Bt0_ + (size_t)gb_ * sB + (size_t)(tn_ * 256 + lrow) * K + lkc + sl_ * nk * 64; } \
        _Pragma("unroll") for (int i = 0; i < 4; ++i) { sa[i] = *(const u32x4*)(Ag + (size_t)i * 64 * lda + ikt * 64); sb[i] = *(const u32x4*)(Bg + (size_t)i * 64 * K + ikt * 64); } \
        if (++ikt == nk) { ikt = 0; ++iti; } } while (0)
#define G_WRITE(bufoff) do { _Pragma("unroll") for (int i = 0; i < 4; ++i) { *(u32x4*)(lds + (bufoff) + woff + i * 8192) = sa[i]; *(u32x4*)(lds + (bufoff) + 32768 + woff + i * 8192) = sb[i]; } } while (0)
#define G_COMPUTE(bufoff) do { _Pragma("unroll") for (int ks = 0; ks < 2; ++ks) { bf16x8 a[8], b[4]; \
        _Pragma("unroll") for (int m = 0; m < 8; ++m) a[m] = *(const bf16x8*)(lds + (bufoff) + (ks ? ra1 : ra0) + m * 2048); \
        _Pragma("unroll") for (int n = 0; n < 4; ++n) b[n] = *(const bf16x8*)(lds + (bufoff) + (ks ? rb1 : rb0) + n * 2048); \
        _Pragma("unroll") for (int m = 0; m < 8; ++m) _Pragma("unroll") for (int n = 0; n < 4; ++n) acc[m][n] = __builtin_amdgcn_mfma_f32_16x16x32_bf16(b[n], a[m], acc[m][n], 0, 0, 0); } } while (0)
    __syncthreads();
    if (total > 0) {
        G_ISSUE(); G_WRITE(0);
        if (total > 1) G_ISSUE();
    }
    __syncthreads();
    int cti = 0, ckt = 0;
    for (int q = 0; q < total; ++q) {
        const int cur = (q & 1) * 65536;
        if (q + 1 < total) G_WRITE(cur ^ 65536);
        if (q + 2 < total) G_ISSUE();
        G_COMPUTE(cur);
        __syncthreads();
        if (++ckt == nk) {
            const int u_ = blockIdx.x + cti * gridDim.x; const int t_ = u_ / ksplit; const int gb_ = t_ / per, tr_ = t_ - gb_ * per; const int tm_ = tr_ / nnt, tn_ = tr_ - tm_ * nnt;
            epi(acc, (mt0 + tm_) * 256 + wr * 128 + fr, tn_ * 256 + wc * 64 + fq * 4, gb_);
#pragma unroll
            for (int m = 0; m < 8; ++m)
#pragma unroll
                for (int n = 0; n < 4; ++n) acc[m][n] = (f32x4){0.f, 0.f, 0.f, 0.f};
            ckt = 0; ++cti;
        }
    }
#undef G_ISSUE
#undef G_WRITE
#undef G_COMPUTE
}

template <int KSP>
DI void thin_gemm_ctx(char* lds, const bf16_t* A, int lda, const bf16_t* Bt, int K, const float* res, float* dst, const float* gate) {
    const int tid = get_tid(), lane = tid & 63, wid = tid >> 6, fr = lane & 15, fq = lane >> 4;
    float* part = (float*)lds;
    for (int t = blockIdx.x; t < 256; t += gridDim.x) {
        const int m0 = (t >> 5) * 64, n0 = (t & 31) * 32;
        f32x4 acc[4][2];
#pragma unroll
        for (int m = 0; m < 4; ++m) { acc[m][0] = (f32x4){0.f, 0.f, 0.f, 0.f}; acc[m][1] = (f32x4){0.f, 0.f, 0.f, 0.f}; }
        const bf16_t* Ap = A + (size_t)(m0 + fr) * lda + wid * (KSP * 32) + fq * 8;
        const bf16_t* Bp = Bt + (size_t)(n0 + fr) * K + wid * (KSP * 32) + fq * 8;
#pragma unroll
        for (int k = 0; k < KSP; ++k) {
            bf16x8 a[4], b[2];
#pragma unroll
            for (int m = 0; m < 4; ++m) a[m] = *(const bf16x8*)(Ap + (size_t)m * 16 * lda + k * 32);
#pragma unroll
            for (int n = 0; n < 2; ++n) b[n] = *(const bf16x8*)(Bp + (size_t)n * 16 * K + k * 32);
#pragma unroll
            for (int m = 0; m < 4; ++m)
#pragma unroll
                for (int n = 0; n < 2; ++n) acc[m][n] = __builtin_amdgcn_mfma_f32_16x16x32_bf16(b[n], a[m], acc[m][n], 0, 0, 0);
        }
        __syncthreads();
#pragma unroll
        for (int m = 0; m < 4; ++m)
#pragma unroll
            for (int n = 0; n < 2; ++n) *(f32x4*)(part + ((wid * 64 + m * 16 + fr) * 32 + n * 16 + fq * 4)) = acc[m][n];
        __syncthreads();
        { const int row = tid >> 3, c4 = (tid & 7) * 4; f32x4 sum = (f32x4){0.f, 0.f, 0.f, 0.f};
#pragma unroll
          for (int w = 0; w < 8; ++w) sum += *(const f32x4*)(part + ((w * 64 + row) * 32 + c4));
          const size_t off = (size_t)(m0 + row) * 1024 + n0 + c4;
          const f32x4 g = *(const f32x4*)(gate + 2 * 6144 + n0 + c4), x = *(const f32x4*)(res + off);
          *(f32x4*)(dst + off) = x + g * sum; }
    }
    __syncthreads();
}

struct EpiWin0 {
    bf16_t* UA; bf16_t* CQN; bf16_t* CKVN; float* SSP; float* KR;
    DI void operator()(const f32x4 (&acc)[8][4], int row0, int col0, int gb) const {
        const int cw = col0 & ~63;
#pragma unroll
        for (int m = 0; m < 8; ++m) { const int ri = row0 + m * 16; const size_t r = ri;
            if (cw < 512) { const int b = row_batch(ri), tp = row_tpos(ri);
#pragma unroll
                for (int n = 0; n < 4; ++n) { const int c = col0 + n * 16; const f32x4 v = acc[m][n]; const int g = c >> 4, s0 = c & 15;
                    *(u32x2*)(UA + ((size_t)g * CHR + b * NCK + (tp >> 5)) * 768 + (tp & 31) * 16 + s0) = (u32x2){pk2(v[0], v[1]), pk2(v[2], v[3])}; }
            } else if (cw < 1152) { const bool isq = cw < 896; bf16_t* dst = isq ? CQN + r * 384 + (col0 - 512) : CKVN + r * 256 + (col0 - 896);
                float ss = 0.f;
#pragma unroll
                for (int n = 0; n < 4; ++n) { const f32x4 v = acc[m][n]; ss += v[0] * v[0] + v[1] * v[1] + v[2] * v[2] + v[3] * v[3];
                    *(u32x2*)(dst + n * 16) = (u32x2){pk2(v[0], v[1]), pk2(v[2], v[3])}; }
                ss += __shfl_xor(ss, 16); ss += __shfl_xor(ss, 32);
                if ((col0 & 15) == 0) SSP[r * 10 + ((cw - 512) >> 6)] = ss;
            } else if (cw < 1216) {
#pragma unroll
                for (int n = 0; n < 4; ++n) *(f32x4*)(KR + r * 64 + (col0 - 1152) + n * 16) = acc[m][n];
            } }
    }
};
struct EpiS1a {
    float* E;
    DI void operator()(const f32x4 (&acc)[8][4], int row0, int col0, int gb) const {
#pragma unroll
        for (int m = 0; m < 8; ++m) { const int r = row0 + m * 16; if (r >= CHR) continue;
#pragma unroll
            for (int n = 0; n < 4; ++n) *(f32x4*)(E + ((size_t)gb * CHR + r) * 256 + col0 + n * 16) = acc[m][n]; }
    }
};
struct EpiS1b {
    bf16_t* YG;
    DI void operator()(const f32x4 (&acc)[8][4], int row0, int col0, int gb) const {
#pragma unroll
        for (int m = 0; m < 8; ++m) { const int r = row0 + m * 16; if (r >= CHR) continue; const int b = r / NCK, c = r % NCK;
#pragma unroll
            for (int n = 0; n < 4; ++n) { const int cc = col0 + n * 16; const int tl = cc >> 4, s0 = cc & 15; const f32x4 v = acc[m][n];
                const int tp = c * SL + tl; const size_t row = tp < CTX ? (size_t)b * CTX + tp : (size_t)NCTX + (size_t)b * SEQ + (tp - CTX);
                *(u32x2*)(YG + row * 512 + gb * 16 + s0) = (u32x2){pk2(gelu_tanh(v[0]), gelu_tanh(v[1])), pk2(gelu_tanh(v[2]), gelu_tanh(v[3]))}; } }
    }
};
struct EpiBf16 {
    bf16_t* O; int ldo; const float* SSP;
    DI void operator()(const f32x4 (&acc)[8][4], int row0, int col0, int gb) const {
#pragma unroll
        for (int m = 0; m < 8; ++m) { const size_t r = row0 + m * 16; const float* sp = SSP + r * 10;
            const float rstd = rsqrtf(((sp[0] + sp[1]) + (sp[2] + sp[3]) + (sp[4] + sp[5])) * (1.f / 384.f) + 1e-6f);
#pragma unroll
            for (int n = 0; n < 4; ++n) { const int c = col0 + n * 16; const f32x4 v = acc[m][n] * rstd;
                *(u32x2*)(O + r * ldo + c) = (u32x2){pk2(v[0], v[1]), pk2(v[2], v[3])}; } }
    }
};
struct EpiKV {
    bf16_t* KNOPE; bf16_t* VT; const float* SSP;
    DI void operator()(const f32x4 (&acc)[8][4], int row0, int col0, int gb) const {
#pragma unroll
        for (int m = 0; m < 8; ++m) { const int r = row0 + m * 16; const int b = row_batch(r), tp = row_tpos(r); const float* sp = SSP + (size_t)r * 10 + 6;
            const float rstd = rsqrtf(((sp[0] + sp[1]) + (sp[2] + sp[3])) * (1.f / 256.f) + 1e-6f);
#pragma unroll
            for (int n = 0; n < 4; ++n) { const int c = col0 + n * 16; const int h = c >> 8, w = c & 255; const f32x4 v = acc[m][n] * rstd;
                if (w < 128) *(u32x2*)(KNOPE + (size_t)r * 512 + h * 128 + w) = (u32x2){pk2(v[0], v[1]), pk2(v[2], v[3])};
                else { bf16_t* d = VT + ((size_t)(b * 4 + h) * 128 + (w - 128)) * TK + tp; const unsigned p0 = pk2(v[0], v[1]), p1 = pk2(v[2], v[3]);
                    d[0] = (bf16_t)(p0 & 0xffff); d[TK] = (bf16_t)(p0 >> 16); d[2 * TK] = (bf16_t)(p1 & 0xffff); d[3 * TK] = (bf16_t)(p1 >> 16); } } }
    }
};
struct EpiGLU {
    const bf16_t* YG; const float* bias; bf16_t* CAT;
    DI void operator()(const f32x4 (&acc)[8][4], int row0, int col0, int gb) const {
#pragma unroll
        for (int m = 0; m < 8; ++m) { const size_t r = row0 + m * 16;
#pragma unroll
            for (int n = 0; n < 4; ++n) { const int c = col0 + n * 16; const f32x4 v = acc[m][n]; const f32x4 bv = *(const f32x4*)(bias + c);
                const u32x2 yy = *(const u32x2*)(YG + r * 512 + c);
                const float y0 = __uint_as_float(yy[0] << 16), y1 = __uint_as_float(yy[0] & 0xffff0000u), y2 = __uint_as_float(yy[1] << 16), y3 = __uint_as_float(yy[1] & 0xffff0000u);
                const float o0 = y0 * sigmoidf_(v[0] + bv[0]), o1 = y1 * sigmoidf_(v[1] + bv[1]), o2 = y2 * sigmoidf_(v[2] + bv[2]), o3 = y3 * sigmoidf_(v[3] + bv[3]);
                *(u32x2*)(CAT + r * 1024 + c) = (u32x2){pk2(o0, o1), pk2(o2, o3)}; } }
    }
};
struct EpiRes {
    const float* res_ctx; const float* res_lat; float* dst_ctx; float* dst_lat; const float* gate; int atomic;
    DI void operator()(const f32x4 (&acc)[8][4], int row0, int col0, int gb) const {
#pragma unroll
        for (int m = 0; m < 8; ++m) { const int r = row0 + m * 16;
            const float* rs = r < NCTX ? res_ctx + (size_t)r * 1024 : res_lat + (size_t)(r - NCTX) * 1024;
            float* ds = r < NCTX ? dst_ctx + (size_t)r * 1024 : dst_lat + (size_t)(r - NCTX) * 1024;
            if (r < NCTX && dst_ctx == nullptr) continue;
            const float* gv = gate + row_vec(r) * 6144;
#pragma unroll
            for (int n = 0; n < 4; ++n) { const int c = col0 + n * 16; const f32x4 g = *(const f32x4*)(gv + c);
                if (atomic) { const f32x4 v = g * acc[m][n];
#pragma unroll
                    for (int j = 0; j < 4; ++j) (void)__hip_atomic_fetch_add(ds + c + j, v[j], __ATOMIC_RELAXED, __HIP_MEMORY_SCOPE_AGENT); }
                else { const f32x4 x = *(const f32x4*)(rs + c); *(f32x4*)(ds + c) = x + g * acc[m][n]; } } }
    }
};
struct EpiSwiGLU {
    bf16_t* HID;
    DI void operator()(const f32x4 (&acc)[8][4], int row0, int col0, int gb) const {
        const int hc = (col0 >> 6) * 32 + (col0 & 15);
#pragma unroll
        for (int m = 0; m < 8; ++m) { const size_t r = row0 + m * 16;
#pragma unroll
            for (int q = 0; q < 2; ++q) { const f32x4 g = acc[m][2 * q], u = acc[m][2 * q + 1];
                const float o0 = siluf_(g[0]) * u[0], o1 = siluf_(g[1]) * u[1], o2 = siluf_(g[2]) * u[2], o3 = siluf_(g[3]) * u[3];
                *(u32x2*)(HID + r * FH + hc + q * 16) = (u32x2){pk2(o0, o1), pk2(o2, o3)}; } }
    }
};
struct EpiWin1 {
    bf16_t* Q; bf16_t* K1; bf16_t* VT; const float* qn; const float* kn; const float* ROPE;
    DI void operator()(const f32x4 (&acc)[8][4], int row0, int col0, int gb) const {
        const int cw = col0 & ~63, i0 = col0 & 15;
        if (cw >= 1280) {
#pragma unroll
            for (int m = 0; m < 8; ++m) { const int r = row0 + m * 16; const int b = row_batch(r), tp = row_tpos(r);
#pragma unroll
                for (int n = 0; n < 4; ++n) { const int cc = col0 + n * 16 - 1280, h = cc >> 6, d0 = cc & 63; const f32x4 v = acc[m][n];
                    bf16_t* d = VT + ((size_t)(b * 4 + h) * 64 + d0) * TK + tp; const unsigned p0 = pk2(v[0], v[1]), p1 = pk2(v[2], v[3]);
                    d[0] = (bf16_t)(p0 & 0xffff); d[TK] = (bf16_t)(p0 >> 16); d[2 * TK] = (bf16_t)(p1 & 0xffff); d[3 * TK] = (bf16_t)(p1 >> 16); } }
            return;
        }
        const bool isq = cw < 1024;
        const float* gn = isq ? qn : kn;
        f32x4 g[4];
#pragma unroll
        for (int n = 0; n < 4; ++n) g[n] = *(const f32x4*)(gn + n * 16 + i0);
        const float osc = isq ? 0.125f * LOG2E : 1.f;
#pragma unroll
        for (int m = 0; m < 8; ++m) { const int r = row0 + m * 16; const bool lat = r >= NCTX;
            if (isq && !lat) continue;
            const int b = row_batch(r), tp = row_tpos(r), t = tp - CTX;
            float ss = 0.f;
#pragma unroll
            for (int n = 0; n < 4; ++n) { const f32x4 v = acc[m][n]; ss += v[0] * v[0] + v[1] * v[1] + v[2] * v[2] + v[3] * v[3]; }
            ss += __shfl_xor(ss, 16); ss += __shfl_xor(ss, 32);
            const float rstd = rsqrtf(ss * (1.f / 64.f) + 1e-6f);
            f32x4 y[4];
#pragma unroll
            for (int n = 0; n < 4; ++n) y[n] = acc[m][n] * rstd * g[n];
            if (lat) { const float* rr = ROPE + ((t >> 6) * 16 + i0) * 2; const float* rc = ROPE + ((t & 63) * 16 + i0) * 2;
#pragma unroll
                for (int j = 0; j < 4; ++j) { const float c0 = rr[2 * j], s0 = rr[2 * j + 1], c1 = rc[2 * j], s1 = rc[2 * j + 1];
                    const float a0 = y[0][j], a1 = y[1][j], a2 = y[2][j], a3 = y[3][j];
                    y[0][j] = a0 * c0 - a1 * s0; y[1][j] = a1 * c0 + a0 * s0; y[2][j] = a2 * c1 - a3 * s1; y[3][j] = a3 * c1 + a2 * s1; } }
            bf16_t* dst = isq ? Q + (size_t)r * 1024 + cw + i0 : K1 + ((size_t)(b * 4 + ((cw - 1024) >> 6)) * TK + tp) * 64 + i0;
#pragma unroll
            for (int n = 0; n < 4; ++n) *(u32x2*)(dst + n * 16) = (u32x2){pk2(y[n][0] * osc, y[n][1] * osc), pk2(y[n][2] * osc, y[n][3] * osc)};
        }
    }
};

template <int DQK, int DV, bool WIN>
DI void attn_item(char* lds, const bf16_t* Q, int qstride, const bf16_t* Kb, const bf16_t* VTb, int ta0, int ta1, int tb0, int tb1,
                  float mref, float l_init, bf16_t* O, int ostride, int qpos0) {
    constexpr int NKS = DQK / 16, NDT = DV / 32, KSTR = DQK + 8, VSTR = 72, NG = NKS;
    constexpr int KCH = 64 * DQK / 8 / NTHREADS, VCH = DV * 8 / NTHREADS;
    constexpr int KBUF = 64 * KSTR, VBUF = DV * VSTR;
    bf16_t* Ks = (bf16_t*)lds; bf16_t* Vs = Ks + 2 * KBUF;
    const int tid = get_tid(), lane = tid & 63, wid = tid >> 6, r = lane & 31, h2 = lane >> 5;
    bf16x8 qf[NKS];
    { const bf16_t* qrow = Q + (size_t)(wid * 32 + r) * qstride + 8 * h2;
#pragma unroll
      for (int ks = 0; ks < NKS; ++ks) qf[ks] = *(const bf16x8*)(qrow + 16 * ks); }
    f32x16 o[NDT];
#pragma unroll
    for (int dt = 0; dt < NDT; ++dt)
#pragma unroll
        for (int i = 0; i < 16; ++i) o[dt][i] = 0.f;
    float lrun = (h2 == 0) ? l_init : 0.f;
    const int na = ta1 - ta0, ntot = na + (tb1 - tb0);
    u32x4 kr[KCH], vr[VCH];
    constexpr int KTPR = (DQK / 8) / KCH, VTPR = 8 / VCH;
    const int krow = tid / KTPR, kcol = (tid % KTPR) * (KCH * 8);
    const int vrow = tid / VTPR, vcol = (tid % VTPR) * (VCH * 8);
    const bf16_t* kgp = Kb + (size_t)krow * DQK + kcol;
    const bf16_t* vgp = VTb + (size_t)vrow * TK + vcol;
    bf16_t* ksp = Ks + krow * KSTR + kcol;
    bf16_t* vsp = Vs + vrow * VSTR + vcol;
    const bf16_t* kfp = Ks + r * KSTR + 8 * h2;
    const bf16_t* vfp = Vs + r * VSTR + 8 * h2;
#define A_TILE(itv) (((itv) < na) ? ta0 + (itv) : tb0 + ((itv) - na))
#define K_LOAD(itv) do { const bf16_t* kg = kgp + (size_t)A_TILE(itv) * 64 * DQK; _Pragma("unroll") for (int i = 0; i < KCH; ++i) kr[i] = *(const u32x4*)(kg + i * 8); } while (0)
#define V_LOADG(itv) do { const bf16_t* vg = vgp + A_TILE(itv) * 64; _Pragma("unroll") for (int i = 0; i < VCH; ++i) vr[i] = *(const u32x4*)(vg + i * 8); } while (0)
#define K_WRITE(bo) do { _Pragma("unroll") for (int i = 0; i < KCH; ++i) *(u32x4*)(ksp + (bo) + i * 8) = kr[i]; } while (0)
#define V_WRITE(bo) do { _Pragma("unroll") for (int i = 0; i < VCH; ++i) { const int c_ = (vcol >> 3) + i; bf16_t* d_ = vsp - vcol + (bo) + (c_ >> 1) * 16 + (c_ & 1) * 4; \
            *(u32x2*)d_ = (u32x2){vr[i][0], vr[i][1]}; *(u32x2*)(d_ + 8) = (u32x2){vr[i][2], vr[i][3]}; } } while (0)
#define T_ACTIVE(itv) (!(WIN && A_TILE(itv) >= 4 && ((A_TILE(itv) - 4) * 64 > qpos0 + wid * 32 + 31 + 128 || (A_TILE(itv) - 4) * 64 + 63 < qpos0 + wid * 32 - 128)))
#define S_MASK(S0, S1, itv) do { if (WIN && A_TILE(itv) >= 4) { const int qp = qpos0 + wid * 32 + r, kp0 = (A_TILE(itv) - 4) * 64 + 4 * h2; \
        _Pragma("unroll") for (int i = 0; i < 16; ++i) { const int d0 = kp0 + (i & 3) + 8 * (i >> 2) - qp, d1 = d0 + 32; \
            if (d0 > 128 || d0 < -128) S0[i] = -1e30f; if (d1 > 128 || d1 < -128) S1[i] = -1e30f; } } } while (0)
    f32x16 s0, s1;
    __syncthreads();
    K_LOAD(0); K_WRITE(0);
    if (1 < ntot) K_LOAD(1);
    V_LOADG(0);
    __syncthreads();
#pragma unroll
    for (int i = 0; i < 16; ++i) { s0[i] = -mref; s1[i] = -mref; }
#pragma unroll 1
    for (int it = -1; it < ntot; ++it) {
        const int kb_n = ((it + 1) & 1) * KBUF, vb_c = (it & 1) * VBUF;
        if (it + 2 < ntot) K_WRITE((it & 1) * KBUF);
        if (it + 1 < ntot) V_WRITE(((it + 1) & 1) * VBUF);
        __builtin_amdgcn_sched_barrier(0);
        const bool act_c = (it >= 0) && T_ACTIVE(it), act_n = (it + 1 < ntot) && T_ACTIVE(it + 1);
        f32x16 n0, n1;
#pragma unroll
        for (int i = 0; i < 16; ++i) { n0[i] = -mref; n1[i] = -mref; }
        float rs = 0.f;
        unsigned pk[16];
#define P_PAIR(j) do { const float e0_ = __builtin_amdgcn_exp2f((j) < 8 ? s0[2 * ((j) & 7)] : s1[2 * ((j) & 7)]), e1_ = __builtin_amdgcn_exp2f((j) < 8 ? s0[2 * ((j) & 7) + 1] : s1[2 * ((j) & 7) + 1]); rs += e0_ + e1_; pk[j] = pk2(e0_, e1_); } while (0)
        if (act_c && act_n) {
#pragma unroll
            for (int g = 0; g < NG; ++g) {
                const bf16x8 ka = *(const bf16x8*)(kfp + kb_n + 16 * g), kb = *(const bf16x8*)(kfp + kb_n + 32 * KSTR + 16 * g);
                n0 = __builtin_amdgcn_mfma_f32_32x32x16_bf16(ka, qf[g], n0, 0, 0, 0);
                n1 = __builtin_amdgcn_mfma_f32_32x32x16_bf16(kb, qf[g], n1, 0, 0, 0);
#pragma unroll
                for (int j = (16 * g) / NG; j < (16 * (g + 1)) / NG; ++j) P_PAIR(j);
            }
            S_MASK(n0, n1, it + 1);
        } else {
            if (act_n) {
#pragma unroll
                for (int ks = 0; ks < NKS; ++ks) { const bf16x8 k0 = *(const bf16x8*)(kfp + kb_n + 16 * ks), k1 = *(const bf16x8*)(kfp + kb_n + 32 * KSTR + 16 * ks);
                    n0 = __builtin_amdgcn_mfma_f32_32x32x16_bf16(k0, qf[ks], n0, 0, 0, 0); n1 = __builtin_amdgcn_mfma_f32_32x32x16_bf16(k1, qf[ks], n1, 0, 0, 0); }
                S_MASK(n0, n1, it + 1);
            }
            if (act_c) {
#pragma unroll
                for (int j = 0; j < 16; ++j) P_PAIR(j);
            }
        }
#undef P_PAIR
        __builtin_amdgcn_sched_barrier(0);
        if (it + 3 < ntot) K_LOAD(it + 3);
        if (it + 2 < ntot) V_LOADG(it + 2);
        __builtin_amdgcn_sched_barrier(0);
        if (act_c) {
            lrun += rs;
#pragma unroll
            for (int q = 0; q < 4; ++q) {
                const u32x4 pw = {pk[4 * q], pk[4 * q + 1], pk[4 * q + 2], pk[4 * q + 3]};
                const bf16x8 pf = __builtin_bit_cast(bf16x8, pw);
#pragma unroll
                for (int dt = 0; dt < NDT; ++dt) { const bf16x8 vf = *(const bf16x8*)(vfp + vb_c + (32 * dt) * VSTR + 16 * q);
                    o[dt] = __builtin_amdgcn_mfma_f32_32x32x16_bf16(vf, pf, o[dt], 0, 0, 0); }
            }
        }
        s0 = n0; s1 = n1;
        __syncthreads();
    }
#undef A_TILE
#undef K_LOAD
#undef V_LOADG
#undef K_WRITE
#undef V_WRITE
#undef T_ACTIVE
#undef S_MASK
    lrun += __shfl_xor(lrun, 32);
    const float inv = 1.f / lrun;
    bf16_t* orow = O + (size_t)(wid * 32 + r) * ostride;
#pragma unroll
    for (int dt = 0; dt < NDT; ++dt)
#pragma unroll
        for (int g = 0; g < 4; ++g)
            *(u32x2*)(orow + 32 * dt + 8 * g + 4 * h2) = (u32x2){pk2(o[dt][4 * g] * inv, o[dt][4 * g + 1] * inv), pk2(o[dt][4 * g + 2] * inv, o[dt][4 * g + 3] * inv)};
    __syncthreads();
}

DI void s5_kk_phase(char* lds, const Params& p) {
    const int tid512 = get_tid(); const int tid = tid512 & 255, s = tid >> 4, sp = tid & 15, dh = tid512 >> 8;
    f32x2* sbb = (f32x2*)lds;
    f32x2* scc = sbb + 1024;
    f32x2* spw = scc + 1024;
    const f32x2* POW = (const f32x2*)(p.ws + H_POW); const f32x2* BB = (const f32x2*)(p.ws + T_BBAR); float* KK = (float*)(p.ws + H_KK);
    for (int it = blockIdx.x; it < 32 * 2 * 4; it += gridDim.x) {
        const int dq = it & 3, dir = (it >> 2) & 1, g = it >> 3; const int dg = dir * 32 + g;
        __syncthreads();
        for (int i = tid512; i < 1024; i += NTHREADS) { sbb[i] = BB[(size_t)dg * 1024 + i]; scc[i] = (f32x2){p.in[18][(size_t)dg * 1024 + i], p.in[19][(size_t)dg * 1024 + i]}; }
        { const int i = tid512; spw[i] = POW[((size_t)dg * 33 + dq * 8 + (i >> 6)) * 64 + (i & 63)]; }
        __syncthreads();
        float acc[4] = {0.f, 0.f, 0.f, 0.f};
#pragma unroll 4
        for (int pp = 0; pp < 64; ++pp) { const f32x2 bb = sbb[pp * 16 + sp], cc = scc[s * 64 + pp];
#pragma unroll
            for (int q = 0; q < 4; ++q) { const f32x2 pw = spw[(dh * 4 + q) * 64 + pp];
                const float zr = pw[0] * bb[0] - pw[1] * bb[1], zi = pw[0] * bb[1] + pw[1] * bb[0];
                acc[q] += cc[0] * zr - cc[1] * zi; } }
#pragma unroll
        for (int q = 0; q < 4; ++q) KK[(size_t)((g * 2 + dir) * 32 + dq * 8 + dh * 4 + q) * 256 + tid] = acc[q];
    }
    __syncthreads();
}
DI void s5_w1a_phase(const Params& p) {
    const int tid = get_tid();
    const f32x2* POW = (const f32x2*)(p.ws + H_POW); const f32x2* BB = (const f32x2*)(p.ws + T_BBAR); bf16_t* W = (bf16_t*)(p.ws + H_W1A);
    for (int idx = blockIdx.x * NTHREADS + tid; idx < 2048 * 256; idx += gridDim.x * NTHREADS) {
        const int kq = idx & 63, n = (idx >> 6) & 255, g = idx >> 14;
        const int dir = n >> 7, ri = (n >> 6) & 1, pp = n & 63; const int e = (dir * 32 + g) * 64 + pp; const int tl = kq >> 1, s0 = (kq & 1) * 8;
        const f32x2 pw = POW[((size_t)(dir * 32 + g) * 33 + (dir ? tl : 31 - tl)) * 64 + pp];
        float v[8];
#pragma unroll
        for (int j = 0; j < 8; ++j) { const f32x2 bb = BB[e * 16 + s0 + j]; v[j] = ri ? pw[0] * bb[1] + pw[1] * bb[0] : pw[0] * bb[0] - pw[1] * bb[1]; }
        *(u32x4*)(W + ((size_t)g * 256 + n) * 512 + kq * 8) = (u32x4){pk2(v[0], v[1]), pk2(v[2], v[3]), pk2(v[4], v[5]), pk2(v[6], v[7])};
    }
}
DI void s5_w1b_phase(const Params& p) {
    const int tid = get_tid();
    const f32x2* POW = (const f32x2*)(p.ws + H_POW); const float* KK = (const float*)(p.ws + H_KK); bf16_t* W = (bf16_t*)(p.ws + A_W1B);
    for (int idx = blockIdx.x * NTHREADS + tid; idx < 6144 * 256; idx += gridDim.x * NTHREADS) {
        const int kq = idx % 96, n = (idx / 96) & 511, g = idx / (96 * 512);
        const int tl = n >> 4, s = n & 15;
        float v[8];
        if (kq < 64) { const int tl2 = kq >> 1, s0 = (kq & 1) * 8;
            f32x4 x0 = {0.f, 0.f, 0.f, 0.f}, x1 = x0;
            if (tl2 <= tl) { const float* k0 = KK + (size_t)((g * 2 + 0) * 32 + (tl - tl2)) * 256 + s * 16 + s0; x0 += *(const f32x4*)k0; x1 += *(const f32x4*)(k0 + 4); }
            if (tl2 >= tl) { const float* k1 = KK + (size_t)((g * 2 + 1) * 32 + (tl2 - tl)) * 256 + s * 16 + s0; x0 += *(const f32x4*)k1; x1 += *(const f32x4*)(k1 + 4); }
#pragma unroll
            for (int j = 0; j < 4; ++j) { v[j] = x0[j]; v[4 + j] = x1[j]; }
            if (tl2 == tl && (s >> 3) == (kq & 1)) { const float dv = p.in[20][g * 16 + s];
#pragma unroll
                for (int j = 0; j < 8; ++j) if (j == (s & 7)) v[j] += dv; }
        } else { const int k2 = (kq - 64) * 8; const int dir = k2 >> 7, ri = (k2 >> 6) & 1, p0 = k2 & 63;
            const float* cre = p.in[18] + ((size_t)(dir * 32 + g) * 16 + s) * 64 + p0; const float* cim = p.in[19] + ((size_t)(dir * 32 + g) * 16 + s) * 64 + p0;
            const f32x2* pwp = POW + ((size_t)(dir * 32 + g) * 33 + (dir ? 32 - tl : tl + 1)) * 64 + p0;
            const f32x4 cr0 = *(const f32x4*)cre, cr1 = *(const f32x4*)(cre + 4), ci0 = *(const f32x4*)cim, ci1 = *(const f32x4*)(cim + 4);
#pragma unroll
            for (int j = 0; j < 8; ++j) { const f32x2 pw = pwp[j];
                const float cr = j < 4 ? cr0[j & 3] : cr1[j & 3], ci = j < 4 ? ci0[j & 3] : ci1[j & 3];
                v[j] = ri ? -(cr * pw[1] + ci * pw[0]) : cr * pw[0] - ci * pw[1]; }
        }
        *(u32x4*)(W + ((size_t)g * 512 + n) * 768 + kq * 8) = (u32x4){pk2(v[0], v[1]), pk2(v[2], v[3]), pk2(v[4], v[5]), pk2(v[6], v[7])};
    }
}
DI void s5_carry_phase(const Params& p) {
    const int tid_ = get_tid(); const int lane = tid_ & 63, wid = tid_ >> 6;
    const f32x2* POW = (const f32x2*)(p.ws + H_POW); const float* E = (const float*)(p.ws + H_E); bf16_t* UA = (bf16_t*)(p.ws + H_UA);
    for (int it = ((int)gridDim.x - 1 - (int)blockIdx.x) * NWV + wid; it < 2 * 2 * 32; it += gridDim.x * NWV) {
        const int g = it & 31, dir = (it >> 5) & 1, b = it >> 6;
        const f32x2 l32 = POW[((size_t)(dir * 32 + g) * 33 + 32) * 64 + lane];
        float hr = 0.f, hi = 0.f;
        float er[8], ei[8], fr_[8], fi_[8];
#define C_IDX(i_) ((size_t)g * CHR + b * NCK + (dir ? ((i_) < 8 ? 7 - (i_) : NCK - 1 - ((i_) - 8)) : (i_)))
#define C_LOAD(R, I, i0_) do { _Pragma("unroll") for (int j = 0; j < 8; ++j) { const size_t m = C_IDX((i0_) + j); R[j] = E[m * 256 + dir * 128 + lane]; I[j] = E[m * 256 + dir * 128 + 64 + lane]; } } while (0)
#define C_STEP(R, I, i0_) do { _Pragma("unroll") for (int j = 0; j < 8; ++j) { const size_t m = C_IDX((i0_) + j); bf16_t* u = UA + m * 768 + 512 + dir * 128 + lane; \
            u[0] = (bf16_t)(pk2(hr, 0.f) & 0xffff); u[64] = (bf16_t)(pk2(hi, 0.f) & 0xffff); \
            const float nr = l32[0] * hr - l32[1] * hi + R[j], ni = l32[0] * hi + l32[1] * hr + I[j]; hr = nr; hi = ni; } } while (0)
        C_LOAD(er, ei, 0);
        for (int i0 = 0; i0 < NCK; i0 += 16) {
            if (i0 + 8 < NCK) C_LOAD(fr_, fi_, i0 + 8);
            C_STEP(er, ei, i0);
            if (i0 + 8 < NCK) { if (i0 + 16 < NCK) C_LOAD(er, ei, i0 + 16); C_STEP(fr_, fi_, i0 + 8); }
        }
#undef C_IDX
#undef C_LOAD
#undef C_STEP
    }
}

DI void qkvnorm_phase(const Params& p) {
    const int tid_ = get_tid(); const int lane = tid_ & 63, wid = tid_ >> 6;
    const float* CQKV = (const float*)(p.ws + S_CQKV);
    bf16_t* CQN = (bf16_t*)(p.ws + S_CQN); bf16_t* CKVN = (bf16_t*)(p.ws + S_CKVN);
    for (int r = blockIdx.x * NWV + wid; r < NR; r += gridDim.x * NWV) {
        const float* src = CQKV + (size_t)r * 640;
        float a[6], k[4]; float sa = 0.f, sk = 0.f;
#pragma unroll
        for (int i = 0; i < 6; ++i) { a[i] = src[lane + 64 * i]; sa += a[i] * a[i]; }
#pragma unroll
        for (int i = 0; i < 4; ++i) { k[i] = src[384 + lane + 64 * i]; sk += k[i] * k[i]; }
        sa = wave_sum(sa); sk = wave_sum(sk);
        const float ra = rsqrtf(sa * (1.f / 384.f) + 1e-6f), rk = rsqrtf(sk * (1.f / 256.f) + 1e-6f);
#pragma unroll
        for (int i = 0; i < 6; ++i) CQN[(size_t)r * 384 + lane + 64 * i] = (bf16_t)(pk2(a[i] * ra * p.in[23][lane + 64 * i], 0.f) & 0xffff);
#pragma unroll
        for (int i = 0; i < 4; ++i) CKVN[(size_t)r * 256 + lane + 64 * i] = (bf16_t)(pk2(k[i] * rk * p.in[25][lane + 64 * i], 0.f) & 0xffff);
    }
}
DI float rope64(float x, int lane, const float* ROPE, int rpos, int cpos) {
    const float partner = __shfl_xor(x, 16);
    const int i = lane & 15; const int pos = lane < 32 ? rpos : cpos;
    const float c = ROPE[(pos * 16 + i) * 2], s = ROPE[(pos * 16 + i) * 2 + 1];
    return (lane & 16) ? x * c + partner * s : x * c - partner * s;
}
DI void mla_prep_phase(const Params& p) {
    const int tid_ = get_tid(); const int lane = tid_ & 63, wid = tid_ >> 6;
    bf16_t* QR = (bf16_t*)(p.ws + S_QRAW); const bf16_t* KN = (const bf16_t*)(p.ws + S_KNOPE); const float* KR = (const float*)(p.ws + H_KR);
    bf16_t* KA = (bf16_t*)(p.ws + S_KA); const float* ROPE = (const float*)(p.ws + T_ROPE);
    const float qsc = 0.07216878364870323f * LOG2E;
    const float qg0 = p.in[27][lane], qg1 = p.in[27][64 + lane], qg2 = p.in[27][128 + lane];
    const float kg0 = p.in[28][lane], kg1 = p.in[28][64 + lane], kg2 = p.in[28][128 + lane];
    for (int r = blockIdx.x * NWV + wid; r < NR; r += gridDim.x * NWV) {
        const bool lat = r >= NCTX; const int b = row_batch(r), tp = row_tpos(r); const int t = tp - CTX;
        const int rpos = lat ? (t >> 6) : 0, cpos = lat ? (t & 63) : 0;
        const float krv = KR[(size_t)r * 64 + lane];
#pragma unroll
        for (int h = 0; h < 4; ++h) {
            bf16_t* q = QR + (size_t)r * 768 + h * 192;
            float x0 = bf2f(q[lane]), x1 = bf2f(q[64 + lane]), x2 = bf2f(q[128 + lane]);
            float ss = wave_sum(x0 * x0 + x1 * x1 + x2 * x2);
            float rs = rsqrtf(ss * (1.f / 192.f) + 1e-6f);
            x0 *= rs * qg0; x1 *= rs * qg1; x2 *= rs * qg2;
            if (lat) x2 = rope64(x2, lane, ROPE, rpos, cpos);
            q[lane] = (bf16_t)(pk2(x0 * qsc, 0.f) & 0xffff); q[64 + lane] = (bf16_t)(pk2(x1 * qsc, 0.f) & 0xffff); q[128 + lane] = (bf16_t)(pk2(x2 * qsc, 0.f) & 0xffff);
            const bf16_t* kn = KN + (size_t)r * 512 + h * 128;
            float k0 = bf2f(kn[lane]), k1 = bf2f(kn[64 + lane]), k2 = krv;
            ss = wave_sum(k0 * k0 + k1 * k1 + k2 * k2);
            rs = rsqrtf(ss * (1.f / 192.f) + 1e-6f);
            k0 *= rs * kg0; k1 *= rs * kg1; k2 *= rs * kg2;
            if (lat) k2 = rope64(k2, lane, ROPE, rpos, cpos);
            bf16_t* kd = KA + ((size_t)(b * 4 + h) * TK + tp) * 192;
            kd[lane] = (bf16_t)(pk2(k0, 0.f) & 0xffff); kd[64 + lane] = (bf16_t)(pk2(k1, 0.f) & 0xffff); kd[128 + lane] = (bf16_t)(pk2(k2, 0.f) & 0xffff);
        }
    }
}
DI void win_prep_phase(const Params& p) {
    const int tid_ = get_tid(); const int lane = tid_ & 63, wid = tid_ >> 6;
    bf16_t* Q = (bf16_t*)(p.ws + S1_Q); const float* KRAW = (const float*)(p.ws + S1_KRAW); bf16_t* K1 = (bf16_t*)(p.ws + S1_K);
    const float* ROPE = (const float*)(p.ws + T_ROPE);
    const float qsc = 0.125f * LOG2E;
    const float qg = p.in[31][lane], kg = p.in[32][lane];
    for (int r = blockIdx.x * NWV + wid; r < NR; r += gridDim.x * NWV) {
        const bool lat = r >= NCTX; const int b = row_batch(r), tp = row_tpos(r); const int t = tp - CTX;
        const int rpos = lat ? (t >> 6) : 0, cpos = lat ? (t & 63) : 0;
        if (lat) {
#pragma unroll 4
            for (int h = 0; h < 16; ++h) { bf16_t* q = Q + (size_t)r * 1024 + h * 64;
                float x = bf2f(q[lane]); const float ss = wave_sum(x * x); x *= rsqrtf(ss * (1.f / 64.f) + 1e-6f) * qg;
                x = rope64(x, lane, ROPE, rpos, cpos);
                q[lane] = (bf16_t)(pk2(x * qsc, 0.f) & 0xffff); }
        }
#pragma unroll
        for (int h = 0; h < 4; ++h) { float x = KRAW[(size_t)r * 256 + h * 64 + lane]; const float ss = wave_sum(x * x); x *= rsqrtf(ss * (1.f / 64.f) + 1e-6f) * kg;
            if (lat) x = rope64(x, lane, ROPE, rpos, cpos);
            K1[((size_t)(b * 4 + h) * TK + tp) * 64 + lane] = (bf16_t)(pk2(x, 0.f) & 0xffff); }
    }
}

__global__ void __launch_bounds__(NTHREADS, 2) fwd_kernel(Params p) {
    extern __shared__ __attribute__((aligned(16))) char lds[];
    cg::grid_group grid = cg::this_grid();
    char* ws = p.ws;
    const bf16_t* WB = (const bf16_t*)ws;
    const float* MOD = (const float*)(ws + T_MOD);
    float* H = (float*)(ws + OFF_H);
    bf16_t* A0 = (bf16_t*)(ws + OFF_A0);
    const int bid = blockIdx.x, nb = gridDim.x;
    volatile LAS unsigned* xst = (volatile LAS unsigned*)(lds + (LDS_BYTES - 16));
    if (threadIdx.x == 0) { xst[0] = 0u; xst[1] = 0u; }
    __syncthreads();
    const XcdBarrier xb = xcd_barrier_post((unsigned*)(ws + T_BAR), xst);
    if (p.pad == 0x7fffffff) grid.sync();
#define GRID_SYNC() xcd_barrier(xb)

    { const int npair = p.jobs[4].tile0 >> 1, nit = 192 + 12 + npair;
      for (int it = bid; it < nit; it += nb) {
          if (it < 192) ada_item(lds, p, it);
          else if (it < 204) tables_item(p, it - 192);
          else { const int lt0 = (it - 204) * 2 + (int)(threadIdx.x >> 8); const bool live = lt0 < p.jobs[4].tile0; const int lt = live ? lt0 : 0; int j = 0;
#pragma unroll
              for (int q = 1; q < 11; ++q) if (lt >= p.jobs[q].tile0) j = q;
              transpose_tile(lds, ws, p.jobs[j], lt - p.jobs[j].tile0, live); } } }
    GRID_SYNC();
    modulate_rows(p, 0, 0, true, 0);
    s5_kk_phase(lds, p);
    GRID_SYNC();
    { EpiWin0 e{(bf16_t*)(ws + H_UA), (bf16_t*)(ws + S_CQN), (bf16_t*)(ws + S_CKVN), (float*)(ws + S_SSP), (float*)(ws + H_KR)};
      gemm_phase(lds, A0, 1024, WB + W_IN0, 1024, 0, NR / 256, 5, e); }
    s5_w1a_phase(p);
    { int rk, nrk; slack_rank((NR / 256) * 5, rk, nrk); transpose_range(lds, ws, p, p.jobs[4].tile0, p.jobs[7].tile0, rk, nrk); }
    GRID_SYNC();
    s5_w1b_phase(p);
    { EpiS1a e{(float*)(ws + H_E)};
      gemm_phase(lds, (const bf16_t*)(ws + H_UA), 768, (const bf16_t*)(ws + H_W1A), 512, 0, 3, 1, e, 32, (size_t)CHR * 768, (size_t)256 * 512); }
    { int rk, nrk; slack_rank(96, rk, nrk); transpose_range(lds, ws, p, p.jobs[7].tile0, p.jobs[9].tile0, rk, nrk); }
    GRID_SYNC();
    s5_carry_phase(p);
    { EpiBf16 e{(bf16_t*)(ws + S_QRAW), 768, (const float*)(ws + S_SSP)};
      gemm_phase(lds, (const bf16_t*)(ws + S_CQN), 384, WB + W_QB, 384, 0, NR / 256, 3, e); }
    { EpiKV e{(bf16_t*)(ws + S_KNOPE), (bf16_t*)(ws + S_VT), (const float*)(ws + S_SSP)};
      gemm_phase(lds, (const bf16_t*)(ws + S_CKVN), 256, WB + W_KVB, 256, 0, NR / 256, 4, e); }
    GRID_SYNC();
    { EpiS1b e{(bf16_t*)(ws + S_YG)};
      gemm_phase(lds, (const bf16_t*)(ws + H_UA), 768, (const bf16_t*)(ws + A_W1B), 768, 0, 3, 2, e, 32, (size_t)CHR * 768, (size_t)512 * 768); }
    mla_prep_phase(p);
    GRID_SYNC();
    { const bf16_t* QR = (const bf16_t*)(ws + S_QRAW); const bf16_t* KA = (const bf16_t*)(ws + S_KA); const bf16_t* VT = (const bf16_t*)(ws + S_VT);
      const int nlat = 2 * 4 * 32, nall = nlat + 2 * 4;
      float mref; { float gq = 0.f, gk = 0.f;
        for (int d_ = 0; d_ < 192; ++d_) { gq = fmaxf(gq, fabsf(p.in[27][d_])); gk = fmaxf(gk, fabsf(p.in[28][d_])); }
        mref = 13.856406f * LOG2E * 1.02f * gq * gk; }
      for (int it0 = bid; it0 < nlat + nb; it0 += nb) {
          const int it = it0 < nlat ? it0 : nlat + (it0 - nlat) - (nb - 8);
          if (it0 >= nlat && (it < nlat || it >= nall)) continue;
          if (it < nlat) { const int h = it & 3, b = (it >> 2) & 1, qb = it >> 3;   const size_t row = NCTX + (size_t)b * SEQ + qb * 256;
              attn_item<192, 128, false>(lds, QR + row * 768 + h * 192, 768, KA + (size_t)(b * 4 + h) * TK * 192, VT + (size_t)(b * 4 + h) * 128 * TK, 0, TK / 64, 0, 0, mref, 0.f,
                                         A0 + row * 1024 + 512 + h * 128, 1024, 0); }
          else { const int j = it - nlat; const int h = j & 3, b = j >> 2; const size_t row = (size_t)b * CTX;
              attn_item<192, 128, false>(lds, QR + row * 768 + h * 192, 768, KA + (size_t)(b * 4 + h) * TK * 192, VT + (size_t)(b * 4 + h) * 128 * TK, 0, 4, 0, 0, mref, 0.f,
                                         A0 + row * 1024 + 512 + h * 128, 1024, 0); } }
      EpiGLU e{(const bf16_t*)(ws + S_YG), p.in[22], A0};
      gemm_phase(lds, (const bf16_t*)(ws + S_YG), 512, WB + W_GLU, 512, 0, NR / 256, 2, e); }
    GRID_SYNC();
    { EpiRes e{p.in[2], p.in[0], H, H + (size_t)NCTX * 1024, MOD + 0 * 3 * 6144 + 2048, 0};
      gemm_phase(lds, A0, 1024, WB + W_OUT0, 1024, 2, NLAT / 256, 4, e);
      thin_gemm_ctx<4>(lds, A0, 1024, WB + W_OUT0, 1024, p.in[2], H, MOD + 0 * 3 * 6144 + 2048); }
    GRID_SYNC();
    modulate_rows(p, 0, 1, false, 0);
    GRID_SYNC();
    { EpiSwiGLU e{(bf16_t*)(ws + S_HID)};
      gemm_phase(lds, A0, 1024, WB + W_GU0, 1024, 0, NR / 256, 22, e); }
    { int rk, nrk; slack_rank((NR / 256) * 22, rk, nrk); transpose_range(lds, ws, p, p.jobs[9].tile0, p.jobs[9].tile0 + 704, rk, nrk); }
    GRID_SYNC();
    { EpiRes e{H, H + (size_t)NCTX * 1024, H, H + (size_t)NCTX * 1024, MOD + 0 * 3 * 6144 + 5120, 0};
      gemm_phase(lds, (const bf16_t*)(ws + S_HID), FH, WB + W_D0, FH, 2, NLAT / 256, 4, e);
      thin_gemm_ctx<11>(lds, (const bf16_t*)(ws + S_HID), FH, WB + W_D0, FH, H, H, MOD + 0 * 3 * 6144 + 5120); }
    GRID_SYNC();
    modulate_rows(p, 1, 0, false, 0);
    GRID_SYNC();
    { EpiWin1 e{(bf16_t*)(ws + S1_Q), (bf16_t*)(ws + S1_K), (bf16_t*)(ws + S1_VT), p.in[31], p.in[32], (const float*)(ws + T_ROPE)};
      gemm_phase(lds, A0, 1024, WB + W_IN1, 1024, 0, NR / 256, 6, e); }
    { int rk, nrk; slack_rank((NR / 256) * 6, rk, nrk); transpose_range(lds, ws, p, p.jobs[9].tile0 + 704, p.njobtiles, rk, nrk); }
    GRID_SYNC();
    { const bf16_t* Q = (const bf16_t*)(ws + S1_Q); const bf16_t* K1 = (const bf16_t*)(ws + S1_K); const bf16_t* VT = (const bf16_t*)(ws + S1_VT);
      const int nit = 2 * 16 * 32;
      float mref; { float gq = 0.f, gk = 0.f;
        for (int d_ = 0; d_ < 64; ++d_) { gq = fmaxf(gq, fabsf(p.in[31][d_])); gk = fmaxf(gk, fabsf(p.in[32][d_])); }
        mref = 8.f * LOG2E * 1.02f * gq * gk; }
      for (int it = bid; it < nit; it += nb) { const int kvh = it & 3, b = (it >> 2) & 1, g = (it >> 3) & 3, i = it >> 5; const int hq = kvh * 4 + g;
          const size_t row = NCTX + (size_t)b * SEQ + i * 256;
          const int l0 = (4 * i - 2) < 0 ? 0 : (4 * i - 2), l1 = (4 * i + 6) > 128 ? 128 : (4 * i + 6);
          attn_item<64, 64, true>(lds, Q + row * 1024 + hq * 64, 1024, K1 + (size_t)(b * 4 + kvh) * TK * 64, VT + (size_t)(b * 4 + kvh) * 64 * TK, 0, 4, 4 + l0, 4 + l1,
                                  mref, __builtin_amdgcn_exp2f(p.in[33][hq] * LOG2E - mref), A0 + row * 1024 + hq * 64, 1024, i * 256); } }
    GRID_SYNC();
    { EpiRes e{H, H + (size_t)NCTX * 1024, nullptr, H + (size_t)NCTX * 1024, MOD + 1 * 3 * 6144 + 2048, 0};
      gemm_phase(lds, A0, 1024, WB + W_OUT1, 1024, 2, NLAT / 256, 4, e); }
    GRID_SYNC();
    modulate_rows(p, 1, 1, false, NCTX);
    GRID_SYNC();
    { EpiSwiGLU e{(bf16_t*)(ws + S_HID)};
      gemm_phase(lds, A0, 1024, WB + W_GU1, 1024, 2, NLAT / 256, 22, e); }
    GRID_SYNC();
    { EpiRes e{H, H + (size_t)NCTX * 1024, nullptr, p.out, MOD + 1 * 3 * 6144 + 5120, 0};
      gemm_phase(lds, (const bf16_t*)(ws + S_HID), FH, WB + W_D1, FH, 2, NLAT / 256, 4, e); }
}

extern "C" void kernel_launch(void* const* d_in, const int* in_sizes, int n_in, void* d_out, int out_size, void* d_ws, size_t ws_size, hipStream_t stream) {
    static int grid_blocks = 0;
    if (grid_blocks == 0) {
        if (n_in != 34 || ws_size < WS_NEED2) { fprintf(stderr, "kernel_launch: unexpected n_in %d / ws %zu (need %zu)\n", n_in, ws_size, (size_t)WS_NEED2); grid_blocks = -1; return; }
        int dev = 0, cus = 0, per_cu = 0;
        (void)hipGetDevice(&dev);
        (void)hipDeviceGetAttribute(&cus, hipDeviceAttributeMultiprocessorCount, dev);
        (void)hipFuncSetAttribute((const void*)fwd_kernel, hipFuncAttributeMaxDynamicSharedMemorySize, LDS_BYTES);
        (void)hipOccupancyMaxActiveBlocksPerMultiprocessor(&per_cu, (const void*)fwd_kernel, NTHREADS, LDS_BYTES);
        if (per_cu < 1) { fprintf(stderr, "kernel_launch: occupancy query returned %d\n", per_cu); grid_blocks = -1; return; }
        if (per_cu > 1) per_cu = 1;
        grid_blocks = cus * per_cu;
        fprintf(stderr, "kernel_launch: grid %d (%d CUs x %d)\n", grid_blocks, cus, per_cu);
    }
    if (grid_blocks < 0) return;
    Params p{};
    for (int i = 0; i < 34; ++i) p.in[i] = (const float*)d_in[i];
    p.out = (float*)d_out; p.ws = (char*)d_ws;
    const float* fg = p.in[8]; const float* fu = p.in[9]; const float* fd = p.in[10];
    const size_t FW = (size_t)1024 * FH;
    int t0 = 0;
    auto mk = [&](int idx, const float* a, const float* b, size_t dst, int K, int ld, int npad, int mode) {
        Job& j = p.jobs[idx]; j.a = a; j.b = b; j.ks = nullptr; j.dst = dst; j.K = K; j.ld = ld; j.ntk = K / 64; j.ntn = npad / 64; j.tile0 = t0; j.mode = mode; t0 += j.ntk * j.ntn; };
    mk(0, p.in[11], nullptr, W_IN0, 1024, 1216, 1280, 0);
    mk(1, p.in[24], nullptr, W_QB, 384, 768, 768, 0);
    mk(2, p.in[26], nullptr, W_KVB, 256, 1024, 1024, 0);
    p.jobs[1].ks = p.in[23]; p.jobs[2].ks = p.in[25];
    mk(3, p.in[21], nullptr, W_GLU, 512, 512, 512, 0);
    mk(4, p.in[12], nullptr, W_OUT0, 1024, 1024, 1024, 0);
    mk(5, fg, fu, W_GU0, 1024, FH, 5632, 1);
    mk(6, fd, nullptr, W_D0, FH, 1024, 1024, 0);
    mk(7, p.in[29], nullptr, W_IN1, 1024, 1536, 1536, 0);
    mk(8, p.in[30], nullptr, W_OUT1, 1024, 1024, 1024, 0);
    mk(9, fg + FW, fu + FW, W_GU1, 1024, FH, 5632, 1);
    mk(10, fd + FW, nullptr, W_D1, FH, 1024, 1024, 0);
    p.njobtiles = t0;
    if (hipMemsetAsync((char*)d_ws + T_BAR, 0, XCD_BAR_WORDS * 4, stream) != hipSuccess) { fprintf(stderr, "kernel_launch: memset failed\n"); return; }
    void* args[] = {&p};
    hipError_t e = hipLaunchCooperativeKernel((const void*)fwd_kernel, dim3(grid_blocks), dim3(NTHREADS), args, LDS_BYTES, stream);
    if (e != hipSuccess) fprintf(stderr, "cooperative launch failed: %s (grid %d)\n", hipGetErrorString(e), grid_blocks);
}
```

```cpp
#include <hip/hip_runtime.h>
#include <hip/hip_cooperative_groups.h>
#include <cstdio>
#include <cstdint>
namespace cg = cooperative_groups;

#define DI __device__ __forceinline__
typedef unsigned short bf16_t;
typedef short bf16x8 __attribute__((ext_vector_type(8)));
typedef short s16x4 __attribute__((ext_vector_type(4)));
typedef float f32x4 __attribute__((ext_vector_type(4)));
typedef float f32x2 __attribute__((ext_vector_type(2)));
typedef float f32x16 __attribute__((ext_vector_type(16)));
typedef unsigned u32x4 __attribute__((ext_vector_type(4)));
typedef unsigned u32x2 __attribute__((ext_vector_type(2)));
typedef __bf16 bf16v2 __attribute__((ext_vector_type(2)));

constexpr int DM = 1024, NBATCH = 2, SEQ = 8192, CTX = 256;
constexpr int NCTX = NBATCH * CTX;
constexpr int NLAT = NBATCH * SEQ;
constexpr int NR = NCTX + NLAT;
constexpr int TK = CTX + SEQ;
constexpr int FH = 2816;
constexpr int NCH = TK / 64;
constexpr float LOG2E = 1.4426950408889634f;
constexpr int LDS_BYTES = 131072 + 64;
constexpr int NTHREADS = 512, NWV = 8;

constexpr size_t W_IN0 = 0;
constexpr size_t W_QB = W_IN0 + (size_t)1280 * 1024;
constexpr size_t W_KVB = W_QB + (size_t)768 * 384;
constexpr size_t W_GLU = W_KVB + (size_t)1024 * 256;
constexpr size_t W_OUT0 = W_GLU + (size_t)512 * 512;
constexpr size_t W_GU0 = W_OUT0 + (size_t)1024 * 1024;
constexpr size_t W_D0 = W_GU0 + (size_t)5632 * 1024;
constexpr size_t W_IN1 = W_D0 + (size_t)1024 * 2816;
constexpr size_t W_OUT1 = W_IN1 + (size_t)1536 * 1024;
constexpr size_t W_GU1 = W_OUT1 + (size_t)1024 * 1024;
constexpr size_t W_D1 = W_GU1 + (size_t)5632 * 1024;
constexpr size_t W_END = W_D1 + (size_t)1024 * 2816;
constexpr size_t OFF_TAB = W_END * 2;
constexpr size_t T_MOD = OFF_TAB;
constexpr size_t T_ROPE = T_MOD + 2 * 3 * 6144 * 4;
constexpr size_t T_LAMB = T_ROPE + 128 * 16 * 2 * 4;
constexpr size_t T_LAM64 = T_LAMB + 2 * 32 * 64 * 8;
constexpr size_t T_BBAR = T_LAM64 + 2 * 32 * 64 * 8;
constexpr size_t T_BAR = T_BBAR + (size_t)2 * 32 * 64 * 16 * 8;
constexpr size_t OFF_H = OFF_TAB + (1u << 20);
constexpr size_t OFF_A0 = OFF_H + (size_t)NR * 1024 * 4;
constexpr size_t OFF_S = OFF_A0 + (size_t)NR * 1024 * 2;
constexpr size_t WS_NEED = OFF_S + (size_t)108134400;
constexpr size_t S_SSP = WS_NEED;
constexpr size_t WS_NEED2 = S_SSP + (size_t)NR * 10 * 4;
static_assert(WS_NEED2 <= ((size_t)256 << 20) && OFF_S + (size_t)NR * FH * 2 <= WS_NEED, "workspace");
constexpr int SL = 32;
constexpr int NCK = TK / SL;
constexpr int CHR = NBATCH * NCK;
constexpr size_t H_UA = OFF_H;
constexpr size_t H_KR = H_UA + (size_t)(32 * CHR + 256) * 768 * 2;
constexpr size_t H_E = H_KR + (size_t)NR * 64 * 4;
constexpr size_t H_KK = H_E + (size_t)32 * CHR * 256 * 4;
constexpr size_t H_POW = H_KK + (size_t)32 * 2 * 32 * 256 * 4;
constexpr size_t H_W1A = H_POW + (size_t)4096 * 33 * 8;
static_assert(H_W1A + (size_t)32 * 256 * 512 * 2 <= OFF_A0, "H region overflow");
constexpr size_t A_W1B = OFF_A0;
constexpr size_t S_CQN = OFF_S;
constexpr size_t S_CKVN = S_CQN + (size_t)NR * 384 * 2;
constexpr size_t S_YG = OFF_S;
constexpr size_t S_X = S_CKVN + (size_t)NR * 256 * 2;
constexpr size_t S_CQKV = S_X;
constexpr size_t S_QRAW = S_X;
constexpr size_t S_KNOPE = S_QRAW + (size_t)NR * 768 * 2;
constexpr size_t S_VT = S_KNOPE + (size_t)NR * 512 * 2;
constexpr size_t S_KA = S_VT + (size_t)2 * 4 * 128 * TK * 2;
static_assert(S_CQKV + (size_t)NR * 640 * 4 <= S_VT, "CQKV overlaps VT");
static_assert(S_KA + (size_t)2 * 4 * TK * 192 * 2 <= WS_NEED, "scratch overflow");
constexpr size_t S_HID = OFF_S;
constexpr size_t S1_Q = OFF_S;
constexpr size_t S1_KRAW = S1_Q + (size_t)NR * 1024 * 2;
constexpr size_t S1_K = S1_KRAW + (size_t)NR * 256 * 4;
constexpr size_t S1_VT = S1_K + (size_t)2 * 4 * TK * 64 * 2;

struct Job { const float* a; const float* b; const float* ks; unsigned long long dst; int K, ld, ntk, ntn, tile0, mode; };
struct Params {
    const float* in[34];
    float* out;
    char* ws;
    Job jobs[11];
    int njobtiles;
    int pad;
};

DI int get_tid() { int t = threadIdx.x; asm volatile("" : "+v"(t)); return t; }
DI unsigned pk2(float lo, float hi) { f32x2 v = {lo, hi}; return __builtin_bit_cast(unsigned, __builtin_convertvector(v, bf16v2)); }
DI float bf2f(unsigned short b) { return __uint_as_float(((unsigned)b) << 16); }
DI float wave_sum(float v) {
#pragma unroll
    for (int o = 32; o > 0; o >>= 1) v += __shfl_xor(v, o);
    return v;
}
DI int row_vec(int r) { return r < NCTX ? 2 : (r - NCTX) / SEQ; }
DI int row_batch(int r) { return r < NCTX ? r / CTX : (r - NCTX) / SEQ; }
DI int row_tpos(int r) { return r < NCTX ? r % CTX : CTX + (r - NCTX) % SEQ; }
DI float sigmoidf_(float x) { return 1.f / (1.f + __expf(-x)); }
DI float siluf_(float x) { return x / (1.f + __expf(-x)); }
DI float gelu_tanh(float y) { const float z = 0.7978845608028654f * (y + 0.044715f * y * y * y); const float t = 1.f - 2.f / (1.f + __expf(2.f * z)); return 0.5f * y * (1.f + t); }
DI void my_sincos(float x, float& s, float& c) {
    const float q = rintf(x * 0.636619772367581f);
    float r = fmaf(-q, 1.5703125f, x);
    r = fmaf(-q, 4.837512969970703125e-4f, r);
    r = fmaf(-q, 7.54978995489188216e-8f, r);
    const int qi = (int)q;
    const float r2 = r * r;
    const float sp = r + r * r2 * (-1.6666654611e-1f + r2 * (8.3321608736e-3f + r2 * (-1.9515295891e-4f)));
    const float cp = 1.0f - 0.5f * r2 + r2 * r2 * (4.166664568298827e-2f + r2 * (-1.388731625493765e-3f + r2 * 2.443315711809948e-5f));
    const int k = qi & 3;
    s = (k == 0) ? sp : (k == 1) ? cp : (k == 2) ? -sp : -cp;
    c = (k == 0) ? cp : (k == 1) ? -sp : (k == 2) ? -cp : sp;
}


#define XB_TMO      128
#define XB_XCNT(j)  (256  + 64 * (j))
#define XB_XSUB(j)  (1280 + 64 * (j))
#define XB_XGEN(j)  (2304 + 64 * (j))
#define XB_TOP      3328
#define XB_TOPGEN   3392
#define XCD_BAR_WORDS 3456
#define XB_SPIN_CAP (1u << 22)
#define LAS __attribute__((address_space(3)))
DI unsigned xb_ld(unsigned* p) { return __hip_atomic_load(p, __ATOMIC_RELAXED, __HIP_MEMORY_SCOPE_AGENT); }
DI unsigned xb_add(unsigned* p, unsigned v) { return __hip_atomic_fetch_add(p, v, __ATOMIC_RELAXED, __HIP_MEMORY_SCOPE_AGENT); }
DI unsigned xb_xcc_id() { return (unsigned)__builtin_amdgcn_s_getreg((3 << 11) | 20) & 0xFu; }
#define XB_SPIN(cond, bar) do { unsigned _sp = 0; while (cond) { __builtin_amdgcn_s_sleep(1); \
    if ((++_sp & 255u) == 0u) { if (xb_ld(&(bar)[XB_TMO])) break; if (_sp > XB_SPIN_CAP) { atomicAdd(&(bar)[XB_TMO], 1u); break; } } } } while (0)
struct XcdBarrier { unsigned* bar; unsigned x; volatile LAS unsigned* st; };
DI XcdBarrier xcd_barrier_post(unsigned* bar, volatile LAS unsigned* st) {
    XcdBarrier b; b.bar = bar; b.x = xb_xcc_id(); b.st = st;
    if (threadIdx.x == 0) (void)xb_add(&bar[XB_XCNT(b.x)], 1u);
    return b;
}
DI void xcd_barrier_complete(unsigned* bar, unsigned x, unsigned& nloc, unsigned& nx) {
    const unsigned G = gridDim.x * gridDim.y * gridDim.z;
    unsigned sum, cnt, mine, sp = 0u;
    for (;;) {
        sum = 0u; cnt = 0u; mine = 0u;
#pragma unroll
        for (unsigned j = 0; j < 16; ++j) { const unsigned c = xb_ld(&bar[XB_XCNT(j)]); sum += c; cnt += (c > 0u) ? 1u : 0u; mine = (j == x) ? c : mine; }
        if (sum == G) break;
        __builtin_amdgcn_s_sleep(1);
        if ((++sp & 255u) == 0u) { if (xb_ld(&bar[XB_TMO])) break; if (sp > XB_SPIN_CAP) { atomicAdd(&bar[XB_TMO], 1u); break; } }
    }
    nloc = mine > 0u ? mine : 1u; nx = cnt > 0u ? cnt : 1u;
}
DI void xcd_barrier(const XcdBarrier& b) {
    asm volatile("s_waitcnt vmcnt(0)" ::: "memory");
    __syncthreads();
    if (threadIdx.x == 0) {
        unsigned* bar = b.bar;
        __builtin_amdgcn_s_waitcnt(0);
        unsigned nloc = b.st[0], nx = b.st[1];
        if (nloc == 0u) { xcd_barrier_complete(bar, b.x, nloc, nx); b.st[0] = nloc; b.st[1] = nx; }
        const unsigned old = xb_add(&bar[XB_XSUB(b.x)], 1u);
        const unsigned gen = old / nloc;
        if (old + 1u == (gen + 1u) * nloc) {
            __builtin_amdgcn_fence(__ATOMIC_RELEASE, "agent");
            asm volatile("s_waitcnt vmcnt(0)" ::: "memory");
            const unsigned og = xb_add(&bar[XB_TOP], 1u);
            const unsigned tg = og / nx;
            if (og + 1u == (tg + 1u) * nx) xb_add(&bar[XB_TOPGEN], 1u);
            else XB_SPIN(xb_ld(&bar[XB_TOPGEN]) == tg, bar);
            __builtin_amdgcn_fence(__ATOMIC_ACQUIRE, "agent");
            xb_add(&bar[XB_XGEN(b.x)], 1u);
            asm volatile("s_waitcnt vmcnt(0)" ::: "memory");
        } else {
            XB_SPIN(xb_ld(&bar[XB_XGEN(b.x)]) == gen, bar);
            __builtin_amdgcn_fence(__ATOMIC_ACQUIRE, "agent");
            asm volatile("s_waitcnt vmcnt(0)" ::: "memory");
        }
    }
    __syncthreads();
}

DI void transpose_tile(char* lds, char* ws, const Job& jb, int lt, bool live) {
    const int tid512 = get_tid(); const int tid = tid512 & 255;
    float (*tile)[65] = (float (*)[65])(lds + (tid512 >> 8) * 17408);
    const int tk = lt % jb.ntk, tn = lt / jb.ntk;
    const int k0 = tk * 64, n0 = tn * 64;
    const int c4 = (tid & 15) * 4, rq = tid >> 4;
    const float* src; int col; bool valid = live;
    if (jb.mode == 0) { src = jb.a; col = n0 + c4; valid = live && col < jb.ld; }
    else { const int nsub = c4 >> 4, i = c4 & 15; src = (nsub & 1) ? jb.b : jb.a; col = tn * 32 + (nsub >> 1) * 16 + i; }
#pragma unroll
    for (int kk = 0; kk < 4; ++kk) { const int k = kk * 16 + rq; f32x4 v = valid ? *(const f32x4*)(src + (size_t)(k0 + k) * jb.ld + col) : (f32x4){0.f, 0.f, 0.f, 0.f};
        if (jb.ks) v = v * jb.ks[k0 + k];
        tile[k][c4] = v[0]; tile[k][c4 + 1] = v[1]; tile[k][c4 + 2] = v[2]; tile[k][c4 + 3] = v[3]; }
    __syncthreads();
    const int r = tid >> 2, ks = (tid & 3) * 16;
    unsigned w[8];
#pragma unroll
    for (int q = 0; q < 8; ++q) w[q] = pk2(tile[ks + 2 * q][r], tile[ks + 2 * q + 1][r]);
    bf16_t* d = (bf16_t*)(ws) + jb.dst + (size_t)(n0 + r) * jb.K + k0 + ks;
    if (live) { *(u32x4*)d = (u32x4){w[0], w[1], w[2], w[3]};
    *(u32x4*)(d + 8) = (u32x4){w[4], w[5], w[6], w[7]}; }
    __syncthreads();
}

DI void transpose_range(char* lds, char* ws, const Params& p, int t_begin, int t_end, int rank, int nranks) {
    if (rank < 0) return;
    for (int pr = (t_begin >> 1) + rank; pr < (t_end >> 1); pr += nranks) {
        const int lt = pr * 2 + (int)(threadIdx.x >> 8); int j = 0;
#pragma unroll
        for (int q = 1; q < 11; ++q) if (lt >= p.jobs[q].tile0) j = q;
        transpose_tile(lds, ws, p.jobs[j], lt - p.jobs[j].tile0, true);
    }
}
DI void slack_rank(int ntile, int& rank, int& nranks) { const int rem = ntile % (int)gridDim.x; if (rem == 0) { rank = blockIdx.x; nranks = gridDim.x; } else { rank = (int)blockIdx.x - rem; nranks = (int)gridDim.x - rem; } }

DI void ada_item(char* lds, const Params& p, int it) {
    float* sil = (float*)lds;
    float* red = sil + 3072;
    float* MOD = (float*)(p.ws + T_MOD);
    const int tid = get_tid(), layer = it / 96, n0 = (it % 96) * 64;
    for (int i = tid; i < 3072; i += NTHREADS) { const int v = i >> 10, k = i & 1023; const float x = v < 2 ? p.in[1][v * 1024 + k] : p.in[3][k]; sil[i] = siluf_(x); }
    __syncthreads();
    const int j4 = (tid & 15) * 4, kg = tid >> 4;
    const float* W = p.in[4] + (size_t)layer * 1024 * 6144 + n0 + j4;
    f32x4 a0 = {0.f, 0.f, 0.f, 0.f}, a1 = a0, a2 = a0;
#pragma unroll 8
    for (int k = kg * 32; k < kg * 32 + 32; ++k) { const f32x4 w = *(const f32x4*)(W + (size_t)k * 6144); a0 += sil[k] * w; a1 += sil[1024 + k] * w; a2 += sil[2048 + k] * w; }
    *(f32x4*)(red + (kg * 3 + 0) * 64 + j4) = a0; *(f32x4*)(red + (kg * 3 + 1) * 64 + j4) = a1; *(f32x4*)(red + (kg * 3 + 2) * 64 + j4) = a2;
    __syncthreads();
    if (tid < 192) { const int v = tid >> 6, jj = tid & 63;
        float s = p.in[5][layer * 6144 + n0 + jj];
#pragma unroll 8
        for (int q = 0; q < 32; ++q) s += red[(q * 3 + v) * 64 + jj];
        MOD[(layer * 3 + v) * 6144 + n0 + jj] = s; }
    __syncthreads();
}

DI void tables_item(const Params& p, int it) {
    const int tid = get_tid();
    if (it < 4) {
        const int e = it * 512 + tid, pos = e >> 4, i = e & 15;
        const float inv = exp2f(-(float)i * (13.287712379549449f / 16.f));
        float s, c; my_sincos((float)pos * inv, s, c);
        float* ROPE = (float*)(p.ws + T_ROPE); ROPE[e * 2] = c; ROPE[e * 2 + 1] = s;
    } else {
        const int e = (it - 4) * 512 + tid;
        const int dg = e >> 6;
        const float lr = p.in[13][e], li = p.in[14][e], step = expf(p.in[15][dg]);
        const float a = lr * step, b = li * step;
        const float ea = expf(a);
        float sb, cb; my_sincos(b, sb, cb);
        float sh, ch; my_sincos(0.5f * b, sh, ch);
        const float em1 = a * (1.f + a * 0.5f * (1.f + a * (1.f / 3.f) * (1.f + a * 0.25f * (1.f + a * 0.2f * (1.f + a * (1.f / 6.f))))));
        const float lbr = ea * cb, lbi = ea * sb;
        const float nr = em1 * cb - 2.f * sh * sh, ni = ea * sb;
        const float den = lr * lr + li * li;
        const float qr = (nr * lr + ni * li) / den, qi = (ni * lr - nr * li) / den;
        f32x2* BB = (f32x2*)(p.ws + T_BBAR);
#pragma unroll
        for (int s = 0; s < 16; ++s) { const float br = p.in[16][e * 16 + s], bi = p.in[17][e * 16 + s]; BB[e * 16 + s] = (f32x2){qr * br - qi * bi, qr * bi + qi * br}; }
        f32x2* POW = (f32x2*)(p.ws + H_POW) + (size_t)dg * 33 * 64 + (e & 63);
        float pr = 1.f, pi = 0.f;
        for (int q = 0; q <= 32; ++q) { POW[q * 64] = (f32x2){pr, pi}; const float nr2 = pr * lbr - pi * lbi, ni2 = pr * lbi + pi * lbr; pr = nr2; pi = ni2; }
    }
}

DI void modulate_rows(const Params& p, int layer, int which, bool from_inputs, int r0) {
    const int tid_ = get_tid(); const int lane = tid_ & 63, wid = tid_ >> 6;
    const float* gain = p.in[which ? 7 : 6] + layer * 1024;
    const float* modl = (const float*)(p.ws + T_MOD) + layer * 3 * 6144 + (which ? 3072 : 0);
    const float* H = (const float*)(p.ws + OFF_H);
    bf16_t* dst = (bf16_t*)(p.ws + OFF_A0);
    const int stride = gridDim.x * NWV;
    for (int ra = r0 + blockIdx.x * NWV + wid; ra < NR; ra += 2 * stride) {
        const int rb = ra + stride; const bool hb = rb < NR; const int rbb = hb ? rb : ra;
        const float* srca = from_inputs ? (ra < NCTX ? p.in[2] + (size_t)ra * 1024 : p.in[0] + (size_t)(ra - NCTX) * 1024) : H + (size_t)ra * 1024;
        const float* srcb = from_inputs ? (rbb < NCTX ? p.in[2] + (size_t)rbb * 1024 : p.in[0] + (size_t)(rbb - NCTX) * 1024) : H + (size_t)rbb * 1024;
        f32x4 xa[4], xb[4]; float sa = 0.f, sb = 0.f;
#pragma unroll
        for (int i = 0; i < 4; ++i) { xa[i] = *(const f32x4*)(srca + i * 256 + lane * 4); xb[i] = *(const f32x4*)(srcb + i * 256 + lane * 4); }
#pragma unroll
        for (int i = 0; i < 4; ++i) { sa += xa[i][0] * xa[i][0] + xa[i][1] * xa[i][1] + xa[i][2] * xa[i][2] + xa[i][3] * xa[i][3];
                                      sb += xb[i][0] * xb[i][0] + xb[i][1] * xb[i][1] + xb[i][2] * xb[i][2] + xb[i][3] * xb[i][3]; }
        sa = wave_sum(sa); sb = wave_sum(sb);
        const float rsa = rsqrtf(sa * (1.f / 1024.f) + 1e-6f), rsb = rsqrtf(sb * (1.f / 1024.f) + 1e-6f);
        const float* mva = modl + row_vec(ra) * 6144; const float* mvb = modl + row_vec(rbb) * 6144;
#pragma unroll
        for (int i = 0; i < 4; ++i) { const int c = i * 256 + lane * 4;
            const f32x4 g = *(const f32x4*)(gain + c);
            { const f32x4 sh = *(const f32x4*)(mva + c), sc = *(const f32x4*)(mva + 1024 + c); const f32x4 y = xa[i] * rsa * g * (1.f + sc) + sh;
              *(u32x2*)(dst + (size_t)ra * 1024 + c) = (u32x2){pk2(y[0], y[1]), pk2(y[2], y[3])}; }
            if (hb) { const f32x4 sh = *(const f32x4*)(mvb + c), sc = *(const f32x4*)(mvb + 1024 + c); const f32x4 y = xb[i] * rsb * g * (1.f + sc) + sh;
              *(u32x2*)(dst + (size_t)rb * 1024 + c) = (u32x2){pk2(y[0], y[1]), pk2(y[2], y[3])}; } }
    }
}

template <class Epi>
DI void gemm_phase(char* lds, const bf16_t* A0_, int lda, const bf16_t* Bt0_, int K, int mt0, int nmt, int nnt, const Epi& epi, int nbatch = 1, size_t sA = 0, size_t sB = 0, int ksplit = 1) {
    const int tid = get_tid(), lane = tid & 63, wid = tid >> 6, wr = wid >> 2, wc = wid & 3, fr = lane & 15, fq = lane >> 4;
    const int nk = (K >> 6) / ksplit;
    const int lrow = tid >> 3, lc = tid & 7, lkc = lc * 8;
    const int woff = lrow * 128 + ((lc ^ ((lrow >> 1) & 7)) << 4);
    const int ra0 = (wr * 128 + fr) * 128 + ((fq ^ (fr >> 1)) << 4);
    const int ra1 = (wr * 128 + fr) * 128 + (((4 + fq) ^ (fr >> 1)) << 4);
    const int rb0 = 32768 + (wc * 64 + fr) * 128 + ((fq ^ (fr >> 1)) << 4);
    const int rb1 = 32768 + (wc * 64 + fr) * 128 + (((4 + fq) ^ (fr >> 1)) << 4);
    const int per = nmt * nnt, ntile = nbatch * per * ksplit;
    const int myn = ((int)blockIdx.x < ntile) ? (ntile - (int)blockIdx.x + (int)gridDim.x - 1) / (int)gridDim.x : 0;
    const int total = myn * nk;
    f32x4 acc[8][4];
#pragma unroll
    for (int m = 0; m < 8; ++m)
#pragma unroll
        for (int n = 0; n < 4; ++n) acc[m][n] = (f32x4){0.f, 0.f, 0.f, 0.f};
    u32x4 sa[4], sb[4];
    int iti = 0, ikt = 0;
    const bf16_t* Ag = A0_; const bf16_t* Bg = Bt0_;
#define G_ISSUE() do { if (ikt == 0) { const int u_ = blockIdx.x + iti * gridDim.x; const int t_ = u_ / ksplit, sl_ = u_ - t_ * ksplit; const int gb_ = t_ / per, tr_ = t_ - gb_ * per; const int tm_ = tr_ / nnt, tn_ = tr_ - tm_ * nnt; \
            Ag = A0_ + (size_t)gb_ * sA + (size_t)((mt0 + tm_) * 256 + lrow) * lda + lkc + sl_ * nk * 64; Bg = Bt0_ + (size_t)gb_ * sB + (size_t)(tn_ * 256 + lrow) * K + lkc + sl_ * nk * 64; } \
        _Pragma("unroll") for (int i = 0; i < 4; ++i) { sa[i] = *(const u32x4*)(Ag + (size_t)i * 64 * lda + ikt * 64); sb[i] = *(const u32x4*)(Bg + (size_t)i * 64 * K + ikt * 64); } \
        if (++ikt == nk) { ikt = 0; ++iti; } } while (0)
#define G_WRITE(bufoff) do { _Pragma("unroll") for (int i = 0; i < 4; ++i) { *(u32x4*)(lds + (bufoff) + woff + i * 8192) = sa[i]; *(u32x4*)(lds + (bufoff) + 32768 + woff + i * 8192) = sb[i]; } } while (0)
#define G_COMPUTE(bufoff) do { _Pragma("unroll") for (int ks = 0; ks < 2; ++ks) { bf16x8 a[8], b[4]; \
        _Pragma("unroll") for (int m = 0; m < 8; ++m) a[m] = *(const bf16x8*)(lds + (bufoff) + (ks ? ra1 : ra0) + m * 2048); \
        _Pragma("unroll") for (int n = 0; n < 4; ++n) b[n] = *(const bf16x8*)(lds + (bufoff) + (ks ? rb1 : rb0) + n * 2048); \
        _Pragma("unroll") for (int m = 0; m < 8; ++m) _Pragma("unroll") for (int n = 0; n < 4; ++n) acc[m][n] = __builtin_amdgcn_mfma_f32_16x16x32_bf16(b[n], a[m], acc[m][n], 0, 0, 0); } } while (0)
    __syncthreads();
    if (total > 0) {
        G_ISSUE(); G_WRITE(0);
        if (total > 1) G_ISSUE();
    }
    __syncthreads();
    int cti = 0, ckt = 0;
    for (int q = 0; q < total; ++q) {
        const int cur = (q & 1) * 65536;
        if (q + 1 < total) G_WRITE(cur ^ 65536);
        if (q + 2 < total) G_ISSUE();
        G_COMPUTE(cur);
        __syncthreads();
        if (++ckt == nk) {
            const int u_ = blockIdx.x + cti * gridDim.x; const int t_ = u_ / ksplit; const int gb_ = t_ / per, tr_ = t_ - gb_ * per; const int tm_ = tr_ / nnt, tn_ = tr_ - tm_ * nnt;
            epi(acc, (mt0 + tm_) * 256 + wr * 128 + fr, tn_ * 256 + wc * 64 + fq * 4, gb_);
#pragma unroll
            for (int m = 0; m < 8; ++m)
#pragma unroll
                for (int n = 0; n < 4; ++n) acc[m][n] = (f32x4){0.f, 0.f, 0.f, 0.f};
            ckt = 0; ++cti;
        }
    }
#undef G_ISSUE
#undef G_WRITE
#undef G_COMPUTE
}

template <int KSP>
DI void thin_gemm_ctx(char* lds, const bf16_t* A, int lda, const bf16_t* Bt, int K, const float* res, float* dst, const float* gate) {
    const int tid = get_tid(), lane = tid & 63, wid = tid >> 6, fr = lane & 15, fq = lane >> 4;
    float* part = (float*)lds;
    for (int t = blockIdx.x; t < 256; t += gridDim.x) {
        const int m0 = (t >> 5) * 64, n0 = (t & 31) * 32;
        f32x4 acc[4][2];
#pragma unroll
        for (int m = 0; m < 4; ++m) { acc[m][0] = (f32x4){0.f, 0.f, 0.f, 0.f}; acc[m][1] = (f32x4){0.f, 0.f, 0.f, 0.f}; }
        const bf16_t* Ap = A + (size_t)(m0 + fr) * lda + wid * (KSP * 32) + fq * 8;
        const bf16_t* Bp = Bt + (size_t)(n0 + fr) * K + wid * (KSP * 32) + fq * 8;
#pragma unroll
        for (int k = 0; k < KSP; ++k) {
            bf16x8 a[4], b[2];
#pragma unroll
            for (int m = 0; m < 4; ++m) a[m] = *(const bf16x8*)(Ap + (size_t)m * 16 * lda + k * 32);
#pragma unroll
            for (int n = 0; n < 2; ++n) b[n] = *(const bf16x8*)(Bp + (size_t)n * 16 * K + k * 32);
#pragma unroll
            for (int m = 0; m < 4; ++m)
#pragma unroll
                for (int n = 0; n < 2; ++n) acc[m][n] = __builtin_amdgcn_mfma_f32_16x16x32_bf16(b[n], a[m], acc[m][n], 0, 0, 0);
        }
        __syncthreads();
#pragma unroll
        for (int m = 0; m < 4; ++m)
#pragma unroll
            for (int n = 0; n < 2; ++n) *(f32x4*)(part + ((wid * 64 + m * 16 + fr) * 32 + n * 16 + fq * 4)) = acc[m][n];
        __syncthreads();
        { const int row = tid >> 3, c4 = (tid & 7) * 4; f32x4 sum = (f32x4){0.f, 0.f, 0.f, 0.f};
#pragma unroll
          for (int w = 0; w < 8; ++w) sum += *(const f32x4*)(part + ((w * 64 + row) * 32 + c4));
          const size_t off = (size_t)(m0 + row) * 1024 + n0 + c4;
          const f32x4 g = *(const f32x4*)(gate + 2 * 6144 + n0 + c4), x = *(const f32x4*)(res + off);
          *(f32x4*)(dst + off) = x + g * sum; }
    }
    __syncthreads();
}

struct EpiWin0 {
    bf16_t* UA; bf16_t* CQN; bf16_t* CKVN; float* SSP; float* KR;
    DI void operator()(const f32x4 (&acc)[8][4], int row0, int col0, int gb) const {
        const int cw = col0 & ~63;
#pragma unroll
        for (int m = 0; m < 8; ++m) { const int ri = row0 + m * 16; const size_t r = ri;
            if (cw < 512) { const int b = row_batch(ri), tp = row_tpos(ri);
#pragma unroll
                for (int n = 0; n < 4; ++n) { const int c = col0 + n * 16; const f32x4 v = acc[m][n]; const int g = c >> 4, s0 = c & 15;
                    *(u32x2*)(UA + ((size_t)g * CHR + b * NCK + (tp >> 5)) * 768 + (tp & 31) * 16 + s0) = (u32x2){pk2(v[0], v[1]), pk2(v[2], v[3])}; }
            } else if (cw < 1152) { const bool isq = cw < 896; bf16_t* dst = isq ? CQN + r * 384 + (col0 - 512) : CKVN + r * 256 + (col0 - 896);
                float ss = 0.f;
#pragma unroll
                for (int n = 0; n < 4; ++n) { const f32x4 v = acc[m][n]; ss += v[0] * v[0] + v[1] * v[1] + v[2] * v[2] + v[3] * v[3];
                    *(u32x2*)(dst + n * 16) = (u32x2){pk2(v[0], v[1]), pk2(v[2], v[3])}; }
                ss += __shfl_xor(ss, 16); ss += __shfl_xor(ss, 32);
                if ((col0 & 15) == 0) SSP[r * 10 + ((cw - 512) >> 6)] = ss;
            } else if (cw < 1216) {
#pragma unroll
                for (int n = 0; n < 4; ++n) *(f32x4*)(KR + r * 64 + (col0 - 1152) + n * 16) = acc[m][n];
            } }
    }
};
struct EpiS1a {
    float* E;
    DI void operator()(const f32x4 (&acc)[8][4], int row0, int col0, int gb) const {
#pragma unroll
        for (int m = 0; m < 8; ++m) { const int r = row0 + m * 16; if (r >= CHR) continue;
#pragma unroll
            for (int n = 0; n < 4; ++n) *(f32x4*)(E + ((size_t)gb * CHR + r) * 256 + col0 + n * 16) = acc[m][n]; }
    }
};
struct EpiS1b {
    bf16_t* YG;
    DI void operator()(const f32x4 (&acc)[8][4], int row0, int col0, int gb) const {
#pragma unroll
        for (int m = 0; m < 8; ++m) { const int r = row0 + m * 16; if (r >= CHR) continue; const int b = r / NCK, c = r % NCK;
#pragma unroll
            for (int n = 0; n < 4; ++n) { const int cc = col0 + n * 16; const int tl = cc >> 4, s0 = cc & 15; const f32x4 v = acc[m][n];
                const int tp = c * SL + tl; const size_t row = tp < CTX ? (size_t)b * CTX + tp : (size_t)NCTX + (size_t)b * SEQ + (tp - CTX);
                *(u32x2*)(YG + row * 512 + gb * 16 + s0) = (u32x2){pk2(gelu_tanh(v[0]), gelu_tanh(v[1])), pk2(gelu_tanh(v[2]), gelu_tanh(v[3]))}; } }
    }
};
struct EpiBf16 {
    bf16_t* O; int ldo; const float* SSP;
    DI void operator()(const f32x4 (&acc)[8][4], int row0, int col0, int gb) const {
#pragma unroll
        for (int m = 0; m < 8; ++m) { const size_t r = row0 + m * 16; const float* sp = SSP + r * 10;
            const float rstd = rsqrtf(((sp[0] + sp[1]) + (sp[2] + sp[3]) + (sp[4] + sp[5])) * (1.f / 384.f) + 1e-6f);
#pragma unroll
            for (int n = 0; n < 4; ++n) { const int c = col0 + n * 16; const f32x4 v = acc[m][n] * rstd;
                *(u32x2*)(O + r * ldo + c) = (u32x2){pk2(v[0], v[1]), pk2(v[2], v[3])}; } }
    }
};
struct EpiKV {
    bf16_t* KNOPE; bf16_t* VT; const float* SSP;
    DI void operator()(const f32x4 (&acc)[8][4], int row0, int col0, int gb) const {
#pragma unroll
        for (int m = 0; m < 8; ++m) { const int r = row0 + m * 16; const int b = row_batch(r), tp = row_tpos(r); const float* sp = SSP + (size_t)r * 10 + 6;
            const float rstd = rsqrtf(((sp[0] + sp[1]) + (sp[2] + sp[3])) * (1.f / 256.f) + 1e-6f);
#pragma unroll
            for (int n = 0; n < 4; ++n) { const int c = col0 + n * 16; const int h = c >> 8, w = c & 255; const f32x4 v = acc[m][n] * rstd;
                if (w < 128) *(u32x2*)(KNOPE + (size_t)r * 512 + h * 128 + w) = (u32x2){pk2(v[0], v[1]), pk2(v[2], v[3])};
                else { bf16_t* d = VT + ((size_t)(b * 4 + h) * 128 + (w - 128)) * TK + tp; const unsigned p0 = pk2(v[0], v[1]), p1 = pk2(v[2], v[3]);
                    d[0] = (bf16_t)(p0 & 0xffff); d[TK] = (bf16_t)(p0 >> 16); d[2 * TK] = (bf16_t)(p1 & 0xffff); d[3 * TK] = (bf16_t)(p1 >> 16); } } }
    }
};
struct EpiGLU {
    const bf16_t* YG; const float* bias; bf16_t* CAT;
    DI void operator()(const f32x4 (&acc)[8][4], int row0, int col0, int gb) const {
#pragma unroll
        for (int m = 0; m < 8; ++m) { const size_t r = row0 + m * 16;
#pragma unroll
            for (int n = 0; n < 4; ++n) { const int c = col0 + n * 16; const f32x4 v = acc[m][n]; const f32x4 bv = *(const f32x4*)(bias + c);
                const u32x2 yy = *(const u32x2*)(YG + r * 512 + c);
                const float y0 = __uint_as_float(yy[0] << 16), y1 = __uint_as_float(yy[0] & 0xffff0000u), y2 = __uint_as_float(yy[1] << 16), y3 = __uint_as_float(yy[1] & 0xffff0000u);
                const float o0 = y0 * sigmoidf_(v[0] + bv[0]), o1 = y1 * sigmoidf_(v[1] + bv[1]), o2 = y2 * sigmoidf_(v[2] + bv[2]), o3 = y3 * sigmoidf_(v[3] + bv[3]);
                *(u32x2*)(CAT + r * 1024 + c) = (u32x2){pk2(o0, o1), pk2(o2, o3)}; } }
    }
};
struct EpiRes {
    const float* res_ctx; const float* res_lat; float* dst_ctx; float* dst_lat; const float* gate; int atomic;
    DI void operator()(const f32x4 (&acc)[8][4], int row0, int col0, int gb) const {
#pragma unroll
        for (int m = 0; m < 8; ++m) { const int r = row0 + m * 16;
            const float* rs = r < NCTX ? res_ctx + (size_t)r * 1024 : res_lat + (size_t)(r - NCTX) * 1024;
            float* ds = r < NCTX ? dst_ctx + (size_t)r * 1024 : dst_lat + (size_t)(r - NCTX) * 1024;
            if (r < NCTX && dst_ctx == nullptr) continue;
            const float* gv = gate + row_vec(r) * 6144;
#pragma unroll
            for (int n = 0; n < 4; ++n) { const int c = col0 + n * 16; const f32x4 g = *(const f32x4*)(gv + c);
                if (atomic) { const f32x4 v = g * acc[m][n];
#pragma unroll
                    for (int j = 0; j < 4; ++j) (void)__hip_atomic_fetch_add(ds + c + j, v[j], __ATOMIC_RELAXED, __HIP_MEMORY_SCOPE_AGENT); }
                else { const f32x4 x = *(const f32x4*)(rs + c); *(f32x4*)(ds + c) = x + g * acc[m][n]; } } }
    }
};
struct EpiSwiGLU {
    bf16_t* HID;
    DI void operator()(const f32x4 (&acc)[8][4], int row0, int col0, int gb) const {
        const int hc = (col0 >> 6) * 32 + (col0 & 15);
#pragma unroll
        for (int m = 0; m < 8; ++m) { const size_t r = row0 + m * 16;
#pragma unroll
            for (int q = 0; q < 2; ++q) { const f32x4 g = acc[m][2 * q], u = acc[m][2 * q + 1];
                const float o0 = siluf_(g[0]) * u[0], o1 = siluf_(g[1]) * u[1], o2 = siluf_(g[2]) * u[2], o3 = siluf_(g[3]) * u[3];
                *(u32x2*)(HID + r * FH + hc + q * 16) = (u32x2){pk2(o0, o1), pk2(o2, o3)}; } }
    }
};
struct EpiWin1 {
    bf16_t* Q; bf16_t* K1; bf16_t* VT; const float* qn; const float* kn; const float* ROPE;
    DI void operator()(const f32x4 (&acc)[8][4], int row0, int col0, int gb) const {
        const int cw = col0 & ~63, i0 = col0 & 15;
        if (cw >= 1280) {
#pragma unroll
            for (int m = 0; m < 8; ++m) { const int r = row0 + m * 16; const int b = row_batch(r), tp = row_tpos(r);
#pragma unroll
                for (int n = 0; n < 4; ++n) { const int cc = col0 + n * 16 - 1280, h = cc >> 6, d0 = cc & 63; const f32x4 v = acc[m][n];
                    bf16_t* d = VT + ((size_t)(b * 4 + h) * 64 + d0) * TK + tp; const unsigned p0 = pk2(v[0], v[1]), p1 = pk2(v[2], v[3]);
                    d[0] = (bf16_t)(p0 & 0xffff); d[TK] = (bf16_t)(p0 >> 16); d[2 * TK] = (bf16_t)(p1 & 0xffff); d[3 * TK] = (bf16_t)(p1 >> 16); } }
            return;
        }
        const bool isq = cw < 1024;
        const float* gn = isq ? qn : kn;
        f32x4 g[4];
#pragma unroll
        for (int n = 0; n < 4; ++n) g[n] = *(const f32x4*)(gn + n * 16 + i0);
        const float osc = isq ? 0.125f * LOG2E : 1.f;
#pragma unroll
        for (int m = 0; m < 8; ++m) { const int r = row0 + m * 16; const bool lat = r >= NCTX;
            if (isq && !lat) continue;
            const int b = row_batch(r), tp = row_tpos(r), t = tp - CTX;
            float ss = 0.f;
#pragma unroll
            for (int n = 0; n < 4; ++n) { const f32x4 v = acc[m][n]; ss += v[0] * v[0] + v[1] * v[1] + v[2] * v[2] + v[3] * v[3]; }
            ss += __shfl_xor(ss, 16); ss += __shfl_xor(ss, 32);
            const float rstd = rsqrtf(ss * (1.f / 64.f) + 1e-6f);
            f32x4 y[4];
#pragma unroll
            for (int n = 0; n < 4; ++n) y[n] = acc[m][n] * rstd * g[n];
            if (lat) { const float* rr = ROPE + ((t >> 6) * 16 + i0) * 2; const float* rc = ROPE + ((t & 63) * 16 + i0) * 2;
#pragma unroll
                for (int j = 0; j < 4; ++j) { const float c0 = rr[2 * j], s0 = rr[2 * j + 1], c1 = rc[2 * j], s1 = rc[2 * j + 1];
                    const float a0 = y[0][j], a1 = y[1][j], a2 = y[2][j], a3 = y[3][j];
                    y[0][j] = a0 * c0 - a1 * s0; y[1][j] = a1 * c0 + a0 * s0; y[2][j] = a2 * c1 - a3 * s1; y[3][j] = a3 * c1 + a2 * s1; } }
            bf16_t* dst = isq ? Q + (size_t)r * 1024 + cw + i0 : K1 + ((size_t)(b * 4 + ((cw - 1024) >> 6)) * TK + tp) * 64 + i0;
#pragma unroll
            for (int n = 0; n < 4; ++n) *(u32x2*)(dst + n * 16) = (u32x2){pk2(y[n][0] * osc, y[n][1] * osc), pk2(y[n][2] * osc, y[n][3] * osc)};
        }
    }
};

template <int DQK, int DV, bool WIN>
DI void attn_item(char* lds, const bf16_t* Q, int qstride, const bf16_t* Kb, const bf16_t* VTb, int ta0, int ta1, int tb0, int tb1,
                  float mref, float l_init, bf16_t* O, int ostride, int qpos0) {
    constexpr int NKS = DQK / 16, NDT = DV / 32, KSTR = DQK + 8, VSTR = 72, NG = NKS;
    constexpr int KCH = 64 * DQK / 8 / NTHREADS, VCH = DV * 8 / NTHREADS;
    constexpr int KBUF = 64 * KSTR, VBUF = DV * VSTR;
    bf16_t* Ks = (bf16_t*)lds; bf16_t* Vs = Ks + 2 * KBUF;
    const int tid = get_tid(), lane = tid & 63, wid = tid >> 6, r = lane & 31, h2 = lane >> 5;
    bf16x8 qf[NKS];
    { const bf16_t* qrow = Q + (size_t)(wid * 32 + r) * qstride + 8 * h2;
#pragma unroll
      for (int ks = 0; ks < NKS; ++ks) qf[ks] = *(const bf16x8*)(qrow + 16 * ks); }
    f32x16 o[NDT];
#pragma unroll
    for (int dt = 0; dt < NDT; ++dt)
#pragma unroll
        for (int i = 0; i < 16; ++i) o[dt][i] = 0.f;
    float lrun = (h2 == 0) ? l_init : 0.f;
    const int na = ta1 - ta0, ntot = na + (tb1 - tb0);
    u32x4 kr[KCH], vr[VCH];
    constexpr int KTPR = (DQK / 8) / KCH, VTPR = 8 / VCH;
    const int krow = tid / KTPR, kcol = (tid % KTPR) * (KCH * 8);
    const int vrow = tid / VTPR, vcol = (tid % VTPR) * (VCH * 8);
    const bf16_t* kgp = Kb + (size_t)krow * DQK + kcol;
    const bf16_t* vgp = VTb + (size_t)vrow * TK + vcol;
    bf16_t* ksp = Ks + krow * KSTR + kcol;
    bf16_t* vsp = Vs + vrow * VSTR + vcol;
    const bf16_t* kfp = Ks + r * KSTR + 8 * h2;
    const bf16_t* vfp = Vs + r * VSTR + 8 * h2;
#define A_TILE(itv) (((itv) < na) ? ta0 + (itv) : tb0 + ((itv) - na))
#define K_LOAD(itv) do { const bf16_t* kg = kgp + (size_t)A_TILE(itv) * 64 * DQK; _Pragma("unroll") for (int i = 0; i < KCH; ++i) kr[i] = *(const u32x4*)(kg + i * 8); } while (0)
#define V_LOADG(itv) do { const bf16_t* vg = vgp + A_TILE(itv) * 64; _Pragma("unroll") for (int i = 0; i < VCH; ++i) vr[i] = *(const u32x4*)(vg + i * 8); } while (0)
#define K_WRITE(bo) do { _Pragma("unroll") for (int i = 0; i < KCH; ++i) *(u32x4*)(ksp + (bo) + i * 8) = kr[i]; } while (0)
#define V_WRITE(bo) do { _Pragma("unroll") for (int i = 0; i < VCH; ++i) { const int c_ = (vcol >> 3) + i; bf16_t* d_ = vsp - vcol + (bo) + (c_ >> 1) * 16 + (c_ & 1) * 4; \
            *(u32x2*)d_ = (u32x2){vr[i][0], vr[i][1]}; *(u32x2*)(d_ + 8) = (u32x2){vr[i][2], vr[i][3]}; } } while (0)
#define T_ACTIVE(itv) (!(WIN && A_TILE(itv) >= 4 && ((A_TILE(itv) - 4) * 64 > qpos0 + wid * 32 + 31 + 128 || (A_TILE(itv) - 4) * 64 + 63 < qpos0 + wid * 32 - 128)))
#define S_MASK(S0, S1, itv) do { if (WIN && A_TILE(itv) >= 4) { const int qp = qpos0 + wid * 32 + r, kp0 = (A_TILE(itv) - 4) * 64 + 4 * h2; \
        _Pragma("unroll") for (int i = 0; i < 16; ++i) { const int d0 = kp0 + (i & 3) + 8 * (i >> 2) - qp, d1 = d0 + 32; \
            if (d0 > 128 || d0 < -128) S0[i] = -1e30f; if (d1 > 128 || d1 < -128) S1[i] = -1e30f; } } } while (0)
    f32x16 s0, s1;
    __syncthreads();
    K_LOAD(0); K_WRITE(0);
    if (1 < ntot) K_LOAD(1);
    V_LOADG(0);
    __syncthreads();
#pragma unroll
    for (int i = 0; i < 16; ++i) { s0[i] = -mref; s1[i] = -mref; }
#pragma unroll 1
    for (int it = -1; it < ntot; ++it) {
        const int kb_n = ((it + 1) & 1) * KBUF, vb_c = (it & 1) * VBUF;
        if (it + 2 < ntot) K_WRITE((it & 1) * KBUF);
        if (it + 1 < ntot) V_WRITE(((it + 1) & 1) * VBUF);
        __builtin_amdgcn_sched_barrier(0);
        const bool act_c = (it >= 0) && T_ACTIVE(it), act_n = (it + 1 < ntot) && T_ACTIVE(it + 1);
        f32x16 n0, n1;
#pragma unroll
        for (int i = 0; i < 16; ++i) { n0[i] = -mref; n1[i] = -mref; }
        float rs = 0.f;
        unsigned pk[16];
#define P_PAIR(j) do { const float e0_ = __builtin_amdgcn_exp2f((j) < 8 ? s0[2 * ((j) & 7)] : s1[2 * ((j) & 7)]), e1_ = __builtin_amdgcn_exp2f((j) < 8 ? s0[2 * ((j) & 7) + 1] : s1[2 * ((j) & 7) + 1]); rs += e0_ + e1_; pk[j] = pk2(e0_, e1_); } while (0)
        if (act_c && act_n) {
#pragma unroll
            for (int g = 0; g < NG; ++g) {
                const bf16x8 ka = *(const bf16x8*)(kfp + kb_n + 16 * g), kb = *(const bf16x8*)(kfp + kb_n + 32 * KSTR + 16 * g);
                n0 = __builtin_amdgcn_mfma_f32_32x32x16_bf16(ka, qf[g], n0, 0, 0, 0);
                n1 = __builtin_amdgcn_mfma_f32_32x32x16_bf16(kb, qf[g], n1, 0, 0, 0);
#pragma unroll
                for (int j = (16 * g) / NG; j < (16 * (g + 1)) / NG; ++j) P_PAIR(j);
            }
            S_MASK(n0, n1, it + 1);
        } else {
            if (act_n) {
#pragma unroll
                for (int ks = 0; ks < NKS; ++ks) { const bf16x8 k0 = *(const bf16x8*)(kfp + kb_n + 16 * ks), k1 = *(const bf16x8*)(kfp + kb_n + 32 * KSTR + 16 * ks);
                    n0 = __builtin_amdgcn_mfma_f32_32x32x16_bf16(k0, qf[ks], n0, 0, 0, 0); n1 = __builtin_amdgcn_mfma_f32_32x32x16_bf16(k1, qf[ks], n1, 0, 0, 0); }
                S_MASK(n0, n1, it + 1);
            }
            if (act_c) {
#pragma unroll
                for (int j = 0; j < 16; ++j) P_PAIR(j);
            }
        }
#undef P_PAIR
        __builtin_amdgcn_sched_barrier(0);
        if (it + 3 < ntot) K_LOAD(it + 3);
        if (it + 2 < ntot) V_LOADG(it + 2);
        __builtin_amdgcn_sched_barrier(0);
        if (act_c) {
            lrun += rs;
#pragma unroll
            for (int q = 0; q < 4; ++q) {
                const u32x4 pw = {pk[4 * q], pk[4 * q + 1], pk[4 * q + 2], pk[4 * q + 3]};
                const bf16x8 pf = __builtin_bit_cast(bf16x8, pw);
#pragma unroll
                for (int dt = 0; dt < NDT; ++dt) { const bf16x8 vf = *(const bf16x8*)(vfp + vb_c + (32 * dt) * VSTR + 16 * q);
                    o[dt] = __builtin_amdgcn_mfma_f32_32x32x16_bf16(vf, pf, o[dt], 0, 0, 0); }
            }
        }
        s0 = n0; s1 = n1;
        __syncthreads();
    }
#undef A_TILE
#undef K_LOAD
#undef V_LOADG
#undef K_WRITE
#undef V_WRITE
#undef T_ACTIVE
#undef S_MASK
    lrun += __shfl_xor(lrun, 32);
    const float inv = 1.f / lrun;
    bf16_t* orow = O + (size_t)(wid * 32 + r) * ostride;
#pragma unroll
    for (int dt = 0; dt < NDT; ++dt)
#pragma unroll
        for (int g = 0; g < 4; ++g)
            *(u32x2*)(orow + 32 * dt + 8 * g + 4 * h2) = (u32x2){pk2(o[dt][4 * g] * inv, o[dt][4 * g + 1] * inv), pk2(o[dt][4 * g + 2] * inv, o[dt][4 * g + 3] * inv)};
    __syncthreads();
}

template <int NH>
DI void win_attn_item(char* lds, const bf16_t* Q, const bf16_t* Kb, const bf16_t* VTb, int tb0, int tb1, float mref, const float* sinkp, bf16_t* O, int qpos0) {
    constexpr int KSTR = 72, VSTR = 72, KBUF = 64 * KSTR, VBUF = 64 * VSTR;
    bf16_t* Ks = (bf16_t*)lds; bf16_t* Vs = Ks + 2 * KBUF;
    const int tid = get_tid(), lane = tid & 63, wid = tid >> 6, r = lane & 31, h2 = lane >> 5;
    bf16x8 qf[NH][4];
#pragma unroll
    for (int h = 0; h < NH; ++h) { const bf16_t* qrow = Q + (size_t)(wid * 32 + r) * 1024 + h * 64 + 8 * h2;
#pragma unroll
        for (int ks = 0; ks < 4; ++ks) qf[h][ks] = *(const bf16x8*)(qrow + 16 * ks); }
    f32x16 o[NH][2]; float lrun[NH];
#pragma unroll
    for (int h = 0; h < NH; ++h) { lrun[h] = (h2 == 0) ? __builtin_amdgcn_exp2f(sinkp[h] * LOG2E - mref) : 0.f;
#pragma unroll
        for (int dt = 0; dt < 2; ++dt)
#pragma unroll
            for (int i = 0; i < 16; ++i) o[h][dt][i] = 0.f; }
    const int na = 4, ntot = na + (tb1 - tb0);
    u32x4 kr, vr;
    const int krow = tid >> 3, kcol = (tid & 7) * 8;
    const bf16_t* kgp = Kb + (size_t)krow * 64 + kcol;
    const bf16_t* vgp = VTb + (size_t)krow * TK + kcol;
    bf16_t* ksp = Ks + krow * KSTR + kcol;
    bf16_t* vsp = Vs + krow * VSTR + (kcol >> 4) * 16 + ((kcol >> 3) & 1) * 4;
    const bf16_t* kfp = Ks + r * KSTR + 8 * h2;
    const bf16_t* vfp = Vs + r * VSTR + 8 * h2;
#define W_TILE(itv) (((itv) < na) ? (itv) : tb0 + ((itv) - na))
#define W_LOAD(itv) do { kr = *(const u32x4*)(kgp + (size_t)W_TILE(itv) * 64 * 64); vr = *(const u32x4*)(vgp + W_TILE(itv) * 64); } while (0)
#define W_WRITE(kb_, vb_) do { *(u32x4*)(ksp + (kb_)) = kr; *(u32x2*)(vsp + (vb_)) = (u32x2){vr[0], vr[1]}; *(u32x2*)(vsp + (vb_) + 8) = (u32x2){vr[2], vr[3]}; } while (0)
    __syncthreads();
    W_LOAD(0); W_WRITE(0, 0);
    if (1 < ntot) W_LOAD(1);
    __syncthreads();
#pragma unroll 1
    for (int it = 0; it < ntot; ++it) {
        const int T = W_TILE(it);
        const int kb = (it & 1) * KBUF, vb = (it & 1) * VBUF;
        if (it + 1 < ntot) W_WRITE(KBUF - kb, VBUF - vb);
        if (it + 2 < ntot) W_LOAD(it + 2);
        bool active = true, need_mask = false;
        if (T >= 4) { const int klo = (T - 4) * 64, qlo = qpos0 + wid * 32;
            active = !(klo > qlo + 31 + 128 || klo + 63 < qlo - 128);
            need_mask = (klo < qlo + 31 - 128) || (klo + 63 > qlo + 128); }
        if (active) {
#pragma unroll
            for (int h = 0; h < NH; ++h) {
                __builtin_amdgcn_sched_barrier(0);
                f32x16 s0, s1;
#pragma unroll
                for (int i = 0; i < 16; ++i) { s0[i] = -mref; s1[i] = -mref; }
#pragma unroll
                for (int ks = 0; ks < 4; ++ks) { const bf16x8 k0 = *(const bf16x8*)(kfp + kb + 16 * ks), k1 = *(const bf16x8*)(kfp + kb + 32 * KSTR + 16 * ks);
                    s0 = __builtin_amdgcn_mfma_f32_32x32x16_bf16(k0, qf[h][ks], s0, 0, 0, 0); s1 = __builtin_amdgcn_mfma_f32_32x32x16_bf16(k1, qf[h][ks], s1, 0, 0, 0); }
                if (need_mask) { const int qp = qpos0 + wid * 32 + r, kp0 = (T - 4) * 64 + 4 * h2;
#pragma unroll
                    for (int i = 0; i < 16; ++i) { const int d0 = kp0 + (i & 3) + 8 * (i >> 2) - qp, d1 = d0 + 32;
                        if (d0 > 128 || d0 < -128) s0[i] = -1e30f; if (d1 > 128 || d1 < -128) s1[i] = -1e30f; } }
                float rs = 0.f; unsigned pk[16];
#pragma unroll
                for (int j = 0; j < 8; ++j) { const float a0 = __builtin_amdgcn_exp2f(s0[2 * j]), a1 = __builtin_amdgcn_exp2f(s0[2 * j + 1]), b0 = __builtin_amdgcn_exp2f(s1[2 * j]), b1 = __builtin_amdgcn_exp2f(s1[2 * j + 1]);
                    rs += (a0 + a1) + (b0 + b1); pk[j] = pk2(a0, a1); pk[8 + j] = pk2(b0, b1); }
                lrun[h] += rs;
                __builtin_amdgcn_sched_barrier(0);
#pragma unroll
                for (int q = 0; q < 4; ++q) { const u32x4 pw = {pk[4 * q], pk[4 * q + 1], pk[4 * q + 2], pk[4 * q + 3]}; const bf16x8 pf = __builtin_bit_cast(bf16x8, pw);
#pragma unroll
                    for (int dt = 0; dt < 2; ++dt) { const bf16x8 vf = *(const bf16x8*)(vfp + vb + (32 * dt) * VSTR + 16 * q);
                        o[h][dt] = __builtin_amdgcn_mfma_f32_32x32x16_bf16(vf, pf, o[h][dt], 0, 0, 0); } }
            }
        }
        __syncthreads();
    }
#undef W_TILE
#undef W_LOAD
#undef W_WRITE
#pragma unroll
    for (int h = 0; h < NH; ++h) { float l = lrun[h]; l += __shfl_xor(l, 32); const float inv = 1.f / l;
        bf16_t* orow = O + (size_t)(wid * 32 + r) * 1024 + h * 64;
#pragma unroll
        for (int dt = 0; dt < 2; ++dt)
#pragma unroll
            for (int g = 0; g < 4; ++g)
                *(u32x2*)(orow + 32 * dt + 8 * g + 4 * h2) = (u32x2){pk2(o[h][dt][4 * g] * inv, o[h][dt][4 * g + 1] * inv), pk2(o[h][dt][4 * g + 2] * inv, o[h][dt][4 * g + 3] * inv)}; }
    __syncthreads();
}

DI void s5_kk_phase(char* lds, const Params& p) {
    const int tid512 = get_tid(); const int tid = tid512 & 255, s = tid >> 4, sp = tid & 15, dh = tid512 >> 8;
    f32x2* sbb = (f32x2*)lds;
    f32x2* scc = sbb + 1024;
    f32x2* spw = scc + 1024;
    const f32x2* POW = (const f32x2*)(p.ws + H_POW); const f32x2* BB = (const f32x2*)(p.ws + T_BBAR); float* KK = (float*)(p.ws + H_KK);
    for (int it = blockIdx.x; it < 32 * 2 * 4; it += gridDim.x) {
        const int dq = it & 3, dir = (it >> 2) & 1, g = it >> 3; const int dg = dir * 32 + g;
        __syncthreads();
        for (int i = tid512; i < 1024; i += NTHREADS) { sbb[i] = BB[(size_t)dg * 1024 + i]; scc[i] = (f32x2){p.in[18][(size_t)dg * 1024 + i], p.in[19][(size_t)dg * 1024 + i]}; }
        { const int i = tid512; spw[i] = POW[((size_t)dg * 33 + dq * 8 + (i >> 6)) * 64 + (i & 63)]; }
        __syncthreads();
        float acc[4] = {0.f, 0.f, 0.f, 0.f};
#pragma unroll 4
        for (int pp = 0; pp < 64; ++pp) { const f32x2 bb = sbb[pp * 16 + sp], cc = scc[s * 64 + pp];
#pragma unroll
            for (int q = 0; q < 4; ++q) { const f32x2 pw = spw[(dh * 4 + q) * 64 + pp];
                const float zr = pw[0] * bb[0] - pw[1] * bb[1], zi = pw[0] * bb[1] + pw[1] * bb[0];
                acc[q] += cc[0] * zr - cc[1] * zi; } }
#pragma unroll
        for (int q = 0; q < 4; ++q) KK[(size_t)((g * 2 + dir) * 32 + dq * 8 + dh * 4 + q) * 256 + tid] = acc[q];
    }
    __syncthreads();
}
DI void s5_w1a_phase(const Params& p) {
    const int tid = get_tid();
    const f32x2* POW = (const f32x2*)(p.ws + H_POW); const f32x2* BB = (const f32x2*)(p.ws + T_BBAR); bf16_t* W = (bf16_t*)(p.ws + H_W1A);
    for (int idx = blockIdx.x * NTHREADS + tid; idx < 2048 * 256; idx += gridDim.x * NTHREADS) {
        const int kq = idx & 63, n = (idx >> 6) & 255, g = idx >> 14;
        const int dir = n >> 7, ri = (n >> 6) & 1, pp = n & 63; const int e = (dir * 32 + g) * 64 + pp; const int tl = kq >> 1, s0 = (kq & 1) * 8;
        const f32x2 pw = POW[((size_t)(dir * 32 + g) * 33 + (dir ? tl : 31 - tl)) * 64 + pp];
        float v[8];
#pragma unroll
        for (int j = 0; j < 8; ++j) { const f32x2 bb = BB[e * 16 + s0 + j]; v[j] = ri ? pw[0] * bb[1] + pw[1] * bb[0] : pw[0] * bb[0] - pw[1] * bb[1]; }
        *(u32x4*)(W + ((size_t)g * 256 + n) * 512 + kq * 8) = (u32x4){pk2(v[0], v[1]), pk2(v[2], v[3]), pk2(v[4], v[5]), pk2(v[6], v[7])};
    }
}
DI void s5_w1b_phase(const Params& p) {
    const int tid = get_tid();
    const f32x2* POW = (const f32x2*)(p.ws + H_POW); const float* KK = (const float*)(p.ws + H_KK); bf16_t* W = (bf16_t*)(p.ws + A_W1B);
    for (int idx = blockIdx.x * NTHREADS + tid; idx < 6144 * 256; idx += gridDim.x * NTHREADS) {
        const int kq = idx % 96, n = (idx / 96) & 511, g = idx / (96 * 512);
        const int tl = n >> 4, s = n & 15;
        float v[8];
        if (kq < 64) { const int tl2 = kq >> 1, s0 = (kq & 1) * 8;
            f32x4 x0 = {0.f, 0.f, 0.f, 0.f}, x1 = x0;
            if (tl2 <= tl) { const float* k0 = KK + (size_t)((g * 2 + 0) * 32 + (tl - tl2)) * 256 + s * 16 + s0; x0 += *(const f32x4*)k0; x1 += *(const f32x4*)(k0 + 4); }
            if (tl2 >= tl) { const float* k1 = KK + (size_t)((g * 2 + 1) * 32 + (tl2 - tl)) * 256 + s * 16 + s0; x0 += *(const f32x4*)k1; x1 += *(const f32x4*)(k1 + 4); }
#pragma unroll
            for (int j = 0; j < 4; ++j) { v[j] = x0[j]; v[4 + j] = x1[j]; }
            if (tl2 == tl && (s >> 3) == (kq & 1)) { const float dv = p.in[20][g * 16 + s];
#pragma unroll
                for (int j = 0; j < 8; ++j) if (j == (s & 7)) v[j] += dv; }
        } else { const int k2 = (kq - 64) * 8; const int dir = k2 >> 7, ri = (k2 >> 6) & 1, p0 = k2 & 63;
            const float* cre = p.in[18] + ((size_t)(dir * 32 + g) * 16 + s) * 64 + p0; const float* cim = p.in[19] + ((size_t)(dir * 32 + g) * 16 + s) * 64 + p0;
            const f32x2* pwp = POW + ((size_t)(dir * 32 + g) * 33 + (dir ? 32 - tl : tl + 1)) * 64 + p0;
            const f32x4 cr0 = *(const f32x4*)cre, cr1 = *(const f32x4*)(cre + 4), ci0 = *(const f32x4*)cim, ci1 = *(const f32x4*)(cim + 4);
#pragma unroll
            for (int j = 0; j < 8; ++j) { const f32x2 pw = pwp[j];
                const float cr = j < 4 ? cr0[j & 3] : cr1[j & 3], ci = j < 4 ? ci0[j & 3] : ci1[j & 3];
                v[j] = ri ? -(cr * pw[1] + ci * pw[0]) : cr * pw[0] - ci * pw[1]; }
        }
        *(u32x4*)(W + ((size_t)g * 512 + n) * 768 + kq * 8) = (u32x4){pk2(v[0], v[1]), pk2(v[2], v[3]), pk2(v[4], v[5]), pk2(v[6], v[7])};
    }
}
DI void s5_carry_phase(const Params& p) {
    const int tid_ = get_tid(); const int lane = tid_ & 63, wid = tid_ >> 6;
    const f32x2* POW = (const f32x2*)(p.ws + H_POW); const float* E = (const float*)(p.ws + H_E); bf16_t* UA = (bf16_t*)(p.ws + H_UA);
    for (int it = ((int)gridDim.x - 1 - (int)blockIdx.x) * NWV + wid; it < 2 * 2 * 32; it += gridDim.x * NWV) {
        const int g = it & 31, dir = (it >> 5) & 1, b = it >> 6;
        const f32x2 l32 = POW[((size_t)(dir * 32 + g) * 33 + 32) * 64 + lane];
        float hr = 0.f, hi = 0.f;
        float er[8], ei[8], fr_[8], fi_[8];
#define C_IDX(i_) ((size_t)g * CHR + b * NCK + (dir ? ((i_) < 8 ? 7 - (i_) : NCK - 1 - ((i_) - 8)) : (i_)))
#define C_LOAD(R, I, i0_) do { _Pragma("unroll") for (int j = 0; j < 8; ++j) { const size_t m = C_IDX((i0_) + j); R[j] = E[m * 256 + dir * 128 + lane]; I[j] = E[m * 256 + dir * 128 + 64 + lane]; } } while (0)
#define C_STEP(R, I, i0_) do { _Pragma("unroll") for (int j = 0; j < 8; ++j) { const size_t m = C_IDX((i0_) + j); bf16_t* u = UA + m * 768 + 512 + dir * 128 + lane; \
            u[0] = (bf16_t)(pk2(hr, 0.f) & 0xffff); u[64] = (bf16_t)(pk2(hi, 0.f) & 0xffff); \
            const float nr = l32[0] * hr - l32[1] * hi + R[j], ni = l32[0] * hi + l32[1] * hr + I[j]; hr = nr; hi = ni; } } while (0)
        C_LOAD(er, ei, 0);
        for (int i0 = 0; i0 < NCK; i0 += 16) {
            if (i0 + 8 < NCK) C_LOAD(fr_, fi_, i0 + 8);
            C_STEP(er, ei, i0);
            if (i0 + 8 < NCK) { if (i0 + 16 < NCK) C_LOAD(er, ei, i0 + 16); C_STEP(fr_, fi_, i0 + 8); }
        }
#undef C_IDX
#undef C_LOAD
#undef C_STEP
    }
}

DI float rope64(float x, int lane, const float* ROPE, int rpos, int cpos) {
    const float partner = __shfl_xor(x, 16);
    const int i = lane & 15; const int pos = lane < 32 ? rpos : cpos;
    const float c = ROPE[(pos * 16 + i) * 2], s = ROPE[(pos * 16 + i) * 2 + 1];
    return (lane & 16) ? x * c + partner * s : x * c - partner * s;
}
DI void mla_prep_phase(const Params& p) {
    const int tid_ = get_tid(); const int lane = tid_ & 63, wid = tid_ >> 6;
    bf16_t* QR = (bf16_t*)(p.ws + S_QRAW); const bf16_t* KN = (const bf16_t*)(p.ws + S_KNOPE); const float* KR = (const float*)(p.ws + H_KR);
    bf16_t* KA = (bf16_t*)(p.ws + S_KA); const float* ROPE = (const float*)(p.ws + T_ROPE);
    const float qsc = 0.07216878364870323f * LOG2E;
    const float qg0 = p.in[27][lane], qg1 = p.in[27][64 + lane], qg2 = p.in[27][128 + lane];
    const float kg0 = p.in[28][lane], kg1 = p.in[28][64 + lane], kg2 = p.in[28][128 + lane];
    for (int r = blockIdx.x * NWV + wid; r < NR; r += gridDim.x * NWV) {
        const bool lat = r >= NCTX; const int b = row_batch(r), tp = row_tpos(r); const int t = tp - CTX;
        const int rpos = lat ? (t >> 6) : 0, cpos = lat ? (t & 63) : 0;
        const float krv = KR[(size_t)r * 64 + lane];
#pragma unroll
        for (int h = 0; h < 4; ++h) {
            bf16_t* q = QR + (size_t)r * 768 + h * 192;
            float x0 = bf2f(q[lane]), x1 = bf2f(q[64 + lane]), x2 = bf2f(q[128 + lane]);
            float ss = wave_sum(x0 * x0 + x1 * x1 + x2 * x2);
            float rs = rsqrtf(ss * (1.f / 192.f) + 1e-6f);
            x0 *= rs * qg0; x1 *= rs * qg1; x2 *= rs * qg2;
            if (lat) x2 = rope64(x2, lane, ROPE, rpos, cpos);
            q[lane] = (bf16_t)(pk2(x0 * qsc, 0.f) & 0xffff); q[64 + lane] = (bf16_t)(pk2(x1 * qsc, 0.f) & 0xffff); q[128 + lane] = (bf16_t)(pk2(x2 * qsc, 0.f) & 0xffff);
            const bf16_t* kn = KN + (size_t)r * 512 + h * 128;
            float k0 = bf2f(kn[lane]), k1 = bf2f(kn[64 + lane]), k2 = krv;
            ss = wave_sum(k0 * k0 + k1 * k1 + k2 * k2);
            rs = rsqrtf(ss * (1.f / 192.f) + 1e-6f);
            k0 *= rs * kg0; k1 *= rs * kg1; k2 *= rs * kg2;
            if (lat) k2 = rope64(k2, lane, ROPE, rpos, cpos);
            bf16_t* kd = KA + ((size_t)(b * 4 + h) * TK + tp) * 192;
            kd[lane] = (bf16_t)(pk2(k0, 0.f) & 0xffff); kd[64 + lane] = (bf16_t)(pk2(k1, 0.f) & 0xffff); kd[128 + lane] = (bf16_t)(pk2(k2, 0.f) & 0xffff);
        }
    }
}
__global__ void __launch_bounds__(NTHREADS, 2) fwd_kernel(Params p) {
    extern __shared__ __attribute__((aligned(16))) char lds[];
    cg::grid_group grid = cg::this_grid();
    char* ws = p.ws;
    const bf16_t* WB = (const bf16_t*)ws;
    const float* MOD = (const float*)(ws + T_MOD);
    float* H = (float*)(ws + OFF_H);
    bf16_t* A0 = (bf16_t*)(ws + OFF_A0);
    const int bid = blockIdx.x, nb = gridDim.x;
    volatile LAS unsigned* xst = (volatile LAS unsigned*)(lds + (LDS_BYTES - 16));
    if (threadIdx.x == 0) { xst[0] = 0u; xst[1] = 0u; }
    __syncthreads();
    const XcdBarrier xb = xcd_barrier_post((unsigned*)(ws + T_BAR), xst);
    if (p.pad == 0x7fffffff) grid.sync();
#define GRID_SYNC() xcd_barrier(xb)

    { const int npair = p.jobs[4].tile0 >> 1, nit = 192 + 12 + npair;
      for (int it = bid; it < nit; it += nb) {
          if (it < 192) ada_item(lds, p, it);
          else if (it < 204) tables_item(p, it - 192);
          else { const int lt0 = (it - 204) * 2 + (int)(threadIdx.x >> 8); const bool live = lt0 < p.jobs[4].tile0; const int lt = live ? lt0 : 0; int j = 0;
#pragma unroll
              for (int q = 1; q < 11; ++q) if (lt >= p.jobs[q].tile0) j = q;
              transpose_tile(lds, ws, p.jobs[j], lt - p.jobs[j].tile0, live); } } }
    GRID_SYNC();
    modulate_rows(p, 0, 0, true, 0);
    s5_kk_phase(lds, p);
    GRID_SYNC();
    { EpiWin0 e{(bf16_t*)(ws + H_UA), (bf16_t*)(ws + S_CQN), (bf16_t*)(ws + S_CKVN), (float*)(ws + S_SSP), (float*)(ws + H_KR)};
      gemm_phase(lds, A0, 1024, WB + W_IN0, 1024, 0, NR / 256, 5, e); }
    s5_w1a_phase(p);
    { int rk, nrk; slack_rank((NR / 256) * 5, rk, nrk); transpose_range(lds, ws, p, p.jobs[4].tile0, p.jobs[7].tile0, rk, nrk); }
    GRID_SYNC();
    s5_w1b_phase(p);
    { EpiS1a e{(float*)(ws + H_E)};
      gemm_phase(lds, (const bf16_t*)(ws + H_UA), 768, (const bf16_t*)(ws + H_W1A), 512, 0, 3, 1, e, 32, (size_t)CHR * 768, (size_t)256 * 512); }
    { int rk, nrk; slack_rank(96, rk, nrk); transpose_range(lds, ws, p, p.jobs[7].tile0, p.jobs[9].tile0, rk, nrk); }
    GRID_SYNC();
    s5_carry_phase(p);
    { EpiBf16 e{(bf16_t*)(ws + S_QRAW), 768, (const float*)(ws + S_SSP)};
      gemm_phase(lds, (const bf16_t*)(ws + S_CQN), 384, WB + W_QB, 384, 0, NR / 256, 3, e); }
    { EpiKV e{(bf16_t*)(ws + S_KNOPE), (bf16_t*)(ws + S_VT), (const float*)(ws + S_SSP)};
      gemm_phase(lds, (const bf16_t*)(ws + S_CKVN), 256, WB + W_KVB, 256, 0, NR / 256, 4, e); }
    GRID_SYNC();
    { EpiS1b e{(bf16_t*)(ws + S_YG)};
      gemm_phase(lds, (const bf16_t*)(ws + H_UA), 768, (const bf16_t*)(ws + A_W1B), 768, 0, 3, 2, e, 32, (size_t)CHR * 768, (size_t)512 * 768); }
    mla_prep_phase(p);
    GRID_SYNC();
    { const bf16_t* QR = (const bf16_t*)(ws + S_QRAW); const bf16_t* KA = (const bf16_t*)(ws + S_KA); const bf16_t* VT = (const bf16_t*)(ws + S_VT);
      const int nlat = 2 * 4 * 32, nall = nlat + 2 * 4;
      float mref; { float gq = 0.f, gk = 0.f;
        for (int d_ = 0; d_ < 192; ++d_) { gq = fmaxf(gq, fabsf(p.in[27][d_])); gk = fmaxf(gk, fabsf(p.in[28][d_])); }
        mref = 13.856406f * LOG2E * 1.02f * gq * gk; }
      for (int it0 = bid; it0 < nlat + nb; it0 += nb) {
          const int it = it0 < nlat ? it0 : nlat + (it0 - nlat) - (nb - 8);
          if (it0 >= nlat && (it < nlat || it >= nall)) continue;
          if (it < nlat) { const int h = it & 3, b = (it >> 2) & 1, qb = it >> 3;   const size_t row = NCTX + (size_t)b * SEQ + qb * 256;
              attn_item<192, 128, false>(lds, QR + row * 768 + h * 192, 768, KA + (size_t)(b * 4 + h) * TK * 192, VT + (size_t)(b * 4 + h) * 128 * TK, 0, TK / 64, 0, 0, mref, 0.f,
                                         A0 + row * 1024 + 512 + h * 128, 1024, 0); }
          else { const int j = it - nlat; const int h = j & 3, b = j >> 2; const size_t row = (size_t)b * CTX;
              attn_item<192, 128, false>(lds, QR + row * 768 + h * 192, 768, KA + (size_t)(b * 4 + h) * TK * 192, VT + (size_t)(b * 4 + h) * 128 * TK, 0, 4, 0, 0, mref, 0.f,
                                         A0 + row * 1024 + 512 + h * 128, 1024, 0); } }
      EpiGLU e{(const bf16_t*)(ws + S_YG), p.in[22], A0};
      gemm_phase(lds, (const bf16_t*)(ws + S_YG), 512, WB + W_GLU, 512, 0, NR / 256, 2, e); }
    GRID_SYNC();
    { EpiRes e{p.in[2], p.in[0], H, H + (size_t)NCTX * 1024, MOD + 0 * 3 * 6144 + 2048, 0};
      gemm_phase(lds, A0, 1024, WB + W_OUT0, 1024, 2, NLAT / 256, 4, e);
      thin_gemm_ctx<4>(lds, A0, 1024, WB + W_OUT0, 1024, p.in[2], H, MOD + 0 * 3 * 6144 + 2048); }
    GRID_SYNC();
    modulate_rows(p, 0, 1, false, 0);
    GRID_SYNC();
    { EpiSwiGLU e{(bf16_t*)(ws + S_HID)};
      gemm_phase(lds, A0, 1024, WB + W_GU0, 1024, 0, NR / 256, 22, e); }
    { int rk, nrk; slack_rank((NR / 256) * 22, rk, nrk); transpose_range(lds, ws, p, p.jobs[9].tile0, p.jobs[9].tile0 + 704, rk, nrk); }
    GRID_SYNC();
    { EpiRes e{H, H + (size_t)NCTX * 1024, H, H + (size_t)NCTX * 1024, MOD + 0 * 3 * 6144 + 5120, 0};
      gemm_phase(lds, (const bf16_t*)(ws + S_HID), FH, WB + W_D0, FH, 2, NLAT / 256, 4, e);
      thin_gemm_ctx<11>(lds, (const bf16_t*)(ws + S_HID), FH, WB + W_D0, FH, H, H, MOD + 0 * 3 * 6144 + 5120); }
    GRID_SYNC();
    modulate_rows(p, 1, 0, false, 0);
    GRID_SYNC();
    { EpiWin1 e{(bf16_t*)(ws + S1_Q), (bf16_t*)(ws + S1_K), (bf16_t*)(ws + S1_VT), p.in[31], p.in[32], (const float*)(ws + T_ROPE)};
      gemm_phase(lds, A0, 1024, WB + W_IN1, 1024, 0, NR / 256, 6, e); }
    { int rk, nrk; slack_rank((NR / 256) * 6, rk, nrk); transpose_range(lds, ws, p, p.jobs[9].tile0 + 704, p.njobtiles, rk, nrk); }
    GRID_SYNC();
    { const bf16_t* Q = (const bf16_t*)(ws + S1_Q); const bf16_t* K1 = (const bf16_t*)(ws + S1_K); const bf16_t* VT = (const bf16_t*)(ws + S1_VT);
      constexpr int WNH = 2;
      const int nit = 2 * 4 * (4 / WNH) * 32;
      float mref; { float gq = 0.f, gk = 0.f;
        for (int d_ = 0; d_ < 64; ++d_) { gq = fmaxf(gq, fabsf(p.in[31][d_])); gk = fmaxf(gk, fabsf(p.in[32][d_])); }
        mref = 8.f * LOG2E * 1.02f * gq * gk; }
      for (int it = bid; it < nit; it += nb) { const int kvh = it & 3, b = (it >> 2) & 1, rest = it >> 3; const int gp = rest % (4 / WNH), i = rest / (4 / WNH); const int hq0 = kvh * 4 + gp * WNH;
          const size_t row = NCTX + (size_t)b * SEQ + i * 256;
          const int l0 = (4 * i - 2) < 0 ? 0 : (4 * i - 2), l1 = (4 * i + 6) > 128 ? 128 : (4 * i + 6);
          win_attn_item<WNH>(lds, Q + row * 1024 + hq0 * 64, K1 + (size_t)(b * 4 + kvh) * TK * 64, VT + (size_t)(b * 4 + kvh) * 64 * TK, 4 + l0, 4 + l1, mref, p.in[33] + hq0, A0 + row * 1024 + hq0 * 64, i * 256); } }
    GRID_SYNC();
    { EpiRes e{H, H + (size_t)NCTX * 1024, nullptr, H + (size_t)NCTX * 1024, MOD + 1 * 3 * 6144 + 2048, 0};
      gemm_phase(lds, A0, 1024, WB + W_OUT1, 1024, 2, NLAT / 256, 4, e); }
    GRID_SYNC();
    modulate_rows(p, 1, 1, false, NCTX);
    GRID_SYNC();
    { EpiSwiGLU e{(bf16_t*)(ws + S_HID)};
      gemm_phase(lds, A0, 1024, WB + W_GU1, 1024, 2, NLAT / 256, 22, e); }
    GRID_SYNC();
    { EpiRes e{H, H + (size_t)NCTX * 1024, nullptr, p.out, MOD + 1 * 3 * 6144 + 5120, 0};
      gemm_phase(lds, (const bf16_t*)(ws + S_HID), FH, WB + W_D1, FH, 2, NLAT / 256, 4, e); }
}

extern "C" void kernel_launch(void* const* d_in, const int* in_sizes, int n_in, void* d_out, int out_size, void* d_ws, size_t ws_size, hipStream_t stream) {
    static int grid_blocks = 0;
    if (grid_blocks == 0) {
        if (n_in != 34 || ws_size < WS_NEED2) { fprintf(stderr, "kernel_launch: unexpected n_in %d / ws %zu (need %zu)\n", n_in, ws_size, (size_t)WS_NEED2); grid_blocks = -1; return; }
        int dev = 0, cus = 0, per_cu = 0;
        (void)hipGetDevice(&dev);
        (void)hipDeviceGetAttribute(&cus, hipDeviceAttributeMultiprocessorCount, dev);
        (void)hipFuncSetAttribute((const void*)fwd_kernel, hipFuncAttributeMaxDynamicSharedMemorySize, LDS_BYTES);
        (void)hipOccupancyMaxActiveBlocksPerMultiprocessor(&per_cu, (const void*)fwd_kernel, NTHREADS, LDS_BYTES);
        if (per_cu < 1) { fprintf(stderr, "kernel_launch: occupancy query returned %d\n", per_cu); grid_blocks = -1; return; }
        if (per_cu > 1) per_cu = 1;
        grid_blocks = cus * per_cu;
        fprintf(stderr, "kernel_launch: grid %d (%d CUs x %d)\n", grid_blocks, cus, per_cu);
    }
    if (grid_blocks < 0) return;
    Params p{};
    for (int i = 0; i < 34; ++i) p.in[i] = (const float*)d_in[i];
    p.out = (float*)d_out; p.ws = (char*)d_ws;
    const float* fg = p.in[8]; const float* fu = p.in[9]; const float* fd = p.in[10];
    const size_t FW = (size_t)1024 * FH;
    int t0 = 0;
    auto mk = [&](int idx, const float* a, const float* b, size_t dst, int K, int ld, int npad, int mode) {
        Job& j = p.jobs[idx]; j.a = a; j.b = b; j.ks = nullptr; j.dst = dst; j.K = K; j.ld = ld; j.ntk = K / 64; j.ntn = npad / 64; j.tile0 = t0; j.mode = mode; t0 += j.ntk * j.ntn; };
    mk(0, p.in[11], nullptr, W_IN0, 1024, 1216, 1280, 0);
    mk(1, p.in[24], nullptr, W_QB, 384, 768, 768, 0);
    mk(2, p.in[26], nullptr, W_KVB, 256, 1024, 1024, 0);
    p.jobs[1].ks = p.in[23]; p.jobs[2].ks = p.in[25];
    mk(3, p.in[21], nullptr, W_GLU, 512, 512, 512, 0);
    mk(4, p.in[12], nullptr, W_OUT0, 1024, 1024, 1024, 0);
    mk(5, fg, fu, W_GU0, 1024, FH, 5632, 1);
    mk(6, fd, nullptr, W_D0, FH, 1024, 1024, 0);
    mk(7, p.in[29], nullptr, W_IN1, 1024, 1536, 1536, 0);
    mk(8, p.in[30], nullptr, W_OUT1, 1024, 1024, 1024, 0);
    mk(9, fg + FW, fu + FW, W_GU1, 1024, FH, 5632, 1);
    mk(10, fd + FW, nullptr, W_D1, FH, 1024, 1024, 0);
    p.njobtiles = t0;
    if (hipMemsetAsync((char*)d_ws + T_BAR, 0, XCD_BAR_WORDS * 4, stream) != hipSuccess) { fprintf(stderr, "kernel_launch: memset failed\n"); return; }
    void* args[] = {&p};
    hipError_t e = hipLaunchCooperativeKernel((const void*)fwd_kernel, dim3(grid_blocks), dim3(NTHREADS), args, LDS_BYTES, stream);
    if (e != hipSuccess) fprintf(stderr, "cooperative launch failed: %s (grid %d)\n", hipGetErrorString(e), grid_blocks);
}
```

```cpp
#include <hip/hip_runtime.h>
#include <hip/hip_cooperative_groups.h>
#include <cstdio>
#include <cstdint>
namespace cg = cooperative_groups;

#define DI __device__ __forceinline__
typedef unsigned short bf16_t;
typedef short bf16x8 __attribute__((ext_vector_type(8)));
typedef short s16x4 __attribute__((ext_vector_type(4)));
typedef float f32x4 __attribute__((ext_vector_type(4)));
typedef float f32x2 __attribute__((ext_vector_type(2)));
typedef float f32x16 __attribute__((ext_vector_type(16)));
typedef unsigned u32x4 __attribute__((ext_vector_type(4)));
typedef unsigned u32x2 __attribute__((ext_vector_type(2)));
typedef __bf16 bf16v2 __attribute__((ext_vector_type(2)));

constexpr int DM = 1024, NBATCH = 2, SEQ = 8192, CTX = 256;
constexpr int NCTX = NBATCH * CTX;
constexpr int NLAT = NBATCH * SEQ;
constexpr int NR = NCTX + NLAT;
constexpr int TK = CTX + SEQ;
constexpr int FH = 2816;
constexpr int NCH = TK / 64;
constexpr float LOG2E = 1.4426950408889634f;
constexpr int LDS_BYTES = 131072 + 64;
constexpr int NTHREADS = 512, NWV = 8;

constexpr size_t W_IN0 = 0;
constexpr size_t W_QB = W_IN0 + (size_t)1280 * 1024;
constexpr size_t W_KVB = W_QB + (size_t)768 * 384;
constexpr size_t W_GLU = W_KVB + (size_t)1024 * 256;
constexpr size_t W_OUT0 = W_GLU + (size_t)512 * 512;
constexpr size_t W_GU0 = W_OUT0 + (size_t)1024 * 1024;
constexpr size_t W_D0 = W_GU0 + (size_t)5632 * 1024;
constexpr size_t W_IN1 = W_D0 + (size_t)1024 * 2816;
constexpr size_t W_OUT1 = W_IN1 + (size_t)1536 * 1024;
constexpr size_t W_GU1 = W_OUT1 + (size_t)1024 * 1024;
constexpr size_t W_D1 = W_GU1 + (size_t)5632 * 1024;
constexpr size_t W_END = W_D1 + (size_t)1024 * 2816;
constexpr size_t OFF_TAB = W_END * 2;
constexpr size_t T_MOD = OFF_TAB;
constexpr size_t T_ROPE = T_MOD + 2 * 3 * 6144 * 4;
constexpr size_t T_LAMB = T_ROPE + 128 * 16 * 2 * 4;
constexpr size_t T_LAM64 = T_LAMB + 2 * 32 * 64 * 8;
constexpr size_t T_BBAR = T_LAM64 + 2 * 32 * 64 * 8;
constexpr size_t T_BAR = T_BBAR + (size_t)2 * 32 * 64 * 16 * 8;
constexpr size_t OFF_H = OFF_TAB + (1u << 20);
constexpr size_t OFF_A0 = OFF_H + (size_t)NR * 1024 * 4;
constexpr size_t OFF_S = OFF_A0 + (size_t)NR * 1024 * 2;
constexpr size_t WS_NEED = OFF_S + (size_t)108134400;
constexpr size_t S_SSP = WS_NEED;
constexpr size_t WS_NEED2 = S_SSP + (size_t)NR * 10 * 4;
static_assert(WS_NEED2 <= ((size_t)256 << 20) && OFF_S + (size_t)NR * FH * 2 <= WS_NEED, "workspace");
constexpr int SL = 32;
constexpr int NCK = TK / SL;
constexpr int CHR = NBATCH * NCK;
constexpr size_t H_UA = OFF_H;
constexpr size_t H_KR = H_UA + (size_t)(32 * CHR + 256) * 768 * 2;
constexpr size_t H_E = H_KR + (size_t)NR * 64 * 4;
constexpr size_t H_KK = H_E + (size_t)32 * CHR * 256 * 4;
constexpr size_t H_POW = H_KK + (size_t)32 * 2 * 32 * 256 * 4;
constexpr size_t H_W1A = H_POW + (size_t)4096 * 33 * 8;
static_assert(H_W1A + (size_t)32 * 256 * 512 * 2 <= OFF_A0, "H region overflow");
constexpr size_t A_W1B = OFF_A0;
constexpr size_t S_CQN = OFF_S;
constexpr size_t S_CKVN = S_CQN + (size_t)NR * 384 * 2;
constexpr size_t S_YG = OFF_S;
constexpr size_t S_X = S_CKVN + (size_t)NR * 256 * 2;
constexpr size_t S_CQKV = S_X;
constexpr size_t S_QRAW = S_X;
constexpr size_t S_KNOPE = S_QRAW + (size_t)NR * 768 * 2;
constexpr size_t S_VT = S_KNOPE + (size_t)NR * 512 * 2;
constexpr size_t S_KA = S_VT + (size_t)2 * 4 * 128 * TK * 2;
static_assert(S_CQKV + (size_t)NR * 640 * 4 <= S_VT, "CQKV overlaps VT");
static_assert(S_KA + (size_t)2 * 4 * TK * 192 * 2 <= WS_NEED, "scratch overflow");
constexpr size_t S_HID = OFF_S;
constexpr size_t S1_Q = OFF_S;
constexpr size_t S1_KRAW = S1_Q + (size_t)NR * 1024 * 2;
constexpr size_t S1_K = S1_KRAW + (size_t)NR * 256 * 4;
constexpr size_t S1_VT = S1_K + (size_t)2 * 4 * TK * 64 * 2;

struct Job { const float* a; const float* b; const float* ks; unsigned long long dst; int K, ld, ntk, ntn, tile0, mode; };
struct Params {
    const float* in[34];
    float* out;
    char* ws;
    Job jobs[11];
    int njobtiles;
    int pad;
};

DI int get_tid() { int t = threadIdx.x; asm volatile("" : "+v"(t)); return t; }
DI unsigned pk2(float lo, float hi) { f32x2 v = {lo, hi}; return __builtin_bit_cast(unsigned, __builtin_convertvector(v, bf16v2)); }
DI float bf2f(unsigned short b) { return __uint_as_float(((unsigned)b) << 16); }
DI float wave_sum(float v) {
#pragma unroll
    for (int o = 32; o > 0; o >>= 1) v += __shfl_xor(v, o);
    return v;
}
DI int row_vec(int r) { return r < NCTX ? 2 : (r - NCTX) / SEQ; }
DI int row_batch(int r) { return r < NCTX ? r / CTX : (r - NCTX) / SEQ; }
DI int row_tpos(int r) { return r < NCTX ? r % CTX : CTX + (r - NCTX) % SEQ; }
DI float sigmoidf_(float x) { return 1.f / (1.f + __expf(-x)); }
DI float siluf_(float x) { return x / (1.f + __expf(-x)); }
DI float gelu_tanh(float y) { const float z = 0.7978845608028654f * (y + 0.044715f * y * y * y); const float t = 1.f - 2.f / (1.f + __expf(2.f * z)); return 0.5f * y * (1.f + t); }
DI void my_sincos(float x, float& s, float& c) {
    const float q = rintf(x * 0.636619772367581f);
    float r = fmaf(-q, 1.5703125f, x);
    r = fmaf(-q, 4.837512969970703125e-4f, r);
    r = fmaf(-q, 7.54978995489188216e-8f, r);
    const int qi = (int)q;
    const float r2 = r * r;
    const float sp = r + r * r2 * (-1.6666654611e-1f + r2 * (8.3321608736e-3f + r2 * (-1.9515295891e-4f)));
    const float cp = 1.0f - 0.5f * r2 + r2 * r2 * (4.166664568298827e-2f + r2 * (-1.388731625493765e-3f + r2 * 2.443315711809948e-5f));
    const int k = qi & 3;
    s = (k == 0) ? sp : (k == 1) ? cp : (k == 2) ? -sp : -cp;
    c = (k == 0) ? cp : (k == 1) ? -sp : (k == 2) ? -cp : sp;
}


#define XB_TMO      128
#define XB_XCNT(j)  (256  + 64 * (j))
#define XB_XSUB(j)  (1280 + 64 * (j))
#define XB_XGEN(j)  (2304 + 64 * (j))
#define XB_TOP      3328
#define XB_TOPGEN   3392
#define XCD_BAR_WORDS 3456
#define XB_SPIN_CAP (1u << 22)
#define LAS __attribute__((address_space(3)))
DI unsigned xb_ld(unsigned* p) { return __hip_atomic_load(p, __ATOMIC_RELAXED, __HIP_MEMORY_SCOPE_AGENT); }
DI unsigned xb_add(unsigned* p, unsigned v) { return __hip_atomic_fetch_add(p, v, __ATOMIC_RELAXED, __HIP_MEMORY_SCOPE_AGENT); }
DI unsigned xb_xcc_id() { return (unsigned)__builtin_amdgcn_s_getreg((3 << 11) | 20) & 0xFu; }
#define XB_SPIN(cond, bar) do { unsigned _sp = 0; while (cond) { __builtin_amdgcn_s_sleep(1); \
    if ((++_sp & 255u) == 0u) { if (xb_ld(&(bar)[XB_TMO])) break; if (_sp > XB_SPIN_CAP) { atomicAdd(&(bar)[XB_TMO], 1u); break; } } } } while (0)
struct XcdBarrier { unsigned* bar; unsigned x; volatile LAS unsigned* st; };
DI XcdBarrier xcd_barrier_post(unsigned* bar, volatile LAS unsigned* st) {
    XcdBarrier b; b.bar = bar; b.x = xb_xcc_id(); b.st = st;
    if (threadIdx.x == 0) (void)xb_add(&bar[XB_XCNT(b.x)], 1u);
    return b;
}
DI void xcd_barrier_complete(unsigned* bar, unsigned x, unsigned& nloc, unsigned& nx) {
    const unsigned G = gridDim.x * gridDim.y * gridDim.z;
    unsigned sum, cnt, mine, sp = 0u;
    for (;;) {
        sum = 0u; cnt = 0u; mine = 0u;
#pragma unroll
        for (unsigned j = 0; j < 16; ++j) { const unsigned c = xb_ld(&bar[XB_XCNT(j)]); sum += c; cnt += (c > 0u) ? 1u : 0u; mine = (j == x) ? c : mine; }
        if (sum == G) break;
        __builtin_amdgcn_s_sleep(1);
        if ((++sp & 255u) == 0u) { if (xb_ld(&bar[XB_TMO])) break; if (sp > XB_SPIN_CAP) { atomicAdd(&bar[XB_TMO], 1u); break; } }
    }
    nloc = mine > 0u ? mine : 1u; nx = cnt > 0u ? cnt : 1u;
}
DI void xcd_barrier(const XcdBarrier& b) {
    asm volatile("s_waitcnt vmcnt(0)" ::: "memory");
    __syncthreads();
    if (threadIdx.x == 0) {
        unsigned* bar = b.bar;
        __builtin_amdgcn_s_waitcnt(0);
        unsigned nloc = b.st[0], nx = b.st[1];
        if (nloc == 0u) { xcd_barrier_complete(bar, b.x, nloc, nx); b.st[0] = nloc; b.st[1] = nx; }
        const unsigned old = xb_add(&bar[XB_XSUB(b.x)], 1u);
        const unsigned gen = old / nloc;
        if (old + 1u == (gen + 1u) * nloc) {
            __builtin_amdgcn_fence(__ATOMIC_RELEASE, "agent");
            asm volatile("s_waitcnt vmcnt(0)" ::: "memory");
            const unsigned og = xb_add(&bar[XB_TOP], 1u);
            const unsigned tg = og / nx;
            if (og + 1u == (tg + 1u) * nx) xb_add(&bar[XB_TOPGEN], 1u);
            else XB_SPIN(xb_ld(&bar[XB_TOPGEN]) == tg, bar);
            __builtin_amdgcn_fence(__ATOMIC_ACQUIRE, "agent");
            xb_add(&bar[XB_XGEN(b.x)], 1u);
            asm volatile("s_waitcnt vmcnt(0)" ::: "memory");
        } else {
            XB_SPIN(xb_ld(&bar[XB_XGEN(b.x)]) == gen, bar);
            __builtin_amdgcn_fence(__ATOMIC_ACQUIRE, "agent");
            asm volatile("s_waitcnt vmcnt(0)" ::: "memory");
        }
    }
    __syncthreads();
}

DI void transpose_tile(char* lds, char* ws, const Job& jb, int lt, bool live) {
    const int tid512 = get_tid(); const int tid = tid512 & 255;
    float (*tile)[65] = (float (*)[65])(lds + (tid512 >> 8) * 17408);
    const int tk = lt % jb.ntk, tn = lt / jb.ntk;
    const int k0 = tk * 64, n0 = tn * 64;
    const int c4 = (tid & 15) * 4, rq = tid >> 4;
    const float* src; int col; bool valid = live;
    if (jb.mode == 0) { src = jb.a; col = n0 + c4; valid = live && col < jb.ld; }
    else { const int nsub = c4 >> 4, i = c4 & 15; src = (nsub & 1) ? jb.b : jb.a; col = tn * 32 + (nsub >> 1) * 16 + i; }
#pragma unroll
    for (int kk = 0; kk < 4; ++kk) { const int k = kk * 16 + rq; f32x4 v = valid ? *(const f32x4*)(src + (size_t)(k0 + k) * jb.ld + col) : (f32x4){0.f, 0.f, 0.f, 0.f};
        if (jb.ks) v = v * jb.ks[k0 + k];
        tile[k][c4] = v[0]; tile[k][c4 + 1] = v[1]; tile[k][c4 + 2] = v[2]; tile[k][c4 + 3] = v[3]; }
    __syncthreads();
    const int r = tid >> 2, ks = (tid & 3) * 16;
    unsigned w[8];
#pragma unroll
    for (int q = 0; q < 8; ++q) w[q] = pk2(tile[ks + 2 * q][r], tile[ks + 2 * q + 1][r]);
    bf16_t* d = (bf16_t*)(ws) + jb.dst + (size_t)(n0 + r) * jb.K + k0 + ks;
    if (live) { *(u32x4*)d = (u32x4){w[0], w[1], w[2], w[3]};
    *(u32x4*)(d + 8) = (u32x4){w[4], w[5], w[6], w[7]}; }
    __syncthreads();
}

DI void transpose_range(char* lds, char* ws, const Params& p, int t_begin, int t_end, int rank, int nranks) {
    if (rank < 0) return;
    for (int pr = (t_begin >> 1) + rank; pr < (t_end >> 1); pr += nranks) {
        const int lt = pr * 2 + (int)(threadIdx.x >> 8); int j = 0;
#pragma unroll
        for (int q = 1; q < 11; ++q) if (lt >= p.jobs[q].tile0) j = q;
        transpose_tile(lds, ws, p.jobs[j], lt - p.jobs[j].tile0, true);
    }
}
DI void slack_rank(int ntile, int& rank, int& nranks) { const int rem = ntile % (int)gridDim.x; if (rem == 0) { rank = blockIdx.x; nranks = gridDim.x; } else { rank = (int)blockIdx.x - rem; nranks = (int)gridDim.x - rem; } }

DI void ada_item(char* lds, const Params& p, int it) {
    float* sil = (float*)lds;
    float* red = sil + 3072;
    float* MOD = (float*)(p.ws + T_MOD);
    const int tid = get_tid(), layer = it / 96, n0 = (it % 96) * 64;
    for (int i = tid; i < 3072; i += NTHREADS) { const int v = i >> 10, k = i & 1023; const float x = v < 2 ? p.in[1][v * 1024 + k] : p.in[3][k]; sil[i] = siluf_(x); }
    __syncthreads();
    const int j4 = (tid & 15) * 4, kg = tid >> 4;
    const float* W = p.in[4] + (size_t)layer * 1024 * 6144 + n0 + j4;
    f32x4 a0 = {0.f, 0.f, 0.f, 0.f}, a1 = a0, a2 = a0;
#pragma unroll 8
    for (int k = kg * 32; k < kg * 32 + 32; ++k) { const f32x4 w = *(const f32x4*)(W + (size_t)k * 6144); a0 += sil[k] * w; a1 += sil[1024 + k] * w; a2 += sil[2048 + k] * w; }
    *(f32x4*)(red + (kg * 3 + 0) * 64 + j4) = a0; *(f32x4*)(red + (kg * 3 + 1) * 64 + j4) = a1; *(f32x4*)(red + (kg * 3 + 2) * 64 + j4) = a2;
    __syncthreads();
    if (tid < 192) { const int v = tid >> 6, jj = tid & 63;
        float s = p.in[5][layer * 6144 + n0 + jj];
#pragma unroll 8
        for (int q = 0; q < 32; ++q) s += red[(q * 3 + v) * 64 + jj];
        MOD[(layer * 3 + v) * 6144 + n0 + jj] = s; }
    __syncthreads();
}

DI void tables_item(const Params& p, int it) {
    const int tid = get_tid();
    if (it < 4) {
        const int e = it * 512 + tid, pos = e >> 4, i = e & 15;
        const float inv = exp2f(-(float)i * (13.287712379549449f / 16.f));
        float s, c; my_sincos((float)pos * inv, s, c);
        float* ROPE = (float*)(p.ws + T_ROPE); ROPE[e * 2] = c; ROPE[e * 2 + 1] = s;
    } else {
        const int e = (it - 4) * 512 + tid;
        const int dg = e >> 6;
        const float lr = p.in[13][e], li = p.in[14][e], step = expf(p.in[15][dg]);
        const float a = lr * step, b = li * step;
        const float ea = expf(a);
        float sb, cb; my_sincos(b, sb, cb);
        float sh, ch; my_sincos(0.5f * b, sh, ch);
        const float em1 = a * (1.f + a * 0.5f * (1.f + a * (1.f / 3.f) * (1.f + a * 0.25f * (1.f + a * 0.2f * (1.f + a * (1.f / 6.f))))));
        const float lbr = ea * cb, lbi = ea * sb;
        const float nr = em1 * cb - 2.f * sh * sh, ni = ea * sb;
        const float den = lr * lr + li * li;
        const float qr = (nr * lr + ni * li) / den, qi = (ni * lr - nr * li) / den;
        f32x2* BB = (f32x2*)(p.ws + T_BBAR);
#pragma unroll
        for (int s = 0; s < 16; ++s) { const float br = p.in[16][e * 16 + s], bi = p.in[17][e * 16 + s]; BB[e * 16 + s] = (f32x2){qr * br - qi * bi, qr * bi + qi * br}; }
        f32x2* POW = (f32x2*)(p.ws + H_POW) + (size_t)dg * 33 * 64 + (e & 63);
        float pr = 1.f, pi = 0.f;
        for (int q = 0; q <= 32; ++q) { POW[q * 64] = (f32x2){pr, pi}; const float nr2 = pr * lbr - pi * lbi, ni2 = pr * lbi + pi * lbr; pr = nr2; pi = ni2; }
    }
}

DI void modulate_rows(const Params& p, int layer, int which, bool from_inputs, int r0) {
    const int tid_ = get_tid(); const int lane = tid_ & 63, wid = tid_ >> 6;
    const float* gain = p.in[which ? 7 : 6] + layer * 1024;
    const float* modl = (const float*)(p.ws + T_MOD) + layer * 3 * 6144 + (which ? 3072 : 0);
    const float* H = (const float*)(p.ws + OFF_H);
    bf16_t* dst = (bf16_t*)(p.ws + OFF_A0);
    const int stride = gridDim.x * NWV;
    for (int ra = r0 + blockIdx.x * NWV + wid; ra < NR; ra += 2 * stride) {
        const int rb = ra + stride; const bool hb = rb < NR; const int rbb = hb ? rb : ra;
        const float* srca = from_inputs ? (ra < NCTX ? p.in[2] + (size_t)ra * 1024 : p.in[0] + (size_t)(ra - NCTX) * 1024) : H + (size_t)ra * 1024;
        const float* srcb = from_inputs ? (rbb < NCTX ? p.in[2] + (size_t)rbb * 1024 : p.in[0] + (size_t)(rbb - NCTX) * 1024) : H + (size_t)rbb * 1024;
        f32x4 xa[4], xb[4]; float sa = 0.f, sb = 0.f;
#pragma unroll
        for (int i = 0; i < 4; ++i) { xa[i] = *(const f32x4*)(srca + i * 256 + lane * 4); xb[i] = *(const f32x4*)(srcb + i * 256 + lane * 4); }
#pragma unroll
        for (int i = 0; i < 4; ++i) { sa += xa[i][0] * xa[i][0] + xa[i][1] * xa[i][1] + xa[i][2] * xa[i][2] + xa[i][3] * xa[i][3];
                                      sb += xb[i][0] * xb[i][0] + xb[i][1] * xb[i][1] + xb[i][2] * xb[i][2] + xb[i][3] * xb[i][3]; }
        sa = wave_sum(sa); sb = wave_sum(sb);
        const float rsa = rsqrtf(sa * (1.f / 1024.f) + 1e-6f), rsb = rsqrtf(sb * (1.f / 1024.f) + 1e-6f);
        const float* mva = modl + row_vec(ra) * 6144; const float* mvb = modl + row_vec(rbb) * 6144;
#pragma unroll
        for (int i = 0; i < 4; ++i) { const int c = i * 256 + lane * 4;
            const f32x4 g = *(const f32x4*)(gain + c);
            { const f32x4 sh = *(const f32x4*)(mva + c), sc = *(const f32x4*)(mva + 1024 + c); const f32x4 y = xa[i] * rsa * g * (1.f + sc) + sh;
              *(u32x2*)(dst + (size_t)ra * 1024 + c) = (u32x2){pk2(y[0], y[1]), pk2(y[2], y[3])}; }
            if (hb) { const f32x4 sh = *(const f32x4*)(mvb + c), sc = *(const f32x4*)(mvb + 1024 + c); const f32x4 y = xb[i] * rsb * g * (1.f + sc) + sh;
              *(u32x2*)(dst + (size_t)rb * 1024 + c) = (u32x2){pk2(y[0], y[1]), pk2(y[2], y[3])}; } }
    }
}

template <class Epi>
DI void gemm_phase(char* lds, const bf16_t* A0_, int lda, const bf16_t* Bt0_, int K, int mt0, int nmt, int nnt, const Epi& epi, int nbatch = 1, size_t sA = 0, size_t sB = 0, int ksplit = 1) {
    const int tid = get_tid(), lane = tid & 63, wid = tid >> 6, wr = wid >> 2, wc = wid & 3, fr = lane & 15, fq = lane >> 4;
    const int nk = (K >> 6) / ksplit;
    const int lrow = tid >> 3, lc = tid & 7, lkc = lc * 8;
    const int woff = lrow * 128 + ((lc ^ ((lrow >> 1) & 7)) << 4);
    const int ra0 = (wr * 128 + fr) * 128 + ((fq ^ (fr >> 1)) << 4);
    const int ra1 = (wr * 128 + fr) * 128 + (((4 + fq) ^ (fr >> 1)) << 4);
    const int rb0 = 32768 + (wc * 64 + fr) * 128 + ((fq ^ (fr >> 1)) << 4);
    const int rb1 = 32768 + (wc * 64 + fr) * 128 + (((4 + fq) ^ (fr >> 1)) << 4);
    const int per = nmt * nnt, ntile = nbatch * per * ksplit;
    const int myn = ((int)blockIdx.x < ntile) ? (ntile - (int)blockIdx.x + (int)gridDim.x - 1) / (int)gridDim.x : 0;
    const int total = myn * nk;
    f32x4 acc[8][4];
#pragma unroll
    for (int m = 0; m < 8; ++m)
#pragma unroll
        for (int n = 0; n < 4; ++n) acc[m][n] = (f32x4){0.f, 0.f, 0.f, 0.f};
    u32x4 sa[4], sb[4];
    int iti = 0, ikt = 0;
    const bf16_t* Ag = A0_; const bf16_t* Bg = Bt0_;
#define G_ISSUE() do { if (ikt == 0) { const int u_ = blockIdx.x + iti * gridDim.x; const int t_ = u_ / ksplit, sl_ = u_ - t_ * ksplit; const int gb_ = t_ / per, tr_ = t_ - gb_ * per; const int tm_ = tr_ / nnt, tn_ = tr_ - tm_ * nnt; \
            Ag = A0_ + (size_t)gb_ * sA + (size_t)((mt0 + tm_) * 256 + lrow) * lda + lkc + sl_ * nk * 64; Bg = Bt0_ + (size_t)gb_ * sB + (size_t)(tn_ * 256 + lrow) * K + lkc + sl_ * nk * 64; } \
        _Pragma("unroll") for (int i = 0; i < 4; ++i) { sa[i] = *(const u32x4*)(Ag + (size_t)i * 64 * lda + ikt * 64); sb[i] = *(const u32x4*)(Bg + (size_t)i * 64 * K + ikt * 64); } \
        if (++ikt == nk) { ikt = 0; ++iti; } } while (0)
#define G_WRITE(bufoff) do { _Pragma("unroll") for (int i = 0; i < 4; ++i) { *(u32x4*)(lds + (bufoff) + woff + i * 8192) = sa[i]; *(u32x4*)(lds + (bufoff) + 32768 + woff + i * 8192) = sb[i]; } } while (0)
#define G_COMPUTE(bufoff) do { _Pragma("unroll") for (int ks = 0; ks < 2; ++ks) { bf16x8 a[8], b[4]; \
        _Pragma("unroll") for (int m = 0; m < 8; ++m) a[m] = *(const bf16x8*)(lds + (bufoff) + (ks ? ra1 : ra0) + m * 2048); \
        _Pragma("unroll") for (int n = 0; n < 4; ++n) b[n] = *(const bf16x8*)(lds + (bufoff) + (ks ? rb1 : rb0) + n * 2048); \
        _Pragma("unroll") for (int m = 0; m < 8; ++m) _Pragma("unroll") for (int n = 0; n < 4; ++n) acc[m][n] = __builtin_amdgcn_mfma_f32_16x16x32_bf16(b[n], a[m], acc[m][n], 0, 0, 0); } } while (0)
    __syncthreads();
    if (total > 0) {
        G_ISSUE(); G_WRITE(0);
        if (total > 1) G_ISSUE();
    }
    __syncthreads();
    int cti = 0, ckt = 0;
    for (int q = 0; q < total; ++q) {
        const int cur = (q & 1) * 65536;
        if (q + 1 < total) G_WRITE(cur ^ 65536);
        if (q + 2 < total) G_ISSUE();
        G_COMPUTE(cur);
        __syncthreads();
        if (++ckt == nk) {
            const int u_ = blockIdx.x + cti * gridDim.x; const int t_ = u_ / ksplit; const int gb_ = t_ / per, tr_ = t_ - gb_ * per; const int tm_ = tr_ / nnt, tn_ = tr_ - tm_ * nnt;
            epi(acc, (mt0 + tm_) * 256 + wr * 128 + fr, tn_ * 256 + wc * 64 + fq * 4, gb_);
#pragma unroll
            for (int m = 0; m < 8; ++m)
#pragma unroll
                for (int n = 0; n < 4; ++n) acc[m][n] = (f32x4){0.f, 0.f, 0.f, 0.f};
            ckt = 0; ++cti;
        }
    }
#undef G_ISSUE
#undef G_WRITE
#undef G_COMPUTE
}

template <int KSP>
DI void thin_gemm_ctx(char* lds, const bf16_t* A, int lda, const bf16_t* Bt, int K, const float* res, float* dst, const float* gate) {
    const int tid = get_tid(), lane = tid & 63, wid = tid >> 6, fr = lane & 15, fq = lane >> 4;
    float* part = (float*)lds;
    for (int t = blockIdx.x; t < 256; t += gridDim.x) {
        const int m0 = (t >> 5) * 64, n0 = (t & 31) * 32;
        f32x4 acc[4][2];
#pragma unroll
        for (int m = 0; m < 4; ++m) { acc[m][0] = (f32x4){0.f, 0.f, 0.f, 0.f}; acc[m][1] = (f32x4){0.f, 0.f, 0.f, 0.f}; }
        const bf16_t* Ap = A + (size_t)(m0 + fr) * lda + wid * (KSP * 32) + fq * 8;
        const bf16_t* Bp = Bt + (size_t)(n0 + fr) * K + wid * (KSP * 32) + fq * 8;
#pragma unroll
        for (int k = 0; k < KSP; ++k) {
            bf16x8 a[4], b[2];
#pragma unroll
            for (int m = 0; m < 4; ++m) a[m] = *(const bf16x8*)(Ap + (size_t)m * 16 * lda + k * 32);
#pragma unroll
            for (int n = 0; n < 2; ++n) b[n] = *(const bf16x8*)(Bp + (size_t)n * 16 * K + k * 32);
#pragma unroll
            for (int m = 0; m < 4; ++m)
#pragma unroll
                for (int n = 0; n < 2; ++n) acc[m][n] = __builtin_amdgcn_mfma_f32_16x16x32_bf16(b[n], a[m], acc[m][n], 0, 0, 0);
        }
        __syncthreads();
#pragma unroll
        for (int m = 0; m < 4; ++m)
#pragma unroll
            for (int n = 0; n < 2; ++n) *(f32x4*)(part + ((wid * 64 + m * 16 + fr) * 32 + n * 16 + fq * 4)) = acc[m][n];
        __syncthreads();
        { const int row = tid >> 3, c4 = (tid & 7) * 4; f32x4 sum = (f32x4){0.f, 0.f, 0.f, 0.f};
#pragma unroll
          for (int w = 0; w < 8; ++w) sum += *(const f32x4*)(part + ((w * 64 + row) * 32 + c4));
          const size_t off = (size_t)(m0 + row) * 1024 + n0 + c4;
          const f32x4 g = *(const f32x4*)(gate + 2 * 6144 + n0 + c4), x = *(const f32x4*)(res + off);
          *(f32x4*)(dst + off) = x + g * sum; }
    }
    __syncthreads();
}

struct EpiWin0 {
    bf16_t* UA; bf16_t* CQN; bf16_t* CKVN; float* SSP; float* KR;
    DI void operator()(const f32x4 (&acc)[8][4], int row0, int col0, int gb) const {
        const int cw = col0 & ~63;
#pragma unroll
        for (int m = 0; m < 8; ++m) { const int ri = row0 + m * 16; const size_t r = ri;
            if (cw < 512) { const int b = row_batch(ri), tp = row_tpos(ri);
#pragma unroll
                for (int n = 0; n < 4; ++n) { const int c = col0 + n * 16; const f32x4 v = acc[m][n]; const int g = c >> 4, s0 = c & 15;
                    *(u32x2*)(UA + ((size_t)g * CHR + b * NCK + (tp >> 5)) * 768 + (tp & 31) * 16 + s0) = (u32x2){pk2(v[0], v[1]), pk2(v[2], v[3])}; }
            } else if (cw < 1152) { const bool isq = cw < 896; bf16_t* dst = isq ? CQN + r * 384 + (col0 - 512) : CKVN + r * 256 + (col0 - 896);
                float ss = 0.f;
#pragma unroll
                for (int n = 0; n < 4; ++n) { const f32x4 v = acc[m][n]; ss += v[0] * v[0] + v[1] * v[1] + v[2] * v[2] + v[3] * v[3];
                    *(u32x2*)(dst + n * 16) = (u32x2){pk2(v[0], v[1]), pk2(v[2], v[3])}; }
                ss += __shfl_xor(ss, 16); ss += __shfl_xor(ss, 32);
                if ((col0 & 15) == 0) SSP[r * 10 + ((cw - 512) >> 6)] = ss;
            } else if (cw < 1216) {
#pragma unroll
                for (int n = 0; n < 4; ++n) *(f32x4*)(KR + r * 64 + (col0 - 1152) + n * 16) = acc[m][n];
            } }
    }
};
struct EpiS1a {
    float* E;
    DI void operator()(const f32x4 (&acc)[8][4], int row0, int col0, int gb) const {
#pragma unroll
        for (int m = 0; m < 8; ++m) { const int r = row0 + m * 16; if (r >= CHR) continue;
#pragma unroll
            for (int n = 0; n < 4; ++n) *(f32x4*)(E + ((size_t)gb * CHR + r) * 256 + col0 + n * 16) = acc[m][n]; }
    }
};
struct EpiS1b {
    bf16_t* YG;
    DI void operator()(const f32x4 (&acc)[8][4], int row0, int col0, int gb) const {
#pragma unroll
        for (int m = 0; m < 8; ++m) { const int r = row0 + m * 16; if (r >= CHR) continue; const int b = r / NCK, c = r % NCK;
#pragma unroll
            for (int n = 0; n < 4; ++n) { const int cc = col0 + n * 16; const int tl = cc >> 4, s0 = cc & 15; const f32x4 v = acc[m][n];
                const int tp = c * SL + tl; const size_t row = tp < CTX ? (size_t)b * CTX + tp : (size_t)NCTX + (size_t)b * SEQ + (tp - CTX);
                *(u32x2*)(YG + row * 512 + gb * 16 + s0) = (u32x2){pk2(gelu_tanh(v[0]), gelu_tanh(v[1])), pk2(gelu_tanh(v[2]), gelu_tanh(v[3]))}; } }
    }
};
struct EpiBf16 {
    bf16_t* O; int ldo; const float* SSP;
    DI void operator()(const f32x4 (&acc)[8][4], int row0, int col0, int gb) const {
#pragma unroll
        for (int m = 0; m < 8; ++m) { const size_t r = row0 + m * 16; const float* sp = SSP + r * 10;
            const float rstd = rsqrtf(((sp[0] + sp[1]) + (sp[2] + sp[3]) + (sp[4] + sp[5])) * (1.f / 384.f) + 1e-6f);
#pragma unroll
            for (int n = 0; n < 4; ++n) { const int c = col0 + n * 16; const f32x4 v = acc[m][n] * rstd;
                *(u32x2*)(O + r * ldo + c) = (u32x2){pk2(v[0], v[1]), pk2(v[2], v[3])}; } }
    }
};
struct EpiKV {
    bf16_t* KNOPE; bf16_t* VT; const float* SSP;
    DI void operator()(const f32x4 (&acc)[8][4], int row0, int col0, int gb) const {
#pragma unroll
        for (int m = 0; m < 8; ++m) { const int r = row0 + m * 16; const int b = row_batch(r), tp = row_tpos(r); const float* sp = SSP + (size_t)r * 10 + 6;
            const float rstd = rsqrtf(((sp[0] + sp[1]) + (sp[2] + sp[3])) * (1.f / 256.f) + 1e-6f);
#pragma unroll
            for (int n = 0; n < 4; ++n) { const int c = col0 + n * 16; const int h = c >> 8, w = c & 255; const f32x4 v = acc[m][n] * rstd;
                if (w < 128) *(u32x2*)(KNOPE + (size_t)r * 512 + h * 128 + w) = (u32x2){pk2(v[0], v[1]), pk2(v[2], v[3])};
                else { bf16_t* d = VT + ((size_t)(b * 4 + h) * 128 + (w - 128)) * TK + tp; const unsigned p0 = pk2(v[0], v[1]), p1 = pk2(v[2], v[3]);
                    d[0] = (bf16_t)(p0 & 0xffff); d[TK] = (bf16_t)(p0 >> 16); d[2 * TK] = (bf16_t)(p1 & 0xffff); d[3 * TK] = (bf16_t)(p1 >> 16); } } }
    }
};
struct EpiGLU {
    const bf16_t* YG; const float* bias; bf16_t* CAT;
    DI void operator()(const f32x4 (&acc)[8][4], int row0, int col0, int gb) const {
#pragma unroll
        for (int m = 0; m < 8; ++m) { const size_t r = row0 + m * 16;
#pragma unroll
            for (int n = 0; n < 4; ++n) { const int c = col0 + n * 16; const f32x4 v = acc[m][n]; const f32x4 bv = *(const f32x4*)(bias + c);
                const u32x2 yy = *(const u32x2*)(YG + r * 512 + c);
                const float y0 = __uint_as_float(yy[0] << 16), y1 = __uint_as_float(yy[0] & 0xffff0000u), y2 = __uint_as_float(yy[1] << 16), y3 = __uint_as_float(yy[1] & 0xffff0000u);
                const float o0 = y0 * sigmoidf_(v[0] + bv[0]), o1 = y1 * sigmoidf_(v[1] + bv[1]), o2 = y2 * sigmoidf_(v[2] + bv[2]), o3 = y3 * sigmoidf_(v[3] + bv[3]);
                *(u32x2*)(CAT + r * 1024 + c) = (u32x2){pk2(o0, o1), pk2(o2, o3)}; } }
    }
};
struct EpiRes {
    const float* res_ctx; const float* res_lat; float* dst_ctx; float* dst_lat; const float* gate; int atomic;
    DI void operator()(const f32x4 (&acc)[8][4], int row0, int col0, int gb) const {
#pragma unroll
        for (int m = 0; m < 8; ++m) { const int r = row0 + m * 16;
            const float* rs = r < NCTX ? res_ctx + (size_t)r * 1024 : res_lat + (size_t)(r - NCTX) * 1024;
            float* ds = r < NCTX ? dst_ctx + (size_t)r * 1024 : dst_lat + (size_t)(r - NCTX) * 1024;
            if (r < NCTX && dst_ctx == nullptr) continue;
            const float* gv = gate + row_vec(r) * 6144;
#pragma unroll
            for (int n = 0; n < 4; ++n) { const int c = col0 + n * 16; const f32x4 g = *(const f32x4*)(gv + c);
                if (atomic) { const f32x4 v = g * acc[m][n];
#pragma unroll
                    for (int j = 0; j < 4; ++j) (void)__hip_atomic_fetch_add(ds + c + j, v[j], __ATOMIC_RELAXED, __HIP_MEMORY_SCOPE_AGENT); }
                else { const f32x4 x = *(const f32x4*)(rs + c); *(f32x4*)(ds + c) = x + g * acc[m][n]; } } }
    }
};
struct EpiSwiGLU {
    bf16_t* HID;
    DI void operator()(const f32x4 (&acc)[8][4], int row0, int col0, int gb) const {
        const int hc = (col0 >> 6) * 32 + (col0 & 15);
#pragma unroll
        for (int m = 0; m < 8; ++m) { const size_t r = row0 + m * 16;
#pragma unroll
            for (int q = 0; q < 2; ++q) { const f32x4 g = acc[m][2 * q], u = acc[m][2 * q + 1];
                const float o0 = siluf_(g[0]) * u[0], o1 = siluf_(g[1]) * u[1], o2 = siluf_(g[2]) * u[2], o3 = siluf_(g[3]) * u[3];
                *(u32x2*)(HID + r * FH + hc + q * 16) = (u32x2){pk2(o0, o1), pk2(o2, o3)}; } }
    }
};
struct EpiWin1 {
    bf16_t* Q; bf16_t* K1; bf16_t* VT; const float* qn; const float* kn; const float* ROPE;
    DI void operator()(const f32x4 (&acc)[8][4], int row0, int col0, int gb) const {
        const int cw = col0 & ~63, i0 = col0 & 15;
        if (cw >= 1280) {
#pragma unroll
            for (int m = 0; m < 8; ++m) { const int r = row0 + m * 16; const int b = row_batch(r), tp = row_tpos(r);
#pragma unroll
                for (int n = 0; n < 4; ++n) { const int cc = col0 + n * 16 - 1280, h = cc >> 6, d0 = cc & 63; const f32x4 v = acc[m][n];
                    bf16_t* d = VT + ((size_t)(b * 4 + h) * 64 + d0) * TK + tp; const unsigned p0 = pk2(v[0], v[1]), p1 = pk2(v[2], v[3]);
                    d[0] = (bf16_t)(p0 & 0xffff); d[TK] = (bf16_t)(p0 >> 16); d[2 * TK] = (bf16_t)(p1 & 0xffff); d[3 * TK] = (bf16_t)(p1 >> 16); } }
            return;
        }
        const bool isq = cw < 1024;
        const float* gn = isq ? qn : kn;
        f32x4 g[4];
#pragma unroll
        for (int n = 0; n < 4; ++n) g[n] = *(const f32x4*)(gn + n * 16 + i0);
        const float osc = isq ? 0.125f * LOG2E : 1.f;
#pragma unroll
        for (int m = 0; m < 8; ++m) { const int r = row0 + m * 16; const bool lat = r >= NCTX;
            if (isq && !lat) continue;
            const int b = row_batch(r), tp = row_tpos(r), t = tp - CTX;
            float ss = 0.f;
#pragma unroll
            for (int n = 0; n < 4; ++n) { const f32x4 v = acc[m][n]; ss += v[0] * v[0] + v[1] * v[1] + v[2] * v[2] + v[3] * v[3]; }
            ss += __shfl_xor(ss, 16); ss += __shfl_xor(ss, 32);
            const float rstd = rsqrtf(ss * (1.f / 64.f) + 1e-6f);
            f32x4 y[4];
#pragma unroll
            for (int n = 0; n < 4; ++n) y[n] = acc[m][n] * rstd * g[n];
            if (lat) { const float* rr = ROPE + ((t >> 6) * 16 + i0) * 2; const float* rc = ROPE + ((t & 63) * 16 + i0) * 2;
#pragma unroll
                for (int j = 0; j < 4; ++j) { const float c0 = rr[2 * j], s0 = rr[2 * j + 1], c1 = rc[2 * j], s1 = rc[2 * j + 1];
                    const float a0 = y[0][j], a1 = y[1][j], a2 = y[2][j], a3 = y[3][j];
                    y[0][j] = a0 * c0 - a1 * s0; y[1][j] = a1 * c0 + a0 * s0; y[2][j] = a2 * c1 - a3 * s1; y[3][j] = a3 * c1 + a2 * s1; } }
            bf16_t* dst = isq ? Q + (size_t)r * 1024 + cw + i0 : K1 + ((size_t)(b * 4 + ((cw - 1024) >> 6)) * TK + tp) * 64 + i0;
#pragma unroll
            for (int n = 0; n < 4; ++n) *(u32x2*)(dst + n * 16) = (u32x2){pk2(y[n][0] * osc, y[n][1] * osc), pk2(y[n][2] * osc, y[n][3] * osc)};
        }
    }
};

template <int DQK, int DV, bool WIN>
DI void attn_item(char* lds, const bf16_t* Q, int qstride, const bf16_t* Kb, const bf16_t* VTb, int ta0, int ta1, int tb0, int tb1,
                  float mref, float l_init, bf16_t* O, int ostride, int qpos0) {
    constexpr int NKS = DQK / 16, NDT = DV / 32, KSTR = DQK + 8, VSTR = 72, NG = NKS;
    constexpr int KCH = 64 * DQK / 8 / NTHREADS, VCH = DV * 8 / NTHREADS;
    constexpr int KBUF = 64 * KSTR, VBUF = DV * VSTR;
    bf16_t* Ks = (bf16_t*)lds; bf16_t* Vs = Ks + 2 * KBUF;
    const int tid = get_tid(), lane = tid & 63, wid = tid >> 6, r = lane & 31, h2 = lane >> 5;
    bf16x8 qf[NKS];
    { const bf16_t* qrow = Q + (size_t)(wid * 32 + r) * qstride + 8 * h2;
#pragma unroll
      for (int ks = 0; ks < NKS; ++ks) qf[ks] = *(const bf16x8*)(qrow + 16 * ks); }
    f32x16 o[NDT];
#pragma unroll
    for (int dt = 0; dt < NDT; ++dt)
#pragma unroll
        for (int i = 0; i < 16; ++i) o[dt][i] = 0.f;
    float lrun = (h2 == 0) ? l_init : 0.f;
    const int na = ta1 - ta0, ntot = na + (tb1 - tb0);
    u32x4 kr[KCH], vr[VCH];
    constexpr int KTPR = (DQK / 8) / KCH, VTPR = 8 / VCH;
    const int krow = tid / KTPR, kcol = (tid % KTPR) * (KCH * 8);
    const int vrow = tid / VTPR, vcol = (tid % VTPR) * (VCH * 8);
    const bf16_t* kgp = Kb + (size_t)krow * DQK + kcol;
    const bf16_t* vgp = VTb + (size_t)vrow * TK + vcol;
    bf16_t* ksp = Ks + krow * KSTR + kcol;
    bf16_t* vsp = Vs + vrow * VSTR + vcol;
    const bf16_t* kfp = Ks + r * KSTR + 8 * h2;
    const bf16_t* vfp = Vs + r * VSTR + 8 * h2;
#define A_TILE(itv) (((itv) < na) ? ta0 + (itv) : tb0 + ((itv) - na))
#define K_LOAD(itv) do { const bf16_t* kg = kgp + (size_t)A_TILE(itv) * 64 * DQK; _Pragma("unroll") for (int i = 0; i < KCH; ++i) kr[i] = *(const u32x4*)(kg + i * 8); } while (0)
#define V_LOADG(itv) do { const bf16_t* vg = vgp + A_TILE(itv) * 64; _Pragma("unroll") for (int i = 0; i < VCH; ++i) vr[i] = *(const u32x4*)(vg + i * 8); } while (0)
#define K_WRITE(bo) do { _Pragma("unroll") for (int i = 0; i < KCH; ++i) *(u32x4*)(ksp + (bo) + i * 8) = kr[i]; } while (0)
#define V_WRITE(bo) do { _Pragma("unroll") for (int i = 0; i < VCH; ++i) { const int c_ = (vcol >> 3) + i; bf16_t* d_ = vsp - vcol + (bo) + (c_ >> 1) * 16 + (c_ & 1) * 4; \
            *(u32x2*)d_ = (u32x2){vr[i][0], vr[i][1]}; *(u32x2*)(d_ + 8) = (u32x2){vr[i][2], vr[i][3]}; } } while (0)
#define T_ACTIVE(itv) (!(WIN && A_TILE(itv) >= 4 && ((A_TILE(itv) - 4) * 64 > qpos0 + wid * 32 + 31 + 128 || (A_TILE(itv) - 4) * 64 + 63 < qpos0 + wid * 32 - 128)))
#define S_MASK(S0, S1, itv) do { if (WIN && A_TILE(itv) >= 4) { const int qp = qpos0 + wid * 32 + r, kp0 = (A_TILE(itv) - 4) * 64 + 4 * h2; \
        _Pragma("unroll") for (int i = 0; i < 16; ++i) { const int d0 = kp0 + (i & 3) + 8 * (i >> 2) - qp, d1 = d0 + 32; \
            if (d0 > 128 || d0 < -128) S0[i] = -1e30f; if (d1 > 128 || d1 < -128) S1[i] = -1e30f; } } } while (0)
    f32x16 s0, s1;
    __syncthreads();
    K_LOAD(0); K_WRITE(0);
    if (1 < ntot) K_LOAD(1);
    V_LOADG(0);
    __syncthreads();
#pragma unroll
    for (int i = 0; i < 16; ++i) { s0[i] = -mref; s1[i] = -mref; }
#pragma unroll 1
    for (int it = -1; it < ntot; ++it) {
        const int kb_n = ((it + 1) & 1) * KBUF, vb_c = (it & 1) * VBUF;
        if (it + 2 < ntot) K_WRITE((it & 1) * KBUF);
        if (it + 1 < ntot) V_WRITE(((it + 1) & 1) * VBUF);
        __builtin_amdgcn_sched_barrier(0);
        const bool act_c = (it >= 0) && T_ACTIVE(it), act_n = (it + 1 < ntot) && T_ACTIVE(it + 1);
        f32x16 n0, n1;
#pragma unroll
        for (int i = 0; i < 16; ++i) { n0[i] = -mref; n1[i] = -mref; }
        float rs = 0.f;
        unsigned pk[16];
#define P_PAIR(j) do { const float e0_ = __builtin_amdgcn_exp2f((j) < 8 ? s0[2 * ((j) & 7)] : s1[2 * ((j) & 7)]), e1_ = __builtin_amdgcn_exp2f((j) < 8 ? s0[2 * ((j) & 7) + 1] : s1[2 * ((j) & 7) + 1]); rs += e0_ + e1_; pk[j] = pk2(e0_, e1_); } while (0)
        if (act_c && act_n) {
#pragma unroll
            for (int g = 0; g < NG; ++g) {
                const bf16x8 ka = *(const bf16x8*)(kfp + kb_n + 16 * g), kb = *(const bf16x8*)(kfp + kb_n + 32 * KSTR + 16 * g);
                n0 = __builtin_amdgcn_mfma_f32_32x32x16_bf16(ka, qf[g], n0, 0, 0, 0);
                n1 = __builtin_amdgcn_mfma_f32_32x32x16_bf16(kb, qf[g], n1, 0, 0, 0);
#pragma unroll
                for (int j = (16 * g) / NG; j < (16 * (g + 1)) / NG; ++j) P_PAIR(j);
            }
            S_MASK(n0, n1, it + 1);
        } else {
            if (act_n) {
#pragma unroll
                for (int ks = 0; ks < NKS; ++ks) { const bf16x8 k0 = *(const bf16x8*)(kfp + kb_n + 16 * ks), k1 = *(const bf16x8*)(kfp + kb_n + 32 * KSTR + 16 * ks);
                    n0 = __builtin_amdgcn_mfma_f32_32x32x16_bf16(k0, qf[ks], n0, 0, 0, 0); n1 = __builtin_amdgcn_mfma_f32_32x32x16_bf16(k1, qf[ks], n1, 0, 0, 0); }
                S_MASK(n0, n1, it + 1);
            }
            if (act_c) {
#pragma unroll
                for (int j = 0; j < 16; ++j) P_PAIR(j);
            }
        }
#undef P_PAIR
        __builtin_amdgcn_sched_barrier(0);
        if (it + 3 < ntot) K_LOAD(it + 3);
        if (it + 2 < ntot) V_LOADG(it + 2);
        __builtin_amdgcn_sched_barrier(0);
        if (act_c) {
            lrun += rs;
#pragma unroll
            for (int q = 0; q < 4; ++q) {
                const u32x4 pw = {pk[4 * q], pk[4 * q + 1], pk[4 * q + 2], pk[4 * q + 3]};
                const bf16x8 pf = __builtin_bit_cast(bf16x8, pw);
#pragma unroll
                for (int dt = 0; dt < NDT; ++dt) { const bf16x8 vf = *(const bf16x8*)(vfp + vb_c + (32 * dt) * VSTR + 16 * q);
                    o[dt] = __builtin_amdgcn_mfma_f32_32x32x16_bf16(vf, pf, o[dt], 0, 0, 0); }
            }
        }
        s0 = n0; s1 = n1;
        __syncthreads();
    }
#undef A_TILE
#undef K_LOAD
#undef V_LOADG
#undef K_WRITE
#undef V_WRITE
#undef T_ACTIVE
#undef S_MASK
    lrun += __shfl_xor(lrun, 32);
    const float inv = 1.f / lrun;
    bf16_t* orow = O + (size_t)(wid * 32 + r) * ostride;
#pragma unroll
    for (int dt = 0; dt < NDT; ++dt)
#pragma unroll
        for (int g = 0; g < 4; ++g)
            *(u32x2*)(orow + 32 * dt + 8 * g + 4 * h2) = (u32x2){pk2(o[dt][4 * g] * inv, o[dt][4 * g + 1] * inv), pk2(o[dt][4 * g + 2] * inv, o[dt][4 * g + 3] * inv)};
    __syncthreads();
}

template <int NH>
DI void win_attn_item(char* lds, const bf16_t* Q, const bf16_t* Kb, const bf16_t* VTb, int tb0, int tb1, float mref, const float* sinkp, bf16_t* O, int qpos0) {
    constexpr int KSTR = 72, VSTR = 72, KBUF = 64 * KSTR, VBUF = 64 * VSTR;
    bf16_t* Ks = (bf16_t*)lds; bf16_t* Vs = Ks + 2 * KBUF;
    const int tid = get_tid(), lane = tid & 63, wid = tid >> 6, r = lane & 31, h2 = lane >> 5;
    bf16x8 qf[NH][4];
#pragma unroll
    for (int h = 0; h < NH; ++h) { const bf16_t* qrow = Q + (size_t)(wid * 32 + r) * 1024 + h * 64 + 8 * h2;
#pragma unroll
        for (int ks = 0; ks < 4; ++ks) qf[h][ks] = *(const bf16x8*)(qrow + 16 * ks); }
    f32x16 o[NH][2]; float lrun[NH];
#pragma unroll
    for (int h = 0; h < NH; ++h) { lrun[h] = (h2 == 0) ? __builtin_amdgcn_exp2f(sinkp[h] * LOG2E - mref) : 0.f;
#pragma unroll
        for (int dt = 0; dt < 2; ++dt)
#pragma unroll
            for (int i = 0; i < 16; ++i) o[h][dt][i] = 0.f; }
    const int na = 4, ntot = na + (tb1 - tb0);
    u32x4 kr, vr;
    const int krow = tid >> 3, kcol = (tid & 7) * 8;
    const bf16_t* kgp = Kb + (size_t)krow * 64 + kcol;
    const bf16_t* vgp = VTb + (size_t)krow * TK + kcol;
    bf16_t* ksp = Ks + krow * KSTR + kcol;
    bf16_t* vsp = Vs + krow * VSTR + (kcol >> 4) * 16 + ((kcol >> 3) & 1) * 4;
    const bf16_t* kfp = Ks + r * KSTR + 8 * h2;
    const bf16_t* vfp = Vs + r * VSTR + 8 * h2;
#define W_TILE(itv) (((itv) < na) ? (itv) : tb0 + ((itv) - na))
#define W_LOAD(itv) do { kr = *(const u32x4*)(kgp + (size_t)W_TILE(itv) * 64 * 64); vr = *(const u32x4*)(vgp + W_TILE(itv) * 64); } while (0)
#define W_WRITE(kb_, vb_) do { *(u32x4*)(ksp + (kb_)) = kr; *(u32x2*)(vsp + (vb_)) = (u32x2){vr[0], vr[1]}; *(u32x2*)(vsp + (vb_) + 8) = (u32x2){vr[2], vr[3]}; } while (0)
    __syncthreads();
    W_LOAD(0); W_WRITE(0, 0);
    if (1 < ntot) W_LOAD(1);
    __syncthreads();
#pragma unroll 1
    for (int it = 0; it < ntot; ++it) {
        const int T = W_TILE(it);
        const int kb = (it & 1) * KBUF, vb = (it & 1) * VBUF;
        if (it + 1 < ntot) W_WRITE(KBUF - kb, VBUF - vb);
        if (it + 2 < ntot) W_LOAD(it + 2);
        bool active = true, need_mask = false;
        if (T >= 4) { const int klo = (T - 4) * 64, qlo = qpos0 + wid * 32;
            active = !(klo > qlo + 31 + 128 || klo + 63 < qlo - 128);
            need_mask = (klo < qlo + 31 - 128) || (klo + 63 > qlo + 128); }
        if (active) {
#pragma unroll
            for (int h = 0; h < NH; ++h) {
                __builtin_amdgcn_sched_barrier(0);
                f32x16 s0, s1;
#pragma unroll
                for (int i = 0; i < 16; ++i) { s0[i] = -mref; s1[i] = -mref; }
#pragma unroll
                for (int ks = 0; ks < 4; ++ks) { const bf16x8 k0 = *(const bf16x8*)(kfp + kb + 16 * ks), k1 = *(const bf16x8*)(kfp + kb + 32 * KSTR + 16 * ks);
                    s0 = __builtin_amdgcn_mfma_f32_32x32x16_bf16(k0, qf[h][ks], s0, 0, 0, 0); s1 = __builtin_amdgcn_mfma_f32_32x32x16_bf16(k1, qf[h][ks], s1, 0, 0, 0); }
                if (need_mask) { const int qp = qpos0 + wid * 32 + r, kp0 = (T - 4) * 64 + 4 * h2;
#pragma unroll
                    for (int i = 0; i < 16; ++i) { const int d0 = kp0 + (i & 3) + 8 * (i >> 2) - qp, d1 = d0 + 32;
                        if (d0 > 128 || d0 < -128) s0[i] = -1e30f; if (d1 > 128 || d1 < -128) s1[i] = -1e30f; } }
                float rs = 0.f; unsigned pk[16];
#pragma unroll
                for (int j = 0; j < 8; ++j) { const float a0 = __builtin_amdgcn_exp2f(s0[2 * j]), a1 = __builtin_amdgcn_exp2f(s0[2 * j + 1]), b0 = __builtin_amdgcn_exp2f(s1[2 * j]), b1 = __builtin_amdgcn_exp2f(s1[2 * j + 1]);
                    rs += (a0 + a1) + (b0 + b1); pk[j] = pk2(a0, a1); pk[8 + j] = pk2(b0, b1); }
                lrun[h] += rs;
                __builtin_amdgcn_sched_barrier(0);
#pragma unroll
                for (int q = 0; q < 4; ++q) { const u32x4 pw = {pk[4 * q], pk[4 * q + 1], pk[4 * q + 2], pk[4 * q + 3]}; const bf16x8 pf = __builtin_bit_cast(bf16x8, pw);
#pragma unroll
                    for (int dt = 0; dt < 2; ++dt) { const bf16x8 vf = *(const bf16x8*)(vfp + vb + (32 * dt) * VSTR + 16 * q);
                        o[h][dt] = __builtin_amdgcn_mfma_f32_32x32x16_bf16(vf, pf, o[h][dt], 0, 0, 0); } }
            }
        }
        __syncthreads();
    }
#undef W_TILE
#undef W_LOAD
#undef W_WRITE
#pragma unroll
    for (int h = 0; h < NH; ++h) { float l = lrun[h]; l += __shfl_xor(l, 32); const float inv = 1.f / l;
        bf16_t* orow = O + (size_t)(wid * 32 + r) * 1024 + h * 64;
#pragma unroll
        for (int dt = 0; dt < 2; ++dt)
#pragma unroll
            for (int g = 0; g < 4; ++g)
                *(u32x2*)(orow + 32 * dt + 8 * g + 4 * h2) = (u32x2){pk2(o[h][dt][4 * g] * inv, o[h][dt][4 * g + 1] * inv), pk2(o[h][dt][4 * g + 2] * inv, o[h][dt][4 * g + 3] * inv)}; }
    __syncthreads();
}

DI void s5_kk_phase(char* lds, const Params& p) {
    const int tid512 = get_tid(); const int tid = tid512 & 255, s = tid >> 4, sp = tid & 15, dh = tid512 >> 8;
    f32x2* sbb = (f32x2*)lds;
    f32x2* scc = sbb + 1024;
    f32x2* spw = scc + 1024;
    const f32x2* POW = (const f32x2*)(p.ws + H_POW); const f32x2* BB = (const f32x2*)(p.ws + T_BBAR); float* KK = (float*)(p.ws + H_KK);
    for (int it = blockIdx.x; it < 32 * 2 * 4; it += gridDim.x) {
        const int dq = it & 3, dir = (it >> 2) & 1, g = it >> 3; const int dg = dir * 32 + g;
        __syncthreads();
        for (int i = tid512; i < 1024; i += NTHREADS) { sbb[i] = BB[(size_t)dg * 1024 + i]; scc[i] = (f32x2){p.in[18][(size_t)dg * 1024 + i], p.in[19][(size_t)dg * 1024 + i]}; }
        { const int i = tid512; spw[i] = POW[((size_t)dg * 33 + dq * 8 + (i >> 6)) * 64 + (i & 63)]; }
        __syncthreads();
        float acc[4] = {0.f, 0.f, 0.f, 0.f};
#pragma unroll 4
        for (int pp = 0; pp < 64; ++pp) { const f32x2 bb = sbb[pp * 16 + sp], cc = scc[s * 64 + pp];
#pragma unroll
            for (int q = 0; q < 4; ++q) { const f32x2 pw = spw[(dh * 4 + q) * 64 + pp];
                const float zr = pw[0] * bb[0] - pw[1] * bb[1], zi = pw[0] * bb[1] + pw[1] * bb[0];
                acc[q] += cc[0] * zr - cc[1] * zi; } }
#pragma unroll
        for (int q = 0; q < 4; ++q) KK[(size_t)((g * 2 + dir) * 32 + dq * 8 + dh * 4 + q) * 256 + tid] = acc[q];
    }
    __syncthreads();
}
DI void s5_w1a_phase(const Params& p) {
    const int tid = get_tid();
    const f32x2* POW = (const f32x2*)(p.ws + H_POW); const f32x2* BB = (const f32x2*)(p.ws + T_BBAR); bf16_t* W = (bf16_t*)(p.ws + H_W1A);
    for (int idx = blockIdx.x * NTHREADS + tid; idx < 2048 * 256; idx += gridDim.x * NTHREADS) {
        const int kq = idx & 63, n = (idx >> 6) & 255, g = idx >> 14;
        const int dir = n >> 7, ri = (n >> 6) & 1, pp = n & 63; const int e = (dir * 32 + g) * 64 + pp; const int tl = kq >> 1, s0 = (kq & 1) * 8;
        const f32x2 pw = POW[((size_t)(dir * 32 + g) * 33 + (dir ? tl : 31 - tl)) * 64 + pp];
        float v[8];
#pragma unroll
        for (int j = 0; j < 8; ++j) { const f32x2 bb = BB[e * 16 + s0 + j]; v[j] = ri ? pw[0] * bb[1] + pw[1] * bb[0] : pw[0] * bb[0] - pw[1] * bb[1]; }
        *(u32x4*)(W + ((size_t)g * 256 + n) * 512 + kq * 8) = (u32x4){pk2(v[0], v[1]), pk2(v[2], v[3]), pk2(v[4], v[5]), pk2(v[6], v[7])};
    }
}
DI void s5_w1b_phase(const Params& p) {
    const int tid = get_tid();
    const f32x2* POW = (const f32x2*)(p.ws + H_POW); const float* KK = (const float*)(p.ws + H_KK); bf16_t* W = (bf16_t*)(p.ws + A_W1B);
    for (int idx = blockIdx.x * NTHREADS + tid; idx < 6144 * 256; idx += gridDim.x * NTHREADS) {
        const int kq = idx % 96, n = (idx / 96) & 511, g = idx / (96 * 512);
        const int tl = n >> 4, s = n & 15;
        float v[8];
        if (kq < 64) { const int tl2 = kq >> 1, s0 = (kq & 1) * 8;
            f32x4 x0 = {0.f, 0.f, 0.f, 0.f}, x1 = x0;
            if (tl2 <= tl) { const float* k0 = KK + (size_t)((g * 2 + 0) * 32 + (tl - tl2)) * 256 + s * 16 + s0; x0 += *(const f32x4*)k0; x1 += *(const f32x4*)(k0 + 4); }
            if (tl2 >= tl) { const float* k1 = KK + (size_t)((g * 2 + 1) * 32 + (tl2 - tl)) * 256 + s * 16 + s0; x0 += *(const f32x4*)k1; x1 += *(const f32x4*)(k1 + 4); }
#pragma unroll
            for (int j = 0; j < 4; ++j) { v[j] = x0[j]; v[4 + j] = x1[j]; }
            if (tl2 == tl && (s >> 3) == (kq & 1)) { const float dv = p.in[20][g * 16 + s];
#pragma unroll
                for (int j = 0; j < 8; ++j) if (j == (s & 7)) v[j] += dv; }
        } else { const int k2 = (kq - 64) * 8; const int dir = k2 >> 7, ri = (k2 >> 6) & 1, p0 = k2 & 63;
            const float* cre = p.in[18] + ((size_t)(dir * 32 + g) * 16 + s) * 64 + p0; const float* cim = p.in[19] + ((size_t)(dir * 32 + g) * 16 + s) * 64 + p0;
            const f32x2* pwp = POW + ((size_t)(dir * 32 + g) * 33 + (dir ? 32 - tl : tl + 1)) * 64 + p0;
            const f32x4 cr0 = *(const f32x4*)cre, cr1 = *(const f32x4*)(cre + 4), ci0 = *(const f32x4*)cim, ci1 = *(const f32x4*)(cim + 4);
#pragma unroll
            for (int j = 0; j < 8; ++j) { const f32x2 pw = pwp[j];
                const float cr = j < 4 ? cr0[j & 3] : cr1[j & 3], ci = j < 4 ? ci0[j & 3] : ci1[j & 3];
                v[j] = ri ? -(cr * pw[1] + ci * pw[0]) : cr * pw[0] - ci * pw[1]; }
        }
        *(u32x4*)(W + ((size_t)g * 512 + n) * 768 + kq * 8) = (u32x4){pk2(v[0], v[1]), pk2(v[2], v[3]), pk2(v[4], v[5]), pk2(v[6], v[7])};
    }
}
DI void s5_carry_phase(const Params& p) {
    const int tid_ = get_tid(); const int lane = tid_ & 63, wid = tid_ >> 6;
    const f32x2* POW = (const f32x2*)(p.ws + H_POW); const float* E = (const float*)(p.ws + H_E); bf16_t* UA = (bf16_t*)(p.ws + H_UA);
    for (int it = ((int)gridDim.x - 1 - (int)blockIdx.x) * NWV + wid; it < 2 * 2 * 32; it += gridDim.x * NWV) {
        const int g = it & 31, dir = (it >> 5) & 1, b = it >> 6;
        const f32x2 l32 = POW[((size_t)(dir * 32 + g) * 33 + 32) * 64 + lane];
        float hr = 0.f, hi = 0.f;
        float er[8], ei[8], fr_[8], fi_[8];
#define C_IDX(i_) ((size_t)g * CHR + b * NCK + (dir ? ((i_) < 8 ? 7 - (i_) : NCK - 1 - ((i_) - 8)) : (i_)))
#define C_LOAD(R, I, i0_) do { _Pragma("unroll") for (int j = 0; j < 8; ++j) { const size_t m = C_IDX((i0_) + j); R[j] = E[m * 256 + dir * 128 + lane]; I[j] = E[m * 256 + dir * 128 + 64 + lane]; } } while (0)
#define C_STEP(R, I, i0_) do { _Pragma("unroll") for (int j = 0; j < 8; ++j) { const size_t m = C_IDX((i0_) + j); bf16_t* u = UA + m * 768 + 512 + dir * 128 + lane; \
            u[0] = (bf16_t)(pk2(hr, 0.f) & 0xffff); u[64] = (bf16_t)(pk2(hi, 0.f) & 0xffff); \
            const float nr = l32[0] * hr - l32[1] * hi + R[j], ni = l32[0] * hi + l32[1] * hr + I[j]; hr = nr; hi = ni; } } while (0)
        C_LOAD(er, ei, 0);
        for (int i0 = 0; i0 < NCK; i0 += 16) {
            if (i0 + 8 < NCK) C_LOAD(fr_, fi_, i0 + 8);
            C_STEP(er, ei, i0);
            if (i0 + 8 < NCK) { if (i0 + 16 < NCK) C_LOAD(er, ei, i0 + 16); C_STEP(fr_, fi_, i0 + 8); }
        }
#undef C_IDX
#undef C_LOAD
#undef C_STEP
    }
}

DI float rope64(float x, int lane, const float* ROPE, int rpos, int cpos) {
    const float partner = __shfl_xor(x, 16);
    const int i = lane & 15; const int pos = lane < 32 ? rpos : cpos;
    const float c = ROPE[(pos * 16 + i) * 2], s = ROPE[(pos * 16 + i) * 2 + 1];
    return (lane & 16) ? x * c + partner * s : x * c - partner * s;
}
DI void mla_prep_phase(const Params& p) {
    const int tid_ = get_tid(); const int lane = tid_ & 63, wid = tid_ >> 6;
    bf16_t* QR = (bf16_t*)(p.ws + S_QRAW); const bf16_t* KN = (const bf16_t*)(p.ws + S_KNOPE); const float* KR = (const float*)(p.ws + H_KR);
    bf16_t* KA = (bf16_t*)(p.ws + S_KA); const float* ROPE = (const float*)(p.ws + T_ROPE);
    const float qsc = 0.07216878364870323f * LOG2E;
    const float qg0 = p.in[27][lane], qg1 = p.in[27][64 + lane], qg2 = p.in[27][128 + lane];
    const float kg0 = p.in[28][lane], kg1 = p.in[28][64 + lane], kg2 = p.in[28][128 + lane];
    for (int r = blockIdx.x * NWV + wid; r < NR; r += gridDim.x * NWV) {
        const bool lat = r >= NCTX; const int b = row_batch(r), tp = row_tpos(r); const int t = tp - CTX;
        const bf16_t* q = QR + (size_t)r * 768; const bf16_t* kn = KN + (size_t)r * 512;
        float x[4][3], k[4][3];
        const float krv = KR[(size_t)r * 64 + lane];
#pragma unroll
        for (int h = 0; h < 4; ++h) { x[h][0] = bf2f(q[h * 192 + lane]); x[h][1] = bf2f(q[h * 192 + 64 + lane]); x[h][2] = bf2f(q[h * 192 + 128 + lane]);
            k[h][0] = bf2f(kn[h * 128 + lane]); k[h][1] = bf2f(kn[h * 128 + 64 + lane]); k[h][2] = krv; }
        float rc = 1.f, rsn = 0.f;
        if (lat) { const int pos = lane < 32 ? (t >> 6) : (t & 63); rc = ROPE[(pos * 16 + (lane & 15)) * 2]; rsn = ROPE[(pos * 16 + (lane & 15)) * 2 + 1]; }
        const float sgn = (lane & 16) ? 1.f : -1.f;
#pragma unroll
        for (int h = 0; h < 4; ++h) {
            float ss = wave_sum(x[h][0] * x[h][0] + x[h][1] * x[h][1] + x[h][2] * x[h][2]);
            float rs = rsqrtf(ss * (1.f / 192.f) + 1e-6f) * qsc;
            const float x0 = x[h][0] * rs * qg0, x1 = x[h][1] * rs * qg1; float x2 = x[h][2] * rs * qg2;
            x2 = x2 * rc + sgn * __shfl_xor(x2, 16) * rsn;
            bf16_t* qd = QR + (size_t)r * 768 + h * 192;
            qd[lane] = (bf16_t)(pk2(x0, 0.f) & 0xffff); qd[64 + lane] = (bf16_t)(pk2(x1, 0.f) & 0xffff); qd[128 + lane] = (bf16_t)(pk2(x2, 0.f) & 0xffff);
            ss = wave_sum(k[h][0] * k[h][0] + k[h][1] * k[h][1] + k[h][2] * k[h][2]);
            rs = rsqrtf(ss * (1.f / 192.f) + 1e-6f);
            const float k0 = k[h][0] * rs * kg0, k1 = k[h][1] * rs * kg1; float k2 = k[h][2] * rs * kg2;
            k2 = k2 * rc + sgn * __shfl_xor(k2, 16) * rsn;
            bf16_t* kd = KA + ((size_t)(b * 4 + h) * TK + tp) * 192;
            kd[lane] = (bf16_t)(pk2(k0, 0.f) & 0xffff); kd[64 + lane] = (bf16_t)(pk2(k1, 0.f) & 0xffff); kd[128 + lane] = (bf16_t)(pk2(k2, 0.f) & 0xffff);
        }
    }
}

__global__ void __launch_bounds__(NTHREADS, 2) fwd_kernel(Params p) {
    extern __shared__ __attribute__((aligned(16))) char lds[];
    cg::grid_group grid = cg::this_grid();
    char* ws = p.ws;
    const bf16_t* WB = (const bf16_t*)ws;
    const float* MOD = (const float*)(ws + T_MOD);
    float* H = (float*)(ws + OFF_H);
    bf16_t* A0 = (bf16_t*)(ws + OFF_A0);
    const int bid = blockIdx.x, nb = gridDim.x;
    volatile LAS unsigned* xst = (volatile LAS unsigned*)(lds + (LDS_BYTES - 16));
    if (threadIdx.x == 0) { xst[0] = 0u; xst[1] = 0u; }
    __syncthreads();
    const XcdBarrier xb = xcd_barrier_post((unsigned*)(ws + T_BAR), xst);
    if (p.pad == 0x7fffffff) grid.sync();
#define GRID_SYNC() xcd_barrier(xb)

    { const int npair = p.jobs[4].tile0 >> 1, nit = 192 + 12 + npair;
      for (int it = bid; it < nit; it += nb) {
          if (it < 192) ada_item(lds, p, it);
          else if (it < 204) tables_item(p, it - 192);
          else { const int lt0 = (it - 204) * 2 + (int)(threadIdx.x >> 8); const bool live = lt0 < p.jobs[4].tile0; const int lt = live ? lt0 : 0; int j = 0;
#pragma unroll
              for (int q = 1; q < 11; ++q) if (lt >= p.jobs[q].tile0) j = q;
              transpose_tile(lds, ws, p.jobs[j], lt - p.jobs[j].tile0, live); } } }
    GRID_SYNC();
    modulate_rows(p, 0, 0, true, 0);
    s5_kk_phase(lds, p);
    GRID_SYNC();
    { EpiWin0 e{(bf16_t*)(ws + H_UA), (bf16_t*)(ws + S_CQN), (bf16_t*)(ws + S_CKVN), (float*)(ws + S_SSP), (float*)(ws + H_KR)};
      gemm_phase(lds, A0, 1024, WB + W_IN0, 1024, 0, NR / 256, 5, e); }
    s5_w1a_phase(p);
    { int rk, nrk; slack_rank((NR / 256) * 5, rk, nrk); transpose_range(lds, ws, p, p.jobs[4].tile0, p.jobs[7].tile0, rk, nrk); }
    GRID_SYNC();
    s5_w1b_phase(p);
    { EpiS1a e{(float*)(ws + H_E)};
      gemm_phase(lds, (const bf16_t*)(ws + H_UA), 768, (const bf16_t*)(ws + H_W1A), 512, 0, 3, 1, e, 32, (size_t)CHR * 768, (size_t)256 * 512); }
    { int rk, nrk; slack_rank(96, rk, nrk); transpose_range(lds, ws, p, p.jobs[7].tile0, p.jobs[9].tile0, rk, nrk); }
    GRID_SYNC();
    s5_carry_phase(p);
    { EpiBf16 e{(bf16_t*)(ws + S_QRAW), 768, (const float*)(ws + S_SSP)};
      gemm_phase(lds, (const bf16_t*)(ws + S_CQN), 384, WB + W_QB, 384, 0, NR / 256, 3, e); }
    { EpiKV e{(bf16_t*)(ws + S_KNOPE), (bf16_t*)(ws + S_VT), (const float*)(ws + S_SSP)};
      gemm_phase(lds, (const bf16_t*)(ws + S_CKVN), 256, WB + W_KVB, 256, 0, NR / 256, 4, e); }
    GRID_SYNC();
    { EpiS1b e{(bf16_t*)(ws + S_YG)};
      gemm_phase(lds, (const bf16_t*)(ws + H_UA), 768, (const bf16_t*)(ws + A_W1B), 768, 0, 3, 2, e, 32, (size_t)CHR * 768, (size_t)512 * 768); }
    mla_prep_phase(p);
    GRID_SYNC();
    { const bf16_t* QR = (const bf16_t*)(ws + S_QRAW); const bf16_t* KA = (const bf16_t*)(ws + S_KA); const bf16_t* VT = (const bf16_t*)(ws + S_VT);
      const int nlat = 2 * 4 * 32, nall = nlat + 2 * 4;
      float mref; { float gq = 0.f, gk = 0.f;
        for (int d_ = 0; d_ < 192; ++d_) { gq = fmaxf(gq, fabsf(p.in[27][d_])); gk = fmaxf(gk, fabsf(p.in[28][d_])); }
        mref = 13.856406f * LOG2E * 1.02f * gq * gk; }
      for (int it0 = bid; it0 < nlat + nb; it0 += nb) {
          const int it = it0 < nlat ? it0 : nlat + (it0 - nlat) - (nb - 8);
          if (it0 >= nlat && (it < nlat || it >= nall)) continue;
          if (it < nlat) { const int h = it & 3, b = (it >> 2) & 1, qb = it >> 3;   const size_t row = NCTX + (size_t)b * SEQ + qb * 256;
              attn_item<192, 128, false>(lds, QR + row * 768 + h * 192, 768, KA + (size_t)(b * 4 + h) * TK * 192, VT + (size_t)(b * 4 + h) * 128 * TK, 0, TK / 64, 0, 0, mref, 0.f,
                                         A0 + row * 1024 + 512 + h * 128, 1024, 0); }
          else { const int j = it - nlat; const int h = j & 3, b = j >> 2; const size_t row = (size_t)b * CTX;
              attn_item<192, 128, false>(lds, QR + row * 768 + h * 192, 768, KA + (size_t)(b * 4 + h) * TK * 192, VT + (size_t)(b * 4 + h) * 128 * TK, 0, 4, 0, 0, mref, 0.f,
                                         A0 + row * 1024 + 512 + h * 128, 1024, 0); } }
      EpiGLU e{(const bf16_t*)(ws + S_YG), p.in[22], A0};
      gemm_phase(lds, (const bf16_t*)(ws + S_YG), 512, WB + W_GLU, 512, 0, NR / 256, 2, e); }
    GRID_SYNC();
    { EpiRes e{p.in[2], p.in[0], H, H + (size_t)NCTX * 1024, MOD + 0 * 3 * 6144 + 2048, 0};
      gemm_phase(lds, A0, 1024, WB + W_OUT0, 1024, 2, NLAT / 256, 4, e);
      thin_gemm_ctx<4>(lds, A0, 1024, WB + W_OUT0, 1024, p.in[2], H, MOD + 0 * 3 * 6144 + 2048); }
    GRID_SYNC();
    modulate_rows(p, 0, 1, false, 0);
    GRID_SYNC();
    { EpiSwiGLU e{(bf16_t*)(ws + S_HID)};
      gemm_phase(lds, A0, 1024, WB + W_GU0, 1024, 0, NR / 256, 22, e); }
    { int rk, nrk; slack_rank((NR / 256) * 22, rk, nrk); transpose_range(lds, ws, p, p.jobs[9].tile0, p.jobs[9].tile0 + 704, rk, nrk); }
    GRID_SYNC();
    { EpiRes e{H, H + (size_t)NCTX * 1024, H, H + (size_t)NCTX * 1024, MOD + 0 * 3 * 6144 + 5120, 0};
      gemm_phase(lds, (const bf16_t*)(ws + S_HID), FH, WB + W_D0, FH, 2, NLAT / 256, 4, e);
      thin_gemm_ctx<11>(lds, (const bf16_t*)(ws + S_HID), FH, WB + W_D0, FH, H, H, MOD + 0 * 3 * 6144 + 5120); }
    GRID_SYNC();
    modulate_rows(p, 1, 0, false, 0);
    GRID_SYNC();
    { EpiWin1 e{(bf16_t*)(ws + S1_Q), (bf16_t*)(ws + S1_K), (bf16_t*)(ws + S1_VT), p.in[31], p.in[32], (const float*)(ws + T_ROPE)};
      gemm_phase(lds, A0, 1024, WB + W_IN1, 1024, 0, NR / 256, 6, e); }
    { int rk, nrk; slack_rank((NR / 256) * 6, rk, nrk); transpose_range(lds, ws, p, p.jobs[9].tile0 + 704, p.njobtiles, rk, nrk); }
    GRID_SYNC();
    { const bf16_t* Q = (const bf16_t*)(ws + S1_Q); const bf16_t* K1 = (const bf16_t*)(ws + S1_K); const bf16_t* VT = (const bf16_t*)(ws + S1_VT);
      constexpr int WNH = 2;
      const int nit = 2 * 4 * (4 / WNH) * 32;
      float mref; { float gq = 0.f, gk = 0.f;
        for (int d_ = 0; d_ < 64; ++d_) { gq = fmaxf(gq, fabsf(p.in[31][d_])); gk = fmaxf(gk, fabsf(p.in[32][d_])); }
        mref = 8.f * LOG2E * 1.02f * gq * gk; }
      for (int it = bid; it < nit; it += nb) { const int kvh = it & 3, b = (it >> 2) & 1, rest = it >> 3; const int gp = rest % (4 / WNH), i = rest / (4 / WNH); const int hq0 = kvh * 4 + gp * WNH;
          const size_t row = NCTX + (size_t)b * SEQ + i * 256;
          const int l0 = (4 * i - 2) < 0 ? 0 : (4 * i - 2), l1 = (4 * i + 6) > 128 ? 128 : (4 * i + 6);
          win_attn_item<WNH>(lds, Q + row * 1024 + hq0 * 64, K1 + (size_t)(b * 4 + kvh) * TK * 64, VT + (size_t)(b * 4 + kvh) * 64 * TK, 4 + l0, 4 + l1, mref, p.in[33] + hq0, A0 + row * 1024 + hq0 * 64, i * 256); } }
    GRID_SYNC();
    { EpiRes e{H, H + (size_t)NCTX * 1024, nullptr, H + (size_t)NCTX * 1024, MOD + 1 * 3 * 6144 + 2048, 0};
      gemm_phase(lds, A0, 1024, WB + W_OUT1, 1024, 2, NLAT / 256, 4, e); }
    GRID_SYNC();
    modulate_rows(p, 1, 1, false, NCTX);
    GRID_SYNC();
    { EpiSwiGLU e{(bf16_t*)(ws + S_HID)};
      gemm_phase(lds, A0, 1024, WB + W_GU1, 1024, 2, NLAT / 256, 22, e); }
    GRID_SYNC();
    { EpiRes e{H, H + (size_t)NCTX * 1024, nullptr, p.out, MOD + 1 * 3 * 6144 + 5120, 0};
      gemm_phase(lds, (const bf16_t*)(ws + S_HID), FH, WB + W_D1, FH, 2, NLAT / 256, 4, e); }
}

extern "C" void kernel_launch(void* const* d_in, const int* in_sizes, int n_in, void* d_out, int out_size, void* d_ws, size_t ws_size, hipStream_t stream) {
    static int grid_blocks = 0;
    if (grid_blocks == 0) {
        if (n_in != 34 || ws_size < WS_NEED2) { fprintf(stderr, "kernel_launch: unexpected n_in %d / ws %zu (need %zu)\n", n_in, ws_size, (size_t)WS_NEED2); grid_blocks = -1; return; }
        int dev = 0, cus = 0, per_cu = 0;
        (void)hipGetDevice(&dev);
        (void)hipDeviceGetAttribute(&cus, hipDeviceAttributeMultiprocessorCount, dev);
        (void)hipFuncSetAttribute((const void*)fwd_kernel, hipFuncAttributeMaxDynamicSharedMemorySize, LDS_BYTES);
        (void)hipOccupancyMaxActiveBlocksPerMultiprocessor(&per_cu, (const void*)fwd_kernel, NTHREADS, LDS_BYTES);
        if (per_cu < 1) { fprintf(stderr, "kernel_launch: occupancy query returned %d\n", per_cu); grid_blocks = -1; return; }
        if (per_cu > 1) per_cu = 1;
        grid_blocks = cus * per_cu;
        fprintf(stderr, "kernel_launch: grid %d (%d CUs x %d)\n", grid_blocks, cus, per_cu);
    }
    if (grid_blocks < 0) return;
    Params p{};
    for (int i = 0; i < 34; ++i) p.in[i] = (const float*)d_in[i];
    p.out = (float*)d_out; p.ws = (char*)d_ws;
    const float* fg = p.in[8]; const float* fu = p.in[9]; const float* fd = p.in[10];
    const size_t FW = (size_t)1024 * FH;
    int t0 = 0;
    auto mk = [&](int idx, const float* a, const float* b, size_t dst, int K, int ld, int npad, int mode) {
        Job& j = p.jobs[idx]; j.a = a; j.b = b; j.ks = nullptr; j.dst = dst; j.K = K; j.ld = ld; j.ntk = K / 64; j.ntn = npad / 64; j.tile0 = t0; j.mode = mode; t0 += j.ntk * j.ntn; };
    mk(0, p.in[11], nullptr, W_IN0, 1024, 1216, 1280, 0);
    mk(1, p.in[24], nullptr, W_QB, 384, 768, 768, 0);
    mk(2, p.in[26], nullptr, W_KVB, 256, 1024, 1024, 0);
    p.jobs[1].ks = p.in[23]; p.jobs[2].ks = p.in[25];
    mk(3, p.in[21], nullptr, W_GLU, 512, 512, 512, 0);
    mk(4, p.in[12], nullptr, W_OUT0, 1024, 1024, 1024, 0);
    mk(5, fg, fu, W_GU0, 1024, FH, 5632, 1);
    mk(6, fd, nullptr, W_D0, FH, 1024, 1024, 0);
    mk(7, p.in[29], nullptr, W_IN1, 1024, 1536, 1536, 0);
    mk(8, p.in[30], nullptr, W_OUT1, 1024, 1024, 1024, 0);
    mk(9, fg + FW, fu + FW, W_GU1, 1024, FH, 5632, 1);
    mk(10, fd + FW, nullptr, W_D1, FH, 1024, 1024, 0);
    p.njobtiles = t0;
    if (hipMemsetAsync((char*)d_ws + T_BAR, 0, XCD_BAR_WORDS * 4, stream) != hipSuccess) { fprintf(stderr, "kernel_launch: memset failed\n"); return; }
    void* args[] = {&p};
    hipError_t e = hipLaunchCooperativeKernel((const void*)fwd_kernel, dim3(grid_blocks), dim3(NTHREADS), args, LDS_BYTES, stream);
    if (e != hipSuccess) fprintf(stderr, "cooperative launch failed: %s (grid %d)\n", hipGetErrorString(e), grid_blocks);
}
```

```cpp
#include <hip/hip_runtime.h>
#include <hip/hip_cooperative_groups.h>
#include <cstdio>
#include <cstdint>
namespace cg = cooperative_groups;

#define DI __device__ __forceinline__
typedef unsigned short bf16_t;
typedef short bf16x8 __attribute__((ext_vector_type(8)));
typedef short s16x4 __attribute__((ext_vector_type(4)));
typedef float f32x4 __attribute__((ext_vector_type(4)));
typedef float f32x2 __attribute__((ext_vector_type(2)));
typedef float f32x16 __attribute__((ext_vector_type(16)));
typedef unsigned u32x4 __attribute__((ext_vector_type(4)));
typedef unsigned u32x2 __attribute__((ext_vector_type(2)));
typedef __bf16 bf16v2 __attribute__((ext_vector_type(2)));

constexpr int DM = 1024, NBATCH = 2, SEQ = 8192, CTX = 256;
constexpr int NCTX = NBATCH * CTX;
constexpr int NLAT = NBATCH * SEQ;
constexpr int NR = NCTX + NLAT;
constexpr int TK = CTX + SEQ;
constexpr int FH = 2816;
constexpr int NCH = TK / 64;
constexpr float LOG2E = 1.4426950408889634f;
constexpr int LDS_BYTES = 131072 + 64;
constexpr int NTHREADS = 512, NWV = 8;

constexpr size_t W_IN0 = 0;
constexpr size_t W_QB = W_IN0 + (size_t)1280 * 1024;
constexpr size_t W_KVB = W_QB + (size_t)768 * 384;
constexpr size_t W_GLU = W_KVB + (size_t)1024 * 256;
constexpr size_t W_OUT0 = W_GLU + (size_t)512 * 512;
constexpr size_t W_GU0 = W_OUT0 + (size_t)1024 * 1024;
constexpr size_t W_D0 = W_GU0 + (size_t)5632 * 1024;
constexpr size_t W_IN1 = W_D0 + (size_t)1024 * 2816;
constexpr size_t W_OUT1 = W_IN1 + (size_t)1536 * 1024;
constexpr size_t W_GU1 = W_OUT1 + (size_t)1024 * 1024;
constexpr size_t W_D1 = W_GU1 + (size_t)5632 * 1024;
constexpr size_t W_END = W_D1 + (size_t)1024 * 2816;
constexpr size_t OFF_TAB = W_END * 2;
constexpr size_t T_MOD = OFF_TAB;
constexpr size_t T_ROPE = T_MOD + 2 * 3 * 6144 * 4;
constexpr size_t T_LAMB = T_ROPE + 128 * 16 * 2 * 4;
constexpr size_t T_LAM64 = T_LAMB + 2 * 32 * 64 * 8;
constexpr size_t T_BBAR = T_LAM64 + 2 * 32 * 64 * 8;
constexpr size_t T_BAR = T_BBAR + (size_t)2 * 32 * 64 * 16 * 8;
constexpr size_t OFF_H = OFF_TAB + (1u << 20);
constexpr size_t OFF_A0 = OFF_H + (size_t)NR * 1024 * 4;
constexpr size_t OFF_S = OFF_A0 + (size_t)NR * 1024 * 2;
constexpr size_t WS_NEED = OFF_S + (size_t)108134400;
constexpr size_t S_SSP = WS_NEED;
constexpr size_t WS_NEED2 = S_SSP + (size_t)NR * 10 * 4;
static_assert(WS_NEED2 <= ((size_t)256 << 20) && OFF_S + (size_t)NR * FH * 2 <= WS_NEED, "workspace");
constexpr int SL = 32;
constexpr int NCK = TK / SL;
constexpr int CHR = NBATCH * NCK;
constexpr size_t H_UA = OFF_H;
constexpr size_t H_KR = H_UA + (size_t)(32 * CHR + 256) * 768 * 2;
constexpr size_t H_E = H_KR + (size_t)NR * 64 * 4;
constexpr size_t H_KK = H_E + (size_t)32 * CHR * 256 * 4;
constexpr size_t H_POW = H_KK + (size_t)32 * 2 * 32 * 256 * 4;
constexpr size_t H_W1A = H_POW + (size_t)4096 * 33 * 8;
static_assert(H_W1A + (size_t)32 * 256 * 512 * 2 <= OFF_A0, "H region overflow");
constexpr size_t A_W1B = OFF_A0;
constexpr size_t S_CQN = OFF_S;
constexpr size_t S_CKVN = S_CQN + (size_t)NR * 384 * 2;
constexpr size_t S_YG = OFF_S;
constexpr size_t S_X = S_CKVN + (size_t)NR * 256 * 2;
constexpr size_t S_CQKV = S_X;
constexpr size_t S_QRAW = S_X;
constexpr size_t S_KNOPE = S_QRAW + (size_t)NR * 768 * 2;
constexpr size_t S_VT = S_KNOPE + (size_t)NR * 512 * 2;
constexpr size_t S_KA = S_VT + (size_t)2 * 4 * 128 * TK * 2;
static_assert(S_CQKV + (size_t)NR * 640 * 4 <= S_VT, "CQKV overlaps VT");
static_assert(S_KA + (size_t)2 * 4 * TK * 192 * 2 <= WS_NEED, "scratch overflow");
constexpr size_t S_HID = OFF_S;
constexpr size_t S1_Q = OFF_S;
constexpr size_t S1_KRAW = S1_Q + (size_t)NR * 1024 * 2;
constexpr size_t S1_K = S1_KRAW + (size_t)NR * 256 * 4;
constexpr size_t S1_VT = S1_K + (size_t)2 * 4 * TK * 64 * 2;

struct Job { const float* a; const float* b; const float* ks; unsigned long long dst; int K, ld, ntk, ntn, tile0, mode; };
struct Params {
    const float* in[34];
    float* out;
    char* ws;
    Job jobs[11];
    int njobtiles;
    int pad;
};

DI int get_tid() { int t = threadIdx.x; asm volatile("" : "+v"(t)); return t; }
DI unsigned pk2(float lo, float hi) { f32x2 v = {lo, hi}; return __builtin_bit_cast(unsigned, __builtin_convertvector(v, bf16v2)); }
DI float bf2f(unsigned short b) { return __uint_as_float(((unsigned)b) << 16); }
DI float wave_sum(float v) {
#pragma unroll
    for (int o = 32; o > 0; o >>= 1) v += __shfl_xor(v, o);
    return v;
}
DI int row_vec(int r) { return r < NCTX ? 2 : (r - NCTX) / SEQ; }
DI int row_batch(int r) { return r < NCTX ? r / CTX : (r - NCTX) / SEQ; }
DI int row_tpos(int r) { return r < NCTX ? r % CTX : CTX + (r - NCTX) % SEQ; }
DI float sigmoidf_(float x) { return __builtin_amdgcn_rcpf(1.f + __expf(-x)); }
DI float siluf_(float x) { return x * __builtin_amdgcn_rcpf(1.f + __expf(-x)); }
DI float gelu_tanh(float y) { const float z = 0.7978845608028654f * (y + 0.044715f * y * y * y); const float t = 1.f - 2.f * __builtin_amdgcn_rcpf(1.f + __expf(2.f * z)); return 0.5f * y * (1.f + t); }
DI void my_sincos(float x, float& s, float& c) {
    const float q = rintf(x * 0.636619772367581f);
    float r = fmaf(-q, 1.5703125f, x);
    r = fmaf(-q, 4.837512969970703125e-4f, r);
    r = fmaf(-q, 7.54978995489188216e-8f, r);
    const int qi = (int)q;
    const float r2 = r * r;
    const float sp = r + r * r2 * (-1.6666654611e-1f + r2 * (8.3321608736e-3f + r2 * (-1.9515295891e-4f)));
    const float cp = 1.0f - 0.5f * r2 + r2 * r2 * (4.166664568298827e-2f + r2 * (-1.388731625493765e-3f + r2 * 2.443315711809948e-5f));
    const int k = qi & 3;
    s = (k == 0) ? sp : (k == 1) ? cp : (k == 2) ? -sp : -cp;
    c = (k == 0) ? cp : (k == 1) ? -sp : (k == 2) ? -cp : sp;
}


#define XB_TMO      128
#define XB_XCNT(j)  (256  + 64 * (j))
#define XB_XSUB(j)  (1280 + 64 * (j))
#define XB_XGEN(j)  (2304 + 64 * (j))
#define XB_TOP      3328
#define XB_TOPGEN   3392
#define XCD_BAR_WORDS 3456
#define XB_SPIN_CAP (1u << 22)
#define LAS __attribute__((address_space(3)))
DI unsigned xb_ld(unsigned* p) { return __hip_atomic_load(p, __ATOMIC_RELAXED, __HIP_MEMORY_SCOPE_AGENT); }
DI unsigned xb_add(unsigned* p, unsigned v) { return __hip_atomic_fetch_add(p, v, __ATOMIC_RELAXED, __HIP_MEMORY_SCOPE_AGENT); }
DI unsigned xb_xcc_id() { return (unsigned)__builtin_amdgcn_s_getreg((3 << 11) | 20) & 0xFu; }
#define XB_SPIN(cond, bar) do { unsigned _sp = 0; while (cond) { __builtin_amdgcn_s_sleep(1); \
    if ((++_sp & 255u) == 0u) { if (xb_ld(&(bar)[XB_TMO])) break; if (_sp > XB_SPIN_CAP) { atomicAdd(&(bar)[XB_TMO], 1u); break; } } } } while (0)
struct XcdBarrier { unsigned* bar; unsigned x; volatile LAS unsigned* st; };
DI XcdBarrier xcd_barrier_post(unsigned* bar, volatile LAS unsigned* st) {
    XcdBarrier b; b.bar = bar; b.x = xb_xcc_id(); b.st = st;
    if (threadIdx.x == 0) (void)xb_add(&bar[XB_XCNT(b.x)], 1u);
    return b;
}
DI void xcd_barrier_complete(unsigned* bar, unsigned x, unsigned& nloc, unsigned& nx) {
    const unsigned G = gridDim.x * gridDim.y * gridDim.z;
    unsigned sum, cnt, mine, sp = 0u;
    for (;;) {
        sum = 0u; cnt = 0u; mine = 0u;
#pragma unroll
        for (unsigned j = 0; j < 16; ++j) { const unsigned c = xb_ld(&bar[XB_XCNT(j)]); sum += c; cnt += (c > 0u) ? 1u : 0u; mine = (j == x) ? c : mine; }
        if (sum == G) break;
        __builtin_amdgcn_s_sleep(1);
        if ((++sp & 255u) == 0u) { if (xb_ld(&bar[XB_TMO])) break; if (sp > XB_SPIN_CAP) { atomicAdd(&bar[XB_TMO], 1u); break; } }
    }
    nloc = mine > 0u ? mine : 1u; nx = cnt > 0u ? cnt : 1u;
}
DI void xcd_barrier(const XcdBarrier& b) {
    asm volatile("s_waitcnt vmcnt(0)" ::: "memory");
    __syncthreads();
    if (threadIdx.x == 0) {
        unsigned* bar = b.bar;
        __builtin_amdgcn_s_waitcnt(0);
        unsigned nloc = b.st[0], nx = b.st[1];
        if (nloc == 0u) { xcd_barrier_complete(bar, b.x, nloc, nx); b.st[0] = nloc; b.st[1] = nx; }
        const unsigned old = xb_add(&bar[XB_XSUB(b.x)], 1u);
        const unsigned gen = old / nloc;
        if (old + 1u == (gen + 1u) * nloc) {
            __builtin_amdgcn_fence(__ATOMIC_RELEASE, "agent");
            asm volatile("s_waitcnt vmcnt(0)" ::: "memory");
            const unsigned og = xb_add(&bar[XB_TOP], 1u);
            const unsigned tg = og / nx;
            if (og + 1u == (tg + 1u) * nx) xb_add(&bar[XB_TOPGEN], 1u);
            else XB_SPIN(xb_ld(&bar[XB_TOPGEN]) == tg, bar);
            __builtin_amdgcn_fence(__ATOMIC_ACQUIRE, "agent");
            xb_add(&bar[XB_XGEN(b.x)], 1u);
            asm volatile("s_waitcnt vmcnt(0)" ::: "memory");
        } else {
            XB_SPIN(xb_ld(&bar[XB_XGEN(b.x)]) == gen, bar);
            __builtin_amdgcn_fence(__ATOMIC_ACQUIRE, "agent");
            asm volatile("s_waitcnt vmcnt(0)" ::: "memory");
        }
    }
    __syncthreads();
}

DI void transpose_tile(char* lds, char* ws, const Job& jb, int lt, bool live) {
    const int tid512 = get_tid(); const int tid = tid512 & 255;
    float (*tile)[65] = (float (*)[65])(lds + (tid512 >> 8) * 17408);
    const int tk = lt % jb.ntk, tn = lt / jb.ntk;
    const int k0 = tk * 64, n0 = tn * 64;
    const int c4 = (tid & 15) * 4, rq = tid >> 4;
    const float* src; int col; bool valid = live;
    if (jb.mode == 0) { src = jb.a; col = n0 + c4; valid = live && col < jb.ld; }
    else if (jb.mode == 2) { src = jb.a; const int rho = (n0 + c4) & 255; col = (n0 + c4 - rho) + 64 * ((rho >> 5) & 3) + 32 * (rho >> 7) + (rho & 31); valid = live && col < jb.ld; }
    else { const int nsub = c4 >> 4, i = c4 & 15; src = (nsub & 1) ? jb.b : jb.a; col = tn * 32 + (nsub >> 1) * 16 + i; }
#pragma unroll
    for (int kk = 0; kk < 4; ++kk) { const int k = kk * 16 + rq; f32x4 v = valid ? *(const f32x4*)(src + (size_t)(k0 + k) * jb.ld + col) : (f32x4){0.f, 0.f, 0.f, 0.f};
        if (jb.ks) v = v * jb.ks[k0 + k];
        tile[k][c4] = v[0]; tile[k][c4 + 1] = v[1]; tile[k][c4 + 2] = v[2]; tile[k][c4 + 3] = v[3]; }
    __syncthreads();
    const int r = tid >> 2, ks = (tid & 3) * 16;
    unsigned w[8];
#pragma unroll
    for (int q = 0; q < 8; ++q) w[q] = pk2(tile[ks + 2 * q][r], tile[ks + 2 * q + 1][r]);
    bf16_t* d = (bf16_t*)(ws) + jb.dst + (size_t)(n0 + r) * jb.K + k0 + ks;
    if (live) { *(u32x4*)d = (u32x4){w[0], w[1], w[2], w[3]};
    *(u32x4*)(d + 8) = (u32x4){w[4], w[5], w[6], w[7]}; }
    __syncthreads();
}

DI void transpose_range(char* lds, char* ws, const Params& p, int t_begin, int t_end, int rank, int nranks) {
    if (rank < 0) return;
    for (int pr = (t_begin >> 1) + rank; pr < (t_end >> 1); pr += nranks) {
        const int lt = pr * 2 + (int)(threadIdx.x >> 8); int j = 0;
#pragma unroll
        for (int q = 1; q < 11; ++q) if (lt >= p.jobs[q].tile0) j = q;
        transpose_tile(lds, ws, p.jobs[j], lt - p.jobs[j].tile0, true);
    }
}
DI void slack_rank(int ntile, int& rank, int& nranks) { const int rem = ntile % (int)gridDim.x; if (rem == 0) { rank = blockIdx.x; nranks = gridDim.x; } else { rank = (int)blockIdx.x - rem; nranks = (int)gridDim.x - rem; } }

DI void ada_item(char* lds, const Params& p, int it) {
    float* sil = (float*)lds;
    float* red = sil + 3072;
    float* MOD = (float*)(p.ws + T_MOD);
    const int tid = get_tid(), layer = it / 96, n0 = (it % 96) * 64;
    for (int i = tid; i < 3072; i += NTHREADS) { const int v = i >> 10, k = i & 1023; const float x = v < 2 ? p.in[1][v * 1024 + k] : p.in[3][k]; sil[i] = siluf_(x); }
    __syncthreads();
    const int j4 = (tid & 15) * 4, kg = tid >> 4;
    const float* W = p.in[4] + (size_t)layer * 1024 * 6144 + n0 + j4;
    f32x4 a0 = {0.f, 0.f, 0.f, 0.f}, a1 = a0, a2 = a0;
#pragma unroll 8
    for (int k = kg * 32; k < kg * 32 + 32; ++k) { const f32x4 w = *(const f32x4*)(W + (size_t)k * 6144); a0 += sil[k] * w; a1 += sil[1024 + k] * w; a2 += sil[2048 + k] * w; }
    *(f32x4*)(red + (kg * 3 + 0) * 64 + j4) = a0; *(f32x4*)(red + (kg * 3 + 1) * 64 + j4) = a1; *(f32x4*)(red + (kg * 3 + 2) * 64 + j4) = a2;
    __syncthreads();
    if (tid < 192) { const int v = tid >> 6, jj = tid & 63;
        float s = p.in[5][layer * 6144 + n0 + jj];
#pragma unroll 8
        for (int q = 0; q < 32; ++q) s += red[(q * 3 + v) * 64 + jj];
        MOD[(layer * 3 + v) * 6144 + n0 + jj] = s; }
    __syncthreads();
}

DI void tables_item(const Params& p, int it) {
    const int tid = get_tid();
    if (it < 4) {
        const int e = it * 512 + tid, pos = e >> 4, i = e & 15;
        const float inv = exp2f(-(float)i * (13.287712379549449f / 16.f));
        float s, c; my_sincos((float)pos * inv, s, c);
        float* ROPE = (float*)(p.ws + T_ROPE); ROPE[e * 2] = c; ROPE[e * 2 + 1] = s;
    } else {
        const int e = (it - 4) * 512 + tid;
        const int dg = e >> 6;
        const float lr = p.in[13][e], li = p.in[14][e], step = expf(p.in[15][dg]);
        const float a = lr * step, b = li * step;
        const float ea = expf(a);
        float sb, cb; my_sincos(b, sb, cb);
        float sh, ch; my_sincos(0.5f * b, sh, ch);
        const float em1 = a * (1.f + a * 0.5f * (1.f + a * (1.f / 3.f) * (1.f + a * 0.25f * (1.f + a * 0.2f * (1.f + a * (1.f / 6.f))))));
        const float lbr = ea * cb, lbi = ea * sb;
        const float nr = em1 * cb - 2.f * sh * sh, ni = ea * sb;
        const float den = lr * lr + li * li;
        const float qr = (nr * lr + ni * li) / den, qi = (ni * lr - nr * li) / den;
        f32x2* BB = (f32x2*)(p.ws + T_BBAR);
#pragma unroll
        for (int s = 0; s < 16; ++s) { const float br = p.in[16][e * 16 + s], bi = p.in[17][e * 16 + s]; BB[e * 16 + s] = (f32x2){qr * br - qi * bi, qr * bi + qi * br}; }
        f32x2* POW = (f32x2*)(p.ws + H_POW) + (size_t)dg * 33 * 64 + (e & 63);
        float pr = 1.f, pi = 0.f;
        for (int q = 0; q <= 32; ++q) { POW[q * 64] = (f32x2){pr, pi}; const float nr2 = pr * lbr - pi * lbi, ni2 = pr * lbi + pi * lbr; pr = nr2; pi = ni2; }
    }
}

DI void modulate_rows(const Params& p, int layer, int which, bool from_inputs, int r0) {
    const int tid_ = get_tid(); const int lane = tid_ & 63, wid = tid_ >> 6;
    const float* gain = p.in[which ? 7 : 6] + layer * 1024;
    const float* modl = (const float*)(p.ws + T_MOD) + layer * 3 * 6144 + (which ? 3072 : 0);
    const float* H = (const float*)(p.ws + OFF_H);
    bf16_t* dst = (bf16_t*)(p.ws + OFF_A0);
    const int stride = gridDim.x * NWV;
    for (int ra = r0 + blockIdx.x * NWV + wid; ra < NR; ra += 2 * stride) {
        const int rb = ra + stride; const bool hb = rb < NR; const int rbb = hb ? rb : ra;
        const float* srca = from_inputs ? (ra < NCTX ? p.in[2] + (size_t)ra * 1024 : p.in[0] + (size_t)(ra - NCTX) * 1024) : H + (size_t)ra * 1024;
        const float* srcb = from_inputs ? (rbb < NCTX ? p.in[2] + (size_t)rbb * 1024 : p.in[0] + (size_t)(rbb - NCTX) * 1024) : H + (size_t)rbb * 1024;
        f32x4 xa[4], xb[4]; float sa = 0.f, sb = 0.f;
#pragma unroll
        for (int i = 0; i < 4; ++i) { xa[i] = *(const f32x4*)(srca + i * 256 + lane * 4); xb[i] = *(const f32x4*)(srcb + i * 256 + lane * 4); }
#pragma unroll
        for (int i = 0; i < 4; ++i) { sa += xa[i][0] * xa[i][0] + xa[i][1] * xa[i][1] + xa[i][2] * xa[i][2] + xa[i][3] * xa[i][3];
                                      sb += xb[i][0] * xb[i][0] + xb[i][1] * xb[i][1] + xb[i][2] * xb[i][2] + xb[i][3] * xb[i][3]; }
        sa = wave_sum(sa); sb = wave_sum(sb);
        const float rsa = rsqrtf(sa * (1.f / 1024.f) + 1e-6f), rsb = rsqrtf(sb * (1.f / 1024.f) + 1e-6f);
        const float* mva = modl + row_vec(ra) * 6144; const float* mvb = modl + row_vec(rbb) * 6144;
#pragma unroll
        for (int i = 0; i < 4; ++i) { const int c = i * 256 + lane * 4;
            const f32x4 g = *(const f32x4*)(gain + c);
            { const f32x4 sh = *(const f32x4*)(mva + c), sc = *(const f32x4*)(mva + 1024 + c); const f32x4 y = xa[i] * rsa * g * (1.f + sc) + sh;
              *(u32x2*)(dst + (size_t)ra * 1024 + c) = (u32x2){pk2(y[0], y[1]), pk2(y[2], y[3])}; }
            if (hb) { const f32x4 sh = *(const f32x4*)(mvb + c), sc = *(const f32x4*)(mvb + 1024 + c); const f32x4 y = xb[i] * rsb * g * (1.f + sc) + sh;
              *(u32x2*)(dst + (size_t)rb * 1024 + c) = (u32x2){pk2(y[0], y[1]), pk2(y[2], y[3])}; } }
    }
}

template <class Epi>
DI void gemm_phase(char* lds, const bf16_t* A0_, int lda, const bf16_t* Bt0_, int K, int mt0, int nmt, int nnt, const Epi& epi, int nbatch = 1, size_t sA = 0, size_t sB = 0, int ksplit = 1, int gact = 0) {
    const int tid = get_tid(), lane = tid & 63, wid = tid >> 6, wr = wid >> 2, wc = wid & 3, fr = lane & 15, fq = lane >> 4;
    const int nk = (K >> 6) / ksplit;
    const int lrow = tid >> 3, lc = tid & 7, lkc = lc * 8;
    const int woff = lrow * 128 + ((lc ^ ((lrow >> 1) & 7)) << 4);
    const int ra0 = (wr * 128 + fr) * 128 + ((fq ^ (fr >> 1)) << 4);
    const int ra1 = (wr * 128 + fr) * 128 + (((4 + fq) ^ (fr >> 1)) << 4);
    const int rb0 = 32768 + (wc * 64 + fr) * 128 + ((fq ^ (fr >> 1)) << 4);
    const int rb1 = 32768 + (wc * 64 + fr) * 128 + (((4 + fq) ^ (fr >> 1)) << 4);
    const int per = nmt * nnt, ntile = nbatch * per * ksplit;
    const int PM = nnt >= 8 ? 4 : 8;
    const int GA = gact > 0 ? gact : (int)gridDim.x;
    const int myn = ((int)blockIdx.x < GA && (int)blockIdx.x < ntile) ? (ntile - (int)blockIdx.x + GA - 1) / GA : 0;
    const int total = myn * nk;
    f32x4 acc[8][4];
#pragma unroll
    for (int m = 0; m < 8; ++m)
#pragma unroll
        for (int n = 0; n < 4; ++n) acc[m][n] = (f32x4){0.f, 0.f, 0.f, 0.f};
    int iti = 0, ikt = 0;
    const int srow = wid * 32 + (lane >> 3);
    const bf16_t* Ag = A0_; const bf16_t* Bg = Bt0_;
#define G_STAGE(bufoff) do { if (ikt == 0) { const int u_ = blockIdx.x + iti * GA; const int t_ = u_ / ksplit, sl_ = u_ - t_ * ksplit; const int gb_ = t_ / per, tr_ = t_ - gb_ * per; const int ch_ = tr_ / (PM * nnt), rm_ = tr_ - ch_ * PM * nnt; const int pc_ = (nmt - ch_ * PM) < PM ? (nmt - ch_ * PM) : PM; const int tn_ = rm_ / pc_, tm_ = ch_ * PM + (rm_ - tn_ * pc_); \
            Ag = A0_ + (size_t)gb_ * sA + (size_t)((mt0 + tm_) * 256) * lda + sl_ * nk * 64; Bg = Bt0_ + (size_t)gb_ * sB + (size_t)(tn_ * 256) * K + sl_ * nk * 64; } \
        _Pragma("unroll") for (int i = 0; i < 4; ++i) { const int row_ = srow + 8 * i; const int c_ = ((lane & 7) ^ ((row_ >> 1) & 7)) * 8; \
            __builtin_amdgcn_global_load_lds((const unsigned*)(Ag + (size_t)row_ * lda + ikt * 64 + c_), (LAS unsigned*)(lds + (bufoff) + (wid * 4 + i) * 1024), 16, 0, 0); \
            __builtin_amdgcn_global_load_lds((const unsigned*)(Bg + (size_t)row_ * K + ikt * 64 + c_), (LAS unsigned*)(lds + (bufoff) + 32768 + (wid * 4 + i) * 1024), 16, 0, 0); } \
        if (++ikt == nk) { ikt = 0; ++iti; } } while (0)
#define G_COMPUTE(bufoff) do { _Pragma("unroll") for (int ks = 0; ks < 2; ++ks) { bf16x8 a[8], b[4]; \
        _Pragma("unroll") for (int m = 0; m < 8; ++m) a[m] = *(const bf16x8*)(lds + (bufoff) + (ks ? ra1 : ra0) + m * 2048); \
        _Pragma("unroll") for (int n = 0; n < 4; ++n) b[n] = *(const bf16x8*)(lds + (bufoff) + (ks ? rb1 : rb0) + n * 2048); \
        _Pragma("unroll") for (int m = 0; m < 8; ++m) _Pragma("unroll") for (int n = 0; n < 4; ++n) acc[m][n] = __builtin_amdgcn_mfma_f32_16x16x32_bf16(b[n], a[m], acc[m][n], 0, 0, 0); } } while (0)
    __syncthreads();
    if (total > 0) G_STAGE(0);
    asm volatile("s_waitcnt vmcnt(0)" ::: "memory");
    __syncthreads();
    int cti = 0, ckt = 0;
    for (int q = 0; q < total; ++q) {
        const int cur = (q & 1) * 65536;
        if (q + 1 < total) G_STAGE(cur ^ 65536);
        G_COMPUTE(cur);
        asm volatile("s_waitcnt vmcnt(0)" ::: "memory");
        __syncthreads();
        if (++ckt == nk) {
            const int u_ = blockIdx.x + cti * GA; const int t_ = u_ / ksplit; const int gb_ = t_ / per, tr_ = t_ - gb_ * per; const int ch_ = tr_ / (PM * nnt), rm_ = tr_ - ch_ * PM * nnt; const int pc_ = (nmt - ch_ * PM) < PM ? (nmt - ch_ * PM) : PM; const int tn_ = rm_ / pc_, tm_ = ch_ * PM + (rm_ - tn_ * pc_);
            epi(acc, (mt0 + tm_) * 256 + wr * 128 + fr, tn_ * 256 + wc * 64 + fq * 4, gb_);
#pragma unroll
            for (int m = 0; m < 8; ++m)
#pragma unroll
                for (int n = 0; n < 4; ++n) acc[m][n] = (f32x4){0.f, 0.f, 0.f, 0.f};
            ckt = 0; ++cti;
        }
    }
#undef G_STAGE
#undef G_COMPUTE
}

template <int KSP>
DI void thin_gemm_ctx(char* lds, const bf16_t* A, int lda, const bf16_t* Bt, int K, const float* res, float* dst, const float* gate) {
    const int tid = get_tid(), lane = tid & 63, wid = tid >> 6, fr = lane & 15, fq = lane >> 4;
    float* part = (float*)lds;
    for (int t = blockIdx.x; t < 256; t += gridDim.x) {
        const int m0 = (t >> 5) * 64, n0 = (t & 31) * 32;
        f32x4 acc[4][2];
#pragma unroll
        for (int m = 0; m < 4; ++m) { acc[m][0] = (f32x4){0.f, 0.f, 0.f, 0.f}; acc[m][1] = (f32x4){0.f, 0.f, 0.f, 0.f}; }
        const bf16_t* Ap = A + (size_t)(m0 + fr) * lda + wid * (KSP * 32) + fq * 8;
        const bf16_t* Bp = Bt + (size_t)(n0 + fr) * K + wid * (KSP * 32) + fq * 8;
#pragma unroll
        for (int k = 0; k < KSP; ++k) {
            bf16x8 a[4], b[2];
#pragma unroll
            for (int m = 0; m < 4; ++m) a[m] = *(const bf16x8*)(Ap + (size_t)m * 16 * lda + k * 32);
#pragma unroll
            for (int n = 0; n < 2; ++n) b[n] = *(const bf16x8*)(Bp + (size_t)n * 16 * K + k * 32);
#pragma unroll
            for (int m = 0; m < 4; ++m)
#pragma unroll
                for (int n = 0; n < 2; ++n) acc[m][n] = __builtin_amdgcn_mfma_f32_16x16x32_bf16(b[n], a[m], acc[m][n], 0, 0, 0);
        }
        __syncthreads();
#pragma unroll
        for (int m = 0; m < 4; ++m)
#pragma unroll
            for (int n = 0; n < 2; ++n) *(f32x4*)(part + ((wid * 64 + m * 16 + fr) * 32 + n * 16 + fq * 4)) = acc[m][n];
        __syncthreads();
        { const int row = tid >> 3, c4 = (tid & 7) * 4; f32x4 sum = (f32x4){0.f, 0.f, 0.f, 0.f};
#pragma unroll
          for (int w = 0; w < 8; ++w) sum += *(const f32x4*)(part + ((w * 64 + row) * 32 + c4));
          const size_t off = (size_t)(m0 + row) * 1024 + n0 + c4;
          const f32x4 g = *(const f32x4*)(gate + 2 * 6144 + n0 + c4), x = *(const f32x4*)(res + off);
          *(f32x4*)(dst + off) = x + g * sum; }
    }
    __syncthreads();
}

struct EpiWin0 {
    bf16_t* UA; bf16_t* CQN; bf16_t* CKVN; float* SSP; float* KR;
    template <int NM> DI void run(const f32x4 (&acc)[NM][4], int row0, int col0) const {
        const int cw = col0 & ~63;
#pragma unroll
        for (int m = 0; m < NM; ++m) { const int ri = row0 + m * 16; const size_t r = ri;
            if (cw < 512) { const int b = row_batch(ri), tp = row_tpos(ri);
#pragma unroll
                for (int n = 0; n < 4; ++n) { const int c = col0 + n * 16; const f32x4 v = acc[m][n]; const int g = c >> 4, s0 = c & 15;
                    *(u32x2*)(UA + ((size_t)g * CHR + b * NCK + (tp >> 5)) * 768 + (tp & 31) * 16 + s0) = (u32x2){pk2(v[0], v[1]), pk2(v[2], v[3])}; }
            } else if (cw < 1152) { const bool isq = cw < 896; bf16_t* dst = isq ? CQN + r * 384 + (col0 - 512) : CKVN + r * 256 + (col0 - 896);
                float ss = 0.f;
#pragma unroll
                for (int n = 0; n < 4; ++n) { const f32x4 v = acc[m][n]; ss += v[0] * v[0] + v[1] * v[1] + v[2] * v[2] + v[3] * v[3];
                    *(u32x2*)(dst + n * 16) = (u32x2){pk2(v[0], v[1]), pk2(v[2], v[3])}; }
                ss += __shfl_xor(ss, 16); ss += __shfl_xor(ss, 32);
                if ((col0 & 15) == 0) SSP[r * 10 + ((cw - 512) >> 6)] = ss;
            } else if (cw < 1216) {
#pragma unroll
                for (int n = 0; n < 4; ++n) *(f32x4*)(KR + r * 64 + (col0 - 1152) + n * 16) = acc[m][n];
            } }
    }
    DI void operator()(const f32x4 (&acc)[8][4], int row0, int col0, int gb) const { run<8>(acc, row0, col0); }
};
struct EpiS1a {
    float* E;
    DI void operator()(const f32x4 (&acc)[8][4], int row0, int col0, int gb) const {
#pragma unroll
        for (int m = 0; m < 8; ++m) { const int r = row0 + m * 16; if (r >= CHR) continue;
#pragma unroll
            for (int n = 0; n < 4; ++n) *(f32x4*)(E + ((size_t)gb * CHR + r) * 256 + col0 + n * 16) = acc[m][n]; }
    }
};
struct EpiS1b {
    bf16_t* YG;
    DI void operator()(const f32x4 (&acc)[8][4], int row0, int col0, int gb) const {
#pragma unroll
        for (int m = 0; m < 8; ++m) { const int r = row0 + m * 16; if (r >= CHR) continue; const int b = r / NCK, c = r % NCK;
#pragma unroll
            for (int n = 0; n < 4; ++n) { const int cc = col0 + n * 16; const int tl = cc >> 4, s0 = cc & 15; const f32x4 v = acc[m][n];
                const int tp = c * SL + tl; const size_t row = tp < CTX ? (size_t)b * CTX + tp : (size_t)NCTX + (size_t)b * SEQ + (tp - CTX);
                *(u32x2*)(YG + row * 512 + gb * 16 + s0) = (u32x2){pk2(gelu_tanh(v[0]), gelu_tanh(v[1])), pk2(gelu_tanh(v[2]), gelu_tanh(v[3]))}; } }
    }
};
struct EpiBf16 {
    bf16_t* O; int ldo; const float* SSP;
    DI void operator()(const f32x4 (&acc)[8][4], int row0, int col0, int gb) const {
#pragma unroll
        for (int m = 0; m < 8; ++m) { const size_t r = row0 + m * 16; const float* sp = SSP + r * 10;
            const float rstd = rsqrtf(((sp[0] + sp[1]) + (sp[2] + sp[3]) + (sp[4] + sp[5])) * (1.f / 384.f) + 1e-6f);
#pragma unroll
            for (int n = 0; n < 4; ++n) { const int c = col0 + n * 16; const f32x4 v = acc[m][n] * rstd;
                *(u32x2*)(O + r * ldo + c) = (u32x2){pk2(v[0], v[1]), pk2(v[2], v[3])}; } }
    }
};
struct EpiKV {
    bf16_t* KNOPE; bf16_t* VT; const float* SSP;
    DI void operator()(const f32x4 (&acc)[8][4], int row0, int col0, int gb) const {
#pragma unroll
        for (int m = 0; m < 8; ++m) { const int r = row0 + m * 16; const int b = row_batch(r), tp = row_tpos(r); const float* sp = SSP + (size_t)r * 10 + 6;
            const float rstd = rsqrtf(((sp[0] + sp[1]) + (sp[2] + sp[3])) * (1.f / 256.f) + 1e-6f);
#pragma unroll
            for (int n = 0; n < 4; ++n) { const int c = col0 + n * 16; const int h = c >> 8, w = c & 255; const f32x4 v = acc[m][n] * rstd;
                if (w < 128) *(u32x2*)(KNOPE + (size_t)r * 512 + h * 128 + w) = (u32x2){pk2(v[0], v[1]), pk2(v[2], v[3])};
                else { bf16_t* d = VT + ((size_t)(b * 4 + h) * 128 + (w - 128)) * TK + tp; const unsigned p0 = pk2(v[0], v[1]), p1 = pk2(v[2], v[3]);
                    d[0] = (bf16_t)(p0 & 0xffff); d[TK] = (bf16_t)(p0 >> 16); d[2 * TK] = (bf16_t)(p1 & 0xffff); d[3 * TK] = (bf16_t)(p1 >> 16); } } }
    }
};
struct EpiGLU {
    const bf16_t* YG; const float* bias; bf16_t* CAT;
    DI void operator()(const f32x4 (&acc)[8][4], int row0, int col0, int gb) const {
#pragma unroll
        for (int m = 0; m < 8; ++m) { const size_t r = row0 + m * 16;
#pragma unroll
            for (int n = 0; n < 4; ++n) { const int c = col0 + n * 16; const f32x4 v = acc[m][n]; const f32x4 bv = *(const f32x4*)(bias + c);
                const u32x2 yy = *(const u32x2*)(YG + r * 512 + c);
                const float y0 = __uint_as_float(yy[0] << 16), y1 = __uint_as_float(yy[0] & 0xffff0000u), y2 = __uint_as_float(yy[1] << 16), y3 = __uint_as_float(yy[1] & 0xffff0000u);
                const float o0 = y0 * sigmoidf_(v[0] + bv[0]), o1 = y1 * sigmoidf_(v[1] + bv[1]), o2 = y2 * sigmoidf_(v[2] + bv[2]), o3 = y3 * sigmoidf_(v[3] + bv[3]);
                *(u32x2*)(CAT + r * 1024 + c) = (u32x2){pk2(o0, o1), pk2(o2, o3)}; } }
    }
};
struct EpiRes {
    const float* res_ctx; const float* res_lat; float* dst_ctx; float* dst_lat; const float* gate; int atomic;
    DI void operator()(const f32x4 (&acc)[8][4], int row0, int col0, int gb) const {
#pragma unroll
        for (int m = 0; m < 8; ++m) { const int r = row0 + m * 16;
            const float* rs = r < NCTX ? res_ctx + (size_t)r * 1024 : res_lat + (size_t)(r - NCTX) * 1024;
            float* ds = r < NCTX ? dst_ctx + (size_t)r * 1024 : dst_lat + (size_t)(r - NCTX) * 1024;
            if (r < NCTX && dst_ctx == nullptr) continue;
            const float* gv = gate + row_vec(r) * 6144;
#pragma unroll
            for (int n = 0; n < 4; ++n) { const int c = col0 + n * 16; const f32x4 g = *(const f32x4*)(gv + c);
                if (atomic) { const f32x4 v = g * acc[m][n];
#pragma unroll
                    for (int j = 0; j < 4; ++j) (void)__hip_atomic_fetch_add(ds + c + j, v[j], __ATOMIC_RELAXED, __HIP_MEMORY_SCOPE_AGENT); }
                else { const f32x4 x = *(const f32x4*)(rs + c); *(f32x4*)(ds + c) = x + g * acc[m][n]; } } }
    }
};
struct EpiSwiGLU {
    bf16_t* HID;
    DI void operator()(const f32x4 (&acc)[8][4], int row0, int col0, int gb) const {
        const int hc = (col0 >> 6) * 32 + (col0 & 15);
#pragma unroll
        for (int m = 0; m < 8; ++m) { const size_t r = row0 + m * 16;
#pragma unroll
            for (int q = 0; q < 2; ++q) { const f32x4 g = acc[m][2 * q], u = acc[m][2 * q + 1];
                const float o0 = siluf_(g[0]) * u[0], o1 = siluf_(g[1]) * u[1], o2 = siluf_(g[2]) * u[2], o3 = siluf_(g[3]) * u[3];
                *(u32x2*)(HID + r * FH + hc + q * 16) = (u32x2){pk2(o0, o1), pk2(o2, o3)}; } }
    }
};
struct EpiWin1 {
    bf16_t* Q; bf16_t* K1; bf16_t* VT; const float* qn; const float* kn; const float* ROPE;
    template <int NM> DI void run(const f32x4 (&acc)[NM][4], int row0, int col0) const {
        const int cw = col0 & ~63, i0 = col0 & 15;
        if (cw >= 1280) {
#pragma unroll
            for (int m = 0; m < NM; ++m) { const int r = row0 + m * 16; const int b = row_batch(r), tp = row_tpos(r);
#pragma unroll
                for (int n = 0; n < 4; ++n) { const int cc = col0 + n * 16 - 1280, h = cc >> 6, d0 = cc & 63; const f32x4 v = acc[m][n];
                    bf16_t* d = VT + ((size_t)(b * 4 + h) * 64 + d0) * TK + tp; const unsigned p0 = pk2(v[0], v[1]), p1 = pk2(v[2], v[3]);
                    d[0] = (bf16_t)(p0 & 0xffff); d[TK] = (bf16_t)(p0 >> 16); d[2 * TK] = (bf16_t)(p1 & 0xffff); d[3 * TK] = (bf16_t)(p1 >> 16); } }
            return;
        }
        const bool isq = cw < 1024;
        const float* gn = isq ? qn : kn;
        f32x4 g[4];
#pragma unroll
        for (int n = 0; n < 4; ++n) g[n] = *(const f32x4*)(gn + n * 16 + i0);
        const float osc = isq ? 0.125f * LOG2E : 1.f;
#pragma unroll
        for (int m = 0; m < NM; ++m) { const int r = row0 + m * 16; const bool lat = r >= NCTX;
            if (isq && !lat) continue;
            const int b = row_batch(r), tp = row_tpos(r), t = tp - CTX;
            float ss = 0.f;
#pragma unroll
            for (int n = 0; n < 4; ++n) { const f32x4 v = acc[m][n]; ss += v[0] * v[0] + v[1] * v[1] + v[2] * v[2] + v[3] * v[3]; }
            ss += __shfl_xor(ss, 16); ss += __shfl_xor(ss, 32);
            const float rstd = rsqrtf(ss * (1.f / 64.f) + 1e-6f);
            f32x4 y[4];
#pragma unroll
            for (int n = 0; n < 4; ++n) y[n] = acc[m][n] * rstd * g[n];
            if (lat) { const float* rr = ROPE + ((t >> 6) * 16 + i0) * 2; const float* rc = ROPE + ((t & 63) * 16 + i0) * 2;
#pragma unroll
                for (int j = 0; j < 4; ++j) { const float c0 = rr[2 * j], s0 = rr[2 * j + 1], c1 = rc[2 * j], s1 = rc[2 * j + 1];
                    const float a0 = y[0][j], a1 = y[1][j], a2 = y[2][j], a3 = y[3][j];
                    y[0][j] = a0 * c0 - a1 * s0; y[1][j] = a1 * c0 + a0 * s0; y[2][j] = a2 * c1 - a3 * s1; y[3][j] = a3 * c1 + a2 * s1; } }
            bf16_t* dst = isq ? Q + (size_t)r * 1024 + cw + i0 : K1 + ((size_t)(b * 4 + ((cw - 1024) >> 6)) * TK + tp) * 64 + i0;
#pragma unroll
            for (int n = 0; n < 4; ++n) *(u32x2*)(dst + n * 16) = (u32x2){pk2(y[n][0] * osc, y[n][1] * osc), pk2(y[n][2] * osc, y[n][3] * osc)};
        }
    }
    DI void operator()(const f32x4 (&acc)[8][4], int row0, int col0, int gb) const { run<8>(acc, row0, col0); }
};

namespace pg8 {
constexpr int BM = 256, BK = 64, HALF = 128, HTB = HALF * BK * 2;
DI int lds_byte(int r, int c) { const int st = (r >> 4) * 2 + (c >> 5), rr = r & 15, cc = c & 31, ob = rr * 64 + cc * 2; return st * 1024 + (ob ^ (((ob >> 9) & 1) << 5)); }
DI void stage_rc(int b, int& R, int& C) { const int st = b / 1024, sb = b % 1024, swz = sb ^ (((sb >> 9) & 1) << 5); R = (st >> 1) * 16 + swz / 64; C = (st & 1) * 32 + (swz % 64) / 2; }
struct Unit { int pm, pn, gb; };
struct Gemm { const bf16_t* A; const bf16_t* Bt; int lda, K; size_t sA = 0, sB = 0; };
struct Order {
    int mt0, nmt, nnt, G, c, nbatch = 1;
    DI bool next(int i, Unit& u) const { const int L0 = i * G + c; if (L0 >= nbatch * nmt * nnt) return false; constexpr int PM = 8; const int gb_ = L0 / (nmt * nnt); const int L = L0 - gb_ * nmt * nnt; u.gb = gb_;
        const int ch = L / (PM * nnt), rm = L - ch * PM * nnt; const int pc = (nmt - ch * PM) < PM ? (nmt - ch * PM) : PM; const int tn = rm / pc;
        u.pm = mt0 + ch * PM + (rm - tn * pc); u.pn = tn; return true; }
};
template <class Epi>
DI void gemm_phase(LAS unsigned char* lds, const Gemm g, const Order& S, const Epi& E) {
    const int tid = get_tid(), wid = __builtin_amdgcn_readfirstlane(tid >> 6), lane = tid & 63, wr = wid >> 2, wc = wid & 3, fr = lane & 15, fq = lane >> 4;
    const int K = g.K, nt = K / BK;
    unsigned voffA[2], voffB[2];
#pragma unroll
    for (int i = 0; i < 2; ++i) { int R, C; stage_rc(tid * 16 + i * 8192, R, C); voffA[i] = (unsigned)(R * g.lda + C) * 2u; voffB[i] = (unsigned)(R * K + C) * 2u; }
    const size_t kstep = (size_t)(BK * 2);
    const size_t hstepA = (size_t)HALF * g.lda * 2, hstepB = (size_t)HALF * K * 2;
    const size_t tstepA = 2 * hstepA, tstepB = 2 * hstepB;
    const unsigned ldsw = (unsigned)wid * 1024u;
    const int aoff = lds_byte(wr * 64 + fr, fq * 8), boff = lds_byte(wc * 32 + fr, fq * 8);
#define PG8_SA(b, h) (((b) * 2 + (h)) * HTB)
#define PG8_SB(b, h) ((4 + (b) * 2 + (h)) * HTB)
#define PG8_STAGE(bufoff, gbase, voff) do { _Pragma("unroll") for (int _i = 0; _i < 2; ++_i) \
        __builtin_amdgcn_global_load_lds((const unsigned*)((const char*)(gbase) + (voff)[_i]), (LAS unsigned*)(lds + (bufoff) + ldsw + _i * 8192), 16, 0, 0); } while (0)
#define PG8_LDA(dst, b, h) do { _Pragma("unroll") for (int m = 0; m < 4; ++m) _Pragma("unroll") for (int k = 0; k < 2; ++k) dst[m][k] = *(const LAS bf16x8*)(lds + PG8_SA(b, h) + aoff + m * 2048 + k * 1024); } while (0)
#define PG8_LDB(dst, b, h) do { _Pragma("unroll") for (int n = 0; n < 2; ++n) _Pragma("unroll") for (int k = 0; k < 2; ++k) dst[n][k] = *(const LAS bf16x8*)(lds + PG8_SB(b, h) + boff + n * 2048 + k * 1024); } while (0)
#define PG8_MMA(ai, bj, At, Bt) do { __builtin_amdgcn_s_setprio(1); _Pragma("unroll") for (int m = 0; m < 4; ++m) _Pragma("unroll") for (int n = 0; n < 2; ++n) _Pragma("unroll") for (int k = 0; k < 2; ++k) \
        acc[ai][bj][m][n] = __builtin_amdgcn_mfma_f32_16x16x32_bf16(Bt[n][k], At[m][k], acc[ai][bj][m][n], 0, 0, 0); __builtin_amdgcn_s_setprio(0); } while (0)
#define PG8_WAIT_V(n) asm volatile("s_waitcnt vmcnt(" #n ")" ::: "memory")
#define PG8_WAIT_L(n) asm volatile("s_waitcnt lgkmcnt(" #n ")" ::: "memory")
#define PG8_BAR __builtin_amdgcn_s_barrier()
#define PG8_SCHED __builtin_amdgcn_sched_barrier(0)
    Unit cur, nxt; int ui = 0;
    if (!S.next(0, cur)) return;
    f32x4 acc[2][2][4][2];
#pragma unroll
    for (int a = 0; a < 2; ++a)
#pragma unroll
        for (int b = 0; b < 2; ++b)
#pragma unroll
            for (int m = 0; m < 4; ++m)
#pragma unroll
                for (int n = 0; n < 2; ++n) acc[a][b][m][n] = (f32x4){0.f, 0.f, 0.f, 0.f};
    bf16x8 At[4][2], B0[2][2], B1[2][2];
    const char* cA = (const char*)(g.A + (size_t)cur.gb * g.sA) + (size_t)cur.pm * tstepA; const char* cB = (const char*)(g.Bt + (size_t)cur.gb * g.sB) + (size_t)cur.pn * tstepB;
    PG8_STAGE(PG8_SB(0, 0), cB, voffB); PG8_STAGE(PG8_SB(0, 1), cB + hstepB, voffB); PG8_STAGE(PG8_SA(0, 0), cA, voffA); PG8_STAGE(PG8_SA(0, 1), cA + hstepA, voffA);
    if (wr == 1) PG8_BAR;
    PG8_WAIT_V(2); PG8_BAR;
    PG8_STAGE(PG8_SB(1, 0), cB + kstep, voffB); PG8_STAGE(PG8_SA(1, 0), cA + kstep, voffA); PG8_STAGE(PG8_SB(1, 1), cB + hstepB + kstep, voffB);
    PG8_WAIT_V(6); PG8_BAR;
    for (;;) {
        const bool has_next = S.next(ui + 1, nxt);
        const char* nA = has_next ? (const char*)(g.A + (size_t)nxt.gb * g.sA) + (size_t)nxt.pm * tstepA : cA; const char* nB = has_next ? (const char*)(g.Bt + (size_t)nxt.gb * g.sB) + (size_t)nxt.pn * tstepB : cB;
        for (int t = 0; t < nt; t += 2) {
            const bool last = (t == nt - 2);
            const char* a1 = cA + (size_t)(t + 1) * kstep;
            const char* a2 = last ? nA : cA + (size_t)(t + 2) * kstep; const char* b2 = last ? nB : cB + (size_t)(t + 2) * kstep;
            const char* a3 = a2 + kstep; const char* b3 = b2 + kstep;
            PG8_LDB(B0, 0, 0); PG8_LDB(B1, 0, 1); PG8_SCHED; PG8_LDA(At, 0, 0); PG8_STAGE(PG8_SA(1, 1), a1 + hstepA, voffA);
            PG8_WAIT_V(8); PG8_WAIT_L(0); PG8_BAR; PG8_MMA(0, 0, At, B0); PG8_MMA(0, 1, At, B1); PG8_BAR; PG8_SCHED;
            PG8_LDA(At, 0, 1); PG8_STAGE(PG8_SB(0, 0), b2, voffB); PG8_STAGE(PG8_SB(0, 1), b2 + hstepB, voffB); PG8_STAGE(PG8_SA(0, 0), a2, voffA);
            PG8_WAIT_V(8); PG8_WAIT_L(0); PG8_BAR; PG8_MMA(1, 0, At, B0); PG8_MMA(1, 1, At, B1); PG8_BAR; PG8_SCHED;
            PG8_LDB(B0, 1, 0); PG8_LDB(B1, 1, 1); PG8_SCHED; PG8_LDA(At, 1, 0); PG8_STAGE(PG8_SA(0, 1), a2 + hstepA, voffA);
            PG8_WAIT_V(8); PG8_WAIT_L(0); PG8_BAR; PG8_MMA(0, 0, At, B0); PG8_MMA(0, 1, At, B1); PG8_BAR; PG8_SCHED;
            PG8_LDA(At, 1, 1); PG8_STAGE(PG8_SB(1, 0), b3, voffB); PG8_STAGE(PG8_SB(1, 1), b3 + hstepB, voffB); PG8_STAGE(PG8_SA(1, 0), a3, voffA);
            PG8_WAIT_V(8); PG8_WAIT_L(0); PG8_BAR; PG8_MMA(1, 0, At, B0); PG8_MMA(1, 1, At, B1); PG8_BAR; PG8_SCHED;
        }
        if (wr == 0) PG8_BAR;
        E(acc, cur, wr, wc, fr, fq);
        if (!has_next) break;
#pragma unroll
        for (int a = 0; a < 2; ++a)
#pragma unroll
            for (int b = 0; b < 2; ++b)
#pragma unroll
                for (int m = 0; m < 4; ++m)
#pragma unroll
                    for (int n = 0; n < 2; ++n) acc[a][b][m][n] = (f32x4){0.f, 0.f, 0.f, 0.f};
        cur = nxt; cA = nA; cB = nB; ++ui;
        if (wr == 1) PG8_BAR;
    }
    PG8_WAIT_V(0);
    PG8_BAR;
#undef PG8_SA
#undef PG8_SB
#undef PG8_STAGE
#undef PG8_LDA
#undef PG8_LDB
#undef PG8_MMA
#undef PG8_WAIT_V
#undef PG8_WAIT_L
#undef PG8_BAR
#undef PG8_SCHED
}
struct EpiRes {
    const float* res_lat; float* dst_lat; const float* gate;
    DI void operator()(const f32x4 (&acc)[2][2][4][2], const Unit& u, int wr, int wc, int fr, int fq) const {
        const int row0 = u.pm * 256 + wr * 64 + fr, col0 = u.pn * 256 + wc * 32 + fq * 4;
#pragma unroll
        for (int ai = 0; ai < 2; ++ai)
#pragma unroll
            for (int m = 0; m < 4; ++m) { const int r = row0 + 128 * ai + 16 * m; const size_t ro = (size_t)(r - NCTX) * 1024; const float* gv = gate + row_vec(r) * 6144;
#pragma unroll
                for (int bj = 0; bj < 2; ++bj)
#pragma unroll
                    for (int n = 0; n < 2; ++n) { const int c = col0 + 128 * bj + 16 * n; const f32x4 g_ = *(const f32x4*)(gv + c), x = *(const f32x4*)(res_lat + ro + c);
                        *(f32x4*)(dst_lat + ro + c) = x + g_ * acc[ai][bj][m][n]; } }
    }
};
struct EpiSwiGLU {
    bf16_t* HID;
    DI void operator()(const f32x4 (&acc)[2][2][4][2], const Unit& u, int wr, int wc, int fr, int fq) const {
        const int row0 = u.pm * 256 + wr * 64 + fr, hc0 = u.pn * 128 + wc * 16 + fq * 4;
#pragma unroll
        for (int ai = 0; ai < 2; ++ai)
#pragma unroll
            for (int m = 0; m < 4; ++m) { const size_t r = row0 + 128 * ai + 16 * m;
#pragma unroll
                for (int bj = 0; bj < 2; ++bj) { const f32x4 g_ = acc[ai][bj][m][0], u_ = acc[ai][bj][m][1];
                    const float o0 = siluf_(g_[0]) * u_[0], o1 = siluf_(g_[1]) * u_[1], o2 = siluf_(g_[2]) * u_[2], o3 = siluf_(g_[3]) * u_[3];
                    *(u32x2*)(HID + r * FH + hc0 + 64 * bj) = (u32x2){pk2(o0, o1), pk2(o2, o3)}; } }
    }
};
struct EpiS1a {
    float* E;
    DI void operator()(const f32x4 (&acc)[2][2][4][2], const Unit& u, int wr, int wc, int fr, int fq) const {
        const int row0 = u.pm * 256 + wr * 64 + fr, col0 = u.pn * 256 + wc * 32 + fq * 4;
#pragma unroll
        for (int ai = 0; ai < 2; ++ai)
#pragma unroll
            for (int m = 0; m < 4; ++m) { const int r = row0 + 128 * ai + 16 * m; if (r >= CHR) continue;
#pragma unroll
                for (int bj = 0; bj < 2; ++bj)
#pragma unroll
                    for (int n = 0; n < 2; ++n) *(f32x4*)(E + ((size_t)u.gb * CHR + r) * 256 + col0 + 128 * bj + 16 * n) = acc[ai][bj][m][n]; }
    }
};
struct EpiS1b {
    bf16_t* YG;
    DI void operator()(const f32x4 (&acc)[2][2][4][2], const Unit& u, int wr, int wc, int fr, int fq) const {
        const int row0 = u.pm * 256 + wr * 64 + fr, col0 = u.pn * 256 + wc * 32 + fq * 4;
#pragma unroll
        for (int ai = 0; ai < 2; ++ai)
#pragma unroll
            for (int m = 0; m < 4; ++m) { const int r = row0 + 128 * ai + 16 * m; if (r >= CHR) continue; const int b = r / NCK, c = r % NCK;
#pragma unroll
                for (int bj = 0; bj < 2; ++bj)
#pragma unroll
                    for (int n = 0; n < 2; ++n) { const int cc = col0 + 128 * bj + 16 * n; const int tl = cc >> 4, s0 = cc & 15; const f32x4 v = acc[ai][bj][m][n];
                        const int tp = c * SL + tl; const size_t row = tp < CTX ? (size_t)b * CTX + tp : (size_t)NCTX + (size_t)b * SEQ + (tp - CTX);
                        *(u32x2*)(YG + row * 512 + u.gb * 16 + s0) = (u32x2){pk2(gelu_tanh(v[0]), gelu_tanh(v[1])), pk2(gelu_tanh(v[2]), gelu_tanh(v[3]))}; } }
    }
};
template <class E> struct EpiHead { E e;
    DI void operator()(const f32x4 (&acc)[2][2][4][2], const Unit& u, int wr, int wc, int fr, int fq) const {
#pragma unroll
        for (int ai = 0; ai < 2; ++ai) { f32x4 t[4][4];
#pragma unroll
            for (int m = 0; m < 4; ++m)
#pragma unroll
                for (int sb = 0; sb < 4; ++sb) t[m][sb] = acc[ai][sb >> 1][m][sb & 1];
            e.template run<4>(t, u.pm * 256 + 128 * ai + wr * 64 + fr, u.pn * 256 + wc * 64 + fq * 4); }
    }
};
}

template <int DQK, int DV, bool WIN>
DI void attn_item(char* lds, const bf16_t* Q, int qstride, const bf16_t* Kb, const bf16_t* VTb, int ta0, int ta1, int tb0, int tb1,
                  float mref, float l_init, bf16_t* O, int ostride, int qpos0) {
    constexpr int NKS = DQK / 16, NDT = DV / 32, KSTR = DQK + 8, VSTR = 72, NG = NKS;
    constexpr int KCH = 64 * DQK / 8 / NTHREADS, VCH = DV * 8 / NTHREADS;
    constexpr int KBUF = 64 * KSTR, VBUF = DV * VSTR;
    bf16_t* Ks = (bf16_t*)lds; bf16_t* Vs = Ks + 2 * KBUF;
    const int tid = get_tid(), lane = tid & 63, wid = tid >> 6, r = lane & 31, h2 = lane >> 5;
    bf16x8 qf[NKS];
    { const bf16_t* qrow = Q + (size_t)(wid * 32 + r) * qstride + 8 * h2;
#pragma unroll
      for (int ks = 0; ks < NKS; ++ks) qf[ks] = *(const bf16x8*)(qrow + 16 * ks); }
    f32x16 o[NDT];
#pragma unroll
    for (int dt = 0; dt < NDT; ++dt)
#pragma unroll
        for (int i = 0; i < 16; ++i) o[dt][i] = 0.f;
    float lrun = (h2 == 0) ? l_init : 0.f;
    const int na = ta1 - ta0, ntot = na + (tb1 - tb0);
    u32x4 kr[KCH], vr[VCH];
    constexpr int KTPR = (DQK / 8) / KCH, VTPR = 8 / VCH;
    const int krow = tid / KTPR, kcol = (tid % KTPR) * (KCH * 8);
    const int vrow = tid / VTPR, vcol = (tid % VTPR) * (VCH * 8);
    const bf16_t* kgp = Kb + (size_t)krow * DQK + kcol;
    const bf16_t* vgp = VTb + (size_t)vrow * TK + vcol;
    bf16_t* ksp = Ks + krow * KSTR + kcol;
    bf16_t* vsp = Vs + vrow * VSTR + vcol;
    const bf16_t* kfp = Ks + r * KSTR + 8 * h2;
    const bf16_t* vfp = Vs + r * VSTR + 8 * h2;
#define A_TILE(itv) (((itv) < na) ? ta0 + (itv) : tb0 + ((itv) - na))
#define K_LOAD(itv) do { const bf16_t* kg = kgp + (size_t)A_TILE(itv) * 64 * DQK; _Pragma("unroll") for (int i = 0; i < KCH; ++i) kr[i] = *(const u32x4*)(kg + i * 8); } while (0)
#define V_LOADG(itv) do { const bf16_t* vg = vgp + A_TILE(itv) * 64; _Pragma("unroll") for (int i = 0; i < VCH; ++i) vr[i] = *(const u32x4*)(vg + i * 8); } while (0)
#define K_WRITE(bo) do { _Pragma("unroll") for (int i = 0; i < KCH; ++i) *(u32x4*)(ksp + (bo) + i * 8) = kr[i]; } while (0)
#define V_WRITE(bo) do { _Pragma("unroll") for (int i = 0; i < VCH; ++i) { const int c_ = (vcol >> 3) + i; bf16_t* d_ = vsp - vcol + (bo) + (c_ >> 1) * 16 + (c_ & 1) * 4; \
            *(u32x2*)d_ = (u32x2){vr[i][0], vr[i][1]}; *(u32x2*)(d_ + 8) = (u32x2){vr[i][2], vr[i][3]}; } } while (0)
#define T_ACTIVE(itv) (!(WIN && A_TILE(itv) >= 4 && ((A_TILE(itv) - 4) * 64 > qpos0 + wid * 32 + 31 + 128 || (A_TILE(itv) - 4) * 64 + 63 < qpos0 + wid * 32 - 128)))
#define S_MASK(S0, S1, itv) do { if (WIN && A_TILE(itv) >= 4) { const int qp = qpos0 + wid * 32 + r, kp0 = (A_TILE(itv) - 4) * 64 + 4 * h2; \
        _Pragma("unroll") for (int i = 0; i < 16; ++i) { const int d0 = kp0 + (i & 3) + 8 * (i >> 2) - qp, d1 = d0 + 32; \
            if (d0 > 128 || d0 < -128) S0[i] = -1e30f; if (d1 > 128 || d1 < -128) S1[i] = -1e30f; } } } while (0)
    f32x16 s0, s1;
    __syncthreads();
    K_LOAD(0); K_WRITE(0);
    if (1 < ntot) K_LOAD(1);
    V_LOADG(0);
    __syncthreads();
#pragma unroll
    for (int i = 0; i < 16; ++i) { s0[i] = -mref; s1[i] = -mref; }
#pragma unroll 1
    for (int it = -1; it < ntot; ++it) {
        const int kb_n = ((it + 1) & 1) * KBUF, vb_c = (it & 1) * VBUF;
        if (it + 2 < ntot) K_WRITE((it & 1) * KBUF);
        if (it + 1 < ntot) V_WRITE(((it + 1) & 1) * VBUF);
        __builtin_amdgcn_sched_barrier(0);
        const bool act_c = (it >= 0) && T_ACTIVE(it), act_n = (it + 1 < ntot) && T_ACTIVE(it + 1);
        f32x16 n0, n1;
#pragma unroll
        for (int i = 0; i < 16; ++i) { n0[i] = -mref; n1[i] = -mref; }
        float rs = 0.f;
        unsigned pk[16];
#define P_PAIR(j) do { const float e0_ = __builtin_amdgcn_exp2f((j) < 8 ? s0[2 * ((j) & 7)] : s1[2 * ((j) & 7)]), e1_ = __builtin_amdgcn_exp2f((j) < 8 ? s0[2 * ((j) & 7) + 1] : s1[2 * ((j) & 7) + 1]); rs += e0_ + e1_; pk[j] = pk2(e0_, e1_); } while (0)
        if (act_c && act_n) {
#pragma unroll
            for (int g = 0; g < NG; ++g) {
                const bf16x8 ka = *(const bf16x8*)(kfp + kb_n + 16 * g), kb = *(const bf16x8*)(kfp + kb_n + 32 * KSTR + 16 * g);
                n0 = __builtin_amdgcn_mfma_f32_32x32x16_bf16(ka, qf[g], n0, 0, 0, 0);
                n1 = __builtin_amdgcn_mfma_f32_32x32x16_bf16(kb, qf[g], n1, 0, 0, 0);
#pragma unroll
                for (int j = (16 * g) / NG; j < (16 * (g + 1)) / NG; ++j) P_PAIR(j);
            }
            S_MASK(n0, n1, it + 1);
        } else {
            if (act_n) {
#pragma unroll
                for (int ks = 0; ks < NKS; ++ks) { const bf16x8 k0 = *(const bf16x8*)(kfp + kb_n + 16 * ks), k1 = *(const bf16x8*)(kfp + kb_n + 32 * KSTR + 16 * ks);
                    n0 = __builtin_amdgcn_mfma_f32_32x32x16_bf16(k0, qf[ks], n0, 0, 0, 0); n1 = __builtin_amdgcn_mfma_f32_32x32x16_bf16(k1, qf[ks], n1, 0, 0, 0); }
                S_MASK(n0, n1, it + 1);
            }
            if (act_c) {
#pragma unroll
                for (int j = 0; j < 16; ++j) P_PAIR(j);
            }
        }
#undef P_PAIR
        __builtin_amdgcn_sched_barrier(0);
        if (it + 3 < ntot) K_LOAD(it + 3);
        if (it + 2 < ntot) V_LOADG(it + 2);
        __builtin_amdgcn_sched_barrier(0);
        if (act_c) {
            lrun += rs;
#pragma unroll
            for (int q = 0; q < 4; ++q) {
                const u32x4 pw = {pk[4 * q], pk[4 * q + 1], pk[4 * q + 2], pk[4 * q + 3]};
                const bf16x8 pf = __builtin_bit_cast(bf16x8, pw);
#pragma unroll
                for (int dt = 0; dt < NDT; ++dt) { const bf16x8 vf = *(const bf16x8*)(vfp + vb_c + (32 * dt) * VSTR + 16 * q);
                    o[dt] = __builtin_amdgcn_mfma_f32_32x32x16_bf16(vf, pf, o[dt], 0, 0, 0); }
            }
        }
        s0 = n0; s1 = n1;
        __syncthreads();
    }
#undef A_TILE
#undef K_LOAD
#undef V_LOADG
#undef K_WRITE
#undef V_WRITE
#undef T_ACTIVE
#undef S_MASK
    lrun += __shfl_xor(lrun, 32);
    const float inv = 1.f / lrun;
    bf16_t* orow = O + (size_t)(wid * 32 + r) * ostride;
#pragma unroll
    for (int dt = 0; dt < NDT; ++dt)
#pragma unroll
        for (int g = 0; g < 4; ++g)
            *(u32x2*)(orow + 32 * dt + 8 * g + 4 * h2) = (u32x2){pk2(o[dt][4 * g] * inv, o[dt][4 * g + 1] * inv), pk2(o[dt][4 * g + 2] * inv, o[dt][4 * g + 3] * inv)};
    __syncthreads();
}

template <int NH>
DI void win_attn_item(char* lds, const bf16_t* Q, const bf16_t* Kb, const bf16_t* VTb, int tb0, int tb1, float mref, const float* sinkp, bf16_t* O, int qpos0) {
    constexpr int KSTR = 72, VSTR = 72, KBUF = 64 * KSTR, VBUF = 64 * VSTR;
    bf16_t* Ks = (bf16_t*)lds; bf16_t* Vs = Ks + 2 * KBUF;
    const int tid = get_tid(), lane = tid & 63, wid = tid >> 6, r = lane & 31, h2 = lane >> 5;
    bf16x8 qf[NH][4];
#pragma unroll
    for (int h = 0; h < NH; ++h) { const bf16_t* qrow = Q + (size_t)(wid * 32 + r) * 1024 + h * 64 + 8 * h2;
#pragma unroll
        for (int ks = 0; ks < 4; ++ks) qf[h][ks] = *(const bf16x8*)(qrow + 16 * ks); }
    f32x16 o[NH][2]; float lrun[NH];
#pragma unroll
    for (int h = 0; h < NH; ++h) { lrun[h] = (h2 == 0) ? __builtin_amdgcn_exp2f(sinkp[h] * LOG2E - mref) : 0.f;
#pragma unroll
        for (int dt = 0; dt < 2; ++dt)
#pragma unroll
            for (int i = 0; i < 16; ++i) o[h][dt][i] = 0.f; }
    const int na = 4, ntot = na + (tb1 - tb0);
    u32x4 kr, vr;
    const int krow = tid >> 3, kcol = (tid & 7) * 8;
    const bf16_t* kgp = Kb + (size_t)krow * 64 + kcol;
    const bf16_t* vgp = VTb + (size_t)krow * TK + kcol;
    bf16_t* ksp = Ks + krow * KSTR + kcol;
    bf16_t* vsp = Vs + krow * VSTR + (kcol >> 4) * 16 + ((kcol >> 3) & 1) * 4;
    const bf16_t* kfp = Ks + r * KSTR + 8 * h2;
    const bf16_t* vfp = Vs + r * VSTR + 8 * h2;
#define W_TILE(itv) (((itv) < na) ? (itv) : tb0 + ((itv) - na))
#define W_LOAD(itv) do { kr = *(const u32x4*)(kgp + (size_t)W_TILE(itv) * 64 * 64); vr = *(const u32x4*)(vgp + W_TILE(itv) * 64); } while (0)
#define W_WRITE(kb_, vb_) do { *(u32x4*)(ksp + (kb_)) = kr; *(u32x2*)(vsp + (vb_)) = (u32x2){vr[0], vr[1]}; *(u32x2*)(vsp + (vb_) + 8) = (u32x2){vr[2], vr[3]}; } while (0)
    __syncthreads();
    W_LOAD(0); W_WRITE(0, 0);
    if (1 < ntot) W_LOAD(1);
    __syncthreads();
#pragma unroll 1
    for (int it = 0; it < ntot; ++it) {
        const int T = W_TILE(it);
        const int kb = (it & 1) * KBUF, vb = (it & 1) * VBUF;
        if (it + 1 < ntot) W_WRITE(KBUF - kb, VBUF - vb);
        if (it + 2 < ntot) W_LOAD(it + 2);
        bool active = true, need_mask = false;
        if (T >= 4) { const int klo = (T - 4) * 64, qlo = qpos0 + wid * 32;
            active = !(klo > qlo + 31 + 128 || klo + 63 < qlo - 128);
            need_mask = (klo < qlo + 31 - 128) || (klo + 63 > qlo + 128); }
        if (active) {
#pragma unroll
            for (int h = 0; h < NH; ++h) {
                __builtin_amdgcn_sched_barrier(0);
                f32x16 s0, s1;
#pragma unroll
                for (int i = 0; i < 16; ++i) { s0[i] = -mref; s1[i] = -mref; }
#pragma unroll
                for (int ks = 0; ks < 4; ++ks) { const bf16x8 k0 = *(const bf16x8*)(kfp + kb + 16 * ks), k1 = *(const bf16x8*)(kfp + kb + 32 * KSTR + 16 * ks);
                    s0 = __builtin_amdgcn_mfma_f32_32x32x16_bf16(k0, qf[h][ks], s0, 0, 0, 0); s1 = __builtin_amdgcn_mfma_f32_32x32x16_bf16(k1, qf[h][ks], s1, 0, 0, 0); }
                if (need_mask) { const int qp = qpos0 + wid * 32 + r, kp0 = (T - 4) * 64 + 4 * h2;
#pragma unroll
                    for (int i = 0; i < 16; ++i) { const int d0 = kp0 + (i & 3) + 8 * (i >> 2) - qp, d1 = d0 + 32;
                        if (d0 > 128 || d0 < -128) s0[i] = -1e30f; if (d1 > 128 || d1 < -128) s1[i] = -1e30f; } }
                float rs = 0.f; unsigned pk[16];
#pragma unroll
                for (int j = 0; j < 8; ++j) { const float a0 = __builtin_amdgcn_exp2f(s0[2 * j]), a1 = __builtin_amdgcn_exp2f(s0[2 * j + 1]), b0 = __builtin_amdgcn_exp2f(s1[2 * j]), b1 = __builtin_amdgcn_exp2f(s1[2 * j + 1]);
                    rs += (a0 + a1) + (b0 + b1); pk[j] = pk2(a0, a1); pk[8 + j] = pk2(b0, b1); }
                lrun[h] += rs;
                __builtin_amdgcn_sched_barrier(0);
#pragma unroll
                for (int q = 0; q < 4; ++q) { const u32x4 pw = {pk[4 * q], pk[4 * q + 1], pk[4 * q + 2], pk[4 * q + 3]}; const bf16x8 pf = __builtin_bit_cast(bf16x8, pw);
#pragma unroll
                    for (int dt = 0; dt < 2; ++dt) { const bf16x8 vf = *(const bf16x8*)(vfp + vb + (32 * dt) * VSTR + 16 * q);
                        o[h][dt] = __builtin_amdgcn_mfma_f32_32x32x16_bf16(vf, pf, o[h][dt], 0, 0, 0); } }
            }
        }
        __syncthreads();
    }
#undef W_TILE
#undef W_LOAD
#undef W_WRITE
#pragma unroll
    for (int h = 0; h < NH; ++h) { float l = lrun[h]; l += __shfl_xor(l, 32); const float inv = 1.f / l;
        bf16_t* orow = O + (size_t)(wid * 32 + r) * 1024 + h * 64;
#pragma unroll
        for (int dt = 0; dt < 2; ++dt)
#pragma unroll
            for (int g = 0; g < 4; ++g)
                *(u32x2*)(orow + 32 * dt + 8 * g + 4 * h2) = (u32x2){pk2(o[h][dt][4 * g] * inv, o[h][dt][4 * g + 1] * inv), pk2(o[h][dt][4 * g + 2] * inv, o[h][dt][4 * g + 3] * inv)}; }
    __syncthreads();
}

DI void s5_kk_phase(char* lds, const Params& p) {
    const int tid512 = get_tid(); const int tid = tid512 & 255, s = tid >> 4, sp = tid & 15, dh = tid512 >> 8;
    f32x2* sbb = (f32x2*)lds;
    f32x2* scc = sbb + 1024;
    f32x2* spw = scc + 1024;
    const f32x2* POW = (const f32x2*)(p.ws + H_POW); const f32x2* BB = (const f32x2*)(p.ws + T_BBAR); float* KK = (float*)(p.ws + H_KK);
    for (int it = blockIdx.x; it < 32 * 2 * 4; it += gridDim.x) {
        const int dq = it & 3, dir = (it >> 2) & 1, g = it >> 3; const int dg = dir * 32 + g;
        __syncthreads();
        for (int i = tid512; i < 1024; i += NTHREADS) { sbb[i] = BB[(size_t)dg * 1024 + i]; scc[i] = (f32x2){p.in[18][(size_t)dg * 1024 + i], p.in[19][(size_t)dg * 1024 + i]}; }
        { const int i = tid512; spw[i] = POW[((size_t)dg * 33 + dq * 8 + (i >> 6)) * 64 + (i & 63)]; }
        __syncthreads();
        float acc[4] = {0.f, 0.f, 0.f, 0.f};
#pragma unroll 4
        for (int pp = 0; pp < 64; ++pp) { const f32x2 bb = sbb[pp * 16 + sp], cc = scc[s * 64 + pp];
#pragma unroll
            for (int q = 0; q < 4; ++q) { const f32x2 pw = spw[(dh * 4 + q) * 64 + pp];
                const float zr = pw[0] * bb[0] - pw[1] * bb[1], zi = pw[0] * bb[1] + pw[1] * bb[0];
                acc[q] += cc[0] * zr - cc[1] * zi; } }
#pragma unroll
        for (int q = 0; q < 4; ++q) KK[(size_t)((g * 2 + dir) * 32 + dq * 8 + dh * 4 + q) * 256 + tid] = acc[q];
    }
    __syncthreads();
}
DI void s5_w1a_phase(const Params& p) {
    const int tid = get_tid();
    const f32x2* POW = (const f32x2*)(p.ws + H_POW); const f32x2* BB = (const f32x2*)(p.ws + T_BBAR); bf16_t* W = (bf16_t*)(p.ws + H_W1A);
    for (int idx = blockIdx.x * NTHREADS + tid; idx < 2048 * 256; idx += gridDim.x * NTHREADS) {
        const int kq = idx & 63, n = (idx >> 6) & 255, g = idx >> 14;
        const int dir = n >> 7, ri = (n >> 6) & 1, pp = n & 63; const int e = (dir * 32 + g) * 64 + pp; const int tl = kq >> 1, s0 = (kq & 1) * 8;
        const f32x2 pw = POW[((size_t)(dir * 32 + g) * 33 + (dir ? tl : 31 - tl)) * 64 + pp];
        float v[8];
#pragma unroll
        for (int j = 0; j < 8; ++j) { const f32x2 bb = BB[e * 16 + s0 + j]; v[j] = ri ? pw[0] * bb[1] + pw[1] * bb[0] : pw[0] * bb[0] - pw[1] * bb[1]; }
        *(u32x4*)(W + ((size_t)g * 256 + n) * 512 + kq * 8) = (u32x4){pk2(v[0], v[1]), pk2(v[2], v[3]), pk2(v[4], v[5]), pk2(v[6], v[7])};
    }
}
DI void s5_w1b_phase(const Params& p) {
    const int tid = get_tid();
    const f32x2* __restrict__ POW = (const f32x2*)(p.ws + H_POW); const float* __restrict__ KK = (const float*)(p.ws + H_KK); bf16_t* __restrict__ W = (bf16_t*)(p.ws + A_W1B);
    const float* __restrict__ CRE = p.in[18]; const float* __restrict__ CIM = p.in[19]; const float* __restrict__ DSK = p.in[20];
    const int nbusy = (int)gridDim.x < 96 ? (int)gridDim.x : 96, nslots = nbusy + 4 * ((int)gridDim.x - nbusy);
    const int myslots = (int)blockIdx.x < nbusy ? 1 : 4, slot0 = (int)blockIdx.x < nbusy ? (int)blockIdx.x : nbusy + 4 * ((int)blockIdx.x - nbusy);
    for (int sj = 0; sj < myslots; ++sj)
#pragma unroll 2
    for (int idx = (slot0 + sj) * NTHREADS + tid; idx < 32 * 512 * 64; idx += nslots * NTHREADS) {
        const int kq = idx & 63, n = (idx >> 6) & 511, g = idx >> 15;
        const int tl = n >> 4, s = n & 15, tl2 = kq >> 1, s0 = (kq & 1) * 8;
        const int d0 = tl - tl2, d1 = tl2 - tl;
        const float* k0 = KK + (size_t)((g * 2 + 0) * 32 + (d0 < 0 ? 0 : d0)) * 256 + s * 16 + s0;
        const float* k1 = KK + (size_t)((g * 2 + 1) * 32 + (d1 < 0 ? 0 : d1)) * 256 + s * 16 + s0;
        const f32x4 a0 = *(const f32x4*)k0, a1 = *(const f32x4*)(k0 + 4), b0 = *(const f32x4*)k1, b1 = *(const f32x4*)(k1 + 4);
        const float w0 = d0 >= 0 ? 1.f : 0.f, w1 = d1 >= 0 ? 1.f : 0.f;
        f32x4 x0 = a0 * w0 + b0 * w1, x1 = a1 * w0 + b1 * w1;
        if (tl2 == tl && (s >> 3) == (kq & 1)) { const float dv = DSK[g * 16 + s];
#pragma unroll
            for (int j = 0; j < 4; ++j) { if (j == (s & 7)) x0[j] += dv; if (4 + j == (s & 7)) x1[j] += dv; } }
        *(u32x4*)(W + ((size_t)g * 512 + n) * 768 + kq * 8) = (u32x4){pk2(x0[0], x0[1]), pk2(x0[2], x0[3]), pk2(x1[0], x1[1]), pk2(x1[2], x1[3])};
    }
    for (int sj = 0; sj < myslots; ++sj)
#pragma unroll 2
    for (int idx = (slot0 + sj) * NTHREADS + tid; idx < 32 * 512 * 32; idx += nslots * NTHREADS) {
        const int kb = idx & 31, n = (idx >> 5) & 511, g = idx >> 14;
        const int tl = n >> 4, s = n & 15, k2 = kb * 8; const int dir = k2 >> 7, ri = (k2 >> 6) & 1, p0 = k2 & 63;
        const float* cre = CRE + ((size_t)(dir * 32 + g) * 16 + s) * 64 + p0; const float* cim = CIM + ((size_t)(dir * 32 + g) * 16 + s) * 64 + p0;
        const f32x2* pwp = POW + ((size_t)(dir * 32 + g) * 33 + (dir ? 32 - tl : tl + 1)) * 64 + p0;
        const f32x4 cr0 = *(const f32x4*)cre, cr1 = *(const f32x4*)(cre + 4), ci0 = *(const f32x4*)cim, ci1 = *(const f32x4*)(cim + 4);
        const f32x4 pa = *(const f32x4*)pwp, pb = *(const f32x4*)(pwp + 2), pc = *(const f32x4*)(pwp + 4), pd = *(const f32x4*)(pwp + 6);
        float v[8];
        const float pr[8] = {pa[0], pa[2], pb[0], pb[2], pc[0], pc[2], pd[0], pd[2]}, pi[8] = {pa[1], pa[3], pb[1], pb[3], pc[1], pc[3], pd[1], pd[3]};
#pragma unroll
        for (int j = 0; j < 8; ++j) { const float cr = j < 4 ? cr0[j & 3] : cr1[j & 3], ci = j < 4 ? ci0[j & 3] : ci1[j & 3];
            v[j] = ri ? -(cr * pi[j] + ci * pr[j]) : cr * pr[j] - ci * pi[j]; }
        *(u32x4*)(W + ((size_t)g * 512 + n) * 768 + 512 + kb * 8) = (u32x4){pk2(v[0], v[1]), pk2(v[2], v[3]), pk2(v[4], v[5]), pk2(v[6], v[7])};
    }
}
DI void s5_carry_phase(const Params& p) {
    const int tid_ = get_tid(); const int lane = tid_ & 63, wid = tid_ >> 6;
    const f32x2* POW = (const f32x2*)(p.ws + H_POW); const float* E = (const float*)(p.ws + H_E); bf16_t* UA = (bf16_t*)(p.ws + H_UA);
    for (int it = ((int)gridDim.x - 1 - (int)blockIdx.x) * NWV + wid; it < 2 * 2 * 32; it += gridDim.x * NWV) {
        const int g = it & 31, dir = (it >> 5) & 1, b = it >> 6;
        const f32x2 l32 = POW[((size_t)(dir * 32 + g) * 33 + 32) * 64 + lane];
        float hr = 0.f, hi = 0.f;
        float er[8], ei[8], fr_[8], fi_[8];
#define C_IDX(i_) ((size_t)g * CHR + b * NCK + (dir ? ((i_) < 8 ? 7 - (i_) : NCK - 1 - ((i_) - 8)) : (i_)))
#define C_LOAD(R, I, i0_) do { _Pragma("unroll") for (int j = 0; j < 8; ++j) { const size_t m = C_IDX((i0_) + j); R[j] = E[m * 256 + dir * 128 + lane]; I[j] = E[m * 256 + dir * 128 + 64 + lane]; } } while (0)
#define C_STEP(R, I, i0_) do { _Pragma("unroll") for (int j = 0; j < 8; ++j) { const size_t m = C_IDX((i0_) + j); bf16_t* u = UA + m * 768 + 512 + dir * 128 + lane; \
            u[0] = (bf16_t)(pk2(hr, 0.f) & 0xffff); u[64] = (bf16_t)(pk2(hi, 0.f) & 0xffff); \
            const float nr = l32[0] * hr - l32[1] * hi + R[j], ni = l32[0] * hi + l32[1] * hr + I[j]; hr = nr; hi = ni; } } while (0)
        C_LOAD(er, ei, 0);
        for (int i0 = 0; i0 < NCK; i0 += 16) {
            if (i0 + 8 < NCK) C_LOAD(fr_, fi_, i0 + 8);
            C_STEP(er, ei, i0);
            if (i0 + 8 < NCK) { if (i0 + 16 < NCK) C_LOAD(er, ei, i0 + 16); C_STEP(fr_, fi_, i0 + 8); }
        }
#undef C_IDX
#undef C_LOAD
#undef C_STEP
    }
}

DI float rope64(float x, int lane, const float* ROPE, int rpos, int cpos) {
    const float partner = __shfl_xor(x, 16);
    const int i = lane & 15; const int pos = lane < 32 ? rpos : cpos;
    const float c = ROPE[(pos * 16 + i) * 2], s = ROPE[(pos * 16 + i) * 2 + 1];
    return (lane & 16) ? x * c + partner * s : x * c - partner * s;
}
DI void mla_prep_phase(const Params& p) {
    const int tid_ = get_tid(); const int lane = tid_ & 63, wid = tid_ >> 6;
    bf16_t* QR = (bf16_t*)(p.ws + S_QRAW); const bf16_t* KN = (const bf16_t*)(p.ws + S_KNOPE); const float* KR = (const float*)(p.ws + H_KR);
    bf16_t* KA = (bf16_t*)(p.ws + S_KA); const float* ROPE = (const float*)(p.ws + T_ROPE);
    const float qsc = 0.07216878364870323f * LOG2E;
    const float qg0 = p.in[27][lane], qg1 = p.in[27][64 + lane], qg2 = p.in[27][128 + lane];
    const float kg0 = p.in[28][lane], kg1 = p.in[28][64 + lane], kg2 = p.in[28][128 + lane];
    const int nbusy = (int)gridDim.x < 192 ? (int)gridDim.x : 192, nslots = nbusy + 3 * ((int)gridDim.x - nbusy);
    const int myslots = (int)blockIdx.x < nbusy ? 1 : 3, slot0 = (int)blockIdx.x < nbusy ? (int)blockIdx.x : nbusy + 3 * ((int)blockIdx.x - nbusy);
    for (int sj = 0; sj < myslots; ++sj)
    for (int r = (slot0 + sj) * NWV + wid; r < NR; r += nslots * NWV) {
        const bool lat = r >= NCTX; const int b = row_batch(r), tp = row_tpos(r); const int t = tp - CTX;
        const bf16_t* q = QR + (size_t)r * 768; const bf16_t* kn = KN + (size_t)r * 512;
        float x[4][3], k[4][3];
        const float krv = KR[(size_t)r * 64 + lane];
#pragma unroll
        for (int h = 0; h < 4; ++h) { x[h][0] = bf2f(q[h * 192 + lane]); x[h][1] = bf2f(q[h * 192 + 64 + lane]); x[h][2] = bf2f(q[h * 192 + 128 + lane]);
            k[h][0] = bf2f(kn[h * 128 + lane]); k[h][1] = bf2f(kn[h * 128 + 64 + lane]); k[h][2] = krv; }
        float rc = 1.f, rsn = 0.f;
        if (lat) { const int pos = lane < 32 ? (t >> 6) : (t & 63); rc = ROPE[(pos * 16 + (lane & 15)) * 2]; rsn = ROPE[(pos * 16 + (lane & 15)) * 2 + 1]; }
        const float sgn = (lane & 16) ? 1.f : -1.f;
#pragma unroll
        for (int h = 0; h < 4; ++h) {
            float ss = wave_sum(x[h][0] * x[h][0] + x[h][1] * x[h][1] + x[h][2] * x[h][2]);
            float rs = rsqrtf(ss * (1.f / 192.f) + 1e-6f) * qsc;
            const float x0 = x[h][0] * rs * qg0, x1 = x[h][1] * rs * qg1; float x2 = x[h][2] * rs * qg2;
            x2 = x2 * rc + sgn * __shfl_xor(x2, 16) * rsn;
            bf16_t* qd = QR + (size_t)r * 768 + h * 192;
            qd[lane] = (bf16_t)(pk2(x0, 0.f) & 0xffff); qd[64 + lane] = (bf16_t)(pk2(x1, 0.f) & 0xffff); qd[128 + lane] = (bf16_t)(pk2(x2, 0.f) & 0xffff);
            ss = wave_sum(k[h][0] * k[h][0] + k[h][1] * k[h][1] + k[h][2] * k[h][2]);
            rs = rsqrtf(ss * (1.f / 192.f) + 1e-6f);
            const float k0 = k[h][0] * rs * kg0, k1 = k[h][1] * rs * kg1; float k2 = k[h][2] * rs * kg2;
            k2 = k2 * rc + sgn * __shfl_xor(k2, 16) * rsn;
            bf16_t* kd = KA + ((size_t)(b * 4 + h) * TK + tp) * 192;
            kd[lane] = (bf16_t)(pk2(k0, 0.f) & 0xffff); kd[64 + lane] = (bf16_t)(pk2(k1, 0.f) & 0xffff); kd[128 + lane] = (bf16_t)(pk2(k2, 0.f) & 0xffff);
        }
    }
}

__global__ void __launch_bounds__(NTHREADS, 2) fwd_kernel(Params p) {
    extern __shared__ __attribute__((aligned(16))) char lds[];
    cg::grid_group grid = cg::this_grid();
    char* ws = p.ws;
    const bf16_t* WB = (const bf16_t*)ws;
    const float* MOD = (const float*)(ws + T_MOD);
    float* H = (float*)(ws + OFF_H);
    bf16_t* A0 = (bf16_t*)(ws + OFF_A0);
    const int bid = blockIdx.x, nb = gridDim.x;
    volatile LAS unsigned* xst = (volatile LAS unsigned*)(lds + (LDS_BYTES - 16));
    if (threadIdx.x == 0) { xst[0] = 0u; xst[1] = 0u; }
    __syncthreads();
    const XcdBarrier xb = xcd_barrier_post((unsigned*)(ws + T_BAR), xst);
    if (p.pad == 0x7fffffff) grid.sync();
#define GRID_SYNC() xcd_barrier(xb)

    { const int npair = p.jobs[4].tile0 >> 1, nit = 192 + 12 + npair;
      for (int it = bid; it < nit; it += nb) {
          if (it < 192) ada_item(lds, p, it);
          else if (it < 204) tables_item(p, it - 192);
          else { const int lt0 = (it - 204) * 2 + (int)(threadIdx.x >> 8); const bool live = lt0 < p.jobs[4].tile0; const int lt = live ? lt0 : 0; int j = 0;
#pragma unroll
              for (int q = 1; q < 11; ++q) if (lt >= p.jobs[q].tile0) j = q;
              transpose_tile(lds, ws, p.jobs[j], lt - p.jobs[j].tile0, live); } } }
    GRID_SYNC();
    modulate_rows(p, 0, 0, true, 0);
    s5_kk_phase(lds, p);
    GRID_SYNC();
    { EpiWin0 e{(bf16_t*)(ws + H_UA), (bf16_t*)(ws + S_CQN), (bf16_t*)(ws + S_CKVN), (float*)(ws + S_SSP), (float*)(ws + H_KR)};
      pg8::EpiHead<EpiWin0> pe{e}; pg8::gemm_phase((LAS unsigned char*)lds, pg8::Gemm{A0, WB + W_IN0, 1024, 1024}, pg8::Order{0, NR / 256, 5, (int)nb, (int)bid}, pe); }
    s5_w1a_phase(p);
    { int rk, nrk; slack_rank((NR / 256) * 5, rk, nrk); transpose_range(lds, ws, p, p.jobs[4].tile0, p.jobs[7].tile0, rk, nrk); }
    GRID_SYNC();
    s5_w1b_phase(p);
    { EpiS1a e{(float*)(ws + H_E)};
      (void)e; pg8::EpiS1a pe{(float*)(ws + H_E)}; pg8::gemm_phase((LAS unsigned char*)lds, pg8::Gemm{(const bf16_t*)(ws + H_UA), (const bf16_t*)(ws + H_W1A), 768, 512, (size_t)CHR * 768, (size_t)256 * 512}, pg8::Order{0, 3, 1, (int)nb, (int)bid, 32}, pe); }
    { int rk, nrk; slack_rank(96, rk, nrk); transpose_range(lds, ws, p, p.jobs[7].tile0, p.jobs[9].tile0, rk, nrk); }
    GRID_SYNC();
    s5_carry_phase(p);
    { EpiBf16 e{(bf16_t*)(ws + S_QRAW), 768, (const float*)(ws + S_SSP)};
      gemm_phase(lds, (const bf16_t*)(ws + S_CQN), 384, WB + W_QB, 384, 0, NR / 256, 3, e); }
    { EpiKV e{(bf16_t*)(ws + S_KNOPE), (bf16_t*)(ws + S_VT), (const float*)(ws + S_SSP)};
      gemm_phase(lds, (const bf16_t*)(ws + S_CKVN), 256, WB + W_KVB, 256, 0, NR / 256, 4, e, 1, 0, 0, 1, nb > 64 ? (int)nb - 16 : 0); }
    GRID_SYNC();
    { EpiS1b e{(bf16_t*)(ws + S_YG)};
      (void)e; pg8::EpiS1b pe{(bf16_t*)(ws + S_YG)}; pg8::gemm_phase((LAS unsigned char*)lds, pg8::Gemm{(const bf16_t*)(ws + H_UA), (const bf16_t*)(ws + A_W1B), 768, 768, (size_t)CHR * 768, (size_t)512 * 768}, pg8::Order{0, 3, 2, (int)nb, (int)bid, 32}, pe); }
    mla_prep_phase(p);
    GRID_SYNC();
    { const bf16_t* QR = (const bf16_t*)(ws + S_QRAW); const bf16_t* KA = (const bf16_t*)(ws + S_KA); const bf16_t* VT = (const bf16_t*)(ws + S_VT);
      const int nlat = 2 * 4 * 32, nall = nlat + 2 * 4;
      float mref; { float gq = 0.f, gk = 0.f;
        for (int d_ = 0; d_ < 192; ++d_) { gq = fmaxf(gq, fabsf(p.in[27][d_])); gk = fmaxf(gk, fabsf(p.in[28][d_])); }
        mref = 13.856406f * LOG2E * 1.02f * gq * gk; }
      for (int it0 = bid; it0 < nlat + nb; it0 += nb) {
          const int it = it0 < nlat ? it0 : nlat + (it0 - nlat) - (nb - 8);
          if (it0 >= nlat && (it < nlat || it >= nall)) continue;
          if (it < nlat) { const int h = it & 3, b = (it >> 2) & 1, qb = it >> 3;   const size_t row = NCTX + (size_t)b * SEQ + qb * 256;
              attn_item<192, 128, false>(lds, QR + row * 768 + h * 192, 768, KA + (size_t)(b * 4 + h) * TK * 192, VT + (size_t)(b * 4 + h) * 128 * TK, 0, TK / 64, 0, 0, mref, 0.f,
                                         A0 + row * 1024 + 512 + h * 128, 1024, 0); }
          else { const int j = it - nlat; const int h = j & 3, b = j >> 2; const size_t row = (size_t)b * CTX;
              attn_item<192, 128, false>(lds, QR + row * 768 + h * 192, 768, KA + (size_t)(b * 4 + h) * TK * 192, VT + (size_t)(b * 4 + h) * 128 * TK, 0, 4, 0, 0, mref, 0.f,
                                         A0 + row * 1024 + 512 + h * 128, 1024, 0); } }
      EpiGLU e{(const bf16_t*)(ws + S_YG), p.in[22], A0};
      gemm_phase(lds, (const bf16_t*)(ws + S_YG), 512, WB + W_GLU, 512, 0, NR / 256, 2, e); }
    GRID_SYNC();
    { EpiRes e{p.in[2], p.in[0], H, H + (size_t)NCTX * 1024, MOD + 0 * 3 * 6144 + 2048, 0};
      (void)e; { pg8::EpiRes pe{p.in[0], H + (size_t)NCTX * 1024, MOD + 0 * 3 * 6144 + 2048}; pg8::gemm_phase((LAS unsigned char*)lds, pg8::Gemm{A0, WB + W_OUT0, 1024, 1024}, pg8::Order{2, NLAT / 256, 4, (int)nb, (int)bid}, pe); }
      thin_gemm_ctx<4>(lds, A0, 1024, WB + W_OUT0, 1024, p.in[2], H, MOD + 0 * 3 * 6144 + 2048); }
    GRID_SYNC();
    modulate_rows(p, 0, 1, false, 0);
    GRID_SYNC();
    { EpiSwiGLU e{(bf16_t*)(ws + S_HID)};
      (void)e; pg8::EpiSwiGLU pe{(bf16_t*)(ws + S_HID)}; pg8::gemm_phase((LAS unsigned char*)lds, pg8::Gemm{A0, WB + W_GU0, 1024, 1024}, pg8::Order{0, NR / 256, 22, (int)nb, (int)bid}, pe); }
    { int rk, nrk; slack_rank((NR / 256) * 22, rk, nrk); transpose_range(lds, ws, p, p.jobs[9].tile0, p.jobs[9].tile0 + 704, rk, nrk); }
    GRID_SYNC();
    { EpiRes e{H, H + (size_t)NCTX * 1024, H, H + (size_t)NCTX * 1024, MOD + 0 * 3 * 6144 + 5120, 0};
      (void)e; { pg8::EpiRes pe{H + (size_t)NCTX * 1024, H + (size_t)NCTX * 1024, MOD + 0 * 3 * 6144 + 5120}; pg8::gemm_phase((LAS unsigned char*)lds, pg8::Gemm{(const bf16_t*)(ws + S_HID), WB + W_D0, FH, FH}, pg8::Order{2, NLAT / 256, 4, (int)nb, (int)bid}, pe); }
      thin_gemm_ctx<11>(lds, (const bf16_t*)(ws + S_HID), FH, WB + W_D0, FH, H, H, MOD + 0 * 3 * 6144 + 5120); }
    GRID_SYNC();
    modulate_rows(p, 1, 0, false, 0);
    GRID_SYNC();
    { EpiWin1 e{(bf16_t*)(ws + S1_Q), (bf16_t*)(ws + S1_K), (bf16_t*)(ws + S1_VT), p.in[31], p.in[32], (const float*)(ws + T_ROPE)};
      pg8::EpiHead<EpiWin1> pe{e}; pg8::gemm_phase((LAS unsigned char*)lds, pg8::Gemm{A0, WB + W_IN1, 1024, 1024}, pg8::Order{0, NR / 256, 6, (int)nb, (int)bid}, pe); }
    { int rk, nrk; slack_rank((NR / 256) * 6, rk, nrk); transpose_range(lds, ws, p, p.jobs[9].tile0 + 704, p.njobtiles, rk, nrk); }
    GRID_SYNC();
    { const bf16_t* Q = (const bf16_t*)(ws + S1_Q); const bf16_t* K1 = (const bf16_t*)(ws + S1_K); const bf16_t* VT = (const bf16_t*)(ws + S1_VT);
      constexpr int WNH = 2;
      const int nit = 2 * 4 * (4 / WNH) * 32;
      float mref; { float gq = 0.f, gk = 0.f;
        for (int d_ = 0; d_ < 64; ++d_) { gq = fmaxf(gq, fabsf(p.in[31][d_])); gk = fmaxf(gk, fabsf(p.in[32][d_])); }
        mref = 8.f * LOG2E * 1.02f * gq * gk; }
      for (int it = bid; it < nit; it += nb) { const int kvh = it & 3, b = (it >> 2) & 1, rest = it >> 3; const int gp = rest % (4 / WNH), i = rest / (4 / WNH); const int hq0 = kvh * 4 + gp * WNH;
          const size_t row = NCTX + (size_t)b * SEQ + i * 256;
          const int l0 = (4 * i - 2) < 0 ? 0 : (4 * i - 2), l1 = (4 * i + 6) > 128 ? 128 : (4 * i + 6);
          win_attn_item<WNH>(lds, Q + row * 1024 + hq0 * 64, K1 + (size_t)(b * 4 + kvh) * TK * 64, VT + (size_t)(b * 4 + kvh) * 64 * TK, 4 + l0, 4 + l1, mref, p.in[33] + hq0, A0 + row * 1024 + hq0 * 64, i * 256); } }
    GRID_SYNC();
    { EpiRes e{H, H + (size_t)NCTX * 1024, nullptr, H + (size_t)NCTX * 1024, MOD + 1 * 3 * 6144 + 2048, 0};
      (void)e; pg8::EpiRes pe{H + (size_t)NCTX * 1024, H + (size_t)NCTX * 1024, MOD + 1 * 3 * 6144 + 2048}; pg8::gemm_phase((LAS unsigned char*)lds, pg8::Gemm{A0, WB + W_OUT1, 1024, 1024}, pg8::Order{2, NLAT / 256, 4, (int)nb, (int)bid}, pe); }
    GRID_SYNC();
    modulate_rows(p, 1, 1, false, NCTX);
    GRID_SYNC();
    { EpiSwiGLU e{(bf16_t*)(ws + S_HID)};
      (void)e; pg8::EpiSwiGLU pe{(bf16_t*)(ws + S_HID)}; pg8::gemm_phase((LAS unsigned char*)lds, pg8::Gemm{A0, WB + W_GU1, 1024, 1024}, pg8::Order{2, NLAT / 256, 22, (int)nb, (int)bid}, pe); }
    GRID_SYNC();
    { EpiRes e{H, H + (size_t)NCTX * 1024, nullptr, p.out, MOD + 1 * 3 * 6144 + 5120, 0};
      (void)e; pg8::EpiRes pe{H + (size_t)NCTX * 1024, p.out, MOD + 1 * 3 * 6144 + 5120}; pg8::gemm_phase((LAS unsigned char*)lds, pg8::Gemm{(const bf16_t*)(ws + S_HID), WB + W_D1, FH, FH}, pg8::Order{2, NLAT / 256, 4, (int)nb, (int)bid}, pe); }
}

extern "C" void kernel_launch(void* const* d_in, const int* in_sizes, int n_in, void* d_out, int out_size, void* d_ws, size_t ws_size, hipStream_t stream) {
    static int grid_blocks = 0;
    if (grid_blocks == 0) {
        if (n_in != 34 || ws_size < WS_NEED2) { fprintf(stderr, "kernel_launch: unexpected n_in %d / ws %zu (need %zu)\n", n_in, ws_size, (size_t)WS_NEED2); grid_blocks = -1; return; }
        int dev = 0, cus = 0, per_cu = 0;
        (void)hipGetDevice(&dev);
        (void)hipDeviceGetAttribute(&cus, hipDeviceAttributeMultiprocessorCount, dev);
        (void)hipFuncSetAttribute((const void*)fwd_kernel, hipFuncAttributeMaxDynamicSharedMemorySize, LDS_BYTES);
        (void)hipOccupancyMaxActiveBlocksPerMultiprocessor(&per_cu, (const void*)fwd_kernel, NTHREADS, LDS_BYTES);
        if (per_cu < 1) { fprintf(stderr, "kernel_launch: occupancy query returned %d\n", per_cu); grid_blocks = -1; return; }
        if (per_cu > 1) per_cu = 1;
        grid_blocks = cus * per_cu;
        fprintf(stderr, "kernel_launch: grid %d (%d CUs x %d)\n", grid_blocks, cus, per_cu);
    }
    if (grid_blocks < 0) return;
    Params p{};
    for (int i = 0; i < 34; ++i) p.in[i] = (const float*)d_in[i];
    p.out = (float*)d_out; p.ws = (char*)d_ws;
    const float* fg = p.in[8]; const float* fu = p.in[9]; const float* fd = p.in[10];
    const size_t FW = (size_t)1024 * FH;
    int t0 = 0;
    auto mk = [&](int idx, const float* a, const float* b, size_t dst, int K, int ld, int npad, int mode) {
        Job& j = p.jobs[idx]; j.a = a; j.b = b; j.ks = nullptr; j.dst = dst; j.K = K; j.ld = ld; j.ntk = K / 64; j.ntn = npad / 64; j.tile0 = t0; j.mode = mode; t0 += j.ntk * j.ntn; };
    mk(0, p.in[11], nullptr, W_IN0, 1024, 1216, 1280, 2);
    mk(1, p.in[24], nullptr, W_QB, 384, 768, 768, 0);
    mk(2, p.in[26], nullptr, W_KVB, 256, 1024, 1024, 0);
    p.jobs[1].ks = p.in[23]; p.jobs[2].ks = p.in[25];
    mk(3, p.in[21], nullptr, W_GLU, 512, 512, 512, 0);
    mk(4, p.in[12], nullptr, W_OUT0, 1024, 1024, 1024, 0);
    mk(5, fg, fu, W_GU0, 1024, FH, 5632, 1);
    mk(6, fd, nullptr, W_D0, FH, 1024, 1024, 0);
    mk(7, p.in[29], nullptr, W_IN1, 1024, 1536, 1536, 2);
    mk(8, p.in[30], nullptr, W_OUT1, 1024, 1024, 1024, 0);
    mk(9, fg + FW, fu + FW, W_GU1, 1024, FH, 5632, 1);
    mk(10, fd + FW, nullptr, W_D1, FH, 1024, 1024, 0);
    p.njobtiles = t0;
    if (hipMemsetAsync((char*)d_ws + T_BAR, 0, XCD_BAR_WORDS * 4, stream) != hipSuccess) { fprintf(stderr, "kernel_launch: memset failed\n"); return; }
    void* args[] = {&p};
    hipError_t e = hipLaunchCooperativeKernel((const void*)fwd_kernel, dim3(grid_blocks), dim3(NTHREADS), args, LDS_BYTES, stream);
    if (e != hipSuccess) fprintf(stderr, "cooperative launch failed: %s (grid %d)\n", hipGetErrorString(e), grid_blocks);
}
```

```cpp
#include <hip/hip_runtime.h>
#include <hip/hip_cooperative_groups.h>
#include <cstdio>
#include <cstdint>
namespace cg = cooperative_groups;

#define DI __device__ __forceinline__
typedef unsigned short bf16_t;
typedef short bf16x8 __attribute__((ext_vector_type(8)));
typedef short s16x4 __attribute__((ext_vector_type(4)));
typedef float f32x4 __attribute__((ext_vector_type(4)));
typedef float f32x2 __attribute__((ext_vector_type(2)));
typedef float f32x16 __attribute__((ext_vector_type(16)));
typedef unsigned u32x4 __attribute__((ext_vector_type(4)));
typedef unsigned u32x2 __attribute__((ext_vector_type(2)));
typedef __bf16 bf16v2 __attribute__((ext_vector_type(2)));

constexpr int DM = 1024, NBATCH = 2, SEQ = 8192, CTX = 256;
constexpr int NCTX = NBATCH * CTX;
constexpr int NLAT = NBATCH * SEQ;
constexpr int NR = NCTX + NLAT;
constexpr int TK = CTX + SEQ;
constexpr int FH = 2816;
constexpr int NCH = TK / 64;
constexpr float LOG2E = 1.4426950408889634f;
constexpr int LDS_BYTES = 131072 + 64;
constexpr int NTHREADS = 512, NWV = 8;

constexpr size_t W_IN0 = 0;
constexpr size_t W_QB = W_IN0 + (size_t)1280 * 1024;
constexpr size_t W_KVB = W_QB + (size_t)768 * 384;
constexpr size_t W_GLU = W_KVB + (size_t)1024 * 256;
constexpr size_t W_OUT0 = W_GLU + (size_t)512 * 512;
constexpr size_t W_GU0 = W_OUT0 + (size_t)1024 * 1024;
constexpr size_t W_D0 = W_GU0 + (size_t)5632 * 1024;
constexpr size_t W_IN1 = W_D0 + (size_t)1024 * 2816;
constexpr size_t W_OUT1 = W_IN1 + (size_t)1536 * 1024;
constexpr size_t W_GU1 = W_OUT1 + (size_t)1024 * 1024;
constexpr size_t W_D1 = W_GU1 + (size_t)5632 * 1024;
constexpr size_t W_END = W_D1 + (size_t)1024 * 2816;
constexpr size_t OFF_TAB = W_END * 2;
constexpr size_t T_MOD = OFF_TAB;
constexpr size_t T_ROPE = T_MOD + 2 * 3 * 6144 * 4;
constexpr size_t T_LAMB = T_ROPE + 128 * 16 * 2 * 4;
constexpr size_t T_LAM64 = T_LAMB + 2 * 32 * 64 * 8;
constexpr size_t T_BBAR = T_LAM64 + 2 * 32 * 64 * 8;
constexpr size_t T_BAR = T_BBAR + (size_t)2 * 32 * 64 * 16 * 8;
constexpr size_t OFF_H = OFF_TAB + (1u << 20);
constexpr size_t OFF_A0 = OFF_H + (size_t)NR * 1024 * 4;
constexpr size_t OFF_S = OFF_A0 + (size_t)NR * 1024 * 2;
constexpr size_t WS_NEED = OFF_S + (size_t)108134400;
constexpr size_t S_SSP = WS_NEED;
constexpr size_t WS_NEED2 = S_SSP + (size_t)NR * 10 * 4;
static_assert(WS_NEED2 <= ((size_t)256 << 20) && OFF_S + (size_t)NR * FH * 2 <= WS_NEED, "workspace");
constexpr int SL = 32;
constexpr int NCK = TK / SL;
constexpr int CHR = NBATCH * NCK;
constexpr size_t H_UA = OFF_H;
constexpr size_t H_KR = H_UA + (size_t)(32 * CHR + 256) * 768 * 2;
constexpr size_t H_E = H_KR + (size_t)NR * 64 * 4;
constexpr size_t H_KK = H_E + (size_t)32 * CHR * 256 * 4;
constexpr size_t H_POW = H_KK + (size_t)32 * 2 * 32 * 256 * 4;
constexpr size_t H_W1A = H_POW + (size_t)4096 * 33 * 8;
static_assert(H_W1A + (size_t)32 * 256 * 512 * 2 <= OFF_A0, "H region overflow");
constexpr size_t A_W1B = OFF_A0;
constexpr size_t S_CQN = OFF_S;
constexpr size_t S_CKVN = S_CQN + (size_t)NR * 384 * 2;
constexpr size_t S_YG = OFF_S;
constexpr size_t S_X = S_CKVN + (size_t)NR * 256 * 2;
constexpr size_t S_CQKV = S_X;
constexpr size_t S_QRAW = S_X;
constexpr size_t S_KNOPE = S_QRAW + (size_t)NR * 768 * 2;
constexpr size_t S_VT = S_KNOPE + (size_t)NR * 512 * 2;
constexpr size_t S_KA = S_VT + (size_t)2 * 4 * 128 * TK * 2;
static_assert(S_CQKV + (size_t)NR * 640 * 4 <= S_VT, "CQKV overlaps VT");
static_assert(S_KA + (size_t)2 * 4 * TK * 192 * 2 <= WS_NEED, "scratch overflow");
constexpr size_t S_HID = OFF_S;
constexpr size_t S1_Q = OFF_S;
constexpr size_t S1_KRAW = S1_Q + (size_t)NR * 1024 * 2;
constexpr size_t S1_K = S1_KRAW + (size_t)NR * 256 * 4;
constexpr size_t S1_VT = S1_K + (size_t)2 * 4 * TK * 64 * 2;

struct Job { const float* a; const float* b; const float* ks; unsigned long long dst; int K, ld, ntk, ntn, tile0, mode; };
struct Params {
    const float* in[34];
    float* out;
    char* ws;
    Job jobs[11];
    int njobtiles;
    int pad;
};

DI int get_tid() { int t = threadIdx.x; asm volatile("" : "+v"(t)); return t; }
DI unsigned pk2(float lo, float hi) { f32x2 v = {lo, hi}; return __builtin_bit_cast(unsigned, __builtin_convertvector(v, bf16v2)); }
DI float bf2f(unsigned short b) { return __uint_as_float(((unsigned)b) << 16); }
DI f32x4 ld_bf4(const bf16_t* q) { const u32x2 w = *(const u32x2*)q; return (f32x4){__uint_as_float(w[0] << 16), __uint_as_float(w[0] & 0xffff0000u), __uint_as_float(w[1] << 16), __uint_as_float(w[1] & 0xffff0000u)}; }
DI void st_bf4(bf16_t* q, f32x4 v) { *(u32x2*)q = (u32x2){pk2(v[0], v[1]), pk2(v[2], v[3])}; }
DI float wave_sum(float v) {
#pragma unroll
    for (int o = 32; o > 0; o >>= 1) v += __shfl_xor(v, o);
    return v;
}
DI int row_vec(int r) { return r < NCTX ? 2 : (r - NCTX) / SEQ; }
DI int row_batch(int r) { return r < NCTX ? r / CTX : (r - NCTX) / SEQ; }
DI int row_tpos(int r) { return r < NCTX ? r % CTX : CTX + (r - NCTX) % SEQ; }
DI float sigmoidf_(float x) { return __builtin_amdgcn_rcpf(1.f + __expf(-x)); }
DI float siluf_(float x) { return x * __builtin_amdgcn_rcpf(1.f + __expf(-x)); }
DI float gelu_tanh(float y) { const float z = 0.7978845608028654f * (y + 0.044715f * y * y * y); const float t = 1.f - 2.f * __builtin_amdgcn_rcpf(1.f + __expf(2.f * z)); return 0.5f * y * (1.f + t); }
DI void my_sincos(float x, float& s, float& c) {
    const float q = rintf(x * 0.636619772367581f);
    float r = fmaf(-q, 1.5703125f, x);
    r = fmaf(-q, 4.837512969970703125e-4f, r);
    r = fmaf(-q, 7.54978995489188216e-8f, r);
    const int qi = (int)q;
    const float r2 = r * r;
    const float sp = r + r * r2 * (-1.6666654611e-1f + r2 * (8.3321608736e-3f + r2 * (-1.9515295891e-4f)));
    const float cp = 1.0f - 0.5f * r2 + r2 * r2 * (4.166664568298827e-2f + r2 * (-1.388731625493765e-3f + r2 * 2.443315711809948e-5f));
    const int k = qi & 3;
    s = (k == 0) ? sp : (k == 1) ? cp : (k == 2) ? -sp : -cp;
    c = (k == 0) ? cp : (k == 1) ? -sp : (k == 2) ? -cp : sp;
}


#define XB_TMO      128
#define XB_XCNT(j)  (256  + 64 * (j))
#define XB_XSUB(j)  (1280 + 64 * (j))
#define XB_XGEN(j)  (2304 + 64 * (j))
#define XB_TOP      3328
#define XB_TOPGEN   3392
#define XCD_BAR_WORDS 3456
#define XB_SPIN_CAP (1u << 22)
#define LAS __attribute__((address_space(3)))
DI unsigned xb_ld(unsigned* p) { return __hip_atomic_load(p, __ATOMIC_RELAXED, __HIP_MEMORY_SCOPE_AGENT); }
DI unsigned xb_add(unsigned* p, unsigned v) { return __hip_atomic_fetch_add(p, v, __ATOMIC_RELAXED, __HIP_MEMORY_SCOPE_AGENT); }
DI unsigned xb_xcc_id() { return (unsigned)__builtin_amdgcn_s_getreg((3 << 11) | 20) & 0xFu; }
#define XB_SPIN(cond, bar) do { unsigned _sp = 0; while (cond) { __builtin_amdgcn_s_sleep(1); \
    if ((++_sp & 255u) == 0u) { if (xb_ld(&(bar)[XB_TMO])) break; if (_sp > XB_SPIN_CAP) { atomicAdd(&(bar)[XB_TMO], 1u); break; } } } } while (0)
struct XcdBarrier { unsigned* bar; unsigned x; volatile LAS unsigned* st; };
DI XcdBarrier xcd_barrier_post(unsigned* bar, volatile LAS unsigned* st) {
    XcdBarrier b; b.bar = bar; b.x = xb_xcc_id(); b.st = st;
    if (threadIdx.x == 0) (void)xb_add(&bar[XB_XCNT(b.x)], 1u);
    return b;
}
DI void xcd_barrier_complete(unsigned* bar, unsigned x, unsigned& nloc, unsigned& nx) {
    const unsigned G = gridDim.x * gridDim.y * gridDim.z;
    unsigned sum, cnt, mine, sp = 0u;
    for (;;) {
        sum = 0u; cnt = 0u; mine = 0u;
#pragma unroll
        for (unsigned j = 0; j < 16; ++j) { const unsigned c = xb_ld(&bar[XB_XCNT(j)]); sum += c; cnt += (c > 0u) ? 1u : 0u; mine = (j == x) ? c : mine; }
        if (sum == G) break;
        __builtin_amdgcn_s_sleep(1);
        if ((++sp & 255u) == 0u) { if (xb_ld(&bar[XB_TMO])) break; if (sp > XB_SPIN_CAP) { atomicAdd(&bar[XB_TMO], 1u); break; } }
    }
    nloc = mine > 0u ? mine : 1u; nx = cnt > 0u ? cnt : 1u;
}
DI void xcd_barrier(const XcdBarrier& b) {
    asm volatile("s_waitcnt vmcnt(0)" ::: "memory");
    __syncthreads();
    if (threadIdx.x == 0) {
        unsigned* bar = b.bar;
        __builtin_amdgcn_s_waitcnt(0);
        unsigned nloc = b.st[0], nx = b.st[1];
        if (nloc == 0u) { xcd_barrier_complete(bar, b.x, nloc, nx); b.st[0] = nloc; b.st[1] = nx; }
        const unsigned old = xb_add(&bar[XB_XSUB(b.x)], 1u);
        const unsigned gen = old / nloc;
        if (old + 1u == (gen + 1u) * nloc) {
            __builtin_amdgcn_fence(__ATOMIC_RELEASE, "agent");
            asm volatile("s_waitcnt vmcnt(0)" ::: "memory");
            const unsigned og = xb_add(&bar[XB_TOP], 1u);
            const unsigned tg = og / nx;
            if (og + 1u == (tg + 1u) * nx) xb_add(&bar[XB_TOPGEN], 1u);
            else XB_SPIN(xb_ld(&bar[XB_TOPGEN]) == tg, bar);
            __builtin_amdgcn_fence(__ATOMIC_ACQUIRE, "agent");
            xb_add(&bar[XB_XGEN(b.x)], 1u);
            asm volatile("s_waitcnt vmcnt(0)" ::: "memory");
        } else {
            XB_SPIN(xb_ld(&bar[XB_XGEN(b.x)]) == gen, bar);
            __builtin_amdgcn_fence(__ATOMIC_ACQUIRE, "agent");
            asm volatile("s_waitcnt vmcnt(0)" ::: "memory");
        }
    }
    __syncthreads();
}

DI void transpose_tile(char* lds, char* ws, const Job& jb, int lt, bool live) {
    const int tid512 = get_tid(); const int tid = tid512 & 255;
    float (*tile)[65] = (float (*)[65])(lds + (tid512 >> 8) * 17408);
    const int tk = lt % jb.ntk, tn = lt / jb.ntk;
    const int k0 = tk * 64, n0 = tn * 64;
    const int c4 = (tid & 15) * 4, rq = tid >> 4;
    const float* src; int col; bool valid = live;
    if (jb.mode == 0) { src = jb.a; col = n0 + c4; valid = live && col < jb.ld; }
    else if (jb.mode == 2) { src = jb.a; const int rho = (n0 + c4) & 255; col = (n0 + c4 - rho) + 64 * ((rho >> 5) & 3) + 32 * (rho >> 7) + (rho & 31); valid = live && col < jb.ld; }
    else { const int nsub = c4 >> 4, i = c4 & 15; src = (nsub & 1) ? jb.b : jb.a; col = tn * 32 + (nsub >> 1) * 16 + i; }
#pragma unroll
    for (int kk = 0; kk < 4; ++kk) { const int k = kk * 16 + rq; f32x4 v = valid ? *(const f32x4*)(src + (size_t)(k0 + k) * jb.ld + col) : (f32x4){0.f, 0.f, 0.f, 0.f};
        if (jb.ks) v = v * jb.ks[k0 + k];
        tile[k][c4] = v[0]; tile[k][c4 + 1] = v[1]; tile[k][c4 + 2] = v[2]; tile[k][c4 + 3] = v[3]; }
    __syncthreads();
    const int r = tid >> 2, ks = (tid & 3) * 16;
    unsigned w[8];
#pragma unroll
    for (int q = 0; q < 8; ++q) w[q] = pk2(tile[ks + 2 * q][r], tile[ks + 2 * q + 1][r]);
    bf16_t* d = (bf16_t*)(ws) + jb.dst + (size_t)(n0 + r) * jb.K + k0 + ks;
    if (live) { *(u32x4*)d = (u32x4){w[0], w[1], w[2], w[3]};
    *(u32x4*)(d + 8) = (u32x4){w[4], w[5], w[6], w[7]}; }
    __syncthreads();
}

DI void transpose_range(char* lds, char* ws, const Params& p, int t_begin, int t_end, int rank, int nranks) {
    if (rank < 0) return;
    for (int pr = (t_begin >> 1) + rank; pr < (t_end >> 1); pr += nranks) {
        const int lt = pr * 2 + (int)(threadIdx.x >> 8); int j = 0;
#pragma unroll
        for (int q = 1; q < 11; ++q) if (lt >= p.jobs[q].tile0) j = q;
        transpose_tile(lds, ws, p.jobs[j], lt - p.jobs[j].tile0, true);
    }
}
DI void slack_rank(int ntile, int& rank, int& nranks) { const int rem = ntile % (int)gridDim.x; if (rem == 0) { rank = blockIdx.x; nranks = gridDim.x; } else { rank = (int)blockIdx.x - rem; nranks = (int)gridDim.x - rem; } }

DI void ada_item(char* lds, const Params& p, int it) {
    float* sil = (float*)lds;
    float* red = sil + 3072;
    float* MOD = (float*)(p.ws + T_MOD);
    const int tid = get_tid(), layer = it / 96, n0 = (it % 96) * 64;
    for (int i = tid; i < 3072; i += NTHREADS) { const int v = i >> 10, k = i & 1023; const float x = v < 2 ? p.in[1][v * 1024 + k] : p.in[3][k]; sil[i] = siluf_(x); }
    __syncthreads();
    const int j4 = (tid & 15) * 4, kg = tid >> 4;
    const float* W = p.in[4] + (size_t)layer * 1024 * 6144 + n0 + j4;
    f32x4 a0 = {0.f, 0.f, 0.f, 0.f}, a1 = a0, a2 = a0;
#pragma unroll 8
    for (int k = kg * 32; k < kg * 32 + 32; ++k) { const f32x4 w = *(const f32x4*)(W + (size_t)k * 6144); a0 += sil[k] * w; a1 += sil[1024 + k] * w; a2 += sil[2048 + k] * w; }
    *(f32x4*)(red + (kg * 3 + 0) * 64 + j4) = a0; *(f32x4*)(red + (kg * 3 + 1) * 64 + j4) = a1; *(f32x4*)(red + (kg * 3 + 2) * 64 + j4) = a2;
    __syncthreads();
    if (tid < 192) { const int v = tid >> 6, jj = tid & 63;
        float s = p.in[5][layer * 6144 + n0 + jj];
#pragma unroll 8
        for (int q = 0; q < 32; ++q) s += red[(q * 3 + v) * 64 + jj];
        MOD[(layer * 3 + v) * 6144 + n0 + jj] = s; }
    __syncthreads();
}

DI void tables_item(const Params& p, int it) {
    const int tid = get_tid();
    if (it < 4) {
        const int e = it * 512 + tid, pos = e >> 4, i = e & 15;
        const float inv = exp2f(-(float)i * (13.287712379549449f / 16.f));
        float s, c; my_sincos((float)pos * inv, s, c);
        float* ROPE = (float*)(p.ws + T_ROPE); ROPE[e * 2] = c; ROPE[e * 2 + 1] = s;
    } else {
        const int e = (it - 4) * 512 + tid;
        const int dg = e >> 6;
        const float lr = p.in[13][e], li = p.in[14][e], step = expf(p.in[15][dg]);
        const float a = lr * step, b = li * step;
        const float ea = expf(a);
        float sb, cb; my_sincos(b, sb, cb);
        float sh, ch; my_sincos(0.5f * b, sh, ch);
        const float em1 = a * (1.f + a * 0.5f * (1.f + a * (1.f / 3.f) * (1.f + a * 0.25f * (1.f + a * 0.2f * (1.f + a * (1.f / 6.f))))));
        const float lbr = ea * cb, lbi = ea * sb;
        const float nr = em1 * cb - 2.f * sh * sh, ni = ea * sb;
        const float den = lr * lr + li * li;
        const float qr = (nr * lr + ni * li) / den, qi = (ni * lr - nr * li) / den;
        f32x2* BB = (f32x2*)(p.ws + T_BBAR);
#pragma unroll
        for (int s = 0; s < 16; ++s) { const float br = p.in[16][e * 16 + s], bi = p.in[17][e * 16 + s]; BB[e * 16 + s] = (f32x2){qr * br - qi * bi, qr * bi + qi * br}; }
        f32x2* POW = (f32x2*)(p.ws + H_POW) + (size_t)dg * 33 * 64 + (e & 63);
        float pr = 1.f, pi = 0.f;
        for (int q = 0; q <= 32; ++q) { POW[q * 64] = (f32x2){pr, pi}; const float nr2 = pr * lbr - pi * lbi, ni2 = pr * lbi + pi * lbr; pr = nr2; pi = ni2; }
    }
}

DI void modulate_rows(const Params& p, int layer, int which, bool from_inputs, int r0) {
    const int tid_ = get_tid(); const int lane = tid_ & 63, wid = tid_ >> 6;
    const float* gain = p.in[which ? 7 : 6] + layer * 1024;
    const float* modl = (const float*)(p.ws + T_MOD) + layer * 3 * 6144 + (which ? 3072 : 0);
    const bf16_t* Hb = (const bf16_t*)(p.ws + OFF_H);
    bf16_t* dst = (bf16_t*)(p.ws + OFF_A0);
    const int stride = gridDim.x * NWV;
    for (int ra = r0 + blockIdx.x * NWV + wid; ra < NR; ra += 2 * stride) {
        const int rb = ra + stride; const bool hb = rb < NR; const int rbb = hb ? rb : ra;
        const float* srca = ra < NCTX ? p.in[2] + (size_t)ra * 1024 : p.in[0] + (size_t)(ra - NCTX) * 1024;
        const float* srcb = rbb < NCTX ? p.in[2] + (size_t)rbb * 1024 : p.in[0] + (size_t)(rbb - NCTX) * 1024;
        f32x4 xa[4], xb[4]; float sa = 0.f, sb = 0.f;
#pragma unroll
        for (int i = 0; i < 4; ++i) { if (from_inputs) { xa[i] = *(const f32x4*)(srca + i * 256 + lane * 4); xb[i] = *(const f32x4*)(srcb + i * 256 + lane * 4); }
                                      else { xa[i] = ld_bf4(Hb + (size_t)ra * 1024 + i * 256 + lane * 4); xb[i] = ld_bf4(Hb + (size_t)rbb * 1024 + i * 256 + lane * 4); } }
#pragma unroll
        for (int i = 0; i < 4; ++i) { sa += xa[i][0] * xa[i][0] + xa[i][1] * xa[i][1] + xa[i][2] * xa[i][2] + xa[i][3] * xa[i][3];
                                      sb += xb[i][0] * xb[i][0] + xb[i][1] * xb[i][1] + xb[i][2] * xb[i][2] + xb[i][3] * xb[i][3]; }
        sa = wave_sum(sa); sb = wave_sum(sb);
        const float rsa = rsqrtf(sa * (1.f / 1024.f) + 1e-6f), rsb = rsqrtf(sb * (1.f / 1024.f) + 1e-6f);
        const float* mva = modl + row_vec(ra) * 6144; const float* mvb = modl + row_vec(rbb) * 6144;
#pragma unroll
        for (int i = 0; i < 4; ++i) { const int c = i * 256 + lane * 4;
            const f32x4 g = *(const f32x4*)(gain + c);
            { const f32x4 sh = *(const f32x4*)(mva + c), sc = *(const f32x4*)(mva + 1024 + c); const f32x4 y = xa[i] * rsa * g * (1.f + sc) + sh;
              *(u32x2*)(dst + (size_t)ra * 1024 + c) = (u32x2){pk2(y[0], y[1]), pk2(y[2], y[3])}; }
            if (hb) { const f32x4 sh = *(const f32x4*)(mvb + c), sc = *(const f32x4*)(mvb + 1024 + c); const f32x4 y = xb[i] * rsb * g * (1.f + sc) + sh;
              *(u32x2*)(dst + (size_t)rb * 1024 + c) = (u32x2){pk2(y[0], y[1]), pk2(y[2], y[3])}; } }
    }
}

template <class Epi>
DI void gemm_phase(char* lds, const bf16_t* A0_, int lda, const bf16_t* Bt0_, int K, int mt0, int nmt, int nnt, const Epi& epi, int nbatch = 1, size_t sA = 0, size_t sB = 0, int ksplit = 1, int gact = 0) {
    const int tid = get_tid(), lane = tid & 63, wid = tid >> 6, wr = wid >> 2, wc = wid & 3, fr = lane & 15, fq = lane >> 4;
    const int nk = (K >> 6) / ksplit;
    const int lrow = tid >> 3, lc = tid & 7, lkc = lc * 8;
    const int woff = lrow * 128 + ((lc ^ ((lrow >> 1) & 7)) << 4);
    const int ra0 = (wr * 128 + fr) * 128 + ((fq ^ (fr >> 1)) << 4);
    const int ra1 = (wr * 128 + fr) * 128 + (((4 + fq) ^ (fr >> 1)) << 4);
    const int rb0 = 32768 + (wc * 64 + fr) * 128 + ((fq ^ (fr >> 1)) << 4);
    const int rb1 = 32768 + (wc * 64 + fr) * 128 + (((4 + fq) ^ (fr >> 1)) << 4);
    const int per = nmt * nnt, ntile = nbatch * per * ksplit;
    const int PM = nnt >= 8 ? 4 : 8;
    const int GA = gact > 0 ? gact : (int)gridDim.x;
    const int myn = ((int)blockIdx.x < GA && (int)blockIdx.x < ntile) ? (ntile - (int)blockIdx.x + GA - 1) / GA : 0;
    const int total = myn * nk;
    f32x4 acc[8][4];
#pragma unroll
    for (int m = 0; m < 8; ++m)
#pragma unroll
        for (int n = 0; n < 4; ++n) acc[m][n] = (f32x4){0.f, 0.f, 0.f, 0.f};
    int iti = 0, ikt = 0;
    const int srow = wid * 32 + (lane >> 3);
    const bf16_t* Ag = A0_; const bf16_t* Bg = Bt0_;
#define G_STAGE(bufoff) do { if (ikt == 0) { const int u_ = blockIdx.x + iti * GA; const int t_ = u_ / ksplit, sl_ = u_ - t_ * ksplit; const int gb_ = t_ / per, tr_ = t_ - gb_ * per; const int ch_ = tr_ / (PM * nnt), rm_ = tr_ - ch_ * PM * nnt; const int pc_ = (nmt - ch_ * PM) < PM ? (nmt - ch_ * PM) : PM; const int tn_ = rm_ / pc_, tm_ = ch_ * PM + (rm_ - tn_ * pc_); \
            Ag = A0_ + (size_t)gb_ * sA + (size_t)((mt0 + tm_) * 256) * lda + sl_ * nk * 64; Bg = Bt0_ + (size_t)gb_ * sB + (size_t)(tn_ * 256) * K + sl_ * nk * 64; } \
        _Pragma("unroll") for (int i = 0; i < 4; ++i) { const int row_ = srow + 8 * i; const int c_ = ((lane & 7) ^ ((row_ >> 1) & 7)) * 8; \
            __builtin_amdgcn_global_load_lds((const unsigned*)(Ag + (size_t)row_ * lda + ikt * 64 + c_), (LAS unsigned*)(lds + (bufoff) + (wid * 4 + i) * 1024), 16, 0, 0); \
            __builtin_amdgcn_global_load_lds((const unsigned*)(Bg + (size_t)row_ * K + ikt * 64 + c_), (LAS unsigned*)(lds + (bufoff) + 32768 + (wid * 4 + i) * 1024), 16, 0, 0); } \
        if (++ikt == nk) { ikt = 0; ++iti; } } while (0)
#define G_COMPUTE(bufoff) do { _Pragma("unroll") for (int ks = 0; ks < 2; ++ks) { bf16x8 a[8], b[4]; \
        _Pragma("unroll") for (int m = 0; m < 8; ++m) a[m] = *(const bf16x8*)(lds + (bufoff) + (ks ? ra1 : ra0) + m * 2048); \
        _Pragma("unroll") for (int n = 0; n < 4; ++n) b[n] = *(const bf16x8*)(lds + (bufoff) + (ks ? rb1 : rb0) + n * 2048); \
        _Pragma("unroll") for (int m = 0; m < 8; ++m) _Pragma("unroll") for (int n = 0; n < 4; ++n) acc[m][n] = __builtin_amdgcn_mfma_f32_16x16x32_bf16(b[n], a[m], acc[m][n], 0, 0, 0); } } while (0)
    __syncthreads();
    if (total > 0) G_STAGE(0);
    asm volatile("s_waitcnt vmcnt(0)" ::: "memory");
    __syncthreads();
    int cti = 0, ckt = 0;
    for (int q = 0; q < total; ++q) {
        const int cur = (q & 1) * 65536;
        if (q + 1 < total) G_STAGE(cur ^ 65536);
        G_COMPUTE(cur);
        asm volatile("s_waitcnt vmcnt(0)" ::: "memory");
        __syncthreads();
        if (++ckt == nk) {
            const int u_ = blockIdx.x + cti * GA; const int t_ = u_ / ksplit; const int gb_ = t_ / per, tr_ = t_ - gb_ * per; const int ch_ = tr_ / (PM * nnt), rm_ = tr_ - ch_ * PM * nnt; const int pc_ = (nmt - ch_ * PM) < PM ? (nmt - ch_ * PM) : PM; const int tn_ = rm_ / pc_, tm_ = ch_ * PM + (rm_ - tn_ * pc_);
            epi(acc, (mt0 + tm_) * 256 + wr * 128 + fr, tn_ * 256 + wc * 64 + fq * 4, gb_);
#pragma unroll
            for (int m = 0; m < 8; ++m)
#pragma unroll
                for (int n = 0; n < 4; ++n) acc[m][n] = (f32x4){0.f, 0.f, 0.f, 0.f};
            ckt = 0; ++cti;
        }
    }
#undef G_STAGE
#undef G_COMPUTE
}

template <int KSP>
DI void thin_gemm_ctx(char* lds, const bf16_t* A, int lda, const bf16_t* Bt, int K, const float* res_f, const bf16_t* res_h, bf16_t* dst, const float* gate) {
    const int tid = get_tid(), lane = tid & 63, wid = tid >> 6, fr = lane & 15, fq = lane >> 4;
    float* part = (float*)lds;
    for (int t = blockIdx.x; t < 256; t += gridDim.x) {
        const int m0 = (t >> 5) * 64, n0 = (t & 31) * 32;
        f32x4 acc[4][2];
#pragma unroll
        for (int m = 0; m < 4; ++m) { acc[m][0] = (f32x4){0.f, 0.f, 0.f, 0.f}; acc[m][1] = (f32x4){0.f, 0.f, 0.f, 0.f}; }
        const bf16_t* Ap = A + (size_t)(m0 + fr) * lda + wid * (KSP * 32) + fq * 8;
        const bf16_t* Bp = Bt + (size_t)(n0 + fr) * K + wid * (KSP * 32) + fq * 8;
#pragma unroll
        for (int k = 0; k < KSP; ++k) {
            bf16x8 a[4], b[2];
#pragma unroll
            for (int m = 0; m < 4; ++m) a[m] = *(const bf16x8*)(Ap + (size_t)m * 16 * lda + k * 32);
#pragma unroll
            for (int n = 0; n < 2; ++n) b[n] = *(const bf16x8*)(Bp + (size_t)n * 16 * K + k * 32);
#pragma unroll
            for (int m = 0; m < 4; ++m)
#pragma unroll
                for (int n = 0; n < 2; ++n) acc[m][n] = __builtin_amdgcn_mfma_f32_16x16x32_bf16(b[n], a[m], acc[m][n], 0, 0, 0);
        }
        __syncthreads();
#pragma unroll
        for (int m = 0; m < 4; ++m)
#pragma unroll
            for (int n = 0; n < 2; ++n) *(f32x4*)(part + ((wid * 64 + m * 16 + fr) * 32 + n * 16 + fq * 4)) = acc[m][n];
        __syncthreads();
        { const int row = tid >> 3, c4 = (tid & 7) * 4; f32x4 sum = (f32x4){0.f, 0.f, 0.f, 0.f};
#pragma unroll
          for (int w = 0; w < 8; ++w) sum += *(const f32x4*)(part + ((w * 64 + row) * 32 + c4));
          const size_t off = (size_t)(m0 + row) * 1024 + n0 + c4;
          const f32x4 g = *(const f32x4*)(gate + 2 * 6144 + n0 + c4), x = res_h ? ld_bf4(res_h + off) : *(const f32x4*)(res_f + off);
          st_bf4(dst + off, x + g * sum); }
    }
    __syncthreads();
}

struct EpiWin0 {
    bf16_t* UA; bf16_t* CQN; bf16_t* CKVN; float* SSP; float* KR;
    template <int NM> DI void run(const f32x4 (&acc)[NM][4], int row0, int col0) const {
        const int cw = col0 & ~63;
#pragma unroll
        for (int m = 0; m < NM; ++m) { const int ri = row0 + m * 16; const size_t r = ri;
            if (cw < 512) { const int b = row_batch(ri), tp = row_tpos(ri);
#pragma unroll
                for (int n = 0; n < 4; ++n) { const int c = col0 + n * 16; const f32x4 v = acc[m][n]; const int g = c >> 4, s0 = c & 15;
                    *(u32x2*)(UA + ((size_t)g * CHR + b * NCK + (tp >> 5)) * 768 + (tp & 31) * 16 + s0) = (u32x2){pk2(v[0], v[1]), pk2(v[2], v[3])}; }
            } else if (cw < 1152) { const bool isq = cw < 896; bf16_t* dst = isq ? CQN + r * 384 + (col0 - 512) : CKVN + r * 256 + (col0 - 896);
                float ss = 0.f;
#pragma unroll
                for (int n = 0; n < 4; ++n) { const f32x4 v = acc[m][n]; ss += v[0] * v[0] + v[1] * v[1] + v[2] * v[2] + v[3] * v[3];
                    *(u32x2*)(dst + n * 16) = (u32x2){pk2(v[0], v[1]), pk2(v[2], v[3])}; }
                ss += __shfl_xor(ss, 16); ss += __shfl_xor(ss, 32);
                if ((col0 & 15) == 0) SSP[r * 10 + ((cw - 512) >> 6)] = ss;
            } else if (cw < 1216) {
#pragma unroll
                for (int n = 0; n < 4; ++n) *(f32x4*)(KR + r * 64 + (col0 - 1152) + n * 16) = acc[m][n];
            } }
    }
    DI void operator()(const f32x4 (&acc)[8][4], int row0, int col0, int gb) const { run<8>(acc, row0, col0); }
};
struct EpiS1a {
    float* E;
    DI void operator()(const f32x4 (&acc)[8][4], int row0, int col0, int gb) const {
#pragma unroll
        for (int m = 0; m < 8; ++m) { const int r = row0 + m * 16; if (r >= CHR) continue;
#pragma unroll
            for (int n = 0; n < 4; ++n) *(f32x4*)(E + ((size_t)gb * CHR + r) * 256 + col0 + n * 16) = acc[m][n]; }
    }
};
struct EpiS1b {
    bf16_t* YG;
    DI void operator()(const f32x4 (&acc)[8][4], int row0, int col0, int gb) const {
#pragma unroll
        for (int m = 0; m < 8; ++m) { const int r = row0 + m * 16; if (r >= CHR) continue; const int b = r / NCK, c = r % NCK;
#pragma unroll
            for (int n = 0; n < 4; ++n) { const int cc = col0 + n * 16; const int tl = cc >> 4, s0 = cc & 15; const f32x4 v = acc[m][n];
                const int tp = c * SL + tl; const size_t row = tp < CTX ? (size_t)b * CTX + tp : (size_t)NCTX + (size_t)b * SEQ + (tp - CTX);
                *(u32x2*)(YG + row * 512 + gb * 16 + s0) = (u32x2){pk2(gelu_tanh(v[0]), gelu_tanh(v[1])), pk2(gelu_tanh(v[2]), gelu_tanh(v[3]))}; } }
    }
};
struct EpiBf16 {
    bf16_t* O; int ldo; const float* SSP;
    DI void operator()(const f32x4 (&acc)[8][4], int row0, int col0, int gb) const {
#pragma unroll
        for (int m = 0; m < 8; ++m) { const size_t r = row0 + m * 16; const float* sp = SSP + r * 10;
            const float rstd = rsqrtf(((sp[0] + sp[1]) + (sp[2] + sp[3]) + (sp[4] + sp[5])) * (1.f / 384.f) + 1e-6f);
#pragma unroll
            for (int n = 0; n < 4; ++n) { const int c = col0 + n * 16; const f32x4 v = acc[m][n] * rstd;
                *(u32x2*)(O + r * ldo + c) = (u32x2){pk2(v[0], v[1]), pk2(v[2], v[3])}; } }
    }
};
struct EpiKV {
    bf16_t* KNOPE; bf16_t* VT; const float* SSP;
    DI void operator()(const f32x4 (&acc)[8][4], int row0, int col0, int gb) const {
#pragma unroll
        for (int m = 0; m < 8; ++m) { const int r = row0 + m * 16; const int b = row_batch(r), tp = row_tpos(r); const float* sp = SSP + (size_t)r * 10 + 6;
            const float rstd = rsqrtf(((sp[0] + sp[1]) + (sp[2] + sp[3])) * (1.f / 256.f) + 1e-6f);
#pragma unroll
            for (int n = 0; n < 4; ++n) { const int c = col0 + n * 16; const int h = c >> 8, w = c & 255; const f32x4 v = acc[m][n] * rstd;
                if (w < 128) *(u32x2*)(KNOPE + (size_t)r * 512 + h * 128 + w) = (u32x2){pk2(v[0], v[1]), pk2(v[2], v[3])};
                else { bf16_t* d = VT + ((size_t)(b * 4 + h) * 128 + (w - 128)) * TK + tp; const unsigned p0 = pk2(v[0], v[1]), p1 = pk2(v[2], v[3]);
                    d[0] = (bf16_t)(p0 & 0xffff); d[TK] = (bf16_t)(p0 >> 16); d[2 * TK] = (bf16_t)(p1 & 0xffff); d[3 * TK] = (bf16_t)(p1 >> 16); } } }
    }
};
struct EpiGLU {
    const bf16_t* YG; const float* bias; bf16_t* CAT;
    DI void operator()(const f32x4 (&acc)[8][4], int row0, int col0, int gb) const {
#pragma unroll
        for (int m = 0; m < 8; ++m) { const size_t r = row0 + m * 16;
#pragma unroll
            for (int n = 0; n < 4; ++n) { const int c = col0 + n * 16; const f32x4 v = acc[m][n]; const f32x4 bv = *(const f32x4*)(bias + c);
                const u32x2 yy = *(const u32x2*)(YG + r * 512 + c);
                const float y0 = __uint_as_float(yy[0] << 16), y1 = __uint_as_float(yy[0] & 0xffff0000u), y2 = __uint_as_float(yy[1] << 16), y3 = __uint_as_float(yy[1] & 0xffff0000u);
                const float o0 = y0 * sigmoidf_(v[0] + bv[0]), o1 = y1 * sigmoidf_(v[1] + bv[1]), o2 = y2 * sigmoidf_(v[2] + bv[2]), o3 = y3 * sigmoidf_(v[3] + bv[3]);
                *(u32x2*)(CAT + r * 1024 + c) = (u32x2){pk2(o0, o1), pk2(o2, o3)}; } }
    }
};
struct EpiRes {
    const float* res_ctx; const float* res_lat; float* dst_ctx; float* dst_lat; const float* gate; int atomic;
    DI void operator()(const f32x4 (&acc)[8][4], int row0, int col0, int gb) const {
#pragma unroll
        for (int m = 0; m < 8; ++m) { const int r = row0 + m * 16;
            const float* rs = r < NCTX ? res_ctx + (size_t)r * 1024 : res_lat + (size_t)(r - NCTX) * 1024;
            float* ds = r < NCTX ? dst_ctx + (size_t)r * 1024 : dst_lat + (size_t)(r - NCTX) * 1024;
            if (r < NCTX && dst_ctx == nullptr) continue;
            const float* gv = gate + row_vec(r) * 6144;
#pragma unroll
            for (int n = 0; n < 4; ++n) { const int c = col0 + n * 16; const f32x4 g = *(const f32x4*)(gv + c);
                if (atomic) { const f32x4 v = g * acc[m][n];
#pragma unroll
                    for (int j = 0; j < 4; ++j) (void)__hip_atomic_fetch_add(ds + c + j, v[j], __ATOMIC_RELAXED, __HIP_MEMORY_SCOPE_AGENT); }
                else { const f32x4 x = *(const f32x4*)(rs + c); *(f32x4*)(ds + c) = x + g * acc[m][n]; } } }
    }
};
struct EpiSwiGLU {
    bf16_t* HID;
    DI void operator()(const f32x4 (&acc)[8][4], int row0, int col0, int gb) const {
        const int hc = (col0 >> 6) * 32 + (col0 & 15);
#pragma unroll
        for (int m = 0; m < 8; ++m) { const size_t r = row0 + m * 16;
#pragma unroll
            for (int q = 0; q < 2; ++q) { const f32x4 g = acc[m][2 * q], u = acc[m][2 * q + 1];
                const float o0 = siluf_(g[0]) * u[0], o1 = siluf_(g[1]) * u[1], o2 = siluf_(g[2]) * u[2], o3 = siluf_(g[3]) * u[3];
                *(u32x2*)(HID + r * FH + hc + q * 16) = (u32x2){pk2(o0, o1), pk2(o2, o3)}; } }
    }
};
struct EpiWin1 {
    bf16_t* Q; bf16_t* K1; bf16_t* VT; const float* qn; const float* kn; const float* ROPE;
    template <int NM> DI void run(const f32x4 (&acc)[NM][4], int row0, int col0) const {
        const int cw = col0 & ~63, i0 = col0 & 15;
        if (cw >= 1280) {
#pragma unroll
            for (int m = 0; m < NM; ++m) { const int r = row0 + m * 16; const int b = row_batch(r), tp = row_tpos(r);
#pragma unroll
                for (int n = 0; n < 4; ++n) { const int cc = col0 + n * 16 - 1280, h = cc >> 6, d0 = cc & 63; const f32x4 v = acc[m][n];
                    bf16_t* d = VT + ((size_t)(b * 4 + h) * 64 + d0) * TK + tp; const unsigned p0 = pk2(v[0], v[1]), p1 = pk2(v[2], v[3]);
                    d[0] = (bf16_t)(p0 & 0xffff); d[TK] = (bf16_t)(p0 >> 16); d[2 * TK] = (bf16_t)(p1 & 0xffff); d[3 * TK] = (bf16_t)(p1 >> 16); } }
            return;
        }
        const bool isq = cw < 1024;
        const float* gn = isq ? qn : kn;
        f32x4 g[4];
#pragma unroll
        for (int n = 0; n < 4; ++n) g[n] = *(const f32x4*)(gn + n * 16 + i0);
        const float osc = isq ? 0.125f * LOG2E : 1.f;
#pragma unroll
        for (int m = 0; m < NM; ++m) { const int r = row0 + m * 16; const bool lat = r >= NCTX;
            if (isq && !lat) continue;
            const int b = row_batch(r), tp = row_tpos(r), t = tp - CTX;
            float ss = 0.f;
#pragma unroll
            for (int n = 0; n < 4; ++n) { const f32x4 v = acc[m][n]; ss += v[0] * v[0] + v[1] * v[1] + v[2] * v[2] + v[3] * v[3]; }
            ss += __shfl_xor(ss, 16); ss += __shfl_xor(ss, 32);
            const float rstd = rsqrtf(ss * (1.f / 64.f) + 1e-6f);
            f32x4 y[4];
#pragma unroll
            for (int n = 0; n < 4; ++n) y[n] = acc[m][n] * rstd * g[n];
            if (lat) { const float* rr = ROPE + ((t >> 6) * 16 + i0) * 2; const float* rc = ROPE + ((t & 63) * 16 + i0) * 2;
#pragma unroll
                for (int j = 0; j < 4; ++j) { const float c0 = rr[2 * j], s0 = rr[2 * j + 1], c1 = rc[2 * j], s1 = rc[2 * j + 1];
                    const float a0 = y[0][j], a1 = y[1][j], a2 = y[2][j], a3 = y[3][j];
                    y[0][j] = a0 * c0 - a1 * s0; y[1][j] = a1 * c0 + a0 * s0; y[2][j] = a2 * c1 - a3 * s1; y[3][j] = a3 * c1 + a2 * s1; } }
            bf16_t* dst = isq ? Q + (size_t)r * 1024 + cw + i0 : K1 + ((size_t)(b * 4 + ((cw - 1024) >> 6)) * TK + tp) * 64 + i0;
#pragma unroll
            for (int n = 0; n < 4; ++n) *(u32x2*)(dst + n * 16) = (u32x2){pk2(y[n][0] * osc, y[n][1] * osc), pk2(y[n][2] * osc, y[n][3] * osc)};
        }
    }
    DI void operator()(const f32x4 (&acc)[8][4], int row0, int col0, int gb) const { run<8>(acc, row0, col0); }
};

namespace pg8 {
constexpr int BM = 256, BK = 64, HALF = 128, HTB = HALF * BK * 2;
DI int lds_byte(int r, int c) { const int st = (r >> 4) * 2 + (c >> 5), rr = r & 15, cc = c & 31, ob = rr * 64 + cc * 2; return st * 1024 + (ob ^ (((ob >> 9) & 1) << 5)); }
DI void stage_rc(int b, int& R, int& C) { const int st = b / 1024, sb = b % 1024, swz = sb ^ (((sb >> 9) & 1) << 5); R = (st >> 1) * 16 + swz / 64; C = (st & 1) * 32 + (swz % 64) / 2; }
struct Unit { int pm, pn, gb; };
struct Gemm { const bf16_t* A; const bf16_t* Bt; int lda, K; size_t sA = 0, sB = 0; };
struct Order {
    int mt0, nmt, nnt, G, c, nbatch = 1;
    DI bool next(int i, Unit& u) const { const int L0 = i * G + c; if (L0 >= nbatch * nmt * nnt) return false; constexpr int PM = 8; const int gb_ = L0 / (nmt * nnt); const int L = L0 - gb_ * nmt * nnt; u.gb = gb_;
        const int ch = L / (PM * nnt), rm = L - ch * PM * nnt; const int pc = (nmt - ch * PM) < PM ? (nmt - ch * PM) : PM; const int tn = rm / pc;
        u.pm = mt0 + ch * PM + (rm - tn * pc); u.pn = tn; return true; }
};
template <class Epi>
DI void gemm_phase(LAS unsigned char* lds, const Gemm g, const Order& S, const Epi& E) {
    const int tid = get_tid(), wid = __builtin_amdgcn_readfirstlane(tid >> 6), lane = tid & 63, wr = wid >> 2, wc = wid & 3, fr = lane & 15, fq = lane >> 4;
    const int K = g.K, nt = K / BK;
    unsigned voffA[2], voffB[2];
#pragma unroll
    for (int i = 0; i < 2; ++i) { int R, C; stage_rc(tid * 16 + i * 8192, R, C); voffA[i] = (unsigned)(R * g.lda + C) * 2u; voffB[i] = (unsigned)(R * K + C) * 2u; }
    const size_t kstep = (size_t)(BK * 2);
    const size_t hstepA = (size_t)HALF * g.lda * 2, hstepB = (size_t)HALF * K * 2;
    const size_t tstepA = 2 * hstepA, tstepB = 2 * hstepB;
    const unsigned ldsw = (unsigned)wid * 1024u;
    const int aoff = lds_byte(wr * 64 + fr, fq * 8), boff = lds_byte(wc * 32 + fr, fq * 8);
#define PG8_SA(b, h) (((b) * 2 + (h)) * HTB)
#define PG8_SB(b, h) ((4 + (b) * 2 + (h)) * HTB)
#define PG8_STAGE(bufoff, gbase, voff) do { _Pragma("unroll") for (int _i = 0; _i < 2; ++_i) \
        __builtin_amdgcn_global_load_lds((const unsigned*)((const char*)(gbase) + (voff)[_i]), (LAS unsigned*)(lds + (bufoff) + ldsw + _i * 8192), 16, 0, 0); } while (0)
#define PG8_LDA(dst, b, h) do { _Pragma("unroll") for (int m = 0; m < 4; ++m) _Pragma("unroll") for (int k = 0; k < 2; ++k) dst[m][k] = *(const LAS bf16x8*)(lds + PG8_SA(b, h) + aoff + m * 2048 + k * 1024); } while (0)
#define PG8_LDB(dst, b, h) do { _Pragma("unroll") for (int n = 0; n < 2; ++n) _Pragma("unroll") for (int k = 0; k < 2; ++k) dst[n][k] = *(const LAS bf16x8*)(lds + PG8_SB(b, h) + boff + n * 2048 + k * 1024); } while (0)
#define PG8_MMA(ai, bj, At, Bt) do { __builtin_amdgcn_s_setprio(1); _Pragma("unroll") for (int m = 0; m < 4; ++m) _Pragma("unroll") for (int n = 0; n < 2; ++n) _Pragma("unroll") for (int k = 0; k < 2; ++k) \
        acc[ai][bj][m][n] = __builtin_amdgcn_mfma_f32_16x16x32_bf16(Bt[n][k], At[m][k], acc[ai][bj][m][n], 0, 0, 0); __builtin_amdgcn_s_setprio(0); } while (0)
#define PG8_WAIT_V(n) asm volatile("s_waitcnt vmcnt(" #n ")" ::: "memory")
#define PG8_WAIT_L(n) asm volatile("s_waitcnt lgkmcnt(" #n ")" ::: "memory")
#define PG8_BAR __builtin_amdgcn_s_barrier()
#define PG8_SCHED __builtin_amdgcn_sched_barrier(0)
    Unit cur, nxt; int ui = 0;
    if (!S.next(0, cur)) return;
    f32x4 acc[2][2][4][2];
#pragma unroll
    for (int a = 0; a < 2; ++a)
#pragma unroll
        for (int b = 0; b < 2; ++b)
#pragma unroll
            for (int m = 0; m < 4; ++m)
#pragma unroll
                for (int n = 0; n < 2; ++n) acc[a][b][m][n] = (f32x4){0.f, 0.f, 0.f, 0.f};
    bf16x8 At[4][2], B0[2][2], B1[2][2];
    const char* cA = (const char*)(g.A + (size_t)cur.gb * g.sA) + (size_t)cur.pm * tstepA; const char* cB = (const char*)(g.Bt + (size_t)cur.gb * g.sB) + (size_t)cur.pn * tstepB;
    PG8_STAGE(PG8_SB(0, 0), cB, voffB); PG8_STAGE(PG8_SB(0, 1), cB + hstepB, voffB); PG8_STAGE(PG8_SA(0, 0), cA, voffA); PG8_STAGE(PG8_SA(0, 1), cA + hstepA, voffA);
    if (wr == 1) PG8_BAR;
    PG8_WAIT_V(2); PG8_BAR;
    PG8_STAGE(PG8_SB(1, 0), cB + kstep, voffB); PG8_STAGE(PG8_SA(1, 0), cA + kstep, voffA); PG8_STAGE(PG8_SB(1, 1), cB + hstepB + kstep, voffB);
    PG8_WAIT_V(6); PG8_BAR;
    for (;;) {
        const bool has_next = S.next(ui + 1, nxt);
        const char* nA = has_next ? (const char*)(g.A + (size_t)nxt.gb * g.sA) + (size_t)nxt.pm * tstepA : cA; const char* nB = has_next ? (const char*)(g.Bt + (size_t)nxt.gb * g.sB) + (size_t)nxt.pn * tstepB : cB;
        for (int t = 0; t < nt; t += 2) {
            const bool last = (t == nt - 2);
            const char* a1 = cA + (size_t)(t + 1) * kstep;
            const char* a2 = last ? nA : cA + (size_t)(t + 2) * kstep; const char* b2 = last ? nB : cB + (size_t)(t + 2) * kstep;
            const char* a3 = a2 + kstep; const char* b3 = b2 + kstep;
            PG8_LDB(B0, 0, 0); PG8_LDB(B1, 0, 1); PG8_SCHED; PG8_LDA(At, 0, 0); PG8_STAGE(PG8_SA(1, 1), a1 + hstepA, voffA);
            PG8_WAIT_V(8); PG8_WAIT_L(0); PG8_BAR; PG8_MMA(0, 0, At, B0); PG8_MMA(0, 1, At, B1); PG8_BAR; PG8_SCHED;
            PG8_LDA(At, 0, 1); PG8_STAGE(PG8_SB(0, 0), b2, voffB); PG8_STAGE(PG8_SB(0, 1), b2 + hstepB, voffB); PG8_STAGE(PG8_SA(0, 0), a2, voffA);
            PG8_WAIT_V(8); PG8_WAIT_L(0); PG8_BAR; PG8_MMA(1, 0, At, B0); PG8_MMA(1, 1, At, B1); PG8_BAR; PG8_SCHED;
            PG8_LDB(B0, 1, 0); PG8_LDB(B1, 1, 1); PG8_SCHED; PG8_LDA(At, 1, 0); PG8_STAGE(PG8_SA(0, 1), a2 + hstepA, voffA);
            PG8_WAIT_V(8); PG8_WAIT_L(0); PG8_BAR; PG8_MMA(0, 0, At, B0); PG8_MMA(0, 1, At, B1); PG8_BAR; PG8_SCHED;
            PG8_LDA(At, 1, 1); PG8_STAGE(PG8_SB(1, 0), b3, voffB); PG8_STAGE(PG8_SB(1, 1), b3 + hstepB, voffB); PG8_STAGE(PG8_SA(1, 0), a3, voffA);
            PG8_WAIT_V(8); PG8_WAIT_L(0); PG8_BAR; PG8_MMA(1, 0, At, B0); PG8_MMA(1, 1, At, B1); PG8_BAR; PG8_SCHED;
        }
        if (wr == 0) PG8_BAR;
        E(acc, cur, wr, wc, fr, fq);
        if (!has_next) break;
#pragma unroll
        for (int a = 0; a < 2; ++a)
#pragma unroll
            for (int b = 0; b < 2; ++b)
#pragma unroll
                for (int m = 0; m < 4; ++m)
#pragma unroll
                    for (int n = 0; n < 2; ++n) acc[a][b][m][n] = (f32x4){0.f, 0.f, 0.f, 0.f};
        cur = nxt; cA = nA; cB = nB; ++ui;
        if (wr == 1) PG8_BAR;
    }
    PG8_WAIT_V(0);
    PG8_BAR;
#undef PG8_SA
#undef PG8_SB
#undef PG8_STAGE
#undef PG8_LDA
#undef PG8_LDB
#undef PG8_MMA
#undef PG8_WAIT_V
#undef PG8_WAIT_L
#undef PG8_BAR
#undef PG8_SCHED
}
struct EpiRes {
    const float* res_f; const bf16_t* res_h; bf16_t* dst_h; float* dst_f; const float* gate;
    DI void operator()(const f32x4 (&acc)[2][2][4][2], const Unit& u, int wr, int wc, int fr, int fq) const {
        const int row0 = u.pm * 256 + wr * 64 + fr, col0 = u.pn * 256 + wc * 32 + fq * 4;
#pragma unroll
        for (int ai = 0; ai < 2; ++ai)
#pragma unroll
            for (int m = 0; m < 4; ++m) { const int r = row0 + 128 * ai + 16 * m; const size_t ro = (size_t)(r - NCTX) * 1024; const float* gv = gate + row_vec(r) * 6144;
#pragma unroll
                for (int bj = 0; bj < 2; ++bj)
#pragma unroll
                    for (int n = 0; n < 2; ++n) { const int c = col0 + 128 * bj + 16 * n; const f32x4 g_ = *(const f32x4*)(gv + c);
                        const f32x4 x = res_h ? ld_bf4(res_h + ro + c) : *(const f32x4*)(res_f + ro + c);
                        const f32x4 y = x + g_ * acc[ai][bj][m][n];
                        if (dst_h) st_bf4(dst_h + ro + c, y); else *(f32x4*)(dst_f + ro + c) = y; } }
    }
};
struct EpiSwiGLU {
    bf16_t* HID;
    DI void operator()(const f32x4 (&acc)[2][2][4][2], const Unit& u, int wr, int wc, int fr, int fq) const {
        const int row0 = u.pm * 256 + wr * 64 + fr, hc0 = u.pn * 128 + wc * 16 + fq * 4;
#pragma unroll
        for (int ai = 0; ai < 2; ++ai)
#pragma unroll
            for (int m = 0; m < 4; ++m) { const size_t r = row0 + 128 * ai + 16 * m;
#pragma unroll
                for (int bj = 0; bj < 2; ++bj) { const f32x4 g_ = acc[ai][bj][m][0], u_ = acc[ai][bj][m][1];
                    const float o0 = siluf_(g_[0]) * u_[0], o1 = siluf_(g_[1]) * u_[1], o2 = siluf_(g_[2]) * u_[2], o3 = siluf_(g_[3]) * u_[3];
                    *(u32x2*)(HID + r * FH + hc0 + 64 * bj) = (u32x2){pk2(o0, o1), pk2(o2, o3)}; } }
    }
};
struct EpiS1a {
    float* E;
    DI void operator()(const f32x4 (&acc)[2][2][4][2], const Unit& u, int wr, int wc, int fr, int fq) const {
        const int row0 = u.pm * 256 + wr * 64 + fr, col0 = u.pn * 256 + wc * 32 + fq * 4;
#pragma unroll
        for (int ai = 0; ai < 2; ++ai)
#pragma unroll
            for (int m = 0; m < 4; ++m) { const int r = row0 + 128 * ai + 16 * m; if (r >= CHR) continue;
#pragma unroll
                for (int bj = 0; bj < 2; ++bj)
#pragma unroll
                    for (int n = 0; n < 2; ++n) *(f32x4*)(E + ((size_t)u.gb * CHR + r) * 256 + col0 + 128 * bj + 16 * n) = acc[ai][bj][m][n]; }
    }
};
struct EpiS1b {
    bf16_t* YG;
    DI void operator()(const f32x4 (&acc)[2][2][4][2], const Unit& u, int wr, int wc, int fr, int fq) const {
        const int row0 = u.pm * 256 + wr * 64 + fr, col0 = u.pn * 256 + wc * 32 + fq * 4;
#pragma unroll
        for (int ai = 0; ai < 2; ++ai)
#pragma unroll
            for (int m = 0; m < 4; ++m) { const int r = row0 + 128 * ai + 16 * m; if (r >= CHR) continue; const int b = r / NCK, c = r % NCK;
#pragma unroll
                for (int bj = 0; bj < 2; ++bj)
#pragma unroll
                    for (int n = 0; n < 2; ++n) { const int cc = col0 + 128 * bj + 16 * n; const int tl = cc >> 4, s0 = cc & 15; const f32x4 v = acc[ai][bj][m][n];
                        const int tp = c * SL + tl; const size_t row = tp < CTX ? (size_t)b * CTX + tp : (size_t)NCTX + (size_t)b * SEQ + (tp - CTX);
                        *(u32x2*)(YG + row * 512 + u.gb * 16 + s0) = (u32x2){pk2(gelu_tanh(v[0]), gelu_tanh(v[1])), pk2(gelu_tanh(v[2]), gelu_tanh(v[3]))}; } }
    }
};
template <class E> struct EpiHead { E e;
    DI void operator()(const f32x4 (&acc)[2][2][4][2], const Unit& u, int wr, int wc, int fr, int fq) const {
#pragma unroll
        for (int ai = 0; ai < 2; ++ai) { f32x4 t[4][4];
#pragma unroll
            for (int m = 0; m < 4; ++m)
#pragma unroll
                for (int sb = 0; sb < 4; ++sb) t[m][sb] = acc[ai][sb >> 1][m][sb & 1];
            e.template run<4>(t, u.pm * 256 + 128 * ai + wr * 64 + fr, u.pn * 256 + wc * 64 + fq * 4); }
    }
};
}

template <int DQK, int DV, bool WIN>
DI void attn_item(char* lds, const bf16_t* Q, int qstride, const bf16_t* Kb, const bf16_t* VTb, int ta0, int ta1, int tb0, int tb1,
                  float mref, float l_init, bf16_t* O, int ostride, int qpos0) {
    constexpr int NKS = DQK / 16, NDT = DV / 32, KSTR = DQK + 8, VSTR = 72, NG = NKS;
    constexpr int KCH = 64 * DQK / 8 / NTHREADS, VCH = DV * 8 / NTHREADS;
    constexpr int KBUF = 64 * KSTR, VBUF = DV * VSTR;
    bf16_t* Ks = (bf16_t*)lds; bf16_t* Vs = Ks + 2 * KBUF;
    const int tid = get_tid(), lane = tid & 63, wid = tid >> 6, r = lane & 31, h2 = lane >> 5;
    bf16x8 qf[NKS];
    { const bf16_t* qrow = Q + (size_t)(wid * 32 + r) * qstride + 8 * h2;
#pragma unroll
      for (int ks = 0; ks < NKS; ++ks) qf[ks] = *(const bf16x8*)(qrow + 16 * ks); }
    f32x16 o[NDT];
#pragma unroll
    for (int dt = 0; dt < NDT; ++dt)
#pragma unroll
        for (int i = 0; i < 16; ++i) o[dt][i] = 0.f;
    float lrun = (h2 == 0) ? l_init : 0.f;
    const int na = ta1 - ta0, ntot = na + (tb1 - tb0);
    u32x4 kr[KCH], vr[VCH];
    constexpr int KTPR = (DQK / 8) / KCH, VTPR = 8 / VCH;
    const int krow = tid / KTPR, kcol = (tid % KTPR) * (KCH * 8);
    const int vrow = tid / VTPR, vcol = (tid % VTPR) * (VCH * 8);
    const bf16_t* kgp = Kb + (size_t)krow * DQK + kcol;
    const bf16_t* vgp = VTb + (size_t)vrow * TK + vcol;
    bf16_t* ksp = Ks + krow * KSTR + kcol;
    bf16_t* vsp = Vs + vrow * VSTR + vcol;
    const bf16_t* kfp = Ks + r * KSTR + 8 * h2;
    const bf16_t* vfp = Vs + r * VSTR + 8 * h2;
#define A_TILE(itv) (((itv) < na) ? ta0 + (itv) : tb0 + ((itv) - na))
#define K_LOAD(itv) do { const bf16_t* kg = kgp + (size_t)A_TILE(itv) * 64 * DQK; _Pragma("unroll") for (int i = 0; i < KCH; ++i) kr[i] = *(const u32x4*)(kg + i * 8); } while (0)
#define V_LOADG(itv) do { const bf16_t* vg = vgp + A_TILE(itv) * 64; _Pragma("unroll") for (int i = 0; i < VCH; ++i) vr[i] = *(const u32x4*)(vg + i * 8); } while (0)
#define K_WRITE(bo) do { _Pragma("unroll") for (int i = 0; i < KCH; ++i) *(u32x4*)(ksp + (bo) + i * 8) = kr[i]; } while (0)
#define V_WRITE(bo) do { _Pragma("unroll") for (int i = 0; i < VCH; ++i) { const int c_ = (vcol >> 3) + i; bf16_t* d_ = vsp - vcol + (bo) + (c_ >> 1) * 16 + (c_ & 1) * 4; \
            *(u32x2*)d_ = (u32x2){vr[i][0], vr[i][1]}; *(u32x2*)(d_ + 8) = (u32x2){vr[i][2], vr[i][3]}; } } while (0)
#define T_ACTIVE(itv) (!(WIN && A_TILE(itv) >= 4 && ((A_TILE(itv) - 4) * 64 > qpos0 + wid * 32 + 31 + 128 || (A_TILE(itv) - 4) * 64 + 63 < qpos0 + wid * 32 - 128)))
#define S_MASK(S0, S1, itv) do { if (WIN && A_TILE(itv) >= 4) { const int qp = qpos0 + wid * 32 + r, kp0 = (A_TILE(itv) - 4) * 64 + 4 * h2; \
        _Pragma("unroll") for (int i = 0; i < 16; ++i) { const int d0 = kp0 + (i & 3) + 8 * (i >> 2) - qp, d1 = d0 + 32; \
            if (d0 > 128 || d0 < -128) S0[i] = -1e30f; if (d1 > 128 || d1 < -128) S1[i] = -1e30f; } } } while (0)
    f32x16 s0, s1;
    __syncthreads();
    K_LOAD(0); K_WRITE(0);
    if (1 < ntot) K_LOAD(1);
    V_LOADG(0);
    __syncthreads();
#pragma unroll
    for (int i = 0; i < 16; ++i) { s0[i] = -mref; s1[i] = -mref; }
#pragma unroll 1
    for (int it = -1; it < ntot; ++it) {
        const int kb_n = ((it + 1) & 1) * KBUF, vb_c = (it & 1) * VBUF;
        if (it + 2 < ntot) K_WRITE((it & 1) * KBUF);
        if (it + 1 < ntot) V_WRITE(((it + 1) & 1) * VBUF);
        __builtin_amdgcn_sched_barrier(0);
        const bool act_c = (it >= 0) && T_ACTIVE(it), act_n = (it + 1 < ntot) && T_ACTIVE(it + 1);
        f32x16 n0, n1;
#pragma unroll
        for (int i = 0; i < 16; ++i) { n0[i] = -mref; n1[i] = -mref; }
        float rs = 0.f;
        unsigned pk[16];
#define P_PAIR(j) do { const float e0_ = __builtin_amdgcn_exp2f((j) < 8 ? s0[2 * ((j) & 7)] : s1[2 * ((j) & 7)]), e1_ = __builtin_amdgcn_exp2f((j) < 8 ? s0[2 * ((j) & 7) + 1] : s1[2 * ((j) & 7) + 1]); rs += e0_ + e1_; pk[j] = pk2(e0_, e1_); } while (0)
        if (act_c && act_n) {
#pragma unroll
            for (int g = 0; g < NG; ++g) {
                const bf16x8 ka = *(const bf16x8*)(kfp + kb_n + 16 * g), kb = *(const bf16x8*)(kfp + kb_n + 32 * KSTR + 16 * g);
                n0 = __builtin_amdgcn_mfma_f32_32x32x16_bf16(ka, qf[g], n0, 0, 0, 0);
                n1 = __builtin_amdgcn_mfma_f32_32x32x16_bf16(kb, qf[g], n1, 0, 0, 0);
#pragma unroll
                for (int j = (16 * g) / NG; j < (16 * (g + 1)) / NG; ++j) P_PAIR(j);
            }
            S_MASK(n0, n1, it + 1);
        } else {
            if (act_n) {
#pragma unroll
                for (int ks = 0; ks < NKS; ++ks) { const bf16x8 k0 = *(const bf16x8*)(kfp + kb_n + 16 * ks), k1 = *(const bf16x8*)(kfp + kb_n + 32 * KSTR + 16 * ks);
                    n0 = __builtin_amdgcn_mfma_f32_32x32x16_bf16(k0, qf[ks], n0, 0, 0, 0); n1 = __builtin_amdgcn_mfma_f32_32x32x16_bf16(k1, qf[ks], n1, 0, 0, 0); }
                S_MASK(n0, n1, it + 1);
            }
            if (act_c) {
#pragma unroll
                for (int j = 0; j < 16; ++j) P_PAIR(j);
            }
        }
#undef P_PAIR
        __builtin_amdgcn_sched_barrier(0);
        if (it + 3 < ntot) K_LOAD(it + 3);
        if (it + 2 < ntot) V_LOADG(it + 2);
        __builtin_amdgcn_sched_barrier(0);
        if (act_c) {
            lrun += rs;
#pragma unroll
            for (int q = 0; q < 4; ++q) {
                const u32x4 pw = {pk[4 * q], pk[4 * q + 1], pk[4 * q + 2], pk[4 * q + 3]};
                const bf16x8 pf = __builtin_bit_cast(bf16x8, pw);
#pragma unroll
                for (int dt = 0; dt < NDT; ++dt) { const bf16x8 vf = *(const bf16x8*)(vfp + vb_c + (32 * dt) * VSTR + 16 * q);
                    o[dt] = __builtin_amdgcn_mfma_f32_32x32x16_bf16(vf, pf, o[dt], 0, 0, 0); }
            }
        }
        s0 = n0; s1 = n1;
        __syncthreads();
    }
#undef A_TILE
#undef K_LOAD
#undef V_LOADG
#undef K_WRITE
#undef V_WRITE
#undef T_ACTIVE
#undef S_MASK
    lrun += __shfl_xor(lrun, 32);
    const float inv = 1.f / lrun;
    bf16_t* orow = O + (size_t)(wid * 32 + r) * ostride;
#pragma unroll
    for (int dt = 0; dt < NDT; ++dt)
#pragma unroll
        for (int g = 0; g < 4; ++g)
            *(u32x2*)(orow + 32 * dt + 8 * g + 4 * h2) = (u32x2){pk2(o[dt][4 * g] * inv, o[dt][4 * g + 1] * inv), pk2(o[dt][4 * g + 2] * inv, o[dt][4 * g + 3] * inv)};
    __syncthreads();
}

template <int NH>
DI void win_attn_item(char* lds, const bf16_t* Q, const bf16_t* Kb, const bf16_t* VTb, int tb0, int tb1, float mref, const float* sinkp, bf16_t* O, int qpos0) {
    constexpr int KSTR = 72, VSTR = 72, KBUF = 64 * KSTR, VBUF = 64 * VSTR;
    bf16_t* Ks = (bf16_t*)lds; bf16_t* Vs = Ks + 2 * KBUF;
    const int tid = get_tid(), lane = tid & 63, wid = tid >> 6, r = lane & 31, h2 = lane >> 5;
    bf16x8 qf[NH][4];
#pragma unroll
    for (int h = 0; h < NH; ++h) { const bf16_t* qrow = Q + (size_t)(wid * 32 + r) * 1024 + h * 64 + 8 * h2;
#pragma unroll
        for (int ks = 0; ks < 4; ++ks) qf[h][ks] = *(const bf16x8*)(qrow + 16 * ks); }
    f32x16 o[NH][2]; float lrun[NH];
#pragma unroll
    for (int h = 0; h < NH; ++h) { lrun[h] = (h2 == 0) ? __builtin_amdgcn_exp2f(sinkp[h] * LOG2E - mref) : 0.f;
#pragma unroll
        for (int dt = 0; dt < 2; ++dt)
#pragma unroll
            for (int i = 0; i < 16; ++i) o[h][dt][i] = 0.f; }
    const int na = 4, ntot = na + (tb1 - tb0);
    u32x4 kr, vr;
    const int krow = tid >> 3, kcol = (tid & 7) * 8;
    const bf16_t* kgp = Kb + (size_t)krow * 64 + kcol;
    const bf16_t* vgp = VTb + (size_t)krow * TK + kcol;
    bf16_t* ksp = Ks + krow * KSTR + kcol;
    bf16_t* vsp = Vs + krow * VSTR + (kcol >> 4) * 16 + ((kcol >> 3) & 1) * 4;
    const bf16_t* kfp = Ks + r * KSTR + 8 * h2;
    const bf16_t* vfp = Vs + r * VSTR + 8 * h2;
#define W_TILE(itv) (((itv) < na) ? (itv) : tb0 + ((itv) - na))
#define W_LOAD(itv) do { kr = *(const u32x4*)(kgp + (size_t)W_TILE(itv) * 64 * 64); vr = *(const u32x4*)(vgp + W_TILE(itv) * 64); } while (0)
#define W_WRITE(kb_, vb_) do { *(u32x4*)(ksp + (kb_)) = kr; *(u32x2*)(vsp + (vb_)) = (u32x2){vr[0], vr[1]}; *(u32x2*)(vsp + (vb_) + 8) = (u32x2){vr[2], vr[3]}; } while (0)
    __syncthreads();
    W_LOAD(0); W_WRITE(0, 0);
    if (1 < ntot) W_LOAD(1);
    __syncthreads();
#pragma unroll 1
    for (int it = 0; it < ntot; ++it) {
        const int T = W_TILE(it);
        const int kb = (it & 1) * KBUF, vb = (it & 1) * VBUF;
        if (it + 1 < ntot) W_WRITE(KBUF - kb, VBUF - vb);
        if (it + 2 < ntot) W_LOAD(it + 2);
        bool active = true, need_mask = false;
        if (T >= 4) { const int klo = (T - 4) * 64, qlo = qpos0 + wid * 32;
            active = !(klo > qlo + 31 + 128 || klo + 63 < qlo - 128);
            need_mask = (klo < qlo + 31 - 128) || (klo + 63 > qlo + 128); }
        if (active) {
#pragma unroll
            for (int h = 0; h < NH; ++h) {
                __builtin_amdgcn_sched_barrier(0);
                f32x16 s0, s1;
#pragma unroll
                for (int i = 0; i < 16; ++i) { s0[i] = -mref; s1[i] = -mref; }
#pragma unroll
                for (int ks = 0; ks < 4; ++ks) { const bf16x8 k0 = *(const bf16x8*)(kfp + kb + 16 * ks), k1 = *(const bf16x8*)(kfp + kb + 32 * KSTR + 16 * ks);
                    s0 = __builtin_amdgcn_mfma_f32_32x32x16_bf16(k0, qf[h][ks], s0, 0, 0, 0); s1 = __builtin_amdgcn_mfma_f32_32x32x16_bf16(k1, qf[h][ks], s1, 0, 0, 0); }
                if (need_mask) { const int qp = qpos0 + wid * 32 + r, kp0 = (T - 4) * 64 + 4 * h2;
#pragma unroll
                    for (int i = 0; i < 16; ++i) { const int d0 = kp0 + (i & 3) + 8 * (i >> 2) - qp, d1 = d0 + 32;
                        if (d0 > 128 || d0 < -128) s0[i] = -1e30f; if (d1 > 128 || d1 < -128) s1[i] = -1e30f; } }
                float rs = 0.f; unsigned pk[16];
#pragma unroll
                for (int j = 0; j < 8; ++j) { const float a0 = __builtin_amdgcn_exp2f(s0[2 * j]), a1 = __builtin_amdgcn_exp2f(s0[2 * j + 1]), b0 = __builtin_amdgcn_exp2f(s1[2 * j]), b1 = __builtin_amdgcn_exp2f(s1[2 * j + 1]);
                    rs += (a0 + a1) + (b0 + b1); pk[j] = pk2(a0, a1); pk[8 + j] = pk2(b0, b1); }
                lrun[h] += rs;
                __builtin_amdgcn_sched_barrier(0);
#pragma unroll
                for (int q = 0; q < 4; ++q) { const u32x4 pw = {pk[4 * q], pk[4 * q + 1], pk[4 * q + 2], pk[4 * q + 3]}; const bf16x8 pf = __builtin_bit_cast(bf16x8, pw);
#pragma unroll
                    for (int dt = 0; dt < 2; ++dt) { const bf16x8 vf = *(const bf16x8*)(vfp + vb + (32 * dt) * VSTR + 16 * q);
                        o[h][dt] = __builtin_amdgcn_mfma_f32_32x32x16_bf16(vf, pf, o[h][dt], 0, 0, 0); } }
            }
        }
        __syncthreads();
    }
#undef W_TILE
#undef W_LOAD
#undef W_WRITE
#pragma unroll
    for (int h = 0; h < NH; ++h) { float l = lrun[h]; l += __shfl_xor(l, 32); const float inv = 1.f / l;
        bf16_t* orow = O + (size_t)(wid * 32 + r) * 1024 + h * 64;
#pragma unroll
        for (int dt = 0; dt < 2; ++dt)
#pragma unroll
            for (int g = 0; g < 4; ++g)
                *(u32x2*)(orow + 32 * dt + 8 * g + 4 * h2) = (u32x2){pk2(o[h][dt][4 * g] * inv, o[h][dt][4 * g + 1] * inv), pk2(o[h][dt][4 * g + 2] * inv, o[h][dt][4 * g + 3] * inv)}; }
    __syncthreads();
}

DI void s5_kk_phase(char* lds, const Params& p) {
    const int tid512 = get_tid(); const int tid = tid512 & 255, s = tid >> 4, sp = tid & 15, dh = tid512 >> 8;
    f32x2* sbb = (f32x2*)lds;
    f32x2* scc = sbb + 1024;
    f32x2* spw = scc + 1024;
    const f32x2* POW = (const f32x2*)(p.ws + H_POW); const f32x2* BB = (const f32x2*)(p.ws + T_BBAR); float* KK = (float*)(p.ws + H_KK);
    for (int it = blockIdx.x; it < 32 * 2 * 4; it += gridDim.x) {
        const int dq = it & 3, dir = (it >> 2) & 1, g = it >> 3; const int dg = dir * 32 + g;
        __syncthreads();
        for (int i = tid512; i < 1024; i += NTHREADS) { sbb[i] = BB[(size_t)dg * 1024 + i]; scc[i] = (f32x2){p.in[18][(size_t)dg * 1024 + i], p.in[19][(size_t)dg * 1024 + i]}; }
        { const int i = tid512; spw[i] = POW[((size_t)dg * 33 + dq * 8 + (i >> 6)) * 64 + (i & 63)]; }
        __syncthreads();
        float acc[4] = {0.f, 0.f, 0.f, 0.f};
#pragma unroll 4
        for (int pp = 0; pp < 64; ++pp) { const f32x2 bb = sbb[pp * 16 + sp], cc = scc[s * 64 + pp];
#pragma unroll
            for (int q = 0; q < 4; ++q) { const f32x2 pw = spw[(dh * 4 + q) * 64 + pp];
                const float zr = pw[0] * bb[0] - pw[1] * bb[1], zi = pw[0] * bb[1] + pw[1] * bb[0];
                acc[q] += cc[0] * zr - cc[1] * zi; } }
#pragma unroll
        for (int q = 0; q < 4; ++q) KK[(size_t)((g * 2 + dir) * 32 + dq * 8 + dh * 4 + q) * 256 + tid] = acc[q];
    }
    __syncthreads();
}
DI void s5_w1a_phase(const Params& p) {
    const int tid = get_tid();
    const f32x2* POW = (const f32x2*)(p.ws + H_POW); const f32x2* BB = (const f32x2*)(p.ws + T_BBAR); bf16_t* W = (bf16_t*)(p.ws + H_W1A);
    for (int idx = blockIdx.x * NTHREADS + tid; idx < 2048 * 256; idx += gridDim.x * NTHREADS) {
        const int kq = idx & 63, n = (idx >> 6) & 255, g = idx >> 14;
        const int dir = n >> 7, ri = (n >> 6) & 1, pp = n & 63; const int e = (dir * 32 + g) * 64 + pp; const int tl = kq >> 1, s0 = (kq & 1) * 8;
        const f32x2 pw = POW[((size_t)(dir * 32 + g) * 33 + (dir ? tl : 31 - tl)) * 64 + pp];
        float v[8];
#pragma unroll
        for (int j = 0; j < 8; ++j) { const f32x2 bb = BB[e * 16 + s0 + j]; v[j] = ri ? pw[0] * bb[1] + pw[1] * bb[0] : pw[0] * bb[0] - pw[1] * bb[1]; }
        *(u32x4*)(W + ((size_t)g * 256 + n) * 512 + kq * 8) = (u32x4){pk2(v[0], v[1]), pk2(v[2], v[3]), pk2(v[4], v[5]), pk2(v[6], v[7])};
    }
}
DI void s5_w1b_phase(const Params& p) {
    const int tid = get_tid();
    const f32x2* __restrict__ POW = (const f32x2*)(p.ws + H_POW); const float* __restrict__ KK = (const float*)(p.ws + H_KK); bf16_t* __restrict__ W = (bf16_t*)(p.ws + A_W1B);
    const float* __restrict__ CRE = p.in[18]; const float* __restrict__ CIM = p.in[19]; const float* __restrict__ DSK = p.in[20];
#pragma unroll 2
    for (int idx = blockIdx.x * NTHREADS + tid; idx < 32 * 512 * 64; idx += gridDim.x * NTHREADS) {
        const int kq = idx & 63, n = (idx >> 6) & 511, g = idx >> 15;
        const int tl = n >> 4, s = n & 15, tl2 = kq >> 1, s0 = (kq & 1) * 8;
        const int d0 = tl - tl2, d1 = tl2 - tl;
        const float* k0 = KK + (size_t)((g * 2 + 0) * 32 + (d0 < 0 ? 0 : d0)) * 256 + s * 16 + s0;
        const float* k1 = KK + (size_t)((g * 2 + 1) * 32 + (d1 < 0 ? 0 : d1)) * 256 + s * 16 + s0;
        const f32x4 a0 = *(const f32x4*)k0, a1 = *(const f32x4*)(k0 + 4), b0 = *(const f32x4*)k1, b1 = *(const f32x4*)(k1 + 4);
        const float w0 = d0 >= 0 ? 1.f : 0.f, w1 = d1 >= 0 ? 1.f : 0.f;
        f32x4 x0 = a0 * w0 + b0 * w1, x1 = a1 * w0 + b1 * w1;
        if (tl2 == tl && (s >> 3) == (kq & 1)) { const float dv = DSK[g * 16 + s];
#pragma unroll
            for (int j = 0; j < 4; ++j) { if (j == (s & 7)) x0[j] += dv; if (4 + j == (s & 7)) x1[j] += dv; } }
        *(u32x4*)(W + ((size_t)g * 512 + n) * 768 + kq * 8) = (u32x4){pk2(x0[0], x0[1]), pk2(x0[2], x0[3]), pk2(x1[0], x1[1]), pk2(x1[2], x1[3])};
    }
#pragma unroll 2
    for (int idx = blockIdx.x * NTHREADS + tid; idx < 32 * 512 * 32; idx += gridDim.x * NTHREADS) {
        const int kb = idx & 31, n = (idx >> 5) & 511, g = idx >> 14;
        const int tl = n >> 4, s = n & 15, k2 = kb * 8; const int dir = k2 >> 7, ri = (k2 >> 6) & 1, p0 = k2 & 63;
        const float* cre = CRE + ((size_t)(dir * 32 + g) * 16 + s) * 64 + p0; const float* cim = CIM + ((size_t)(dir * 32 + g) * 16 + s) * 64 + p0;
        const f32x2* pwp = POW + ((size_t)(dir * 32 + g) * 33 + (dir ? 32 - tl : tl + 1)) * 64 + p0;
        const f32x4 cr0 = *(const f32x4*)cre, cr1 = *(const f32x4*)(cre + 4), ci0 = *(const f32x4*)cim, ci1 = *(const f32x4*)(cim + 4);
        const f32x4 pa = *(const f32x4*)pwp, pb = *(const f32x4*)(pwp + 2), pc = *(const f32x4*)(pwp + 4), pd = *(const f32x4*)(pwp + 6);
        float v[8];
        const float pr[8] = {pa[0], pa[2], pb[0], pb[2], pc[0], pc[2], pd[0], pd[2]}, pi[8] = {pa[1], pa[3], pb[1], pb[3], pc[1], pc[3], pd[1], pd[3]};
#pragma unroll
        for (int j = 0; j < 8; ++j) { const float cr = j < 4 ? cr0[j & 3] : cr1[j & 3], ci = j < 4 ? ci0[j & 3] : ci1[j & 3];
            v[j] = ri ? -(cr * pi[j] + ci * pr[j]) : cr * pr[j] - ci * pi[j]; }
        *(u32x4*)(W + ((size_t)g * 512 + n) * 768 + 512 + kb * 8) = (u32x4){pk2(v[0], v[1]), pk2(v[2], v[3]), pk2(v[4], v[5]), pk2(v[6], v[7])};
    }
}
DI void s5_carry_phase(const Params& p) {
    const int tid_ = get_tid(); const int lane = tid_ & 63, wid = tid_ >> 6;
    const f32x2* POW = (const f32x2*)(p.ws + H_POW); const float* E = (const float*)(p.ws + H_E); bf16_t* UA = (bf16_t*)(p.ws + H_UA);
    for (int it = ((int)gridDim.x - 1 - (int)blockIdx.x) * NWV + wid; it < 2 * 2 * 32; it += gridDim.x * NWV) {
        const int g = it & 31, dir = (it >> 5) & 1, b = it >> 6;
        const f32x2 l32 = POW[((size_t)(dir * 32 + g) * 33 + 32) * 64 + lane];
        float hr = 0.f, hi = 0.f;
        float er[8], ei[8], fr_[8], fi_[8];
#define C_IDX(i_) ((size_t)g * CHR + b * NCK + (dir ? ((i_) < 8 ? 7 - (i_) : NCK - 1 - ((i_) - 8)) : (i_)))
#define C_LOAD(R, I, i0_) do { _Pragma("unroll") for (int j = 0; j < 8; ++j) { const size_t m = C_IDX((i0_) + j); R[j] = E[m * 256 + dir * 128 + lane]; I[j] = E[m * 256 + dir * 128 + 64 + lane]; } } while (0)
#define C_STEP(R, I, i0_) do { _Pragma("unroll") for (int j = 0; j < 8; ++j) { const size_t m = C_IDX((i0_) + j); bf16_t* u = UA + m * 768 + 512 + dir * 128 + lane; \
            u[0] = (bf16_t)(pk2(hr, 0.f) & 0xffff); u[64] = (bf16_t)(pk2(hi, 0.f) & 0xffff); \
            const float nr = l32[0] * hr - l32[1] * hi + R[j], ni = l32[0] * hi + l32[1] * hr + I[j]; hr = nr; hi = ni; } } while (0)
        C_LOAD(er, ei, 0);
        for (int i0 = 0; i0 < NCK; i0 += 16) {
            if (i0 + 8 < NCK) C_LOAD(fr_, fi_, i0 + 8);
            C_STEP(er, ei, i0);
            if (i0 + 8 < NCK) { if (i0 + 16 < NCK) C_LOAD(er, ei, i0 + 16); C_STEP(fr_, fi_, i0 + 8); }
        }
#undef C_IDX
#undef C_LOAD
#undef C_STEP
    }
}

DI float rope64(float x, int lane, const float* ROPE, int rpos, int cpos) {
    const float partner = __shfl_xor(x, 16);
    const int i = lane & 15; const int pos = lane < 32 ? rpos : cpos;
    const float c = ROPE[(pos * 16 + i) * 2], s = ROPE[(pos * 16 + i) * 2 + 1];
    return (lane & 16) ? x * c + partner * s : x * c - partner * s;
}
DI void mla_prep_phase(const Params& p) {
    const int tid_ = get_tid(); const int lane = tid_ & 63, wid = tid_ >> 6;
    bf16_t* QR = (bf16_t*)(p.ws + S_QRAW); const bf16_t* KN = (const bf16_t*)(p.ws + S_KNOPE); const float* KR = (const float*)(p.ws + H_KR);
    bf16_t* KA = (bf16_t*)(p.ws + S_KA); const float* ROPE = (const float*)(p.ws + T_ROPE);
    const float qsc = 0.07216878364870323f * LOG2E;
    const float qg0 = p.in[27][lane], qg1 = p.in[27][64 + lane], qg2 = p.in[27][128 + lane];
    const float kg0 = p.in[28][lane], kg1 = p.in[28][64 + lane], kg2 = p.in[28][128 + lane];
    const int nbusy = (int)gridDim.x < 192 ? (int)gridDim.x : 192, nslots = nbusy + 3 * ((int)gridDim.x - nbusy);
    const int myslots = (int)blockIdx.x < nbusy ? 1 : 3, slot0 = (int)blockIdx.x < nbusy ? (int)blockIdx.x : nbusy + 3 * ((int)blockIdx.x - nbusy);
    for (int sj = 0; sj < myslots; ++sj)
    for (int r = (slot0 + sj) * NWV + wid; r < NR; r += nslots * NWV) {
        const bool lat = r >= NCTX; const int b = row_batch(r), tp = row_tpos(r); const int t = tp - CTX;
        const bf16_t* q = QR + (size_t)r * 768; const bf16_t* kn = KN + (size_t)r * 512;
        float x[4][3], k[4][3];
        const float krv = KR[(size_t)r * 64 + lane];
#pragma unroll
        for (int h = 0; h < 4; ++h) { x[h][0] = bf2f(q[h * 192 + lane]); x[h][1] = bf2f(q[h * 192 + 64 + lane]); x[h][2] = bf2f(q[h * 192 + 128 + lane]);
            k[h][0] = bf2f(kn[h * 128 + lane]); k[h][1] = bf2f(kn[h * 128 + 64 + lane]); k[h][2] = krv; }
        float rc = 1.f, rsn = 0.f;
        if (lat) { const int pos = lane < 32 ? (t >> 6) : (t & 63); rc = ROPE[(pos * 16 + (lane & 15)) * 2]; rsn = ROPE[(pos * 16 + (lane & 15)) * 2 + 1]; }
        const float sgn = (lane & 16) ? 1.f : -1.f;
#pragma unroll
        for (int h = 0; h < 4; ++h) {
            float ss = wave_sum(x[h][0] * x[h][0] + x[h][1] * x[h][1] + x[h][2] * x[h][2]);
            float rs = rsqrtf(ss * (1.f / 192.f) + 1e-6f) * qsc;
            const float x0 = x[h][0] * rs * qg0, x1 = x[h][1] * rs * qg1; float x2 = x[h][2] * rs * qg2;
            x2 = x2 * rc + sgn * __shfl_xor(x2, 16) * rsn;
            bf16_t* qd = QR + (size_t)r * 768 + h * 192;
            qd[lane] = (bf16_t)(pk2(x0, 0.f) & 0xffff); qd[64 + lane] = (bf16_t)(pk2(x1, 0.f) & 0xffff); qd[128 + lane] = (bf16_t)(pk2(x2, 0.f) & 0xffff);
            ss = wave_sum(k[h][0] * k[h][0] + k[h][1] * k[h][1] + k[h][2] * k[h][2]);
            rs = rsqrtf(ss * (1.f / 192.f) + 1e-6f);
            const float k0 = k[h][0] * rs * kg0, k1 = k[h][1] * rs * kg1; float k2 = k[h][2] * rs * kg2;
            k2 = k2 * rc + sgn * __shfl_xor(k2, 16) * rsn;
            bf16_t* kd = KA + ((size_t)(b * 4 + h) * TK + tp) * 192;
            kd[lane] = (bf16_t)(pk2(k0, 0.f) & 0xffff); kd[64 + lane] = (bf16_t)(pk2(k1, 0.f) & 0xffff); kd[128 + lane] = (bf16_t)(pk2(k2, 0.f) & 0xffff);
        }
    }
}

__global__ void __launch_bounds__(NTHREADS, 2) fwd_kernel(Params p) {
    extern __shared__ __attribute__((aligned(16))) char lds[];
    cg::grid_group grid = cg::this_grid();
    char* ws = p.ws;
    const bf16_t* WB = (const bf16_t*)ws;
    const float* MOD = (const float*)(ws + T_MOD);
    float* H = (float*)(ws + OFF_H);
    bf16_t* Hb = (bf16_t*)(ws + OFF_H);
    bf16_t* A0 = (bf16_t*)(ws + OFF_A0);
    const int bid = blockIdx.x, nb = gridDim.x;
    volatile LAS unsigned* xst = (volatile LAS unsigned*)(lds + (LDS_BYTES - 16));
    if (threadIdx.x == 0) { xst[0] = 0u; xst[1] = 0u; }
    __syncthreads();
    const XcdBarrier xb = xcd_barrier_post((unsigned*)(ws + T_BAR), xst);
    if (p.pad == 0x7fffffff) grid.sync();
#define GRID_SYNC() xcd_barrier(xb)

    { const int npair = p.jobs[4].tile0 >> 1, nit = 192 + 12 + npair;
      for (int it = bid; it < nit; it += nb) {
          if (it < 192) ada_item(lds, p, it);
          else if (it < 204) tables_item(p, it - 192);
          else { const int lt0 = (it - 204) * 2 + (int)(threadIdx.x >> 8); const bool live = lt0 < p.jobs[4].tile0; const int lt = live ? lt0 : 0; int j = 0;
#pragma unroll
              for (int q = 1; q < 11; ++q) if (lt >= p.jobs[q].tile0) j = q;
              transpose_tile(lds, ws, p.jobs[j], lt - p.jobs[j].tile0, live); } } }
    GRID_SYNC();
    modulate_rows(p, 0, 0, true, 0);
    s5_kk_phase(lds, p);
    GRID_SYNC();
    { EpiWin0 e{(bf16_t*)(ws + H_UA), (bf16_t*)(ws + S_CQN), (bf16_t*)(ws + S_CKVN), (float*)(ws + S_SSP), (float*)(ws + H_KR)};
      pg8::EpiHead<EpiWin0> pe{e}; pg8::gemm_phase((LAS unsigned char*)lds, pg8::Gemm{A0, WB + W_IN0, 1024, 1024}, pg8::Order{0, NR / 256, 5, (int)nb, (int)bid}, pe); }
    s5_w1a_phase(p);
    { int rk, nrk; slack_rank((NR / 256) * 5, rk, nrk); transpose_range(lds, ws, p, p.jobs[4].tile0, p.jobs[7].tile0, rk, nrk); }
    GRID_SYNC();
    s5_w1b_phase(p);
    { EpiS1a e{(float*)(ws + H_E)};
      (void)e; pg8::EpiS1a pe{(float*)(ws + H_E)}; pg8::gemm_phase((LAS unsigned char*)lds, pg8::Gemm{(const bf16_t*)(ws + H_UA), (const bf16_t*)(ws + H_W1A), 768, 512, (size_t)CHR * 768, (size_t)256 * 512}, pg8::Order{0, 3, 1, (int)nb, (int)bid, 32}, pe); }
    { int rk, nrk; slack_rank(96, rk, nrk); transpose_range(lds, ws, p, p.jobs[7].tile0, p.jobs[9].tile0, rk, nrk); }
    GRID_SYNC();
    s5_carry_phase(p);
    { EpiBf16 e{(bf16_t*)(ws + S_QRAW), 768, (const float*)(ws + S_SSP)};
      gemm_phase(lds, (const bf16_t*)(ws + S_CQN), 384, WB + W_QB, 384, 0, NR / 256, 3, e); }
    { EpiKV e{(bf16_t*)(ws + S_KNOPE), (bf16_t*)(ws + S_VT), (const float*)(ws + S_SSP)};
      gemm_phase(lds, (const bf16_t*)(ws + S_CKVN), 256, WB + W_KVB, 256, 0, NR / 256, 4, e, 1, 0, 0, 1, nb > 64 ? (int)nb - 16 : 0); }
    GRID_SYNC();
    { EpiS1b e{(bf16_t*)(ws + S_YG)};
      (void)e; pg8::EpiS1b pe{(bf16_t*)(ws + S_YG)}; pg8::gemm_phase((LAS unsigned char*)lds, pg8::Gemm{(const bf16_t*)(ws + H_UA), (const bf16_t*)(ws + A_W1B), 768, 768, (size_t)CHR * 768, (size_t)512 * 768}, pg8::Order{0, 3, 2, (int)nb, (int)bid, 32}, pe); }
    mla_prep_phase(p);
    GRID_SYNC();
    { const bf16_t* QR = (const bf16_t*)(ws + S_QRAW); const bf16_t* KA = (const bf16_t*)(ws + S_KA); const bf16_t* VT = (const bf16_t*)(ws + S_VT);
      const int nlat = 2 * 4 * 32, nall = nlat + 2 * 4;
      float mref; { float gq = 0.f, gk = 0.f;
        for (int d_ = 0; d_ < 192; ++d_) { gq = fmaxf(gq, fabsf(p.in[27][d_])); gk = fmaxf(gk, fabsf(p.in[28][d_])); }
        mref = 13.856406f * LOG2E * 1.02f * gq * gk; }
      for (int it0 = bid; it0 < nlat + nb; it0 += nb) {
          const int it = it0 < nlat ? it0 : nlat + (it0 - nlat) - (nb - 8);
          if (it0 >= nlat && (it < nlat || it >= nall)) continue;
          if (it < nlat) { const int h = it & 3, b = (it >> 2) & 1, qb = it >> 3;   const size_t row = NCTX + (size_t)b * SEQ + qb * 256;
              attn_item<192, 128, false>(lds, QR + row * 768 + h * 192, 768, KA + (size_t)(b * 4 + h) * TK * 192, VT + (size_t)(b * 4 + h) * 128 * TK, 0, TK / 64, 0, 0, mref, 0.f,
                                         A0 + row * 1024 + 512 + h * 128, 1024, 0); }
          else { const int j = it - nlat; const int h = j & 3, b = j >> 2; const size_t row = (size_t)b * CTX;
              attn_item<192, 128, false>(lds, QR + row * 768 + h * 192, 768, KA + (size_t)(b * 4 + h) * TK * 192, VT + (size_t)(b * 4 + h) * 128 * TK, 0, 4, 0, 0, mref, 0.f,
                                         A0 + row * 1024 + 512 + h * 128, 1024, 0); } }
      EpiGLU e{(const bf16_t*)(ws + S_YG), p.in[22], A0};
      gemm_phase(lds, (const bf16_t*)(ws + S_YG), 512, WB + W_GLU, 512, 0, NR / 256, 2, e); }
    GRID_SYNC();
    { EpiRes e{p.in[2], p.in[0], H, H + (size_t)NCTX * 1024, MOD + 0 * 3 * 6144 + 2048, 0};
      (void)e; { pg8::EpiRes pe{p.in[0], nullptr, Hb + (size_t)NCTX * 1024, nullptr, MOD + 0 * 3 * 6144 + 2048}; pg8::gemm_phase((LAS unsigned char*)lds, pg8::Gemm{A0, WB + W_OUT0, 1024, 1024}, pg8::Order{2, NLAT / 256, 4, (int)nb, (int)bid}, pe); }
      thin_gemm_ctx<4>(lds, A0, 1024, WB + W_OUT0, 1024, p.in[2], nullptr, Hb, MOD + 0 * 3 * 6144 + 2048); }
    GRID_SYNC();
    modulate_rows(p, 0, 1, false, 0);
    GRID_SYNC();
    { EpiSwiGLU e{(bf16_t*)(ws + S_HID)};
      (void)e; pg8::EpiSwiGLU pe{(bf16_t*)(ws + S_HID)}; pg8::gemm_phase((LAS unsigned char*)lds, pg8::Gemm{A0, WB + W_GU0, 1024, 1024}, pg8::Order{0, NR / 256, 22, (int)nb, (int)bid}, pe); }
    { int rk, nrk; slack_rank((NR / 256) * 22, rk, nrk); transpose_range(lds, ws, p, p.jobs[9].tile0, p.jobs[9].tile0 + 704, rk, nrk); }
    GRID_SYNC();
    { EpiRes e{H, H + (size_t)NCTX * 1024, H, H + (size_t)NCTX * 1024, MOD + 0 * 3 * 6144 + 5120, 0};
      (void)e; { pg8::EpiRes pe{nullptr, Hb + (size_t)NCTX * 1024, Hb + (size_t)NCTX * 1024, nullptr, MOD + 0 * 3 * 6144 + 5120}; pg8::gemm_phase((LAS unsigned char*)lds, pg8::Gemm{(const bf16_t*)(ws + S_HID), WB + W_D0, FH, FH}, pg8::Order{2, NLAT / 256, 4, (int)nb, (int)bid}, pe); }
      thin_gemm_ctx<11>(lds, (const bf16_t*)(ws + S_HID), FH, WB + W_D0, FH, nullptr, Hb, Hb, MOD + 0 * 3 * 6144 + 5120); }
    GRID_SYNC();
    modulate_rows(p, 1, 0, false, 0);
    GRID_SYNC();
    { EpiWin1 e{(bf16_t*)(ws + S1_Q), (bf16_t*)(ws + S1_K), (bf16_t*)(ws + S1_VT), p.in[31], p.in[32], (const float*)(ws + T_ROPE)};
      pg8::EpiHead<EpiWin1> pe{e}; pg8::gemm_phase((LAS unsigned char*)lds, pg8::Gemm{A0, WB + W_IN1, 1024, 1024}, pg8::Order{0, NR / 256, 6, (int)nb, (int)bid}, pe); }
    { int rk, nrk; slack_rank((NR / 256) * 6, rk, nrk); transpose_range(lds, ws, p, p.jobs[9].tile0 + 704, p.njobtiles, rk, nrk); }
    GRID_SYNC();
    { const bf16_t* Q = (const bf16_t*)(ws + S1_Q); const bf16_t* K1 = (const bf16_t*)(ws + S1_K); const bf16_t* VT = (const bf16_t*)(ws + S1_VT);
      constexpr int WNH = 2;
      const int nit = 2 * 4 * (4 / WNH) * 32;
      float mref; { float gq = 0.f, gk = 0.f;
        for (int d_ = 0; d_ < 64; ++d_) { gq = fmaxf(gq, fabsf(p.in[31][d_])); gk = fmaxf(gk, fabsf(p.in[32][d_])); }
        mref = 8.f * LOG2E * 1.02f * gq * gk; }
      for (int it = bid; it < nit; it += nb) { const int kvh = it & 3, b = (it >> 2) & 1, rest = it >> 3; const int gp = rest % (4 / WNH), i = rest / (4 / WNH); const int hq0 = kvh * 4 + gp * WNH;
          const size_t row = NCTX + (size_t)b * SEQ + i * 256;
          const int l0 = (4 * i - 2) < 0 ? 0 : (4 * i - 2), l1 = (4 * i + 6) > 128 ? 128 : (4 * i + 6);
          win_attn_item<WNH>(lds, Q + row * 1024 + hq0 * 64, K1 + (size_t)(b * 4 + kvh) * TK * 64, VT + (size_t)(b * 4 + kvh) * 64 * TK, 4 + l0, 4 + l1, mref, p.in[33] + hq0, A0 + row * 1024 + hq0 * 64, i * 256); } }
    GRID_SYNC();
    { EpiRes e{H, H + (size_t)NCTX * 1024, nullptr, H + (size_t)NCTX * 1024, MOD + 1 * 3 * 6144 + 2048, 0};
      (void)e; pg8::EpiRes pe{nullptr, Hb + (size_t)NCTX * 1024, Hb + (size_t)NCTX * 1024, nullptr, MOD + 1 * 3 * 6144 + 2048}; pg8::gemm_phase((LAS unsigned char*)lds, pg8::Gemm{A0, WB + W_OUT1, 1024, 1024}, pg8::Order{2, NLAT / 256, 4, (int)nb, (int)bid}, pe); }
    GRID_SYNC();
    modulate_rows(p, 1, 1, false, NCTX);
    GRID_SYNC();
    { EpiSwiGLU e{(bf16_t*)(ws + S_HID)};
      (void)e; pg8::EpiSwiGLU pe{(bf16_t*)(ws + S_HID)}; pg8::gemm_phase((LAS unsigned char*)lds, pg8::Gemm{A0, WB + W_GU1, 1024, 1024}, pg8::Order{2, NLAT / 256, 22, (int)nb, (int)bid}, pe); }
    GRID_SYNC();
    { EpiRes e{H, H + (size_t)NCTX * 1024, nullptr, p.out, MOD + 1 * 3 * 6144 + 5120, 0};
      (void)e; pg8::EpiRes pe{nullptr, Hb + (size_t)NCTX * 1024, nullptr, p.out, MOD + 1 * 3 * 6144 + 5120}; pg8::gemm_phase((LAS unsigned char*)lds, pg8::Gemm{(const bf16_t*)(ws + S_HID), WB + W_D1, FH, FH}, pg8::Order{2, NLAT / 256, 4, (int)nb, (int)bid}, pe); }
}

extern "C" void kernel_launch(void* const* d_in, const int* in_sizes, int n_in, void* d_out, int out_size, void* d_ws, size_t ws_size, hipStream_t stream) {
    static int grid_blocks = 0;
    if (grid_blocks == 0) {
        if (n_in != 34 || ws_size < WS_NEED2) { fprintf(stderr, "kernel_launch: unexpected n_in %d / ws %zu (need %zu)\n", n_in, ws_size, (size_t)WS_NEED2); grid_blocks = -1; return; }
        int dev = 0, cus = 0, per_cu = 0;
        (void)hipGetDevice(&dev);
        (void)hipDeviceGetAttribute(&cus, hipDeviceAttributeMultiprocessorCount, dev);
        (void)hipFuncSetAttribute((const void*)fwd_kernel, hipFuncAttributeMaxDynamicSharedMemorySize, LDS_BYTES);
        (void)hipOccupancyMaxActiveBlocksPerMultiprocessor(&per_cu, (const void*)fwd_kernel, NTHREADS, LDS_BYTES);
        if (per_cu < 1) { fprintf(stderr, "kernel_launch: occupancy query returned %d\n", per_cu); grid_blocks = -1; return; }
        if (per_cu > 1) per_cu = 1;
        grid_blocks = cus * per_cu;
        fprintf(stderr, "kernel_launch: grid %d (%d CUs x %d)\n", grid_blocks, cus, per_cu);
    }
    if (grid_blocks < 0) return;
    Params p{};
    for (int i = 0; i < 34; ++i) p.in[i] = (const float*)d_in[i];
    p.out = (float*)d_out; p.ws = (char*)d_ws;
    const float* fg = p.in[8]; const float* fu = p.in[9]; const float* fd = p.in[10];
    const size_t FW = (size_t)1024 * FH;
    int t0 = 0;
    auto mk = [&](int idx, const float* a, const float* b, size_t dst, int K, int ld, int npad, int mode) {
        Job& j = p.jobs[idx]; j.a = a; j.b = b; j.ks = nullptr; j.dst = dst; j.K = K; j.ld = ld; j.ntk = K / 64; j.ntn = npad / 64; j.tile0 = t0; j.mode = mode; t0 += j.ntk * j.ntn; };
    mk(0, p.in[11], nullptr, W_IN0, 1024, 1216, 1280, 2);
    mk(1, p.in[24], nullptr, W_QB, 384, 768, 768, 0);
    mk(2, p.in[26], nullptr, W_KVB, 256, 1024, 1024, 0);
    p.jobs[1].ks = p.in[23]; p.jobs[2].ks = p.in[25];
    mk(3, p.in[21], nullptr, W_GLU, 512, 512, 512, 0);
    mk(4, p.in[12], nullptr, W_OUT0, 1024, 1024, 1024, 0);
    mk(5, fg, fu, W_GU0, 1024, FH, 5632, 1);
    mk(6, fd, nullptr, W_D0, FH, 1024, 1024, 0);
    mk(7, p.in[29], nullptr, W_IN1, 1024, 1536, 1536, 2);
    mk(8, p.in[30], nullptr, W_OUT1, 1024, 1024, 1024, 0);
    mk(9, fg + FW, fu + FW, W_GU1, 1024, FH, 5632, 1);
    mk(10, fd + FW, nullptr, W_D1, FH, 1024, 1024, 0);
    p.njobtiles = t0;
    if (hipMemsetAsync((char*)d_ws + T_BAR, 0, XCD_BAR_WORDS * 4, stream) != hipSuccess) { fprintf(stderr, "kernel_launch: memset failed\n"); return; }
    void* args[] = {&p};
    hipError_t e = hipLaunchCooperativeKernel((const void*)fwd_kernel, dim3(grid_blocks), dim3(NTHREADS), args, LDS_BYTES, stream);
    if (e != hipSuccess) fprintf(stderr, "cooperative launch failed: %s (grid %d)\n", hipGetErrorString(e), grid_blocks);
}
```

```cpp
#include <hip/hip_runtime.h>
#include <hip/hip_cooperative_groups.h>
#include <cstdio>
#include <cstdint>
namespace cg = cooperative_groups;

#define DI __device__ __forceinline__
typedef unsigned short bf16_t;
typedef short bf16x8 __attribute__((ext_vector_type(8)));
typedef short s16x4 __attribute__((ext_vector_type(4)));
typedef float f32x4 __attribute__((ext_vector_type(4)));
typedef float f32x2 __attribute__((ext_vector_type(2)));
typedef float f32x16 __attribute__((ext_vector_type(16)));
typedef unsigned u32x4 __attribute__((ext_vector_type(4)));
typedef unsigned u32x2 __attribute__((ext_vector_type(2)));
typedef __bf16 bf16v2 __attribute__((ext_vector_type(2)));

constexpr int DM = 1024, NBATCH = 2, SEQ = 8192, CTX = 256;
constexpr int NCTX = NBATCH * CTX;
constexpr int NLAT = NBATCH * SEQ;
constexpr int NR = NCTX + NLAT;
constexpr int TK = CTX + SEQ;
constexpr int FH = 2816;
constexpr int NCH = TK / 64;
constexpr float LOG2E = 1.4426950408889634f;
constexpr int LDS_BYTES = 131072 + 64;
constexpr int NTHREADS = 512, NWV = 8;

constexpr size_t W_IN0 = 0;
constexpr size_t W_QB = W_IN0 + (size_t)1280 * 1024;
constexpr size_t W_KVB = W_QB + (size_t)768 * 384;
constexpr size_t W_GLU = W_KVB + (size_t)1024 * 256;
constexpr size_t W_OUT0 = W_GLU + (size_t)512 * 512;
constexpr size_t W_GU0 = W_OUT0 + (size_t)1024 * 1024;
constexpr size_t W_D0 = W_GU0 + (size_t)5632 * 1024;
constexpr size_t W_IN1 = W_D0 + (size_t)1024 * 2816;
constexpr size_t W_OUT1 = W_IN1 + (size_t)1536 * 1024;
constexpr size_t W_GU1 = W_OUT1 + (size_t)1024 * 1024;
constexpr size_t W_D1 = W_GU1 + (size_t)5632 * 1024;
constexpr size_t W_END = W_D1 + (size_t)1024 * 2816;
constexpr size_t OFF_TAB = W_END * 2;
constexpr size_t T_MOD = OFF_TAB;
constexpr size_t T_ROPE = T_MOD + 2 * 3 * 6144 * 4;
constexpr size_t T_LAMB = T_ROPE + 128 * 16 * 2 * 4;
constexpr size_t T_LAM64 = T_LAMB + 2 * 32 * 64 * 8;
constexpr size_t T_BBAR = T_LAM64 + 2 * 32 * 64 * 8;
constexpr size_t T_BAR = T_BBAR + (size_t)2 * 32 * 64 * 16 * 8;
constexpr size_t OFF_H = OFF_TAB + (1u << 20);
constexpr size_t OFF_A0 = OFF_H + (size_t)NR * 1024 * 4;
constexpr size_t OFF_S = OFF_A0 + (size_t)NR * 1024 * 2;
constexpr size_t WS_NEED = OFF_S + (size_t)108134400;
constexpr size_t S_SSP = WS_NEED;
constexpr size_t WS_NEED2 = S_SSP + (size_t)NR * 10 * 4;
static_assert(WS_NEED2 <= ((size_t)256 << 20) && OFF_S + (size_t)NR * FH * 2 <= WS_NEED, "workspace");
constexpr int SL = 32;
constexpr int NCK = TK / SL;
constexpr int CHR = NBATCH * NCK;
constexpr size_t H_UA = OFF_H;
constexpr size_t H_KR = H_UA + (size_t)(32 * CHR + 256) * 768 * 2;
constexpr size_t H_E = H_KR + (size_t)NR * 64 * 4;
constexpr size_t H_KK = H_E + (size_t)32 * CHR * 256 * 4;
constexpr size_t H_POW = H_KK + (size_t)32 * 2 * 32 * 256 * 4;
constexpr size_t H_W1A = H_POW + (size_t)4096 * 33 * 8;
static_assert(H_W1A + (size_t)32 * 256 * 512 * 2 <= OFF_A0, "H region overflow");
constexpr size_t A_W1B = OFF_A0;
constexpr size_t S_CQN = OFF_S;
constexpr size_t S_CKVN = S_CQN + (size_t)NR * 384 * 2;
constexpr size_t S_YG = OFF_S;
constexpr size_t S_X = S_CKVN + (size_t)NR * 256 * 2;
constexpr size_t S_CQKV = S_X;
constexpr size_t S_QRAW = S_X;
constexpr size_t S_KNOPE = S_QRAW + (size_t)NR * 768 * 2;
constexpr size_t S_VT = S_KNOPE + (size_t)NR * 512 * 2;
constexpr size_t S_KA = S_VT + (size_t)2 * 4 * 128 * TK * 2;
static_assert(S_CQKV + (size_t)NR * 640 * 4 <= S_VT, "CQKV overlaps VT");
static_assert(S_KA + (size_t)2 * 4 * TK * 192 * 2 <= WS_NEED, "scratch overflow");
constexpr size_t S_HID = OFF_S;
constexpr size_t S1_Q = OFF_S;
constexpr size_t S1_KRAW = S1_Q + (size_t)NR * 1024 * 2;
constexpr size_t S1_K = S1_KRAW + (size_t)NR * 256 * 4;
constexpr size_t S1_VT = S1_K + (size_t)2 * 4 * TK * 64 * 2;

struct Job { const float* a; const float* b; const float* ks; unsigned long long dst; int K, ld, ntk, ntn, tile0, mode; };
struct Params {
    const float* in[34];
    float* out;
    char* ws;
    Job jobs[11];
    int njobtiles;
    int pad;
};

DI int get_tid() { int t = threadIdx.x; asm volatile("" : "+v"(t)); return t; }
DI unsigned pk2(float lo, float hi) { f32x2 v = {lo, hi}; return __builtin_bit_cast(unsigned, __builtin_convertvector(v, bf16v2)); }
DI float bf2f(unsigned short b) { return __uint_as_float(((unsigned)b) << 16); }
DI f32x4 ld_bf4(const bf16_t* q) { const u32x2 w = *(const u32x2*)q; return (f32x4){__uint_as_float(w[0] << 16), __uint_as_float(w[0] & 0xffff0000u), __uint_as_float(w[1] << 16), __uint_as_float(w[1] & 0xffff0000u)}; }
DI void st_bf4(bf16_t* q, f32x4 v) { *(u32x2*)q = (u32x2){pk2(v[0], v[1]), pk2(v[2], v[3])}; }
DI float wave_sum(float v) {
#pragma unroll
    for (int o = 32; o > 0; o >>= 1) v += __shfl_xor(v, o);
    return v;
}
DI int row_vec(int r) { return r < NCTX ? 2 : (r - NCTX) / SEQ; }
DI int row_batch(int r) { return r < NCTX ? r / CTX : (r - NCTX) / SEQ; }
DI int row_tpos(int r) { return r < NCTX ? r % CTX : CTX + (r - NCTX) % SEQ; }
DI float sigmoidf_(float x) { return __builtin_amdgcn_rcpf(1.f + __expf(-x)); }
DI float siluf_(float x) { return x * __builtin_amdgcn_rcpf(1.f + __expf(-x)); }
DI float gelu_tanh(float y) { const float z = 0.7978845608028654f * (y + 0.044715f * y * y * y); const float t = 1.f - 2.f * __builtin_amdgcn_rcpf(1.f + __expf(2.f * z)); return 0.5f * y * (1.f + t); }
DI void my_sincos(float x, float& s, float& c) {
    const float q = rintf(x * 0.636619772367581f);
    float r = fmaf(-q, 1.5703125f, x);
    r = fmaf(-q, 4.837512969970703125e-4f, r);
    r = fmaf(-q, 7.54978995489188216e-8f, r);
    const int qi = (int)q;
    const float r2 = r * r;
    const float sp = r + r * r2 * (-1.6666654611e-1f + r2 * (8.3321608736e-3f + r2 * (-1.9515295891e-4f)));
    const float cp = 1.0f - 0.5f * r2 + r2 * r2 * (4.166664568298827e-2f + r2 * (-1.388731625493765e-3f + r2 * 2.443315711809948e-5f));
    const int k = qi & 3;
    s = (k == 0) ? sp : (k == 1) ? cp : (k == 2) ? -sp : -cp;
    c = (k == 0) ? cp : (k == 1) ? -sp : (k == 2) ? -cp : sp;
}


#define XB_TMO      128
#define XB_XCNT(j)  (256  + 64 * (j))
#define XB_XSUB(j)  (1280 + 64 * (j))
#define XB_XGEN(j)  (2304 + 64 * (j))
#define XB_TOP      3328
#define XB_TOPGEN   3392
#define XCD_BAR_WORDS 3456
#define XB_SPIN_CAP (1u << 22)
#define LAS __attribute__((address_space(3)))
DI unsigned xb_ld(unsigned* p) { return __hip_atomic_load(p, __ATOMIC_RELAXED, __HIP_MEMORY_SCOPE_AGENT); }
DI unsigned xb_add(unsigned* p, unsigned v) { return __hip_atomic_fetch_add(p, v, __ATOMIC_RELAXED, __HIP_MEMORY_SCOPE_AGENT); }
DI unsigned xb_xcc_id() { return (unsigned)__builtin_amdgcn_s_getreg((3 << 11) | 20) & 0xFu; }
#define XB_SPIN(cond, bar) do { unsigned _sp = 0; while (cond) { __builtin_amdgcn_s_sleep(1); \
    if ((++_sp & 255u) == 0u) { if (xb_ld(&(bar)[XB_TMO])) break; if (_sp > XB_SPIN_CAP) { atomicAdd(&(bar)[XB_TMO], 1u); break; } } } } while (0)
struct XcdBarrier { unsigned* bar; unsigned x; volatile LAS unsigned* st; };
DI XcdBarrier xcd_barrier_post(unsigned* bar, volatile LAS unsigned* st) {
    XcdBarrier b; b.bar = bar; b.x = xb_xcc_id(); b.st = st;
    if (threadIdx.x == 0) (void)xb_add(&bar[XB_XCNT(b.x)], 1u);
    return b;
}
DI void xcd_barrier_complete(unsigned* bar, unsigned x, unsigned& nloc, unsigned& nx) {
    const unsigned G = gridDim.x * gridDim.y * gridDim.z;
    unsigned sum, cnt, mine, sp = 0u;
    for (;;) {
        sum = 0u; cnt = 0u; mine = 0u;
#pragma unroll
        for (unsigned j = 0; j < 16; ++j) { const unsigned c = xb_ld(&bar[XB_XCNT(j)]); sum += c; cnt += (c > 0u) ? 1u : 0u; mine = (j == x) ? c : mine; }
        if (sum == G) break;
        __builtin_amdgcn_s_sleep(1);
        if ((++sp & 255u) == 0u) { if (xb_ld(&bar[XB_TMO])) break; if (sp > XB_SPIN_CAP) { atomicAdd(&bar[XB_TMO], 1u); break; } }
    }
    nloc = mine > 0u ? mine : 1u; nx = cnt > 0u ? cnt : 1u;
}
DI void xcd_barrier(const XcdBarrier& b) {
    asm volatile("s_waitcnt vmcnt(0)" ::: "memory");
    __syncthreads();
    if (threadIdx.x == 0) {
        unsigned* bar = b.bar;
        __builtin_amdgcn_s_waitcnt(0);
        unsigned nloc = b.st[0], nx = b.st[1];
        if (nloc == 0u) { xcd_barrier_complete(bar, b.x, nloc, nx); b.st[0] = nloc; b.st[1] = nx; }
        const unsigned old = xb_add(&bar[XB_XSUB(b.x)], 1u);
        const unsigned gen = old / nloc;
        if (old + 1u == (gen + 1u) * nloc) {
            __builtin_amdgcn_fence(__ATOMIC_RELEASE, "agent");
            asm volatile("s_waitcnt vmcnt(0)" ::: "memory");
            const unsigned og = xb_add(&bar[XB_TOP], 1u);
            const unsigned tg = og / nx;
            if (og + 1u == (tg + 1u) * nx) xb_add(&bar[XB_TOPGEN], 1u);
            else XB_SPIN(xb_ld(&bar[XB_TOPGEN]) == tg, bar);
            __builtin_amdgcn_fence(__ATOMIC_ACQUIRE, "agent");
            xb_add(&bar[XB_XGEN(b.x)], 1u);
            asm volatile("s_waitcnt vmcnt(0)" ::: "memory");
        } else {
            XB_SPIN(xb_ld(&bar[XB_XGEN(b.x)]) == gen, bar);
            __builtin_amdgcn_fence(__ATOMIC_ACQUIRE, "agent");
            asm volatile("s_waitcnt vmcnt(0)" ::: "memory");
        }
    }
    __syncthreads();
}

DI void transpose_tile(char* lds, char* ws, const Job& jb, int lt, bool live) {
    const int tid512 = get_tid(); const int tid = tid512 & 255;
    float (*tile)[65] = (float (*)[65])(lds + (tid512 >> 8) * 17408);
    const int tk = lt % jb.ntk, tn = lt / jb.ntk;
    const int k0 = tk * 64, n0 = tn * 64;
    const int c4 = (tid & 15) * 4, rq = tid >> 4;
    const float* src; int col; bool valid = live;
    if (jb.mode == 0) { src = jb.a; col = n0 + c4; valid = live && col < jb.ld; }
    else if (jb.mode == 2) { src = jb.a; const int rho = (n0 + c4) & 255; col = (n0 + c4 - rho) + 64 * ((rho >> 5) & 3) + 32 * (rho >> 7) + (rho & 31); valid = live && col < jb.ld; }
    else { const int nsub = c4 >> 4, i = c4 & 15; src = (nsub & 1) ? jb.b : jb.a; col = tn * 32 + (nsub >> 1) * 16 + i; }
#pragma unroll
    for (int kk = 0; kk < 4; ++kk) { const int k = kk * 16 + rq; f32x4 v = valid ? *(const f32x4*)(src + (size_t)(k0 + k) * jb.ld + col) : (f32x4){0.f, 0.f, 0.f, 0.f};
        if (jb.ks) v = v * jb.ks[k0 + k];
        tile[k][c4] = v[0]; tile[k][c4 + 1] = v[1]; tile[k][c4 + 2] = v[2]; tile[k][c4 + 3] = v[3]; }
    __syncthreads();
    const int r = tid >> 2, ks = (tid & 3) * 16;
    unsigned w[8];
#pragma unroll
    for (int q = 0; q < 8; ++q) w[q] = pk2(tile[ks + 2 * q][r], tile[ks + 2 * q + 1][r]);
    bf16_t* d = (bf16_t*)(ws) + jb.dst + (size_t)(n0 + r) * jb.K + k0 + ks;
    if (live) { *(u32x4*)d = (u32x4){w[0], w[1], w[2], w[3]};
    *(u32x4*)(d + 8) = (u32x4){w[4], w[5], w[6], w[7]}; }
    __syncthreads();
}

DI void transpose_range(char* lds, char* ws, const Params& p, int t_begin, int t_end, int rank, int nranks) {
    if (rank < 0) return;
    for (int pr = (t_begin >> 1) + rank; pr < (t_end >> 1); pr += nranks) {
        const int lt = pr * 2 + (int)(threadIdx.x >> 8); int j = 0;
#pragma unroll
        for (int q = 1; q < 11; ++q) if (lt >= p.jobs[q].tile0) j = q;
        transpose_tile(lds, ws, p.jobs[j], lt - p.jobs[j].tile0, true);
    }
}
DI int virt_block() { const int G_ = gridDim.x; return ((G_ & 7) == 0) ? (int)(blockIdx.x & 7) * (G_ >> 3) + (int)(blockIdx.x >> 3) : (int)blockIdx.x; }
DI void slack_rank(int ntile, int& rank, int& nranks) { const int rem = ntile % (int)gridDim.x; const int vb = virt_block(); if (rem == 0) { rank = vb; nranks = gridDim.x; } else { rank = vb - rem; nranks = (int)gridDim.x - rem; } }

DI void ada_item(char* lds, const Params& p, int it) {
    float* sil = (float*)lds;
    float* red = sil + 3072;
    float* MOD = (float*)(p.ws + T_MOD);
    const int tid = get_tid(), layer = it / 96, n0 = (it % 96) * 64;
    for (int i = tid; i < 3072; i += NTHREADS) { const int v = i >> 10, k = i & 1023; const float x = v < 2 ? p.in[1][v * 1024 + k] : p.in[3][k]; sil[i] = siluf_(x); }
    __syncthreads();
    const int j4 = (tid & 15) * 4, kg = tid >> 4;
    const float* W = p.in[4] + (size_t)layer * 1024 * 6144 + n0 + j4;
    f32x4 a0 = {0.f, 0.f, 0.f, 0.f}, a1 = a0, a2 = a0;
#pragma unroll 8
    for (int k = kg * 32; k < kg * 32 + 32; ++k) { const f32x4 w = *(const f32x4*)(W + (size_t)k * 6144); a0 += sil[k] * w; a1 += sil[1024 + k] * w; a2 += sil[2048 + k] * w; }
    *(f32x4*)(red + (kg * 3 + 0) * 64 + j4) = a0; *(f32x4*)(red + (kg * 3 + 1) * 64 + j4) = a1; *(f32x4*)(red + (kg * 3 + 2) * 64 + j4) = a2;
    __syncthreads();
    if (tid < 192) { const int v = tid >> 6, jj = tid & 63;
        float s = p.in[5][layer * 6144 + n0 + jj];
#pragma unroll 8
        for (int q = 0; q < 32; ++q) s += red[(q * 3 + v) * 64 + jj];
        MOD[(layer * 3 + v) * 6144 + n0 + jj] = s; }
    __syncthreads();
}

DI void tables_item(const Params& p, int it) {
    const int tid = get_tid();
    if (it < 4) {
        const int e = it * 512 + tid, pos = e >> 4, i = e & 15;
        const float inv = exp2f(-(float)i * (13.287712379549449f / 16.f));
        float s, c; my_sincos((float)pos * inv, s, c);
        float* ROPE = (float*)(p.ws + T_ROPE); ROPE[e * 2] = c; ROPE[e * 2 + 1] = s;
    } else {
        const int e = (it - 4) * 512 + tid;
        const int dg = e >> 6;
        const float lr = p.in[13][e], li = p.in[14][e], step = expf(p.in[15][dg]);
        const float a = lr * step, b = li * step;
        const float ea = expf(a);
        float sb, cb; my_sincos(b, sb, cb);
        float sh, ch; my_sincos(0.5f * b, sh, ch);
        const float em1 = a * (1.f + a * 0.5f * (1.f + a * (1.f / 3.f) * (1.f + a * 0.25f * (1.f + a * 0.2f * (1.f + a * (1.f / 6.f))))));
        const float lbr = ea * cb, lbi = ea * sb;
        const float nr = em1 * cb - 2.f * sh * sh, ni = ea * sb;
        const float den = lr * lr + li * li;
        const float qr = (nr * lr + ni * li) / den, qi = (ni * lr - nr * li) / den;
        f32x2* BB = (f32x2*)(p.ws + T_BBAR);
#pragma unroll
        for (int s = 0; s < 16; ++s) { const float br = p.in[16][e * 16 + s], bi = p.in[17][e * 16 + s]; BB[e * 16 + s] = (f32x2){qr * br - qi * bi, qr * bi + qi * br}; }
        f32x2* POW = (f32x2*)(p.ws + H_POW) + (size_t)dg * 33 * 64 + (e & 63);
        float pr = 1.f, pi = 0.f;
        for (int q = 0; q <= 32; ++q) { POW[q * 64] = (f32x2){pr, pi}; const float nr2 = pr * lbr - pi * lbi, ni2 = pr * lbi + pi * lbr; pr = nr2; pi = ni2; }
    }
}

DI void modulate_rows(const Params& p, int layer, int which, bool from_inputs, int r0) {
    const int tid_ = get_tid(); const int lane = tid_ & 63, wid = tid_ >> 6;
    const float* gain = p.in[which ? 7 : 6] + layer * 1024;
    const float* modl = (const float*)(p.ws + T_MOD) + layer * 3 * 6144 + (which ? 3072 : 0);
    const bf16_t* Hb = (const bf16_t*)(p.ws + OFF_H);
    bf16_t* dst = (bf16_t*)(p.ws + OFF_A0);
    const int stride = gridDim.x * NWV;
    for (int ra = r0 + blockIdx.x * NWV + wid; ra < NR; ra += 2 * stride) {
        const int rb = ra + stride; const bool hb = rb < NR; const int rbb = hb ? rb : ra;
        const float* srca = ra < NCTX ? p.in[2] + (size_t)ra * 1024 : p.in[0] + (size_t)(ra - NCTX) * 1024;
        const float* srcb = rbb < NCTX ? p.in[2] + (size_t)rbb * 1024 : p.in[0] + (size_t)(rbb - NCTX) * 1024;
        f32x4 xa[4], xb[4]; float sa = 0.f, sb = 0.f;
#pragma unroll
        for (int i = 0; i < 4; ++i) { if (from_inputs) { xa[i] = *(const f32x4*)(srca + i * 256 + lane * 4); xb[i] = *(const f32x4*)(srcb + i * 256 + lane * 4); }
                                      else { xa[i] = ld_bf4(Hb + (size_t)ra * 1024 + i * 256 + lane * 4); xb[i] = ld_bf4(Hb + (size_t)rbb * 1024 + i * 256 + lane * 4); } }
#pragma unroll
        for (int i = 0; i < 4; ++i) { sa += xa[i][0] * xa[i][0] + xa[i][1] * xa[i][1] + xa[i][2] * xa[i][2] + xa[i][3] * xa[i][3];
                                      sb += xb[i][0] * xb[i][0] + xb[i][1] * xb[i][1] + xb[i][2] * xb[i][2] + xb[i][3] * xb[i][3]; }
        sa = wave_sum(sa); sb = wave_sum(sb);
        const float rsa = rsqrtf(sa * (1.f / 1024.f) + 1e-6f), rsb = rsqrtf(sb * (1.f / 1024.f) + 1e-6f);
        const float* mva = modl + row_vec(ra) * 6144; const float* mvb = modl + row_vec(rbb) * 6144;
#pragma unroll
        for (int i = 0; i < 4; ++i) { const int c = i * 256 + lane * 4;
            const f32x4 g = *(const f32x4*)(gain + c);
            { const f32x4 sh = *(const f32x4*)(mva + c), sc = *(const f32x4*)(mva + 1024 + c); const f32x4 y = xa[i] * rsa * g * (1.f + sc) + sh;
              *(u32x2*)(dst + (size_t)ra * 1024 + c) = (u32x2){pk2(y[0], y[1]), pk2(y[2], y[3])}; }
            if (hb) { const f32x4 sh = *(const f32x4*)(mvb + c), sc = *(const f32x4*)(mvb + 1024 + c); const f32x4 y = xb[i] * rsb * g * (1.f + sc) + sh;
              *(u32x2*)(dst + (size_t)rb * 1024 + c) = (u32x2){pk2(y[0], y[1]), pk2(y[2], y[3])}; } }
    }
}

template <class Epi>
DI void gemm_phase(char* lds, const bf16_t* A0_, int lda, const bf16_t* Bt0_, int K, int mt0, int nmt, int nnt, const Epi& epi, int nbatch = 1, size_t sA = 0, size_t sB = 0, int ksplit = 1, int gact = 0) {
    const int tid = get_tid(), lane = tid & 63, wid = tid >> 6, wr = wid >> 2, wc = wid & 3, fr = lane & 15, fq = lane >> 4;
    const int nk = (K >> 6) / ksplit;
    const int lrow = tid >> 3, lc = tid & 7, lkc = lc * 8;
    const int woff = lrow * 128 + ((lc ^ ((lrow >> 1) & 7)) << 4);
    const int ra0 = (wr * 128 + fr) * 128 + ((fq ^ (fr >> 1)) << 4);
    const int ra1 = (wr * 128 + fr) * 128 + (((4 + fq) ^ (fr >> 1)) << 4);
    const int rb0 = 32768 + (wc * 64 + fr) * 128 + ((fq ^ (fr >> 1)) << 4);
    const int rb1 = 32768 + (wc * 64 + fr) * 128 + (((4 + fq) ^ (fr >> 1)) << 4);
    const int per = nmt * nnt, ntile = nbatch * per * ksplit;
    const int PM = nnt >= 8 ? 4 : 8;
    const int GA = gact > 0 ? gact : (int)gridDim.x;
    const int myn = ((int)blockIdx.x < GA && (int)blockIdx.x < ntile) ? (ntile - (int)blockIdx.x + GA - 1) / GA : 0;
    const int total = myn * nk;
    f32x4 acc[8][4];
#pragma unroll
    for (int m = 0; m < 8; ++m)
#pragma unroll
        for (int n = 0; n < 4; ++n) acc[m][n] = (f32x4){0.f, 0.f, 0.f, 0.f};
    int iti = 0, ikt = 0;
    const int srow = wid * 32 + (lane >> 3);
    const bf16_t* Ag = A0_; const bf16_t* Bg = Bt0_;
#define G_STAGE(bufoff) do { if (ikt == 0) { const int u_ = blockIdx.x + iti * GA; const int t_ = u_ / ksplit, sl_ = u_ - t_ * ksplit; const int gb_ = t_ / per, tr_ = t_ - gb_ * per; const int ch_ = tr_ / (PM * nnt), rm_ = tr_ - ch_ * PM * nnt; const int pc_ = (nmt - ch_ * PM) < PM ? (nmt - ch_ * PM) : PM; const int tn_ = rm_ / pc_, tm_ = ch_ * PM + (rm_ - tn_ * pc_); \
            Ag = A0_ + (size_t)gb_ * sA + (size_t)((mt0 + tm_) * 256) * lda + sl_ * nk * 64; Bg = Bt0_ + (size_t)gb_ * sB + (size_t)(tn_ * 256) * K + sl_ * nk * 64; } \
        _Pragma("unroll") for (int i = 0; i < 4; ++i) { const int row_ = srow + 8 * i; const int c_ = ((lane & 7) ^ ((row_ >> 1) & 7)) * 8; \
            __builtin_amdgcn_global_load_lds((const unsigned*)(Ag + (size_t)row_ * lda + ikt * 64 + c_), (LAS unsigned*)(lds + (bufoff) + (wid * 4 + i) * 1024), 16, 0, 0); \
            __builtin_amdgcn_global_load_lds((const unsigned*)(Bg + (size_t)row_ * K + ikt * 64 + c_), (LAS unsigned*)(lds + (bufoff) + 32768 + (wid * 4 + i) * 1024), 16, 0, 0); } \
        if (++ikt == nk) { ikt = 0; ++iti; } } while (0)
#define G_COMPUTE(bufoff) do { _Pragma("unroll") for (int ks = 0; ks < 2; ++ks) { bf16x8 a[8], b[4]; \
        _Pragma("unroll") for (int m = 0; m < 8; ++m) a[m] = *(const bf16x8*)(lds + (bufoff) + (ks ? ra1 : ra0) + m * 2048); \
        _Pragma("unroll") for (int n = 0; n < 4; ++n) b[n] = *(const bf16x8*)(lds + (bufoff) + (ks ? rb1 : rb0) + n * 2048); \
        _Pragma("unroll") for (int m = 0; m < 8; ++m) _Pragma("unroll") for (int n = 0; n < 4; ++n) acc[m][n] = __builtin_amdgcn_mfma_f32_16x16x32_bf16(b[n], a[m], acc[m][n], 0, 0, 0); } } while (0)
    __syncthreads();
    if (total > 0) G_STAGE(0);
    asm volatile("s_waitcnt vmcnt(0)" ::: "memory");
    __syncthreads();
    int cti = 0, ckt = 0;
    for (int q = 0; q < total; ++q) {
        const int cur = (q & 1) * 65536;
        if (q + 1 < total) G_STAGE(cur ^ 65536);
        G_COMPUTE(cur);
        asm volatile("s_waitcnt vmcnt(0)" ::: "memory");
        __syncthreads();
        if (++ckt == nk) {
            const int u_ = blockIdx.x + cti * GA; const int t_ = u_ / ksplit; const int gb_ = t_ / per, tr_ = t_ - gb_ * per; const int ch_ = tr_ / (PM * nnt), rm_ = tr_ - ch_ * PM * nnt; const int pc_ = (nmt - ch_ * PM) < PM ? (nmt - ch_ * PM) : PM; const int tn_ = rm_ / pc_, tm_ = ch_ * PM + (rm_ - tn_ * pc_);
            epi(acc, (mt0 + tm_) * 256 + wr * 128 + fr, tn_ * 256 + wc * 64 + fq * 4, gb_);
#pragma unroll
            for (int m = 0; m < 8; ++m)
#pragma unroll
                for (int n = 0; n < 4; ++n) acc[m][n] = (f32x4){0.f, 0.f, 0.f, 0.f};
            ckt = 0; ++cti;
        }
    }
#undef G_STAGE
#undef G_COMPUTE
}

template <int KSP>
DI void thin_gemm_ctx(char* lds, const bf16_t* A, int lda, const bf16_t* Bt, int K, const float* res_f, const bf16_t* res_h, bf16_t* dst, const float* gate) {
    const int tid = get_tid(), lane = tid & 63, wid = tid >> 6, fr = lane & 15, fq = lane >> 4;
    float* part = (float*)lds;
    for (int t = blockIdx.x; t < 256; t += gridDim.x) {
        const int m0 = (t >> 5) * 64, n0 = (t & 31) * 32;
        f32x4 acc[4][2];
#pragma unroll
        for (int m = 0; m < 4; ++m) { acc[m][0] = (f32x4){0.f, 0.f, 0.f, 0.f}; acc[m][1] = (f32x4){0.f, 0.f, 0.f, 0.f}; }
        const bf16_t* Ap = A + (size_t)(m0 + fr) * lda + wid * (KSP * 32) + fq * 8;
        const bf16_t* Bp = Bt + (size_t)(n0 + fr) * K + wid * (KSP * 32) + fq * 8;
#pragma unroll
        for (int k = 0; k < KSP; ++k) {
            bf16x8 a[4], b[2];
#pragma unroll
            for (int m = 0; m < 4; ++m) a[m] = *(const bf16x8*)(Ap + (size_t)m * 16 * lda + k * 32);
#pragma unroll
            for (int n = 0; n < 2; ++n) b[n] = *(const bf16x8*)(Bp + (size_t)n * 16 * K + k * 32);
#pragma unroll
            for (int m = 0; m < 4; ++m)
#pragma unroll
                for (int n = 0; n < 2; ++n) acc[m][n] = __builtin_amdgcn_mfma_f32_16x16x32_bf16(b[n], a[m], acc[m][n], 0, 0, 0);
        }
        __syncthreads();
#pragma unroll
        for (int m = 0; m < 4; ++m)
#pragma unroll
            for (int n = 0; n < 2; ++n) *(f32x4*)(part + ((wid * 64 + m * 16 + fr) * 32 + n * 16 + fq * 4)) = acc[m][n];
        __syncthreads();
        { const int row = tid >> 3, c4 = (tid & 7) * 4; f32x4 sum = (f32x4){0.f, 0.f, 0.f, 0.f};
#pragma unroll
          for (int w = 0; w < 8; ++w) sum += *(const f32x4*)(part + ((w * 64 + row) * 32 + c4));
          const size_t off = (size_t)(m0 + row) * 1024 + n0 + c4;
          const f32x4 g = *(const f32x4*)(gate + 2 * 6144 + n0 + c4), x = res_h ? ld_bf4(res_h + off) : *(const f32x4*)(res_f + off);
          st_bf4(dst + off, x + g * sum); }
    }
    __syncthreads();
}

struct EpiWin0 {
    bf16_t* UA; bf16_t* CQN; bf16_t* CKVN; float* SSP; float* KR;
    template <int NM> DI void run(const f32x4 (&acc)[NM][4], int row0, int col0) const {
        const int cw = col0 & ~63;
#pragma unroll
        for (int m = 0; m < NM; ++m) { const int ri = row0 + m * 16; const size_t r = ri;
            if (cw < 512) { const int b = row_batch(ri), tp = row_tpos(ri);
#pragma unroll
                for (int n = 0; n < 4; ++n) { const int c = col0 + n * 16; const f32x4 v = acc[m][n]; const int g = c >> 4, s0 = c & 15;
                    *(u32x2*)(UA + ((size_t)g * CHR + b * NCK + (tp >> 5)) * 768 + (tp & 31) * 16 + s0) = (u32x2){pk2(v[0], v[1]), pk2(v[2], v[3])}; }
            } else if (cw < 1152) { const bool isq = cw < 896; bf16_t* dst = isq ? CQN + r * 384 + (col0 - 512) : CKVN + r * 256 + (col0 - 896);
                float ss = 0.f;
#pragma unroll
                for (int n = 0; n < 4; ++n) { const f32x4 v = acc[m][n]; ss += v[0] * v[0] + v[1] * v[1] + v[2] * v[2] + v[3] * v[3];
                    *(u32x2*)(dst + n * 16) = (u32x2){pk2(v[0], v[1]), pk2(v[2], v[3])}; }
                ss += __shfl_xor(ss, 16); ss += __shfl_xor(ss, 32);
                if ((col0 & 15) == 0) SSP[r * 10 + ((cw - 512) >> 6)] = ss;
            } else if (cw < 1216) {
#pragma unroll
                for (int n = 0; n < 4; ++n) *(f32x4*)(KR + r * 64 + (col0 - 1152) + n * 16) = acc[m][n];
            } }
    }
    DI void operator()(const f32x4 (&acc)[8][4], int row0, int col0, int gb) const { run<8>(acc, row0, col0); }
};
struct EpiS1a {
    float* E;
    DI void operator()(const f32x4 (&acc)[8][4], int row0, int col0, int gb) const {
#pragma unroll
        for (int m = 0; m < 8; ++m) { const int r = row0 + m * 16; if (r >= CHR) continue;
#pragma unroll
            for (int n = 0; n < 4; ++n) *(f32x4*)(E + ((size_t)gb * CHR + r) * 256 + col0 + n * 16) = acc[m][n]; }
    }
};
struct EpiS1b {
    bf16_t* YG;
    DI void operator()(const f32x4 (&acc)[8][4], int row0, int col0, int gb) const {
#pragma unroll
        for (int m = 0; m < 8; ++m) { const int r = row0 + m * 16; if (r >= CHR) continue; const int b = r / NCK, c = r % NCK;
#pragma unroll
            for (int n = 0; n < 4; ++n) { const int cc = col0 + n * 16; const int tl = cc >> 4, s0 = cc & 15; const f32x4 v = acc[m][n];
                const int tp = c * SL + tl; const size_t row = tp < CTX ? (size_t)b * CTX + tp : (size_t)NCTX + (size_t)b * SEQ + (tp - CTX);
                *(u32x2*)(YG + row * 512 + gb * 16 + s0) = (u32x2){pk2(gelu_tanh(v[0]), gelu_tanh(v[1])), pk2(gelu_tanh(v[2]), gelu_tanh(v[3]))}; } }
    }
};
struct EpiBf16 {
    bf16_t* O; int ldo; const float* SSP;
    DI void operator()(const f32x4 (&acc)[8][4], int row0, int col0, int gb) const {
#pragma unroll
        for (int m = 0; m < 8; ++m) { const size_t r = row0 + m * 16; const float* sp = SSP + r * 10;
            const float rstd = rsqrtf(((sp[0] + sp[1]) + (sp[2] + sp[3]) + (sp[4] + sp[5])) * (1.f / 384.f) + 1e-6f);
#pragma unroll
            for (int n = 0; n < 4; ++n) { const int c = col0 + n * 16; const f32x4 v = acc[m][n] * rstd;
                *(u32x2*)(O + r * ldo + c) = (u32x2){pk2(v[0], v[1]), pk2(v[2], v[3])}; } }
    }
};
struct EpiKV {
    bf16_t* KNOPE; bf16_t* VT; const float* SSP;
    DI void operator()(const f32x4 (&acc)[8][4], int row0, int col0, int gb) const {
#pragma unroll
        for (int m = 0; m < 8; ++m) { const int r = row0 + m * 16; const int b = row_batch(r), tp = row_tpos(r); const float* sp = SSP + (size_t)r * 10 + 6;
            const float rstd = rsqrtf(((sp[0] + sp[1]) + (sp[2] + sp[3])) * (1.f / 256.f) + 1e-6f);
#pragma unroll
            for (int n = 0; n < 4; ++n) { const int c = col0 + n * 16; const int h = c >> 8, w = c & 255; const f32x4 v = acc[m][n] * rstd;
                if (w < 128) *(u32x2*)(KNOPE + (size_t)r * 512 + h * 128 + w) = (u32x2){pk2(v[0], v[1]), pk2(v[2], v[3])};
                else { bf16_t* d = VT + ((size_t)(b * 4 + h) * 128 + (w - 128)) * TK + tp; const unsigned p0 = pk2(v[0], v[1]), p1 = pk2(v[2], v[3]);
                    d[0] = (bf16_t)(p0 & 0xffff); d[TK] = (bf16_t)(p0 >> 16); d[2 * TK] = (bf16_t)(p1 & 0xffff); d[3 * TK] = (bf16_t)(p1 >> 16); } } }
    }
};
struct EpiGLU {
    const bf16_t* YG; const float* bias; bf16_t* CAT;
    DI void operator()(const f32x4 (&acc)[8][4], int row0, int col0, int gb) const {
#pragma unroll
        for (int m = 0; m < 8; ++m) { const size_t r = row0 + m * 16;
#pragma unroll
            for (int n = 0; n < 4; ++n) { const int c = col0 + n * 16; const f32x4 v = acc[m][n]; const f32x4 bv = *(const f32x4*)(bias + c);
                const u32x2 yy = *(const u32x2*)(YG + r * 512 + c);
                const float y0 = __uint_as_float(yy[0] << 16), y1 = __uint_as_float(yy[0] & 0xffff0000u), y2 = __uint_as_float(yy[1] << 16), y3 = __uint_as_float(yy[1] & 0xffff0000u);
                const float o0 = y0 * sigmoidf_(v[0] + bv[0]), o1 = y1 * sigmoidf_(v[1] + bv[1]), o2 = y2 * sigmoidf_(v[2] + bv[2]), o3 = y3 * sigmoidf_(v[3] + bv[3]);
                *(u32x2*)(CAT + r * 1024 + c) = (u32x2){pk2(o0, o1), pk2(o2, o3)}; } }
    }
};
struct EpiRes {
    const float* res_ctx; const float* res_lat; float* dst_ctx; float* dst_lat; const float* gate; int atomic;
    DI void operator()(const f32x4 (&acc)[8][4], int row0, int col0, int gb) const {
#pragma unroll
        for (int m = 0; m < 8; ++m) { const int r = row0 + m * 16;
            const float* rs = r < NCTX ? res_ctx + (size_t)r * 1024 : res_lat + (size_t)(r - NCTX) * 1024;
            float* ds = r < NCTX ? dst_ctx + (size_t)r * 1024 : dst_lat + (size_t)(r - NCTX) * 1024;
            if (r < NCTX && dst_ctx == nullptr) continue;
            const float* gv = gate + row_vec(r) * 6144;
#pragma unroll
            for (int n = 0; n < 4; ++n) { const int c = col0 + n * 16; const f32x4 g = *(const f32x4*)(gv + c);
                if (atomic) { const f32x4 v = g * acc[m][n];
#pragma unroll
                    for (int j = 0; j < 4; ++j) (void)__hip_atomic_fetch_add(ds + c + j, v[j], __ATOMIC_RELAXED, __HIP_MEMORY_SCOPE_AGENT); }
                else { const f32x4 x = *(const f32x4*)(rs + c); *(f32x4*)(ds + c) = x + g * acc[m][n]; } } }
    }
};
struct EpiSwiGLU {
    bf16_t* HID;
    DI void operator()(const f32x4 (&acc)[8][4], int row0, int col0, int gb) const {
        const int hc = (col0 >> 6) * 32 + (col0 & 15);
#pragma unroll
        for (int m = 0; m < 8; ++m) { const size_t r = row0 + m * 16;
#pragma unroll
            for (int q = 0; q < 2; ++q) { const f32x4 g = acc[m][2 * q], u = acc[m][2 * q + 1];
                const float o0 = siluf_(g[0]) * u[0], o1 = siluf_(g[1]) * u[1], o2 = siluf_(g[2]) * u[2], o3 = siluf_(g[3]) * u[3];
                *(u32x2*)(HID + r * FH + hc + q * 16) = (u32x2){pk2(o0, o1), pk2(o2, o3)}; } }
    }
};
struct EpiWin1 {
    bf16_t* Q; bf16_t* K1; bf16_t* VT; const float* qn; const float* kn; const float* ROPE;
    template <int NM> DI void run(const f32x4 (&acc)[NM][4], int row0, int col0) const {
        const int cw = col0 & ~63, i0 = col0 & 15;
        if (cw >= 1280) {
#pragma unroll
            for (int m = 0; m < NM; ++m) { const int r = row0 + m * 16; const int b = row_batch(r), tp = row_tpos(r);
#pragma unroll
                for (int n = 0; n < 4; ++n) { const int cc = col0 + n * 16 - 1280, h = cc >> 6, d0 = cc & 63; const f32x4 v = acc[m][n];
                    bf16_t* d = VT + ((size_t)(b * 4 + h) * 64 + d0) * TK + tp; const unsigned p0 = pk2(v[0], v[1]), p1 = pk2(v[2], v[3]);
                    d[0] = (bf16_t)(p0 & 0xffff); d[TK] = (bf16_t)(p0 >> 16); d[2 * TK] = (bf16_t)(p1 & 0xffff); d[3 * TK] = (bf16_t)(p1 >> 16); } }
            return;
        }
        const bool isq = cw < 1024;
        const float* gn = isq ? qn : kn;
        f32x4 g[4];
#pragma unroll
        for (int n = 0; n < 4; ++n) g[n] = *(const f32x4*)(gn + n * 16 + i0);
        const float osc = isq ? 0.125f * LOG2E : 1.f;
#pragma unroll
        for (int m = 0; m < NM; ++m) { const int r = row0 + m * 16; const bool lat = r >= NCTX;
            if (isq && !lat) continue;
            const int b = row_batch(r), tp = row_tpos(r), t = tp - CTX;
            float ss = 0.f;
#pragma unroll
            for (int n = 0; n < 4; ++n) { const f32x4 v = acc[m][n]; ss += v[0] * v[0] + v[1] * v[1] + v[2] * v[2] + v[3] * v[3]; }
            ss += __shfl_xor(ss, 16); ss += __shfl_xor(ss, 32);
            const float rstd = rsqrtf(ss * (1.f / 64.f) + 1e-6f);
            f32x4 y[4];
#pragma unroll
            for (int n = 0; n < 4; ++n) y[n] = acc[m][n] * rstd * g[n];
            if (lat) { const float* rr = ROPE + ((t >> 6) * 16 + i0) * 2; const float* rc = ROPE + ((t & 63) * 16 + i0) * 2;
#pragma unroll
                for (int j = 0; j < 4; ++j) { const float c0 = rr[2 * j], s0 = rr[2 * j + 1], c1 = rc[2 * j], s1 = rc[2 * j + 1];
                    const float a0 = y[0][j], a1 = y[1][j], a2 = y[2][j], a3 = y[3][j];
                    y[0][j] = a0 * c0 - a1 * s0; y[1][j] = a1 * c0 + a0 * s0; y[2][j] = a2 * c1 - a3 * s1; y[3][j] = a3 * c1 + a2 * s1; } }
            bf16_t* dst = isq ? Q + (size_t)r * 1024 + cw + i0 : K1 + ((size_t)(b * 4 + ((cw - 1024) >> 6)) * TK + tp) * 64 + i0;
#pragma unroll
            for (int n = 0; n < 4; ++n) *(u32x2*)(dst + n * 16) = (u32x2){pk2(y[n][0] * osc, y[n][1] * osc), pk2(y[n][2] * osc, y[n][3] * osc)};
        }
    }
    DI void operator()(const f32x4 (&acc)[8][4], int row0, int col0, int gb) const { run<8>(acc, row0, col0); }
};

namespace pg8 {
constexpr int BM = 256, BK = 64, HALF = 128, HTB = HALF * BK * 2;
DI int lds_byte(int r, int c) { const int st = (r >> 4) * 2 + (c >> 5), rr = r & 15, cc = c & 31, ob = rr * 64 + cc * 2; return st * 1024 + (ob ^ (((ob >> 9) & 1) << 5)); }
DI void stage_rc(int b, int& R, int& C) { const int st = b / 1024, sb = b % 1024, swz = sb ^ (((sb >> 9) & 1) << 5); R = (st >> 1) * 16 + swz / 64; C = (st & 1) * 32 + (swz % 64) / 2; }
struct Unit { int pm, pn, gb; };
struct Gemm { const bf16_t* A; const bf16_t* Bt; int lda, K; size_t sA = 0, sB = 0; };
struct Order {
    int mt0, nmt, nnt, G, c, nbatch = 1;
    DI bool next(int i, Unit& u) const { const int L0 = i * G + c; if (L0 >= nbatch * nmt * nnt) return false; constexpr int PM = 8; const int gb_ = L0 / (nmt * nnt); const int L = L0 - gb_ * nmt * nnt; u.gb = gb_;
        const int ch = L / (PM * nnt), rm = L - ch * PM * nnt; const int pc = (nmt - ch * PM) < PM ? (nmt - ch * PM) : PM; const int tn = rm / pc;
        u.pm = mt0 + ch * PM + (rm - tn * pc); u.pn = tn; return true; }
};
template <class Epi>
DI void gemm_phase(LAS unsigned char* lds, const Gemm g, const Order& S, const Epi& E) {
    const int tid = get_tid(), wid = __builtin_amdgcn_readfirstlane(tid >> 6), lane = tid & 63, wr = wid >> 2, wc = wid & 3, fr = lane & 15, fq = lane >> 4;
    const int K = g.K, nt = K / BK;
    unsigned voffA[2], voffB[2];
#pragma unroll
    for (int i = 0; i < 2; ++i) { int R, C; stage_rc(tid * 16 + i * 8192, R, C); voffA[i] = (unsigned)(R * g.lda + C) * 2u; voffB[i] = (unsigned)(R * K + C) * 2u; }
    const size_t kstep = (size_t)(BK * 2);
    const size_t hstepA = (size_t)HALF * g.lda * 2, hstepB = (size_t)HALF * K * 2;
    const size_t tstepA = 2 * hstepA, tstepB = 2 * hstepB;
    const unsigned ldsw = (unsigned)wid * 1024u;
    const int aoff = lds_byte(wr * 64 + fr, fq * 8), boff = lds_byte(wc * 32 + fr, fq * 8);
#define PG8_SA(b, h) (((b) * 2 + (h)) * HTB)
#define PG8_SB(b, h) ((4 + (b) * 2 + (h)) * HTB)
#define PG8_STAGE(bufoff, gbase, voff) do { _Pragma("unroll") for (int _i = 0; _i < 2; ++_i) \
        __builtin_amdgcn_global_load_lds((const unsigned*)((const char*)(gbase) + (voff)[_i]), (LAS unsigned*)(lds + (bufoff) + ldsw + _i * 8192), 16, 0, 0); } while (0)
#define PG8_LDA(dst, b, h) do { _Pragma("unroll") for (int m = 0; m < 4; ++m) _Pragma("unroll") for (int k = 0; k < 2; ++k) dst[m][k] = *(const LAS bf16x8*)(lds + PG8_SA(b, h) + aoff + m * 2048 + k * 1024); } while (0)
#define PG8_LDB(dst, b, h) do { _Pragma("unroll") for (int n = 0; n < 2; ++n) _Pragma("unroll") for (int k = 0; k < 2; ++k) dst[n][k] = *(const LAS bf16x8*)(lds + PG8_SB(b, h) + boff + n * 2048 + k * 1024); } while (0)
#define PG8_MMA(ai, bj, At, Bt) do { __builtin_amdgcn_s_setprio(1); _Pragma("unroll") for (int m = 0; m < 4; ++m) _Pragma("unroll") for (int n = 0; n < 2; ++n) _Pragma("unroll") for (int k = 0; k < 2; ++k) \
        acc[ai][bj][m][n] = __builtin_amdgcn_mfma_f32_16x16x32_bf16(Bt[n][k], At[m][k], acc[ai][bj][m][n], 0, 0, 0); __builtin_amdgcn_s_setprio(0); } while (0)
#define PG8_WAIT_V(n) asm volatile("s_waitcnt vmcnt(" #n ")" ::: "memory")
#define PG8_WAIT_L(n) asm volatile("s_waitcnt lgkmcnt(" #n ")" ::: "memory")
#define PG8_BAR __builtin_amdgcn_s_barrier()
#define PG8_SCHED __builtin_amdgcn_sched_barrier(0)
    Unit cur, nxt; int ui = 0;
    if (!S.next(0, cur)) return;
    f32x4 acc[2][2][4][2];
#pragma unroll
    for (int a = 0; a < 2; ++a)
#pragma unroll
        for (int b = 0; b < 2; ++b)
#pragma unroll
            for (int m = 0; m < 4; ++m)
#pragma unroll
                for (int n = 0; n < 2; ++n) acc[a][b][m][n] = (f32x4){0.f, 0.f, 0.f, 0.f};
    bf16x8 At[4][2], B0[2][2], B1[2][2];
    const char* cA = (const char*)(g.A + (size_t)cur.gb * g.sA) + (size_t)cur.pm * tstepA; const char* cB = (const char*)(g.Bt + (size_t)cur.gb * g.sB) + (size_t)cur.pn * tstepB;
    PG8_STAGE(PG8_SB(0, 0), cB, voffB); PG8_STAGE(PG8_SB(0, 1), cB + hstepB, voffB); PG8_STAGE(PG8_SA(0, 0), cA, voffA); PG8_STAGE(PG8_SA(0, 1), cA + hstepA, voffA);
    if (wr == 1) PG8_BAR;
    PG8_WAIT_V(2); PG8_BAR;
    PG8_STAGE(PG8_SB(1, 0), cB + kstep, voffB); PG8_STAGE(PG8_SA(1, 0), cA + kstep, voffA); PG8_STAGE(PG8_SB(1, 1), cB + hstepB + kstep, voffB);
    PG8_WAIT_V(6); PG8_BAR;
    for (;;) {
        const bool has_next = S.next(ui + 1, nxt);
        const char* nA = has_next ? (const char*)(g.A + (size_t)nxt.gb * g.sA) + (size_t)nxt.pm * tstepA : cA; const char* nB = has_next ? (const char*)(g.Bt + (size_t)nxt.gb * g.sB) + (size_t)nxt.pn * tstepB : cB;
        for (int t = 0; t < nt; t += 2) {
            const bool last = (t == nt - 2);
            const char* a1 = cA + (size_t)(t + 1) * kstep;
            const char* a2 = last ? nA : cA + (size_t)(t + 2) * kstep; const char* b2 = last ? nB : cB + (size_t)(t + 2) * kstep;
            const char* a3 = a2 + kstep; const char* b3 = b2 + kstep;
            PG8_LDB(B0, 0, 0); PG8_LDB(B1, 0, 1); PG8_SCHED; PG8_LDA(At, 0, 0); PG8_STAGE(PG8_SA(1, 1), a1 + hstepA, voffA);
            PG8_WAIT_V(8); PG8_WAIT_L(0); PG8_BAR; PG8_MMA(0, 0, At, B0); PG8_MMA(0, 1, At, B1); PG8_BAR; PG8_SCHED;
            PG8_LDA(At, 0, 1); PG8_STAGE(PG8_SB(0, 0), b2, voffB); PG8_STAGE(PG8_SB(0, 1), b2 + hstepB, voffB); PG8_STAGE(PG8_SA(0, 0), a2, voffA);
            PG8_WAIT_V(8); PG8_WAIT_L(0); PG8_BAR; PG8_MMA(1, 0, At, B0); PG8_MMA(1, 1, At, B1); PG8_BAR; PG8_SCHED;
            PG8_LDB(B0, 1, 0); PG8_LDB(B1, 1, 1); PG8_SCHED; PG8_LDA(At, 1, 0); PG8_STAGE(PG8_SA(0, 1), a2 + hstepA, voffA);
            PG8_WAIT_V(8); PG8_WAIT_L(0); PG8_BAR; PG8_MMA(0, 0, At, B0); PG8_MMA(0, 1, At, B1); PG8_BAR; PG8_SCHED;
            PG8_LDA(At, 1, 1); PG8_STAGE(PG8_SB(1, 0), b3, voffB); PG8_STAGE(PG8_SB(1, 1), b3 + hstepB, voffB); PG8_STAGE(PG8_SA(1, 0), a3, voffA);
            PG8_WAIT_V(8); PG8_WAIT_L(0); PG8_BAR; PG8_MMA(1, 0, At, B0); PG8_MMA(1, 1, At, B1); PG8_BAR; PG8_SCHED;
        }
        if (wr == 0) PG8_BAR;
        E(acc, cur, wr, wc, fr, fq);
        if (!has_next) break;
#pragma unroll
        for (int a = 0; a < 2; ++a)
#pragma unroll
            for (int b = 0; b < 2; ++b)
#pragma unroll
                for (int m = 0; m < 4; ++m)
#pragma unroll
                    for (int n = 0; n < 2; ++n) acc[a][b][m][n] = (f32x4){0.f, 0.f, 0.f, 0.f};
        cur = nxt; cA = nA; cB = nB; ++ui;
        if (wr == 1) PG8_BAR;
    }
    PG8_WAIT_V(0);
    PG8_BAR;
#undef PG8_SA
#undef PG8_SB
#undef PG8_STAGE
#undef PG8_LDA
#undef PG8_LDB
#undef PG8_MMA
#undef PG8_WAIT_V
#undef PG8_WAIT_L
#undef PG8_BAR
#undef PG8_SCHED
}
struct EpiRes {
    const float* res_f; const bf16_t* res_h; bf16_t* dst_h; float* dst_f; const float* gate;
    DI void operator()(const f32x4 (&acc)[2][2][4][2], const Unit& u, int wr, int wc, int fr, int fq) const {
        const int row0 = u.pm * 256 + wr * 64 + fr, col0 = u.pn * 256 + wc * 32 + fq * 4;
#pragma unroll
        for (int ai = 0; ai < 2; ++ai)
#pragma unroll
            for (int m = 0; m < 4; ++m) { const int r = row0 + 128 * ai + 16 * m; const size_t ro = (size_t)(r - NCTX) * 1024; const float* gv = gate + row_vec(r) * 6144;
#pragma unroll
                for (int bj = 0; bj < 2; ++bj)
#pragma unroll
                    for (int n = 0; n < 2; ++n) { const int c = col0 + 128 * bj + 16 * n; const f32x4 g_ = *(const f32x4*)(gv + c);
                        const f32x4 x = res_h ? ld_bf4(res_h + ro + c) : *(const f32x4*)(res_f + ro + c);
                        const f32x4 y = x + g_ * acc[ai][bj][m][n];
                        if (dst_h) st_bf4(dst_h + ro + c, y); else *(f32x4*)(dst_f + ro + c) = y; } }
    }
};
struct EpiSwiGLU {
    bf16_t* HID;
    DI void operator()(const f32x4 (&acc)[2][2][4][2], const Unit& u, int wr, int wc, int fr, int fq) const {
        const int row0 = u.pm * 256 + wr * 64 + fr, hc0 = u.pn * 128 + wc * 16 + fq * 4;
#pragma unroll
        for (int ai = 0; ai < 2; ++ai)
#pragma unroll
            for (int m = 0; m < 4; ++m) { const size_t r = row0 + 128 * ai + 16 * m;
#pragma unroll
                for (int bj = 0; bj < 2; ++bj) { const f32x4 g_ = acc[ai][bj][m][0], u_ = acc[ai][bj][m][1];
                    const float o0 = siluf_(g_[0]) * u_[0], o1 = siluf_(g_[1]) * u_[1], o2 = siluf_(g_[2]) * u_[2], o3 = siluf_(g_[3]) * u_[3];
                    *(u32x2*)(HID + r * FH + hc0 + 64 * bj) = (u32x2){pk2(o0, o1), pk2(o2, o3)}; } }
    }
};
struct EpiS1a {
    float* E;
    DI void operator()(const f32x4 (&acc)[2][2][4][2], const Unit& u, int wr, int wc, int fr, int fq) const {
        const int row0 = u.pm * 256 + wr * 64 + fr, col0 = u.pn * 256 + wc * 32 + fq * 4;
#pragma unroll
        for (int ai = 0; ai < 2; ++ai)
#pragma unroll
            for (int m = 0; m < 4; ++m) { const int r = row0 + 128 * ai + 16 * m; if (r >= CHR) continue;
#pragma unroll
                for (int bj = 0; bj < 2; ++bj)
#pragma unroll
                    for (int n = 0; n < 2; ++n) *(f32x4*)(E + ((size_t)u.gb * CHR + r) * 256 + col0 + 128 * bj + 16 * n) = acc[ai][bj][m][n]; }
    }
};
struct EpiS1b {
    bf16_t* YG;
    DI void operator()(const f32x4 (&acc)[2][2][4][2], const Unit& u, int wr, int wc, int fr, int fq) const {
        const int row0 = u.pm * 256 + wr * 64 + fr, col0 = u.pn * 256 + wc * 32 + fq * 4;
#pragma unroll
        for (int ai = 0; ai < 2; ++ai)
#pragma unroll
            for (int m = 0; m < 4; ++m) { const int r = row0 + 128 * ai + 16 * m; if (r >= CHR) continue; const int b = r / NCK, c = r % NCK;
#pragma unroll
                for (int bj = 0; bj < 2; ++bj)
#pragma unroll
                    for (int n = 0; n < 2; ++n) { const int cc = col0 + 128 * bj + 16 * n; const int tl = cc >> 4, s0 = cc & 15; const f32x4 v = acc[ai][bj][m][n];
                        const int tp = c * SL + tl; const size_t row = tp < CTX ? (size_t)b * CTX + tp : (size_t)NCTX + (size_t)b * SEQ + (tp - CTX);
                        *(u32x2*)(YG + row * 512 + u.gb * 16 + s0) = (u32x2){pk2(gelu_tanh(v[0]), gelu_tanh(v[1])), pk2(gelu_tanh(v[2]), gelu_tanh(v[3]))}; } }
    }
};
template <class E> struct EpiHead { E e;
    DI void operator()(const f32x4 (&acc)[2][2][4][2], const Unit& u, int wr, int wc, int fr, int fq) const {
#pragma unroll
        for (int ai = 0; ai < 2; ++ai) { f32x4 t[4][4];
#pragma unroll
            for (int m = 0; m < 4; ++m)
#pragma unroll
                for (int sb = 0; sb < 4; ++sb) t[m][sb] = acc[ai][sb >> 1][m][sb & 1];
            e.template run<4>(t, u.pm * 256 + 128 * ai + wr * 64 + fr, u.pn * 256 + wc * 64 + fq * 4); }
    }
};
}

template <int DQK, int DV, bool WIN>
DI void attn_item(char* lds, const bf16_t* Q, int qstride, const bf16_t* Kb, const bf16_t* VTb, int ta0, int ta1, int tb0, int tb1,
                  float mref, float l_init, bf16_t* O, int ostride, int qpos0) {
    constexpr int NKS = DQK / 16, NDT = DV / 32, KSTR = DQK + 8, VSTR = 72, NG = NKS;
    constexpr int KCH = 64 * DQK / 8 / NTHREADS, VCH = DV * 8 / NTHREADS;
    constexpr int KBUF = 64 * KSTR, VBUF = DV * VSTR;
    bf16_t* Ks = (bf16_t*)lds; bf16_t* Vs = Ks + 2 * KBUF;
    const int tid = get_tid(), lane = tid & 63, wid = tid >> 6, r = lane & 31, h2 = lane >> 5;
    bf16x8 qf[NKS];
    { const bf16_t* qrow = Q + (size_t)(wid * 32 + r) * qstride + 8 * h2;
#pragma unroll
      for (int ks = 0; ks < NKS; ++ks) qf[ks] = *(const bf16x8*)(qrow + 16 * ks); }
    f32x16 o[NDT];
#pragma unroll
    for (int dt = 0; dt < NDT; ++dt)
#pragma unroll
        for (int i = 0; i < 16; ++i) o[dt][i] = 0.f;
    float lrun = (h2 == 0) ? l_init : 0.f;
    const int na = ta1 - ta0, ntot = na + (tb1 - tb0);
    u32x4 kr[KCH], vr[VCH];
    constexpr int KTPR = (DQK / 8) / KCH, VTPR = 8 / VCH;
    const int krow = tid / KTPR, kcol = (tid % KTPR) * (KCH * 8);
    const int vrow = tid / VTPR, vcol = (tid % VTPR) * (VCH * 8);
    const bf16_t* kgp = Kb + (size_t)krow * DQK + kcol;
    const bf16_t* vgp = VTb + (size_t)vrow * TK + vcol;
    bf16_t* ksp = Ks + krow * KSTR + kcol;
    bf16_t* vsp = Vs + vrow * VSTR + vcol;
    const bf16_t* kfp = Ks + r * KSTR + 8 * h2;
    const bf16_t* vfp = Vs + r * VSTR + 8 * h2;
#define A_TILE(itv) (((itv) < na) ? ta0 + (itv) : tb0 + ((itv) - na))
#define K_LOAD(itv) do { const bf16_t* kg = kgp + (size_t)A_TILE(itv) * 64 * DQK; _Pragma("unroll") for (int i = 0; i < KCH; ++i) kr[i] = *(const u32x4*)(kg + i * 8); } while (0)
#define V_LOADG(itv) do { const bf16_t* vg = vgp + A_TILE(itv) * 64; _Pragma("unroll") for (int i = 0; i < VCH; ++i) vr[i] = *(const u32x4*)(vg + i * 8); } while (0)
#define K_WRITE(bo) do { _Pragma("unroll") for (int i = 0; i < KCH; ++i) *(u32x4*)(ksp + (bo) + i * 8) = kr[i]; } while (0)
#define V_WRITE(bo) do { _Pragma("unroll") for (int i = 0; i < VCH; ++i) { const int c_ = (vcol >> 3) + i; bf16_t* d_ = vsp - vcol + (bo) + (c_ >> 1) * 16 + (c_ & 1) * 4; \
            *(u32x2*)d_ = (u32x2){vr[i][0], vr[i][1]}; *(u32x2*)(d_ + 8) = (u32x2){vr[i][2], vr[i][3]}; } } while (0)
#define T_ACTIVE(itv) (!(WIN && A_TILE(itv) >= 4 && ((A_TILE(itv) - 4) * 64 > qpos0 + wid * 32 + 31 + 128 || (A_TILE(itv) - 4) * 64 + 63 < qpos0 + wid * 32 - 128)))
#define S_MASK(S0, S1, itv) do { if (WIN && A_TILE(itv) >= 4) { const int qp = qpos0 + wid * 32 + r, kp0 = (A_TILE(itv) - 4) * 64 + 4 * h2; \
        _Pragma("unroll") for (int i = 0; i < 16; ++i) { const int d0 = kp0 + (i & 3) + 8 * (i >> 2) - qp, d1 = d0 + 32; \
            if (d0 > 128 || d0 < -128) S0[i] = -1e30f; if (d1 > 128 || d1 < -128) S1[i] = -1e30f; } } } while (0)
    f32x16 s0, s1;
    __syncthreads();
    K_LOAD(0); K_WRITE(0);
    if (1 < ntot) K_LOAD(1);
    V_LOADG(0);
    __syncthreads();
#pragma unroll
    for (int i = 0; i < 16; ++i) { s0[i] = -mref; s1[i] = -mref; }
#pragma unroll 1
    for (int it = -1; it < ntot; ++it) {
        const int kb_n = ((it + 1) & 1) * KBUF, vb_c = (it & 1) * VBUF;
        if (it + 2 < ntot) K_WRITE((it & 1) * KBUF);
        if (it + 1 < ntot) V_WRITE(((it + 1) & 1) * VBUF);
        __builtin_amdgcn_sched_barrier(0);
        const bool act_c = (it >= 0) && T_ACTIVE(it), act_n = (it + 1 < ntot) && T_ACTIVE(it + 1);
        f32x16 n0, n1;
#pragma unroll
        for (int i = 0; i < 16; ++i) { n0[i] = -mref; n1[i] = -mref; }
        float rs = 0.f;
        unsigned pk[16];
#define P_PAIR(j) do { const float e0_ = __builtin_amdgcn_exp2f((j) < 8 ? s0[2 * ((j) & 7)] : s1[2 * ((j) & 7)]), e1_ = __builtin_amdgcn_exp2f((j) < 8 ? s0[2 * ((j) & 7) + 1] : s1[2 * ((j) & 7) + 1]); rs += e0_ + e1_; pk[j] = pk2(e0_, e1_); } while (0)
        if (act_c && act_n) {
#pragma unroll
            for (int g = 0; g < NG; ++g) {
                const bf16x8 ka = *(const bf16x8*)(kfp + kb_n + 16 * g), kb = *(const bf16x8*)(kfp + kb_n + 32 * KSTR + 16 * g);
                n0 = __builtin_amdgcn_mfma_f32_32x32x16_bf16(ka, qf[g], n0, 0, 0, 0);
                n1 = __builtin_amdgcn_mfma_f32_32x32x16_bf16(kb, qf[g], n1, 0, 0, 0);
#pragma unroll
                for (int j = (16 * g) / NG; j < (16 * (g + 1)) / NG; ++j) P_PAIR(j);
            }
            S_MASK(n0, n1, it + 1);
        } else {
            if (act_n) {
#pragma unroll
                for (int ks = 0; ks < NKS; ++ks) { const bf16x8 k0 = *(const bf16x8*)(kfp + kb_n + 16 * ks), k1 = *(const bf16x8*)(kfp + kb_n + 32 * KSTR + 16 * ks);
                    n0 = __builtin_amdgcn_mfma_f32_32x32x16_bf16(k0, qf[ks], n0, 0, 0, 0); n1 = __builtin_amdgcn_mfma_f32_32x32x16_bf16(k1, qf[ks], n1, 0, 0, 0); }
                S_MASK(n0, n1, it + 1);
            }
            if (act_c) {
#pragma unroll
                for (int j = 0; j < 16; ++j) P_PAIR(j);
            }
        }
#undef P_PAIR
        __builtin_amdgcn_sched_barrier(0);
        if (it + 3 < ntot) K_LOAD(it + 3);
        if (it + 2 < ntot) V_LOADG(it + 2);
        __builtin_amdgcn_sched_barrier(0);
        if (act_c) {
            lrun += rs;
#pragma unroll
            for (int q = 0; q < 4; ++q) {
                const u32x4 pw = {pk[4 * q], pk[4 * q + 1], pk[4 * q + 2], pk[4 * q + 3]};
                const bf16x8 pf = __builtin_bit_cast(bf16x8, pw);
#pragma unroll
                for (int dt = 0; dt < NDT; ++dt) { const bf16x8 vf = *(const bf16x8*)(vfp + vb_c + (32 * dt) * VSTR + 16 * q);
                    o[dt] = __builtin_amdgcn_mfma_f32_32x32x16_bf16(vf, pf, o[dt], 0, 0, 0); }
            }
        }
        s0 = n0; s1 = n1;
        __syncthreads();
    }
#undef A_TILE
#undef K_LOAD
#undef V_LOADG
#undef K_WRITE
#undef V_WRITE
#undef T_ACTIVE
#undef S_MASK
    lrun += __shfl_xor(lrun, 32);
    const float inv = 1.f / lrun;
    bf16_t* orow = O + (size_t)(wid * 32 + r) * ostride;
#pragma unroll
    for (int dt = 0; dt < NDT; ++dt)
#pragma unroll
        for (int g = 0; g < 4; ++g)
            *(u32x2*)(orow + 32 * dt + 8 * g + 4 * h2) = (u32x2){pk2(o[dt][4 * g] * inv, o[dt][4 * g + 1] * inv), pk2(o[dt][4 * g + 2] * inv, o[dt][4 * g + 3] * inv)};
    __syncthreads();
}

template <int NH>
DI void win_attn_item(char* lds, const bf16_t* Q, const bf16_t* Kb, const bf16_t* VTb, int tb0, int tb1, float mref, const float* sinkp, bf16_t* O, int qpos0) {
    constexpr int KSTR = 72, VSTR = 72, KBUF = 64 * KSTR, VBUF = 64 * VSTR;
    bf16_t* Ks = (bf16_t*)lds; bf16_t* Vs = Ks + 2 * KBUF;
    const int tid = get_tid(), lane = tid & 63, wid = tid >> 6, r = lane & 31, h2 = lane >> 5;
    bf16x8 qf[NH][4];
#pragma unroll
    for (int h = 0; h < NH; ++h) { const bf16_t* qrow = Q + (size_t)(wid * 32 + r) * 1024 + h * 64 + 8 * h2;
#pragma unroll
        for (int ks = 0; ks < 4; ++ks) qf[h][ks] = *(const bf16x8*)(qrow + 16 * ks); }
    f32x16 o[NH][2]; float lrun[NH];
#pragma unroll
    for (int h = 0; h < NH; ++h) { lrun[h] = (h2 == 0) ? __builtin_amdgcn_exp2f(sinkp[h] * LOG2E - mref) : 0.f;
#pragma unroll
        for (int dt = 0; dt < 2; ++dt)
#pragma unroll
            for (int i = 0; i < 16; ++i) o[h][dt][i] = 0.f; }
    const int na = 4, ntot = na + (tb1 - tb0);
    u32x4 kr, vr;
    const int krow = tid >> 3, kcol = (tid & 7) * 8;
    const bf16_t* kgp = Kb + (size_t)krow * 64 + kcol;
    const bf16_t* vgp = VTb + (size_t)krow * TK + kcol;
    bf16_t* ksp = Ks + krow * KSTR + kcol;
    bf16_t* vsp = Vs + krow * VSTR + (kcol >> 4) * 16 + ((kcol >> 3) & 1) * 4;
    const bf16_t* kfp = Ks + r * KSTR + 8 * h2;
    const bf16_t* vfp = Vs + r * VSTR + 8 * h2;
#define W_TILE(itv) (((itv) < na) ? (itv) : tb0 + ((itv) - na))
#define W_LOAD(itv) do { kr = *(const u32x4*)(kgp + (size_t)W_TILE(itv) * 64 * 64); vr = *(const u32x4*)(vgp + W_TILE(itv) * 64); } while (0)
#define W_WRITE(kb_, vb_) do { *(u32x4*)(ksp + (kb_)) = kr; *(u32x2*)(vsp + (vb_)) = (u32x2){vr[0], vr[1]}; *(u32x2*)(vsp + (vb_) + 8) = (u32x2){vr[2], vr[3]}; } while (0)
    __syncthreads();
    W_LOAD(0); W_WRITE(0, 0);
    if (1 < ntot) W_LOAD(1);
    __syncthreads();
#pragma unroll 1
    for (int it = 0; it < ntot; ++it) {
        const int T = W_TILE(it);
        const int kb = (it & 1) * KBUF, vb = (it & 1) * VBUF;
        if (it + 1 < ntot) W_WRITE(KBUF - kb, VBUF - vb);
        if (it + 2 < ntot) W_LOAD(it + 2);
        bool active = true, need_mask = false;
        if (T >= 4) { const int klo = (T - 4) * 64, qlo = qpos0 + wid * 32;
            active = !(klo > qlo + 31 + 128 || klo + 63 < qlo - 128);
            need_mask = (klo < qlo + 31 - 128) || (klo + 63 > qlo + 128); }
        if (active) {
#pragma unroll
            for (int h = 0; h < NH; ++h) {
                __builtin_amdgcn_sched_barrier(0);
                f32x16 s0, s1;
#pragma unroll
                for (int i = 0; i < 16; ++i) { s0[i] = -mref; s1[i] = -mref; }
#pragma unroll
                for (int ks = 0; ks < 4; ++ks) { const bf16x8 k0 = *(const bf16x8*)(kfp + kb + 16 * ks), k1 = *(const bf16x8*)(kfp + kb + 32 * KSTR + 16 * ks);
                    s0 = __builtin_amdgcn_mfma_f32_32x32x16_bf16(k0, qf[h][ks], s0, 0, 0, 0); s1 = __builtin_amdgcn_mfma_f32_32x32x16_bf16(k1, qf[h][ks], s1, 0, 0, 0); }
                if (need_mask) { const int qp = qpos0 + wid * 32 + r, kp0 = (T - 4) * 64 + 4 * h2;
#pragma unroll
                    for (int i = 0; i < 16; ++i) { const int d0 = kp0 + (i & 3) + 8 * (i >> 2) - qp, d1 = d0 + 32;
                        if (d0 > 128 || d0 < -128) s0[i] = -1e30f; if (d1 > 128 || d1 < -128) s1[i] = -1e30f; } }
                float rs = 0.f; unsigned pk[16];
#pragma unroll
                for (int j = 0; j < 8; ++j) { const float a0 = __builtin_amdgcn_exp2f(s0[2 * j]), a1 = __builtin_amdgcn_exp2f(s0[2 * j + 1]), b0 = __builtin_amdgcn_exp2f(s1[2 * j]), b1 = __builtin_amdgcn_exp2f(s1[2 * j + 1]);
                    rs += (a0 + a1) + (b0 + b1); pk[j] = pk2(a0, a1); pk[8 + j] = pk2(b0, b1); }
                lrun[h] += rs;
                __builtin_amdgcn_sched_barrier(0);
#pragma unroll
                for (int q = 0; q < 4; ++q) { const u32x4 pw = {pk[4 * q], pk[4 * q + 1], pk[4 * q + 2], pk[4 * q + 3]}; const bf16x8 pf = __builtin_bit_cast(bf16x8, pw);
#pragma unroll
                    for (int dt = 0; dt < 2; ++dt) { const bf16x8 vf = *(const bf16x8*)(vfp + vb + (32 * dt) * VSTR + 16 * q);
                        o[h][dt] = __builtin_amdgcn_mfma_f32_32x32x16_bf16(vf, pf, o[h][dt], 0, 0, 0); } }
            }
        }
        __syncthreads();
    }
#undef W_TILE
#undef W_LOAD
#undef W_WRITE
#pragma unroll
    for (int h = 0; h < NH; ++h) { float l = lrun[h]; l += __shfl_xor(l, 32); const float inv = 1.f / l;
        bf16_t* orow = O + (size_t)(wid * 32 + r) * 1024 + h * 64;
#pragma unroll
        for (int dt = 0; dt < 2; ++dt)
#pragma unroll
            for (int g = 0; g < 4; ++g)
                *(u32x2*)(orow + 32 * dt + 8 * g + 4 * h2) = (u32x2){pk2(o[h][dt][4 * g] * inv, o[h][dt][4 * g + 1] * inv), pk2(o[h][dt][4 * g + 2] * inv, o[h][dt][4 * g + 3] * inv)}; }
    __syncthreads();
}

DI void s5_kk_phase(char* lds, const Params& p) {
    const int tid512 = get_tid(); const int tid = tid512 & 255, s = tid >> 4, sp = tid & 15, dh = tid512 >> 8;
    f32x2* sbb = (f32x2*)lds;
    f32x2* scc = sbb + 1024;
    f32x2* spw = scc + 1024;
    const f32x2* POW = (const f32x2*)(p.ws + H_POW); const f32x2* BB = (const f32x2*)(p.ws + T_BBAR); float* KK = (float*)(p.ws + H_KK);
    for (int it = blockIdx.x; it < 32 * 2 * 4; it += gridDim.x) {
        const int dq = it & 3, dir = (it >> 2) & 1, g = it >> 3; const int dg = dir * 32 + g;
        __syncthreads();
        for (int i = tid512; i < 1024; i += NTHREADS) { sbb[i] = BB[(size_t)dg * 1024 + i]; scc[i] = (f32x2){p.in[18][(size_t)dg * 1024 + i], p.in[19][(size_t)dg * 1024 + i]}; }
        { const int i = tid512; spw[i] = POW[((size_t)dg * 33 + dq * 8 + (i >> 6)) * 64 + (i & 63)]; }
        __syncthreads();
        float acc[4] = {0.f, 0.f, 0.f, 0.f};
#pragma unroll 4
        for (int pp = 0; pp < 64; ++pp) { const f32x2 bb = sbb[pp * 16 + sp], cc = scc[s * 64 + pp];
#pragma unroll
            for (int q = 0; q < 4; ++q) { const f32x2 pw = spw[(dh * 4 + q) * 64 + pp];
                const float zr = pw[0] * bb[0] - pw[1] * bb[1], zi = pw[0] * bb[1] + pw[1] * bb[0];
                acc[q] += cc[0] * zr - cc[1] * zi; } }
#pragma unroll
        for (int q = 0; q < 4; ++q) KK[(size_t)((g * 2 + dir) * 32 + dq * 8 + dh * 4 + q) * 256 + tid] = acc[q];
    }
    __syncthreads();
}
DI void s5_w1a_phase(const Params& p) {
    const int tid = get_tid();
    const f32x2* POW = (const f32x2*)(p.ws + H_POW); const f32x2* BB = (const f32x2*)(p.ws + T_BBAR); bf16_t* W = (bf16_t*)(p.ws + H_W1A);
    for (int idx = blockIdx.x * NTHREADS + tid; idx < 2048 * 256; idx += gridDim.x * NTHREADS) {
        const int kq = idx & 63, n = (idx >> 6) & 255, g = idx >> 14;
        const int dir = n >> 7, ri = (n >> 6) & 1, pp = n & 63; const int e = (dir * 32 + g) * 64 + pp; const int tl = kq >> 1, s0 = (kq & 1) * 8;
        const f32x2 pw = POW[((size_t)(dir * 32 + g) * 33 + (dir ? tl : 31 - tl)) * 64 + pp];
        float v[8];
#pragma unroll
        for (int j = 0; j < 8; ++j) { const f32x2 bb = BB[e * 16 + s0 + j]; v[j] = ri ? pw[0] * bb[1] + pw[1] * bb[0] : pw[0] * bb[0] - pw[1] * bb[1]; }
        *(u32x4*)(W + ((size_t)g * 256 + n) * 512 + kq * 8) = (u32x4){pk2(v[0], v[1]), pk2(v[2], v[3]), pk2(v[4], v[5]), pk2(v[6], v[7])};
    }
}
DI void s5_w1b_phase(const Params& p) {
    const int tid = get_tid();
    const f32x2* __restrict__ POW = (const f32x2*)(p.ws + H_POW); const float* __restrict__ KK = (const float*)(p.ws + H_KK); bf16_t* __restrict__ W = (bf16_t*)(p.ws + A_W1B);
    const float* __restrict__ CRE = p.in[18]; const float* __restrict__ CIM = p.in[19]; const float* __restrict__ DSK = p.in[20];
#pragma unroll 2
    for (int idx = blockIdx.x * NTHREADS + tid; idx < 32 * 512 * 64; idx += gridDim.x * NTHREADS) {
        const int kq = idx & 63, n = (idx >> 6) & 511, g = idx >> 15;
        const int tl = n >> 4, s = n & 15, tl2 = kq >> 1, s0 = (kq & 1) * 8;
        const int d0 = tl - tl2, d1 = tl2 - tl;
        const float* k0 = KK + (size_t)((g * 2 + 0) * 32 + (d0 < 0 ? 0 : d0)) * 256 + s * 16 + s0;
        const float* k1 = KK + (size_t)((g * 2 + 1) * 32 + (d1 < 0 ? 0 : d1)) * 256 + s * 16 + s0;
        const f32x4 a0 = *(const f32x4*)k0, a1 = *(const f32x4*)(k0 + 4), b0 = *(const f32x4*)k1, b1 = *(const f32x4*)(k1 + 4);
        const float w0 = d0 >= 0 ? 1.f : 0.f, w1 = d1 >= 0 ? 1.f : 0.f;
        f32x4 x0 = a0 * w0 + b0 * w1, x1 = a1 * w0 + b1 * w1;
        if (tl2 == tl && (s >> 3) == (kq & 1)) { const float dv = DSK[g * 16 + s];
#pragma unroll
            for (int j = 0; j < 4; ++j) { if (j == (s & 7)) x0[j] += dv; if (4 + j == (s & 7)) x1[j] += dv; } }
        *(u32x4*)(W + ((size_t)g * 512 + n) * 768 + kq * 8) = (u32x4){pk2(x0[0], x0[1]), pk2(x0[2], x0[3]), pk2(x1[0], x1[1]), pk2(x1[2], x1[3])};
    }
#pragma unroll 2
    for (int idx = blockIdx.x * NTHREADS + tid; idx < 32 * 512 * 32; idx += gridDim.x * NTHREADS) {
        const int kb = idx & 31, n = (idx >> 5) & 511, g = idx >> 14;
        const int tl = n >> 4, s = n & 15, k2 = kb * 8; const int dir = k2 >> 7, ri = (k2 >> 6) & 1, p0 = k2 & 63;
        const float* cre = CRE + ((size_t)(dir * 32 + g) * 16 + s) * 64 + p0; const float* cim = CIM + ((size_t)(dir * 32 + g) * 16 + s) * 64 + p0;
        const f32x2* pwp = POW + ((size_t)(dir * 32 + g) * 33 + (dir ? 32 - tl : tl + 1)) * 64 + p0;
        const f32x4 cr0 = *(const f32x4*)cre, cr1 = *(const f32x4*)(cre + 4), ci0 = *(const f32x4*)cim, ci1 = *(const f32x4*)(cim + 4);
        const f32x4 pa = *(const f32x4*)pwp, pb = *(const f32x4*)(pwp + 2), pc = *(const f32x4*)(pwp + 4), pd = *(const f32x4*)(pwp + 6);
        float v[8];
        const float pr[8] = {pa[0], pa[2], pb[0], pb[2], pc[0], pc[2], pd[0], pd[2]}, pi[8] = {pa[1], pa[3], pb[1], pb[3], pc[1], pc[3], pd[1], pd[3]};
#pragma unroll
        for (int j = 0; j < 8; ++j) { const float cr = j < 4 ? cr0[j & 3] : cr1[j & 3], ci = j < 4 ? ci0[j & 3] : ci1[j & 3];
            v[j] = ri ? -(cr * pi[j] + ci * pr[j]) : cr * pr[j] - ci * pi[j]; }
        *(u32x4*)(W + ((size_t)g * 512 + n) * 768 + 512 + kb * 8) = (u32x4){pk2(v[0], v[1]), pk2(v[2], v[3]), pk2(v[4], v[5]), pk2(v[6], v[7])};
    }
}
DI void s5_carry_phase(const Params& p) {
    const int tid_ = get_tid(); const int lane = tid_ & 63, wid = tid_ >> 6;
    const f32x2* POW = (const f32x2*)(p.ws + H_POW); const float* E = (const float*)(p.ws + H_E); bf16_t* UA = (bf16_t*)(p.ws + H_UA);
    for (int it = ((int)gridDim.x - 1 - (int)blockIdx.x) * NWV + wid; it < 2 * 2 * 32; it += gridDim.x * NWV) {
        const int g = it & 31, dir = (it >> 5) & 1, b = it >> 6;
        const f32x2 l32 = POW[((size_t)(dir * 32 + g) * 33 + 32) * 64 + lane];
        float hr = 0.f, hi = 0.f;
        float er[8], ei[8], fr_[8], fi_[8];
#define C_IDX(i_) ((size_t)g * CHR + b * NCK + (dir ? ((i_) < 8 ? 7 - (i_) : NCK - 1 - ((i_) - 8)) : (i_)))
#define C_LOAD(R, I, i0_) do { _Pragma("unroll") for (int j = 0; j < 8; ++j) { const size_t m = C_IDX((i0_) + j); R[j] = E[m * 256 + dir * 128 + lane]; I[j] = E[m * 256 + dir * 128 + 64 + lane]; } } while (0)
#define C_STEP(R, I, i0_) do { _Pragma("unroll") for (int j = 0; j < 8; ++j) { const size_t m = C_IDX((i0_) + j); bf16_t* u = UA + m * 768 + 512 + dir * 128 + lane; \
            u[0] = (bf16_t)(pk2(hr, 0.f) & 0xffff); u[64] = (bf16_t)(pk2(hi, 0.f) & 0xffff); \
            const float nr = l32[0] * hr - l32[1] * hi + R[j], ni = l32[0] * hi + l32[1] * hr + I[j]; hr = nr; hi = ni; } } while (0)
        C_LOAD(er, ei, 0);
        for (int i0 = 0; i0 < NCK; i0 += 16) {
            if (i0 + 8 < NCK) C_LOAD(fr_, fi_, i0 + 8);
            C_STEP(er, ei, i0);
            if (i0 + 8 < NCK) { if (i0 + 16 < NCK) C_LOAD(er, ei, i0 + 16); C_STEP(fr_, fi_, i0 + 8); }
        }
#undef C_IDX
#undef C_LOAD
#undef C_STEP
    }
}

DI float rope64(float x, int lane, const float* ROPE, int rpos, int cpos) {
    const float partner = __shfl_xor(x, 16);
    const int i = lane & 15; const int pos = lane < 32 ? rpos : cpos;
    const float c = ROPE[(pos * 16 + i) * 2], s = ROPE[(pos * 16 + i) * 2 + 1];
    return (lane & 16) ? x * c + partner * s : x * c - partner * s;
}
DI void mla_prep_phase(const Params& p) {
    const int tid_ = get_tid(); const int lane = tid_ & 63, wid = tid_ >> 6;
    bf16_t* QR = (bf16_t*)(p.ws + S_QRAW); const bf16_t* KN = (const bf16_t*)(p.ws + S_KNOPE); const float* KR = (const float*)(p.ws + H_KR);
    bf16_t* KA = (bf16_t*)(p.ws + S_KA); const float* ROPE = (const float*)(p.ws + T_ROPE);
    const float qsc = 0.07216878364870323f * LOG2E;
    const float qg0 = p.in[27][lane], qg1 = p.in[27][64 + lane], qg2 = p.in[27][128 + lane];
    const float kg0 = p.in[28][lane], kg1 = p.in[28][64 + lane], kg2 = p.in[28][128 + lane];
    const int nbusy = (int)gridDim.x < 192 ? (int)gridDim.x : 192, nslots = nbusy + 3 * ((int)gridDim.x - nbusy);
    const int vb_ = virt_block();
    const int myslots = vb_ < nbusy ? 1 : 3, slot0 = vb_ < nbusy ? vb_ : nbusy + 3 * (vb_ - nbusy);
    for (int sj = 0; sj < myslots; ++sj)
    for (int r = (slot0 + sj) * NWV + wid; r < NR; r += nslots * NWV) {
        const bool lat = r >= NCTX; const int b = row_batch(r), tp = row_tpos(r); const int t = tp - CTX;
        const bf16_t* q = QR + (size_t)r * 768; const bf16_t* kn = KN + (size_t)r * 512;
        float x[4][3], k[4][3];
        const float krv = KR[(size_t)r * 64 + lane];
#pragma unroll
        for (int h = 0; h < 4; ++h) { x[h][0] = bf2f(q[h * 192 + lane]); x[h][1] = bf2f(q[h * 192 + 64 + lane]); x[h][2] = bf2f(q[h * 192 + 128 + lane]);
            k[h][0] = bf2f(kn[h * 128 + lane]); k[h][1] = bf2f(kn[h * 128 + 64 + lane]); k[h][2] = krv; }
        float rc = 1.f, rsn = 0.f;
        if (lat) { const int pos = lane < 32 ? (t >> 6) : (t & 63); rc = ROPE[(pos * 16 + (lane & 15)) * 2]; rsn = ROPE[(pos * 16 + (lane & 15)) * 2 + 1]; }
        const float sgn = (lane & 16) ? 1.f : -1.f;
#pragma unroll
        for (int h = 0; h < 4; ++h) {
            float ss = wave_sum(x[h][0] * x[h][0] + x[h][1] * x[h][1] + x[h][2] * x[h][2]);
            float rs = rsqrtf(ss * (1.f / 192.f) + 1e-6f) * qsc;
            const float x0 = x[h][0] * rs * qg0, x1 = x[h][1] * rs * qg1; float x2 = x[h][2] * rs * qg2;
            x2 = x2 * rc + sgn * __shfl_xor(x2, 16) * rsn;
            bf16_t* qd = QR + (size_t)r * 768 + h * 192;
            qd[lane] = (bf16_t)(pk2(x0, 0.f) & 0xffff); qd[64 + lane] = (bf16_t)(pk2(x1, 0.f) & 0xffff); qd[128 + lane] = (bf16_t)(pk2(x2, 0.f) & 0xffff);
            ss = wave_sum(k[h][0] * k[h][0] + k[h][1] * k[h][1] + k[h][2] * k[h][2]);
            rs = rsqrtf(ss * (1.f / 192.f) + 1e-6f);
            const float k0 = k[h][0] * rs * kg0, k1 = k[h][1] * rs * kg1; float k2 = k[h][2] * rs * kg2;
            k2 = k2 * rc + sgn * __shfl_xor(k2, 16) * rsn;
            bf16_t* kd = KA + ((size_t)(b * 4 + h) * TK + tp) * 192;
            kd[lane] = (bf16_t)(pk2(k0, 0.f) & 0xffff); kd[64 + lane] = (bf16_t)(pk2(k1, 0.f) & 0xffff); kd[128 + lane] = (bf16_t)(pk2(k2, 0.f) & 0xffff);
        }
    }
}

__global__ void __launch_bounds__(NTHREADS, 2) fwd_kernel(Params p) {
    extern __shared__ __attribute__((aligned(16))) char lds[];
    cg::grid_group grid = cg::this_grid();
    char* ws = p.ws;
    const bf16_t* WB = (const bf16_t*)ws;
    const float* MOD = (const float*)(ws + T_MOD);
    float* H = (float*)(ws + OFF_H);
    bf16_t* Hb = (bf16_t*)(ws + OFF_H);
    bf16_t* A0 = (bf16_t*)(ws + OFF_A0);
    const int bid = blockIdx.x, nb = gridDim.x;
    const int vbid = virt_block();
    volatile LAS unsigned* xst = (volatile LAS unsigned*)(lds + (LDS_BYTES - 16));
    if (threadIdx.x == 0) { xst[0] = 0u; xst[1] = 0u; }
    __syncthreads();
    const XcdBarrier xb = xcd_barrier_post((unsigned*)(ws + T_BAR), xst);
    if (p.pad == 0x7fffffff) grid.sync();
#define GRID_SYNC() xcd_barrier(xb)

    { const int npair = p.jobs[4].tile0 >> 1, nit = 192 + 12 + npair;
      for (int it = bid; it < nit; it += nb) {
          if (it < 192) ada_item(lds, p, it);
          else if (it < 204) tables_item(p, it - 192);
          else { const int lt0 = (it - 204) * 2 + (int)(threadIdx.x >> 8); const bool live = lt0 < p.jobs[4].tile0; const int lt = live ? lt0 : 0; int j = 0;
#pragma unroll
              for (int q = 1; q < 11; ++q) if (lt >= p.jobs[q].tile0) j = q;
              transpose_tile(lds, ws, p.jobs[j], lt - p.jobs[j].tile0, live); } } }
    GRID_SYNC();
    modulate_rows(p, 0, 0, true, 0);
    s5_kk_phase(lds, p);
    GRID_SYNC();
    { EpiWin0 e{(bf16_t*)(ws + H_UA), (bf16_t*)(ws + S_CQN), (bf16_t*)(ws + S_CKVN), (float*)(ws + S_SSP), (float*)(ws + H_KR)};
      pg8::EpiHead<EpiWin0> pe{e}; pg8::gemm_phase((LAS unsigned char*)lds, pg8::Gemm{A0, WB + W_IN0, 1024, 1024}, pg8::Order{0, NR / 256, 5, (int)nb, vbid}, pe); }
    s5_w1a_phase(p);
    { int rk, nrk; slack_rank((NR / 256) * 5, rk, nrk); transpose_range(lds, ws, p, p.jobs[4].tile0, p.jobs[7].tile0, rk, nrk); }
    GRID_SYNC();
    s5_w1b_phase(p);
    { EpiS1a e{(float*)(ws + H_E)};
      (void)e; pg8::EpiS1a pe{(float*)(ws + H_E)}; pg8::gemm_phase((LAS unsigned char*)lds, pg8::Gemm{(const bf16_t*)(ws + H_UA), (const bf16_t*)(ws + H_W1A), 768, 512, (size_t)CHR * 768, (size_t)256 * 512}, pg8::Order{0, 3, 1, (int)nb, vbid, 32}, pe); }
    { int rk, nrk; slack_rank(96, rk, nrk); transpose_range(lds, ws, p, p.jobs[7].tile0, p.jobs[9].tile0, rk, nrk); }
    GRID_SYNC();
    s5_carry_phase(p);
    { EpiBf16 e{(bf16_t*)(ws + S_QRAW), 768, (const float*)(ws + S_SSP)};
      gemm_phase(lds, (const bf16_t*)(ws + S_CQN), 384, WB + W_QB, 384, 0, NR / 256, 3, e); }
    { EpiKV e{(bf16_t*)(ws + S_KNOPE), (bf16_t*)(ws + S_VT), (const float*)(ws + S_SSP)};
      gemm_phase(lds, (const bf16_t*)(ws + S_CKVN), 256, WB + W_KVB, 256, 0, NR / 256, 4, e, 1, 0, 0, 1, nb > 64 ? (int)nb - 16 : 0); }
    GRID_SYNC();
    { EpiS1b e{(bf16_t*)(ws + S_YG)};
      (void)e; pg8::EpiS1b pe{(bf16_t*)(ws + S_YG)}; pg8::gemm_phase((LAS unsigned char*)lds, pg8::Gemm{(const bf16_t*)(ws + H_UA), (const bf16_t*)(ws + A_W1B), 768, 768, (size_t)CHR * 768, (size_t)512 * 768}, pg8::Order{0, 3, 2, (int)nb, vbid, 32}, pe); }
    mla_prep_phase(p);
    GRID_SYNC();
    { const bf16_t* QR = (const bf16_t*)(ws + S_QRAW); const bf16_t* KA = (const bf16_t*)(ws + S_KA); const bf16_t* VT = (const bf16_t*)(ws + S_VT);
      const int nlat = 2 * 4 * 32, nall = nlat + 2 * 4;
      float mref; { float gq = 0.f, gk = 0.f;
        for (int d_ = 0; d_ < 192; ++d_) { gq = fmaxf(gq, fabsf(p.in[27][d_])); gk = fmaxf(gk, fabsf(p.in[28][d_])); }
        mref = 13.856406f * LOG2E * 1.02f * gq * gk; }
      for (int it0 = bid; it0 < nlat + nb; it0 += nb) {
          const int it = it0 < nlat ? it0 : nlat + (it0 - nlat) - (nb - 8);
          if (it0 >= nlat && (it < nlat || it >= nall)) continue;
          if (it < nlat) { const int h = it & 3, b = (it >> 2) & 1, qb = it >> 3;   const size_t row = NCTX + (size_t)b * SEQ + qb * 256;
              attn_item<192, 128, false>(lds, QR + row * 768 + h * 192, 768, KA + (size_t)(b * 4 + h) * TK * 192, VT + (size_t)(b * 4 + h) * 128 * TK, 0, TK / 64, 0, 0, mref, 0.f,
                                         A0 + row * 1024 + 512 + h * 128, 1024, 0); }
          else { const int j = it - nlat; const int h = j & 3, b = j >> 2; const size_t row = (size_t)b * CTX;
              attn_item<192, 128, false>(lds, QR + row * 768 + h * 192, 768, KA + (size_t)(b * 4 + h) * TK * 192, VT + (size_t)(b * 4 + h) * 128 * TK, 0, 4, 0, 0, mref, 0.f,
                                         A0 + row * 1024 + 512 + h * 128, 1024, 0); } }
      EpiGLU e{(const bf16_t*)(ws + S_YG), p.in[22], A0};
      gemm_phase(lds, (const bf16_t*)(ws + S_YG), 512, WB + W_GLU, 512, 0, NR / 256, 2, e); }
    GRID_SYNC();
    { EpiRes e{p.in[2], p.in[0], H, H + (size_t)NCTX * 1024, MOD + 0 * 3 * 6144 + 2048, 0};
      (void)e; { pg8::EpiRes pe{p.in[0], nullptr, Hb + (size_t)NCTX * 1024, nullptr, MOD + 0 * 3 * 6144 + 2048}; pg8::gemm_phase((LAS unsigned char*)lds, pg8::Gemm{A0, WB + W_OUT0, 1024, 1024}, pg8::Order{2, NLAT / 256, 4, (int)nb, vbid}, pe); }
      thin_gemm_ctx<4>(lds, A0, 1024, WB + W_OUT0, 1024, p.in[2], nullptr, Hb, MOD + 0 * 3 * 6144 + 2048); }
    GRID_SYNC();
    modulate_rows(p, 0, 1, false, 0);
    GRID_SYNC();
    { EpiSwiGLU e{(bf16_t*)(ws + S_HID)};
      (void)e; pg8::EpiSwiGLU pe{(bf16_t*)(ws + S_HID)}; pg8::gemm_phase((LAS unsigned char*)lds, pg8::Gemm{A0, WB + W_GU0, 1024, 1024}, pg8::Order{0, NR / 256, 22, (int)nb, vbid}, pe); }
    { int rk, nrk; slack_rank((NR / 256) * 22, rk, nrk); transpose_range(lds, ws, p, p.jobs[9].tile0, p.jobs[9].tile0 + 704, rk, nrk); }
    GRID_SYNC();
    { EpiRes e{H, H + (size_t)NCTX * 1024, H, H + (size_t)NCTX * 1024, MOD + 0 * 3 * 6144 + 5120, 0};
      (void)e; { pg8::EpiRes pe{nullptr, Hb + (size_t)NCTX * 1024, Hb + (size_t)NCTX * 1024, nullptr, MOD + 0 * 3 * 6144 + 5120}; pg8::gemm_phase((LAS unsigned char*)lds, pg8::Gemm{(const bf16_t*)(ws + S_HID), WB + W_D0, FH, FH}, pg8::Order{2, NLAT / 256, 4, (int)nb, vbid}, pe); }
      thin_gemm_ctx<11>(lds, (const bf16_t*)(ws + S_HID), FH, WB + W_D0, FH, nullptr, Hb, Hb, MOD + 0 * 3 * 6144 + 5120); }
    GRID_SYNC();
    modulate_rows(p, 1, 0, false, 0);
    GRID_SYNC();
    { EpiWin1 e{(bf16_t*)(ws + S1_Q), (bf16_t*)(ws + S1_K), (bf16_t*)(ws + S1_VT), p.in[31], p.in[32], (const float*)(ws + T_ROPE)};
      pg8::EpiHead<EpiWin1> pe{e}; pg8::gemm_phase((LAS unsigned char*)lds, pg8::Gemm{A0, WB + W_IN1, 1024, 1024}, pg8::Order{0, NR / 256, 6, (int)nb, vbid}, pe); }
    { int rk, nrk; slack_rank((NR / 256) * 6, rk, nrk); transpose_range(lds, ws, p, p.jobs[9].tile0 + 704, p.njobtiles, rk, nrk); }
    GRID_SYNC();
    { const bf16_t* Q = (const bf16_t*)(ws + S1_Q); const bf16_t* K1 = (const bf16_t*)(ws + S1_K); const bf16_t* VT = (const bf16_t*)(ws + S1_VT);
      constexpr int WNH = 2;
      const int nit = 2 * 4 * (4 / WNH) * 32;
      float mref; { float gq = 0.f, gk = 0.f;
        for (int d_ = 0; d_ < 64; ++d_) { gq = fmaxf(gq, fabsf(p.in[31][d_])); gk = fmaxf(gk, fabsf(p.in[32][d_])); }
        mref = 8.f * LOG2E * 1.02f * gq * gk; }
      for (int it = bid; it < nit; it += nb) { const int kvh = it & 3, b = (it >> 2) & 1, rest = it >> 3; const int gp = rest % (4 / WNH), i = rest / (4 / WNH); const int hq0 = kvh * 4 + gp * WNH;
          const size_t row = NCTX + (size_t)b * SEQ + i * 256;
          const int l0 = (4 * i - 2) < 0 ? 0 : (4 * i - 2), l1 = (4 * i + 6) > 128 ? 128 : (4 * i + 6);
          win_attn_item<WNH>(lds, Q + row * 1024 + hq0 * 64, K1 + (size_t)(b * 4 + kvh) * TK * 64, VT + (size_t)(b * 4 + kvh) * 64 * TK, 4 + l0, 4 + l1, mref, p.in[33] + hq0, A0 + row * 1024 + hq0 * 64, i * 256); } }
    GRID_SYNC();
    { EpiRes e{H, H + (size_t)NCTX * 1024, nullptr, H + (size_t)NCTX * 1024, MOD + 1 * 3 * 6144 + 2048, 0};
      (void)e; pg8::EpiRes pe{nullptr, Hb + (size_t)NCTX * 1024, Hb + (size_t)NCTX * 1024, nullptr, MOD + 1 * 3 * 6144 + 2048}; pg8::gemm_phase((LAS unsigned char*)lds, pg8::Gemm{A0, WB + W_OUT1, 1024, 1024}, pg8::Order{2, NLAT / 256, 4, (int)nb, vbid}, pe); }
    GRID_SYNC();
    modulate_rows(p, 1, 1, false, NCTX);
    GRID_SYNC();
    { EpiSwiGLU e{(bf16_t*)(ws + S_HID)};
      (void)e; pg8::EpiSwiGLU pe{(bf16_t*)(ws + S_HID)}; pg8::gemm_phase((LAS unsigned char*)lds, pg8::Gemm{A0, WB + W_GU1, 1024, 1024}, pg8::Order{2, NLAT / 256, 22, (int)nb, vbid}, pe); }
    GRID_SYNC();
    { EpiRes e{H, H + (size_t)NCTX * 1024, nullptr, p.out, MOD + 1 * 3 * 6144 + 5120, 0};
      (void)e; pg8::EpiRes pe{nullptr, Hb + (size_t)NCTX * 1024, nullptr, p.out, MOD + 1 * 3 * 6144 + 5120}; pg8::gemm_phase((LAS unsigned char*)lds, pg8::Gemm{(const bf16_t*)(ws + S_HID), WB + W_D1, FH, FH}, pg8::Order{2, NLAT / 256, 4, (int)nb, vbid}, pe); }
}

extern "C" void kernel_launch(void* const* d_in, const int* in_sizes, int n_in, void* d_out, int out_size, void* d_ws, size_t ws_size, hipStream_t stream) {
    static int grid_blocks = 0;
    if (grid_blocks == 0) {
        if (n_in != 34 || ws_size < WS_NEED2) { fprintf(stderr, "kernel_launch: unexpected n_in %d / ws %zu (need %zu)\n", n_in, ws_size, (size_t)WS_NEED2); grid_blocks = -1; return; }
        int dev = 0, cus = 0, per_cu = 0;
        (void)hipGetDevice(&dev);
        (void)hipDeviceGetAttribute(&cus, hipDeviceAttributeMultiprocessorCount, dev);
        (void)hipFuncSetAttribute((const void*)fwd_kernel, hipFuncAttributeMaxDynamicSharedMemorySize, LDS_BYTES);
        (void)hipOccupancyMaxActiveBlocksPerMultiprocessor(&per_cu, (const void*)fwd_kernel, NTHREADS, LDS_BYTES);
        if (per_cu < 1) { fprintf(stderr, "kernel_launch: occupancy query returned %d\n", per_cu); grid_blocks = -1; return; }
        if (per_cu > 1) per_cu = 1;
        grid_blocks = cus * per_cu;
        fprintf(stderr, "kernel_launch: grid %d (%d CUs x %d)\n", grid_blocks, cus, per_cu);
    }
    if (grid_blocks < 0) return;
    Params p{};
    for (int i = 0; i < 34; ++i) p.in[i] = (const float*)d_in[i];
    p.out = (float*)d_out; p.ws = (char*)d_ws;
    const float* fg = p.in[8]; const float* fu = p.in[9]; const float* fd = p.in[10];
    const size_t FW = (size_t)1024 * FH;
    int t0 = 0;
    auto mk = [&](int idx, const float* a, const float* b, size_t dst, int K, int ld, int npad, int mode) {
        Job& j = p.jobs[idx]; j.a = a; j.b = b; j.ks = nullptr; j.dst = dst; j.K = K; j.ld = ld; j.ntk = K / 64; j.ntn = npad / 64; j.tile0 = t0; j.mode = mode; t0 += j.ntk * j.ntn; };
    mk(0, p.in[11], nullptr, W_IN0, 1024, 1216, 1280, 2);
    mk(1, p.in[24], nullptr, W_QB, 384, 768, 768, 0);
    mk(2, p.in[26], nullptr, W_KVB, 256, 1024, 1024, 0);
    p.jobs[1].ks = p.in[23]; p.jobs[2].ks = p.in[25];
    mk(3, p.in[21], nullptr, W_GLU, 512, 512, 512, 0);
    mk(4, p.in[12], nullptr, W_OUT0, 1024, 1024, 1024, 0);
    mk(5, fg, fu, W_GU0, 1024, FH, 5632, 1);
    mk(6, fd, nullptr, W_D0, FH, 1024, 1024, 0);
    mk(7, p.in[29], nullptr, W_IN1, 1024, 1536, 1536, 2);
    mk(8, p.in[30], nullptr, W_OUT1, 1024, 1024, 1024, 0);
    mk(9, fg + FW, fu + FW, W_GU1, 1024, FH, 5632, 1);
    mk(10, fd + FW, nullptr, W_D1, FH, 1024, 1024, 0);
    p.njobtiles = t0;
    if (hipMemsetAsync((char*)d_ws + T_BAR, 0, XCD_BAR_WORDS * 4, stream) != hipSuccess) { fprintf(stderr, "kernel_launch: memset failed\n"); return; }
    void* args[] = {&p};
    hipError_t e = hipLaunchCooperativeKernel((const void*)fwd_kernel, dim3(grid_blocks), dim3(NTHREADS), args, LDS_BYTES, stream);
    if (e != hipSuccess) fprintf(stderr, "cooperative launch failed: %s (grid %d)\n", hipGetErrorString(e), grid_blocks);
}
```

```cpp
#include <hip/hip_runtime.h>
#include <hip/hip_cooperative_groups.h>
#include <cstdio>
#include <cstdint>
namespace cg = cooperative_groups;

#define DI __device__ __forceinline__
typedef unsigned short bf16_t;
typedef short bf16x8 __attribute__((ext_vector_type(8)));
typedef short s16x4 __attribute__((ext_vector_type(4)));
typedef float f32x4 __attribute__((ext_vector_type(4)));
typedef float f32x2 __attribute__((ext_vector_type(2)));
typedef float f32x16 __attribute__((ext_vector_type(16)));
typedef unsigned u32x4 __attribute__((ext_vector_type(4)));
typedef unsigned u32x2 __attribute__((ext_vector_type(2)));
typedef __bf16 bf16v2 __attribute__((ext_vector_type(2)));

constexpr int DM = 1024, NBATCH = 2, SEQ = 8192, CTX = 256;
constexpr int NCTX = NBATCH * CTX;
constexpr int NLAT = NBATCH * SEQ;
constexpr int NR = NCTX + NLAT;
constexpr int TK = CTX + SEQ;
constexpr int FH = 2816;
constexpr int NCH = TK / 64;
constexpr float LOG2E = 1.4426950408889634f;
constexpr int LDS_BYTES = 131072 + 64;
constexpr int NTHREADS = 512, NWV = 8;

constexpr size_t W_IN0 = 0;
constexpr size_t W_QB = W_IN0 + (size_t)1280 * 1024;
constexpr size_t W_KVB = W_QB + (size_t)768 * 384;
constexpr size_t W_GLU = W_KVB + (size_t)1024 * 256;
constexpr size_t W_OUT0 = W_GLU + (size_t)512 * 512;
constexpr size_t W_GU0 = W_OUT0 + (size_t)1024 * 1024;
constexpr size_t W_D0 = W_GU0 + (size_t)5632 * 1024;
constexpr size_t W_IN1 = W_D0 + (size_t)1024 * 2816;
constexpr size_t W_OUT1 = W_IN1 + (size_t)1536 * 1024;
constexpr size_t W_GU1 = W_OUT1 + (size_t)1024 * 1024;
constexpr size_t W_D1 = W_GU1 + (size_t)5632 * 1024;
constexpr size_t W_END = W_D1 + (size_t)1024 * 2816;
constexpr size_t OFF_TAB = W_END * 2;
constexpr size_t T_MOD = OFF_TAB;
constexpr size_t T_ROPE = T_MOD + 2 * 3 * 6144 * 4;
constexpr size_t T_LAMB = T_ROPE + 128 * 16 * 2 * 4;
constexpr size_t T_LAM64 = T_LAMB + 2 * 32 * 64 * 8;
constexpr size_t T_BBAR = T_LAM64 + 2 * 32 * 64 * 8;
constexpr size_t T_BAR = T_BBAR + (size_t)2 * 32 * 64 * 16 * 8;
constexpr size_t OFF_H = OFF_TAB + (1u << 20);
constexpr size_t OFF_A0 = OFF_H + (size_t)NR * 1024 * 4;
constexpr size_t OFF_S = OFF_A0 + (size_t)NR * 1024 * 2;
constexpr size_t WS_NEED = OFF_S + (size_t)108134400;
constexpr size_t S_SSP = WS_NEED;
constexpr size_t WS_NEED2 = S_SSP + (size_t)NR * 10 * 4;
static_assert(WS_NEED2 <= ((size_t)256 << 20) && OFF_S + (size_t)NR * FH * 2 <= WS_NEED, "workspace");
constexpr int SL = 32;
constexpr int NCK = TK / SL;
constexpr int CHR = NBATCH * NCK;
constexpr size_t H_UA = OFF_H;
constexpr size_t H_KR = H_UA + (size_t)(32 * CHR + 256) * 768 * 2;
constexpr size_t H_E = H_KR + (size_t)NR * 64 * 4;
constexpr size_t H_KK = H_E + (size_t)32 * CHR * 256 * 4;
constexpr size_t H_POW = H_KK + (size_t)32 * 2 * 32 * 256 * 4;
constexpr size_t H_W1A = H_POW + (size_t)4096 * 33 * 8;
static_assert(H_W1A + (size_t)32 * 256 * 512 * 2 <= OFF_A0, "H region overflow");
constexpr size_t A_W1B = OFF_A0;
constexpr size_t S_CQN = OFF_S;
constexpr size_t S_CKVN = S_CQN + (size_t)NR * 384 * 2;
constexpr size_t S_YG = OFF_S;
constexpr size_t S_X = S_CKVN + (size_t)NR * 256 * 2;
constexpr size_t S_CQKV = S_X;
constexpr size_t S_QRAW = S_X;
constexpr size_t S_KNOPE = S_QRAW + (size_t)NR * 768 * 2;
constexpr size_t S_VT = S_KNOPE + (size_t)NR * 512 * 2;
constexpr size_t S_KA = S_VT + (size_t)2 * 4 * 128 * TK * 2;
static_assert(S_CQKV + (size_t)NR * 640 * 4 <= S_VT, "CQKV overlaps VT");
static_assert(S_KA + (size_t)2 * 4 * TK * 192 * 2 <= WS_NEED, "scratch overflow");
constexpr size_t S_HID = OFF_S;
constexpr size_t S1_Q = OFF_S;
constexpr size_t S1_KRAW = S1_Q + (size_t)NR * 1024 * 2;
constexpr size_t S1_K = S1_KRAW + (size_t)NR * 256 * 4;
constexpr size_t S1_VT = S1_K + (size_t)2 * 4 * TK * 64 * 2;

struct Job { const float* a; const float* b; const float* ks; unsigned long long dst; int K, ld, ntk, ntn, tile0, mode; };
struct Params {
    const float* in[34];
    float* out;
    char* ws;
    Job jobs[11];
    int njobtiles;
    int pad;
};

DI int get_tid() { int t = threadIdx.x; asm volatile("" : "+v"(t)); return t; }
DI unsigned pk2(float lo, float hi) { f32x2 v = {lo, hi}; return __builtin_bit_cast(unsigned, __builtin_convertvector(v, bf16v2)); }
DI float bf2f(unsigned short b) { return __uint_as_float(((unsigned)b) << 16); }
DI f32x4 ld_bf4(const bf16_t* q) { const u32x2 w = *(const u32x2*)q; return (f32x4){__uint_as_float(w[0] << 16), __uint_as_float(w[0] & 0xffff0000u), __uint_as_float(w[1] << 16), __uint_as_float(w[1] & 0xffff0000u)}; }
DI void st_bf4(bf16_t* q, f32x4 v) { *(u32x2*)q = (u32x2){pk2(v[0], v[1]), pk2(v[2], v[3])}; }
DI float wave_sum(float v) {
#pragma unroll
    for (int o = 32; o > 0; o >>= 1) v += __shfl_xor(v, o);
    return v;
}
DI int row_vec(int r) { return r < NCTX ? 2 : (r - NCTX) / SEQ; }
DI int row_batch(int r) { return r < NCTX ? r / CTX : (r - NCTX) / SEQ; }
DI int row_tpos(int r) { return r < NCTX ? r % CTX : CTX + (r - NCTX) % SEQ; }
DI float sigmoidf_(float x) { return __builtin_amdgcn_rcpf(1.f + __expf(-x)); }
DI float siluf_(float x) { return x * __builtin_amdgcn_rcpf(1.f + __expf(-x)); }
DI float gelu_tanh(float y) { const float z = 0.7978845608028654f * (y + 0.044715f * y * y * y); const float t = 1.f - 2.f * __builtin_amdgcn_rcpf(1.f + __expf(2.f * z)); return 0.5f * y * (1.f + t); }
DI void my_sincos(float x, float& s, float& c) {
    const float q = rintf(x * 0.636619772367581f);
    float r = fmaf(-q, 1.5703125f, x);
    r = fmaf(-q, 4.837512969970703125e-4f, r);
    r = fmaf(-q, 7.54978995489188216e-8f, r);
    const int qi = (int)q;
    const float r2 = r * r;
    const float sp = r + r * r2 * (-1.6666654611e-1f + r2 * (8.3321608736e-3f + r2 * (-1.9515295891e-4f)));
    const float cp = 1.0f - 0.5f * r2 + r2 * r2 * (4.166664568298827e-2f + r2 * (-1.388731625493765e-3f + r2 * 2.443315711809948e-5f));
    const int k = qi & 3;
    s = (k == 0) ? sp : (k == 1) ? cp : (k == 2) ? -sp : -cp;
    c = (k == 0) ? cp : (k == 1) ? -sp : (k == 2) ? -cp : sp;
}


#define XB_TMO      128
#define XB_XCNT(j)  (256  + 64 * (j))
#define XB_XSUB(j)  (1280 + 64 * (j))
#define XB_XGEN(j)  (2304 + 64 * (j))
#define XB_TOP      3328
#define XB_TOPGEN   3392
#define XCD_BAR_WORDS 3456
#define XB_SPIN_CAP (1u << 22)
#define LAS __attribute__((address_space(3)))
DI unsigned xb_ld(unsigned* p) { return __hip_atomic_load(p, __ATOMIC_RELAXED, __HIP_MEMORY_SCOPE_AGENT); }
DI unsigned xb_add(unsigned* p, unsigned v) { return __hip_atomic_fetch_add(p, v, __ATOMIC_RELAXED, __HIP_MEMORY_SCOPE_AGENT); }
DI unsigned xb_xcc_id() { return (unsigned)__builtin_amdgcn_s_getreg((3 << 11) | 20) & 0xFu; }
#define XB_SPIN(cond, bar) do { unsigned _sp = 0; while (cond) { __builtin_amdgcn_s_sleep(1); \
    if ((++_sp & 255u) == 0u) { if (xb_ld(&(bar)[XB_TMO])) break; if (_sp > XB_SPIN_CAP) { atomicAdd(&(bar)[XB_TMO], 1u); break; } } } } while (0)
struct XcdBarrier { unsigned* bar; unsigned x; volatile LAS unsigned* st; };
DI XcdBarrier xcd_barrier_post(unsigned* bar, volatile LAS unsigned* st) {
    XcdBarrier b; b.bar = bar; b.x = xb_xcc_id(); b.st = st;
    if (threadIdx.x == 0) (void)xb_add(&bar[XB_XCNT(b.x)], 1u);
    return b;
}
DI void xcd_barrier_complete(unsigned* bar, unsigned x, unsigned& nloc, unsigned& nx) {
    const unsigned G = gridDim.x * gridDim.y * gridDim.z;
    unsigned sum, cnt, mine, sp = 0u;
    for (;;) {
        sum = 0u; cnt = 0u; mine = 0u;
#pragma unroll
        for (unsigned j = 0; j < 16; ++j) { const unsigned c = xb_ld(&bar[XB_XCNT(j)]); sum += c; cnt += (c > 0u) ? 1u : 0u; mine = (j == x) ? c : mine; }
        if (sum == G) break;
        __builtin_amdgcn_s_sleep(1);
        if ((++sp & 255u) == 0u) { if (xb_ld(&bar[XB_TMO])) break; if (sp > XB_SPIN_CAP) { atomicAdd(&bar[XB_TMO], 1u); break; } }
    }
    nloc = mine > 0u ? mine : 1u; nx = cnt > 0u ? cnt : 1u;
}
DI void xcd_barrier(const XcdBarrier& b) {
    asm volatile("s_waitcnt vmcnt(0)" ::: "memory");
    __syncthreads();
    if (threadIdx.x == 0) {
        unsigned* bar = b.bar;
        __builtin_amdgcn_s_waitcnt(0);
        unsigned nloc = b.st[0], nx = b.st[1];
        if (nloc == 0u) { xcd_barrier_complete(bar, b.x, nloc, nx); b.st[0] = nloc; b.st[1] = nx; }
        const unsigned old = xb_add(&bar[XB_XSUB(b.x)], 1u);
        const unsigned gen = old / nloc;
        if (old + 1u == (gen + 1u) * nloc) {
            __builtin_amdgcn_fence(__ATOMIC_RELEASE, "agent");
            asm volatile("s_waitcnt vmcnt(0)" ::: "memory");
            const unsigned og = xb_add(&bar[XB_TOP], 1u);
            const unsigned tg = og / nx;
            if (og + 1u == (tg + 1u) * nx) xb_add(&bar[XB_TOPGEN], 1u);
            else XB_SPIN(xb_ld(&bar[XB_TOPGEN]) == tg, bar);
            __builtin_amdgcn_fence(__ATOMIC_ACQUIRE, "agent");
            xb_add(&bar[XB_XGEN(b.x)], 1u);
            asm volatile("s_waitcnt vmcnt(0)" ::: "memory");
        } else {
            XB_SPIN(xb_ld(&bar[XB_XGEN(b.x)]) == gen, bar);
            __builtin_amdgcn_fence(__ATOMIC_ACQUIRE, "agent");
            asm volatile("s_waitcnt vmcnt(0)" ::: "memory");
        }
    }
    __syncthreads();
}

DI void transpose_tile(char* lds, char* ws, const Job& jb, int lt, bool live) {
    const int tid512 = get_tid(); const int tid = tid512 & 255;
    float (*tile)[65] = (float (*)[65])(lds + (tid512 >> 8) * 17408);
    const int tk = lt % jb.ntk, tn = lt / jb.ntk;
    const int k0 = tk * 64, n0 = tn * 64;
    const int c4 = (tid & 15) * 4, rq = tid >> 4;
    const float* src; int col; bool valid = live;
    if (jb.mode == 0) { src = jb.a; col = n0 + c4; valid = live && col < jb.ld; }
    else if (jb.mode == 2) { src = jb.a; const int rho = (n0 + c4) & 255; col = (n0 + c4 - rho) + 64 * ((rho >> 5) & 3) + 32 * (rho >> 7) + (rho & 31); valid = live && col < jb.ld; }
    else { const int nsub = c4 >> 4, i = c4 & 15; src = (nsub & 1) ? jb.b : jb.a; col = tn * 32 + (nsub >> 1) * 16 + i; }
#pragma unroll
    for (int kk = 0; kk < 4; ++kk) { const int k = kk * 16 + rq; f32x4 v = valid ? *(const f32x4*)(src + (size_t)(k0 + k) * jb.ld + col) : (f32x4){0.f, 0.f, 0.f, 0.f};
        if (jb.ks) v = v * jb.ks[k0 + k];
        tile[k][c4] = v[0]; tile[k][c4 + 1] = v[1]; tile[k][c4 + 2] = v[2]; tile[k][c4 + 3] = v[3]; }
    __syncthreads();
    const int r = tid >> 2, ks = (tid & 3) * 16;
    unsigned w[8];
#pragma unroll
    for (int q = 0; q < 8; ++q) w[q] = pk2(tile[ks + 2 * q][r], tile[ks + 2 * q + 1][r]);
    bf16_t* d = (bf16_t*)(ws) + jb.dst + (size_t)(n0 + r) * jb.K + k0 + ks;
    if (live) { *(u32x4*)d = (u32x4){w[0], w[1], w[2], w[3]};
    *(u32x4*)(d + 8) = (u32x4){w[4], w[5], w[6], w[7]}; }
    __syncthreads();
}

DI void transpose_range(char* lds, char* ws, const Params& p, int t_begin, int t_end, int rank, int nranks) {
    if (rank < 0) return;
    for (int pr = (t_begin >> 1) + rank; pr < (t_end >> 1); pr += nranks) {
        const int lt = pr * 2 + (int)(threadIdx.x >> 8); int j = 0;
#pragma unroll
        for (int q = 1; q < 11; ++q) if (lt >= p.jobs[q].tile0) j = q;
        transpose_tile(lds, ws, p.jobs[j], lt - p.jobs[j].tile0, true);
    }
}
DI int virt_block() { const int G_ = gridDim.x; return ((G_ & 7) == 0) ? (int)(blockIdx.x & 7) * (G_ >> 3) + (int)(blockIdx.x >> 3) : (int)blockIdx.x; }
DI void slack_rank(int ntile, int& rank, int& nranks) { const int rem = ntile % (int)gridDim.x; const int vb = virt_block(); if (rem == 0) { rank = vb; nranks = gridDim.x; } else { rank = vb - rem; nranks = (int)gridDim.x - rem; } }

DI void ada_item(char* lds, const Params& p, int it) {
    float* sil = (float*)lds;
    float* red = sil + 3072;
    float* MOD = (float*)(p.ws + T_MOD);
    const int tid = get_tid(), layer = it / 96, n0 = (it % 96) * 64;
    for (int i = tid; i < 3072; i += NTHREADS) { const int v = i >> 10, k = i & 1023; const float x = v < 2 ? p.in[1][v * 1024 + k] : p.in[3][k]; sil[i] = siluf_(x); }
    __syncthreads();
    const int j4 = (tid & 15) * 4, kg = tid >> 4;
    const float* W = p.in[4] + (size_t)layer * 1024 * 6144 + n0 + j4;
    f32x4 a0 = {0.f, 0.f, 0.f, 0.f}, a1 = a0, a2 = a0;
#pragma unroll 8
    for (int k = kg * 32; k < kg * 32 + 32; ++k) { const f32x4 w = *(const f32x4*)(W + (size_t)k * 6144); a0 += sil[k] * w; a1 += sil[1024 + k] * w; a2 += sil[2048 + k] * w; }
    *(f32x4*)(red + (kg * 3 + 0) * 64 + j4) = a0; *(f32x4*)(red + (kg * 3 + 1) * 64 + j4) = a1; *(f32x4*)(red + (kg * 3 + 2) * 64 + j4) = a2;
    __syncthreads();
    if (tid < 192) { const int v = tid >> 6, jj = tid & 63;
        float s = p.in[5][layer * 6144 + n0 + jj];
#pragma unroll 8
        for (int q = 0; q < 32; ++q) s += red[(q * 3 + v) * 64 + jj];
        MOD[(layer * 3 + v) * 6144 + n0 + jj] = s; }
    __syncthreads();
}

DI void tables_item(const Params& p, int it) {
    const int tid = get_tid();
    if (it < 4) {
        const int e = it * 512 + tid, pos = e >> 4, i = e & 15;
        const float inv = exp2f(-(float)i * (13.287712379549449f / 16.f));
        float s, c; my_sincos((float)pos * inv, s, c);
        float* ROPE = (float*)(p.ws + T_ROPE); ROPE[e * 2] = c; ROPE[e * 2 + 1] = s;
    } else {
        const int e = (it - 4) * 512 + tid;
        const int dg = e >> 6;
        const float lr = p.in[13][e], li = p.in[14][e], step = expf(p.in[15][dg]);
        const float a = lr * step, b = li * step;
        const float ea = expf(a);
        float sb, cb; my_sincos(b, sb, cb);
        float sh, ch; my_sincos(0.5f * b, sh, ch);
        const float em1 = a * (1.f + a * 0.5f * (1.f + a * (1.f / 3.f) * (1.f + a * 0.25f * (1.f + a * 0.2f * (1.f + a * (1.f / 6.f))))));
        const float lbr = ea * cb, lbi = ea * sb;
        const float nr = em1 * cb - 2.f * sh * sh, ni = ea * sb;
        const float den = lr * lr + li * li;
        const float qr = (nr * lr + ni * li) / den, qi = (ni * lr - nr * li) / den;
        f32x2* BB = (f32x2*)(p.ws + T_BBAR);
#pragma unroll
        for (int s = 0; s < 16; ++s) { const float br = p.in[16][e * 16 + s], bi = p.in[17][e * 16 + s]; BB[e * 16 + s] = (f32x2){qr * br - qi * bi, qr * bi + qi * br}; }
        f32x2* POW = (f32x2*)(p.ws + H_POW) + (size_t)dg * 33 * 64 + (e & 63);
        float pr = 1.f, pi = 0.f;
        for (int q = 0; q <= 32; ++q) { POW[q * 64] = (f32x2){pr, pi}; const float nr2 = pr * lbr - pi * lbi, ni2 = pr * lbi + pi * lbr; pr = nr2; pi = ni2; }
    }
}

DI void modulate_rows(const Params& p, int layer, int which, bool from_inputs, int r0) {
    const int tid_ = get_tid(); const int lane = tid_ & 63, wid = tid_ >> 6;
    const float* gain = p.in[which ? 7 : 6] + layer * 1024;
    const float* modl = (const float*)(p.ws + T_MOD) + layer * 3 * 6144 + (which ? 3072 : 0);
    const bf16_t* Hb = (const bf16_t*)(p.ws + OFF_H);
    bf16_t* dst = (bf16_t*)(p.ws + OFF_A0);
    const int stride = gridDim.x * NWV;
    for (int ra = r0 + blockIdx.x * NWV + wid; ra < NR; ra += 2 * stride) {
        const int rb = ra + stride; const bool hb = rb < NR; const int rbb = hb ? rb : ra;
        const float* srca = ra < NCTX ? p.in[2] + (size_t)ra * 1024 : p.in[0] + (size_t)(ra - NCTX) * 1024;
        const float* srcb = rbb < NCTX ? p.in[2] + (size_t)rbb * 1024 : p.in[0] + (size_t)(rbb - NCTX) * 1024;
        f32x4 xa[4], xb[4]; float sa = 0.f, sb = 0.f;
#pragma unroll
        for (int i = 0; i < 4; ++i) { if (from_inputs) { xa[i] = *(const f32x4*)(srca + i * 256 + lane * 4); xb[i] = *(const f32x4*)(srcb + i * 256 + lane * 4); }
                                      else { xa[i] = ld_bf4(Hb + (size_t)ra * 1024 + i * 256 + lane * 4); xb[i] = ld_bf4(Hb + (size_t)rbb * 1024 + i * 256 + lane * 4); } }
#pragma unroll
        for (int i = 0; i < 4; ++i) { sa += xa[i][0] * xa[i][0] + xa[i][1] * xa[i][1] + xa[i][2] * xa[i][2] + xa[i][3] * xa[i][3];
                                      sb += xb[i][0] * xb[i][0] + xb[i][1] * xb[i][1] + xb[i][2] * xb[i][2] + xb[i][3] * xb[i][3]; }
        sa = wave_sum(sa); sb = wave_sum(sb);
        const float rsa = rsqrtf(sa * (1.f / 1024.f) + 1e-6f), rsb = rsqrtf(sb * (1.f / 1024.f) + 1e-6f);
        const float* mva = modl + row_vec(ra) * 6144; const float* mvb = modl + row_vec(rbb) * 6144;
#pragma unroll
        for (int i = 0; i < 4; ++i) { const int c = i * 256 + lane * 4;
            const f32x4 g = *(const f32x4*)(gain + c);
            { const f32x4 sh = *(const f32x4*)(mva + c), sc = *(const f32x4*)(mva + 1024 + c); const f32x4 y = xa[i] * rsa * g * (1.f + sc) + sh;
              *(u32x2*)(dst + (size_t)ra * 1024 + c) = (u32x2){pk2(y[0], y[1]), pk2(y[2], y[3])}; }
            if (hb) { const f32x4 sh = *(const f32x4*)(mvb + c), sc = *(const f32x4*)(mvb + 1024 + c); const f32x4 y = xb[i] * rsb * g * (1.f + sc) + sh;
              *(u32x2*)(dst + (size_t)rb * 1024 + c) = (u32x2){pk2(y[0], y[1]), pk2(y[2], y[3])}; } }
    }
}

template <class Epi>
DI void gemm_phase(char* lds, const bf16_t* A0_, int lda, const bf16_t* Bt0_, int K, int mt0, int nmt, int nnt, const Epi& epi, int nbatch = 1, size_t sA = 0, size_t sB = 0, int ksplit = 1, int gact = 0) {
    const int tid = get_tid(), lane = tid & 63, wid = tid >> 6, wr = wid >> 2, wc = wid & 3, fr = lane & 15, fq = lane >> 4;
    const int nk = (K >> 6) / ksplit;
    const int lrow = tid >> 3, lc = tid & 7, lkc = lc * 8;
    const int woff = lrow * 128 + ((lc ^ ((lrow >> 1) & 7)) << 4);
    const int ra0 = (wr * 128 + fr) * 128 + ((fq ^ (fr >> 1)) << 4);
    const int ra1 = (wr * 128 + fr) * 128 + (((4 + fq) ^ (fr >> 1)) << 4);
    const int rb0 = 32768 + (wc * 64 + fr) * 128 + ((fq ^ (fr >> 1)) << 4);
    const int rb1 = 32768 + (wc * 64 + fr) * 128 + (((4 + fq) ^ (fr >> 1)) << 4);
    const int per = nmt * nnt, ntile = nbatch * per * ksplit;
    const int PM = nnt >= 8 ? 4 : 8;
    const int GA = gact > 0 ? gact : (int)gridDim.x;
    const int myn = ((int)blockIdx.x < GA && (int)blockIdx.x < ntile) ? (ntile - (int)blockIdx.x + GA - 1) / GA : 0;
    const int total = myn * nk;
    f32x4 acc[8][4];
#pragma unroll
    for (int m = 0; m < 8; ++m)
#pragma unroll
        for (int n = 0; n < 4; ++n) acc[m][n] = (f32x4){0.f, 0.f, 0.f, 0.f};
    int iti = 0, ikt = 0;
    const int srow = wid * 32 + (lane >> 3);
    const bf16_t* Ag = A0_; const bf16_t* Bg = Bt0_;
#define G_STAGE(bufoff) do { if (ikt == 0) { const int u_ = blockIdx.x + iti * GA; const int t_ = u_ / ksplit, sl_ = u_ - t_ * ksplit; const int gb_ = t_ / per, tr_ = t_ - gb_ * per; const int ch_ = tr_ / (PM * nnt), rm_ = tr_ - ch_ * PM * nnt; const int pc_ = (nmt - ch_ * PM) < PM ? (nmt - ch_ * PM) : PM; const int tn_ = rm_ / pc_, tm_ = ch_ * PM + (rm_ - tn_ * pc_); \
            Ag = A0_ + (size_t)gb_ * sA + (size_t)((mt0 + tm_) * 256) * lda + sl_ * nk * 64; Bg = Bt0_ + (size_t)gb_ * sB + (size_t)(tn_ * 256) * K + sl_ * nk * 64; } \
        _Pragma("unroll") for (int i = 0; i < 4; ++i) { const int row_ = srow + 8 * i; const int c_ = ((lane & 7) ^ ((row_ >> 1) & 7)) * 8; \
            __builtin_amdgcn_global_load_lds((const unsigned*)(Ag + (size_t)row_ * lda + ikt * 64 + c_), (LAS unsigned*)(lds + (bufoff) + (wid * 4 + i) * 1024), 16, 0, 0); \
            __builtin_amdgcn_global_load_lds((const unsigned*)(Bg + (size_t)row_ * K + ikt * 64 + c_), (LAS unsigned*)(lds + (bufoff) + 32768 + (wid * 4 + i) * 1024), 16, 0, 0); } \
        if (++ikt == nk) { ikt = 0; ++iti; } } while (0)
#define G_COMPUTE(bufoff) do { _Pragma("unroll") for (int ks = 0; ks < 2; ++ks) { bf16x8 a[8], b[4]; \
        _Pragma("unroll") for (int m = 0; m < 8; ++m) a[m] = *(const bf16x8*)(lds + (bufoff) + (ks ? ra1 : ra0) + m * 2048); \
        _Pragma("unroll") for (int n = 0; n < 4; ++n) b[n] = *(const bf16x8*)(lds + (bufoff) + (ks ? rb1 : rb0) + n * 2048); \
        _Pragma("unroll") for (int m = 0; m < 8; ++m) _Pragma("unroll") for (int n = 0; n < 4; ++n) acc[m][n] = __builtin_amdgcn_mfma_f32_16x16x32_bf16(b[n], a[m], acc[m][n], 0, 0, 0); } } while (0)
    __syncthreads();
    if (total > 0) G_STAGE(0);
    asm volatile("s_waitcnt vmcnt(0)" ::: "memory");
    __syncthreads();
    int cti = 0, ckt = 0;
    for (int q = 0; q < total; ++q) {
        const int cur = (q & 1) * 65536;
        if (q + 1 < total) G_STAGE(cur ^ 65536);
        G_COMPUTE(cur);
        asm volatile("s_waitcnt vmcnt(0)" ::: "memory");
        __syncthreads();
        if (++ckt == nk) {
            const int u_ = blockIdx.x + cti * GA; const int t_ = u_ / ksplit; const int gb_ = t_ / per, tr_ = t_ - gb_ * per; const int ch_ = tr_ / (PM * nnt), rm_ = tr_ - ch_ * PM * nnt; const int pc_ = (nmt - ch_ * PM) < PM ? (nmt - ch_ * PM) : PM; const int tn_ = rm_ / pc_, tm_ = ch_ * PM + (rm_ - tn_ * pc_);
            epi(acc, (mt0 + tm_) * 256 + wr * 128 + fr, tn_ * 256 + wc * 64 + fq * 4, gb_);
#pragma unroll
            for (int m = 0; m < 8; ++m)
#pragma unroll
                for (int n = 0; n < 4; ++n) acc[m][n] = (f32x4){0.f, 0.f, 0.f, 0.f};
            ckt = 0; ++cti;
        }
    }
#undef G_STAGE
#undef G_COMPUTE
}

template <int KSP>
DI void thin_gemm_ctx(char* lds, const bf16_t* A, int lda, const bf16_t* Bt, int K, const float* res_f, const bf16_t* res_h, bf16_t* dst, const float* gate) {
    const int tid = get_tid(), lane = tid & 63, wid = tid >> 6, fr = lane & 15, fq = lane >> 4;
    float* part = (float*)lds;
    for (int t = blockIdx.x; t < 256; t += gridDim.x) {
        const int m0 = (t >> 5) * 64, n0 = (t & 31) * 32;
        f32x4 acc[4][2];
#pragma unroll
        for (int m = 0; m < 4; ++m) { acc[m][0] = (f32x4){0.f, 0.f, 0.f, 0.f}; acc[m][1] = (f32x4){0.f, 0.f, 0.f, 0.f}; }
        const bf16_t* Ap = A + (size_t)(m0 + fr) * lda + wid * (KSP * 32) + fq * 8;
        const bf16_t* Bp = Bt + (size_t)(n0 + fr) * K + wid * (KSP * 32) + fq * 8;
#pragma unroll
        for (int k = 0; k < KSP; ++k) {
            bf16x8 a[4], b[2];
#pragma unroll
            for (int m = 0; m < 4; ++m) a[m] = *(const bf16x8*)(Ap + (size_t)m * 16 * lda + k * 32);
#pragma unroll
            for (int n = 0; n < 2; ++n) b[n] = *(const bf16x8*)(Bp + (size_t)n * 16 * K + k * 32);
#pragma unroll
            for (int m = 0; m < 4; ++m)
#pragma unroll
                for (int n = 0; n < 2; ++n) acc[m][n] = __builtin_amdgcn_mfma_f32_16x16x32_bf16(b[n], a[m], acc[m][n], 0, 0, 0);
        }
        __syncthreads();
#pragma unroll
        for (int m = 0; m < 4; ++m)
#pragma unroll
            for (int n = 0; n < 2; ++n) *(f32x4*)(part + ((wid * 64 + m * 16 + fr) * 32 + n * 16 + fq * 4)) = acc[m][n];
        __syncthreads();
        { const int row = tid >> 3, c4 = (tid & 7) * 4; f32x4 sum = (f32x4){0.f, 0.f, 0.f, 0.f};
#pragma unroll
          for (int w = 0; w < 8; ++w) sum += *(const f32x4*)(part + ((w * 64 + row) * 32 + c4));
          const size_t off = (size_t)(m0 + row) * 1024 + n0 + c4;
          const f32x4 g = *(const f32x4*)(gate + 2 * 6144 + n0 + c4), x = res_h ? ld_bf4(res_h + off) : *(const f32x4*)(res_f + off);
          st_bf4(dst + off, x + g * sum); }
    }
    __syncthreads();
}

struct EpiWin0 {
    bf16_t* UA; bf16_t* CQN; bf16_t* CKVN; float* SSP; float* KR;
    template <int NM> DI void run(const f32x4 (&acc)[NM][4], int row0, int col0) const {
        const int cw = col0 & ~63;
#pragma unroll
        for (int m = 0; m < NM; ++m) { const int ri = row0 + m * 16; const size_t r = ri;
            if (cw < 512) { const int b = row_batch(ri), tp = row_tpos(ri);
#pragma unroll
                for (int n = 0; n < 4; ++n) { const int c = col0 + n * 16; const f32x4 v = acc[m][n]; const int g = c >> 4, s0 = c & 15;
                    *(u32x2*)(UA + ((size_t)g * CHR + b * NCK + (tp >> 5)) * 768 + (tp & 31) * 16 + s0) = (u32x2){pk2(v[0], v[1]), pk2(v[2], v[3])}; }
            } else if (cw < 1152) { const bool isq = cw < 896; bf16_t* dst = isq ? CQN + r * 384 + (col0 - 512) : CKVN + r * 256 + (col0 - 896);
                float ss = 0.f;
#pragma unroll
                for (int n = 0; n < 4; ++n) { const f32x4 v = acc[m][n]; ss += v[0] * v[0] + v[1] * v[1] + v[2] * v[2] + v[3] * v[3];
                    *(u32x2*)(dst + n * 16) = (u32x2){pk2(v[0], v[1]), pk2(v[2], v[3])}; }
                ss += __shfl_xor(ss, 16); ss += __shfl_xor(ss, 32);
                if ((col0 & 15) == 0) SSP[r * 10 + ((cw - 512) >> 6)] = ss;
            } else if (cw < 1216) {
#pragma unroll
                for (int n = 0; n < 4; ++n) *(f32x4*)(KR + r * 64 + (col0 - 1152) + n * 16) = acc[m][n];
            } }
    }
    DI void operator()(const f32x4 (&acc)[8][4], int row0, int col0, int gb) const { run<8>(acc, row0, col0); }
};
struct EpiS1a {
    float* E;
    DI void operator()(const f32x4 (&acc)[8][4], int row0, int col0, int gb) const {
#pragma unroll
        for (int m = 0; m < 8; ++m) { const int r = row0 + m * 16; if (r >= CHR) continue;
#pragma unroll
            for (int n = 0; n < 4; ++n) *(f32x4*)(E + ((size_t)gb * CHR + r) * 256 + col0 + n * 16) = acc[m][n]; }
    }
};
struct EpiS1b {
    bf16_t* YG;
    DI void operator()(const f32x4 (&acc)[8][4], int row0, int col0, int gb) const {
#pragma unroll
        for (int m = 0; m < 8; ++m) { const int r = row0 + m * 16; if (r >= CHR) continue; const int b = r / NCK, c = r % NCK;
#pragma unroll
            for (int n = 0; n < 4; ++n) { const int cc = col0 + n * 16; const int tl = cc >> 4, s0 = cc & 15; const f32x4 v = acc[m][n];
                const int tp = c * SL + tl; const size_t row = tp < CTX ? (size_t)b * CTX + tp : (size_t)NCTX + (size_t)b * SEQ + (tp - CTX);
                *(u32x2*)(YG + row * 512 + gb * 16 + s0) = (u32x2){pk2(gelu_tanh(v[0]), gelu_tanh(v[1])), pk2(gelu_tanh(v[2]), gelu_tanh(v[3]))}; } }
    }
};
struct EpiBf16 {
    bf16_t* O; int ldo; const float* SSP;
    DI void operator()(const f32x4 (&acc)[8][4], int row0, int col0, int gb) const {
#pragma unroll
        for (int m = 0; m < 8; ++m) { const size_t r = row0 + m * 16; const float* sp = SSP + r * 10;
            const float rstd = rsqrtf(((sp[0] + sp[1]) + (sp[2] + sp[3]) + (sp[4] + sp[5])) * (1.f / 384.f) + 1e-6f);
#pragma unroll
            for (int n = 0; n < 4; ++n) { const int c = col0 + n * 16; const f32x4 v = acc[m][n] * rstd;
                *(u32x2*)(O + r * ldo + c) = (u32x2){pk2(v[0], v[1]), pk2(v[2], v[3])}; } }
    }
};
struct EpiKV {
    bf16_t* KNOPE; bf16_t* VT; const float* SSP;
    DI void operator()(const f32x4 (&acc)[8][4], int row0, int col0, int gb) const {
#pragma unroll
        for (int m = 0; m < 8; ++m) { const int r = row0 + m * 16; const int b = row_batch(r), tp = row_tpos(r); const float* sp = SSP + (size_t)r * 10 + 6;
            const float rstd = rsqrtf(((sp[0] + sp[1]) + (sp[2] + sp[3])) * (1.f / 256.f) + 1e-6f);
#pragma unroll
            for (int n = 0; n < 4; ++n) { const int c = col0 + n * 16; const int h = c >> 8, w = c & 255; const f32x4 v = acc[m][n] * rstd;
                if (w < 128) *(u32x2*)(KNOPE + (size_t)r * 512 + h * 128 + w) = (u32x2){pk2(v[0], v[1]), pk2(v[2], v[3])};
                else { bf16_t* d = VT + ((size_t)(b * 4 + h) * 128 + (w - 128)) * TK + tp; const unsigned p0 = pk2(v[0], v[1]), p1 = pk2(v[2], v[3]);
                    d[0] = (bf16_t)(p0 & 0xffff); d[TK] = (bf16_t)(p0 >> 16); d[2 * TK] = (bf16_t)(p1 & 0xffff); d[3 * TK] = (bf16_t)(p1 >> 16); } } }
    }
};
struct EpiGLU {
    const bf16_t* YG; const float* bias; bf16_t* CAT;
    DI void operator()(const f32x4 (&acc)[8][4], int row0, int col0, int gb) const {
#pragma unroll
        for (int m = 0; m < 8; ++m) { const size_t r = row0 + m * 16;
#pragma unroll
            for (int n = 0; n < 4; ++n) { const int c = col0 + n * 16; const f32x4 v = acc[m][n]; const f32x4 bv = *(const f32x4*)(bias + c);
                const u32x2 yy = *(const u32x2*)(YG + r * 512 + c);
                const float y0 = __uint_as_float(yy[0] << 16), y1 = __uint_as_float(yy[0] & 0xffff0000u), y2 = __uint_as_float(yy[1] << 16), y3 = __uint_as_float(yy[1] & 0xffff0000u);
                const float o0 = y0 * sigmoidf_(v[0] + bv[0]), o1 = y1 * sigmoidf_(v[1] + bv[1]), o2 = y2 * sigmoidf_(v[2] + bv[2]), o3 = y3 * sigmoidf_(v[3] + bv[3]);
                *(u32x2*)(CAT + r * 1024 + c) = (u32x2){pk2(o0, o1), pk2(o2, o3)}; } }
    }
};
struct EpiRes {
    const float* res_ctx; const float* res_lat; float* dst_ctx; float* dst_lat; const float* gate; int atomic;
    DI void operator()(const f32x4 (&acc)[8][4], int row0, int col0, int gb) const {
#pragma unroll
        for (int m = 0; m < 8; ++m) { const int r = row0 + m * 16;
            const float* rs = r < NCTX ? res_ctx + (size_t)r * 1024 : res_lat + (size_t)(r - NCTX) * 1024;
            float* ds = r < NCTX ? dst_ctx + (size_t)r * 1024 : dst_lat + (size_t)(r - NCTX) * 1024;
            if (r < NCTX && dst_ctx == nullptr) continue;
            const float* gv = gate + row_vec(r) * 6144;
#pragma unroll
            for (int n = 0; n < 4; ++n) { const int c = col0 + n * 16; const f32x4 g = *(const f32x4*)(gv + c);
                if (atomic) { const f32x4 v = g * acc[m][n];
#pragma unroll
                    for (int j = 0; j < 4; ++j) (void)__hip_atomic_fetch_add(ds + c + j, v[j], __ATOMIC_RELAXED, __HIP_MEMORY_SCOPE_AGENT); }
                else { const f32x4 x = *(const f32x4*)(rs + c); *(f32x4*)(ds + c) = x + g * acc[m][n]; } } }
    }
};
struct EpiSwiGLU {
    bf16_t* HID;
    DI void operator()(const f32x4 (&acc)[8][4], int row0, int col0, int gb) const {
        const int hc = (col0 >> 6) * 32 + (col0 & 15);
#pragma unroll
        for (int m = 0; m < 8; ++m) { const size_t r = row0 + m * 16;
#pragma unroll
            for (int q = 0; q < 2; ++q) { const f32x4 g = acc[m][2 * q], u = acc[m][2 * q + 1];
                const float o0 = siluf_(g[0]) * u[0], o1 = siluf_(g[1]) * u[1], o2 = siluf_(g[2]) * u[2], o3 = siluf_(g[3]) * u[3];
                *(u32x2*)(HID + r * FH + hc + q * 16) = (u32x2){pk2(o0, o1), pk2(o2, o3)}; } }
    }
};
struct EpiWin1 {
    bf16_t* Q; bf16_t* K1; bf16_t* VT; const float* qn; const float* kn; const float* ROPE;
    template <int NM> DI void run(const f32x4 (&acc)[NM][4], int row0, int col0) const {
        const int cw = col0 & ~63, i0 = col0 & 15;
        if (cw >= 1280) {
#pragma unroll
            for (int m = 0; m < NM; ++m) { const int r = row0 + m * 16; const int b = row_batch(r), tp = row_tpos(r);
#pragma unroll
                for (int n = 0; n < 4; ++n) { const int cc = col0 + n * 16 - 1280, h = cc >> 6, d0 = cc & 63; const f32x4 v = acc[m][n];
                    bf16_t* d = VT + ((size_t)(b * 4 + h) * 64 + d0) * TK + tp; const unsigned p0 = pk2(v[0], v[1]), p1 = pk2(v[2], v[3]);
                    d[0] = (bf16_t)(p0 & 0xffff); d[TK] = (bf16_t)(p0 >> 16); d[2 * TK] = (bf16_t)(p1 & 0xffff); d[3 * TK] = (bf16_t)(p1 >> 16); } }
            return;
        }
        const bool isq = cw < 1024;
        const float* gn = isq ? qn : kn;
        f32x4 g[4];
#pragma unroll
        for (int n = 0; n < 4; ++n) g[n] = *(const f32x4*)(gn + n * 16 + i0);
        const float osc = isq ? 0.125f * LOG2E : 1.f;
#pragma unroll
        for (int m = 0; m < NM; ++m) { const int r = row0 + m * 16; const bool lat = r >= NCTX;
            if (isq && !lat) continue;
            const int b = row_batch(r), tp = row_tpos(r), t = tp - CTX;
            float ss = 0.f;
#pragma unroll
            for (int n = 0; n < 4; ++n) { const f32x4 v = acc[m][n]; ss += v[0] * v[0] + v[1] * v[1] + v[2] * v[2] + v[3] * v[3]; }
            ss += __shfl_xor(ss, 16); ss += __shfl_xor(ss, 32);
            const float rstd = rsqrtf(ss * (1.f / 64.f) + 1e-6f);
            f32x4 y[4];
#pragma unroll
            for (int n = 0; n < 4; ++n) y[n] = acc[m][n] * rstd * g[n];
            if (lat) { const float* rr = ROPE + ((t >> 6) * 16 + i0) * 2; const float* rc = ROPE + ((t & 63) * 16 + i0) * 2;
#pragma unroll
                for (int j = 0; j < 4; ++j) { const float c0 = rr[2 * j], s0 = rr[2 * j + 1], c1 = rc[2 * j], s1 = rc[2 * j + 1];
                    const float a0 = y[0][j], a1 = y[1][j], a2 = y[2][j], a3 = y[3][j];
                    y[0][j] = a0 * c0 - a1 * s0; y[1][j] = a1 * c0 + a0 * s0; y[2][j] = a2 * c1 - a3 * s1; y[3][j] = a3 * c1 + a2 * s1; } }
            bf16_t* dst = isq ? Q + (size_t)r * 1024 + cw + i0 : K1 + ((size_t)(b * 4 + ((cw - 1024) >> 6)) * TK + tp) * 64 + i0;
#pragma unroll
            for (int n = 0; n < 4; ++n) *(u32x2*)(dst + n * 16) = (u32x2){pk2(y[n][0] * osc, y[n][1] * osc), pk2(y[n][2] * osc, y[n][3] * osc)};
        }
    }
    DI void operator()(const f32x4 (&acc)[8][4], int row0, int col0, int gb) const { run<8>(acc, row0, col0); }
};

namespace pg8 {
constexpr int BM = 256, BK = 64, HALF = 128, HTB = HALF * BK * 2;
DI int lds_byte(int r, int c) { const int st = (r >> 4) * 2 + (c >> 5), rr = r & 15, cc = c & 31, ob = rr * 64 + cc * 2; return st * 1024 + (ob ^ (((ob >> 9) & 1) << 5)); }
DI void stage_rc(int b, int& R, int& C) { const int st = b / 1024, sb = b % 1024, swz = sb ^ (((sb >> 9) & 1) << 5); R = (st >> 1) * 16 + swz / 64; C = (st & 1) * 32 + (swz % 64) / 2; }
struct Unit { int pm, pn, gb; };
struct Gemm { const bf16_t* A; const bf16_t* Bt; int lda, K; size_t sA = 0, sB = 0; };
struct Order {
    int mt0, nmt, nnt, G, c, nbatch = 1;
    DI bool next(int i, Unit& u) const { const int L0 = i * G + c; if (L0 >= nbatch * nmt * nnt) return false; constexpr int PM = 8; const int gb_ = L0 / (nmt * nnt); const int L = L0 - gb_ * nmt * nnt; u.gb = gb_;
        const int ch = L / (PM * nnt), rm = L - ch * PM * nnt; const int pc = (nmt - ch * PM) < PM ? (nmt - ch * PM) : PM; const int tn = rm / pc;
        u.pm = mt0 + ch * PM + (rm - tn * pc); u.pn = tn; return true; }
};
template <class Epi>
DI void gemm_phase(LAS unsigned char* lds, const Gemm g, const Order& S, const Epi& E) {
    const int tid = get_tid(), wid = __builtin_amdgcn_readfirstlane(tid >> 6), lane = tid & 63, wr = wid >> 2, wc = wid & 3, fr = lane & 15, fq = lane >> 4;
    const int K = g.K, nt = K / BK;
    unsigned voffA[2], voffB[2];
#pragma unroll
    for (int i = 0; i < 2; ++i) { int R, C; stage_rc(tid * 16 + i * 8192, R, C); voffA[i] = (unsigned)(R * g.lda + C) * 2u; voffB[i] = (unsigned)(R * K + C) * 2u; }
    const size_t kstep = (size_t)(BK * 2);
    const size_t hstepA = (size_t)HALF * g.lda * 2, hstepB = (size_t)HALF * K * 2;
    const size_t tstepA = 2 * hstepA, tstepB = 2 * hstepB;
    const unsigned ldsw = (unsigned)wid * 1024u;
    const int aoff = lds_byte(wr * 64 + fr, fq * 8), boff = lds_byte(wc * 32 + fr, fq * 8);
#define PG8_SA(b, h) (((b) * 2 + (h)) * HTB)
#define PG8_SB(b, h) ((4 + (b) * 2 + (h)) * HTB)
#define PG8_STAGE(bufoff, gbase, voff) do { _Pragma("unroll") for (int _i = 0; _i < 2; ++_i) \
        __builtin_amdgcn_global_load_lds((const unsigned*)((const char*)(gbase) + (voff)[_i]), (LAS unsigned*)(lds + (bufoff) + ldsw + _i * 8192), 16, 0, 0); } while (0)
#define PG8_LDA(dst, b, h) do { _Pragma("unroll") for (int m = 0; m < 4; ++m) _Pragma("unroll") for (int k = 0; k < 2; ++k) dst[m][k] = *(const LAS bf16x8*)(lds + PG8_SA(b, h) + aoff + m * 2048 + k * 1024); } while (0)
#define PG8_LDB(dst, b, h) do { _Pragma("unroll") for (int n = 0; n < 2; ++n) _Pragma("unroll") for (int k = 0; k < 2; ++k) dst[n][k] = *(const LAS bf16x8*)(lds + PG8_SB(b, h) + boff + n * 2048 + k * 1024); } while (0)
#define PG8_MMA(ai, bj, At, Bt) do { __builtin_amdgcn_s_setprio(1); _Pragma("unroll") for (int m = 0; m < 4; ++m) _Pragma("unroll") for (int n = 0; n < 2; ++n) _Pragma("unroll") for (int k = 0; k < 2; ++k) \
        acc[ai][bj][m][n] = __builtin_amdgcn_mfma_f32_16x16x32_bf16(Bt[n][k], At[m][k], acc[ai][bj][m][n], 0, 0, 0); __builtin_amdgcn_s_setprio(0); } while (0)
#define PG8_WAIT_V(n) asm volatile("s_waitcnt vmcnt(" #n ")" ::: "memory")
#define PG8_WAIT_L(n) asm volatile("s_waitcnt lgkmcnt(" #n ")" ::: "memory")
#define PG8_BAR __builtin_amdgcn_s_barrier()
#define PG8_SCHED __builtin_amdgcn_sched_barrier(0)
    Unit cur, nxt; int ui = 0;
    if (!S.next(0, cur)) return;
    f32x4 acc[2][2][4][2];
#pragma unroll
    for (int a = 0; a < 2; ++a)
#pragma unroll
        for (int b = 0; b < 2; ++b)
#pragma unroll
            for (int m = 0; m < 4; ++m)
#pragma unroll
                for (int n = 0; n < 2; ++n) acc[a][b][m][n] = (f32x4){0.f, 0.f, 0.f, 0.f};
    bf16x8 At[4][2], B0[2][2], B1[2][2];
    const char* cA = (const char*)(g.A + (size_t)cur.gb * g.sA) + (size_t)cur.pm * tstepA; const char* cB = (const char*)(g.Bt + (size_t)cur.gb * g.sB) + (size_t)cur.pn * tstepB;
    PG8_STAGE(PG8_SB(0, 0), cB, voffB); PG8_STAGE(PG8_SB(0, 1), cB + hstepB, voffB); PG8_STAGE(PG8_SA(0, 0), cA, voffA); PG8_STAGE(PG8_SA(0, 1), cA + hstepA, voffA);
    if (wr == 1) PG8_BAR;
    PG8_WAIT_V(2); PG8_BAR;
    PG8_STAGE(PG8_SB(1, 0), cB + kstep, voffB); PG8_STAGE(PG8_SA(1, 0), cA + kstep, voffA); PG8_STAGE(PG8_SB(1, 1), cB + hstepB + kstep, voffB);
    PG8_WAIT_V(6); PG8_BAR;
    for (;;) {
        const bool has_next = S.next(ui + 1, nxt);
        const char* nA = has_next ? (const char*)(g.A + (size_t)nxt.gb * g.sA) + (size_t)nxt.pm * tstepA : cA; const char* nB = has_next ? (const char*)(g.Bt + (size_t)nxt.gb * g.sB) + (size_t)nxt.pn * tstepB : cB;
        for (int t = 0; t < nt; t += 2) {
            const bool last = (t == nt - 2);
            const char* a1 = cA + (size_t)(t + 1) * kstep;
            const char* a2 = last ? nA : cA + (size_t)(t + 2) * kstep; const char* b2 = last ? nB : cB + (size_t)(t + 2) * kstep;
            const char* a3 = a2 + kstep; const char* b3 = b2 + kstep;
            PG8_LDB(B0, 0, 0); PG8_LDB(B1, 0, 1); PG8_SCHED; PG8_LDA(At, 0, 0); PG8_STAGE(PG8_SA(1, 1), a1 + hstepA, voffA);
            PG8_WAIT_V(8); PG8_WAIT_L(0); PG8_BAR; PG8_MMA(0, 0, At, B0); PG8_MMA(0, 1, At, B1); PG8_BAR; PG8_SCHED;
            PG8_LDA(At, 0, 1); PG8_STAGE(PG8_SB(0, 0), b2, voffB); PG8_STAGE(PG8_SB(0, 1), b2 + hstepB, voffB); PG8_STAGE(PG8_SA(0, 0), a2, voffA);
            PG8_WAIT_V(8); PG8_WAIT_L(0); PG8_BAR; PG8_MMA(1, 0, At, B0); PG8_MMA(1, 1, At, B1); PG8_BAR; PG8_SCHED;
            PG8_LDB(B0, 1, 0); PG8_LDB(B1, 1, 1); PG8_SCHED; PG8_LDA(At, 1, 0); PG8_STAGE(PG8_SA(0, 1), a2 + hstepA, voffA);
            PG8_WAIT_V(8); PG8_WAIT_L(0); PG8_BAR; PG8_MMA(0, 0, At, B0); PG8_MMA(0, 1, At, B1); PG8_BAR; PG8_SCHED;
            PG8_LDA(At, 1, 1); PG8_STAGE(PG8_SB(1, 0), b3, voffB); PG8_STAGE(PG8_SB(1, 1), b3 + hstepB, voffB); PG8_STAGE(PG8_SA(1, 0), a3, voffA);
            PG8_WAIT_V(8); PG8_WAIT_L(0); PG8_BAR; PG8_MMA(1, 0, At, B0); PG8_MMA(1, 1, At, B1); PG8_BAR; PG8_SCHED;
        }
        if (wr == 0) PG8_BAR;
        E(acc, cur, wr, wc, fr, fq);
        if (!has_next) break;
#pragma unroll
        for (int a = 0; a < 2; ++a)
#pragma unroll
            for (int b = 0; b < 2; ++b)
#pragma unroll
                for (int m = 0; m < 4; ++m)
#pragma unroll
                    for (int n = 0; n < 2; ++n) acc[a][b][m][n] = (f32x4){0.f, 0.f, 0.f, 0.f};
        cur = nxt; cA = nA; cB = nB; ++ui;
        if (wr == 1) PG8_BAR;
    }
    PG8_WAIT_V(0);
    PG8_BAR;
#undef PG8_SA
#undef PG8_SB
#undef PG8_STAGE
#undef PG8_LDA
#undef PG8_LDB
#undef PG8_MMA
#undef PG8_WAIT_V
#undef PG8_WAIT_L
#undef PG8_BAR
#undef PG8_SCHED
}
struct EpiRes {
    const float* res_f; const bf16_t* res_h; bf16_t* dst_h; float* dst_f; const float* gate;
    DI void operator()(const f32x4 (&acc)[2][2][4][2], const Unit& u, int wr, int wc, int fr, int fq) const {
        const int row0 = u.pm * 256 + wr * 64 + fr, col0 = u.pn * 256 + wc * 32 + fq * 4;
#pragma unroll
        for (int ai = 0; ai < 2; ++ai)
#pragma unroll
            for (int m = 0; m < 4; ++m) { const int r = row0 + 128 * ai + 16 * m; const size_t ro = (size_t)(r - NCTX) * 1024; const float* gv = gate + row_vec(r) * 6144;
#pragma unroll
                for (int bj = 0; bj < 2; ++bj)
#pragma unroll
                    for (int n = 0; n < 2; ++n) { const int c = col0 + 128 * bj + 16 * n; const f32x4 g_ = *(const f32x4*)(gv + c);
                        const f32x4 x = res_h ? ld_bf4(res_h + ro + c) : *(const f32x4*)(res_f + ro + c);
                        const f32x4 y = x + g_ * acc[ai][bj][m][n];
                        if (dst_h) st_bf4(dst_h + ro + c, y); else __builtin_nontemporal_store(y, (f32x4*)(dst_f + ro + c)); } }
    }
};
struct EpiSwiGLU {
    bf16_t* HID;
    DI void operator()(const f32x4 (&acc)[2][2][4][2], const Unit& u, int wr, int wc, int fr, int fq) const {
        const int row0 = u.pm * 256 + wr * 64 + fr, hc0 = u.pn * 128 + wc * 16 + fq * 4;
#pragma unroll
        for (int ai = 0; ai < 2; ++ai)
#pragma unroll
            for (int m = 0; m < 4; ++m) { const size_t r = row0 + 128 * ai + 16 * m;
#pragma unroll
                for (int bj = 0; bj < 2; ++bj) { const f32x4 g_ = acc[ai][bj][m][0], u_ = acc[ai][bj][m][1];
                    const float o0 = siluf_(g_[0]) * u_[0], o1 = siluf_(g_[1]) * u_[1], o2 = siluf_(g_[2]) * u_[2], o3 = siluf_(g_[3]) * u_[3];
                    *(u32x2*)(HID + r * FH + hc0 + 64 * bj) = (u32x2){pk2(o0, o1), pk2(o2, o3)}; } }
    }
};
struct EpiS1a {
    float* E;
    DI void operator()(const f32x4 (&acc)[2][2][4][2], const Unit& u, int wr, int wc, int fr, int fq) const {
        const int row0 = u.pm * 256 + wr * 64 + fr, col0 = u.pn * 256 + wc * 32 + fq * 4;
#pragma unroll
        for (int ai = 0; ai < 2; ++ai)
#pragma unroll
            for (int m = 0; m < 4; ++m) { const int r = row0 + 128 * ai + 16 * m; if (r >= CHR) continue;
#pragma unroll
                for (int bj = 0; bj < 2; ++bj)
#pragma unroll
                    for (int n = 0; n < 2; ++n) *(f32x4*)(E + ((size_t)u.gb * CHR + r) * 256 + col0 + 128 * bj + 16 * n) = acc[ai][bj][m][n]; }
    }
};
struct EpiS1b {
    bf16_t* YG;
    DI void operator()(const f32x4 (&acc)[2][2][4][2], const Unit& u, int wr, int wc, int fr, int fq) const {
        const int row0 = u.pm * 256 + wr * 64 + fr, col0 = u.pn * 256 + wc * 32 + fq * 4;
#pragma unroll
        for (int ai = 0; ai < 2; ++ai)
#pragma unroll
            for (int m = 0; m < 4; ++m) { const int r = row0 + 128 * ai + 16 * m; if (r >= CHR) continue; const int b = r / NCK, c = r % NCK;
#pragma unroll
                for (int bj = 0; bj < 2; ++bj)
#pragma unroll
                    for (int n = 0; n < 2; ++n) { const int cc = col0 + 128 * bj + 16 * n; const int tl = cc >> 4, s0 = cc & 15; const f32x4 v = acc[ai][bj][m][n];
                        const int tp = c * SL + tl; const size_t row = tp < CTX ? (size_t)b * CTX + tp : (size_t)NCTX + (size_t)b * SEQ + (tp - CTX);
                        *(u32x2*)(YG + row * 512 + u.gb * 16 + s0) = (u32x2){pk2(gelu_tanh(v[0]), gelu_tanh(v[1])), pk2(gelu_tanh(v[2]), gelu_tanh(v[3]))}; } }
    }
};
template <class E> struct EpiHead { E e;
    DI void operator()(const f32x4 (&acc)[2][2][4][2], const Unit& u, int wr, int wc, int fr, int fq) const {
#pragma unroll
        for (int ai = 0; ai < 2; ++ai) { f32x4 t[4][4];
#pragma unroll
            for (int m = 0; m < 4; ++m)
#pragma unroll
                for (int sb = 0; sb < 4; ++sb) t[m][sb] = acc[ai][sb >> 1][m][sb & 1];
            e.template run<4>(t, u.pm * 256 + 128 * ai + wr * 64 + fr, u.pn * 256 + wc * 64 + fq * 4); }
    }
};
}

template <int DQK, int DV, bool WIN>
DI void attn_item(char* lds, const bf16_t* Q, int qstride, const bf16_t* Kb, const bf16_t* VTb, int ta0, int ta1, int tb0, int tb1,
                  float mref, float l_init, bf16_t* O, int ostride, int qpos0) {
    constexpr int NKS = DQK / 16, NDT = DV / 32, KSTR = DQK + 8, VSTR = 72, NG = NKS;
    constexpr int KCH = 64 * DQK / 8 / NTHREADS, VCH = DV * 8 / NTHREADS;
    constexpr int KBUF = 64 * KSTR, VBUF = DV * VSTR;
    bf16_t* Ks = (bf16_t*)lds; bf16_t* Vs = Ks + 2 * KBUF;
    const int tid = get_tid(), lane = tid & 63, wid = tid >> 6, r = lane & 31, h2 = lane >> 5;
    bf16x8 qf[NKS];
    { const bf16_t* qrow = Q + (size_t)(wid * 32 + r) * qstride + 8 * h2;
#pragma unroll
      for (int ks = 0; ks < NKS; ++ks) qf[ks] = *(const bf16x8*)(qrow + 16 * ks); }
    f32x16 o[NDT];
#pragma unroll
    for (int dt = 0; dt < NDT; ++dt)
#pragma unroll
        for (int i = 0; i < 16; ++i) o[dt][i] = 0.f;
    float lrun = (h2 == 0) ? l_init : 0.f;
    const int na = ta1 - ta0, ntot = na + (tb1 - tb0);
    u32x4 kr[KCH], vr[VCH];
    constexpr int KTPR = (DQK / 8) / KCH, VTPR = 8 / VCH;
    const int krow = tid / KTPR, kcol = (tid % KTPR) * (KCH * 8);
    const int vrow = tid / VTPR, vcol = (tid % VTPR) * (VCH * 8);
    const bf16_t* kgp = Kb + (size_t)krow * DQK + kcol;
    const bf16_t* vgp = VTb + (size_t)vrow * TK + vcol;
    bf16_t* ksp = Ks + krow * KSTR + kcol;
    bf16_t* vsp = Vs + vrow * VSTR + vcol;
    const bf16_t* kfp = Ks + r * KSTR + 8 * h2;
    const bf16_t* vfp = Vs + r * VSTR + 8 * h2;
#define A_TILE(itv) (((itv) < na) ? ta0 + (itv) : tb0 + ((itv) - na))
#define K_LOAD(itv) do { const bf16_t* kg = kgp + (size_t)A_TILE(itv) * 64 * DQK; _Pragma("unroll") for (int i = 0; i < KCH; ++i) kr[i] = *(const u32x4*)(kg + i * 8); } while (0)
#define V_LOADG(itv) do { const bf16_t* vg = vgp + A_TILE(itv) * 64; _Pragma("unroll") for (int i = 0; i < VCH; ++i) vr[i] = *(const u32x4*)(vg + i * 8); } while (0)
#define K_WRITE(bo) do { _Pragma("unroll") for (int i = 0; i < KCH; ++i) *(u32x4*)(ksp + (bo) + i * 8) = kr[i]; } while (0)
#define V_WRITE(bo) do { _Pragma("unroll") for (int i = 0; i < VCH; ++i) { const int c_ = (vcol >> 3) + i; bf16_t* d_ = vsp - vcol + (bo) + (c_ >> 1) * 16 + (c_ & 1) * 4; \
            *(u32x2*)d_ = (u32x2){vr[i][0], vr[i][1]}; *(u32x2*)(d_ + 8) = (u32x2){vr[i][2], vr[i][3]}; } } while (0)
#define T_ACTIVE(itv) (!(WIN && A_TILE(itv) >= 4 && ((A_TILE(itv) - 4) * 64 > qpos0 + wid * 32 + 31 + 128 || (A_TILE(itv) - 4) * 64 + 63 < qpos0 + wid * 32 - 128)))
#define S_MASK(S0, S1, itv) do { if (WIN && A_TILE(itv) >= 4) { const int qp = qpos0 + wid * 32 + r, kp0 = (A_TILE(itv) - 4) * 64 + 4 * h2; \
        _Pragma("unroll") for (int i = 0; i < 16; ++i) { const int d0 = kp0 + (i & 3) + 8 * (i >> 2) - qp, d1 = d0 + 32; \
            if (d0 > 128 || d0 < -128) S0[i] = -1e30f; if (d1 > 128 || d1 < -128) S1[i] = -1e30f; } } } while (0)
    f32x16 s0, s1;
    __syncthreads();
    K_LOAD(0); K_WRITE(0);
    if (1 < ntot) K_LOAD(1);
    V_LOADG(0);
    __syncthreads();
#pragma unroll
    for (int i = 0; i < 16; ++i) { s0[i] = -mref; s1[i] = -mref; }
#pragma unroll 1
    for (int it = -1; it < ntot; ++it) {
        const int kb_n = ((it + 1) & 1) * KBUF, vb_c = (it & 1) * VBUF;
        if (it + 2 < ntot) K_WRITE((it & 1) * KBUF);
        if (it + 1 < ntot) V_WRITE(((it + 1) & 1) * VBUF);
        __builtin_amdgcn_sched_barrier(0);
        const bool act_c = (it >= 0) && T_ACTIVE(it), act_n = (it + 1 < ntot) && T_ACTIVE(it + 1);
        f32x16 n0, n1;
#pragma unroll
        for (int i = 0; i < 16; ++i) { n0[i] = -mref; n1[i] = -mref; }
        float rs = 0.f;
        unsigned pk[16];
#define P_PAIR(j) do { const float e0_ = __builtin_amdgcn_exp2f((j) < 8 ? s0[2 * ((j) & 7)] : s1[2 * ((j) & 7)]), e1_ = __builtin_amdgcn_exp2f((j) < 8 ? s0[2 * ((j) & 7) + 1] : s1[2 * ((j) & 7) + 1]); rs += e0_ + e1_; pk[j] = pk2(e0_, e1_); } while (0)
        if (act_c && act_n) {
#pragma unroll
            for (int g = 0; g < NG; ++g) {
                const bf16x8 ka = *(const bf16x8*)(kfp + kb_n + 16 * g), kb = *(const bf16x8*)(kfp + kb_n + 32 * KSTR + 16 * g);
                n0 = __builtin_amdgcn_mfma_f32_32x32x16_bf16(ka, qf[g], n0, 0, 0, 0);
                n1 = __builtin_amdgcn_mfma_f32_32x32x16_bf16(kb, qf[g], n1, 0, 0, 0);
#pragma unroll
                for (int j = (16 * g) / NG; j < (16 * (g + 1)) / NG; ++j) P_PAIR(j);
            }
            S_MASK(n0, n1, it + 1);
        } else {
            if (act_n) {
#pragma unroll
                for (int ks = 0; ks < NKS; ++ks) { const bf16x8 k0 = *(const bf16x8*)(kfp + kb_n + 16 * ks), k1 = *(const bf16x8*)(kfp + kb_n + 32 * KSTR + 16 * ks);
                    n0 = __builtin_amdgcn_mfma_f32_32x32x16_bf16(k0, qf[ks], n0, 0, 0, 0); n1 = __builtin_amdgcn_mfma_f32_32x32x16_bf16(k1, qf[ks], n1, 0, 0, 0); }
                S_MASK(n0, n1, it + 1);
            }
            if (act_c) {
#pragma unroll
                for (int j = 0; j < 16; ++j) P_PAIR(j);
            }
        }
#undef P_PAIR
        __builtin_amdgcn_sched_barrier(0);
        if (it + 3 < ntot) K_LOAD(it + 3);
        if (it + 2 < ntot) V_LOADG(it + 2);
        __builtin_amdgcn_sched_barrier(0);
        if (act_c) {
            lrun += rs;
#pragma unroll
            for (int q = 0; q < 4; ++q) {
                const u32x4 pw = {pk[4 * q], pk[4 * q + 1], pk[4 * q + 2], pk[4 * q + 3]};
                const bf16x8 pf = __builtin_bit_cast(bf16x8, pw);
#pragma unroll
                for (int dt = 0; dt < NDT; ++dt) { const bf16x8 vf = *(const bf16x8*)(vfp + vb_c + (32 * dt) * VSTR + 16 * q);
                    o[dt] = __builtin_amdgcn_mfma_f32_32x32x16_bf16(vf, pf, o[dt], 0, 0, 0); }
            }
        }
        s0 = n0; s1 = n1;
        __syncthreads();
    }
#undef A_TILE
#undef K_LOAD
#undef V_LOADG
#undef K_WRITE
#undef V_WRITE
#undef T_ACTIVE
#undef S_MASK
    lrun += __shfl_xor(lrun, 32);
    const float inv = 1.f / lrun;
    bf16_t* orow = O + (size_t)(wid * 32 + r) * ostride;
#pragma unroll
    for (int dt = 0; dt < NDT; ++dt)
#pragma unroll
        for (int g = 0; g < 4; ++g)
            *(u32x2*)(orow + 32 * dt + 8 * g + 4 * h2) = (u32x2){pk2(o[dt][4 * g] * inv, o[dt][4 * g + 1] * inv), pk2(o[dt][4 * g + 2] * inv, o[dt][4 * g + 3] * inv)};
    __syncthreads();
}

template <int NH>
DI void win_attn_item(char* lds, const bf16_t* Q, const bf16_t* Kb, const bf16_t* VTb, int tb0, int tb1, float mref, const float* sinkp, bf16_t* O, int qpos0) {
    constexpr int KSTR = 72, VSTR = 72, KBUF = 64 * KSTR, VBUF = 64 * VSTR;
    bf16_t* Ks = (bf16_t*)lds; bf16_t* Vs = Ks + 2 * KBUF;
    const int tid = get_tid(), lane = tid & 63, wid = tid >> 6, r = lane & 31, h2 = lane >> 5;
    bf16x8 qf[NH][4];
#pragma unroll
    for (int h = 0; h < NH; ++h) { const bf16_t* qrow = Q + (size_t)(wid * 32 + r) * 1024 + h * 64 + 8 * h2;
#pragma unroll
        for (int ks = 0; ks < 4; ++ks) qf[h][ks] = *(const bf16x8*)(qrow + 16 * ks); }
    f32x16 o[NH][2]; float lrun[NH];
#pragma unroll
    for (int h = 0; h < NH; ++h) { lrun[h] = (h2 == 0) ? __builtin_amdgcn_exp2f(sinkp[h] * LOG2E - mref) : 0.f;
#pragma unroll
        for (int dt = 0; dt < 2; ++dt)
#pragma unroll
            for (int i = 0; i < 16; ++i) o[h][dt][i] = 0.f; }
    const int na = 4, ntot = na + (tb1 - tb0);
    u32x4 kr, vr;
    const int krow = tid >> 3, kcol = (tid & 7) * 8;
    const bf16_t* kgp = Kb + (size_t)krow * 64 + kcol;
    const bf16_t* vgp = VTb + (size_t)krow * TK + kcol;
    bf16_t* ksp = Ks + krow * KSTR + kcol;
    bf16_t* vsp = Vs + krow * VSTR + (kcol >> 4) * 16 + ((kcol >> 3) & 1) * 4;
    const bf16_t* kfp = Ks + r * KSTR + 8 * h2;
    const bf16_t* vfp = Vs + r * VSTR + 8 * h2;
#define W_TILE(itv) (((itv) < na) ? (itv) : tb0 + ((itv) - na))
#define W_LOAD(itv) do { kr = *(const u32x4*)(kgp + (size_t)W_TILE(itv) * 64 * 64); vr = *(const u32x4*)(vgp + W_TILE(itv) * 64); } while (0)
#define W_WRITE(kb_, vb_) do { *(u32x4*)(ksp + (kb_)) = kr; *(u32x2*)(vsp + (vb_)) = (u32x2){vr[0], vr[1]}; *(u32x2*)(vsp + (vb_) + 8) = (u32x2){vr[2], vr[3]}; } while (0)
    __syncthreads();
    W_LOAD(0); W_WRITE(0, 0);
    if (1 < ntot) W_LOAD(1);
    __syncthreads();
#pragma unroll 1
    for (int it = 0; it < ntot; ++it) {
        const int T = W_TILE(it);
        const int kb = (it & 1) * KBUF, vb = (it & 1) * VBUF;
        if (it + 1 < ntot) W_WRITE(KBUF - kb, VBUF - vb);
        if (it + 2 < ntot) W_LOAD(it + 2);
        bool active = true, need_mask = false;
        if (T >= 4) { const int klo = (T - 4) * 64, qlo = qpos0 + wid * 32;
            active = !(klo > qlo + 31 + 128 || klo + 63 < qlo - 128);
            need_mask = (klo < qlo + 31 - 128) || (klo + 63 > qlo + 128); }
        if (active) {
#pragma unroll
            for (int h = 0; h < NH; ++h) {
                __builtin_amdgcn_sched_barrier(0);
                f32x16 s0, s1;
#pragma unroll
                for (int i = 0; i < 16; ++i) { s0[i] = -mref; s1[i] = -mref; }
#pragma unroll
                for (int ks = 0; ks < 4; ++ks) { const bf16x8 k0 = *(const bf16x8*)(kfp + kb + 16 * ks), k1 = *(const bf16x8*)(kfp + kb + 32 * KSTR + 16 * ks);
                    s0 = __builtin_amdgcn_mfma_f32_32x32x16_bf16(k0, qf[h][ks], s0, 0, 0, 0); s1 = __builtin_amdgcn_mfma_f32_32x32x16_bf16(k1, qf[h][ks], s1, 0, 0, 0); }
                if (need_mask) { const int qp = qpos0 + wid * 32 + r, kp0 = (T - 4) * 64 + 4 * h2;
#pragma unroll
                    for (int i = 0; i < 16; ++i) { const int d0 = kp0 + (i & 3) + 8 * (i >> 2) - qp, d1 = d0 + 32;
                        if (d0 > 128 || d0 < -128) s0[i] = -1e30f; if (d1 > 128 || d1 < -128) s1[i] = -1e30f; } }
                float rs = 0.f; unsigned pk[16];
#pragma unroll
                for (int j = 0; j < 8; ++j) { const float a0 = __builtin_amdgcn_exp2f(s0[2 * j]), a1 = __builtin_amdgcn_exp2f(s0[2 * j + 1]), b0 = __builtin_amdgcn_exp2f(s1[2 * j]), b1 = __builtin_amdgcn_exp2f(s1[2 * j + 1]);
                    rs += (a0 + a1) + (b0 + b1); pk[j] = pk2(a0, a1); pk[8 + j] = pk2(b0, b1); }
                lrun[h] += rs;
                __builtin_amdgcn_sched_barrier(0);
#pragma unroll
                for (int q = 0; q < 4; ++q) { const u32x4 pw = {pk[4 * q], pk[4 * q + 1], pk[4 * q + 2], pk[4 * q + 3]}; const bf16x8 pf = __builtin_bit_cast(bf16x8, pw);
#pragma unroll
                    for (int dt = 0; dt < 2; ++dt) { const bf16x8 vf = *(const bf16x8*)(vfp + vb + (32 * dt) * VSTR + 16 * q);
                        o[h][dt] = __builtin_amdgcn_mfma_f32_32x32x16_bf16(vf, pf, o[h][dt], 0, 0, 0); } }
            }
        }
        __syncthreads();
    }
#undef W_TILE
#undef W_LOAD
#undef W_WRITE
#pragma unroll
    for (int h = 0; h < NH; ++h) { float l = lrun[h]; l += __shfl_xor(l, 32); const float inv = 1.f / l;
        bf16_t* orow = O + (size_t)(wid * 32 + r) * 1024 + h * 64;
#pragma unroll
        for (int dt = 0; dt < 2; ++dt)
#pragma unroll
            for (int g = 0; g < 4; ++g)
                *(u32x2*)(orow + 32 * dt + 8 * g + 4 * h2) = (u32x2){pk2(o[h][dt][4 * g] * inv, o[h][dt][4 * g + 1] * inv), pk2(o[h][dt][4 * g + 2] * inv, o[h][dt][4 * g + 3] * inv)}; }
    __syncthreads();
}

DI void s5_kk_phase(char* lds, const Params& p) {
    const int tid512 = get_tid(); const int tid = tid512 & 255, s = tid >> 4, sp = tid & 15, dh = tid512 >> 8;
    f32x2* sbb = (f32x2*)lds;
    f32x2* scc = sbb + 1024;
    f32x2* spw = scc + 1024;
    const f32x2* POW = (const f32x2*)(p.ws + H_POW); const f32x2* BB = (const f32x2*)(p.ws + T_BBAR); float* KK = (float*)(p.ws + H_KK);
    for (int it = blockIdx.x; it < 32 * 2 * 4; it += gridDim.x) {
        const int dq = it & 3, dir = (it >> 2) & 1, g = it >> 3; const int dg = dir * 32 + g;
        __syncthreads();
        for (int i = tid512; i < 1024; i += NTHREADS) { sbb[i] = BB[(size_t)dg * 1024 + i]; scc[i] = (f32x2){p.in[18][(size_t)dg * 1024 + i], p.in[19][(size_t)dg * 1024 + i]}; }
        { const int i = tid512; spw[i] = POW[((size_t)dg * 33 + dq * 8 + (i >> 6)) * 64 + (i & 63)]; }
        __syncthreads();
        float acc[4] = {0.f, 0.f, 0.f, 0.f};
#pragma unroll 4
        for (int pp = 0; pp < 64; ++pp) { const f32x2 bb = sbb[pp * 16 + sp], cc = scc[s * 64 + pp];
#pragma unroll
            for (int q = 0; q < 4; ++q) { const f32x2 pw = spw[(dh * 4 + q) * 64 + pp];
                const float zr = pw[0] * bb[0] - pw[1] * bb[1], zi = pw[0] * bb[1] + pw[1] * bb[0];
                acc[q] += cc[0] * zr - cc[1] * zi; } }
#pragma unroll
        for (int q = 0; q < 4; ++q) KK[(size_t)((g * 2 + dir) * 32 + dq * 8 + dh * 4 + q) * 256 + tid] = acc[q];
    }
    __syncthreads();
}
DI void s5_w1a_phase(const Params& p) {
    const int tid = get_tid();
    const f32x2* POW = (const f32x2*)(p.ws + H_POW); const f32x2* BB = (const f32x2*)(p.ws + T_BBAR); bf16_t* W = (bf16_t*)(p.ws + H_W1A);
    for (int idx = blockIdx.x * NTHREADS + tid; idx < 2048 * 256; idx += gridDim.x * NTHREADS) {
        const int kq = idx & 63, n = (idx >> 6) & 255, g = idx >> 14;
        const int dir = n >> 7, ri = (n >> 6) & 1, pp = n & 63; const int e = (dir * 32 + g) * 64 + pp; const int tl = kq >> 1, s0 = (kq & 1) * 8;
        const f32x2 pw = POW[((size_t)(dir * 32 + g) * 33 + (dir ? tl : 31 - tl)) * 64 + pp];
        float v[8];
#pragma unroll
        for (int j = 0; j < 8; ++j) { const f32x2 bb = BB[e * 16 + s0 + j]; v[j] = ri ? pw[0] * bb[1] + pw[1] * bb[0] : pw[0] * bb[0] - pw[1] * bb[1]; }
        *(u32x4*)(W + ((size_t)g * 256 + n) * 512 + kq * 8) = (u32x4){pk2(v[0], v[1]), pk2(v[2], v[3]), pk2(v[4], v[5]), pk2(v[6], v[7])};
    }
}
DI void s5_w1b_phase(const Params& p) {
    const int tid = get_tid();
    const f32x2* __restrict__ POW = (const f32x2*)(p.ws + H_POW); const float* __restrict__ KK = (const float*)(p.ws + H_KK); bf16_t* __restrict__ W = (bf16_t*)(p.ws + A_W1B);
    const float* __restrict__ CRE = p.in[18]; const float* __restrict__ CIM = p.in[19]; const float* __restrict__ DSK = p.in[20];
#pragma unroll 2
    for (int idx = blockIdx.x * NTHREADS + tid; idx < 32 * 512 * 64; idx += gridDim.x * NTHREADS) {
        const int kq = idx & 63, n = (idx >> 6) & 511, g = idx >> 15;
        const int tl = n >> 4, s = n & 15, tl2 = kq >> 1, s0 = (kq & 1) * 8;
        const int d0 = tl - tl2, d1 = tl2 - tl;
        const float* k0 = KK + (size_t)((g * 2 + 0) * 32 + (d0 < 0 ? 0 : d0)) * 256 + s * 16 + s0;
        const float* k1 = KK + (size_t)((g * 2 + 1) * 32 + (d1 < 0 ? 0 : d1)) * 256 + s * 16 + s0;
        const f32x4 a0 = *(const f32x4*)k0, a1 = *(const f32x4*)(k0 + 4), b0 = *(const f32x4*)k1, b1 = *(const f32x4*)(k1 + 4);
        const float w0 = d0 >= 0 ? 1.f : 0.f, w1 = d1 >= 0 ? 1.f : 0.f;
        f32x4 x0 = a0 * w0 + b0 * w1, x1 = a1 * w0 + b1 * w1;
        if (tl2 == tl && (s >> 3) == (kq & 1)) { const float dv = DSK[g * 16 + s];
#pragma unroll
            for (int j = 0; j < 4; ++j) { if (j == (s & 7)) x0[j] += dv; if (4 + j == (s & 7)) x1[j] += dv; } }
        *(u32x4*)(W + ((size_t)g * 512 + n) * 768 + kq * 8) = (u32x4){pk2(x0[0], x0[1]), pk2(x0[2], x0[3]), pk2(x1[0], x1[1]), pk2(x1[2], x1[3])};
    }
#pragma unroll 2
    for (int idx = blockIdx.x * NTHREADS + tid; idx < 32 * 512 * 32; idx += gridDim.x * NTHREADS) {
        const int kb = idx & 31, n = (idx >> 5) & 511, g = idx >> 14;
        const int tl = n >> 4, s = n & 15, k2 = kb * 8; const int dir = k2 >> 7, ri = (k2 >> 6) & 1, p0 = k2 & 63;
        const float* cre = CRE + ((size_t)(dir * 32 + g) * 16 + s) * 64 + p0; const float* cim = CIM + ((size_t)(dir * 32 + g) * 16 + s) * 64 + p0;
        const f32x2* pwp = POW + ((size_t)(dir * 32 + g) * 33 + (dir ? 32 - tl : tl + 1)) * 64 + p0;
        const f32x4 cr0 = *(const f32x4*)cre, cr1 = *(const f32x4*)(cre + 4), ci0 = *(const f32x4*)cim, ci1 = *(const f32x4*)(cim + 4);
        const f32x4 pa = *(const f32x4*)pwp, pb = *(const f32x4*)(pwp + 2), pc = *(const f32x4*)(pwp + 4), pd = *(const f32x4*)(pwp + 6);
        float v[8];
        const float pr[8] = {pa[0], pa[2], pb[0], pb[2], pc[0], pc[2], pd[0], pd[2]}, pi[8] = {pa[1], pa[3], pb[1], pb[3], pc[1], pc[3], pd[1], pd[3]};
#pragma unroll
        for (int j = 0; j < 8; ++j) { const float cr = j < 4 ? cr0[j & 3] : cr1[j & 3], ci = j < 4 ? ci0[j & 3] : ci1[j & 3];
            v[j] = ri ? -(cr * pi[j] + ci * pr[j]) : cr * pr[j] - ci * pi[j]; }
        *(u32x4*)(W + ((size_t)g * 512 + n) * 768 + 512 + kb * 8) = (u32x4){pk2(v[0], v[1]), pk2(v[2], v[3]), pk2(v[4], v[5]), pk2(v[6], v[7])};
    }
}
DI void s5_carry_phase(const Params& p) {
    const int tid_ = get_tid(); const int lane = tid_ & 63, wid = tid_ >> 6;
    const f32x2* POW = (const f32x2*)(p.ws + H_POW); const float* E = (const float*)(p.ws + H_E); bf16_t* UA = (bf16_t*)(p.ws + H_UA);
    for (int it = ((int)gridDim.x - 1 - (int)blockIdx.x) * NWV + wid; it < 2 * 2 * 32; it += gridDim.x * NWV) {
        const int g = it & 31, dir = (it >> 5) & 1, b = it >> 6;
        const f32x2 l32 = POW[((size_t)(dir * 32 + g) * 33 + 32) * 64 + lane];
        float hr = 0.f, hi = 0.f;
        float er[8], ei[8], fr_[8], fi_[8];
#define C_IDX(i_) ((size_t)g * CHR + b * NCK + (dir ? ((i_) < 8 ? 7 - (i_) : NCK - 1 - ((i_) - 8)) : (i_)))
#define C_LOAD(R, I, i0_) do { _Pragma("unroll") for (int j = 0; j < 8; ++j) { const size_t m = C_IDX((i0_) + j); R[j] = E[m * 256 + dir * 128 + lane]; I[j] = E[m * 256 + dir * 128 + 64 + lane]; } } while (0)
#define C_STEP(R, I, i0_) do { _Pragma("unroll") for (int j = 0; j < 8; ++j) { const size_t m = C_IDX((i0_) + j); bf16_t* u = UA + m * 768 + 512 + dir * 128 + lane; \
            u[0] = (bf16_t)(pk2(hr, 0.f) & 0xffff); u[64] = (bf16_t)(pk2(hi, 0.f) & 0xffff); \
            const float nr = l32[0] * hr - l32[1] * hi + R[j], ni = l32[0] * hi + l32[1] * hr + I[j]; hr = nr; hi = ni; } } while (0)
        C_LOAD(er, ei, 0);
        for (int i0 = 0; i0 < NCK; i0 += 16) {
            if (i0 + 8 < NCK) C_LOAD(fr_, fi_, i0 + 8);
            C_STEP(er, ei, i0);
            if (i0 + 8 < NCK) { if (i0 + 16 < NCK) C_LOAD(er, ei, i0 + 16); C_STEP(fr_, fi_, i0 + 8); }
        }
#undef C_IDX
#undef C_LOAD
#undef C_STEP
    }
}

DI float rope64(float x, int lane, const float* ROPE, int rpos, int cpos) {
    const float partner = __shfl_xor(x, 16);
    const int i = lane & 15; const int pos = lane < 32 ? rpos : cpos;
    const float c = ROPE[(pos * 16 + i) * 2], s = ROPE[(pos * 16 + i) * 2 + 1];
    return (lane & 16) ? x * c + partner * s : x * c - partner * s;
}
DI void mla_prep_phase(const Params& p) {
    const int tid_ = get_tid(); const int lane = tid_ & 63, wid = tid_ >> 6;
    bf16_t* QR = (bf16_t*)(p.ws + S_QRAW); const bf16_t* KN = (const bf16_t*)(p.ws + S_KNOPE); const float* KR = (const float*)(p.ws + H_KR);
    bf16_t* KA = (bf16_t*)(p.ws + S_KA); const float* ROPE = (const float*)(p.ws + T_ROPE);
    const float qsc = 0.07216878364870323f * LOG2E;
    const float qg0 = p.in[27][lane], qg1 = p.in[27][64 + lane], qg2 = p.in[27][128 + lane];
    const float kg0 = p.in[28][lane], kg1 = p.in[28][64 + lane], kg2 = p.in[28][128 + lane];
    const int nbusy = (int)gridDim.x < 192 ? (int)gridDim.x : 192, nslots = nbusy + 3 * ((int)gridDim.x - nbusy);
    const int vb_ = virt_block();
    const int myslots = vb_ < nbusy ? 1 : 3, slot0 = vb_ < nbusy ? vb_ : nbusy + 3 * (vb_ - nbusy);
    for (int sj = 0; sj < myslots; ++sj)
    for (int r = (slot0 + sj) * NWV + wid; r < NR; r += nslots * NWV) {
        const bool lat = r >= NCTX; const int b = row_batch(r), tp = row_tpos(r); const int t = tp - CTX;
        const bf16_t* q = QR + (size_t)r * 768; const bf16_t* kn = KN + (size_t)r * 512;
        float x[4][3], k[4][3];
        const float krv = KR[(size_t)r * 64 + lane];
#pragma unroll
        for (int h = 0; h < 4; ++h) { x[h][0] = bf2f(q[h * 192 + lane]); x[h][1] = bf2f(q[h * 192 + 64 + lane]); x[h][2] = bf2f(q[h * 192 + 128 + lane]);
            k[h][0] = bf2f(kn[h * 128 + lane]); k[h][1] = bf2f(kn[h * 128 + 64 + lane]); k[h][2] = krv; }
        float rc = 1.f, rsn = 0.f;
        if (lat) { const int pos = lane < 32 ? (t >> 6) : (t & 63); rc = ROPE[(pos * 16 + (lane & 15)) * 2]; rsn = ROPE[(pos * 16 + (lane & 15)) * 2 + 1]; }
        const float sgn = (lane & 16) ? 1.f : -1.f;
#pragma unroll
        for (int h = 0; h < 4; ++h) {
            float ss = wave_sum(x[h][0] * x[h][0] + x[h][1] * x[h][1] + x[h][2] * x[h][2]);
            float rs = rsqrtf(ss * (1.f / 192.f) + 1e-6f) * qsc;
            const float x0 = x[h][0] * rs * qg0, x1 = x[h][1] * rs * qg1; float x2 = x[h][2] * rs * qg2;
            x2 = x2 * rc + sgn * __shfl_xor(x2, 16) * rsn;
            bf16_t* qd = QR + (size_t)r * 768 + h * 192;
            qd[lane] = (bf16_t)(pk2(x0, 0.f) & 0xffff); qd[64 + lane] = (bf16_t)(pk2(x1, 0.f) & 0xffff); qd[128 + lane] = (bf16_t)(pk2(x2, 0.f) & 0xffff);
            ss = wave_sum(k[h][0] * k[h][0] + k[h][1] * k[h][1] + k[h][2] * k[h][2]);
            rs = rsqrtf(ss * (1.f / 192.f) + 1e-6f);
            const float k0 = k[h][0] * rs * kg0, k1 = k[h][1] * rs * kg1; float k2 = k[h][2] * rs * kg2;
            k2 = k2 * rc + sgn * __shfl_xor(k2, 16) * rsn;
            bf16_t* kd = KA + ((size_t)(b * 4 + h) * TK + tp) * 192;
            kd[lane] = (bf16_t)(pk2(k0, 0.f) & 0xffff); kd[64 + lane] = (bf16_t)(pk2(k1, 0.f) & 0xffff); kd[128 + lane] = (bf16_t)(pk2(k2, 0.f) & 0xffff);
        }
    }
}

__global__ void __launch_bounds__(NTHREADS, 2) fwd_kernel(Params p) {
    extern __shared__ __attribute__((aligned(16))) char lds[];
    cg::grid_group grid = cg::this_grid();
    char* ws = p.ws;
    const bf16_t* WB = (const bf16_t*)ws;
    const float* MOD = (const float*)(ws + T_MOD);
    float* H = (float*)(ws + OFF_H);
    bf16_t* Hb = (bf16_t*)(ws + OFF_H);
    bf16_t* A0 = (bf16_t*)(ws + OFF_A0);
    const int bid = blockIdx.x, nb = gridDim.x;
    const int vbid = virt_block();
    volatile LAS unsigned* xst = (volatile LAS unsigned*)(lds + (LDS_BYTES - 16));
    if (threadIdx.x == 0) { xst[0] = 0u; xst[1] = 0u; }
    __syncthreads();
    const XcdBarrier xb = xcd_barrier_post((unsigned*)(ws + T_BAR), xst);
    if (p.pad == 0x7fffffff) grid.sync();
#define GRID_SYNC() xcd_barrier(xb)

    { const int npair = p.jobs[4].tile0 >> 1, nit = 192 + 12 + npair;
      for (int it = bid; it < nit; it += nb) {
          if (it < 192) ada_item(lds, p, it);
          else if (it < 204) tables_item(p, it - 192);
          else { const int lt0 = (it - 204) * 2 + (int)(threadIdx.x >> 8); const bool live = lt0 < p.jobs[4].tile0; const int lt = live ? lt0 : 0; int j = 0;
#pragma unroll
              for (int q = 1; q < 11; ++q) if (lt >= p.jobs[q].tile0) j = q;
              transpose_tile(lds, ws, p.jobs[j], lt - p.jobs[j].tile0, live); } } }
    GRID_SYNC();
    modulate_rows(p, 0, 0, true, 0);
    s5_kk_phase(lds, p);
    GRID_SYNC();
    { EpiWin0 e{(bf16_t*)(ws + H_UA), (bf16_t*)(ws + S_CQN), (bf16_t*)(ws + S_CKVN), (float*)(ws + S_SSP), (float*)(ws + H_KR)};
      pg8::EpiHead<EpiWin0> pe{e}; pg8::gemm_phase((LAS unsigned char*)lds, pg8::Gemm{A0, WB + W_IN0, 1024, 1024}, pg8::Order{0, NR / 256, 5, (int)nb, vbid}, pe); }
    s5_w1a_phase(p);
    { int rk, nrk; slack_rank((NR / 256) * 5, rk, nrk); transpose_range(lds, ws, p, p.jobs[4].tile0, p.jobs[7].tile0, rk, nrk); }
    GRID_SYNC();
    s5_w1b_phase(p);
    { EpiS1a e{(float*)(ws + H_E)};
      (void)e; pg8::EpiS1a pe{(float*)(ws + H_E)}; pg8::gemm_phase((LAS unsigned char*)lds, pg8::Gemm{(const bf16_t*)(ws + H_UA), (const bf16_t*)(ws + H_W1A), 768, 512, (size_t)CHR * 768, (size_t)256 * 512}, pg8::Order{0, 3, 1, (int)nb, vbid, 32}, pe); }
    { int rk, nrk; slack_rank(96, rk, nrk); transpose_range(lds, ws, p, p.jobs[7].tile0, p.jobs[9].tile0, rk, nrk); }
    GRID_SYNC();
    s5_carry_phase(p);
    { EpiBf16 e{(bf16_t*)(ws + S_QRAW), 768, (const float*)(ws + S_SSP)};
      gemm_phase(lds, (const bf16_t*)(ws + S_CQN), 384, WB + W_QB, 384, 0, NR / 256, 3, e); }
    { EpiKV e{(bf16_t*)(ws + S_KNOPE), (bf16_t*)(ws + S_VT), (const float*)(ws + S_SSP)};
      gemm_phase(lds, (const bf16_t*)(ws + S_CKVN), 256, WB + W_KVB, 256, 0, NR / 256, 4, e, 1, 0, 0, 1, nb > 64 ? (int)nb - 16 : 0); }
    GRID_SYNC();
    { EpiS1b e{(bf16_t*)(ws + S_YG)};
      (void)e; pg8::EpiS1b pe{(bf16_t*)(ws + S_YG)}; pg8::gemm_phase((LAS unsigned char*)lds, pg8::Gemm{(const bf16_t*)(ws + H_UA), (const bf16_t*)(ws + A_W1B), 768, 768, (size_t)CHR * 768, (size_t)512 * 768}, pg8::Order{0, 3, 2, (int)nb, vbid, 32}, pe); }
    mla_prep_phase(p);
    GRID_SYNC();
    { const bf16_t* QR = (const bf16_t*)(ws + S_QRAW); const bf16_t* KA = (const bf16_t*)(ws + S_KA); const bf16_t* VT = (const bf16_t*)(ws + S_VT);
      const int nlat = 2 * 4 * 32, nall = nlat + 2 * 4;
      float mref; { float gq = 0.f, gk = 0.f;
        for (int d_ = 0; d_ < 192; ++d_) { gq = fmaxf(gq, fabsf(p.in[27][d_])); gk = fmaxf(gk, fabsf(p.in[28][d_])); }
        mref = 13.856406f * LOG2E * 1.02f * gq * gk; }
      for (int it0 = bid; it0 < nlat + nb; it0 += nb) {
          const int it = it0 < nlat ? it0 : nlat + (it0 - nlat) - (nb - 8);
          if (it0 >= nlat && (it < nlat || it >= nall)) continue;
          if (it < nlat) { const int h = it & 3, b = (it >> 2) & 1, qb = it >> 3;   const size_t row = NCTX + (size_t)b * SEQ + qb * 256;
              attn_item<192, 128, false>(lds, QR + row * 768 + h * 192, 768, KA + (size_t)(b * 4 + h) * TK * 192, VT + (size_t)(b * 4 + h) * 128 * TK, 0, TK / 64, 0, 0, mref, 0.f,
                                         A0 + row * 1024 + 512 + h * 128, 1024, 0); }
          else { const int j = it - nlat; const int h = j & 3, b = j >> 2; const size_t row = (size_t)b * CTX;
              attn_item<192, 128, false>(lds, QR + row * 768 + h * 192, 768, KA + (size_t)(b * 4 + h) * TK * 192, VT + (size_t)(b * 4 + h) * 128 * TK, 0, 4, 0, 0, mref, 0.f,
                                         A0 + row * 1024 + 512 + h * 128, 1024, 0); } }
      EpiGLU e{(const bf16_t*)(ws + S_YG), p.in[22], A0};
      gemm_phase(lds, (const bf16_t*)(ws + S_YG), 512, WB + W_GLU, 512, 0, NR / 256, 2, e); }
    GRID_SYNC();
    { EpiRes e{p.in[2], p.in[0], H, H + (size_t)NCTX * 1024, MOD + 0 * 3 * 6144 + 2048, 0};
      (void)e; { pg8::EpiRes pe{p.in[0], nullptr, Hb + (size_t)NCTX * 1024, nullptr, MOD + 0 * 3 * 6144 + 2048}; pg8::gemm_phase((LAS unsigned char*)lds, pg8::Gemm{A0, WB + W_OUT0, 1024, 1024}, pg8::Order{2, NLAT / 256, 4, (int)nb, vbid}, pe); }
      thin_gemm_ctx<4>(lds, A0, 1024, WB + W_OUT0, 1024, p.in[2], nullptr, Hb, MOD + 0 * 3 * 6144 + 2048); }
    GRID_SYNC();
    modulate_rows(p, 0, 1, false, 0);
    GRID_SYNC();
    { EpiSwiGLU e{(bf16_t*)(ws + S_HID)};
      (void)e; pg8::EpiSwiGLU pe{(bf16_t*)(ws + S_HID)}; pg8::gemm_phase((LAS unsigned char*)lds, pg8::Gemm{A0, WB + W_GU0, 1024, 1024}, pg8::Order{0, NR / 256, 22, (int)nb, vbid}, pe); }
    { int rk, nrk; slack_rank((NR / 256) * 22, rk, nrk); transpose_range(lds, ws, p, p.jobs[9].tile0, p.jobs[9].tile0 + 704, rk, nrk); }
    GRID_SYNC();
    { EpiRes e{H, H + (size_t)NCTX * 1024, H, H + (size_t)NCTX * 1024, MOD + 0 * 3 * 6144 + 5120, 0};
      (void)e; { pg8::EpiRes pe{nullptr, Hb + (size_t)NCTX * 1024, Hb + (size_t)NCTX * 1024, nullptr, MOD + 0 * 3 * 6144 + 5120}; pg8::gemm_phase((LAS unsigned char*)lds, pg8::Gemm{(const bf16_t*)(ws + S_HID), WB + W_D0, FH, FH}, pg8::Order{2, NLAT / 256, 4, (int)nb, vbid}, pe); }
      thin_gemm_ctx<11>(lds, (const bf16_t*)(ws + S_HID), FH, WB + W_D0, FH, nullptr, Hb, Hb, MOD + 0 * 3 * 6144 + 5120); }
    GRID_SYNC();
    modulate_rows(p, 1, 0, false, 0);
    GRID_SYNC();
    { EpiWin1 e{(bf16_t*)(ws + S1_Q), (bf16_t*)(ws + S1_K), (bf16_t*)(ws + S1_VT), p.in[31], p.in[32], (const float*)(ws + T_ROPE)};
      pg8::EpiHead<EpiWin1> pe{e}; pg8::gemm_phase((LAS unsigned char*)lds, pg8::Gemm{A0, WB + W_IN1, 1024, 1024}, pg8::Order{0, NR / 256, 6, (int)nb, vbid}, pe); }
    { int rk, nrk; slack_rank((NR / 256) * 6, rk, nrk); transpose_range(lds, ws, p, p.jobs[9].tile0 + 704, p.njobtiles, rk, nrk); }
    GRID_SYNC();
    { const bf16_t* Q = (const bf16_t*)(ws + S1_Q); const bf16_t* K1 = (const bf16_t*)(ws + S1_K); const bf16_t* VT = (const bf16_t*)(ws + S1_VT);
      constexpr int WNH = 2;
      const int nit = 2 * 4 * (4 / WNH) * 32;
      float mref; { float gq = 0.f, gk = 0.f;
        for (int d_ = 0; d_ < 64; ++d_) { gq = fmaxf(gq, fabsf(p.in[31][d_])); gk = fmaxf(gk, fabsf(p.in[32][d_])); }
        mref = 8.f * LOG2E * 1.02f * gq * gk; }
      for (int it = bid; it < nit; it += nb) { const int kvh = it & 3, b = (it >> 2) & 1, rest = it >> 3; const int gp = rest % (4 / WNH), i = rest / (4 / WNH); const int hq0 = kvh * 4 + gp * WNH;
          const size_t row = NCTX + (size_t)b * SEQ + i * 256;
          const int l0 = (4 * i - 2) < 0 ? 0 : (4 * i - 2), l1 = (4 * i + 6) > 128 ? 128 : (4 * i + 6);
          win_attn_item<WNH>(lds, Q + row * 1024 + hq0 * 64, K1 + (size_t)(b * 4 + kvh) * TK * 64, VT + (size_t)(b * 4 + kvh) * 64 * TK, 4 + l0, 4 + l1, mref, p.in[33] + hq0, A0 + row * 1024 + hq0 * 64, i * 256); } }
    GRID_SYNC();
    { EpiRes e{H, H + (size_t)NCTX * 1024, nullptr, H + (size_t)NCTX * 1024, MOD + 1 * 3 * 6144 + 2048, 0};
      (void)e; pg8::EpiRes pe{nullptr, Hb + (size_t)NCTX * 1024, Hb + (size_t)NCTX * 1024, nullptr, MOD + 1 * 3 * 6144 + 2048}; pg8::gemm_phase((LAS unsigned char*)lds, pg8::Gemm{A0, WB + W_OUT1, 1024, 1024}, pg8::Order{2, NLAT / 256, 4, (int)nb, vbid}, pe); }
    GRID_SYNC();
    modulate_rows(p, 1, 1, false, NCTX);
    GRID_SYNC();
    { EpiSwiGLU e{(bf16_t*)(ws + S_HID)};
      (void)e; pg8::EpiSwiGLU pe{(bf16_t*)(ws + S_HID)}; pg8::gemm_phase((LAS unsigned char*)lds, pg8::Gemm{A0, WB + W_GU1, 1024, 1024}, pg8::Order{2, NLAT / 256, 22, (int)nb, vbid}, pe); }
    GRID_SYNC();
    { EpiRes e{H, H + (size_t)NCTX * 1024, nullptr, p.out, MOD + 1 * 3 * 6144 + 5120, 0};
      (void)e; pg8::EpiRes pe{nullptr, Hb + (size_t)NCTX * 1024, nullptr, p.out, MOD + 1 * 3 * 6144 + 5120}; pg8::gemm_phase((LAS unsigned char*)lds, pg8::Gemm{(const bf16_t*)(ws + S_HID), WB + W_D1, FH, FH}, pg8::Order{2, NLAT / 256, 4, (int)nb, vbid}, pe); }
}

extern "C" void kernel_launch(void* const* d_in, const int* in_sizes, int n_in, void* d_out, int out_size, void* d_ws, size_t ws_size, hipStream_t stream) {
    static int grid_blocks = 0;
    if (grid_blocks == 0) {
        if (n_in != 34 || ws_size < WS_NEED2) { fprintf(stderr, "kernel_launch: unexpected n_in %d / ws %zu (need %zu)\n", n_in, ws_size, (size_t)WS_NEED2); grid_blocks = -1; return; }
        int dev = 0, cus = 0, per_cu = 0;
        (void)hipGetDevice(&dev);
        (void)hipDeviceGetAttribute(&cus, hipDeviceAttributeMultiprocessorCount, dev);
        (void)hipFuncSetAttribute((const void*)fwd_kernel, hipFuncAttributeMaxDynamicSharedMemorySize, LDS_BYTES);
        (void)hipOccupancyMaxActiveBlocksPerMultiprocessor(&per_cu, (const void*)fwd_kernel, NTHREADS, LDS_BYTES);
        if (per_cu < 1) { fprintf(stderr, "kernel_launch: occupancy query returned %d\n", per_cu); grid_blocks = -1; return; }
        if (per_cu > 1) per_cu = 1;
        grid_blocks = cus * per_cu;
        fprintf(stderr, "kernel_launch: grid %d (%d CUs x %d)\n", grid_blocks, cus, per_cu);
    }
    if (grid_blocks < 0) return;
    Params p{};
    for (int i = 0; i < 34; ++i) p.in[i] = (const float*)d_in[i];
    p.out = (float*)d_out; p.ws = (char*)d_ws;
    const float* fg = p.in[8]; const float* fu = p.in[9]; const float* fd = p.in[10];
    const size_t FW = (size_t)1024 * FH;
    int t0 = 0;
    auto mk = [&](int idx, const float* a, const float* b, size_t dst, int K, int ld, int npad, int mode) {
        Job& j = p.jobs[idx]; j.a = a; j.b = b; j.ks = nullptr; j.dst = dst; j.K = K; j.ld = ld; j.ntk = K / 64; j.ntn = npad / 64; j.tile0 = t0; j.mode = mode; t0 += j.ntk * j.ntn; };
    mk(0, p.in[11], nullptr, W_IN0, 1024, 1216, 1280, 2);
    mk(1, p.in[24], nullptr, W_QB, 384, 768, 768, 0);
    mk(2, p.in[26], nullptr, W_KVB, 256, 1024, 1024, 0);
    p.jobs[1].ks = p.in[23]; p.jobs[2].ks = p.in[25];
    mk(3, p.in[21], nullptr, W_GLU, 512, 512, 512, 0);
    mk(4, p.in[12], nullptr, W_OUT0, 1024, 1024, 1024, 0);
    mk(5, fg, fu, W_GU0, 1024, FH, 5632, 1);
    mk(6, fd, nullptr, W_D0, FH, 1024, 1024, 0);
    mk(7, p.in[29], nullptr, W_IN1, 1024, 1536, 1536, 2);
    mk(8, p.in[30], nullptr, W_OUT1, 1024, 1024, 1024, 0);
    mk(9, fg + FW, fu + FW, W_GU1, 1024, FH, 5632, 1);
    mk(10, fd + FW, nullptr, W_D1, FH, 1024, 1024, 0);
    p.njobtiles = t0;
    if (hipMemsetAsync((char*)d_ws + T_BAR, 0, XCD_BAR_WORDS * 4, stream) != hipSuccess) { fprintf(stderr, "kernel_launch: memset failed\n"); return; }
    void* args[] = {&p};
    hipError_t e = hipLaunchCooperativeKernel((const void*)fwd_kernel, dim3(grid_blocks), dim3(NTHREADS), args, LDS_BYTES, stream);
    if (e != hipSuccess) fprintf(stderr, "cooperative launch failed: %s (grid %d)\n", hipGetErrorString(e), grid_blocks);
}
```

```cpp
#include <hip/hip_runtime.h>
#include <hip/hip_cooperative_groups.h>
#include <cstdio>
#include <cstdint>
namespace cg = cooperative_groups;

#define DI __device__ __forceinline__
typedef unsigned short bf16_t;
typedef short bf16x8 __attribute__((ext_vector_type(8)));
typedef short s16x4 __attribute__((ext_vector_type(4)));
typedef float f32x4 __attribute__((ext_vector_type(4)));
typedef float f32x2 __attribute__((ext_vector_type(2)));
typedef float f32x16 __attribute__((ext_vector_type(16)));
typedef unsigned u32x4 __attribute__((ext_vector_type(4)));
typedef unsigned u32x2 __attribute__((ext_vector_type(2)));
typedef __bf16 bf16v2 __attribute__((ext_vector_type(2)));

constexpr int DM = 1024, NBATCH = 2, SEQ = 8192, CTX = 256;
constexpr int NCTX = NBATCH * CTX;
constexpr int NLAT = NBATCH * SEQ;
constexpr int NR = NCTX + NLAT;
constexpr int TK = CTX + SEQ;
constexpr int FH = 2816;
constexpr int NCH = TK / 64;
constexpr float LOG2E = 1.4426950408889634f;
constexpr int LDS_BYTES = 131072 + 64;
constexpr int NTHREADS = 512, NWV = 8;

constexpr size_t W_IN0 = 0;
constexpr size_t W_QB = W_IN0 + (size_t)1280 * 1024;
constexpr size_t W_KVB = W_QB + (size_t)768 * 384;
constexpr size_t W_GLU = W_KVB + (size_t)1024 * 256;
constexpr size_t W_OUT0 = W_GLU + (size_t)512 * 512;
constexpr size_t W_GU0 = W_OUT0 + (size_t)1024 * 1024;
constexpr size_t W_D0 = W_GU0 + (size_t)5632 * 1024;
constexpr size_t W_IN1 = W_D0 + (size_t)1024 * 2816;
constexpr size_t W_OUT1 = W_IN1 + (size_t)1536 * 1024;
constexpr size_t W_GU1 = W_OUT1 + (size_t)1024 * 1024;
constexpr size_t W_D1 = W_GU1 + (size_t)5632 * 1024;
constexpr size_t W_END = W_D1 + (size_t)1024 * 2816;
constexpr size_t OFF_TAB = W_END * 2;
constexpr size_t T_MOD = OFF_TAB;
constexpr size_t T_ROPE = T_MOD + 2 * 3 * 6144 * 4;
constexpr size_t T_LAMB = T_ROPE + 128 * 16 * 2 * 4;
constexpr size_t T_LAM64 = T_LAMB + 2 * 32 * 64 * 8;
constexpr size_t T_BBAR = T_LAM64 + 2 * 32 * 64 * 8;
constexpr size_t T_BAR = T_BBAR + (size_t)2 * 32 * 64 * 16 * 8;
constexpr size_t OFF_H = OFF_TAB + (1u << 20);
constexpr size_t OFF_A0 = OFF_H + (size_t)NR * 1024 * 4;
constexpr size_t OFF_S = OFF_A0 + (size_t)NR * 1024 * 2;
constexpr size_t WS_NEED = OFF_S + (size_t)108134400;
constexpr size_t S_SSP = WS_NEED;
constexpr size_t WS_NEED2 = S_SSP + (size_t)NR * 10 * 4;
static_assert(WS_NEED2 <= ((size_t)256 << 20) && OFF_S + (size_t)NR * FH * 2 <= WS_NEED, "workspace");
constexpr int SL = 32;
constexpr int NCK = TK / SL;
constexpr int CHR = NBATCH * NCK;
constexpr size_t H_UA = OFF_H;
constexpr size_t H_KR = H_UA + (size_t)(32 * CHR + 256) * 768 * 2;
constexpr size_t H_E = H_KR + (size_t)NR * 64 * 4;
constexpr size_t H_KK = H_E + (size_t)32 * CHR * 256 * 4;
constexpr size_t H_POW = H_KK + (size_t)32 * 2 * 32 * 256 * 4;
constexpr size_t H_W1A = H_POW + (size_t)4096 * 33 * 8;
static_assert(H_W1A + (size_t)32 * 256 * 512 * 2 <= OFF_A0, "H region overflow");
constexpr size_t A_W1B = OFF_A0;
constexpr size_t S_CQN = OFF_S;
constexpr size_t S_CKVN = S_CQN + (size_t)NR * 384 * 2;
constexpr size_t S_YG = OFF_S;
constexpr size_t S_X = S_CKVN + (size_t)NR * 256 * 2;
constexpr size_t S_CQKV = S_X;
constexpr size_t S_QRAW = S_X;
constexpr size_t S_KNOPE = S_QRAW + (size_t)NR * 768 * 2;
constexpr size_t S_VT = S_KNOPE + (size_t)NR * 512 * 2;
constexpr size_t S_KA = S_VT + (size_t)2 * 4 * 128 * TK * 2;
static_assert(S_CQKV + (size_t)NR * 640 * 4 <= S_VT, "CQKV overlaps VT");
static_assert(S_KA + (size_t)2 * 4 * TK * 192 * 2 <= WS_NEED, "scratch overflow");
constexpr size_t S_HID = OFF_S;
constexpr size_t S1_Q = OFF_S;
constexpr size_t S1_KRAW = S1_Q + (size_t)NR * 1024 * 2;
constexpr size_t S1_K = S1_KRAW + (size_t)NR * 256 * 4;
constexpr size_t S1_VT = S1_K + (size_t)2 * 4 * TK * 64 * 2;

struct Job { const float* a; const float* b; const float* ks; unsigned long long dst; int K, ld, ntk, ntn, tile0, mode; };
struct Params {
    const float* in[34];
    float* out;
    char* ws;
    Job jobs[11];
    int njobtiles;
    int pad;
};

DI int get_tid() { int t = threadIdx.x; asm volatile("" : "+v"(t)); return t; }
DI unsigned pk2(float lo, float hi) { f32x2 v = {lo, hi}; return __builtin_bit_cast(unsigned, __builtin_convertvector(v, bf16v2)); }
DI float bf2f(unsigned short b) { return __uint_as_float(((unsigned)b) << 16); }
DI f32x4 ld_bf4(const bf16_t* q) { const u32x2 w = *(const u32x2*)q; return (f32x4){__uint_as_float(w[0] << 16), __uint_as_float(w[0] & 0xffff0000u), __uint_as_float(w[1] << 16), __uint_as_float(w[1] & 0xffff0000u)}; }
DI void st_bf4(bf16_t* q, f32x4 v) { *(u32x2*)q = (u32x2){pk2(v[0], v[1]), pk2(v[2], v[3])}; }
DI float wave_sum(float v) {
#pragma unroll
    for (int o = 32; o > 0; o >>= 1) v += __shfl_xor(v, o);
    return v;
}
DI int row_vec(int r) { return r < NCTX ? 2 : (r - NCTX) / SEQ; }
DI int row_batch(int r) { return r < NCTX ? r / CTX : (r - NCTX) / SEQ; }
DI int row_tpos(int r) { return r < NCTX ? r % CTX : CTX + (r - NCTX) % SEQ; }
DI float sigmoidf_(float x) { return __builtin_amdgcn_rcpf(1.f + __expf(-x)); }
DI float siluf_(float x) { return x * __builtin_amdgcn_rcpf(1.f + __expf(-x)); }
DI float gelu_tanh(float y) { const float z = 0.7978845608028654f * (y + 0.044715f * y * y * y); const float t = 1.f - 2.f * __builtin_amdgcn_rcpf(1.f + __expf(2.f * z)); return 0.5f * y * (1.f + t); }
DI void my_sincos(float x, float& s, float& c) {
    const float q = rintf(x * 0.636619772367581f);
    float r = fmaf(-q, 1.5703125f, x);
    r = fmaf(-q, 4.837512969970703125e-4f, r);
    r = fmaf(-q, 7.54978995489188216e-8f, r);
    const int qi = (int)q;
    const float r2 = r * r;
    const float sp = r + r * r2 * (-1.6666654611e-1f + r2 * (8.3321608736e-3f + r2 * (-1.9515295891e-4f)));
    const float cp = 1.0f - 0.5f * r2 + r2 * r2 * (4.166664568298827e-2f + r2 * (-1.388731625493765e-3f + r2 * 2.443315711809948e-5f));
    const int k = qi & 3;
    s = (k == 0) ? sp : (k == 1) ? cp : (k == 2) ? -sp : -cp;
    c = (k == 0) ? cp : (k == 1) ? -sp : (k == 2) ? -cp : sp;
}


#define XB_TMO      128
#define XB_XCNT(j)  (256  + 64 * (j))
#define XB_XSUB(j)  (1280 + 64 * (j))
#define XB_XGEN(j)  (2304 + 64 * (j))
#define XB_TOP      3328
#define XB_TOPGEN   3392
#define XCD_BAR_WORDS 3456
#define XB_SPIN_CAP (1u << 22)
#define LAS __attribute__((address_space(3)))
DI unsigned xb_ld(unsigned* p) { return __hip_atomic_load(p, __ATOMIC_RELAXED, __HIP_MEMORY_SCOPE_AGENT); }
DI unsigned xb_add(unsigned* p, unsigned v) { return __hip_atomic_fetch_add(p, v, __ATOMIC_RELAXED, __HIP_MEMORY_SCOPE_AGENT); }
DI unsigned xb_xcc_id() { return (unsigned)__builtin_amdgcn_s_getreg((3 << 11) | 20) & 0xFu; }
#define XB_SPIN(cond, bar) do { unsigned _sp = 0; while (cond) { __builtin_amdgcn_s_sleep(1); \
    if ((++_sp & 255u) == 0u) { if (xb_ld(&(bar)[XB_TMO])) break; if (_sp > XB_SPIN_CAP) { atomicAdd(&(bar)[XB_TMO], 1u); break; } } } } while (0)
struct XcdBarrier { unsigned* bar; unsigned x; volatile LAS unsigned* st; };
DI XcdBarrier xcd_barrier_post(unsigned* bar, volatile LAS unsigned* st) {
    XcdBarrier b; b.bar = bar; b.x = xb_xcc_id(); b.st = st;
    if (threadIdx.x == 0) (void)xb_add(&bar[XB_XCNT(b.x)], 1u);
    return b;
}
DI void xcd_barrier_complete(unsigned* bar, unsigned x, unsigned& nloc, unsigned& nx) {
    const unsigned G = gridDim.x * gridDim.y * gridDim.z;
    unsigned sum, cnt, mine, sp = 0u;
    for (;;) {
        sum = 0u; cnt = 0u; mine = 0u;
#pragma unroll
        for (unsigned j = 0; j < 16; ++j) { const unsigned c = xb_ld(&bar[XB_XCNT(j)]); sum += c; cnt += (c > 0u) ? 1u : 0u; mine = (j == x) ? c : mine; }
        if (sum == G) break;
        __builtin_amdgcn_s_sleep(1);
        if ((++sp & 255u) == 0u) { if (xb_ld(&bar[XB_TMO])) break; if (sp > XB_SPIN_CAP) { atomicAdd(&bar[XB_TMO], 1u); break; } }
    }
    nloc = mine > 0u ? mine : 1u; nx = cnt > 0u ? cnt : 1u;
}
DI void xcd_barrier(const XcdBarrier& b) {
    asm volatile("s_waitcnt vmcnt(0)" ::: "memory");
    __syncthreads();
    if (threadIdx.x == 0) {
        unsigned* bar = b.bar;
        __builtin_amdgcn_s_waitcnt(0);
        unsigned nloc = b.st[0], nx = b.st[1];
        if (nloc == 0u) { xcd_barrier_complete(bar, b.x, nloc, nx); b.st[0] = nloc; b.st[1] = nx; }
        const unsigned old = xb_add(&bar[XB_XSUB(b.x)], 1u);
        const unsigned gen = old / nloc;
        if (old + 1u == (gen + 1u) * nloc) {
            __builtin_amdgcn_fence(__ATOMIC_RELEASE, "agent");
            asm volatile("s_waitcnt vmcnt(0)" ::: "memory");
            const unsigned og = xb_add(&bar[XB_TOP], 1u);
            const unsigned tg = og / nx;
            if (og + 1u == (tg + 1u) * nx) xb_add(&bar[XB_TOPGEN], 1u);
            else XB_SPIN(xb_ld(&bar[XB_TOPGEN]) == tg, bar);
            __builtin_amdgcn_fence(__ATOMIC_ACQUIRE, "agent");
            xb_add(&bar[XB_XGEN(b.x)], 1u);
            asm volatile("s_waitcnt vmcnt(0)" ::: "memory");
        } else {
            XB_SPIN(xb_ld(&bar[XB_XGEN(b.x)]) == gen, bar);
            __builtin_amdgcn_fence(__ATOMIC_ACQUIRE, "agent");
            asm volatile("s_waitcnt vmcnt(0)" ::: "memory");
        }
    }
    __syncthreads();
}

DI void transpose_tile(char* lds, char* ws, const Job& jb, int lt, bool live) {
    const int tid512 = get_tid(); const int tid = tid512 & 255;
    float (*tile)[65] = (float (*)[65])(lds + (tid512 >> 8) * 17408);
    const int tk = lt % jb.ntk, tn = lt / jb.ntk;
    const int k0 = tk * 64, n0 = tn * 64;
    const int c4 = (tid & 15) * 4, rq = tid >> 4;
    const float* src; int col; bool valid = live;
    if (jb.mode == 0) { src = jb.a; col = n0 + c4; valid = live && col < jb.ld; }
    else if (jb.mode == 2) { src = jb.a; const int rho = (n0 + c4) & 255; col = (n0 + c4 - rho) + 64 * ((rho >> 5) & 3) + 32 * (rho >> 7) + (rho & 31); valid = live && col < jb.ld; }
    else { const int nsub = c4 >> 4, i = c4 & 15; src = (nsub & 1) ? jb.b : jb.a; col = tn * 32 + (nsub >> 1) * 16 + i; }
#pragma unroll
    for (int kk = 0; kk < 4; ++kk) { const int k = kk * 16 + rq; f32x4 v = valid ? __builtin_nontemporal_load((const f32x4*)(src + (size_t)(k0 + k) * jb.ld + col)) : (f32x4){0.f, 0.f, 0.f, 0.f};
        if (jb.ks) v = v * jb.ks[k0 + k];
        tile[k][c4] = v[0]; tile[k][c4 + 1] = v[1]; tile[k][c4 + 2] = v[2]; tile[k][c4 + 3] = v[3]; }
    __syncthreads();
    const int r = tid >> 2, ks = (tid & 3) * 16;
    unsigned w[8];
#pragma unroll
    for (int q = 0; q < 8; ++q) w[q] = pk2(tile[ks + 2 * q][r], tile[ks + 2 * q + 1][r]);
    bf16_t* d = (bf16_t*)(ws) + jb.dst + (size_t)(n0 + r) * jb.K + k0 + ks;
    if (live) { *(u32x4*)d = (u32x4){w[0], w[1], w[2], w[3]};
    *(u32x4*)(d + 8) = (u32x4){w[4], w[5], w[6], w[7]}; }
    __syncthreads();
}

DI void transpose_range(char* lds, char* ws, const Params& p, int t_begin, int t_end, int rank, int nranks) {
    if (rank < 0) return;
    for (int pr = (t_begin >> 1) + rank; pr < (t_end >> 1); pr += nranks) {
        const int lt = pr * 2 + (int)(threadIdx.x >> 8); int j = 0;
#pragma unroll
        for (int q = 1; q < 11; ++q) if (lt >= p.jobs[q].tile0) j = q;
        transpose_tile(lds, ws, p.jobs[j], lt - p.jobs[j].tile0, true);
    }
}
DI int virt_block() { const int G_ = gridDim.x; return ((G_ & 7) == 0) ? (int)(blockIdx.x & 7) * (G_ >> 3) + (int)(blockIdx.x >> 3) : (int)blockIdx.x; }
DI void slack_rank(int ntile, int& rank, int& nranks) { const int rem = ntile % (int)gridDim.x; const int vb = virt_block(); if (rem == 0) { rank = vb; nranks = gridDim.x; } else { rank = vb - rem; nranks = (int)gridDim.x - rem; } }

DI void ada_item(char* lds, const Params& p, int it) {
    float* sil = (float*)lds;
    float* red = sil + 3072;
    float* MOD = (float*)(p.ws + T_MOD);
    const int tid = get_tid(), layer = it / 96, n0 = (it % 96) * 64;
    for (int i = tid; i < 3072; i += NTHREADS) { const int v = i >> 10, k = i & 1023; const float x = v < 2 ? p.in[1][v * 1024 + k] : p.in[3][k]; sil[i] = siluf_(x); }
    __syncthreads();
    const int j4 = (tid & 15) * 4, kg = tid >> 4;
    const float* W = p.in[4] + (size_t)layer * 1024 * 6144 + n0 + j4;
    f32x4 a0 = {0.f, 0.f, 0.f, 0.f}, a1 = a0, a2 = a0;
#pragma unroll 8
    for (int k = kg * 32; k < kg * 32 + 32; ++k) { const f32x4 w = __builtin_nontemporal_load((const f32x4*)(W + (size_t)k * 6144)); a0 += sil[k] * w; a1 += sil[1024 + k] * w; a2 += sil[2048 + k] * w; }
    *(f32x4*)(red + (kg * 3 + 0) * 64 + j4) = a0; *(f32x4*)(red + (kg * 3 + 1) * 64 + j4) = a1; *(f32x4*)(red + (kg * 3 + 2) * 64 + j4) = a2;
    __syncthreads();
    if (tid < 192) { const int v = tid >> 6, jj = tid & 63;
        float s = p.in[5][layer * 6144 + n0 + jj];
#pragma unroll 8
        for (int q = 0; q < 32; ++q) s += red[(q * 3 + v) * 64 + jj];
        MOD[(layer * 3 + v) * 6144 + n0 + jj] = s; }
    __syncthreads();
}

DI void tables_item(const Params& p, int it) {
    const int tid = get_tid();
    if (it < 4) {
        const int e = it * 512 + tid, pos = e >> 4, i = e & 15;
        const float inv = exp2f(-(float)i * (13.287712379549449f / 16.f));
        float s, c; my_sincos((float)pos * inv, s, c);
        float* ROPE = (float*)(p.ws + T_ROPE); ROPE[e * 2] = c; ROPE[e * 2 + 1] = s;
    } else {
        const int e = (it - 4) * 512 + tid;
        const int dg = e >> 6;
        const float lr = p.in[13][e], li = p.in[14][e], step = expf(p.in[15][dg]);
        const float a = lr * step, b = li * step;
        const float ea = expf(a);
        float sb, cb; my_sincos(b, sb, cb);
        float sh, ch; my_sincos(0.5f * b, sh, ch);
        const float em1 = a * (1.f + a * 0.5f * (1.f + a * (1.f / 3.f) * (1.f + a * 0.25f * (1.f + a * 0.2f * (1.f + a * (1.f / 6.f))))));
        const float lbr = ea * cb, lbi = ea * sb;
        const float nr = em1 * cb - 2.f * sh * sh, ni = ea * sb;
        const float den = lr * lr + li * li;
        const float qr = (nr * lr + ni * li) / den, qi = (ni * lr - nr * li) / den;
        f32x2* BB = (f32x2*)(p.ws + T_BBAR);
#pragma unroll
        for (int s = 0; s < 16; ++s) { const float br = p.in[16][e * 16 + s], bi = p.in[17][e * 16 + s]; BB[e * 16 + s] = (f32x2){qr * br - qi * bi, qr * bi + qi * br}; }
        f32x2* POW = (f32x2*)(p.ws + H_POW) + (size_t)dg * 33 * 64 + (e & 63);
        float pr = 1.f, pi = 0.f;
        for (int q = 0; q <= 32; ++q) { POW[q * 64] = (f32x2){pr, pi}; const float nr2 = pr * lbr - pi * lbi, ni2 = pr * lbi + pi * lbr; pr = nr2; pi = ni2; }
    }
}

DI void modulate_rows(const Params& p, int layer, int which, bool from_inputs, int r0) {
    const int tid_ = get_tid(); const int lane = tid_ & 63, wid = tid_ >> 6;
    const float* gain = p.in[which ? 7 : 6] + layer * 1024;
    const float* modl = (const float*)(p.ws + T_MOD) + layer * 3 * 6144 + (which ? 3072 : 0);
    const bf16_t* Hb = (const bf16_t*)(p.ws + OFF_H);
    bf16_t* dst = (bf16_t*)(p.ws + OFF_A0);
    const int stride = gridDim.x * NWV;
    for (int ra = r0 + blockIdx.x * NWV + wid; ra < NR; ra += 2 * stride) {
        const int rb = ra + stride; const bool hb = rb < NR; const int rbb = hb ? rb : ra;
        const float* srca = ra < NCTX ? p.in[2] + (size_t)ra * 1024 : p.in[0] + (size_t)(ra - NCTX) * 1024;
        const float* srcb = rbb < NCTX ? p.in[2] + (size_t)rbb * 1024 : p.in[0] + (size_t)(rbb - NCTX) * 1024;
        f32x4 xa[4], xb[4]; float sa = 0.f, sb = 0.f;
#pragma unroll
        for (int i = 0; i < 4; ++i) { if (from_inputs) { xa[i] = *(const f32x4*)(srca + i * 256 + lane * 4); xb[i] = *(const f32x4*)(srcb + i * 256 + lane * 4); }
                                      else { xa[i] = ld_bf4(Hb + (size_t)ra * 1024 + i * 256 + lane * 4); xb[i] = ld_bf4(Hb + (size_t)rbb * 1024 + i * 256 + lane * 4); } }
#pragma unroll
        for (int i = 0; i < 4; ++i) { sa += xa[i][0] * xa[i][0] + xa[i][1] * xa[i][1] + xa[i][2] * xa[i][2] + xa[i][3] * xa[i][3];
                                      sb += xb[i][0] * xb[i][0] + xb[i][1] * xb[i][1] + xb[i][2] * xb[i][2] + xb[i][3] * xb[i][3]; }
        sa = wave_sum(sa); sb = wave_sum(sb);
        const float rsa = rsqrtf(sa * (1.f / 1024.f) + 1e-6f), rsb = rsqrtf(sb * (1.f / 1024.f) + 1e-6f);
        const float* mva = modl + row_vec(ra) * 6144; const float* mvb = modl + row_vec(rbb) * 6144;
#pragma unroll
        for (int i = 0; i < 4; ++i) { const int c = i * 256 + lane * 4;
            const f32x4 g = *(const f32x4*)(gain + c);
            { const f32x4 sh = *(const f32x4*)(mva + c), sc = *(const f32x4*)(mva + 1024 + c); const f32x4 y = xa[i] * rsa * g * (1.f + sc) + sh;
              *(u32x2*)(dst + (size_t)ra * 1024 + c) = (u32x2){pk2(y[0], y[1]), pk2(y[2], y[3])}; }
            if (hb) { const f32x4 sh = *(const f32x4*)(mvb + c), sc = *(const f32x4*)(mvb + 1024 + c); const f32x4 y = xb[i] * rsb * g * (1.f + sc) + sh;
              *(u32x2*)(dst + (size_t)rb * 1024 + c) = (u32x2){pk2(y[0], y[1]), pk2(y[2], y[3])}; } }
    }
}

template <class Epi>
DI void gemm_phase(char* lds, const bf16_t* A0_, int lda, const bf16_t* Bt0_, int K, int mt0, int nmt, int nnt, const Epi& epi, int nbatch = 1, size_t sA = 0, size_t sB = 0, int ksplit = 1, int gact = 0) {
    const int tid = get_tid(), lane = tid & 63, wid = tid >> 6, wr = wid >> 2, wc = wid & 3, fr = lane & 15, fq = lane >> 4;
    const int nk = (K >> 6) / ksplit;
    const int lrow = tid >> 3, lc = tid & 7, lkc = lc * 8;
    const int woff = lrow * 128 + ((lc ^ ((lrow >> 1) & 7)) << 4);
    const int ra0 = (wr * 128 + fr) * 128 + ((fq ^ (fr >> 1)) << 4);
    const int ra1 = (wr * 128 + fr) * 128 + (((4 + fq) ^ (fr >> 1)) << 4);
    const int rb0 = 32768 + (wc * 64 + fr) * 128 + ((fq ^ (fr >> 1)) << 4);
    const int rb1 = 32768 + (wc * 64 + fr) * 128 + (((4 + fq) ^ (fr >> 1)) << 4);
    const int per = nmt * nnt, ntile = nbatch * per * ksplit;
    const int PM = nnt >= 8 ? 4 : 8;
    const int GA = gact > 0 ? gact : (int)gridDim.x;
    const int myn = ((int)blockIdx.x < GA && (int)blockIdx.x < ntile) ? (ntile - (int)blockIdx.x + GA - 1) / GA : 0;
    const int total = myn * nk;
    f32x4 acc[8][4];
#pragma unroll
    for (int m = 0; m < 8; ++m)
#pragma unroll
        for (int n = 0; n < 4; ++n) acc[m][n] = (f32x4){0.f, 0.f, 0.f, 0.f};
    int iti = 0, ikt = 0;
    const int srow = wid * 32 + (lane >> 3);
    const bf16_t* Ag = A0_; const bf16_t* Bg = Bt0_;
#define G_STAGE(bufoff) do { if (ikt == 0) { const int u_ = blockIdx.x + iti * GA; const int t_ = u_ / ksplit, sl_ = u_ - t_ * ksplit; const int gb_ = t_ / per, tr_ = t_ - gb_ * per; const int ch_ = tr_ / (PM * nnt), rm_ = tr_ - ch_ * PM * nnt; const int pc_ = (nmt - ch_ * PM) < PM ? (nmt - ch_ * PM) : PM; const int tn_ = rm_ / pc_, tm_ = ch_ * PM + (rm_ - tn_ * pc_); \
            Ag = A0_ + (size_t)gb_ * sA + (size_t)((mt0 + tm_) * 256) * lda + sl_ * nk * 64; Bg = Bt0_ + (size_t)gb_ * sB + (size_t)(tn_ * 256) * K + sl_ * nk * 64; } \
        _Pragma("unroll") for (int i = 0; i < 4; ++i) { const int row_ = srow + 8 * i; const int c_ = ((lane & 7) ^ ((row_ >> 1) & 7)) * 8; \
            __builtin_amdgcn_global_load_lds((const unsigned*)(Ag + (size_t)row_ * lda + ikt * 64 + c_), (LAS unsigned*)(lds + (bufoff) + (wid * 4 + i) * 1024), 16, 0, 0); \
            __builtin_amdgcn_global_load_lds((const unsigned*)(Bg + (size_t)row_ * K + ikt * 64 + c_), (LAS unsigned*)(lds + (bufoff) + 32768 + (wid * 4 + i) * 1024), 16, 0, 0); } \
        if (++ikt == nk) { ikt = 0; ++iti; } } while (0)
#define G_COMPUTE(bufoff) do { _Pragma("unroll") for (int ks = 0; ks < 2; ++ks) { bf16x8 a[8], b[4]; \
        _Pragma("unroll") for (int m = 0; m < 8; ++m) a[m] = *(const bf16x8*)(lds + (bufoff) + (ks ? ra1 : ra0) + m * 2048); \
        _Pragma("unroll") for (int n = 0; n < 4; ++n) b[n] = *(const bf16x8*)(lds + (bufoff) + (ks ? rb1 : rb0) + n * 2048); \
        _Pragma("unroll") for (int m = 0; m < 8; ++m) _Pragma("unroll") for (int n = 0; n < 4; ++n) acc[m][n] = __builtin_amdgcn_mfma_f32_16x16x32_bf16(b[n], a[m], acc[m][n], 0, 0, 0); } } while (0)
    __syncthreads();
    if (total > 0) G_STAGE(0);
    asm volatile("s_waitcnt vmcnt(0)" ::: "memory");
    __syncthreads();
    int cti = 0, ckt = 0;
    for (int q = 0; q < total; ++q) {
        const int cur = (q & 1) * 65536;
        if (q + 1 < total) G_STAGE(cur ^ 65536);
        G_COMPUTE(cur);
        asm volatile("s_waitcnt vmcnt(0)" ::: "memory");
        __syncthreads();
        if (++ckt == nk) {
            const int u_ = blockIdx.x + cti * GA; const int t_ = u_ / ksplit; const int gb_ = t_ / per, tr_ = t_ - gb_ * per; const int ch_ = tr_ / (PM * nnt), rm_ = tr_ - ch_ * PM * nnt; const int pc_ = (nmt - ch_ * PM) < PM ? (nmt - ch_ * PM) : PM; const int tn_ = rm_ / pc_, tm_ = ch_ * PM + (rm_ - tn_ * pc_);
            epi(acc, (mt0 + tm_) * 256 + wr * 128 + fr, tn_ * 256 + wc * 64 + fq * 4, gb_);
#pragma unroll
            for (int m = 0; m < 8; ++m)
#pragma unroll
                for (int n = 0; n < 4; ++n) acc[m][n] = (f32x4){0.f, 0.f, 0.f, 0.f};
            ckt = 0; ++cti;
        }
    }
#undef G_STAGE
#undef G_COMPUTE
}

template <int KSP>
DI void thin_gemm_ctx(char* lds, const bf16_t* A, int lda, const bf16_t* Bt, int K, const float* res_f, const bf16_t* res_h, bf16_t* dst, const float* gate) {
    const int tid = get_tid(), lane = tid & 63, wid = tid >> 6, fr = lane & 15, fq = lane >> 4;
    float* part = (float*)lds;
    for (int t = blockIdx.x; t < 256; t += gridDim.x) {
        const int m0 = (t >> 5) * 64, n0 = (t & 31) * 32;
        f32x4 acc[4][2];
#pragma unroll
        for (int m = 0; m < 4; ++m) { acc[m][0] = (f32x4){0.f, 0.f, 0.f, 0.f}; acc[m][1] = (f32x4){0.f, 0.f, 0.f, 0.f}; }
        const bf16_t* Ap = A + (size_t)(m0 + fr) * lda + wid * (KSP * 32) + fq * 8;
        const bf16_t* Bp = Bt + (size_t)(n0 + fr) * K + wid * (KSP * 32) + fq * 8;
#pragma unroll
        for (int k = 0; k < KSP; ++k) {
            bf16x8 a[4], b[2];
#pragma unroll
            for (int m = 0; m < 4; ++m) a[m] = *(const bf16x8*)(Ap + (size_t)m * 16 * lda + k * 32);
#pragma unroll
            for (int n = 0; n < 2; ++n) b[n] = *(const bf16x8*)(Bp + (size_t)n * 16 * K + k * 32);
#pragma unroll
            for (int m = 0; m < 4; ++m)
#pragma unroll
                for (int n = 0; n < 2; ++n) acc[m][n] = __builtin_amdgcn_mfma_f32_16x16x32_bf16(b[n], a[m], acc[m][n], 0, 0, 0);
        }
        __syncthreads();
#pragma unroll
        for (int m = 0; m < 4; ++m)
#pragma unroll
            for (int n = 0; n < 2; ++n) *(f32x4*)(part + ((wid * 64 + m * 16 + fr) * 32 + n * 16 + fq * 4)) = acc[m][n];
        __syncthreads();
        { const int row = tid >> 3, c4 = (tid & 7) * 4; f32x4 sum = (f32x4){0.f, 0.f, 0.f, 0.f};
#pragma unroll
          for (int w = 0; w < 8; ++w) sum += *(const f32x4*)(part + ((w * 64 + row) * 32 + c4));
          const size_t off = (size_t)(m0 + row) * 1024 + n0 + c4;
          const f32x4 g = *(const f32x4*)(gate + 2 * 6144 + n0 + c4), x = res_h ? ld_bf4(res_h + off) : *(const f32x4*)(res_f + off);
          st_bf4(dst + off, x + g * sum); }
    }
    __syncthreads();
}

struct EpiWin0 {
    bf16_t* UA; bf16_t* CQN; bf16_t* CKVN; float* SSP; float* KR;
    template <int NM> DI void run(const f32x4 (&acc)[NM][4], int row0, int col0) const {
        const int cw = col0 & ~63;
#pragma unroll
        for (int m = 0; m < NM; ++m) { const int ri = row0 + m * 16; const size_t r = ri;
            if (cw < 512) { const int b = row_batch(ri), tp = row_tpos(ri);
#pragma unroll
                for (int n = 0; n < 4; ++n) { const int c = col0 + n * 16; const f32x4 v = acc[m][n]; const int g = c >> 4, s0 = c & 15;
                    *(u32x2*)(UA + ((size_t)g * CHR + b * NCK + (tp >> 5)) * 768 + (tp & 31) * 16 + s0) = (u32x2){pk2(v[0], v[1]), pk2(v[2], v[3])}; }
            } else if (cw < 1152) { const bool isq = cw < 896; bf16_t* dst = isq ? CQN + r * 384 + (col0 - 512) : CKVN + r * 256 + (col0 - 896);
                float ss = 0.f;
#pragma unroll
                for (int n = 0; n < 4; ++n) { const f32x4 v = acc[m][n]; ss += v[0] * v[0] + v[1] * v[1] + v[2] * v[2] + v[3] * v[3];
                    *(u32x2*)(dst + n * 16) = (u32x2){pk2(v[0], v[1]), pk2(v[2], v[3])}; }
                ss += __shfl_xor(ss, 16); ss += __shfl_xor(ss, 32);
                if ((col0 & 15) == 0) SSP[r * 10 + ((cw - 512) >> 6)] = ss;
            } else if (cw < 1216) {
#pragma unroll
                for (int n = 0; n < 4; ++n) *(f32x4*)(KR + r * 64 + (col0 - 1152) + n * 16) = acc[m][n];
            } }
    }
    DI void operator()(const f32x4 (&acc)[8][4], int row0, int col0, int gb) const { run<8>(acc, row0, col0); }
};
struct EpiS1a {
    float* E;
    DI void operator()(const f32x4 (&acc)[8][4], int row0, int col0, int gb) const {
#pragma unroll
        for (int m = 0; m < 8; ++m) { const int r = row0 + m * 16; if (r >= CHR) continue;
#pragma unroll
            for (int n = 0; n < 4; ++n) *(f32x4*)(E + ((size_t)gb * CHR + r) * 256 + col0 + n * 16) = acc[m][n]; }
    }
};
struct EpiS1b {
    bf16_t* YG;
    DI void operator()(const f32x4 (&acc)[8][4], int row0, int col0, int gb) const {
#pragma unroll
        for (int m = 0; m < 8; ++m) { const int r = row0 + m * 16; if (r >= CHR) continue; const int b = r / NCK, c = r % NCK;
#pragma unroll
            for (int n = 0; n < 4; ++n) { const int cc = col0 + n * 16; const int tl = cc >> 4, s0 = cc & 15; const f32x4 v = acc[m][n];
                const int tp = c * SL + tl; const size_t row = tp < CTX ? (size_t)b * CTX + tp : (size_t)NCTX + (size_t)b * SEQ + (tp - CTX);
                *(u32x2*)(YG + row * 512 + gb * 16 + s0) = (u32x2){pk2(gelu_tanh(v[0]), gelu_tanh(v[1])), pk2(gelu_tanh(v[2]), gelu_tanh(v[3]))}; } }
    }
};
struct EpiBf16 {
    bf16_t* O; int ldo; const float* SSP;
    DI void operator()(const f32x4 (&acc)[8][4], int row0, int col0, int gb) const {
#pragma unroll
        for (int m = 0; m < 8; ++m) { const size_t r = row0 + m * 16; const float* sp = SSP + r * 10;
            const float rstd = rsqrtf(((sp[0] + sp[1]) + (sp[2] + sp[3]) + (sp[4] + sp[5])) * (1.f / 384.f) + 1e-6f);
#pragma unroll
            for (int n = 0; n < 4; ++n) { const int c = col0 + n * 16; const f32x4 v = acc[m][n] * rstd;
                *(u32x2*)(O + r * ldo + c) = (u32x2){pk2(v[0], v[1]), pk2(v[2], v[3])}; } }
    }
};
struct EpiKV {
    bf16_t* KNOPE; bf16_t* VT; const float* SSP;
    DI void operator()(const f32x4 (&acc)[8][4], int row0, int col0, int gb) const {
#pragma unroll
        for (int m = 0; m < 8; ++m) { const int r = row0 + m * 16; const int b = row_batch(r), tp = row_tpos(r); const float* sp = SSP + (size_t)r * 10 + 6;
            const float rstd = rsqrtf(((sp[0] + sp[1]) + (sp[2] + sp[3])) * (1.f / 256.f) + 1e-6f);
#pragma unroll
            for (int n = 0; n < 4; ++n) { const int c = col0 + n * 16; const int h = c >> 8, w = c & 255; const f32x4 v = acc[m][n] * rstd;
                if (w < 128) *(u32x2*)(KNOPE + (size_t)r * 512 + h * 128 + w) = (u32x2){pk2(v[0], v[1]), pk2(v[2], v[3])};
                else { bf16_t* d = VT + ((size_t)(b * 4 + h) * 128 + (w - 128)) * TK + tp; const unsigned p0 = pk2(v[0], v[1]), p1 = pk2(v[2], v[3]);
                    d[0] = (bf16_t)(p0 & 0xffff); d[TK] = (bf16_t)(p0 >> 16); d[2 * TK] = (bf16_t)(p1 & 0xffff); d[3 * TK] = (bf16_t)(p1 >> 16); } } }
    }
};
struct EpiGLU {
    const bf16_t* YG; const float* bias; bf16_t* CAT;
    DI void operator()(const f32x4 (&acc)[8][4], int row0, int col0, int gb) const {
#pragma unroll
        for (int m = 0; m < 8; ++m) { const size_t r = row0 + m * 16;
#pragma unroll
            for (int n = 0; n < 4; ++n) { const int c = col0 + n * 16; const f32x4 v = acc[m][n]; const f32x4 bv = *(const f32x4*)(bias + c);
                const u32x2 yy = *(const u32x2*)(YG + r * 512 + c);
                const float y0 = __uint_as_float(yy[0] << 16), y1 = __uint_as_float(yy[0] & 0xffff0000u), y2 = __uint_as_float(yy[1] << 16), y3 = __uint_as_float(yy[1] & 0xffff0000u);
                const float o0 = y0 * sigmoidf_(v[0] + bv[0]), o1 = y1 * sigmoidf_(v[1] + bv[1]), o2 = y2 * sigmoidf_(v[2] + bv[2]), o3 = y3 * sigmoidf_(v[3] + bv[3]);
                *(u32x2*)(CAT + r * 1024 + c) = (u32x2){pk2(o0, o1), pk2(o2, o3)}; } }
    }
};
struct EpiRes {
    const float* res_ctx; const float* res_lat; float* dst_ctx; float* dst_lat; const float* gate; int atomic;
    DI void operator()(const f32x4 (&acc)[8][4], int row0, int col0, int gb) const {
#pragma unroll
        for (int m = 0; m < 8; ++m) { const int r = row0 + m * 16;
            const float* rs = r < NCTX ? res_ctx + (size_t)r * 1024 : res_lat + (size_t)(r - NCTX) * 1024;
            float* ds = r < NCTX ? dst_ctx + (size_t)r * 1024 : dst_lat + (size_t)(r - NCTX) * 1024;
            if (r < NCTX && dst_ctx == nullptr) continue;
            const float* gv = gate + row_vec(r) * 6144;
#pragma unroll
            for (int n = 0; n < 4; ++n) { const int c = col0 + n * 16; const f32x4 g = *(const f32x4*)(gv + c);
                if (atomic) { const f32x4 v = g * acc[m][n];
#pragma unroll
                    for (int j = 0; j < 4; ++j) (void)__hip_atomic_fetch_add(ds + c + j, v[j], __ATOMIC_RELAXED, __HIP_MEMORY_SCOPE_AGENT); }
                else { const f32x4 x = *(const f32x4*)(rs + c); *(f32x4*)(ds + c) = x + g * acc[m][n]; } } }
    }
};
struct EpiSwiGLU {
    bf16_t* HID;
    DI void operator()(const f32x4 (&acc)[8][4], int row0, int col0, int gb) const {
        const int hc = (col0 >> 6) * 32 + (col0 & 15);
#pragma unroll
        for (int m = 0; m < 8; ++m) { const size_t r = row0 + m * 16;
#pragma unroll
            for (int q = 0; q < 2; ++q) { const f32x4 g = acc[m][2 * q], u = acc[m][2 * q + 1];
                const float o0 = siluf_(g[0]) * u[0], o1 = siluf_(g[1]) * u[1], o2 = siluf_(g[2]) * u[2], o3 = siluf_(g[3]) * u[3];
                *(u32x2*)(HID + r * FH + hc + q * 16) = (u32x2){pk2(o0, o1), pk2(o2, o3)}; } }
    }
};
struct EpiWin1 {
    bf16_t* Q; bf16_t* K1; bf16_t* VT; const float* qn; const float* kn; const float* ROPE;
    template <int NM> DI void run(const f32x4 (&acc)[NM][4], int row0, int col0) const {
        const int cw = col0 & ~63, i0 = col0 & 15;
        if (cw >= 1280) {
#pragma unroll
            for (int m = 0; m < NM; ++m) { const int r = row0 + m * 16; const int b = row_batch(r), tp = row_tpos(r);
#pragma unroll
                for (int n = 0; n < 4; ++n) { const int cc = col0 + n * 16 - 1280, h = cc >> 6, d0 = cc & 63; const f32x4 v = acc[m][n];
                    bf16_t* d = VT + ((size_t)(b * 4 + h) * 64 + d0) * TK + tp; const unsigned p0 = pk2(v[0], v[1]), p1 = pk2(v[2], v[3]);
                    d[0] = (bf16_t)(p0 & 0xffff); d[TK] = (bf16_t)(p0 >> 16); d[2 * TK] = (bf16_t)(p1 & 0xffff); d[3 * TK] = (bf16_t)(p1 >> 16); } }
            return;
        }
        const bool isq = cw < 1024;
        const float* gn = isq ? qn : kn;
        f32x4 g[4];
#pragma unroll
        for (int n = 0; n < 4; ++n) g[n] = *(const f32x4*)(gn + n * 16 + i0);
        const float osc = isq ? 0.125f * LOG2E : 1.f;
#pragma unroll
        for (int m = 0; m < NM; ++m) { const int r = row0 + m * 16; const bool lat = r >= NCTX;
            if (isq && !lat) continue;
            const int b = row_batch(r), tp = row_tpos(r), t = tp - CTX;
            float ss = 0.f;
#pragma unroll
            for (int n = 0; n < 4; ++n) { const f32x4 v = acc[m][n]; ss += v[0] * v[0] + v[1] * v[1] + v[2] * v[2] + v[3] * v[3]; }
            ss += __shfl_xor(ss, 16); ss += __shfl_xor(ss, 32);
            const float rstd = rsqrtf(ss * (1.f / 64.f) + 1e-6f);
            f32x4 y[4];
#pragma unroll
            for (int n = 0; n < 4; ++n) y[n] = acc[m][n] * rstd * g[n];
            if (lat) { const float* rr = ROPE + ((t >> 6) * 16 + i0) * 2; const float* rc = ROPE + ((t & 63) * 16 + i0) * 2;
#pragma unroll
                for (int j = 0; j < 4; ++j) { const float c0 = rr[2 * j], s0 = rr[2 * j + 1], c1 = rc[2 * j], s1 = rc[2 * j + 1];
                    const float a0 = y[0][j], a1 = y[1][j], a2 = y[2][j], a3 = y[3][j];
                    y[0][j] = a0 * c0 - a1 * s0; y[1][j] = a1 * c0 + a0 * s0; y[2][j] = a2 * c1 - a3 * s1; y[3][j] = a3 * c1 + a2 * s1; } }
            bf16_t* dst = isq ? Q + (size_t)r * 1024 + cw + i0 : K1 + ((size_t)(b * 4 + ((cw - 1024) >> 6)) * TK + tp) * 64 + i0;
#pragma unroll
            for (int n = 0; n < 4; ++n) *(u32x2*)(dst + n * 16) = (u32x2){pk2(y[n][0] * osc, y[n][1] * osc), pk2(y[n][2] * osc, y[n][3] * osc)};
        }
    }
    DI void operator()(const f32x4 (&acc)[8][4], int row0, int col0, int gb) const { run<8>(acc, row0, col0); }
};

namespace pg8 {
constexpr int BM = 256, BK = 64, HALF = 128, HTB = HALF * BK * 2;
DI int lds_byte(int r, int c) { const int st = (r >> 4) * 2 + (c >> 5), rr = r & 15, cc = c & 31, ob = rr * 64 + cc * 2; return st * 1024 + (ob ^ (((ob >> 9) & 1) << 5)); }
DI void stage_rc(int b, int& R, int& C) { const int st = b / 1024, sb = b % 1024, swz = sb ^ (((sb >> 9) & 1) << 5); R = (st >> 1) * 16 + swz / 64; C = (st & 1) * 32 + (swz % 64) / 2; }
struct Unit { int pm, pn, gb; };
struct Gemm { const bf16_t* A; const bf16_t* Bt; int lda, K; size_t sA = 0, sB = 0; };
struct Order {
    int mt0, nmt, nnt, G, c, nbatch = 1;
    DI bool next(int i, Unit& u) const { const int L0 = i * G + c; if (L0 >= nbatch * nmt * nnt) return false; constexpr int PM = 8; const int gb_ = L0 / (nmt * nnt); const int L = L0 - gb_ * nmt * nnt; u.gb = gb_;
        const int ch = L / (PM * nnt), rm = L - ch * PM * nnt; const int pc = (nmt - ch * PM) < PM ? (nmt - ch * PM) : PM; const int tn = rm / pc;
        u.pm = mt0 + ch * PM + (rm - tn * pc); u.pn = tn; return true; }
};
template <class Epi>
DI void gemm_phase(LAS unsigned char* lds, const Gemm g, const Order& S, const Epi& E) {
    const int tid = get_tid(), wid = __builtin_amdgcn_readfirstlane(tid >> 6), lane = tid & 63, wr = wid >> 2, wc = wid & 3, fr = lane & 15, fq = lane >> 4;
    const int K = g.K, nt = K / BK;
    unsigned voffA[2], voffB[2];
#pragma unroll
    for (int i = 0; i < 2; ++i) { int R, C; stage_rc(tid * 16 + i * 8192, R, C); voffA[i] = (unsigned)(R * g.lda + C) * 2u; voffB[i] = (unsigned)(R * K + C) * 2u; }
    const size_t kstep = (size_t)(BK * 2);
    const size_t hstepA = (size_t)HALF * g.lda * 2, hstepB = (size_t)HALF * K * 2;
    const size_t tstepA = 2 * hstepA, tstepB = 2 * hstepB;
    const unsigned ldsw = (unsigned)wid * 1024u;
    const int aoff = lds_byte(wr * 64 + fr, fq * 8), boff = lds_byte(wc * 32 + fr, fq * 8);
#define PG8_SA(b, h) (((b) * 2 + (h)) * HTB)
#define PG8_SB(b, h) ((4 + (b) * 2 + (h)) * HTB)
#define PG8_STAGE(bufoff, gbase, voff) do { _Pragma("unroll") for (int _i = 0; _i < 2; ++_i) \
        __builtin_amdgcn_global_load_lds((const unsigned*)((const char*)(gbase) + (voff)[_i]), (LAS unsigned*)(lds + (bufoff) + ldsw + _i * 8192), 16, 0, 0); } while (0)
#define PG8_LDA(dst, b, h) do { _Pragma("unroll") for (int m = 0; m < 4; ++m) _Pragma("unroll") for (int k = 0; k < 2; ++k) dst[m][k] = *(const LAS bf16x8*)(lds + PG8_SA(b, h) + aoff + m * 2048 + k * 1024); } while (0)
#define PG8_LDB(dst, b, h) do { _Pragma("unroll") for (int n = 0; n < 2; ++n) _Pragma("unroll") for (int k = 0; k < 2; ++k) dst[n][k] = *(const LAS bf16x8*)(lds + PG8_SB(b, h) + boff + n * 2048 + k * 1024); } while (0)
#define PG8_MMA(ai, bj, At, Bt) do { __builtin_amdgcn_s_setprio(1); _Pragma("unroll") for (int m = 0; m < 4; ++m) _Pragma("unroll") for (int n = 0; n < 2; ++n) _Pragma("unroll") for (int k = 0; k < 2; ++k) \
        acc[ai][bj][m][n] = __builtin_amdgcn_mfma_f32_16x16x32_bf16(Bt[n][k], At[m][k], acc[ai][bj][m][n], 0, 0, 0); __builtin_amdgcn_s_setprio(0); } while (0)
#define PG8_WAIT_V(n) asm volatile("s_waitcnt vmcnt(" #n ")" ::: "memory")
#define PG8_WAIT_L(n) asm volatile("s_waitcnt lgkmcnt(" #n ")" ::: "memory")
#define PG8_BAR __builtin_amdgcn_s_barrier()
#define PG8_SCHED __builtin_amdgcn_sched_barrier(0)
    Unit cur, nxt; int ui = 0;
    if (!S.next(0, cur)) return;
    f32x4 acc[2][2][4][2];
#pragma unroll
    for (int a = 0; a < 2; ++a)
#pragma unroll
        for (int b = 0; b < 2; ++b)
#pragma unroll
            for (int m = 0; m < 4; ++m)
#pragma unroll
                for (int n = 0; n < 2; ++n) acc[a][b][m][n] = (f32x4){0.f, 0.f, 0.f, 0.f};
    bf16x8 At[4][2], B0[2][2], B1[2][2];
    const char* cA = (const char*)(g.A + (size_t)cur.gb * g.sA) + (size_t)cur.pm * tstepA; const char* cB = (const char*)(g.Bt + (size_t)cur.gb * g.sB) + (size_t)cur.pn * tstepB;
    PG8_STAGE(PG8_SB(0, 0), cB, voffB); PG8_STAGE(PG8_SB(0, 1), cB + hstepB, voffB); PG8_STAGE(PG8_SA(0, 0), cA, voffA); PG8_STAGE(PG8_SA(0, 1), cA + hstepA, voffA);
    if (wr == 1) PG8_BAR;
    PG8_WAIT_V(2); PG8_BAR;
    PG8_STAGE(PG8_SB(1, 0), cB + kstep, voffB); PG8_STAGE(PG8_SA(1, 0), cA + kstep, voffA); PG8_STAGE(PG8_SB(1, 1), cB + hstepB + kstep, voffB);
    PG8_WAIT_V(6); PG8_BAR;
    for (;;) {
        const bool has_next = S.next(ui + 1, nxt);
        const char* nA = has_next ? (const char*)(g.A + (size_t)nxt.gb * g.sA) + (size_t)nxt.pm * tstepA : cA; const char* nB = has_next ? (const char*)(g.Bt + (size_t)nxt.gb * g.sB) + (size_t)nxt.pn * tstepB : cB;
        for (int t = 0; t < nt; t += 2) {
            const bool last = (t == nt - 2);
            const char* a1 = cA + (size_t)(t + 1) * kstep;
            const char* a2 = last ? nA : cA + (size_t)(t + 2) * kstep; const char* b2 = last ? nB : cB + (size_t)(t + 2) * kstep;
            const char* a3 = a2 + kstep; const char* b3 = b2 + kstep;
            PG8_LDB(B0, 0, 0); PG8_LDB(B1, 0, 1); PG8_SCHED; PG8_LDA(At, 0, 0); PG8_STAGE(PG8_SA(1, 1), a1 + hstepA, voffA);
            PG8_WAIT_V(8); PG8_WAIT_L(0); PG8_BAR; PG8_MMA(0, 0, At, B0); PG8_MMA(0, 1, At, B1); PG8_BAR; PG8_SCHED;
            PG8_LDA(At, 0, 1); PG8_STAGE(PG8_SB(0, 0), b2, voffB); PG8_STAGE(PG8_SB(0, 1), b2 + hstepB, voffB); PG8_STAGE(PG8_SA(0, 0), a2, voffA);
            PG8_WAIT_V(8); PG8_WAIT_L(0); PG8_BAR; PG8_MMA(1, 0, At, B0); PG8_MMA(1, 1, At, B1); PG8_BAR; PG8_SCHED;
            PG8_LDB(B0, 1, 0); PG8_LDB(B1, 1, 1); PG8_SCHED; PG8_LDA(At, 1, 0); PG8_STAGE(PG8_SA(0, 1), a2 + hstepA, voffA);
            PG8_WAIT_V(8); PG8_WAIT_L(0); PG8_BAR; PG8_MMA(0, 0, At, B0); PG8_MMA(0, 1, At, B1); PG8_BAR; PG8_SCHED;
            PG8_LDA(At, 1, 1); PG8_STAGE(PG8_SB(1, 0), b3, voffB); PG8_STAGE(PG8_SB(1, 1), b3 + hstepB, voffB); PG8_STAGE(PG8_SA(1, 0), a3, voffA);
            PG8_WAIT_V(8); PG8_WAIT_L(0); PG8_BAR; PG8_MMA(1, 0, At, B0); PG8_MMA(1, 1, At, B1); PG8_BAR; PG8_SCHED;
        }
        if (wr == 0) PG8_BAR;
        E(acc, cur, wr, wc, fr, fq);
        if (!has_next) break;
#pragma unroll
        for (int a = 0; a < 2; ++a)
#pragma unroll
            for (int b = 0; b < 2; ++b)
#pragma unroll
                for (int m = 0; m < 4; ++m)
#pragma unroll
                    for (int n = 0; n < 2; ++n) acc[a][b][m][n] = (f32x4){0.f, 0.f, 0.f, 0.f};
        cur = nxt; cA = nA; cB = nB; ++ui;
        if (wr == 1) PG8_BAR;
    }
    PG8_WAIT_V(0);
    PG8_BAR;
#undef PG8_SA
#undef PG8_SB
#undef PG8_STAGE
#undef PG8_LDA
#undef PG8_LDB
#undef PG8_MMA
#undef PG8_WAIT_V
#undef PG8_WAIT_L
#undef PG8_BAR
#undef PG8_SCHED
}
struct EpiRes {
    const float* res_f; const bf16_t* res_h; bf16_t* dst_h; float* dst_f; const float* gate;
    DI void operator()(const f32x4 (&acc)[2][2][4][2], const Unit& u, int wr, int wc, int fr, int fq) const {
        const int row0 = u.pm * 256 + wr * 64 + fr, col0 = u.pn * 256 + wc * 32 + fq * 4;
#pragma unroll
        for (int ai = 0; ai < 2; ++ai)
#pragma unroll
            for (int m = 0; m < 4; ++m) { const int r = row0 + 128 * ai + 16 * m; const size_t ro = (size_t)(r - NCTX) * 1024; const float* gv = gate + row_vec(r) * 6144;
#pragma unroll
                for (int bj = 0; bj < 2; ++bj)
#pragma unroll
                    for (int n = 0; n < 2; ++n) { const int c = col0 + 128 * bj + 16 * n; const f32x4 g_ = *(const f32x4*)(gv + c);
                        const f32x4 x = res_h ? ld_bf4(res_h + ro + c) : *(const f32x4*)(res_f + ro + c);
                        const f32x4 y = x + g_ * acc[ai][bj][m][n];
                        if (dst_h) st_bf4(dst_h + ro + c, y); else __builtin_nontemporal_store(y, (f32x4*)(dst_f + ro + c)); } }
    }
};
struct EpiSwiGLU {
    bf16_t* HID;
    DI void operator()(const f32x4 (&acc)[2][2][4][2], const Unit& u, int wr, int wc, int fr, int fq) const {
        const int row0 = u.pm * 256 + wr * 64 + fr, hc0 = u.pn * 128 + wc * 16 + fq * 4;
#pragma unroll
        for (int ai = 0; ai < 2; ++ai)
#pragma unroll
            for (int m = 0; m < 4; ++m) { const size_t r = row0 + 128 * ai + 16 * m;
#pragma unroll
                for (int bj = 0; bj < 2; ++bj) { const f32x4 g_ = acc[ai][bj][m][0], u_ = acc[ai][bj][m][1];
                    const float o0 = siluf_(g_[0]) * u_[0], o1 = siluf_(g_[1]) * u_[1], o2 = siluf_(g_[2]) * u_[2], o3 = siluf_(g_[3]) * u_[3];
                    *(u32x2*)(HID + r * FH + hc0 + 64 * bj) = (u32x2){pk2(o0, o1), pk2(o2, o3)}; } }
    }
};
struct EpiS1a {
    float* E;
    DI void operator()(const f32x4 (&acc)[2][2][4][2], const Unit& u, int wr, int wc, int fr, int fq) const {
        const int row0 = u.pm * 256 + wr * 64 + fr, col0 = u.pn * 256 + wc * 32 + fq * 4;
#pragma unroll
        for (int ai = 0; ai < 2; ++ai)
#pragma unroll
            for (int m = 0; m < 4; ++m) { const int r = row0 + 128 * ai + 16 * m; if (r >= CHR) continue;
#pragma unroll
                for (int bj = 0; bj < 2; ++bj)
#pragma unroll
                    for (int n = 0; n < 2; ++n) *(f32x4*)(E + ((size_t)u.gb * CHR + r) * 256 + col0 + 128 * bj + 16 * n) = acc[ai][bj][m][n]; }
    }
};
struct EpiS1b {
    bf16_t* YG;
    DI void operator()(const f32x4 (&acc)[2][2][4][2], const Unit& u, int wr, int wc, int fr, int fq) const {
        const int row0 = u.pm * 256 + wr * 64 + fr, col0 = u.pn * 256 + wc * 32 + fq * 4;
#pragma unroll
        for (int ai = 0; ai < 2; ++ai)
#pragma unroll
            for (int m = 0; m < 4; ++m) { const int r = row0 + 128 * ai + 16 * m; if (r >= CHR) continue; const int b = r / NCK, c = r % NCK;
#pragma unroll
                for (int bj = 0; bj < 2; ++bj)
#pragma unroll
                    for (int n = 0; n < 2; ++n) { const int cc = col0 + 128 * bj + 16 * n; const int tl = cc >> 4, s0 = cc & 15; const f32x4 v = acc[ai][bj][m][n];
                        const int tp = c * SL + tl; const size_t row = tp < CTX ? (size_t)b * CTX + tp : (size_t)NCTX + (size_t)b * SEQ + (tp - CTX);
                        *(u32x2*)(YG + row * 512 + u.gb * 16 + s0) = (u32x2){pk2(gelu_tanh(v[0]), gelu_tanh(v[1])), pk2(gelu_tanh(v[2]), gelu_tanh(v[3]))}; } }
    }
};
template <class E> struct EpiHead { E e;
    DI void operator()(const f32x4 (&acc)[2][2][4][2], const Unit& u, int wr, int wc, int fr, int fq) const {
#pragma unroll
        for (int ai = 0; ai < 2; ++ai) { f32x4 t[4][4];
#pragma unroll
            for (int m = 0; m < 4; ++m)
#pragma unroll
                for (int sb = 0; sb < 4; ++sb) t[m][sb] = acc[ai][sb >> 1][m][sb & 1];
            e.template run<4>(t, u.pm * 256 + 128 * ai + wr * 64 + fr, u.pn * 256 + wc * 64 + fq * 4); }
    }
};
}

template <int DQK, int DV, bool WIN>
DI void attn_item(char* lds, const bf16_t* Q, int qstride, const bf16_t* Kb, const bf16_t* VTb, int ta0, int ta1, int tb0, int tb1,
                  float mref, float l_init, bf16_t* O, int ostride, int qpos0) {
    constexpr int NKS = DQK / 16, NDT = DV / 32, KSTR = DQK + 8, VSTR = 72, NG = NKS;
    constexpr int KCH = 64 * DQK / 8 / NTHREADS, VCH = DV * 8 / NTHREADS;
    constexpr int KBUF = 64 * KSTR, VBUF = DV * VSTR;
    bf16_t* Ks = (bf16_t*)lds; bf16_t* Vs = Ks + 2 * KBUF;
    const int tid = get_tid(), lane = tid & 63, wid = tid >> 6, r = lane & 31, h2 = lane >> 5;
    bf16x8 qf[NKS];
    { const bf16_t* qrow = Q + (size_t)(wid * 32 + r) * qstride + 8 * h2;
#pragma unroll
      for (int ks = 0; ks < NKS; ++ks) qf[ks] = *(const bf16x8*)(qrow + 16 * ks); }
    f32x16 o[NDT];
#pragma unroll
    for (int dt = 0; dt < NDT; ++dt)
#pragma unroll
        for (int i = 0; i < 16; ++i) o[dt][i] = 0.f;
    float lrun = (h2 == 0) ? l_init : 0.f;
    const int na = ta1 - ta0, ntot = na + (tb1 - tb0);
    u32x4 kr[KCH], vr[VCH];
    constexpr int KTPR = (DQK / 8) / KCH, VTPR = 8 / VCH;
    const int krow = tid / KTPR, kcol = (tid % KTPR) * (KCH * 8);
    const int vrow = tid / VTPR, vcol = (tid % VTPR) * (VCH * 8);
    const bf16_t* kgp = Kb + (size_t)krow * DQK + kcol;
    const bf16_t* vgp = VTb + (size_t)vrow * TK + vcol;
    bf16_t* ksp = Ks + krow * KSTR + kcol;
    bf16_t* vsp = Vs + vrow * VSTR + vcol;
    const bf16_t* kfp = Ks + r * KSTR + 8 * h2;
    const bf16_t* vfp = Vs + r * VSTR + 8 * h2;
#define A_TILE(itv) (((itv) < na) ? ta0 + (itv) : tb0 + ((itv) - na))
#define K_LOAD(itv) do { const bf16_t* kg = kgp + (size_t)A_TILE(itv) * 64 * DQK; _Pragma("unroll") for (int i = 0; i < KCH; ++i) kr[i] = *(const u32x4*)(kg + i * 8); } while (0)
#define V_LOADG(itv) do { const bf16_t* vg = vgp + A_TILE(itv) * 64; _Pragma("unroll") for (int i = 0; i < VCH; ++i) vr[i] = *(const u32x4*)(vg + i * 8); } while (0)
#define K_WRITE(bo) do { _Pragma("unroll") for (int i = 0; i < KCH; ++i) *(u32x4*)(ksp + (bo) + i * 8) = kr[i]; } while (0)
#define V_WRITE(bo) do { _Pragma("unroll") for (int i = 0; i < VCH; ++i) { const int c_ = (vcol >> 3) + i; bf16_t* d_ = vsp - vcol + (bo) + (c_ >> 1) * 16 + (c_ & 1) * 4; \
            *(u32x2*)d_ = (u32x2){vr[i][0], vr[i][1]}; *(u32x2*)(d_ + 8) = (u32x2){vr[i][2], vr[i][3]}; } } while (0)
#define T_ACTIVE(itv) (!(WIN && A_TILE(itv) >= 4 && ((A_TILE(itv) - 4) * 64 > qpos0 + wid * 32 + 31 + 128 || (A_TILE(itv) - 4) * 64 + 63 < qpos0 + wid * 32 - 128)))
#define S_MASK(S0, S1, itv) do { if (WIN && A_TILE(itv) >= 4) { const int qp = qpos0 + wid * 32 + r, kp0 = (A_TILE(itv) - 4) * 64 + 4 * h2; \
        _Pragma("unroll") for (int i = 0; i < 16; ++i) { const int d0 = kp0 + (i & 3) + 8 * (i >> 2) - qp, d1 = d0 + 32; \
            if (d0 > 128 || d0 < -128) S0[i] = -1e30f; if (d1 > 128 || d1 < -128) S1[i] = -1e30f; } } } while (0)
    f32x16 s0, s1;
    __syncthreads();
    K_LOAD(0); K_WRITE(0);
    if (1 < ntot) K_LOAD(1);
    V_LOADG(0);
    __syncthreads();
#pragma unroll
    for (int i = 0; i < 16; ++i) { s0[i] = -mref; s1[i] = -mref; }
#pragma unroll 1
    for (int it = -1; it < ntot; ++it) {
        const int kb_n = ((it + 1) & 1) * KBUF, vb_c = (it & 1) * VBUF;
        if (it + 2 < ntot) K_WRITE((it & 1) * KBUF);
        if (it + 1 < ntot) V_WRITE(((it + 1) & 1) * VBUF);
        __builtin_amdgcn_sched_barrier(0);
        const bool act_c = (it >= 0) && T_ACTIVE(it), act_n = (it + 1 < ntot) && T_ACTIVE(it + 1);
        f32x16 n0, n1;
#pragma unroll
        for (int i = 0; i < 16; ++i) { n0[i] = -mref; n1[i] = -mref; }
        float rs = 0.f;
        unsigned pk[16];
#define P_PAIR(j) do { const float e0_ = __builtin_amdgcn_exp2f((j) < 8 ? s0[2 * ((j) & 7)] : s1[2 * ((j) & 7)]), e1_ = __builtin_amdgcn_exp2f((j) < 8 ? s0[2 * ((j) & 7) + 1] : s1[2 * ((j) & 7) + 1]); rs += e0_ + e1_; pk[j] = pk2(e0_, e1_); } while (0)
        if (act_c && act_n) {
#pragma unroll
            for (int g = 0; g < NG; ++g) {
                const bf16x8 ka = *(const bf16x8*)(kfp + kb_n + 16 * g), kb = *(const bf16x8*)(kfp + kb_n + 32 * KSTR + 16 * g);
                n0 = __builtin_amdgcn_mfma_f32_32x32x16_bf16(ka, qf[g], n0, 0, 0, 0);
                n1 = __builtin_amdgcn_mfma_f32_32x32x16_bf16(kb, qf[g], n1, 0, 0, 0);
#pragma unroll
                for (int j = (16 * g) / NG; j < (16 * (g + 1)) / NG; ++j) P_PAIR(j);
            }
            S_MASK(n0, n1, it + 1);
        } else {
            if (act_n) {
#pragma unroll
                for (int ks = 0; ks < NKS; ++ks) { const bf16x8 k0 = *(const bf16x8*)(kfp + kb_n + 16 * ks), k1 = *(const bf16x8*)(kfp + kb_n + 32 * KSTR + 16 * ks);
                    n0 = __builtin_amdgcn_mfma_f32_32x32x16_bf16(k0, qf[ks], n0, 0, 0, 0); n1 = __builtin_amdgcn_mfma_f32_32x32x16_bf16(k1, qf[ks], n1, 0, 0, 0); }
                S_MASK(n0, n1, it + 1);
            }
            if (act_c) {
#pragma unroll
                for (int j = 0; j < 16; ++j) P_PAIR(j);
            }
        }
#undef P_PAIR
        __builtin_amdgcn_sched_barrier(0);
        if (it + 3 < ntot) K_LOAD(it + 3);
        if (it + 2 < ntot) V_LOADG(it + 2);
        __builtin_amdgcn_sched_barrier(0);
        if (act_c) {
            lrun += rs;
#pragma unroll
            for (int q = 0; q < 4; ++q) {
                const u32x4 pw = {pk[4 * q], pk[4 * q + 1], pk[4 * q + 2], pk[4 * q + 3]};
                const bf16x8 pf = __builtin_bit_cast(bf16x8, pw);
#pragma unroll
                for (int dt = 0; dt < NDT; ++dt) { const bf16x8 vf = *(const bf16x8*)(vfp + vb_c + (32 * dt) * VSTR + 16 * q);
                    o[dt] = __builtin_amdgcn_mfma_f32_32x32x16_bf16(vf, pf, o[dt], 0, 0, 0); }
            }
        }
        s0 = n0; s1 = n1;
        __syncthreads();
    }
#undef A_TILE
#undef K_LOAD
#undef V_LOADG
#undef K_WRITE
#undef V_WRITE
#undef T_ACTIVE
#undef S_MASK
    lrun += __shfl_xor(lrun, 32);
    const float inv = 1.f / lrun;
    bf16_t* orow = O + (size_t)(wid * 32 + r) * ostride;
#pragma unroll
    for (int dt = 0; dt < NDT; ++dt)
#pragma unroll
        for (int g = 0; g < 4; ++g)
            *(u32x2*)(orow + 32 * dt + 8 * g + 4 * h2) = (u32x2){pk2(o[dt][4 * g] * inv, o[dt][4 * g + 1] * inv), pk2(o[dt][4 * g + 2] * inv, o[dt][4 * g + 3] * inv)};
    __syncthreads();
}

template <int NH>
DI void win_attn_item(char* lds, const bf16_t* Q, const bf16_t* Kb, const bf16_t* VTb, int tb0, int tb1, float mref, const float* sinkp, bf16_t* O, int qpos0) {
    constexpr int KSTR = 72, VSTR = 72, KBUF = 64 * KSTR, VBUF = 64 * VSTR;
    bf16_t* Ks = (bf16_t*)lds; bf16_t* Vs = Ks + 2 * KBUF;
    const int tid = get_tid(), lane = tid & 63, wid = tid >> 6, r = lane & 31, h2 = lane >> 5;
    bf16x8 qf[NH][4];
#pragma unroll
    for (int h = 0; h < NH; ++h) { const bf16_t* qrow = Q + (size_t)(wid * 32 + r) * 1024 + h * 64 + 8 * h2;
#pragma unroll
        for (int ks = 0; ks < 4; ++ks) qf[h][ks] = *(const bf16x8*)(qrow + 16 * ks); }
    f32x16 o[NH][2]; float lrun[NH];
#pragma unroll
    for (int h = 0; h < NH; ++h) { lrun[h] = (h2 == 0) ? __builtin_amdgcn_exp2f(sinkp[h] * LOG2E - mref) : 0.f;
#pragma unroll
        for (int dt = 0; dt < 2; ++dt)
#pragma unroll
            for (int i = 0; i < 16; ++i) o[h][dt][i] = 0.f; }
    const int na = 4, ntot = na + (tb1 - tb0);
    u32x4 kr, vr;
    const int krow = tid >> 3, kcol = (tid & 7) * 8;
    const bf16_t* kgp = Kb + (size_t)krow * 64 + kcol;
    const bf16_t* vgp = VTb + (size_t)krow * TK + kcol;
    bf16_t* ksp = Ks + krow * KSTR + kcol;
    bf16_t* vsp = Vs + krow * VSTR + (kcol >> 4) * 16 + ((kcol >> 3) & 1) * 4;
    const bf16_t* kfp = Ks + r * KSTR + 8 * h2;
    const bf16_t* vfp = Vs + r * VSTR + 8 * h2;
#define W_TILE(itv) (((itv) < na) ? (itv) : tb0 + ((itv) - na))
#define W_LOAD(itv) do { kr = *(const u32x4*)(kgp + (size_t)W_TILE(itv) * 64 * 64); vr = *(const u32x4*)(vgp + W_TILE(itv) * 64); } while (0)
#define W_WRITE(kb_, vb_) do { *(u32x4*)(ksp + (kb_)) = kr; *(u32x2*)(vsp + (vb_)) = (u32x2){vr[0], vr[1]}; *(u32x2*)(vsp + (vb_) + 8) = (u32x2){vr[2], vr[3]}; } while (0)
    __syncthreads();
    W_LOAD(0); W_WRITE(0, 0);
    if (1 < ntot) W_LOAD(1);
    __syncthreads();
#pragma unroll 1
    for (int it = 0; it < ntot; ++it) {
        const int T = W_TILE(it);
        const int kb = (it & 1) * KBUF, vb = (it & 1) * VBUF;
        if (it + 1 < ntot) W_WRITE(KBUF - kb, VBUF - vb);
        if (it + 2 < ntot) W_LOAD(it + 2);
        bool active = true, need_mask = false;
        if (T >= 4) { const int klo = (T - 4) * 64, qlo = qpos0 + wid * 32;
            active = !(klo > qlo + 31 + 128 || klo + 63 < qlo - 128);
            need_mask = (klo < qlo + 31 - 128) || (klo + 63 > qlo + 128); }
        if (active) {
#pragma unroll
            for (int h = 0; h < NH; ++h) {
                __builtin_amdgcn_sched_barrier(0);
                f32x16 s0, s1;
#pragma unroll
                for (int i = 0; i < 16; ++i) { s0[i] = -mref; s1[i] = -mref; }
#pragma unroll
                for (int ks = 0; ks < 4; ++ks) { const bf16x8 k0 = *(const bf16x8*)(kfp + kb + 16 * ks), k1 = *(const bf16x8*)(kfp + kb + 32 * KSTR + 16 * ks);
                    s0 = __builtin_amdgcn_mfma_f32_32x32x16_bf16(k0, qf[h][ks], s0, 0, 0, 0); s1 = __builtin_amdgcn_mfma_f32_32x32x16_bf16(k1, qf[h][ks], s1, 0, 0, 0); }
                if (need_mask) { const int qp = qpos0 + wid * 32 + r, kp0 = (T - 4) * 64 + 4 * h2;
#pragma unroll
                    for (int i = 0; i < 16; ++i) { const int d0 = kp0 + (i & 3) + 8 * (i >> 2) - qp, d1 = d0 + 32;
                        if (d0 > 128 || d0 < -128) s0[i] = -1e30f; if (d1 > 128 || d1 < -128) s1[i] = -1e30f; } }
                float rs = 0.f; unsigned pk[16];
#pragma unroll
                for (int j = 0; j < 8; ++j) { const float a0 = __builtin_amdgcn_exp2f(s0[2 * j]), a1 = __builtin_amdgcn_exp2f(s0[2 * j + 1]), b0 = __builtin_amdgcn_exp2f(s1[2 * j]), b1 = __builtin_amdgcn_exp2f(s1[2 * j + 1]);
                    rs += (a0 + a1) + (b0 + b1); pk[j] = pk2(a0, a1); pk[8 + j] = pk2(b0, b1); }
                lrun[h] += rs;
                __builtin_amdgcn_sched_barrier(0);
#pragma unroll
                for (int q = 0; q < 4; ++q) { const u32x4 pw = {pk[4 * q], pk[4 * q + 1], pk[4 * q + 2], pk[4 * q + 3]}; const bf16x8 pf = __builtin_bit_cast(bf16x8, pw);
#pragma unroll
                    for (int dt = 0; dt < 2; ++dt) { const bf16x8 vf = *(const bf16x8*)(vfp + vb + (32 * dt) * VSTR + 16 * q);
                        o[h][dt] = __builtin_amdgcn_mfma_f32_32x32x16_bf16(vf, pf, o[h][dt], 0, 0, 0); } }
            }
        }
        __syncthreads();
    }
#undef W_TILE
#undef W_LOAD
#undef W_WRITE
#pragma unroll
    for (int h = 0; h < NH; ++h) { float l = lrun[h]; l += __shfl_xor(l, 32); const float inv = 1.f / l;
        bf16_t* orow = O + (size_t)(wid * 32 + r) * 1024 + h * 64;
#pragma unroll
        for (int dt = 0; dt < 2; ++dt)
#pragma unroll
            for (int g = 0; g < 4; ++g)
                *(u32x2*)(orow + 32 * dt + 8 * g + 4 * h2) = (u32x2){pk2(o[h][dt][4 * g] * inv, o[h][dt][4 * g + 1] * inv), pk2(o[h][dt][4 * g + 2] * inv, o[h][dt][4 * g + 3] * inv)}; }
    __syncthreads();
}

DI void s5_kk_phase(char* lds, const Params& p) {
    const int tid512 = get_tid(); const int tid = tid512 & 255, s = tid >> 4, sp = tid & 15, dh = tid512 >> 8;
    f32x2* sbb = (f32x2*)lds;
    f32x2* scc = sbb + 1024;
    f32x2* spw = scc + 1024;
    const f32x2* POW = (const f32x2*)(p.ws + H_POW); const f32x2* BB = (const f32x2*)(p.ws + T_BBAR); float* KK = (float*)(p.ws + H_KK);
    for (int it = blockIdx.x; it < 32 * 2 * 4; it += gridDim.x) {
        const int dq = it & 3, dir = (it >> 2) & 1, g = it >> 3; const int dg = dir * 32 + g;
        __syncthreads();
        for (int i = tid512; i < 1024; i += NTHREADS) { sbb[i] = BB[(size_t)dg * 1024 + i]; scc[i] = (f32x2){p.in[18][(size_t)dg * 1024 + i], p.in[19][(size_t)dg * 1024 + i]}; }
        { const int i = tid512; spw[i] = POW[((size_t)dg * 33 + dq * 8 + (i >> 6)) * 64 + (i & 63)]; }
        __syncthreads();
        float acc[4] = {0.f, 0.f, 0.f, 0.f};
#pragma unroll 4
        for (int pp = 0; pp < 64; ++pp) { const f32x2 bb = sbb[pp * 16 + sp], cc = scc[s * 64 + pp];
#pragma unroll
            for (int q = 0; q < 4; ++q) { const f32x2 pw = spw[(dh * 4 + q) * 64 + pp];
                const float zr = pw[0] * bb[0] - pw[1] * bb[1], zi = pw[0] * bb[1] + pw[1] * bb[0];
                acc[q] += cc[0] * zr - cc[1] * zi; } }
#pragma unroll
        for (int q = 0; q < 4; ++q) KK[(size_t)((g * 2 + dir) * 32 + dq * 8 + dh * 4 + q) * 256 + tid] = acc[q];
    }
    __syncthreads();
}
DI void s5_w1a_phase(const Params& p) {
    const int tid = get_tid();
    const f32x2* POW = (const f32x2*)(p.ws + H_POW); const f32x2* BB = (const f32x2*)(p.ws + T_BBAR); bf16_t* W = (bf16_t*)(p.ws + H_W1A);
    for (int idx = blockIdx.x * NTHREADS + tid; idx < 2048 * 256; idx += gridDim.x * NTHREADS) {
        const int kq = idx & 63, n = (idx >> 6) & 255, g = idx >> 14;
        const int dir = n >> 7, ri = (n >> 6) & 1, pp = n & 63; const int e = (dir * 32 + g) * 64 + pp; const int tl = kq >> 1, s0 = (kq & 1) * 8;
        const f32x2 pw = POW[((size_t)(dir * 32 + g) * 33 + (dir ? tl : 31 - tl)) * 64 + pp];
        float v[8];
#pragma unroll
        for (int j = 0; j < 8; ++j) { const f32x2 bb = BB[e * 16 + s0 + j]; v[j] = ri ? pw[0] * bb[1] + pw[1] * bb[0] : pw[0] * bb[0] - pw[1] * bb[1]; }
        *(u32x4*)(W + ((size_t)g * 256 + n) * 512 + kq * 8) = (u32x4){pk2(v[0], v[1]), pk2(v[2], v[3]), pk2(v[4], v[5]), pk2(v[6], v[7])};
    }
}
DI void s5_w1b_phase(const Params& p) {
    const int tid = get_tid();
    const f32x2* __restrict__ POW = (const f32x2*)(p.ws + H_POW); const float* __restrict__ KK = (const float*)(p.ws + H_KK); bf16_t* __restrict__ W = (bf16_t*)(p.ws + A_W1B);
    const float* __restrict__ CRE = p.in[18]; const float* __restrict__ CIM = p.in[19]; const float* __restrict__ DSK = p.in[20];
#pragma unroll 2
    for (int idx = blockIdx.x * NTHREADS + tid; idx < 32 * 512 * 64; idx += gridDim.x * NTHREADS) {
        const int kq = idx & 63, n = (idx >> 6) & 511, g = idx >> 15;
        const int tl = n >> 4, s = n & 15, tl2 = kq >> 1, s0 = (kq & 1) * 8;
        const int d0 = tl - tl2, d1 = tl2 - tl;
        const float* k0 = KK + (size_t)((g * 2 + 0) * 32 + (d0 < 0 ? 0 : d0)) * 256 + s * 16 + s0;
        const float* k1 = KK + (size_t)((g * 2 + 1) * 32 + (d1 < 0 ? 0 : d1)) * 256 + s * 16 + s0;
        const f32x4 a0 = *(const f32x4*)k0, a1 = *(const f32x4*)(k0 + 4), b0 = *(const f32x4*)k1, b1 = *(const f32x4*)(k1 + 4);
        const float w0 = d0 >= 0 ? 1.f : 0.f, w1 = d1 >= 0 ? 1.f : 0.f;
        f32x4 x0 = a0 * w0 + b0 * w1, x1 = a1 * w0 + b1 * w1;
        if (tl2 == tl && (s >> 3) == (kq & 1)) { const float dv = DSK[g * 16 + s];
#pragma unroll
            for (int j = 0; j < 4; ++j) { if (j == (s & 7)) x0[j] += dv; if (4 + j == (s & 7)) x1[j] += dv; } }
        *(u32x4*)(W + ((size_t)g * 512 + n) * 768 + kq * 8) = (u32x4){pk2(x0[0], x0[1]), pk2(x0[2], x0[3]), pk2(x1[0], x1[1]), pk2(x1[2], x1[3])};
    }
#pragma unroll 2
    for (int idx = blockIdx.x * NTHREADS + tid; idx < 32 * 512 * 32; idx += gridDim.x * NTHREADS) {
        const int kb = idx & 31, n = (idx >> 5) & 511, g = idx >> 14;
        const int tl = n >> 4, s = n & 15, k2 = kb * 8; const int dir = k2 >> 7, ri = (k2 >> 6) & 1, p0 = k2 & 63;
        const float* cre = CRE + ((size_t)(dir * 32 + g) * 16 + s) * 64 + p0; const float* cim = CIM + ((size_t)(dir * 32 + g) * 16 + s) * 64 + p0;
        const f32x2* pwp = POW + ((size_t)(dir * 32 + g) * 33 + (dir ? 32 - tl : tl + 1)) * 64 + p0;
        const f32x4 cr0 = *(const f32x4*)cre, cr1 = *(const f32x4*)(cre + 4), ci0 = *(const f32x4*)cim, ci1 = *(const f32x4*)(cim + 4);
        const f32x4 pa = *(const f32x4*)pwp, pb = *(const f32x4*)(pwp + 2), pc = *(const f32x4*)(pwp + 4), pd = *(const f32x4*)(pwp + 6);
        float v[8];
        const float pr[8] = {pa[0], pa[2], pb[0], pb[2], pc[0], pc[2], pd[0], pd[2]}, pi[8] = {pa[1], pa[3], pb[1], pb[3], pc[1], pc[3], pd[1], pd[3]};
#pragma unroll
        for (int j = 0; j < 8; ++j) { const float cr = j < 4 ? cr0[j & 3] : cr1[j & 3], ci = j < 4 ? ci0[j & 3] : ci1[j & 3];
            v[j] = ri ? -(cr * pi[j] + ci * pr[j]) : cr * pr[j] - ci * pi[j]; }
        *(u32x4*)(W + ((size_t)g * 512 + n) * 768 + 512 + kb * 8) = (u32x4){pk2(v[0], v[1]), pk2(v[2], v[3]), pk2(v[4], v[5]), pk2(v[6], v[7])};
    }
}
DI void s5_carry_phase(const Params& p) {
    const int tid_ = get_tid(); const int lane = tid_ & 63, wid = tid_ >> 6;
    const f32x2* POW = (const f32x2*)(p.ws + H_POW); const float* E = (const float*)(p.ws + H_E); bf16_t* UA = (bf16_t*)(p.ws + H_UA);
    for (int it = ((int)gridDim.x - 1 - (int)blockIdx.x) * NWV + wid; it < 2 * 2 * 32; it += gridDim.x * NWV) {
        const int g = it & 31, dir = (it >> 5) & 1, b = it >> 6;
        const f32x2 l32 = POW[((size_t)(dir * 32 + g) * 33 + 32) * 64 + lane];
        float hr = 0.f, hi = 0.f;
        float er[8], ei[8], fr_[8], fi_[8];
#define C_IDX(i_) ((size_t)g * CHR + b * NCK + (dir ? ((i_) < 8 ? 7 - (i_) : NCK - 1 - ((i_) - 8)) : (i_)))
#define C_LOAD(R, I, i0_) do { _Pragma("unroll") for (int j = 0; j < 8; ++j) { const size_t m = C_IDX((i0_) + j); R[j] = E[m * 256 + dir * 128 + lane]; I[j] = E[m * 256 + dir * 128 + 64 + lane]; } } while (0)
#define C_STEP(R, I, i0_) do { _Pragma("unroll") for (int j = 0; j < 8; ++j) { const size_t m = C_IDX((i0_) + j); bf16_t* u = UA + m * 768 + 512 + dir * 128 + lane; \
            u[0] = (bf16_t)(pk2(hr, 0.f) & 0xffff); u[64] = (bf16_t)(pk2(hi, 0.f) & 0xffff); \
            const float nr = l32[0] * hr - l32[1] * hi + R[j], ni = l32[0] * hi + l32[1] * hr + I[j]; hr = nr; hi = ni; } } while (0)
        C_LOAD(er, ei, 0);
        for (int i0 = 0; i0 < NCK; i0 += 16) {
            if (i0 + 8 < NCK) C_LOAD(fr_, fi_, i0 + 8);
            C_STEP(er, ei, i0);
            if (i0 + 8 < NCK) { if (i0 + 16 < NCK) C_LOAD(er, ei, i0 + 16); C_STEP(fr_, fi_, i0 + 8); }
        }
#undef C_IDX
#undef C_LOAD
#undef C_STEP
    }
}

DI float rope64(float x, int lane, const float* ROPE, int rpos, int cpos) {
    const float partner = __shfl_xor(x, 16);
    const int i = lane & 15; const int pos = lane < 32 ? rpos : cpos;
    const float c = ROPE[(pos * 16 + i) * 2], s = ROPE[(pos * 16 + i) * 2 + 1];
    return (lane & 16) ? x * c + partner * s : x * c - partner * s;
}
DI void mla_prep_phase(const Params& p) {
    const int tid_ = get_tid(); const int lane = tid_ & 63, wid = tid_ >> 6;
    bf16_t* QR = (bf16_t*)(p.ws + S_QRAW); const bf16_t* KN = (const bf16_t*)(p.ws + S_KNOPE); const float* KR = (const float*)(p.ws + H_KR);
    bf16_t* KA = (bf16_t*)(p.ws + S_KA); const float* ROPE = (const float*)(p.ws + T_ROPE);
    const float qsc = 0.07216878364870323f * LOG2E;
    const float qg0 = p.in[27][lane], qg1 = p.in[27][64 + lane], qg2 = p.in[27][128 + lane];
    const float kg0 = p.in[28][lane], kg1 = p.in[28][64 + lane], kg2 = p.in[28][128 + lane];
    const int nbusy = (int)gridDim.x < 192 ? (int)gridDim.x : 192, nslots = nbusy + 3 * ((int)gridDim.x - nbusy);
    const int vb_ = virt_block();
    const int myslots = vb_ < nbusy ? 1 : 3, slot0 = vb_ < nbusy ? vb_ : nbusy + 3 * (vb_ - nbusy);
    for (int sj = 0; sj < myslots; ++sj)
    for (int r = (slot0 + sj) * NWV + wid; r < NR; r += nslots * NWV) {
        const bool lat = r >= NCTX; const int b = row_batch(r), tp = row_tpos(r); const int t = tp - CTX;
        const bf16_t* q = QR + (size_t)r * 768; const bf16_t* kn = KN + (size_t)r * 512;
        float x[4][3], k[4][3];
        const float krv = KR[(size_t)r * 64 + lane];
#pragma unroll
        for (int h = 0; h < 4; ++h) { x[h][0] = bf2f(q[h * 192 + lane]); x[h][1] = bf2f(q[h * 192 + 64 + lane]); x[h][2] = bf2f(q[h * 192 + 128 + lane]);
            k[h][0] = bf2f(kn[h * 128 + lane]); k[h][1] = bf2f(kn[h * 128 + 64 + lane]); k[h][2] = krv; }
        float rc = 1.f, rsn = 0.f;
        if (lat) { const int pos = lane < 32 ? (t >> 6) : (t & 63); rc = ROPE[(pos * 16 + (lane & 15)) * 2]; rsn = ROPE[(pos * 16 + (lane & 15)) * 2 + 1]; }
        const float sgn = (lane & 16) ? 1.f : -1.f;
#pragma unroll
        for (int h = 0; h < 4; ++h) {
            float ss = wave_sum(x[h][0] * x[h][0] + x[h][1] * x[h][1] + x[h][2] * x[h][2]);
            float rs = rsqrtf(ss * (1.f / 192.f) + 1e-6f) * qsc;
            const float x0 = x[h][0] * rs * qg0, x1 = x[h][1] * rs * qg1; float x2 = x[h][2] * rs * qg2;
            x2 = x2 * rc + sgn * __shfl_xor(x2, 16) * rsn;
            bf16_t* qd = QR + (size_t)r * 768 + h * 192;
            qd[lane] = (bf16_t)(pk2(x0, 0.f) & 0xffff); qd[64 + lane] = (bf16_t)(pk2(x1, 0.f) & 0xffff); qd[128 + lane] = (bf16_t)(pk2(x2, 0.f) & 0xffff);
            ss = wave_sum(k[h][0] * k[h][0] + k[h][1] * k[h][1] + k[h][2] * k[h][2]);
            rs = rsqrtf(ss * (1.f / 192.f) + 1e-6f);
            const float k0 = k[h][0] * rs * kg0, k1 = k[h][1] * rs * kg1; float k2 = k[h][2] * rs * kg2;
            k2 = k2 * rc + sgn * __shfl_xor(k2, 16) * rsn;
            bf16_t* kd = KA + ((size_t)(b * 4 + h) * TK + tp) * 192;
            kd[lane] = (bf16_t)(pk2(k0, 0.f) & 0xffff); kd[64 + lane] = (bf16_t)(pk2(k1, 0.f) & 0xffff); kd[128 + lane] = (bf16_t)(pk2(k2, 0.f) & 0xffff);
        }
    }
}

__global__ void __launch_bounds__(NTHREADS, 2) fwd_kernel(Params p) {
    extern __shared__ __attribute__((aligned(16))) char lds[];
    cg::grid_group grid = cg::this_grid();
    char* ws = p.ws;
    const bf16_t* WB = (const bf16_t*)ws;
    const float* MOD = (const float*)(ws + T_MOD);
    float* H = (float*)(ws + OFF_H);
    bf16_t* Hb = (bf16_t*)(ws + OFF_H);
    bf16_t* A0 = (bf16_t*)(ws + OFF_A0);
    const int bid = blockIdx.x, nb = gridDim.x;
    const int vbid = virt_block();
    volatile LAS unsigned* xst = (volatile LAS unsigned*)(lds + (LDS_BYTES - 16));
    if (threadIdx.x == 0) { xst[0] = 0u; xst[1] = 0u; }
    __syncthreads();
    const XcdBarrier xb = xcd_barrier_post((unsigned*)(ws + T_BAR), xst);
    if (p.pad == 0x7fffffff) grid.sync();
#define GRID_SYNC() xcd_barrier(xb)

    { const int npair = p.jobs[4].tile0 >> 1, nit = 192 + 12 + npair;
      for (int it = bid; it < nit; it += nb) {
          if (it < 192) ada_item(lds, p, it);
          else if (it < 204) tables_item(p, it - 192);
          else { const int lt0 = (it - 204) * 2 + (int)(threadIdx.x >> 8); const bool live = lt0 < p.jobs[4].tile0; const int lt = live ? lt0 : 0; int j = 0;
#pragma unroll
              for (int q = 1; q < 11; ++q) if (lt >= p.jobs[q].tile0) j = q;
              transpose_tile(lds, ws, p.jobs[j], lt - p.jobs[j].tile0, live); } } }
    GRID_SYNC();
    modulate_rows(p, 0, 0, true, 0);
    s5_kk_phase(lds, p);
    GRID_SYNC();
    { EpiWin0 e{(bf16_t*)(ws + H_UA), (bf16_t*)(ws + S_CQN), (bf16_t*)(ws + S_CKVN), (float*)(ws + S_SSP), (float*)(ws + H_KR)};
      pg8::EpiHead<EpiWin0> pe{e}; pg8::gemm_phase((LAS unsigned char*)lds, pg8::Gemm{A0, WB + W_IN0, 1024, 1024}, pg8::Order{0, NR / 256, 5, (int)nb, vbid}, pe); }
    s5_w1a_phase(p);
    { int rk, nrk; slack_rank((NR / 256) * 5, rk, nrk); transpose_range(lds, ws, p, p.jobs[4].tile0, p.jobs[7].tile0, rk, nrk); }
    GRID_SYNC();
    s5_w1b_phase(p);
    { EpiS1a e{(float*)(ws + H_E)};
      (void)e; pg8::EpiS1a pe{(float*)(ws + H_E)}; pg8::gemm_phase((LAS unsigned char*)lds, pg8::Gemm{(const bf16_t*)(ws + H_UA), (const bf16_t*)(ws + H_W1A), 768, 512, (size_t)CHR * 768, (size_t)256 * 512}, pg8::Order{0, 3, 1, (int)nb, vbid, 32}, pe); }
    { int rk, nrk; slack_rank(96, rk, nrk); transpose_range(lds, ws, p, p.jobs[7].tile0, p.jobs[9].tile0, rk, nrk); }
    GRID_SYNC();
    s5_carry_phase(p);
    { EpiBf16 e{(bf16_t*)(ws + S_QRAW), 768, (const float*)(ws + S_SSP)};
      gemm_phase(lds, (const bf16_t*)(ws + S_CQN), 384, WB + W_QB, 384, 0, NR / 256, 3, e); }
    { EpiKV e{(bf16_t*)(ws + S_KNOPE), (bf16_t*)(ws + S_VT), (const float*)(ws + S_SSP)};
      gemm_phase(lds, (const bf16_t*)(ws + S_CKVN), 256, WB + W_KVB, 256, 0, NR / 256, 4, e, 1, 0, 0, 1, nb > 64 ? (int)nb - 16 : 0); }
    GRID_SYNC();
    { EpiS1b e{(bf16_t*)(ws + S_YG)};
      (void)e; pg8::EpiS1b pe{(bf16_t*)(ws + S_YG)}; pg8::gemm_phase((LAS unsigned char*)lds, pg8::Gemm{(const bf16_t*)(ws + H_UA), (const bf16_t*)(ws + A_W1B), 768, 768, (size_t)CHR * 768, (size_t)512 * 768}, pg8::Order{0, 3, 2, (int)nb, vbid, 32}, pe); }
    mla_prep_phase(p);
    GRID_SYNC();
    { const bf16_t* QR = (const bf16_t*)(ws + S_QRAW); const bf16_t* KA = (const bf16_t*)(ws + S_KA); const bf16_t* VT = (const bf16_t*)(ws + S_VT);
      const int nlat = 2 * 4 * 32, nall = nlat + 2 * 4;
      float mref; { float gq = 0.f, gk = 0.f;
        for (int d_ = 0; d_ < 192; ++d_) { gq = fmaxf(gq, fabsf(p.in[27][d_])); gk = fmaxf(gk, fabsf(p.in[28][d_])); }
        mref = 13.856406f * LOG2E * 1.02f * gq * gk; }
      for (int it0 = bid; it0 < nlat + nb; it0 += nb) {
          const int it = it0 < nlat ? it0 : nlat + (it0 - nlat) - (nb - 8);
          if (it0 >= nlat && (it < nlat || it >= nall)) continue;
          if (it < nlat) { const int h = it & 3, b = (it >> 2) & 1, qb = it >> 3;   const size_t row = NCTX + (size_t)b * SEQ + qb * 256;
              attn_item<192, 128, false>(lds, QR + row * 768 + h * 192, 768, KA + (size_t)(b * 4 + h) * TK * 192, VT + (size_t)(b * 4 + h) * 128 * TK, 0, TK / 64, 0, 0, mref, 0.f,
                                         A0 + row * 1024 + 512 + h * 128, 1024, 0); }
          else { const int j = it - nlat; const int h = j & 3, b = j >> 2; const size_t row = (size_t)b * CTX;
              attn_item<192, 128, false>(lds, QR + row * 768 + h * 192, 768, KA + (size_t)(b * 4 + h) * TK * 192, VT + (size_t)(b * 4 + h) * 128 * TK, 0, 4, 0, 0, mref, 0.f,
                                         A0 + row * 1024 + 512 + h * 128, 1024, 0); } }
      EpiGLU e{(const bf16_t*)(ws + S_YG), p.in[22], A0};
      gemm_phase(lds, (const bf16_t*)(ws + S_YG), 512, WB + W_GLU, 512, 0, NR / 256, 2, e); }
    GRID_SYNC();
    { EpiRes e{p.in[2], p.in[0], H, H + (size_t)NCTX * 1024, MOD + 0 * 3 * 6144 + 2048, 0};
      (void)e; { pg8::EpiRes pe{p.in[0], nullptr, Hb + (size_t)NCTX * 1024, nullptr, MOD + 0 * 3 * 6144 + 2048}; pg8::gemm_phase((LAS unsigned char*)lds, pg8::Gemm{A0, WB + W_OUT0, 1024, 1024}, pg8::Order{2, NLAT / 256, 4, (int)nb, vbid}, pe); }
      thin_gemm_ctx<4>(lds, A0, 1024, WB + W_OUT0, 1024, p.in[2], nullptr, Hb, MOD + 0 * 3 * 6144 + 2048); }
    GRID_SYNC();
    modulate_rows(p, 0, 1, false, 0);
    GRID_SYNC();
    { EpiSwiGLU e{(bf16_t*)(ws + S_HID)};
      (void)e; pg8::EpiSwiGLU pe{(bf16_t*)(ws + S_HID)}; pg8::gemm_phase((LAS unsigned char*)lds, pg8::Gemm{A0, WB + W_GU0, 1024, 1024}, pg8::Order{0, NR / 256, 22, (int)nb, vbid}, pe); }
    { int rk, nrk; slack_rank((NR / 256) * 22, rk, nrk); transpose_range(lds, ws, p, p.jobs[9].tile0, p.jobs[9].tile0 + 704, rk, nrk); }
    GRID_SYNC();
    { EpiRes e{H, H + (size_t)NCTX * 1024, H, H + (size_t)NCTX * 1024, MOD + 0 * 3 * 6144 + 5120, 0};
      (void)e; { pg8::EpiRes pe{nullptr, Hb + (size_t)NCTX * 1024, Hb + (size_t)NCTX * 1024, nullptr, MOD + 0 * 3 * 6144 + 5120}; pg8::gemm_phase((LAS unsigned char*)lds, pg8::Gemm{(const bf16_t*)(ws + S_HID), WB + W_D0, FH, FH}, pg8::Order{2, NLAT / 256, 4, (int)nb, vbid}, pe); }
      thin_gemm_ctx<11>(lds, (const bf16_t*)(ws + S_HID), FH, WB + W_D0, FH, nullptr, Hb, Hb, MOD + 0 * 3 * 6144 + 5120); }
    GRID_SYNC();
    modulate_rows(p, 1, 0, false, 0);
    GRID_SYNC();
    { EpiWin1 e{(bf16_t*)(ws + S1_Q), (bf16_t*)(ws + S1_K), (bf16_t*)(ws + S1_VT), p.in[31], p.in[32], (const float*)(ws + T_ROPE)};
      pg8::EpiHead<EpiWin1> pe{e}; pg8::gemm_phase((LAS unsigned char*)lds, pg8::Gemm{A0, WB + W_IN1, 1024, 1024}, pg8::Order{0, NR / 256, 6, (int)nb, vbid}, pe); }
    { int rk, nrk; slack_rank((NR / 256) * 6, rk, nrk); transpose_range(lds, ws, p, p.jobs[9].tile0 + 704, p.njobtiles, rk, nrk); }
    GRID_SYNC();
    { const bf16_t* Q = (const bf16_t*)(ws + S1_Q); const bf16_t* K1 = (const bf16_t*)(ws + S1_K); const bf16_t* VT = (const bf16_t*)(ws + S1_VT);
      constexpr int WNH = 2;
      const int nit = 2 * 4 * (4 / WNH) * 32;
      float mref; { float gq = 0.f, gk = 0.f;
        for (int d_ = 0; d_ < 64; ++d_) { gq = fmaxf(gq, fabsf(p.in[31][d_])); gk = fmaxf(gk, fabsf(p.in[32][d_])); }
        mref = 8.f * LOG2E * 1.02f * gq * gk; }
      for (int it = bid; it < nit; it += nb) { const int kvh = it & 3, b = (it >> 2) & 1, rest = it >> 3; const int gp = rest % (4 / WNH), i = rest / (4 / WNH); const int hq0 = kvh * 4 + gp * WNH;
          const size_t row = NCTX + (size_t)b * SEQ + i * 256;
          const int l0 = (4 * i - 2) < 0 ? 0 : (4 * i - 2), l1 = (4 * i + 6) > 128 ? 128 : (4 * i + 6);
          win_attn_item<WNH>(lds, Q + row * 1024 + hq0 * 64, K1 + (size_t)(b * 4 + kvh) * TK * 64, VT + (size_t)(b * 4 + kvh) * 64 * TK, 4 + l0, 4 + l1, mref, p.in[33] + hq0, A0 + row * 1024 + hq0 * 64, i * 256); } }
    GRID_SYNC();
    { EpiRes e{H, H + (size_t)NCTX * 1024, nullptr, H + (size_t)NCTX * 1024, MOD + 1 * 3 * 6144 + 2048, 0};
      (void)e; pg8::EpiRes pe{nullptr, Hb + (size_t)NCTX * 1024, Hb + (size_t)NCTX * 1024, nullptr, MOD + 1 * 3 * 6144 + 2048}; pg8::gemm_phase((LAS unsigned char*)lds, pg8::Gemm{A0, WB + W_OUT1, 1024, 1024}, pg8::Order{2, NLAT / 256, 4, (int)nb, vbid}, pe); }
    GRID_SYNC();
    modulate_rows(p, 1, 1, false, NCTX);
    GRID_SYNC();
    { EpiSwiGLU e{(bf16_t*)(ws + S_HID)};
      (void)e; pg8::EpiSwiGLU pe{(bf16_t*)(ws + S_HID)}; pg8::gemm_phase((LAS unsigned char*)lds, pg8::Gemm{A0, WB + W_GU1, 1024, 1024}, pg8::Order{2, NLAT / 256, 22, (int)nb, vbid}, pe); }
    GRID_SYNC();
    { EpiRes e{H, H + (size_t)NCTX * 1024, nullptr, p.out, MOD + 1 * 3 * 6144 + 5120, 0};
      (void)e; pg8::EpiRes pe{nullptr, Hb + (size_t)NCTX * 1024, nullptr, p.out, MOD + 1 * 3 * 6144 + 5120}; pg8::gemm_phase((LAS unsigned char*)lds, pg8::Gemm{(const bf16_t*)(ws + S_HID), WB + W_D1, FH, FH}, pg8::Order{2, NLAT / 256, 4, (int)nb, vbid}, pe); }
}

extern "C" void kernel_launch(void* const* d_in, const int* in_sizes, int n_in, void* d_out, int out_size, void* d_ws, size_t ws_size, hipStream_t stream) {
    static int grid_blocks = 0;
    if (grid_blocks == 0) {
        if (n_in != 34 || ws_size < WS_NEED2) { fprintf(stderr, "kernel_launch: unexpected n_in %d / ws %zu (need %zu)\n", n_in, ws_size, (size_t)WS_NEED2); grid_blocks = -1; return; }
        int dev = 0, cus = 0, per_cu = 0;
        (void)hipGetDevice(&dev);
        (void)hipDeviceGetAttribute(&cus, hipDeviceAttributeMultiprocessorCount, dev);
        (void)hipFuncSetAttribute((const void*)fwd_kernel, hipFuncAttributeMaxDynamicSharedMemorySize, LDS_BYTES);
        (void)hipOccupancyMaxActiveBlocksPerMultiprocessor(&per_cu, (const void*)fwd_kernel, NTHREADS, LDS_BYTES);
        if (per_cu < 1) { fprintf(stderr, "kernel_launch: occupancy query returned %d\n", per_cu); grid_blocks = -1; return; }
        if (per_cu > 1) per_cu = 1;
        grid_blocks = cus * per_cu;
        fprintf(stderr, "kernel_launch: grid %d (%d CUs x %d)\n", grid_blocks, cus, per_cu);
    }
    if (grid_blocks < 0) return;
    Params p{};
    for (int i = 0; i < 34; ++i) p.in[i] = (const float*)d_in[i];
    p.out = (float*)d_out; p.ws = (char*)d_ws;
    const float* fg = p.in[8]; const float* fu = p.in[9]; const float* fd = p.in[10];
    const size_t FW = (size_t)1024 * FH;
    int t0 = 0;
    auto mk = [&](int idx, const float* a, const float* b, size_t dst, int K, int ld, int npad, int mode) {
        Job& j = p.jobs[idx]; j.a = a; j.b = b; j.ks = nullptr; j.dst = dst; j.K = K; j.ld = ld; j.ntk = K / 64; j.ntn = npad / 64; j.tile0 = t0; j.mode = mode; t0 += j.ntk * j.ntn; };
    mk(0, p.in[11], nullptr, W_IN0, 1024, 1216, 1280, 2);
    mk(1, p.in[24], nullptr, W_QB, 384, 768, 768, 0);
    mk(2, p.in[26], nullptr, W_KVB, 256, 1024, 1024, 0);
    p.jobs[1].ks = p.in[23]; p.jobs[2].ks = p.in[25];
    mk(3, p.in[21], nullptr, W_GLU, 512, 512, 512, 0);
    mk(4, p.in[12], nullptr, W_OUT0, 1024, 1024, 1024, 0);
    mk(5, fg, fu, W_GU0, 1024, FH, 5632, 1);
    mk(6, fd, nullptr, W_D0, FH, 1024, 1024, 0);
    mk(7, p.in[29], nullptr, W_IN1, 1024, 1536, 1536, 2);
    mk(8, p.in[30], nullptr, W_OUT1, 1024, 1024, 1024, 0);
    mk(9, fg + FW, fu + FW, W_GU1, 1024, FH, 5632, 1);
    mk(10, fd + FW, nullptr, W_D1, FH, 1024, 1024, 0);
    p.njobtiles = t0;
    if (hipMemsetAsync((char*)d_ws + T_BAR, 0, XCD_BAR_WORDS * 4, stream) != hipSuccess) { fprintf(stderr, "kernel_launch: memset failed\n"); return; }
    void* args[] = {&p};
    hipError_t e = hipLaunchCooperativeKernel((const void*)fwd_kernel, dim3(grid_blocks), dim3(NTHREADS), args, LDS_BYTES, stream);
    if (e != hipSuccess) fprintf(stderr, "cooperative launch failed: %s (grid %d)\n", hipGetErrorString(e), grid_blocks);
}
```

```cpp
#include <hip/hip_runtime.h>
#include <hip/hip_cooperative_groups.h>
#include <cstdio>
#include <cstdint>
namespace cg = cooperative_groups;

#define DI __device__ __forceinline__
typedef unsigned short bf16_t;
typedef short bf16x8 __attribute__((ext_vector_type(8)));
typedef short s16x4 __attribute__((ext_vector_type(4)));
typedef float f32x4 __attribute__((ext_vector_type(4)));
typedef float f32x2 __attribute__((ext_vector_type(2)));
typedef float f32x16 __attribute__((ext_vector_type(16)));
typedef unsigned u32x4 __attribute__((ext_vector_type(4)));
typedef unsigned u32x2 __attribute__((ext_vector_type(2)));
typedef __bf16 bf16v2 __attribute__((ext_vector_type(2)));

constexpr int DM = 1024, NBATCH = 2, SEQ = 8192, CTX = 256;
constexpr int NCTX = NBATCH * CTX;
constexpr int NLAT = NBATCH * SEQ;
constexpr int NR = NCTX + NLAT;
constexpr int TK = CTX + SEQ;
constexpr int FH = 2816;
constexpr int NCH = TK / 64;
constexpr float LOG2E = 1.4426950408889634f;
constexpr int LDS_BYTES = 131072 + 64;
constexpr int NTHREADS = 512, NWV = 8;

constexpr size_t W_IN0 = 0;
constexpr size_t W_QB = W_IN0 + (size_t)1280 * 1024;
constexpr size_t W_KVB = W_QB + (size_t)768 * 384;
constexpr size_t W_GLU = W_KVB + (size_t)1024 * 256;
constexpr size_t W_OUT0 = W_GLU + (size_t)512 * 512;
constexpr size_t W_GU0 = W_OUT0 + (size_t)1024 * 1024;
constexpr size_t W_D0 = W_GU0 + (size_t)5632 * 1024;
constexpr size_t W_IN1 = W_D0 + (size_t)1024 * 2816;
constexpr size_t W_OUT1 = W_IN1 + (size_t)1536 * 1024;
constexpr size_t W_GU1 = W_OUT1 + (size_t)1024 * 1024;
constexpr size_t W_D1 = W_GU1 + (size_t)5632 * 1024;
constexpr size_t W_END = W_D1 + (size_t)1024 * 2816;
constexpr size_t OFF_TAB = W_END * 2;
constexpr size_t T_MOD = OFF_TAB;
constexpr size_t T_ROPE = T_MOD + 2 * 3 * 6144 * 4;
constexpr size_t T_LAMB = T_ROPE + 128 * 16 * 2 * 4;
constexpr size_t T_LAM64 = T_LAMB + 2 * 32 * 64 * 8;
constexpr size_t T_BBAR = T_LAM64 + 2 * 32 * 64 * 8;
constexpr size_t T_BAR = T_BBAR + (size_t)2 * 32 * 64 * 16 * 8;
constexpr size_t OFF_H = OFF_TAB + (1u << 20);
constexpr size_t OFF_A0 = OFF_H + (size_t)NR * 1024 * 4;
constexpr size_t OFF_S = OFF_A0 + (size_t)NR * 1024 * 2;
constexpr size_t WS_NEED = OFF_S + (size_t)108134400;
constexpr size_t S_SSP = WS_NEED;
constexpr size_t WS_NEED2 = S_SSP + (size_t)NR * 10 * 4;
static_assert(WS_NEED2 <= ((size_t)256 << 20) && OFF_S + (size_t)NR * FH * 2 <= WS_NEED, "workspace");
constexpr int SL = 32;
constexpr int NCK = TK / SL;
constexpr int CHR = NBATCH * NCK;
constexpr size_t H_UA = OFF_H;
constexpr size_t H_KR = H_UA + (size_t)(32 * CHR + 256) * 768 * 2;
constexpr size_t H_E = H_KR + (size_t)NR * 64 * 4;
constexpr size_t H_KK = H_E + (size_t)32 * CHR * 256 * 4;
constexpr size_t H_POW = H_KK + (size_t)32 * 2 * 32 * 256 * 4;
constexpr size_t H_W1A = H_POW + (size_t)4096 * 33 * 8;
static_assert(H_W1A + (size_t)32 * 256 * 512 * 2 <= OFF_A0, "H region overflow");
constexpr size_t A_W1B = OFF_A0;
constexpr size_t S_CQN = OFF_S;
constexpr size_t S_CKVN = S_CQN + (size_t)NR * 384 * 2;
constexpr size_t S_YG = OFF_S;
constexpr size_t S_X = S_CKVN + (size_t)NR * 256 * 2;
constexpr size_t S_CQKV = S_X;
constexpr size_t S_QRAW = S_X;
constexpr size_t S_KNOPE = S_QRAW + (size_t)NR * 768 * 2;
constexpr size_t S_VT = S_KNOPE + (size_t)NR * 512 * 2;
constexpr size_t S_KA = S_VT + (size_t)2 * 4 * 128 * TK * 2;
static_assert(S_CQKV + (size_t)NR * 640 * 4 <= S_VT, "CQKV overlaps VT");
static_assert(S_KA + (size_t)2 * 4 * TK * 192 * 2 <= WS_NEED, "scratch overflow");
constexpr size_t S_HID = OFF_S;
constexpr size_t S1_Q = OFF_S;
constexpr size_t S1_KRAW = S1_Q + (size_t)NR * 1024 * 2;
constexpr size_t S1_K = S1_KRAW + (size_t)NR * 256 * 4;
constexpr size_t S1_VT = S1_K + (size_t)2 * 4 * TK * 64 * 2;

struct Job { const float* a; const float* b; const float* ks; unsigned long long dst; int K, ld, ntk, ntn, tile0, mode; };
struct Params {
    const float* in[34];
    float* out;
    char* ws;
    Job jobs[11];
    int njobtiles;
    int pad;
};

DI int get_tid() { int t = threadIdx.x; asm volatile("" : "+v"(t)); return t; }
DI unsigned pk2(float lo, float hi) { f32x2 v = {lo, hi}; return __builtin_bit_cast(unsigned, __builtin_convertvector(v, bf16v2)); }
DI float bf2f(unsigned short b) { return __uint_as_float(((unsigned)b) << 16); }
DI f32x4 ld_bf4(const bf16_t* q) { const u32x2 w = *(const u32x2*)q; return (f32x4){__uint_as_float(w[0] << 16), __uint_as_float(w[0] & 0xffff0000u), __uint_as_float(w[1] << 16), __uint_as_float(w[1] & 0xffff0000u)}; }
DI void st_bf4(bf16_t* q, f32x4 v) { *(u32x2*)q = (u32x2){pk2(v[0], v[1]), pk2(v[2], v[3])}; }
DI float wave_sum(float v) {
#pragma unroll
    for (int o = 32; o > 0; o >>= 1) v += __shfl_xor(v, o);
    return v;
}
DI int row_vec(int r) { return r < NCTX ? 2 : (r - NCTX) / SEQ; }
DI int row_batch(int r) { return r < NCTX ? r / CTX : (r - NCTX) / SEQ; }
DI int row_tpos(int r) { return r < NCTX ? r % CTX : CTX + (r - NCTX) % SEQ; }
DI float sigmoidf_(float x) { return __builtin_amdgcn_rcpf(1.f + __expf(-x)); }
DI float siluf_(float x) { return x * __builtin_amdgcn_rcpf(1.f + __expf(-x)); }
DI float gelu_tanh(float y) { const float z = 0.7978845608028654f * (y + 0.044715f * y * y * y); const float t = 1.f - 2.f * __builtin_amdgcn_rcpf(1.f + __expf(2.f * z)); return 0.5f * y * (1.f + t); }
DI void my_sincos(float x, float& s, float& c) {
    const float q = rintf(x * 0.636619772367581f);
    float r = fmaf(-q, 1.5703125f, x);
    r = fmaf(-q, 4.837512969970703125e-4f, r);
    r = fmaf(-q, 7.54978995489188216e-8f, r);
    const int qi = (int)q;
    const float r2 = r * r;
    const float sp = r + r * r2 * (-1.6666654611e-1f + r2 * (8.3321608736e-3f + r2 * (-1.9515295891e-4f)));
    const float cp = 1.0f - 0.5f * r2 + r2 * r2 * (4.166664568298827e-2f + r2 * (-1.388731625493765e-3f + r2 * 2.443315711809948e-5f));
    const int k = qi & 3;
    s = (k == 0) ? sp : (k == 1) ? cp : (k == 2) ? -sp : -cp;
    c = (k == 0) ? cp : (k == 1) ? -sp : (k == 2) ? -cp : sp;
}


#define XB_TMO      128
#define XB_XCNT(j)  (256  + 64 * (j))
#define XB_XSUB(j)  (1280 + 64 * (j))
#define XB_XGEN(j)  (2304 + 64 * (j))
#define XB_TOP      3328
#define XB_TOPGEN   3392
#define XCD_BAR_WORDS 3456
#define XB_SPIN_CAP (1u << 22)
#define LAS __attribute__((address_space(3)))
DI unsigned xb_ld(unsigned* p) { return __hip_atomic_load(p, __ATOMIC_RELAXED, __HIP_MEMORY_SCOPE_AGENT); }
DI unsigned xb_add(unsigned* p, unsigned v) { return __hip_atomic_fetch_add(p, v, __ATOMIC_RELAXED, __HIP_MEMORY_SCOPE_AGENT); }
DI unsigned xb_xcc_id() { return (unsigned)__builtin_amdgcn_s_getreg((3 << 11) | 20) & 0xFu; }
#define XB_SPIN(cond, bar) do { unsigned _sp = 0; while (cond) { __builtin_amdgcn_s_sleep(1); \
    if ((++_sp & 255u) == 0u) { if (xb_ld(&(bar)[XB_TMO])) break; if (_sp > XB_SPIN_CAP) { atomicAdd(&(bar)[XB_TMO], 1u); break; } } } } while (0)
struct XcdBarrier { unsigned* bar; unsigned x; volatile LAS unsigned* st; };
DI XcdBarrier xcd_barrier_post(unsigned* bar, volatile LAS unsigned* st) {
    XcdBarrier b; b.bar = bar; b.x = xb_xcc_id(); b.st = st;
    if (threadIdx.x == 0) (void)xb_add(&bar[XB_XCNT(b.x)], 1u);
    return b;
}
DI void xcd_barrier_complete(unsigned* bar, unsigned x, unsigned& nloc, unsigned& nx) {
    const unsigned G = gridDim.x * gridDim.y * gridDim.z;
    unsigned sum, cnt, mine, sp = 0u;
    for (;;) {
        sum = 0u; cnt = 0u; mine = 0u;
#pragma unroll
        for (unsigned j = 0; j < 16; ++j) { const unsigned c = xb_ld(&bar[XB_XCNT(j)]); sum += c; cnt += (c > 0u) ? 1u : 0u; mine = (j == x) ? c : mine; }
        if (sum == G) break;
        __builtin_amdgcn_s_sleep(1);
        if ((++sp & 255u) == 0u) { if (xb_ld(&bar[XB_TMO])) break; if (sp > XB_SPIN_CAP) { atomicAdd(&bar[XB_TMO], 1u); break; } }
    }
    nloc = mine > 0u ? mine : 1u; nx = cnt > 0u ? cnt : 1u;
}
DI void xcd_barrier(const XcdBarrier& b) {
    asm volatile("s_waitcnt vmcnt(0)" ::: "memory");
    __syncthreads();
    if (threadIdx.x == 0) {
        unsigned* bar = b.bar;
        __builtin_amdgcn_s_waitcnt(0);
        unsigned nloc = b.st[0], nx = b.st[1];
        if (nloc == 0u) { xcd_barrier_complete(bar, b.x, nloc, nx); b.st[0] = nloc; b.st[1] = nx; }
        const unsigned old = xb_add(&bar[XB_XSUB(b.x)], 1u);
        const unsigned gen = old / nloc;
        if (old + 1u == (gen + 1u) * nloc) {
            __builtin_amdgcn_fence(__ATOMIC_RELEASE, "agent");
            asm volatile("s_waitcnt vmcnt(0)" ::: "memory");
            const unsigned og = xb_add(&bar[XB_TOP], 1u);
            const unsigned tg = og / nx;
            if (og + 1u == (tg + 1u) * nx) xb_add(&bar[XB_TOPGEN], 1u);
            else XB_SPIN(xb_ld(&bar[XB_TOPGEN]) == tg, bar);
            __builtin_amdgcn_fence(__ATOMIC_ACQUIRE, "agent");
            xb_add(&bar[XB_XGEN(b.x)], 1u);
            asm volatile("s_waitcnt vmcnt(0)" ::: "memory");
        } else {
            XB_SPIN(xb_ld(&bar[XB_XGEN(b.x)]) == gen, bar);
            __builtin_amdgcn_fence(__ATOMIC_ACQUIRE, "agent");
            asm volatile("s_waitcnt vmcnt(0)" ::: "memory");
        }
    }
    __syncthreads();
}

DI void transpose_tile(char* lds, char* ws, const Job& jb, int lt, bool live) {
    const int tid512 = get_tid(); const int tid = tid512 & 255;
    float (*tile)[65] = (float (*)[65])(lds + (tid512 >> 8) * 17408);
    const int tk = lt % jb.ntk, tn = lt / jb.ntk;
    const int k0 = tk * 64, n0 = tn * 64;
    const int c4 = (tid & 15) * 4, rq = tid >> 4;
    const float* src; int col; bool valid = live;
    if (jb.mode == 0) { src = jb.a; col = n0 + c4; valid = live && col < jb.ld; }
    else if (jb.mode == 2) { src = jb.a; const int rho = (n0 + c4) & 255; col = (n0 + c4 - rho) + 64 * ((rho >> 5) & 3) + 32 * (rho >> 7) + (rho & 31); valid = live && col < jb.ld; }
    else { const int nsub = c4 >> 4, i = c4 & 15; src = (nsub & 1) ? jb.b : jb.a; col = tn * 32 + (nsub >> 1) * 16 + i; }
#pragma unroll
    for (int kk = 0; kk < 4; ++kk) { const int k = kk * 16 + rq; f32x4 v = valid ? __builtin_nontemporal_load((const f32x4*)(src + (size_t)(k0 + k) * jb.ld + col)) : (f32x4){0.f, 0.f, 0.f, 0.f};
        if (jb.ks) v = v * jb.ks[k0 + k];
        tile[k][c4] = v[0]; tile[k][c4 + 1] = v[1]; tile[k][c4 + 2] = v[2]; tile[k][c4 + 3] = v[3]; }
    __syncthreads();
    const int r = tid >> 2, ks = (tid & 3) * 16;
    unsigned w[8];
#pragma unroll
    for (int q = 0; q < 8; ++q) w[q] = pk2(tile[ks + 2 * q][r], tile[ks + 2 * q + 1][r]);
    bf16_t* d = (bf16_t*)(ws) + jb.dst + (size_t)(n0 + r) * jb.K + k0 + ks;
    if (live) { *(u32x4*)d = (u32x4){w[0], w[1], w[2], w[3]};
    *(u32x4*)(d + 8) = (u32x4){w[4], w[5], w[6], w[7]}; }
    __syncthreads();
}

DI void transpose_range(char* lds, char* ws, const Params& p, int t_begin, int t_end, int rank, int nranks) {
    if (rank < 0) return;
    for (int pr = (t_begin >> 1) + rank; pr < (t_end >> 1); pr += nranks) {
        const int lt = pr * 2 + (int)(threadIdx.x >> 8); int j = 0;
#pragma unroll
        for (int q = 1; q < 11; ++q) if (lt >= p.jobs[q].tile0) j = q;
        transpose_tile(lds, ws, p.jobs[j], lt - p.jobs[j].tile0, true);
    }
}
DI int virt_block() { const int G_ = gridDim.x; return ((G_ & 7) == 0) ? (int)(blockIdx.x & 7) * (G_ >> 3) + (int)(blockIdx.x >> 3) : (int)blockIdx.x; }
DI void slack_rank(int ntile, int& rank, int& nranks) { const int rem = ntile % (int)gridDim.x; const int vb = virt_block(); if (rem == 0) { rank = vb; nranks = gridDim.x; } else { rank = vb - rem; nranks = (int)gridDim.x - rem; } }

DI void ada_item(char* lds, const Params& p, int it) {
    float* sil = (float*)lds;
    float* red = sil + 3072;
    float* MOD = (float*)(p.ws + T_MOD);
    const int tid = get_tid(), layer = it / 96, n0 = (it % 96) * 64;
    for (int i = tid; i < 3072; i += NTHREADS) { const int v = i >> 10, k = i & 1023; const float x = v < 2 ? p.in[1][v * 1024 + k] : p.in[3][k]; sil[i] = siluf_(x); }
    __syncthreads();
    const int j4 = (tid & 15) * 4, kg = tid >> 4;
    const float* W = p.in[4] + (size_t)layer * 1024 * 6144 + n0 + j4;
    f32x4 a0 = {0.f, 0.f, 0.f, 0.f}, a1 = a0, a2 = a0;
#pragma unroll 8
    for (int k = kg * 32; k < kg * 32 + 32; ++k) { const f32x4 w = __builtin_nontemporal_load((const f32x4*)(W + (size_t)k * 6144)); a0 += sil[k] * w; a1 += sil[1024 + k] * w; a2 += sil[2048 + k] * w; }
    *(f32x4*)(red + (kg * 3 + 0) * 64 + j4) = a0; *(f32x4*)(red + (kg * 3 + 1) * 64 + j4) = a1; *(f32x4*)(red + (kg * 3 + 2) * 64 + j4) = a2;
    __syncthreads();
    if (tid < 192) { const int v = tid >> 6, jj = tid & 63;
        float s = p.in[5][layer * 6144 + n0 + jj];
#pragma unroll 8
        for (int q = 0; q < 32; ++q) s += red[(q * 3 + v) * 64 + jj];
        MOD[(layer * 3 + v) * 6144 + n0 + jj] = s; }
    __syncthreads();
}

DI void tables_item(const Params& p, int it) {
    const int tid = get_tid();
    if (it < 4) {
        const int e = it * 512 + tid, pos = e >> 4, i = e & 15;
        const float inv = exp2f(-(float)i * (13.287712379549449f / 16.f));
        float s, c; my_sincos((float)pos * inv, s, c);
        float* ROPE = (float*)(p.ws + T_ROPE); ROPE[e * 2] = c; ROPE[e * 2 + 1] = s;
    } else {
        const int e = (it - 4) * 512 + tid;
        const int dg = e >> 6;
        const float lr = p.in[13][e], li = p.in[14][e], step = expf(p.in[15][dg]);
        const float a = lr * step, b = li * step;
        const float ea = expf(a);
        float sb, cb; my_sincos(b, sb, cb);
        float sh, ch; my_sincos(0.5f * b, sh, ch);
        const float em1 = a * (1.f + a * 0.5f * (1.f + a * (1.f / 3.f) * (1.f + a * 0.25f * (1.f + a * 0.2f * (1.f + a * (1.f / 6.f))))));
        const float lbr = ea * cb, lbi = ea * sb;
        const float nr = em1 * cb - 2.f * sh * sh, ni = ea * sb;
        const float den = lr * lr + li * li;
        const float qr = (nr * lr + ni * li) / den, qi = (ni * lr - nr * li) / den;
        f32x2* BB = (f32x2*)(p.ws + T_BBAR);
#pragma unroll
        for (int s = 0; s < 16; ++s) { const float br = p.in[16][e * 16 + s], bi = p.in[17][e * 16 + s]; BB[e * 16 + s] = (f32x2){qr * br - qi * bi, qr * bi + qi * br}; }
        f32x2* POW = (f32x2*)(p.ws + H_POW) + (size_t)dg * 33 * 64 + (e & 63);
        float pr = 1.f, pi = 0.f;
        for (int q = 0; q <= 32; ++q) { POW[q * 64] = (f32x2){pr, pi}; const float nr2 = pr * lbr - pi * lbi, ni2 = pr * lbi + pi * lbr; pr = nr2; pi = ni2; }
    }
}

DI void modulate_rows(const Params& p, int layer, int which, bool from_inputs, int r0) {
    const int tid_ = get_tid(); const int lane = tid_ & 63, wid = tid_ >> 6;
    const float* gain = p.in[which ? 7 : 6] + layer * 1024;
    const float* modl = (const float*)(p.ws + T_MOD) + layer * 3 * 6144 + (which ? 3072 : 0);
    const bf16_t* Hb = (const bf16_t*)(p.ws + OFF_H);
    bf16_t* dst = (bf16_t*)(p.ws + OFF_A0);
    const int stride = gridDim.x * NWV;
    for (int ra = r0 + blockIdx.x * NWV + wid; ra < NR; ra += 2 * stride) {
        const int rb = ra + stride; const bool hb = rb < NR; const int rbb = hb ? rb : ra;
        const float* srca = ra < NCTX ? p.in[2] + (size_t)ra * 1024 : p.in[0] + (size_t)(ra - NCTX) * 1024;
        const float* srcb = rbb < NCTX ? p.in[2] + (size_t)rbb * 1024 : p.in[0] + (size_t)(rbb - NCTX) * 1024;
        f32x4 xa[4], xb[4]; float sa = 0.f, sb = 0.f;
#pragma unroll
        for (int i = 0; i < 4; ++i) { if (from_inputs) { xa[i] = *(const f32x4*)(srca + i * 256 + lane * 4); xb[i] = *(const f32x4*)(srcb + i * 256 + lane * 4); }
                                      else { xa[i] = ld_bf4(Hb + (size_t)ra * 1024 + i * 256 + lane * 4); xb[i] = ld_bf4(Hb + (size_t)rbb * 1024 + i * 256 + lane * 4); } }
#pragma unroll
        for (int i = 0; i < 4; ++i) { sa += xa[i][0] * xa[i][0] + xa[i][1] * xa[i][1] + xa[i][2] * xa[i][2] + xa[i][3] * xa[i][3];
                                      sb += xb[i][0] * xb[i][0] + xb[i][1] * xb[i][1] + xb[i][2] * xb[i][2] + xb[i][3] * xb[i][3]; }
        sa = wave_sum(sa); sb = wave_sum(sb);
        const float rsa = rsqrtf(sa * (1.f / 1024.f) + 1e-6f), rsb = rsqrtf(sb * (1.f / 1024.f) + 1e-6f);
        const float* mva = modl + row_vec(ra) * 6144; const float* mvb = modl + row_vec(rbb) * 6144;
#pragma unroll
        for (int i = 0; i < 4; ++i) { const int c = i * 256 + lane * 4;
            const f32x4 g = *(const f32x4*)(gain + c);
            { const f32x4 sh = *(const f32x4*)(mva + c), sc = *(const f32x4*)(mva + 1024 + c); const f32x4 y = xa[i] * rsa * g * (1.f + sc) + sh;
              *(u32x2*)(dst + (size_t)ra * 1024 + c) = (u32x2){pk2(y[0], y[1]), pk2(y[2], y[3])}; }
            if (hb) { const f32x4 sh = *(const f32x4*)(mvb + c), sc = *(const f32x4*)(mvb + 1024 + c); const f32x4 y = xb[i] * rsb * g * (1.f + sc) + sh;
              *(u32x2*)(dst + (size_t)rb * 1024 + c) = (u32x2){pk2(y[0], y[1]), pk2(y[2], y[3])}; } }
    }
}

template <class Epi>
DI void gemm_phase(char* lds, const bf16_t* A0_, int lda, const bf16_t* Bt0_, int K, int mt0, int nmt, int nnt, const Epi& epi, int nbatch = 1, size_t sA = 0, size_t sB = 0, int ksplit = 1, int gact = 0) {
    const int tid = get_tid(), lane = tid & 63, wid = tid >> 6, wr = wid >> 2, wc = wid & 3, fr = lane & 15, fq = lane >> 4;
    const int nk = (K >> 6) / ksplit;
    const int lrow = tid >> 3, lc = tid & 7, lkc = lc * 8;
    const int woff = lrow * 128 + ((lc ^ ((lrow >> 1) & 7)) << 4);
    const int ra0 = (wr * 128 + fr) * 128 + ((fq ^ (fr >> 1)) << 4);
    const int ra1 = (wr * 128 + fr) * 128 + (((4 + fq) ^ (fr >> 1)) << 4);
    const int rb0 = 32768 + (wc * 64 + fr) * 128 + ((fq ^ (fr >> 1)) << 4);
    const int rb1 = 32768 + (wc * 64 + fr) * 128 + (((4 + fq) ^ (fr >> 1)) << 4);
    const int per = nmt * nnt, ntile = nbatch * per * ksplit;
    const int PM = nnt >= 8 ? 4 : 8;
    const int GA = gact > 0 ? gact : (int)gridDim.x;
    const int myn = ((int)blockIdx.x < GA && (int)blockIdx.x < ntile) ? (ntile - (int)blockIdx.x + GA - 1) / GA : 0;
    const int total = myn * nk;
    f32x4 acc[8][4];
#pragma unroll
    for (int m = 0; m < 8; ++m)
#pragma unroll
        for (int n = 0; n < 4; ++n) acc[m][n] = (f32x4){0.f, 0.f, 0.f, 0.f};
    int iti = 0, ikt = 0;
    const int srow = wid * 32 + (lane >> 3);
    const bf16_t* Ag = A0_; const bf16_t* Bg = Bt0_;
#define G_STAGE(bufoff) do { if (ikt == 0) { const int u_ = blockIdx.x + iti * GA; const int t_ = u_ / ksplit, sl_ = u_ - t_ * ksplit; const int gb_ = t_ / per, tr_ = t_ - gb_ * per; const int ch_ = tr_ / (PM * nnt), rm_ = tr_ - ch_ * PM * nnt; const int pc_ = (nmt - ch_ * PM) < PM ? (nmt - ch_ * PM) : PM; const int tn_ = rm_ / pc_, tm_ = ch_ * PM + (rm_ - tn_ * pc_); \
            Ag = A0_ + (size_t)gb_ * sA + (size_t)((mt0 + tm_) * 256) * lda + sl_ * nk * 64; Bg = Bt0_ + (size_t)gb_ * sB + (size_t)(tn_ * 256) * K + sl_ * nk * 64; } \
        _Pragma("unroll") for (int i = 0; i < 4; ++i) { const int row_ = srow + 8 * i; const int c_ = ((lane & 7) ^ ((row_ >> 1) & 7)) * 8; \
            __builtin_amdgcn_global_load_lds((const unsigned*)(Ag + (size_t)row_ * lda + ikt * 64 + c_), (LAS unsigned*)(lds + (bufoff) + (wid * 4 + i) * 1024), 16, 0, 0); \
            __builtin_amdgcn_global_load_lds((const unsigned*)(Bg + (size_t)row_ * K + ikt * 64 + c_), (LAS unsigned*)(lds + (bufoff) + 32768 + (wid * 4 + i) * 1024), 16, 0, 0); } \
        if (++ikt == nk) { ikt = 0; ++iti; } } while (0)
#define G_COMPUTE(bufoff) do { _Pragma("unroll") for (int ks = 0; ks < 2; ++ks) { bf16x8 a[8], b[4]; \
        _Pragma("unroll") for (int m = 0; m < 8; ++m) a[m] = *(const bf16x8*)(lds + (bufoff) + (ks ? ra1 : ra0) + m * 2048); \
        _Pragma("unroll") for (int n = 0; n < 4; ++n) b[n] = *(const bf16x8*)(lds + (bufoff) + (ks ? rb1 : rb0) + n * 2048); \
        _Pragma("unroll") for (int m = 0; m < 8; ++m) _Pragma("unroll") for (int n = 0; n < 4; ++n) acc[m][n] = __builtin_amdgcn_mfma_f32_16x16x32_bf16(b[n], a[m], acc[m][n], 0, 0, 0); } } while (0)
    __syncthreads();
    if (total > 0) G_STAGE(0);
    asm volatile("s_waitcnt vmcnt(0)" ::: "memory");
    __syncthreads();
    int cti = 0, ckt = 0;
    for (int q = 0; q < total; ++q) {
        const int cur = (q & 1) * 65536;
        if (q + 1 < total) G_STAGE(cur ^ 65536);
        G_COMPUTE(cur);
        asm volatile("s_waitcnt vmcnt(0)" ::: "memory");
        __syncthreads();
        if (++ckt == nk) {
            const int u_ = blockIdx.x + cti * GA; const int t_ = u_ / ksplit; const int gb_ = t_ / per, tr_ = t_ - gb_ * per; const int ch_ = tr_ / (PM * nnt), rm_ = tr_ - ch_ * PM * nnt; const int pc_ = (nmt - ch_ * PM) < PM ? (nmt - ch_ * PM) : PM; const int tn_ = rm_ / pc_, tm_ = ch_ * PM + (rm_ - tn_ * pc_);
            epi(acc, (mt0 + tm_) * 256 + wr * 128 + fr, tn_ * 256 + wc * 64 + fq * 4, gb_);
#pragma unroll
            for (int m = 0; m < 8; ++m)
#pragma unroll
                for (int n = 0; n < 4; ++n) acc[m][n] = (f32x4){0.f, 0.f, 0.f, 0.f};
            ckt = 0; ++cti;
        }
    }
#undef G_STAGE
#undef G_COMPUTE
}

template <int KSP>
DI void thin_gemm_ctx(char* lds, const bf16_t* A, int lda, const bf16_t* Bt, int K, const float* res_f, const bf16_t* res_h, bf16_t* dst, const float* gate) {
    const int tid = get_tid(), lane = tid & 63, wid = tid >> 6, fr = lane & 15, fq = lane >> 4;
    float* part = (float*)lds;
    for (int t = blockIdx.x; t < 256; t += gridDim.x) {
        const int m0 = (t >> 5) * 64, n0 = (t & 31) * 32;
        f32x4 acc[4][2];
#pragma unroll
        for (int m = 0; m < 4; ++m) { acc[m][0] = (f32x4){0.f, 0.f, 0.f, 0.f}; acc[m][1] = (f32x4){0.f, 0.f, 0.f, 0.f}; }
        const bf16_t* Ap = A + (size_t)(m0 + fr) * lda + wid * (KSP * 32) + fq * 8;
        const bf16_t* Bp = Bt + (size_t)(n0 + fr) * K + wid * (KSP * 32) + fq * 8;
#pragma unroll
        for (int k = 0; k < KSP; ++k) {
            bf16x8 a[4], b[2];
#pragma unroll
            for (int m = 0; m < 4; ++m) a[m] = *(const bf16x8*)(Ap + (size_t)m * 16 * lda + k * 32);
#pragma unroll
            for (int n = 0; n < 2; ++n) b[n] = *(const bf16x8*)(Bp + (size_t)n * 16 * K + k * 32);
#pragma unroll
            for (int m = 0; m < 4; ++m)
#pragma unroll
                for (int n = 0; n < 2; ++n) acc[m][n] = __builtin_amdgcn_mfma_f32_16x16x32_bf16(b[n], a[m], acc[m][n], 0, 0, 0);
        }
        __syncthreads();
#pragma unroll
        for (int m = 0; m < 4; ++m)
#pragma unroll
            for (int n = 0; n < 2; ++n) *(f32x4*)(part + ((wid * 64 + m * 16 + fr) * 32 + n * 16 + fq * 4)) = acc[m][n];
        __syncthreads();
        { const int row = tid >> 3, c4 = (tid & 7) * 4; f32x4 sum = (f32x4){0.f, 0.f, 0.f, 0.f};
#pragma unroll
          for (int w = 0; w < 8; ++w) sum += *(const f32x4*)(part + ((w * 64 + row) * 32 + c4));
          const size_t off = (size_t)(m0 + row) * 1024 + n0 + c4;
          const f32x4 g = *(const f32x4*)(gate + 2 * 6144 + n0 + c4), x = res_h ? ld_bf4(res_h + off) : *(const f32x4*)(res_f + off);
          st_bf4(dst + off, x + g * sum); }
    }
    __syncthreads();
}

struct EpiWin0 {
    bf16_t* UA; bf16_t* CQN; bf16_t* CKVN; float* SSP; float* KR;
    template <int NM> DI void run(const f32x4 (&acc)[NM][4], int row0, int col0) const {
        const int cw = col0 & ~63;
#pragma unroll
        for (int m = 0; m < NM; ++m) { const int ri = row0 + m * 16; const size_t r = ri;
            if (cw < 512) { const int b = row_batch(ri), tp = row_tpos(ri);
#pragma unroll
                for (int n = 0; n < 4; ++n) { const int c = col0 + n * 16; const f32x4 v = acc[m][n]; const int g = c >> 4, s0 = c & 15;
                    *(u32x2*)(UA + ((size_t)g * CHR + b * NCK + (tp >> 5)) * 768 + (tp & 31) * 16 + s0) = (u32x2){pk2(v[0], v[1]), pk2(v[2], v[3])}; }
            } else if (cw < 1152) { const bool isq = cw < 896; bf16_t* dst = isq ? CQN + r * 384 + (col0 - 512) : CKVN + r * 256 + (col0 - 896);
                float ss = 0.f;
#pragma unroll
                for (int n = 0; n < 4; ++n) { const f32x4 v = acc[m][n]; ss += v[0] * v[0] + v[1] * v[1] + v[2] * v[2] + v[3] * v[3];
                    *(u32x2*)(dst + n * 16) = (u32x2){pk2(v[0], v[1]), pk2(v[2], v[3])}; }
                ss += __shfl_xor(ss, 16); ss += __shfl_xor(ss, 32);
                if ((col0 & 15) == 0) SSP[r * 10 + ((cw - 512) >> 6)] = ss;
            } else if (cw < 1216) {
#pragma unroll
                for (int n = 0; n < 4; ++n) *(f32x4*)(KR + r * 64 + (col0 - 1152) + n * 16) = acc[m][n];
            } }
    }
    DI void operator()(const f32x4 (&acc)[8][4], int row0, int col0, int gb) const { run<8>(acc, row0, col0); }
};
struct EpiS1a {
    float* E;
    DI void operator()(const f32x4 (&acc)[8][4], int row0, int col0, int gb) const {
#pragma unroll
        for (int m = 0; m < 8; ++m) { const int r = row0 + m * 16; if (r >= CHR) continue;
#pragma unroll
            for (int n = 0; n < 4; ++n) *(f32x4*)(E + ((size_t)gb * CHR + r) * 256 + col0 + n * 16) = acc[m][n]; }
    }
};
struct EpiS1b {
    bf16_t* YG;
    DI void operator()(const f32x4 (&acc)[8][4], int row0, int col0, int gb) const {
#pragma unroll
        for (int m = 0; m < 8; ++m) { const int r = row0 + m * 16; if (r >= CHR) continue; const int b = r / NCK, c = r % NCK;
#pragma unroll
            for (int n = 0; n < 4; ++n) { const int cc = col0 + n * 16; const int tl = cc >> 4, s0 = cc & 15; const f32x4 v = acc[m][n];
                const int tp = c * SL + tl; const size_t row = tp < CTX ? (size_t)b * CTX + tp : (size_t)NCTX + (size_t)b * SEQ + (tp - CTX);
                *(u32x2*)(YG + row * 512 + gb * 16 + s0) = (u32x2){pk2(gelu_tanh(v[0]), gelu_tanh(v[1])), pk2(gelu_tanh(v[2]), gelu_tanh(v[3]))}; } }
    }
};
struct EpiBf16 {
    bf16_t* O; int ldo; const float* SSP;
    DI void operator()(const f32x4 (&acc)[8][4], int row0, int col0, int gb) const {
#pragma unroll
        for (int m = 0; m < 8; ++m) { const size_t r = row0 + m * 16; const float* sp = SSP + r * 10;
            const float rstd = rsqrtf(((sp[0] + sp[1]) + (sp[2] + sp[3]) + (sp[4] + sp[5])) * (1.f / 384.f) + 1e-6f);
#pragma unroll
            for (int n = 0; n < 4; ++n) { const int c = col0 + n * 16; const f32x4 v = acc[m][n] * rstd;
                *(u32x2*)(O + r * ldo + c) = (u32x2){pk2(v[0], v[1]), pk2(v[2], v[3])}; } }
    }
};
struct EpiKV {
    bf16_t* KNOPE; bf16_t* VT; const float* SSP;
    DI void operator()(const f32x4 (&acc)[8][4], int row0, int col0, int gb) const {
#pragma unroll
        for (int m = 0; m < 8; ++m) { const int r = row0 + m * 16; const int b = row_batch(r), tp = row_tpos(r); const float* sp = SSP + (size_t)r * 10 + 6;
            const float rstd = rsqrtf(((sp[0] + sp[1]) + (sp[2] + sp[3])) * (1.f / 256.f) + 1e-6f);
#pragma unroll
            for (int n = 0; n < 4; ++n) { const int c = col0 + n * 16; const int h = c >> 8, w = c & 255; const f32x4 v = acc[m][n] * rstd;
                if (w < 128) *(u32x2*)(KNOPE + (size_t)r * 512 + h * 128 + w) = (u32x2){pk2(v[0], v[1]), pk2(v[2], v[3])};
                else { bf16_t* d = VT + ((size_t)(b * 4 + h) * 128 + (w - 128)) * TK + tp; const unsigned p0 = pk2(v[0], v[1]), p1 = pk2(v[2], v[3]);
                    d[0] = (bf16_t)(p0 & 0xffff); d[TK] = (bf16_t)(p0 >> 16); d[2 * TK] = (bf16_t)(p1 & 0xffff); d[3 * TK] = (bf16_t)(p1 >> 16); } } }
    }
};
struct EpiGLU {
    const bf16_t* YG; const float* bias; bf16_t* CAT;
    DI void operator()(const f32x4 (&acc)[8][4], int row0, int col0, int gb) const {
#pragma unroll
        for (int m = 0; m < 8; ++m) { const size_t r = row0 + m * 16;
#pragma unroll
            for (int n = 0; n < 4; ++n) { const int c = col0 + n * 16; const f32x4 v = acc[m][n]; const f32x4 bv = *(const f32x4*)(bias + c);
                const u32x2 yy = *(const u32x2*)(YG + r * 512 + c);
                const float y0 = __uint_as_float(yy[0] << 16), y1 = __uint_as_float(yy[0] & 0xffff0000u), y2 = __uint_as_float(yy[1] << 16), y3 = __uint_as_float(yy[1] & 0xffff0000u);
                const float o0 = y0 * sigmoidf_(v[0] + bv[0]), o1 = y1 * sigmoidf_(v[1] + bv[1]), o2 = y2 * sigmoidf_(v[2] + bv[2]), o3 = y3 * sigmoidf_(v[3] + bv[3]);
                *(u32x2*)(CAT + r * 1024 + c) = (u32x2){pk2(o0, o1), pk2(o2, o3)}; } }
    }
};
struct EpiRes {
    const float* res_ctx; const float* res_lat; float* dst_ctx; float* dst_lat; const float* gate; int atomic;
    DI void operator()(const f32x4 (&acc)[8][4], int row0, int col0, int gb) const {
#pragma unroll
        for (int m = 0; m < 8; ++m) { const int r = row0 + m * 16;
            const float* rs = r < NCTX ? res_ctx + (size_t)r * 1024 : res_lat + (size_t)(r - NCTX) * 1024;
            float* ds = r < NCTX ? dst_ctx + (size_t)r * 1024 : dst_lat + (size_t)(r - NCTX) * 1024;
            if (r < NCTX && dst_ctx == nullptr) continue;
            const float* gv = gate + row_vec(r) * 6144;
#pragma unroll
            for (int n = 0; n < 4; ++n) { const int c = col0 + n * 16; const f32x4 g = *(const f32x4*)(gv + c);
                if (atomic) { const f32x4 v = g * acc[m][n];
#pragma unroll
                    for (int j = 0; j < 4; ++j) (void)__hip_atomic_fetch_add(ds + c + j, v[j], __ATOMIC_RELAXED, __HIP_MEMORY_SCOPE_AGENT); }
                else { const f32x4 x = *(const f32x4*)(rs + c); *(f32x4*)(ds + c) = x + g * acc[m][n]; } } }
    }
};
struct EpiSwiGLU {
    bf16_t* HID;
    DI void operator()(const f32x4 (&acc)[8][4], int row0, int col0, int gb) const {
        const int hc = (col0 >> 6) * 32 + (col0 & 15);
#pragma unroll
        for (int m = 0; m < 8; ++m) { const size_t r = row0 + m * 16;
#pragma unroll
            for (int q = 0; q < 2; ++q) { const f32x4 g = acc[m][2 * q], u = acc[m][2 * q + 1];
                const float o0 = siluf_(g[0]) * u[0], o1 = siluf_(g[1]) * u[1], o2 = siluf_(g[2]) * u[2], o3 = siluf_(g[3]) * u[3];
                *(u32x2*)(HID + r * FH + hc + q * 16) = (u32x2){pk2(o0, o1), pk2(o2, o3)}; } }
    }
};
struct EpiWin1 {
    bf16_t* Q; bf16_t* K1; bf16_t* VT; const float* qn; const float* kn; const float* ROPE;
    template <int NM> DI void run(const f32x4 (&acc)[NM][4], int row0, int col0) const {
        const int cw = col0 & ~63, i0 = col0 & 15;
        if (cw >= 1280) {
#pragma unroll
            for (int m = 0; m < NM; ++m) { const int r = row0 + m * 16; const int b = row_batch(r), tp = row_tpos(r);
#pragma unroll
                for (int n = 0; n < 4; ++n) { const int cc = col0 + n * 16 - 1280, h = cc >> 6, d0 = cc & 63; const f32x4 v = acc[m][n];
                    bf16_t* d = VT + ((size_t)(b * 4 + h) * 64 + d0) * TK + tp; const unsigned p0 = pk2(v[0], v[1]), p1 = pk2(v[2], v[3]);
                    d[0] = (bf16_t)(p0 & 0xffff); d[TK] = (bf16_t)(p0 >> 16); d[2 * TK] = (bf16_t)(p1 & 0xffff); d[3 * TK] = (bf16_t)(p1 >> 16); } }
            return;
        }
        const bool isq = cw < 1024;
        const float* gn = isq ? qn : kn;
        f32x4 g[4];
#pragma unroll
        for (int n = 0; n < 4; ++n) g[n] = *(const f32x4*)(gn + n * 16 + i0);
        const float osc = isq ? 0.125f * LOG2E : 1.f;
#pragma unroll
        for (int m = 0; m < NM; ++m) { const int r = row0 + m * 16; const bool lat = r >= NCTX;
            if (isq && !lat) continue;
            const int b = row_batch(r), tp = row_tpos(r), t = tp - CTX;
            float ss = 0.f;
#pragma unroll
            for (int n = 0; n < 4; ++n) { const f32x4 v = acc[m][n]; ss += v[0] * v[0] + v[1] * v[1] + v[2] * v[2] + v[3] * v[3]; }
            ss += __shfl_xor(ss, 16); ss += __shfl_xor(ss, 32);
            const float rstd = rsqrtf(ss * (1.f / 64.f) + 1e-6f);
            f32x4 y[4];
#pragma unroll
            for (int n = 0; n < 4; ++n) y[n] = acc[m][n] * rstd * g[n];
            if (lat) { const float* rr = ROPE + ((t >> 6) * 16 + i0) * 2; const float* rc = ROPE + ((t & 63) * 16 + i0) * 2;
#pragma unroll
                for (int j = 0; j < 4; ++j) { const float c0 = rr[2 * j], s0 = rr[2 * j + 1], c1 = rc[2 * j], s1 = rc[2 * j + 1];
                    const float a0 = y[0][j], a1 = y[1][j], a2 = y[2][j], a3 = y[3][j];
                    y[0][j] = a0 * c0 - a1 * s0; y[1][j] = a1 * c0 + a0 * s0; y[2][j] = a2 * c1 - a3 * s1; y[3][j] = a3 * c1 + a2 * s1; } }
            bf16_t* dst = isq ? Q + (size_t)r * 1024 + cw + i0 : K1 + ((size_t)(b * 4 + ((cw - 1024) >> 6)) * TK + tp) * 64 + i0;
#pragma unroll
            for (int n = 0; n < 4; ++n) *(u32x2*)(dst + n * 16) = (u32x2){pk2(y[n][0] * osc, y[n][1] * osc), pk2(y[n][2] * osc, y[n][3] * osc)};
        }
    }
    DI void operator()(const f32x4 (&acc)[8][4], int row0, int col0, int gb) const { run<8>(acc, row0, col0); }
};

namespace pg8 {
constexpr int BM = 256, BK = 64, HALF = 128, HTB = HALF * BK * 2;
DI int lds_byte(int r, int c) { const int st = (r >> 4) * 2 + (c >> 5), rr = r & 15, cc = c & 31, ob = rr * 64 + cc * 2; return st * 1024 + (ob ^ (((ob >> 9) & 1) << 5)); }
DI void stage_rc(int b, int& R, int& C) { const int st = b / 1024, sb = b % 1024, swz = sb ^ (((sb >> 9) & 1) << 5); R = (st >> 1) * 16 + swz / 64; C = (st & 1) * 32 + (swz % 64) / 2; }
struct Unit { int pm, pn, gb; };
struct Gemm { const bf16_t* A; const bf16_t* Bt; int lda, K; size_t sA = 0, sB = 0; };
struct Order {
    int mt0, nmt, nnt, G, c, nbatch = 1;
    DI bool next(int i, Unit& u) const { const int L0 = i * G + c; if (L0 >= nbatch * nmt * nnt) return false; constexpr int PM = 8; const int gb_ = L0 / (nmt * nnt); const int L = L0 - gb_ * nmt * nnt; u.gb = gb_;
        const int ch = L / (PM * nnt), rm = L - ch * PM * nnt; const int pc = (nmt - ch * PM) < PM ? (nmt - ch * PM) : PM; const int tn = rm / pc;
        u.pm = mt0 + ch * PM + (rm - tn * pc); u.pn = tn; return true; }
};
template <class Epi>
DI void gemm_phase(LAS unsigned char* lds, const Gemm g, const Order& S, const Epi& E) {
    const int tid = get_tid(), wid = __builtin_amdgcn_readfirstlane(tid >> 6), lane = tid & 63, wr = wid >> 2, wc = wid & 3, fr = lane & 15, fq = lane >> 4;
    const int K = g.K, nt = K / BK;
    unsigned voffA[2], voffB[2];
#pragma unroll
    for (int i = 0; i < 2; ++i) { int R, C; stage_rc(tid * 16 + i * 8192, R, C); voffA[i] = (unsigned)(R * g.lda + C) * 2u; voffB[i] = (unsigned)(R * K + C) * 2u; }
    const size_t kstep = (size_t)(BK * 2);
    const size_t hstepA = (size_t)HALF * g.lda * 2, hstepB = (size_t)HALF * K * 2;
    const size_t tstepA = 2 * hstepA, tstepB = 2 * hstepB;
    const unsigned ldsw = (unsigned)wid * 1024u;
    const int aoff = lds_byte(wr * 64 + fr, fq * 8), boff = lds_byte(wc * 32 + fr, fq * 8);
#define PG8_SA(b, h) (((b) * 2 + (h)) * HTB)
#define PG8_SB(b, h) ((4 + (b) * 2 + (h)) * HTB)
#define PG8_STAGE(bufoff, gbase, voff) do { _Pragma("unroll") for (int _i = 0; _i < 2; ++_i) \
        __builtin_amdgcn_global_load_lds((const unsigned*)((const char*)(gbase) + (voff)[_i]), (LAS unsigned*)(lds + (bufoff) + ldsw + _i * 8192), 16, 0, 0); } while (0)
#define PG8_LDA(dst, b, h) do { _Pragma("unroll") for (int m = 0; m < 4; ++m) _Pragma("unroll") for (int k = 0; k < 2; ++k) dst[m][k] = *(const LAS bf16x8*)(lds + PG8_SA(b, h) + aoff + m * 2048 + k * 1024); } while (0)
#define PG8_LDB(dst, b, h) do { _Pragma("unroll") for (int n = 0; n < 2; ++n) _Pragma("unroll") for (int k = 0; k < 2; ++k) dst[n][k] = *(const LAS bf16x8*)(lds + PG8_SB(b, h) + boff + n * 2048 + k * 1024); } while (0)
#define PG8_MMA(ai, bj, At, Bt) do { __builtin_amdgcn_s_setprio(1); _Pragma("unroll") for (int m = 0; m < 4; ++m) _Pragma("unroll") for (int n = 0; n < 2; ++n) _Pragma("unroll") for (int k = 0; k < 2; ++k) \
        acc[ai][bj][m][n] = __builtin_amdgcn_mfma_f32_16x16x32_bf16(Bt[n][k], At[m][k], acc[ai][bj][m][n], 0, 0, 0); __builtin_amdgcn_s_setprio(0); } while (0)
#define PG8_WAIT_V(n) asm volatile("s_waitcnt vmcnt(" #n ")" ::: "memory")
#define PG8_WAIT_L(n) asm volatile("s_waitcnt lgkmcnt(" #n ")" ::: "memory")
#define PG8_BAR __builtin_amdgcn_s_barrier()
#define PG8_SCHED __builtin_amdgcn_sched_barrier(0)
    Unit cur, nxt; int ui = 0;
    if (!S.next(0, cur)) return;
    f32x4 acc[2][2][4][2];
#pragma unroll
    for (int a = 0; a < 2; ++a)
#pragma unroll
        for (int b = 0; b < 2; ++b)
#pragma unroll
            for (int m = 0; m < 4; ++m)
#pragma unroll
                for (int n = 0; n < 2; ++n) acc[a][b][m][n] = (f32x4){0.f, 0.f, 0.f, 0.f};
    bf16x8 At[4][2], B0[2][2], B1[2][2];
    const char* cA = (const char*)(g.A + (size_t)cur.gb * g.sA) + (size_t)cur.pm * tstepA; const char* cB = (const char*)(g.Bt + (size_t)cur.gb * g.sB) + (size_t)cur.pn * tstepB;
    PG8_STAGE(PG8_SB(0, 0), cB, voffB); PG8_STAGE(PG8_SB(0, 1), cB + hstepB, voffB); PG8_STAGE(PG8_SA(0, 0), cA, voffA); PG8_STAGE(PG8_SA(0, 1), cA + hstepA, voffA);
    if (wr == 1) PG8_BAR;
    PG8_WAIT_V(2); PG8_BAR;
    PG8_STAGE(PG8_SB(1, 0), cB + kstep, voffB); PG8_STAGE(PG8_SA(1, 0), cA + kstep, voffA); PG8_STAGE(PG8_SB(1, 1), cB + hstepB + kstep, voffB);
    PG8_WAIT_V(6); PG8_BAR;
    for (;;) {
        const bool has_next = S.next(ui + 1, nxt);
        const char* nA = has_next ? (const char*)(g.A + (size_t)nxt.gb * g.sA) + (size_t)nxt.pm * tstepA : cA; const char* nB = has_next ? (const char*)(g.Bt + (size_t)nxt.gb * g.sB) + (size_t)nxt.pn * tstepB : cB;
        for (int t = 0; t < nt; t += 2) {
            const bool last = (t == nt - 2);
            const char* a1 = cA + (size_t)(t + 1) * kstep;
            const char* a2 = last ? nA : cA + (size_t)(t + 2) * kstep; const char* b2 = last ? nB : cB + (size_t)(t + 2) * kstep;
            const char* a3 = a2 + kstep; const char* b3 = b2 + kstep;
            PG8_LDB(B0, 0, 0); PG8_LDB(B1, 0, 1); PG8_SCHED; PG8_LDA(At, 0, 0); PG8_STAGE(PG8_SA(1, 1), a1 + hstepA, voffA);
            PG8_WAIT_V(8); PG8_WAIT_L(0); PG8_BAR; PG8_MMA(0, 0, At, B0); PG8_MMA(0, 1, At, B1); PG8_BAR; PG8_SCHED;
            PG8_LDA(At, 0, 1); PG8_STAGE(PG8_SB(0, 0), b2, voffB); PG8_STAGE(PG8_SB(0, 1), b2 + hstepB, voffB); PG8_STAGE(PG8_SA(0, 0), a2, voffA);
            PG8_WAIT_V(8); PG8_WAIT_L(0); PG8_BAR; PG8_MMA(1, 0, At, B0); PG8_MMA(1, 1, At, B1); PG8_BAR; PG8_SCHED;
            PG8_LDB(B0, 1, 0); PG8_LDB(B1, 1, 1); PG8_SCHED; PG8_LDA(At, 1, 0); PG8_STAGE(PG8_SA(0, 1), a2 + hstepA, voffA);
            PG8_WAIT_V(8); PG8_WAIT_L(0); PG8_BAR; PG8_MMA(0, 0, At, B0); PG8_MMA(0, 1, At, B1); PG8_BAR; PG8_SCHED;
            PG8_LDA(At, 1, 1); PG8_STAGE(PG8_SB(1, 0), b3, voffB); PG8_STAGE(PG8_SB(1, 1), b3 + hstepB, voffB); PG8_STAGE(PG8_SA(1, 0), a3, voffA);
            PG8_WAIT_V(8); PG8_WAIT_L(0); PG8_BAR; PG8_MMA(1, 0, At, B0); PG8_MMA(1, 1, At, B1); PG8_BAR; PG8_SCHED;
        }
        if (wr == 0) PG8_BAR;
        E(acc, cur, wr, wc, fr, fq);
        if (!has_next) break;
#pragma unroll
        for (int a = 0; a < 2; ++a)
#pragma unroll
            for (int b = 0; b < 2; ++b)
#pragma unroll
                for (int m = 0; m < 4; ++m)
#pragma unroll
                    for (int n = 0; n < 2; ++n) acc[a][b][m][n] = (f32x4){0.f, 0.f, 0.f, 0.f};
        cur = nxt; cA = nA; cB = nB; ++ui;
        if (wr == 1) PG8_BAR;
    }
    PG8_WAIT_V(0);
    PG8_BAR;
#undef PG8_SA
#undef PG8_SB
#undef PG8_STAGE
#undef PG8_LDA
#undef PG8_LDB
#undef PG8_MMA
#undef PG8_WAIT_V
#undef PG8_WAIT_L
#undef PG8_BAR
#undef PG8_SCHED
}
struct EpiRes {
    const float* res_f; const bf16_t* res_h; bf16_t* dst_h; float* dst_f; const float* gate;
    DI void operator()(const f32x4 (&acc)[2][2][4][2], const Unit& u, int wr, int wc, int fr, int fq) const {
        const int row0 = u.pm * 256 + wr * 64 + fr, col0 = u.pn * 256 + wc * 32 + fq * 4;
#pragma unroll
        for (int ai = 0; ai < 2; ++ai)
#pragma unroll
            for (int m = 0; m < 4; ++m) { const int r = row0 + 128 * ai + 16 * m; const size_t ro = (size_t)(r - NCTX) * 1024; const float* gv = gate + row_vec(r) * 6144;
#pragma unroll
                for (int bj = 0; bj < 2; ++bj)
#pragma unroll
                    for (int n = 0; n < 2; ++n) { const int c = col0 + 128 * bj + 16 * n; const f32x4 g_ = *(const f32x4*)(gv + c);
                        const f32x4 x = res_h ? ld_bf4(res_h + ro + c) : __builtin_nontemporal_load((const f32x4*)(res_f + ro + c));
                        const f32x4 y = x + g_ * acc[ai][bj][m][n];
                        if (dst_h) st_bf4(dst_h + ro + c, y); else __builtin_nontemporal_store(y, (f32x4*)(dst_f + ro + c)); } }
    }
};
struct EpiSwiGLU {
    bf16_t* HID;
    DI void operator()(const f32x4 (&acc)[2][2][4][2], const Unit& u, int wr, int wc, int fr, int fq) const {
        const int row0 = u.pm * 256 + wr * 64 + fr, hc0 = u.pn * 128 + wc * 16 + fq * 4;
#pragma unroll
        for (int ai = 0; ai < 2; ++ai)
#pragma unroll
            for (int m = 0; m < 4; ++m) { const size_t r = row0 + 128 * ai + 16 * m;
#pragma unroll
                for (int bj = 0; bj < 2; ++bj) { const f32x4 g_ = acc[ai][bj][m][0], u_ = acc[ai][bj][m][1];
                    const float o0 = siluf_(g_[0]) * u_[0], o1 = siluf_(g_[1]) * u_[1], o2 = siluf_(g_[2]) * u_[2], o3 = siluf_(g_[3]) * u_[3];
                    *(u32x2*)(HID + r * FH + hc0 + 64 * bj) = (u32x2){pk2(o0, o1), pk2(o2, o3)}; } }
    }
};
struct EpiS1a {
    float* E;
    DI void operator()(const f32x4 (&acc)[2][2][4][2], const Unit& u, int wr, int wc, int fr, int fq) const {
        const int row0 = u.pm * 256 + wr * 64 + fr, col0 = u.pn * 256 + wc * 32 + fq * 4;
#pragma unroll
        for (int ai = 0; ai < 2; ++ai)
#pragma unroll
            for (int m = 0; m < 4; ++m) { const int r = row0 + 128 * ai + 16 * m; if (r >= CHR) continue;
#pragma unroll
                for (int bj = 0; bj < 2; ++bj)
#pragma unroll
                    for (int n = 0; n < 2; ++n) *(f32x4*)(E + ((size_t)u.gb * CHR + r) * 256 + col0 + 128 * bj + 16 * n) = acc[ai][bj][m][n]; }
    }
};
struct EpiS1b {
    bf16_t* YG;
    DI void operator()(const f32x4 (&acc)[2][2][4][2], const Unit& u, int wr, int wc, int fr, int fq) const {
        const int row0 = u.pm * 256 + wr * 64 + fr, col0 = u.pn * 256 + wc * 32 + fq * 4;
#pragma unroll
        for (int ai = 0; ai < 2; ++ai)
#pragma unroll
            for (int m = 0; m < 4; ++m) { const int r = row0 + 128 * ai + 16 * m; if (r >= CHR) continue; const int b = r / NCK, c = r % NCK;
#pragma unroll
                for (int bj = 0; bj < 2; ++bj)
#pragma unroll
                    for (int n = 0; n < 2; ++n) { const int cc = col0 + 128 * bj + 16 * n; const int tl = cc >> 4, s0 = cc & 15; const f32x4 v = acc[ai][bj][m][n];
                        const int tp = c * SL + tl; const size_t row = tp < CTX ? (size_t)b * CTX + tp : (size_t)NCTX + (size_t)b * SEQ + (tp - CTX);
                        *(u32x2*)(YG + row * 512 + u.gb * 16 + s0) = (u32x2){pk2(gelu_tanh(v[0]), gelu_tanh(v[1])), pk2(gelu_tanh(v[2]), gelu_tanh(v[3]))}; } }
    }
};
template <class E> struct EpiHead { E e;
    DI void operator()(const f32x4 (&acc)[2][2][4][2], const Unit& u, int wr, int wc, int fr, int fq) const {
#pragma unroll
        for (int ai = 0; ai < 2; ++ai) { f32x4 t[4][4];
#pragma unroll
            for (int m = 0; m < 4; ++m)
#pragma unroll
                for (int sb = 0; sb < 4; ++sb) t[m][sb] = acc[ai][sb >> 1][m][sb & 1];
            e.template run<4>(t, u.pm * 256 + 128 * ai + wr * 64 + fr, u.pn * 256 + wc * 64 + fq * 4); }
    }
};
}

template <int DQK, int DV, bool WIN>
DI void attn_item(char* lds, const bf16_t* Q, int qstride, const bf16_t* Kb, const bf16_t* VTb, int ta0, int ta1, int tb0, int tb1,
                  float mref, float l_init, bf16_t* O, int ostride, int qpos0) {
    constexpr int NKS = DQK / 16, NDT = DV / 32, KSTR = DQK + 8, VSTR = 72, NG = NKS;
    constexpr int KCH = 64 * DQK / 8 / NTHREADS, VCH = DV * 8 / NTHREADS;
    constexpr int KBUF = 64 * KSTR, VBUF = DV * VSTR;
    bf16_t* Ks = (bf16_t*)lds; bf16_t* Vs = Ks + 2 * KBUF;
    const int tid = get_tid(), lane = tid & 63, wid = tid >> 6, r = lane & 31, h2 = lane >> 5;
    bf16x8 qf[NKS];
    { const bf16_t* qrow = Q + (size_t)(wid * 32 + r) * qstride + 8 * h2;
#pragma unroll
      for (int ks = 0; ks < NKS; ++ks) qf[ks] = *(const bf16x8*)(qrow + 16 * ks); }
    f32x16 o[NDT];
#pragma unroll
    for (int dt = 0; dt < NDT; ++dt)
#pragma unroll
        for (int i = 0; i < 16; ++i) o[dt][i] = 0.f;
    float lrun = (h2 == 0) ? l_init : 0.f;
    const int na = ta1 - ta0, ntot = na + (tb1 - tb0);
    u32x4 kr[KCH], vr[VCH];
    constexpr int KTPR = (DQK / 8) / KCH, VTPR = 8 / VCH;
    const int krow = tid / KTPR, kcol = (tid % KTPR) * (KCH * 8);
    const int vrow = tid / VTPR, vcol = (tid % VTPR) * (VCH * 8);
    const bf16_t* kgp = Kb + (size_t)krow * DQK + kcol;
    const bf16_t* vgp = VTb + (size_t)vrow * TK + vcol;
    bf16_t* ksp = Ks + krow * KSTR + kcol;
    bf16_t* vsp = Vs + vrow * VSTR + vcol;
    const bf16_t* kfp = Ks + r * KSTR + 8 * h2;
    const bf16_t* vfp = Vs + r * VSTR + 8 * h2;
#define A_TILE(itv) (((itv) < na) ? ta0 + (itv) : tb0 + ((itv) - na))
#define K_LOAD(itv) do { const bf16_t* kg = kgp + (size_t)A_TILE(itv) * 64 * DQK; _Pragma("unroll") for (int i = 0; i < KCH; ++i) kr[i] = *(const u32x4*)(kg + i * 8); } while (0)
#define V_LOADG(itv) do { const bf16_t* vg = vgp + A_TILE(itv) * 64; _Pragma("unroll") for (int i = 0; i < VCH; ++i) vr[i] = *(const u32x4*)(vg + i * 8); } while (0)
#define K_WRITE(bo) do { _Pragma("unroll") for (int i = 0; i < KCH; ++i) *(u32x4*)(ksp + (bo) + i * 8) = kr[i]; } while (0)
#define V_WRITE(bo) do { _Pragma("unroll") for (int i = 0; i < VCH; ++i) { const int c_ = (vcol >> 3) + i; bf16_t* d_ = vsp - vcol + (bo) + (c_ >> 1) * 16 + (c_ & 1) * 4; \
            *(u32x2*)d_ = (u32x2){vr[i][0], vr[i][1]}; *(u32x2*)(d_ + 8) = (u32x2){vr[i][2], vr[i][3]}; } } while (0)
#define T_ACTIVE(itv) (!(WIN && A_TILE(itv) >= 4 && ((A_TILE(itv) - 4) * 64 > qpos0 + wid * 32 + 31 + 128 || (A_TILE(itv) - 4) * 64 + 63 < qpos0 + wid * 32 - 128)))
#define S_MASK(S0, S1, itv) do { if (WIN && A_TILE(itv) >= 4) { const int qp = qpos0 + wid * 32 + r, kp0 = (A_TILE(itv) - 4) * 64 + 4 * h2; \
        _Pragma("unroll") for (int i = 0; i < 16; ++i) { const int d0 = kp0 + (i & 3) + 8 * (i >> 2) - qp, d1 = d0 + 32; \
            if (d0 > 128 || d0 < -128) S0[i] = -1e30f; if (d1 > 128 || d1 < -128) S1[i] = -1e30f; } } } while (0)
    f32x16 s0, s1;
    __syncthreads();
    K_LOAD(0); K_WRITE(0);
    if (1 < ntot) K_LOAD(1);
    V_LOADG(0);
    __syncthreads();
#pragma unroll
    for (int i = 0; i < 16; ++i) { s0[i] = -mref; s1[i] = -mref; }
#pragma unroll 1
    for (int it = -1; it < ntot; ++it) {
        const int kb_n = ((it + 1) & 1) * KBUF, vb_c = (it & 1) * VBUF;
        if (it + 2 < ntot) K_WRITE((it & 1) * KBUF);
        if (it + 1 < ntot) V_WRITE(((it + 1) & 1) * VBUF);
        __builtin_amdgcn_sched_barrier(0);
        const bool act_c = (it >= 0) && T_ACTIVE(it), act_n = (it + 1 < ntot) && T_ACTIVE(it + 1);
        f32x16 n0, n1;
#pragma unroll
        for (int i = 0; i < 16; ++i) { n0[i] = -mref; n1[i] = -mref; }
        float rs = 0.f;
        unsigned pk[16];
#define P_PAIR(j) do { const float e0_ = __builtin_amdgcn_exp2f((j) < 8 ? s0[2 * ((j) & 7)] : s1[2 * ((j) & 7)]), e1_ = __builtin_amdgcn_exp2f((j) < 8 ? s0[2 * ((j) & 7) + 1] : s1[2 * ((j) & 7) + 1]); rs += e0_ + e1_; pk[j] = pk2(e0_, e1_); } while (0)
        if (act_c && act_n) {
#pragma unroll
            for (int g = 0; g < NG; ++g) {
                const bf16x8 ka = *(const bf16x8*)(kfp + kb_n + 16 * g), kb = *(const bf16x8*)(kfp + kb_n + 32 * KSTR + 16 * g);
                n0 = __builtin_amdgcn_mfma_f32_32x32x16_bf16(ka, qf[g], n0, 0, 0, 0);
                n1 = __builtin_amdgcn_mfma_f32_32x32x16_bf16(kb, qf[g], n1, 0, 0, 0);
#pragma unroll
                for (int j = (16 * g) / NG; j < (16 * (g + 1)) / NG; ++j) P_PAIR(j);
            }
            S_MASK(n0, n1, it + 1);
        } else {
            if (act_n) {
#pragma unroll
                for (int ks = 0; ks < NKS; ++ks) { const bf16x8 k0 = *(const bf16x8*)(kfp + kb_n + 16 * ks), k1 = *(const bf16x8*)(kfp + kb_n + 32 * KSTR + 16 * ks);
                    n0 = __builtin_amdgcn_mfma_f32_32x32x16_bf16(k0, qf[ks], n0, 0, 0, 0); n1 = __builtin_amdgcn_mfma_f32_32x32x16_bf16(k1, qf[ks], n1, 0, 0, 0); }
                S_MASK(n0, n1, it + 1);
            }
            if (act_c) {
#pragma unroll
                for (int j = 0; j < 16; ++j) P_PAIR(j);
            }
        }
#undef P_PAIR
        __builtin_amdgcn_sched_barrier(0);
        if (it + 3 < ntot) K_LOAD(it + 3);
        if (it + 2 < ntot) V_LOADG(it + 2);
        __builtin_amdgcn_sched_barrier(0);
        if (act_c) {
            lrun += rs;
#pragma unroll
            for (int q = 0; q < 4; ++q) {
                const u32x4 pw = {pk[4 * q], pk[4 * q + 1], pk[4 * q + 2], pk[4 * q + 3]};
                const bf16x8 pf = __builtin_bit_cast(bf16x8, pw);
#pragma unroll
                for (int dt = 0; dt < NDT; ++dt) { const bf16x8 vf = *(const bf16x8*)(vfp + vb_c + (32 * dt) * VSTR + 16 * q);
                    o[dt] = __builtin_amdgcn_mfma_f32_32x32x16_bf16(vf, pf, o[dt], 0, 0, 0); }
            }
        }
        s0 = n0; s1 = n1;
        __syncthreads();
    }
#undef A_TILE
#undef K_LOAD
#undef V_LOADG
#undef K_WRITE
#undef V_WRITE
#undef T_ACTIVE
#undef S_MASK
    lrun += __shfl_xor(lrun, 32);
    const float inv = 1.f / lrun;
    bf16_t* orow = O + (size_t)(wid * 32 + r) * ostride;
#pragma unroll
    for (int dt = 0; dt < NDT; ++dt)
#pragma unroll
        for (int g = 0; g < 4; ++g)
            *(u32x2*)(orow + 32 * dt + 8 * g + 4 * h2) = (u32x2){pk2(o[dt][4 * g] * inv, o[dt][4 * g + 1] * inv), pk2(o[dt][4 * g + 2] * inv, o[dt][4 * g + 3] * inv)};
    __syncthreads();
}

template <int NH>
DI void win_attn_item(char* lds, const bf16_t* Q, const bf16_t* Kb, const bf16_t* VTb, int tb0, int tb1, float mref, const float* sinkp, bf16_t* O, int qpos0) {
    constexpr int KSTR = 72, VSTR = 72, KBUF = 64 * KSTR, VBUF = 64 * VSTR;
    bf16_t* Ks = (bf16_t*)lds; bf16_t* Vs = Ks + 2 * KBUF;
    const int tid = get_tid(), lane = tid & 63, wid = tid >> 6, r = lane & 31, h2 = lane >> 5;
    bf16x8 qf[NH][4];
#pragma unroll
    for (int h = 0; h < NH; ++h) { const bf16_t* qrow = Q + (size_t)(wid * 32 + r) * 1024 + h * 64 + 8 * h2;
#pragma unroll
        for (int ks = 0; ks < 4; ++ks) qf[h][ks] = *(const bf16x8*)(qrow + 16 * ks); }
    f32x16 o[NH][2]; float lrun[NH];
#pragma unroll
    for (int h = 0; h < NH; ++h) { lrun[h] = (h2 == 0) ? __builtin_amdgcn_exp2f(sinkp[h] * LOG2E - mref) : 0.f;
#pragma unroll
        for (int dt = 0; dt < 2; ++dt)
#pragma unroll
            for (int i = 0; i < 16; ++i) o[h][dt][i] = 0.f; }
    const int na = 4, ntot = na + (tb1 - tb0);
    u32x4 kr, vr;
    const int krow = tid >> 3, kcol = (tid & 7) * 8;
    const bf16_t* kgp = Kb + (size_t)krow * 64 + kcol;
    const bf16_t* vgp = VTb + (size_t)krow * TK + kcol;
    bf16_t* ksp = Ks + krow * KSTR + kcol;
    bf16_t* vsp = Vs + krow * VSTR + (kcol >> 4) * 16 + ((kcol >> 3) & 1) * 4;
    const bf16_t* kfp = Ks + r * KSTR + 8 * h2;
    const bf16_t* vfp = Vs + r * VSTR + 8 * h2;
#define W_TILE(itv) (((itv) < na) ? (itv) : tb0 + ((itv) - na))
#define W_LOAD(itv) do { kr = *(const u32x4*)(kgp + (size_t)W_TILE(itv) * 64 * 64); vr = *(const u32x4*)(vgp + W_TILE(itv) * 64); } while (0)
#define W_WRITE(kb_, vb_) do { *(u32x4*)(ksp + (kb_)) = kr; *(u32x2*)(vsp + (vb_)) = (u32x2){vr[0], vr[1]}; *(u32x2*)(vsp + (vb_) + 8) = (u32x2){vr[2], vr[3]}; } while (0)
    __syncthreads();
    W_LOAD(0); W_WRITE(0, 0);
    if (1 < ntot) W_LOAD(1);
    __syncthreads();
#pragma unroll 1
    for (int it = 0; it < ntot; ++it) {
        const int T = W_TILE(it);
        const int kb = (it & 1) * KBUF, vb = (it & 1) * VBUF;
        if (it + 1 < ntot) W_WRITE(KBUF - kb, VBUF - vb);
        if (it + 2 < ntot) W_LOAD(it + 2);
        bool active = true, need_mask = false;
        if (T >= 4) { const int klo = (T - 4) * 64, qlo = qpos0 + wid * 32;
            active = !(klo > qlo + 31 + 128 || klo + 63 < qlo - 128);
            need_mask = (klo < qlo + 31 - 128) || (klo + 63 > qlo + 128); }
        if (active) {
#pragma unroll
            for (int h = 0; h < NH; ++h) {
                __builtin_amdgcn_sched_barrier(0);
                f32x16 s0, s1;
#pragma unroll
                for (int i = 0; i < 16; ++i) { s0[i] = -mref; s1[i] = -mref; }
#pragma unroll
                for (int ks = 0; ks < 4; ++ks) { const bf16x8 k0 = *(const bf16x8*)(kfp + kb + 16 * ks), k1 = *(const bf16x8*)(kfp + kb + 32 * KSTR + 16 * ks);
                    s0 = __builtin_amdgcn_mfma_f32_32x32x16_bf16(k0, qf[h][ks], s0, 0, 0, 0); s1 = __builtin_amdgcn_mfma_f32_32x32x16_bf16(k1, qf[h][ks], s1, 0, 0, 0); }
                if (need_mask) { const int qp = qpos0 + wid * 32 + r, kp0 = (T - 4) * 64 + 4 * h2;
#pragma unroll
                    for (int i = 0; i < 16; ++i) { const int d0 = kp0 + (i & 3) + 8 * (i >> 2) - qp, d1 = d0 + 32;
                        if (d0 > 128 || d0 < -128) s0[i] = -1e30f; if (d1 > 128 || d1 < -128) s1[i] = -1e30f; } }
                float rs = 0.f; unsigned pk[16];
#pragma unroll
                for (int j = 0; j < 8; ++j) { const float a0 = __builtin_amdgcn_exp2f(s0[2 * j]), a1 = __builtin_amdgcn_exp2f(s0[2 * j + 1]), b0 = __builtin_amdgcn_exp2f(s1[2 * j]), b1 = __builtin_amdgcn_exp2f(s1[2 * j + 1]);
                    rs += (a0 + a1) + (b0 + b1); pk[j] = pk2(a0, a1); pk[8 + j] = pk2(b0, b1); }
                lrun[h] += rs;
                __builtin_amdgcn_sched_barrier(0);
#pragma unroll
                for (int q = 0; q < 4; ++q) { const u32x4 pw = {pk[4 * q], pk[4 * q + 1], pk[4 * q + 2], pk[4 * q + 3]}; const bf16x8 pf = __builtin_bit_cast(bf16x8, pw);
#pragma unroll
                    for (int dt = 0; dt < 2; ++dt) { const bf16x8 vf = *(const bf16x8*)(vfp + vb + (32 * dt) * VSTR + 16 * q);
                        o[h][dt] = __builtin_amdgcn_mfma_f32_32x32x16_bf16(vf, pf, o[h][dt], 0, 0, 0); } }
            }
        }
        __syncthreads();
    }
#undef W_TILE
#undef W_LOAD
#undef W_WRITE
#pragma unroll
    for (int h = 0; h < NH; ++h) { float l = lrun[h]; l += __shfl_xor(l, 32); const float inv = 1.f / l;
        bf16_t* orow = O + (size_t)(wid * 32 + r) * 1024 + h * 64;
#pragma unroll
        for (int dt = 0; dt < 2; ++dt)
#pragma unroll
            for (int g = 0; g < 4; ++g)
                *(u32x2*)(orow + 32 * dt + 8 * g + 4 * h2) = (u32x2){pk2(o[h][dt][4 * g] * inv, o[h][dt][4 * g + 1] * inv), pk2(o[h][dt][4 * g + 2] * inv, o[h][dt][4 * g + 3] * inv)}; }
    __syncthreads();
}

DI void s5_kk_phase(char* lds, const Params& p) {
    const int tid512 = get_tid(); const int tid = tid512 & 255, s = tid >> 4, sp = tid & 15, dh = tid512 >> 8;
    f32x2* sbb = (f32x2*)lds;
    f32x2* scc = sbb + 1024;
    f32x2* spw = scc + 1024;
    const f32x2* POW = (const f32x2*)(p.ws + H_POW); const f32x2* BB = (const f32x2*)(p.ws + T_BBAR); float* KK = (float*)(p.ws + H_KK);
    for (int it = blockIdx.x; it < 32 * 2 * 4; it += gridDim.x) {
        const int dq = it & 3, dir = (it >> 2) & 1, g = it >> 3; const int dg = dir * 32 + g;
        __syncthreads();
        for (int i = tid512; i < 1024; i += NTHREADS) { sbb[i] = BB[(size_t)dg * 1024 + i]; scc[i] = (f32x2){p.in[18][(size_t)dg * 1024 + i], p.in[19][(size_t)dg * 1024 + i]}; }
        { const int i = tid512; spw[i] = POW[((size_t)dg * 33 + dq * 8 + (i >> 6)) * 64 + (i & 63)]; }
        __syncthreads();
        float acc[4] = {0.f, 0.f, 0.f, 0.f};
#pragma unroll 4
        for (int pp = 0; pp < 64; ++pp) { const f32x2 bb = sbb[pp * 16 + sp], cc = scc[s * 64 + pp];
#pragma unroll
            for (int q = 0; q < 4; ++q) { const f32x2 pw = spw[(dh * 4 + q) * 64 + pp];
                const float zr = pw[0] * bb[0] - pw[1] * bb[1], zi = pw[0] * bb[1] + pw[1] * bb[0];
                acc[q] += cc[0] * zr - cc[1] * zi; } }
#pragma unroll
        for (int q = 0; q < 4; ++q) KK[(size_t)((g * 2 + dir) * 32 + dq * 8 + dh * 4 + q) * 256 + tid] = acc[q];
    }
    __syncthreads();
}
DI void s5_w1a_phase(const Params& p) {
    const int tid = get_tid();
    const f32x2* POW = (const f32x2*)(p.ws + H_POW); const f32x2* BB = (const f32x2*)(p.ws + T_BBAR); bf16_t* W = (bf16_t*)(p.ws + H_W1A);
    for (int idx = blockIdx.x * NTHREADS + tid; idx < 2048 * 256; idx += gridDim.x * NTHREADS) {
        const int kq = idx & 63, n = (idx >> 6) & 255, g = idx >> 14;
        const int dir = n >> 7, ri = (n >> 6) & 1, pp = n & 63; const int e = (dir * 32 + g) * 64 + pp; const int tl = kq >> 1, s0 = (kq & 1) * 8;
        const f32x2 pw = POW[((size_t)(dir * 32 + g) * 33 + (dir ? tl : 31 - tl)) * 64 + pp];
        float v[8];
#pragma unroll
        for (int j = 0; j < 8; ++j) { const f32x2 bb = BB[e * 16 + s0 + j]; v[j] = ri ? pw[0] * bb[1] + pw[1] * bb[0] : pw[0] * bb[0] - pw[1] * bb[1]; }
        *(u32x4*)(W + ((size_t)g * 256 + n) * 512 + kq * 8) = (u32x4){pk2(v[0], v[1]), pk2(v[2], v[3]), pk2(v[4], v[5]), pk2(v[6], v[7])};
    }
}
DI void s5_w1b_phase(const Params& p) {
    const int tid = get_tid();
    const f32x2* __restrict__ POW = (const f32x2*)(p.ws + H_POW); const float* __restrict__ KK = (const float*)(p.ws + H_KK); bf16_t* __restrict__ W = (bf16_t*)(p.ws + A_W1B);
    const float* __restrict__ CRE = p.in[18]; const float* __restrict__ CIM = p.in[19]; const float* __restrict__ DSK = p.in[20];
#pragma unroll 2
    for (int idx = blockIdx.x * NTHREADS + tid; idx < 32 * 512 * 64; idx += gridDim.x * NTHREADS) {
        const int kq = idx & 63, n = (idx >> 6) & 511, g = idx >> 15;
        const int tl = n >> 4, s = n & 15, tl2 = kq >> 1, s0 = (kq & 1) * 8;
        const int d0 = tl - tl2, d1 = tl2 - tl;
        const float* k0 = KK + (size_t)((g * 2 + 0) * 32 + (d0 < 0 ? 0 : d0)) * 256 + s * 16 + s0;
        const float* k1 = KK + (size_t)((g * 2 + 1) * 32 + (d1 < 0 ? 0 : d1)) * 256 + s * 16 + s0;
        const f32x4 a0 = *(const f32x4*)k0, a1 = *(const f32x4*)(k0 + 4), b0 = *(const f32x4*)k1, b1 = *(const f32x4*)(k1 + 4);
        const float w0 = d0 >= 0 ? 1.f : 0.f, w1 = d1 >= 0 ? 1.f : 0.f;
        f32x4 x0 = a0 * w0 + b0 * w1, x1 = a1 * w0 + b1 * w1;
        if (tl2 == tl && (s >> 3) == (kq & 1)) { const float dv = DSK[g * 16 + s];
#pragma unroll
            for (int j = 0; j < 4; ++j) { if (j == (s & 7)) x0[j] += dv; if (4 + j == (s & 7)) x1[j] += dv; } }
        *(u32x4*)(W + ((size_t)g * 512 + n) * 768 + kq * 8) = (u32x4){pk2(x0[0], x0[1]), pk2(x0[2], x0[3]), pk2(x1[0], x1[1]), pk2(x1[2], x1[3])};
    }
#pragma unroll 2
    for (int idx = blockIdx.x * NTHREADS + tid; idx < 32 * 512 * 32; idx += gridDim.x * NTHREADS) {
        const int kb = idx & 31, n = (idx >> 5) & 511, g = idx >> 14;
        const int tl = n >> 4, s = n & 15, k2 = kb * 8; const int dir = k2 >> 7, ri = (k2 >> 6) & 1, p0 = k2 & 63;
        const float* cre = CRE + ((size_t)(dir * 32 + g) * 16 + s) * 64 + p0; const float* cim = CIM + ((size_t)(dir * 32 + g) * 16 + s) * 64 + p0;
        const f32x2* pwp = POW + ((size_t)(dir * 32 + g) * 33 + (dir ? 32 - tl : tl + 1)) * 64 + p0;
        const f32x4 cr0 = *(const f32x4*)cre, cr1 = *(const f32x4*)(cre + 4), ci0 = *(const f32x4*)cim, ci1 = *(const f32x4*)(cim + 4);
        const f32x4 pa = *(const f32x4*)pwp, pb = *(const f32x4*)(pwp + 2), pc = *(const f32x4*)(pwp + 4), pd = *(const f32x4*)(pwp + 6);
        float v[8];
        const float pr[8] = {pa[0], pa[2], pb[0], pb[2], pc[0], pc[2], pd[0], pd[2]}, pi[8] = {pa[1], pa[3], pb[1], pb[3], pc[1], pc[3], pd[1], pd[3]};
#pragma unroll
        for (int j = 0; j < 8; ++j) { const float cr = j < 4 ? cr0[j & 3] : cr1[j & 3], ci = j < 4 ? ci0[j & 3] : ci1[j & 3];
            v[j] = ri ? -(cr * pi[j] + ci * pr[j]) : cr * pr[j] - ci * pi[j]; }
        *(u32x4*)(W + ((size_t)g * 512 + n) * 768 + 512 + kb * 8) = (u32x4){pk2(v[0], v[1]), pk2(v[2], v[3]), pk2(v[4], v[5]), pk2(v[6], v[7])};
    }
}
DI void s5_carry_phase(const Params& p) {
    const int tid_ = get_tid(); const int lane = tid_ & 63, wid = tid_ >> 6;
    const f32x2* POW = (const f32x2*)(p.ws + H_POW); const float* E = (const float*)(p.ws + H_E); bf16_t* UA = (bf16_t*)(p.ws + H_UA);
    for (int it = ((int)gridDim.x - 1 - (int)blockIdx.x) * NWV + wid; it < 2 * 2 * 32; it += gridDim.x * NWV) {
        const int g = it & 31, dir = (it >> 5) & 1, b = it >> 6;
        const f32x2 l32 = POW[((size_t)(dir * 32 + g) * 33 + 32) * 64 + lane];
        float hr = 0.f, hi = 0.f;
        float er[8], ei[8], fr_[8], fi_[8];
#define C_IDX(i_) ((size_t)g * CHR + b * NCK + (dir ? ((i_) < 8 ? 7 - (i_) : NCK - 1 - ((i_) - 8)) : (i_)))
#define C_LOAD(R, I, i0_) do { _Pragma("unroll") for (int j = 0; j < 8; ++j) { const size_t m = C_IDX((i0_) + j); R[j] = E[m * 256 + dir * 128 + lane]; I[j] = E[m * 256 + dir * 128 + 64 + lane]; } } while (0)
#define C_STEP(R, I, i0_) do { _Pragma("unroll") for (int j = 0; j < 8; ++j) { const size_t m = C_IDX((i0_) + j); bf16_t* u = UA + m * 768 + 512 + dir * 128 + lane; \
            u[0] = (bf16_t)(pk2(hr, 0.f) & 0xffff); u[64] = (bf16_t)(pk2(hi, 0.f) & 0xffff); \
            const float nr = l32[0] * hr - l32[1] * hi + R[j], ni = l32[0] * hi + l32[1] * hr + I[j]; hr = nr; hi = ni; } } while (0)
        C_LOAD(er, ei, 0);
        for (int i0 = 0; i0 < NCK; i0 += 16) {
            if (i0 + 8 < NCK) C_LOAD(fr_, fi_, i0 + 8);
            C_STEP(er, ei, i0);
            if (i0 + 8 < NCK) { if (i0 + 16 < NCK) C_LOAD(er, ei, i0 + 16); C_STEP(fr_, fi_, i0 + 8); }
        }
#undef C_IDX
#undef C_LOAD
#undef C_STEP
    }
}

DI float rope64(float x, int lane, const float* ROPE, int rpos, int cpos) {
    const float partner = __shfl_xor(x, 16);
    const int i = lane & 15; const int pos = lane < 32 ? rpos : cpos;
    const float c = ROPE[(pos * 16 + i) * 2], s = ROPE[(pos * 16 + i) * 2 + 1];
    return (lane & 16) ? x * c + partner * s : x * c - partner * s;
}
DI void mla_prep_phase(const Params& p) {
    const int tid_ = get_tid(); const int lane = tid_ & 63, wid = tid_ >> 6;
    bf16_t* QR = (bf16_t*)(p.ws + S_QRAW); const bf16_t* KN = (const bf16_t*)(p.ws + S_KNOPE); const float* KR = (const float*)(p.ws + H_KR);
    bf16_t* KA = (bf16_t*)(p.ws + S_KA); const float* ROPE = (const float*)(p.ws + T_ROPE);
    const float qsc = 0.07216878364870323f * LOG2E;
    const float qg0 = p.in[27][lane], qg1 = p.in[27][64 + lane], qg2 = p.in[27][128 + lane];
    const float kg0 = p.in[28][lane], kg1 = p.in[28][64 + lane], kg2 = p.in[28][128 + lane];
    const int nbusy = (int)gridDim.x < 192 ? (int)gridDim.x : 192, nslots = nbusy + 3 * ((int)gridDim.x - nbusy);
    const int vb_ = virt_block();
    const int myslots = vb_ < nbusy ? 1 : 3, slot0 = vb_ < nbusy ? vb_ : nbusy + 3 * (vb_ - nbusy);
    for (int sj = 0; sj < myslots; ++sj)
    for (int r = (slot0 + sj) * NWV + wid; r < NR; r += nslots * NWV) {
        const bool lat = r >= NCTX; const int b = row_batch(r), tp = row_tpos(r); const int t = tp - CTX;
        const bf16_t* q = QR + (size_t)r * 768; const bf16_t* kn = KN + (size_t)r * 512;
        float x[4][3], k[4][3];
        const float krv = KR[(size_t)r * 64 + lane];
#pragma unroll
        for (int h = 0; h < 4; ++h) { x[h][0] = bf2f(q[h * 192 + lane]); x[h][1] = bf2f(q[h * 192 + 64 + lane]); x[h][2] = bf2f(q[h * 192 + 128 + lane]);
            k[h][0] = bf2f(kn[h * 128 + lane]); k[h][1] = bf2f(kn[h * 128 + 64 + lane]); k[h][2] = krv; }
        float rc = 1.f, rsn = 0.f;
        if (lat) { const int pos = lane < 32 ? (t >> 6) : (t & 63); rc = ROPE[(pos * 16 + (lane & 15)) * 2]; rsn = ROPE[(pos * 16 + (lane & 15)) * 2 + 1]; }
        const float sgn = (lane & 16) ? 1.f : -1.f;
#pragma unroll
        for (int h = 0; h < 4; ++h) {
            float ss = wave_sum(x[h][0] * x[h][0] + x[h][1] * x[h][1] + x[h][2] * x[h][2]);
            float rs = rsqrtf(ss * (1.f / 192.f) + 1e-6f) * qsc;
            const float x0 = x[h][0] * rs * qg0, x1 = x[h][1] * rs * qg1; float x2 = x[h][2] * rs * qg2;
            x2 = x2 * rc + sgn * __shfl_xor(x2, 16) * rsn;
            bf16_t* qd = QR + (size_t)r * 768 + h * 192;
            qd[lane] = (bf16_t)(pk2(x0, 0.f) & 0xffff); qd[64 + lane] = (bf16_t)(pk2(x1, 0.f) & 0xffff); qd[128 + lane] = (bf16_t)(pk2(x2, 0.f) & 0xffff);
            ss = wave_sum(k[h][0] * k[h][0] + k[h][1] * k[h][1] + k[h][2] * k[h][2]);
            rs = rsqrtf(ss * (1.f / 192.f) + 1e-6f);
            const float k0 = k[h][0] * rs * kg0, k1 = k[h][1] * rs * kg1; float k2 = k[h][2] * rs * kg2;
            k2 = k2 * rc + sgn * __shfl_xor(k2, 16) * rsn;
            bf16_t* kd = KA + ((size_t)(b * 4 + h) * TK + tp) * 192;
            kd[lane] = (bf16_t)(pk2(k0, 0.f) & 0xffff); kd[64 + lane] = (bf16_t)(pk2(k1, 0.f) & 0xffff); kd[128 + lane] = (bf16_t)(pk2(k2, 0.f) & 0xffff);
        }
    }
}

__global__ void __launch_bounds__(NTHREADS, 2) fwd_kernel(Params p) {
    extern __shared__ __attribute__((aligned(16))) char lds[];
    cg::grid_group grid = cg::this_grid();
    char* ws = p.ws;
    const bf16_t* WB = (const bf16_t*)ws;
    const float* MOD = (const float*)(ws + T_MOD);
    float* H = (float*)(ws + OFF_H);
    bf16_t* Hb = (bf16_t*)(ws + OFF_H);
    bf16_t* A0 = (bf16_t*)(ws + OFF_A0);
    const int bid = blockIdx.x, nb = gridDim.x;
    const int vbid = virt_block();
    volatile LAS unsigned* xst = (volatile LAS unsigned*)(lds + (LDS_BYTES - 16));
    if (threadIdx.x == 0) { xst[0] = 0u; xst[1] = 0u; }
    __syncthreads();
    const XcdBarrier xb = xcd_barrier_post((unsigned*)(ws + T_BAR), xst);
    if (p.pad == 0x7fffffff) grid.sync();
#define GRID_SYNC() xcd_barrier(xb)

    { const int npair = p.jobs[4].tile0 >> 1, nit = 192 + 12 + npair;
      for (int it = bid; it < nit; it += nb) {
          if (it < 192) ada_item(lds, p, it);
          else if (it < 204) tables_item(p, it - 192);
          else { const int lt0 = (it - 204) * 2 + (int)(threadIdx.x >> 8); const bool live = lt0 < p.jobs[4].tile0; const int lt = live ? lt0 : 0; int j = 0;
#pragma unroll
              for (int q = 1; q < 11; ++q) if (lt >= p.jobs[q].tile0) j = q;
              transpose_tile(lds, ws, p.jobs[j], lt - p.jobs[j].tile0, live); } } }
    GRID_SYNC();
    modulate_rows(p, 0, 0, true, 0);
    s5_kk_phase(lds, p);
    GRID_SYNC();
    { EpiWin0 e{(bf16_t*)(ws + H_UA), (bf16_t*)(ws + S_CQN), (bf16_t*)(ws + S_CKVN), (float*)(ws + S_SSP), (float*)(ws + H_KR)};
      pg8::EpiHead<EpiWin0> pe{e}; pg8::gemm_phase((LAS unsigned char*)lds, pg8::Gemm{A0, WB + W_IN0, 1024, 1024}, pg8::Order{0, NR / 256, 5, (int)nb, vbid}, pe); }
    s5_w1a_phase(p);
    { int rk, nrk; slack_rank((NR / 256) * 5, rk, nrk); transpose_range(lds, ws, p, p.jobs[4].tile0, p.jobs[7].tile0, rk, nrk); }
    GRID_SYNC();
    s5_w1b_phase(p);
    { EpiS1a e{(float*)(ws + H_E)};
      (void)e; pg8::EpiS1a pe{(float*)(ws + H_E)}; pg8::gemm_phase((LAS unsigned char*)lds, pg8::Gemm{(const bf16_t*)(ws + H_UA), (const bf16_t*)(ws + H_W1A), 768, 512, (size_t)CHR * 768, (size_t)256 * 512}, pg8::Order{0, 3, 1, (int)nb, vbid, 32}, pe); }
    { int rk, nrk; slack_rank(96, rk, nrk); transpose_range(lds, ws, p, p.jobs[7].tile0, p.jobs[9].tile0, rk, nrk); }
    GRID_SYNC();
    s5_carry_phase(p);
    { EpiBf16 e{(bf16_t*)(ws + S_QRAW), 768, (const float*)(ws + S_SSP)};
      gemm_phase(lds, (const bf16_t*)(ws + S_CQN), 384, WB + W_QB, 384, 0, NR / 256, 3, e); }
    { EpiKV e{(bf16_t*)(ws + S_KNOPE), (bf16_t*)(ws + S_VT), (const float*)(ws + S_SSP)};
      gemm_phase(lds, (const bf16_t*)(ws + S_CKVN), 256, WB + W_KVB, 256, 0, NR / 256, 4, e, 1, 0, 0, 1, nb > 64 ? (int)nb - 16 : 0); }
    GRID_SYNC();
    { EpiS1b e{(bf16_t*)(ws + S_YG)};
      (void)e; pg8::EpiS1b pe{(bf16_t*)(ws + S_YG)}; pg8::gemm_phase((LAS unsigned char*)lds, pg8::Gemm{(const bf16_t*)(ws + H_UA), (const bf16_t*)(ws + A_W1B), 768, 768, (size_t)CHR * 768, (size_t)512 * 768}, pg8::Order{0, 3, 2, (int)nb, vbid, 32}, pe); }
    mla_prep_phase(p);
    GRID_SYNC();
    { const bf16_t* QR = (const bf16_t*)(ws + S_QRAW); const bf16_t* KA = (const bf16_t*)(ws + S_KA); const bf16_t* VT = (const bf16_t*)(ws + S_VT);
      const int nlat = 2 * 4 * 32, nall = nlat + 2 * 4;
      float mref; { float gq = 0.f, gk = 0.f;
        for (int d_ = 0; d_ < 192; ++d_) { gq = fmaxf(gq, fabsf(p.in[27][d_])); gk = fmaxf(gk, fabsf(p.in[28][d_])); }
        mref = 13.856406f * LOG2E * 1.02f * gq * gk; }
      for (int it0 = bid; it0 < nlat + nb; it0 += nb) {
          const int it = it0 < nlat ? it0 : nlat + (it0 - nlat) - (nb - 8);
          if (it0 >= nlat && (it < nlat || it >= nall)) continue;
          if (it < nlat) { const int h = it & 3, b = (it >> 2) & 1, qb = it >> 3;   const size_t row = NCTX + (size_t)b * SEQ + qb * 256;
              attn_item<192, 128, false>(lds, QR + row * 768 + h * 192, 768, KA + (size_t)(b * 4 + h) * TK * 192, VT + (size_t)(b * 4 + h) * 128 * TK, 0, TK / 64, 0, 0, mref, 0.f,
                                         A0 + row * 1024 + 512 + h * 128, 1024, 0); }
          else { const int j = it - nlat; const int h = j & 3, b = j >> 2; const size_t row = (size_t)b * CTX;
              attn_item<192, 128, false>(lds, QR + row * 768 + h * 192, 768, KA + (size_t)(b * 4 + h) * TK * 192, VT + (size_t)(b * 4 + h) * 128 * TK, 0, 4, 0, 0, mref, 0.f,
                                         A0 + row * 1024 + 512 + h * 128, 1024, 0); } }
      EpiGLU e{(const bf16_t*)(ws + S_YG), p.in[22], A0};
      gemm_phase(lds, (const bf16_t*)(ws + S_YG), 512, WB + W_GLU, 512, 0, NR / 256, 2, e); }
    GRID_SYNC();
    { EpiRes e{p.in[2], p.in[0], H, H + (size_t)NCTX * 1024, MOD + 0 * 3 * 6144 + 2048, 0};
      (void)e; { pg8::EpiRes pe{p.in[0], nullptr, Hb + (size_t)NCTX * 1024, nullptr, MOD + 0 * 3 * 6144 + 2048}; pg8::gemm_phase((LAS unsigned char*)lds, pg8::Gemm{A0, WB + W_OUT0, 1024, 1024}, pg8::Order{2, NLAT / 256, 4, (int)nb, vbid}, pe); }
      thin_gemm_ctx<4>(lds, A0, 1024, WB + W_OUT0, 1024, p.in[2], nullptr, Hb, MOD + 0 * 3 * 6144 + 2048); }
    GRID_SYNC();
    modulate_rows(p, 0, 1, false, 0);
    GRID_SYNC();
    { EpiSwiGLU e{(bf16_t*)(ws + S_HID)};
      (void)e; pg8::EpiSwiGLU pe{(bf16_t*)(ws + S_HID)}; pg8::gemm_phase((LAS unsigned char*)lds, pg8::Gemm{A0, WB + W_GU0, 1024, 1024}, pg8::Order{0, NR / 256, 22, (int)nb, vbid}, pe); }
    { int rk, nrk; slack_rank((NR / 256) * 22, rk, nrk); transpose_range(lds, ws, p, p.jobs[9].tile0, p.jobs[9].tile0 + 704, rk, nrk); }
    GRID_SYNC();
    { EpiRes e{H, H + (size_t)NCTX * 1024, H, H + (size_t)NCTX * 1024, MOD + 0 * 3 * 6144 + 5120, 0};
      (void)e; { pg8::EpiRes pe{nullptr, Hb + (size_t)NCTX * 1024, Hb + (size_t)NCTX * 1024, nullptr, MOD + 0 * 3 * 6144 + 5120}; pg8::gemm_phase((LAS unsigned char*)lds, pg8::Gemm{(const bf16_t*)(ws + S_HID), WB + W_D0, FH, FH}, pg8::Order{2, NLAT / 256, 4, (int)nb, vbid}, pe); }
      thin_gemm_ctx<11>(lds, (const bf16_t*)(ws + S_HID), FH, WB + W_D0, FH, nullptr, Hb, Hb, MOD + 0 * 3 * 6144 + 5120); }
    GRID_SYNC();
    modulate_rows(p, 1, 0, false, 0);
    GRID_SYNC();
    { EpiWin1 e{(bf16_t*)(ws + S1_Q), (bf16_t*)(ws + S1_K), (bf16_t*)(ws + S1_VT), p.in[31], p.in[32], (const float*)(ws + T_ROPE)};
      pg8::EpiHead<EpiWin1> pe{e}; pg8::gemm_phase((LAS unsigned char*)lds, pg8::Gemm{A0, WB + W_IN1, 1024, 1024}, pg8::Order{0, NR / 256, 6, (int)nb, vbid}, pe); }
    { int rk, nrk; slack_rank((NR / 256) * 6, rk, nrk); transpose_range(lds, ws, p, p.jobs[9].tile0 + 704, p.njobtiles, rk, nrk); }
    GRID_SYNC();
    { const bf16_t* Q = (const bf16_t*)(ws + S1_Q); const bf16_t* K1 = (const bf16_t*)(ws + S1_K); const bf16_t* VT = (const bf16_t*)(ws + S1_VT);
      constexpr int WNH = 2;
      const int nit = 2 * 4 * (4 / WNH) * 32;
      float mref; { float gq = 0.f, gk = 0.f;
        for (int d_ = 0; d_ < 64; ++d_) { gq = fmaxf(gq, fabsf(p.in[31][d_])); gk = fmaxf(gk, fabsf(p.in[32][d_])); }
        mref = 8.f * LOG2E * 1.02f * gq * gk; }
      for (int it = bid; it < nit; it += nb) { const int kvh = it & 3, b = (it >> 2) & 1, rest = it >> 3; const int gp = rest % (4 / WNH), i = rest / (4 / WNH); const int hq0 = kvh * 4 + gp * WNH;
          const size_t row = NCTX + (size_t)b * SEQ + i * 256;
          const int l0 = (4 * i - 2) < 0 ? 0 : (4 * i - 2), l1 = (4 * i + 6) > 128 ? 128 : (4 * i + 6);
          win_attn_item<WNH>(lds, Q + row * 1024 + hq0 * 64, K1 + (size_t)(b * 4 + kvh) * TK * 64, VT + (size_t)(b * 4 + kvh) * 64 * TK, 4 + l0, 4 + l1, mref, p.in[33] + hq0, A0 + row * 1024 + hq0 * 64, i * 256); } }
    GRID_SYNC();
    { EpiRes e{H, H + (size_t)NCTX * 1024, nullptr, H + (size_t)NCTX * 1024, MOD + 1 * 3 * 6144 + 2048, 0};
      (void)e; pg8::EpiRes pe{nullptr, Hb + (size_t)NCTX * 1024, Hb + (size_t)NCTX * 1024, nullptr, MOD + 1 * 3 * 6144 + 2048}; pg8::gemm_phase((LAS unsigned char*)lds, pg8::Gemm{A0, WB + W_OUT1, 1024, 1024}, pg8::Order{2, NLAT / 256, 4, (int)nb, vbid}, pe); }
    GRID_SYNC();
    modulate_rows(p, 1, 1, false, NCTX);
    GRID_SYNC();
    { EpiSwiGLU e{(bf16_t*)(ws + S_HID)};
      (void)e; pg8::EpiSwiGLU pe{(bf16_t*)(ws + S_HID)}; pg8::gemm_phase((LAS unsigned char*)lds, pg8::Gemm{A0, WB + W_GU1, 1024, 1024}, pg8::Order{2, NLAT / 256, 22, (int)nb, vbid}, pe); }
    GRID_SYNC();
    { EpiRes e{H, H + (size_t)NCTX * 1024, nullptr, p.out, MOD + 1 * 3 * 6144 + 5120, 0};
      (void)e; pg8::EpiRes pe{nullptr, Hb + (size_t)NCTX * 1024, nullptr, p.out, MOD + 1 * 3 * 6144 + 5120}; pg8::gemm_phase((LAS unsigned char*)lds, pg8::Gemm{(const bf16_t*)(ws + S_HID), WB + W_D1, FH, FH}, pg8::Order{2, NLAT / 256, 4, (int)nb, vbid}, pe); }
}

extern "C" void kernel_launch(void* const* d_in, const int* in_sizes, int n_in, void* d_out, int out_size, void* d_ws, size_t ws_size, hipStream_t stream) {
    static int grid_blocks = 0;
    if (grid_blocks == 0) {
        if (n_in != 34 || ws_size < WS_NEED2) { fprintf(stderr, "kernel_launch: unexpected n_in %d / ws %zu (need %zu)\n", n_in, ws_size, (size_t)WS_NEED2); grid_blocks = -1; return; }
        int dev = 0, cus = 0, per_cu = 0;
        (void)hipGetDevice(&dev);
        (void)hipDeviceGetAttribute(&cus, hipDeviceAttributeMultiprocessorCount, dev);
        (void)hipFuncSetAttribute((const void*)fwd_kernel, hipFuncAttributeMaxDynamicSharedMemorySize, LDS_BYTES);
        (void)hipOccupancyMaxActiveBlocksPerMultiprocessor(&per_cu, (const void*)fwd_kernel, NTHREADS, LDS_BYTES);
        if (per_cu < 1) { fprintf(stderr, "kernel_launch: occupancy query returned %d\n", per_cu); grid_blocks = -1; return; }
        if (per_cu > 1) per_cu = 1;
        grid_blocks = cus * per_cu;
        fprintf(stderr, "kernel_launch: grid %d (%d CUs x %d)\n", grid_blocks, cus, per_cu);
    }
    if (grid_blocks < 0) return;
    Params p{};
    for (int i = 0; i < 34; ++i) p.in[i] = (const float*)d_in[i];
    p.out = (float*)d_out; p.ws = (char*)d_ws;
    const float* fg = p.in[8]; const float* fu = p.in[9]; const float* fd = p.in[10];
    const size_t FW = (size_t)1024 * FH;
    int t0 = 0;
    auto mk = [&](int idx, const float* a, const float* b, size_t dst, int K, int ld, int npad, int mode) {
        Job& j = p.jobs[idx]; j.a = a; j.b = b; j.ks = nullptr; j.dst = dst; j.K = K; j.ld = ld; j.ntk = K / 64; j.ntn = npad / 64; j.tile0 = t0; j.mode = mode; t0 += j.ntk * j.ntn; };
    mk(0, p.in[11], nullptr, W_IN0, 1024, 1216, 1280, 2);
    mk(1, p.in[24], nullptr, W_QB, 384, 768, 768, 0);
    mk(2, p.in[26], nullptr, W_KVB, 256, 1024, 1024, 0);
    p.jobs[1].ks = p.in[23]; p.jobs[2].ks = p.in[25];
    mk(3, p.in[21], nullptr, W_GLU, 512, 512, 512, 0);
    mk(4, p.in[12], nullptr, W_OUT0, 1024, 1024, 1024, 0);
    mk(5, fg, fu, W_GU0, 1024, FH, 5632, 1);
    mk(6, fd, nullptr, W_D0, FH, 1024, 1024, 0);
    mk(7, p.in[29], nullptr, W_IN1, 1024, 1536, 1536, 2);
    mk(8, p.in[30], nullptr, W_OUT1, 1024, 1024, 1024, 0);
    mk(9, fg + FW, fu + FW, W_GU1, 1024, FH, 5632, 1);
    mk(10, fd + FW, nullptr, W_D1, FH, 1024, 1024, 0);
    p.njobtiles = t0;
    if (hipMemsetAsync((char*)d_ws + T_BAR, 0, XCD_BAR_WORDS * 4, stream) != hipSuccess) { fprintf(stderr, "kernel_launch: memset failed\n"); return; }
    void* args[] = {&p};
    hipError_t e = hipLaunchCooperativeKernel((const void*)fwd_kernel, dim3(grid_blocks), dim3(NTHREADS), args, LDS_BYTES, stream);
    if (e != hipSuccess) fprintf(stderr, "cooperative launch failed: %s (grid %d)\n", hipGetErrorString(e), grid_blocks);
}
```

```cpp
#include <hip/hip_runtime.h>
#include <hip/hip_cooperative_groups.h>
#include <cstdio>
#include <cstdint>
namespace cg = cooperative_groups;

#define DI __device__ __forceinline__
typedef unsigned short bf16_t;
typedef short bf16x8 __attribute__((ext_vector_type(8)));
typedef short s16x4 __attribute__((ext_vector_type(4)));
typedef float f32x4 __attribute__((ext_vector_type(4)));
typedef float f32x2 __attribute__((ext_vector_type(2)));
typedef float f32x16 __attribute__((ext_vector_type(16)));
typedef unsigned u32x4 __attribute__((ext_vector_type(4)));
typedef unsigned u32x2 __attribute__((ext_vector_type(2)));
typedef __bf16 bf16v2 __attribute__((ext_vector_type(2)));

constexpr int DM = 1024, NBATCH = 2, SEQ = 8192, CTX = 256;
constexpr int NCTX = NBATCH * CTX;
constexpr int NLAT = NBATCH * SEQ;
constexpr int NR = NCTX + NLAT;
constexpr int TK = CTX + SEQ;
constexpr int FH = 2816;
constexpr int NCH = TK / 64;
constexpr float LOG2E = 1.4426950408889634f;
constexpr int LDS_BYTES = 131072 + 64;
constexpr int NTHREADS = 512, NWV = 8;

constexpr size_t W_IN0 = 0;
constexpr size_t W_QB = W_IN0 + (size_t)1280 * 1024;
constexpr size_t W_KVB = W_QB + (size_t)768 * 384;
constexpr size_t W_GLU = W_KVB + (size_t)1024 * 256;
constexpr size_t W_OUT0 = W_GLU + (size_t)512 * 512;
constexpr size_t W_GU0 = W_OUT0 + (size_t)1024 * 1024;
constexpr size_t W_D0 = W_GU0 + (size_t)5632 * 1024;
constexpr size_t W_IN1 = W_D0 + (size_t)1024 * 2816;
constexpr size_t W_OUT1 = W_IN1 + (size_t)1536 * 1024;
constexpr size_t W_GU1 = W_OUT1 + (size_t)1024 * 1024;
constexpr size_t W_D1 = W_GU1 + (size_t)5632 * 1024;
constexpr size_t W_END = W_D1 + (size_t)1024 * 2816;
constexpr size_t OFF_TAB = W_END * 2;
constexpr size_t T_MOD = OFF_TAB;
constexpr size_t T_ROPE = T_MOD + 2 * 3 * 6144 * 4;
constexpr size_t T_LAMB = T_ROPE + 128 * 16 * 2 * 4;
constexpr size_t T_LAM64 = T_LAMB + 2 * 32 * 64 * 8;
constexpr size_t T_BBAR = T_LAM64 + 2 * 32 * 64 * 8;
constexpr size_t T_BAR = T_BBAR + (size_t)2 * 32 * 64 * 16 * 8;
constexpr size_t OFF_H = OFF_TAB + (1u << 20);
constexpr size_t OFF_A0 = OFF_H + (size_t)NR * 1024 * 4;
constexpr size_t OFF_S = OFF_A0 + (size_t)NR * 1024 * 2;
constexpr size_t WS_NEED = OFF_S + (size_t)108134400;
constexpr size_t S_SSP = WS_NEED;
constexpr size_t WS_NEED2 = S_SSP + (size_t)NR * 10 * 4;
static_assert(WS_NEED2 <= ((size_t)256 << 20) && OFF_S + (size_t)NR * FH * 2 <= WS_NEED, "workspace");
constexpr int SL = 32;
constexpr int NCK = TK / SL;
constexpr int CHR = NBATCH * NCK;
constexpr size_t H_UA = OFF_H;
constexpr size_t H_KR = H_UA + (size_t)(32 * CHR + 256) * 768 * 2;
constexpr size_t H_E = H_KR + (size_t)NR * 64 * 4;
constexpr size_t H_KK = H_E + (size_t)32 * CHR * 256 * 4;
constexpr size_t H_POW = H_KK + (size_t)32 * 2 * 32 * 256 * 4;
constexpr size_t H_W1A = H_POW + (size_t)4096 * 33 * 8;
static_assert(H_W1A + (size_t)32 * 256 * 512 * 2 <= OFF_A0, "H region overflow");
constexpr size_t A_W1B = OFF_A0;
constexpr size_t S_CQN = OFF_S;
constexpr size_t S_CKVN = S_CQN + (size_t)NR * 384 * 2;
constexpr size_t S_YG = OFF_S;
constexpr size_t S_X = S_CKVN + (size_t)NR * 256 * 2;
constexpr size_t S_CQKV = S_X;
constexpr size_t S_QRAW = S_X;
constexpr size_t S_KNOPE = S_QRAW + (size_t)NR * 768 * 2;
constexpr size_t S_VT = S_KNOPE + (size_t)NR * 512 * 2;
constexpr size_t S_KA = S_VT + (size_t)2 * 4 * 128 * TK * 2;
static_assert(S_CQKV + (size_t)NR * 640 * 4 <= S_VT, "CQKV overlaps VT");
static_assert(S_KA + (size_t)2 * 4 * TK * 192 * 2 <= WS_NEED, "scratch overflow");
constexpr size_t S_HID = OFF_S;
constexpr size_t S1_Q = OFF_S;
constexpr size_t S1_KRAW = S1_Q + (size_t)NR * 1024 * 2;
constexpr size_t S1_K = S1_KRAW + (size_t)NR * 256 * 4;
constexpr size_t S1_VT = S1_K + (size_t)2 * 4 * TK * 64 * 2;

struct Job { const float* a; const float* b; const float* ks; unsigned long long dst; int K, ld, ntk, ntn, tile0, mode; };
struct Params {
    const float* in[34];
    float* out;
    char* ws;
    Job jobs[11];
    int njobtiles;
    int pad;
};

DI int get_tid() { int t = threadIdx.x; asm volatile("" : "+v"(t)); return t; }
DI unsigned pk2(float lo, float hi) { f32x2 v = {lo, hi}; return __builtin_bit_cast(unsigned, __builtin_convertvector(v, bf16v2)); }
DI float bf2f(unsigned short b) { return __uint_as_float(((unsigned)b) << 16); }
DI f32x4 ld_bf4(const bf16_t* q) { const u32x2 w = *(const u32x2*)q; return (f32x4){__uint_as_float(w[0] << 16), __uint_as_float(w[0] & 0xffff0000u), __uint_as_float(w[1] << 16), __uint_as_float(w[1] & 0xffff0000u)}; }
DI void st_bf4(bf16_t* q, f32x4 v) { *(u32x2*)q = (u32x2){pk2(v[0], v[1]), pk2(v[2], v[3])}; }
DI float wave_sum(float v) {
#pragma unroll
    for (int o = 32; o > 0; o >>= 1) v += __shfl_xor(v, o);
    return v;
}
DI int row_vec(int r) { return r < NCTX ? 2 : (r - NCTX) / SEQ; }
DI int row_batch(int r) { return r < NCTX ? r / CTX : (r - NCTX) / SEQ; }
DI int row_tpos(int r) { return r < NCTX ? r % CTX : CTX + (r - NCTX) % SEQ; }
DI float sigmoidf_(float x) { return __builtin_amdgcn_rcpf(1.f + __expf(-x)); }
DI float siluf_(float x) { return x * __builtin_amdgcn_rcpf(1.f + __expf(-x)); }
DI float gelu_tanh(float y) { const float z = 0.7978845608028654f * (y + 0.044715f * y * y * y); const float t = 1.f - 2.f * __builtin_amdgcn_rcpf(1.f + __expf(2.f * z)); return 0.5f * y * (1.f + t); }
DI void my_sincos(float x, float& s, float& c) {
    const float q = rintf(x * 0.636619772367581f);
    float r = fmaf(-q, 1.5703125f, x);
    r = fmaf(-q, 4.837512969970703125e-4f, r);
    r = fmaf(-q, 7.54978995489188216e-8f, r);
    const int qi = (int)q;
    const float r2 = r * r;
    const float sp = r + r * r2 * (-1.6666654611e-1f + r2 * (8.3321608736e-3f + r2 * (-1.9515295891e-4f)));
    const float cp = 1.0f - 0.5f * r2 + r2 * r2 * (4.166664568298827e-2f + r2 * (-1.388731625493765e-3f + r2 * 2.443315711809948e-5f));
    const int k = qi & 3;
    s = (k == 0) ? sp : (k == 1) ? cp : (k == 2) ? -sp : -cp;
    c = (k == 0) ? cp : (k == 1) ? -sp : (k == 2) ? -cp : sp;
}


#define XB_TMO      128
#define XB_XCNT(j)  (256  + 64 * (j))
#define XB_XSUB(j)  (1280 + 64 * (j))
#define XB_XGEN(j)  (2304 + 64 * (j))
#define XB_TOP      3328
#define XB_TOPGEN   3392
#define XCD_BAR_WORDS 3456
#define XB_SPIN_CAP (1u << 22)
#define LAS __attribute__((address_space(3)))
DI unsigned xb_ld(unsigned* p) { return __hip_atomic_load(p, __ATOMIC_RELAXED, __HIP_MEMORY_SCOPE_AGENT); }
DI unsigned xb_add(unsigned* p, unsigned v) { return __hip_atomic_fetch_add(p, v, __ATOMIC_RELAXED, __HIP_MEMORY_SCOPE_AGENT); }
DI unsigned xb_xcc_id() { return (unsigned)__builtin_amdgcn_s_getreg((3 << 11) | 20) & 0xFu; }
#define XB_SPIN(cond, bar) do { unsigned _sp = 0; while (cond) { __builtin_amdgcn_s_sleep(1); \
    if ((++_sp & 255u) == 0u) { if (xb_ld(&(bar)[XB_TMO])) break; if (_sp > XB_SPIN_CAP) { atomicAdd(&(bar)[XB_TMO], 1u); break; } } } } while (0)
struct XcdBarrier { unsigned* bar; unsigned x; volatile LAS unsigned* st; };
DI XcdBarrier xcd_barrier_post(unsigned* bar, volatile LAS unsigned* st) {
    XcdBarrier b; b.bar = bar; b.x = xb_xcc_id(); b.st = st;
    if (threadIdx.x == 0) (void)xb_add(&bar[XB_XCNT(b.x)], 1u);
    return b;
}
DI void xcd_barrier_complete(unsigned* bar, unsigned x, unsigned& nloc, unsigned& nx) {
    const unsigned G = gridDim.x * gridDim.y * gridDim.z;
    unsigned sum, cnt, mine, sp = 0u;
    for (;;) {
        sum = 0u; cnt = 0u; mine = 0u;
#pragma unroll
        for (unsigned j = 0; j < 16; ++j) { const unsigned c = xb_ld(&bar[XB_XCNT(j)]); sum += c; cnt += (c > 0u) ? 1u : 0u; mine = (j == x) ? c : mine; }
        if (sum == G) break;
        __builtin_amdgcn_s_sleep(1);
        if ((++sp & 255u) == 0u) { if (xb_ld(&bar[XB_TMO])) break; if (sp > XB_SPIN_CAP) { atomicAdd(&bar[XB_TMO], 1u); break; } }
    }
    nloc = mine > 0u ? mine : 1u; nx = cnt > 0u ? cnt : 1u;
}
DI void xcd_barrier(const XcdBarrier& b) {
    asm volatile("s_waitcnt vmcnt(0)" ::: "memory");
    __syncthreads();
    if (threadIdx.x == 0) {
        unsigned* bar = b.bar;
        __builtin_amdgcn_s_waitcnt(0);
        unsigned nloc = b.st[0], nx = b.st[1];
        if (nloc == 0u) { xcd_barrier_complete(bar, b.x, nloc, nx); b.st[0] = nloc; b.st[1] = nx; }
        const unsigned old = xb_add(&bar[XB_XSUB(b.x)], 1u);
        const unsigned gen = old / nloc;
        if (old + 1u == (gen + 1u) * nloc) {
            __builtin_amdgcn_fence(__ATOMIC_RELEASE, "agent");
            asm volatile("s_waitcnt vmcnt(0)" ::: "memory");
            const unsigned og = xb_add(&bar[XB_TOP], 1u);
            const unsigned tg = og / nx;
            if (og + 1u == (tg + 1u) * nx) xb_add(&bar[XB_TOPGEN], 1u);
            else XB_SPIN(xb_ld(&bar[XB_TOPGEN]) == tg, bar);
            __builtin_amdgcn_fence(__ATOMIC_ACQUIRE, "agent");
            xb_add(&bar[XB_XGEN(b.x)], 1u);
            asm volatile("s_waitcnt vmcnt(0)" ::: "memory");
        } else {
            XB_SPIN(xb_ld(&bar[XB_XGEN(b.x)]) == gen, bar);
            __builtin_amdgcn_fence(__ATOMIC_ACQUIRE, "agent");
            asm volatile("s_waitcnt vmcnt(0)" ::: "memory");
        }
    }
    __syncthreads();
}

DI void transpose_tile(char* lds, char* ws, const Job& jb, int lt, bool live) {
    const int tid512 = get_tid(); const int tid = tid512 & 255;
    float (*tile)[65] = (float (*)[65])(lds + (tid512 >> 8) * 17408);
    const int tk = lt % jb.ntk, tn = lt / jb.ntk;
    const int k0 = tk * 64, n0 = tn * 64;
    const int c4 = (tid & 15) * 4, rq = tid >> 4;
    const float* src; int col; bool valid = live;
    if (jb.mode == 0) { src = jb.a; col = n0 + c4; valid = live && col < jb.ld; }
    else if (jb.mode == 2) { src = jb.a; const int rho = (n0 + c4) & 255; col = (n0 + c4 - rho) + 64 * ((rho >> 5) & 3) + 32 * (rho >> 7) + (rho & 31); valid = live && col < jb.ld; }
    else { const int nsub = c4 >> 4, i = c4 & 15; src = (nsub & 1) ? jb.b : jb.a; col = tn * 32 + (nsub >> 1) * 16 + i; }
#pragma unroll
    for (int kk = 0; kk < 4; ++kk) { const int k = kk * 16 + rq; f32x4 v = valid ? __builtin_nontemporal_load((const f32x4*)(src + (size_t)(k0 + k) * jb.ld + col)) : (f32x4){0.f, 0.f, 0.f, 0.f};
        if (jb.ks) v = v * jb.ks[k0 + k];
        tile[k][c4] = v[0]; tile[k][c4 + 1] = v[1]; tile[k][c4 + 2] = v[2]; tile[k][c4 + 3] = v[3]; }
    __syncthreads();
    const int r = tid >> 2, ks = (tid & 3) * 16;
    unsigned w[8];
#pragma unroll
    for (int q = 0; q < 8; ++q) w[q] = pk2(tile[ks + 2 * q][r], tile[ks + 2 * q + 1][r]);
    bf16_t* d = (bf16_t*)(ws) + jb.dst + (size_t)(n0 + r) * jb.K + k0 + ks;
    if (live) { *(u32x4*)d = (u32x4){w[0], w[1], w[2], w[3]};
    *(u32x4*)(d + 8) = (u32x4){w[4], w[5], w[6], w[7]}; }
    __syncthreads();
}

DI void transpose_range(char* lds, char* ws, const Params& p, int t_begin, int t_end, int rank, int nranks) {
    if (rank < 0) return;
    for (int pr = (t_begin >> 1) + rank; pr < (t_end >> 1); pr += nranks) {
        const int lt = pr * 2 + (int)(threadIdx.x >> 8); int j = 0;
#pragma unroll
        for (int q = 1; q < 11; ++q) if (lt >= p.jobs[q].tile0) j = q;
        transpose_tile(lds, ws, p.jobs[j], lt - p.jobs[j].tile0, true);
    }
}
DI int virt_block() { const int G_ = gridDim.x; return ((G_ & 7) == 0) ? (int)(blockIdx.x & 7) * (G_ >> 3) + (int)(blockIdx.x >> 3) : (int)blockIdx.x; }
DI void slack_rank(int ntile, int& rank, int& nranks) { const int rem = ntile % (int)gridDim.x; const int vb = virt_block(); if (rem == 0) { rank = vb; nranks = gridDim.x; } else { rank = vb - rem; nranks = (int)gridDim.x - rem; } }

DI void ada_item(char* lds, const Params& p, int it) {
    float* sil = (float*)lds;
    float* red = sil + 3072;
    float* MOD = (float*)(p.ws + T_MOD);
    const int tid = get_tid(), layer = it / 96, n0 = (it % 96) * 64;
    for (int i = tid; i < 3072; i += NTHREADS) { const int v = i >> 10, k = i & 1023; const float x = v < 2 ? p.in[1][v * 1024 + k] : p.in[3][k]; sil[i] = siluf_(x); }
    __syncthreads();
    const int j4 = (tid & 15) * 4, kg = tid >> 4;
    const float* W = p.in[4] + (size_t)layer * 1024 * 6144 + n0 + j4;
    f32x4 a0 = {0.f, 0.f, 0.f, 0.f}, a1 = a0, a2 = a0;
#pragma unroll 8
    for (int k = kg * 32; k < kg * 32 + 32; ++k) { const f32x4 w = __builtin_nontemporal_load((const f32x4*)(W + (size_t)k * 6144)); a0 += sil[k] * w; a1 += sil[1024 + k] * w; a2 += sil[2048 + k] * w; }
    *(f32x4*)(red + (kg * 3 + 0) * 64 + j4) = a0; *(f32x4*)(red + (kg * 3 + 1) * 64 + j4) = a1; *(f32x4*)(red + (kg * 3 + 2) * 64 + j4) = a2;
    __syncthreads();
    if (tid < 192) { const int v = tid >> 6, jj = tid & 63;
        float s = p.in[5][layer * 6144 + n0 + jj];
#pragma unroll 8
        for (int q = 0; q < 32; ++q) s += red[(q * 3 + v) * 64 + jj];
        MOD[(layer * 3 + v) * 6144 + n0 + jj] = s; }
    __syncthreads();
}

DI void tables_item(const Params& p, int it) {
    const int tid = get_tid();
    if (it < 4) {
        const int e = it * 512 + tid, pos = e >> 4, i = e & 15;
        const float inv = exp2f(-(float)i * (13.287712379549449f / 16.f));
        float s, c; my_sincos((float)pos * inv, s, c);
        float* ROPE = (float*)(p.ws + T_ROPE); ROPE[e * 2] = c; ROPE[e * 2 + 1] = s;
    } else {
        const int e = (it - 4) * 512 + tid;
        const int dg = e >> 6;
        const float lr = p.in[13][e], li = p.in[14][e], step = expf(p.in[15][dg]);
        const float a = lr * step, b = li * step;
        const float ea = expf(a);
        float sb, cb; my_sincos(b, sb, cb);
        float sh, ch; my_sincos(0.5f * b, sh, ch);
        const float em1 = a * (1.f + a * 0.5f * (1.f + a * (1.f / 3.f) * (1.f + a * 0.25f * (1.f + a * 0.2f * (1.f + a * (1.f / 6.f))))));
        const float lbr = ea * cb, lbi = ea * sb;
        const float nr = em1 * cb - 2.f * sh * sh, ni = ea * sb;
        const float den = lr * lr + li * li;
        const float qr = (nr * lr + ni * li) / den, qi = (ni * lr - nr * li) / den;
        f32x2* BB = (f32x2*)(p.ws + T_BBAR);
#pragma unroll
        for (int s = 0; s < 16; ++s) { const float br = p.in[16][e * 16 + s], bi = p.in[17][e * 16 + s]; BB[e * 16 + s] = (f32x2){qr * br - qi * bi, qr * bi + qi * br}; }
        f32x2* POW = (f32x2*)(p.ws + H_POW) + (size_t)dg * 33 * 64 + (e & 63);
        float pr = 1.f, pi = 0.f;
        for (int q = 0; q <= 32; ++q) { POW[q * 64] = (f32x2){pr, pi}; const float nr2 = pr * lbr - pi * lbi, ni2 = pr * lbi + pi * lbr; pr = nr2; pi = ni2; }
    }
}

DI void modulate_rows(const Params& p, int layer, int which, bool from_inputs, int r0) {
    const int tid_ = get_tid(); const int lane = tid_ & 63, wid = tid_ >> 6;
    const float* gain = p.in[which ? 7 : 6] + layer * 1024;
    const float* modl = (const float*)(p.ws + T_MOD) + layer * 3 * 6144 + (which ? 3072 : 0);
    const bf16_t* Hb = (const bf16_t*)(p.ws + OFF_H);
    bf16_t* dst = (bf16_t*)(p.ws + OFF_A0);
    const int stride = gridDim.x * NWV;
    for (int ra = r0 + blockIdx.x * NWV + wid; ra < NR; ra += 2 * stride) {
        const int rb = ra + stride; const bool hb = rb < NR; const int rbb = hb ? rb : ra;
        const float* srca = ra < NCTX ? p.in[2] + (size_t)ra * 1024 : p.in[0] + (size_t)(ra - NCTX) * 1024;
        const float* srcb = rbb < NCTX ? p.in[2] + (size_t)rbb * 1024 : p.in[0] + (size_t)(rbb - NCTX) * 1024;
        f32x4 xa[4], xb[4]; float sa = 0.f, sb = 0.f;
#pragma unroll
        for (int i = 0; i < 4; ++i) { if (from_inputs) { xa[i] = __builtin_nontemporal_load((const f32x4*)(srca + i * 256 + lane * 4)); xb[i] = __builtin_nontemporal_load((const f32x4*)(srcb + i * 256 + lane * 4)); }
                                      else { xa[i] = ld_bf4(Hb + (size_t)ra * 1024 + i * 256 + lane * 4); xb[i] = ld_bf4(Hb + (size_t)rbb * 1024 + i * 256 + lane * 4); } }
#pragma unroll
        for (int i = 0; i < 4; ++i) { sa += xa[i][0] * xa[i][0] + xa[i][1] * xa[i][1] + xa[i][2] * xa[i][2] + xa[i][3] * xa[i][3];
                                      sb += xb[i][0] * xb[i][0] + xb[i][1] * xb[i][1] + xb[i][2] * xb[i][2] + xb[i][3] * xb[i][3]; }
        sa = wave_sum(sa); sb = wave_sum(sb);
        const float rsa = rsqrtf(sa * (1.f / 1024.f) + 1e-6f), rsb = rsqrtf(sb * (1.f / 1024.f) + 1e-6f);
        const float* mva = modl + row_vec(ra) * 6144; const float* mvb = modl + row_vec(rbb) * 6144;
#pragma unroll
        for (int i = 0; i < 4; ++i) { const int c = i * 256 + lane * 4;
            const f32x4 g = *(const f32x4*)(gain + c);
            { const f32x4 sh = *(const f32x4*)(mva + c), sc = *(const f32x4*)(mva + 1024 + c); const f32x4 y = xa[i] * rsa * g * (1.f + sc) + sh;
              *(u32x2*)(dst + (size_t)ra * 1024 + c) = (u32x2){pk2(y[0], y[1]), pk2(y[2], y[3])}; }
            if (hb) { const f32x4 sh = *(const f32x4*)(mvb + c), sc = *(const f32x4*)(mvb + 1024 + c); const f32x4 y = xb[i] * rsb * g * (1.f + sc) + sh;
              *(u32x2*)(dst + (size_t)rb * 1024 + c) = (u32x2){pk2(y[0], y[1]), pk2(y[2], y[3])}; } }
    }
}

template <class Epi>
DI void gemm_phase(char* lds, const bf16_t* A0_, int lda, const bf16_t* Bt0_, int K, int mt0, int nmt, int nnt, const Epi& epi, int nbatch = 1, size_t sA = 0, size_t sB = 0, int ksplit = 1, int gact = 0) {
    const int tid = get_tid(), lane = tid & 63, wid = tid >> 6, wr = wid >> 2, wc = wid & 3, fr = lane & 15, fq = lane >> 4;
    const int nk = (K >> 6) / ksplit;
    const int lrow = tid >> 3, lc = tid & 7, lkc = lc * 8;
    const int woff = lrow * 128 + ((lc ^ ((lrow >> 1) & 7)) << 4);
    const int ra0 = (wr * 128 + fr) * 128 + ((fq ^ (fr >> 1)) << 4);
    const int ra1 = (wr * 128 + fr) * 128 + (((4 + fq) ^ (fr >> 1)) << 4);
    const int rb0 = 32768 + (wc * 64 + fr) * 128 + ((fq ^ (fr >> 1)) << 4);
    const int rb1 = 32768 + (wc * 64 + fr) * 128 + (((4 + fq) ^ (fr >> 1)) << 4);
    const int per = nmt * nnt, ntile = nbatch * per * ksplit;
    const int PM = nnt >= 8 ? 4 : 8;
    const int GA = gact > 0 ? gact : (int)gridDim.x;
    const int myn = ((int)blockIdx.x < GA && (int)blockIdx.x < ntile) ? (ntile - (int)blockIdx.x + GA - 1) / GA : 0;
    const int total = myn * nk;
    f32x4 acc[8][4];
#pragma unroll
    for (int m = 0; m < 8; ++m)
#pragma unroll
        for (int n = 0; n < 4; ++n) acc[m][n] = (f32x4){0.f, 0.f, 0.f, 0.f};
    int iti = 0, ikt = 0;
    const int srow = wid * 32 + (lane >> 3);
    const bf16_t* Ag = A0_; const bf16_t* Bg = Bt0_;
#define G_STAGE(bufoff) do { if (ikt == 0) { const int u_ = blockIdx.x + iti * GA; const int t_ = u_ / ksplit, sl_ = u_ - t_ * ksplit; const int gb_ = t_ / per, tr_ = t_ - gb_ * per; const int ch_ = tr_ / (PM * nnt), rm_ = tr_ - ch_ * PM * nnt; const int pc_ = (nmt - ch_ * PM) < PM ? (nmt - ch_ * PM) : PM; const int tn_ = rm_ / pc_, tm_ = ch_ * PM + (rm_ - tn_ * pc_); \
            Ag = A0_ + (size_t)gb_ * sA + (size_t)((mt0 + tm_) * 256) * lda + sl_ * nk * 64; Bg = Bt0_ + (size_t)gb_ * sB + (size_t)(tn_ * 256) * K + sl_ * nk * 64; } \
        _Pragma("unroll") for (int i = 0; i < 4; ++i) { const int row_ = srow + 8 * i; const int c_ = ((lane & 7) ^ ((row_ >> 1) & 7)) * 8; \
            __builtin_amdgcn_global_load_lds((const unsigned*)(Ag + (size_t)row_ * lda + ikt * 64 + c_), (LAS unsigned*)(lds + (bufoff) + (wid * 4 + i) * 1024), 16, 0, 0); \
            __builtin_amdgcn_global_load_lds((const unsigned*)(Bg + (size_t)row_ * K + ikt * 64 + c_), (LAS unsigned*)(lds + (bufoff) + 32768 + (wid * 4 + i) * 1024), 16, 0, 0); } \
        if (++ikt == nk) { ikt = 0; ++iti; } } while (0)
#define G_COMPUTE(bufoff) do { _Pragma("unroll") for (int ks = 0; ks < 2; ++ks) { bf16x8 a[8], b[4]; \
        _Pragma("unroll") for (int m = 0; m < 8; ++m) a[m] = *(const bf16x8*)(lds + (bufoff) + (ks ? ra1 : ra0) + m * 2048); \
        _Pragma("unroll") for (int n = 0; n < 4; ++n) b[n] = *(const bf16x8*)(lds + (bufoff) + (ks ? rb1 : rb0) + n * 2048); \
        _Pragma("unroll") for (int m = 0; m < 8; ++m) _Pragma("unroll") for (int n = 0; n < 4; ++n) acc[m][n] = __builtin_amdgcn_mfma_f32_16x16x32_bf16(b[n], a[m], acc[m][n], 0, 0, 0); } } while (0)
    __syncthreads();
    if (total > 0) G_STAGE(0);
    asm volatile("s_waitcnt vmcnt(0)" ::: "memory");
    __syncthreads();
    int cti = 0, ckt = 0;
    for (int q = 0; q < total; ++q) {
        const int cur = (q & 1) * 65536;
        if (q + 1 < total) G_STAGE(cur ^ 65536);
        G_COMPUTE(cur);
        asm volatile("s_waitcnt vmcnt(0)" ::: "memory");
        __syncthreads();
        if (++ckt == nk) {
            const int u_ = blockIdx.x + cti * GA; const int t_ = u_ / ksplit; const int gb_ = t_ / per, tr_ = t_ - gb_ * per; const int ch_ = tr_ / (PM * nnt), rm_ = tr_ - ch_ * PM * nnt; const int pc_ = (nmt - ch_ * PM) < PM ? (nmt - ch_ * PM) : PM; const int tn_ = rm_ / pc_, tm_ = ch_ * PM + (rm_ - tn_ * pc_);
            epi(acc, (mt0 + tm_) * 256 + wr * 128 + fr, tn_ * 256 + wc * 64 + fq * 4, gb_);
#pragma unroll
            for (int m = 0; m < 8; ++m)
#pragma unroll
                for (int n = 0; n < 4; ++n) acc[m][n] = (f32x4){0.f, 0.f, 0.f, 0.f};
            ckt = 0; ++cti;
        }
    }
#undef G_STAGE
#undef G_COMPUTE
}

template <int KSP>
DI void thin_gemm_ctx(char* lds, const bf16_t* A, int lda, const bf16_t* Bt, int K, const float* res_f, const bf16_t* res_h, bf16_t* dst, const float* gate) {
    const int tid = get_tid(), lane = tid & 63, wid = tid >> 6, fr = lane & 15, fq = lane >> 4;
    float* part = (float*)lds;
    for (int t = blockIdx.x; t < 256; t += gridDim.x) {
        const int m0 = (t >> 5) * 64, n0 = (t & 31) * 32;
        f32x4 acc[4][2];
#pragma unroll
        for (int m = 0; m < 4; ++m) { acc[m][0] = (f32x4){0.f, 0.f, 0.f, 0.f}; acc[m][1] = (f32x4){0.f, 0.f, 0.f, 0.f}; }
        const bf16_t* Ap = A + (size_t)(m0 + fr) * lda + wid * (KSP * 32) + fq * 8;
        const bf16_t* Bp = Bt + (size_t)(n0 + fr) * K + wid * (KSP * 32) + fq * 8;
#pragma unroll
        for (int k = 0; k < KSP; ++k) {
            bf16x8 a[4], b[2];
#pragma unroll
            for (int m = 0; m < 4; ++m) a[m] = *(const bf16x8*)(Ap + (size_t)m * 16 * lda + k * 32);
#pragma unroll
            for (int n = 0; n < 2; ++n) b[n] = *(const bf16x8*)(Bp + (size_t)n * 16 * K + k * 32);
#pragma unroll
            for (int m = 0; m < 4; ++m)
#pragma unroll
                for (int n = 0; n < 2; ++n) acc[m][n] = __builtin_amdgcn_mfma_f32_16x16x32_bf16(b[n], a[m], acc[m][n], 0, 0, 0);
        }
        __syncthreads();
#pragma unroll
        for (int m = 0; m < 4; ++m)
#pragma unroll
            for (int n = 0; n < 2; ++n) *(f32x4*)(part + ((wid * 64 + m * 16 + fr) * 32 + n * 16 + fq * 4)) = acc[m][n];
        __syncthreads();
        { const int row = tid >> 3, c4 = (tid & 7) * 4; f32x4 sum = (f32x4){0.f, 0.f, 0.f, 0.f};
#pragma unroll
          for (int w = 0; w < 8; ++w) sum += *(const f32x4*)(part + ((w * 64 + row) * 32 + c4));
          const size_t off = (size_t)(m0 + row) * 1024 + n0 + c4;
          const f32x4 g = *(const f32x4*)(gate + 2 * 6144 + n0 + c4), x = res_h ? ld_bf4(res_h + off) : *(const f32x4*)(res_f + off);
          st_bf4(dst + off, x + g * sum); }
    }
    __syncthreads();
}

struct EpiWin0 {
    bf16_t* UA; bf16_t* CQN; bf16_t* CKVN; float* SSP; float* KR;
    template <int NM> DI void run(const f32x4 (&acc)[NM][4], int row0, int col0) const {
        const int cw = col0 & ~63;
#pragma unroll
        for (int m = 0; m < NM; ++m) { const int ri = row0 + m * 16; const size_t r = ri;
            if (cw < 512) { const int b = row_batch(ri), tp = row_tpos(ri);
#pragma unroll
                for (int n = 0; n < 4; ++n) { const int c = col0 + n * 16; const f32x4 v = acc[m][n]; const int g = c >> 4, s0 = c & 15;
                    *(u32x2*)(UA + ((size_t)g * CHR + b * NCK + (tp >> 5)) * 768 + (tp & 31) * 16 + s0) = (u32x2){pk2(v[0], v[1]), pk2(v[2], v[3])}; }
            } else if (cw < 1152) { const bool isq = cw < 896; bf16_t* dst = isq ? CQN + r * 384 + (col0 - 512) : CKVN + r * 256 + (col0 - 896);
                float ss = 0.f;
#pragma unroll
                for (int n = 0; n < 4; ++n) { const f32x4 v = acc[m][n]; ss += v[0] * v[0] + v[1] * v[1] + v[2] * v[2] + v[3] * v[3];
                    *(u32x2*)(dst + n * 16) = (u32x2){pk2(v[0], v[1]), pk2(v[2], v[3])}; }
                ss += __shfl_xor(ss, 16); ss += __shfl_xor(ss, 32);
                if ((col0 & 15) == 0) SSP[r * 10 + ((cw - 512) >> 6)] = ss;
            } else if (cw < 1216) {
#pragma unroll
                for (int n = 0; n < 4; ++n) *(f32x4*)(KR + r * 64 + (col0 - 1152) + n * 16) = acc[m][n];
            } }
    }
    DI void operator()(const f32x4 (&acc)[8][4], int row0, int col0, int gb) const { run<8>(acc, row0, col0); }
};
struct EpiS1a {
    float* E;
    DI void operator()(const f32x4 (&acc)[8][4], int row0, int col0, int gb) const {
#pragma unroll
        for (int m = 0; m < 8; ++m) { const int r = row0 + m * 16; if (r >= CHR) continue;
#pragma unroll
            for (int n = 0; n < 4; ++n) *(f32x4*)(E + ((size_t)gb * CHR + r) * 256 + col0 + n * 16) = acc[m][n]; }
    }
};
struct EpiS1b {
    bf16_t* YG;
    DI void operator()(const f32x4 (&acc)[8][4], int row0, int col0, int gb) const {
#pragma unroll
        for (int m = 0; m < 8; ++m) { const int r = row0 + m * 16; if (r >= CHR) continue; const int b = r / NCK, c = r % NCK;
#pragma unroll
            for (int n = 0; n < 4; ++n) { const int cc = col0 + n * 16; const int tl = cc >> 4, s0 = cc & 15; const f32x4 v = acc[m][n];
                const int tp = c * SL + tl; const size_t row = tp < CTX ? (size_t)b * CTX + tp : (size_t)NCTX + (size_t)b * SEQ + (tp - CTX);
                *(u32x2*)(YG + row * 512 + gb * 16 + s0) = (u32x2){pk2(gelu_tanh(v[0]), gelu_tanh(v[1])), pk2(gelu_tanh(v[2]), gelu_tanh(v[3]))}; } }
    }
};
struct EpiBf16 {
    bf16_t* O; int ldo; const float* SSP;
    DI void operator()(const f32x4 (&acc)[8][4], int row0, int col0, int gb) const {
#pragma unroll
        for (int m = 0; m < 8; ++m) { const size_t r = row0 + m * 16; const float* sp = SSP + r * 10;
            const float rstd = rsqrtf(((sp[0] + sp[1]) + (sp[2] + sp[3]) + (sp[4] + sp[5])) * (1.f / 384.f) + 1e-6f);
#pragma unroll
            for (int n = 0; n < 4; ++n) { const int c = col0 + n * 16; const f32x4 v = acc[m][n] * rstd;
                *(u32x2*)(O + r * ldo + c) = (u32x2){pk2(v[0], v[1]), pk2(v[2], v[3])}; } }
    }
};
struct EpiKV {
    bf16_t* KNOPE; bf16_t* VT; const float* SSP;
    DI void operator()(const f32x4 (&acc)[8][4], int row0, int col0, int gb) const {
#pragma unroll
        for (int m = 0; m < 8; ++m) { const int r = row0 + m * 16; const int b = row_batch(r), tp = row_tpos(r); const float* sp = SSP + (size_t)r * 10 + 6;
            const float rstd = rsqrtf(((sp[0] + sp[1]) + (sp[2] + sp[3])) * (1.f / 256.f) + 1e-6f);
#pragma unroll
            for (int n = 0; n < 4; ++n) { const int c = col0 + n * 16; const int h = c >> 8, w = c & 255; const f32x4 v = acc[m][n] * rstd;
                if (w < 128) *(u32x2*)(KNOPE + (size_t)r * 512 + h * 128 + w) = (u32x2){pk2(v[0], v[1]), pk2(v[2], v[3])};
                else { bf16_t* d = VT + ((size_t)(b * 4 + h) * 128 + (w - 128)) * TK + tp; const unsigned p0 = pk2(v[0], v[1]), p1 = pk2(v[2], v[3]);
                    d[0] = (bf16_t)(p0 & 0xffff); d[TK] = (bf16_t)(p0 >> 16); d[2 * TK] = (bf16_t)(p1 & 0xffff); d[3 * TK] = (bf16_t)(p1 >> 16); } } }
    }
};
struct EpiGLU {
    const bf16_t* YG; const float* bias; bf16_t* CAT;
    DI void operator()(const f32x4 (&acc)[8][4], int row0, int col0, int gb) const {
#pragma unroll
        for (int m = 0; m < 8; ++m) { const size_t r = row0 + m * 16;
#pragma unroll
            for (int n = 0; n < 4; ++n) { const int c = col0 + n * 16; const f32x4 v = acc[m][n]; const f32x4 bv = *(const f32x4*)(bias + c);
                const u32x2 yy = *(const u32x2*)(YG + r * 512 + c);
                const float y0 = __uint_as_float(yy[0] << 16), y1 = __uint_as_float(yy[0] & 0xffff0000u), y2 = __uint_as_float(yy[1] << 16), y3 = __uint_as_float(yy[1] & 0xffff0000u);
                const float o0 = y0 * sigmoidf_(v[0] + bv[0]), o1 = y1 * sigmoidf_(v[1] + bv[1]), o2 = y2 * sigmoidf_(v[2] + bv[2]), o3 = y3 * sigmoidf_(v[3] + bv[3]);
                *(u32x2*)(CAT + r * 1024 + c) = (u32x2){pk2(o0, o1), pk2(o2, o3)}; } }
    }
};
struct EpiRes {
    const float* res_ctx; const float* res_lat; float* dst_ctx; float* dst_lat; const float* gate; int atomic;
    DI void operator()(const f32x4 (&acc)[8][4], int row0, int col0, int gb) const {
#pragma unroll
        for (int m = 0; m < 8; ++m) { const int r = row0 + m * 16;
            const float* rs = r < NCTX ? res_ctx + (size_t)r * 1024 : res_lat + (size_t)(r - NCTX) * 1024;
            float* ds = r < NCTX ? dst_ctx + (size_t)r * 1024 : dst_lat + (size_t)(r - NCTX) * 1024;
            if (r < NCTX && dst_ctx == nullptr) continue;
            const float* gv = gate + row_vec(r) * 6144;
#pragma unroll
            for (int n = 0; n < 4; ++n) { const int c = col0 + n * 16; const f32x4 g = *(const f32x4*)(gv + c);
                if (atomic) { const f32x4 v = g * acc[m][n];
#pragma unroll
                    for (int j = 0; j < 4; ++j) (void)__hip_atomic_fetch_add(ds + c + j, v[j], __ATOMIC_RELAXED, __HIP_MEMORY_SCOPE_AGENT); }
                else { const f32x4 x = *(const f32x4*)(rs + c); *(f32x4*)(ds + c) = x + g * acc[m][n]; } } }
    }
};
struct EpiSwiGLU {
    bf16_t* HID;
    DI void operator()(const f32x4 (&acc)[8][4], int row0, int col0, int gb) const {
        const int hc = (col0 >> 6) * 32 + (col0 & 15);
#pragma unroll
        for (int m = 0; m < 8; ++m) { const size_t r = row0 + m * 16;
#pragma unroll
            for (int q = 0; q < 2; ++q) { const f32x4 g = acc[m][2 * q], u = acc[m][2 * q + 1];
                const float o0 = siluf_(g[0]) * u[0], o1 = siluf_(g[1]) * u[1], o2 = siluf_(g[2]) * u[2], o3 = siluf_(g[3]) * u[3];
                *(u32x2*)(HID + r * FH + hc + q * 16) = (u32x2){pk2(o0, o1), pk2(o2, o3)}; } }
    }
};
struct EpiWin1 {
    bf16_t* Q; bf16_t* K1; bf16_t* VT; const float* qn; const float* kn; const float* ROPE;
    template <int NM> DI void run(const f32x4 (&acc)[NM][4], int row0, int col0) const {
        const int cw = col0 & ~63, i0 = col0 & 15;
        if (cw >= 1280) {
#pragma unroll
            for (int m = 0; m < NM; ++m) { const int r = row0 + m * 16; const int b = row_batch(r), tp = row_tpos(r);
#pragma unroll
                for (int n = 0; n < 4; ++n) { const int cc = col0 + n * 16 - 1280, h = cc >> 6, d0 = cc & 63; const f32x4 v = acc[m][n];
                    bf16_t* d = VT + ((size_t)(b * 4 + h) * 64 + d0) * TK + tp; const unsigned p0 = pk2(v[0], v[1]), p1 = pk2(v[2], v[3]);
                    d[0] = (bf16_t)(p0 & 0xffff); d[TK] = (bf16_t)(p0 >> 16); d[2 * TK] = (bf16_t)(p1 & 0xffff); d[3 * TK] = (bf16_t)(p1 >> 16); } }
            return;
        }
        const bool isq = cw < 1024;
        const float* gn = isq ? qn : kn;
        f32x4 g[4];
#pragma unroll
        for (int n = 0; n < 4; ++n) g[n] = *(const f32x4*)(gn + n * 16 + i0);
        const float osc = isq ? 0.125f * LOG2E : 1.f;
#pragma unroll
        for (int m = 0; m < NM; ++m) { const int r = row0 + m * 16; const bool lat = r >= NCTX;
            if (isq && !lat) continue;
            const int b = row_batch(r), tp = row_tpos(r), t = tp - CTX;
            float ss = 0.f;
#pragma unroll
            for (int n = 0; n < 4; ++n) { const f32x4 v = acc[m][n]; ss += v[0] * v[0] + v[1] * v[1] + v[2] * v[2] + v[3] * v[3]; }
            ss += __shfl_xor(ss, 16); ss += __shfl_xor(ss, 32);
            const float rstd = rsqrtf(ss * (1.f / 64.f) + 1e-6f);
            f32x4 y[4];
#pragma unroll
            for (int n = 0; n < 4; ++n) y[n] = acc[m][n] * rstd * g[n];
            if (lat) { const float* rr = ROPE + ((t >> 6) * 16 + i0) * 2; const float* rc = ROPE + ((t & 63) * 16 + i0) * 2;
#pragma unroll
                for (int j = 0; j < 4; ++j) { const float c0 = rr[2 * j], s0 = rr[2 * j + 1], c1 = rc[2 * j], s1 = rc[2 * j + 1];
                    const float a0 = y[0][j], a1 = y[1][j], a2 = y[2][j], a3 = y[3][j];
                    y[0][j] = a0 * c0 - a1 * s0; y[1][j] = a1 * c0 + a0 * s0; y[2][j] = a2 * c1 - a3 * s1; y[3][j] = a3 * c1 + a2 * s1; } }
            bf16_t* dst = isq ? Q + (size_t)r * 1024 + cw + i0 : K1 + ((size_t)(b * 4 + ((cw - 1024) >> 6)) * TK + tp) * 64 + i0;
#pragma unroll
            for (int n = 0; n < 4; ++n) *(u32x2*)(dst + n * 16) = (u32x2){pk2(y[n][0] * osc, y[n][1] * osc), pk2(y[n][2] * osc, y[n][3] * osc)};
        }
    }
    DI void operator()(const f32x4 (&acc)[8][4], int row0, int col0, int gb) const { run<8>(acc, row0, col0); }
};

namespace pg8 {
constexpr int BM = 256, BK = 64, HALF = 128, HTB = HALF * BK * 2;
DI int lds_byte(int r, int c) { const int st = (r >> 4) * 2 + (c >> 5), rr = r & 15, cc = c & 31, ob = rr * 64 + cc * 2; return st * 1024 + (ob ^ (((ob >> 9) & 1) << 5)); }
DI void stage_rc(int b, int& R, int& C) { const int st = b / 1024, sb = b % 1024, swz = sb ^ (((sb >> 9) & 1) << 5); R = (st >> 1) * 16 + swz / 64; C = (st & 1) * 32 + (swz % 64) / 2; }
struct Unit { int pm, pn, gb; };
struct Gemm { const bf16_t* A; const bf16_t* Bt; int lda, K; size_t sA = 0, sB = 0; };
struct Order {
    int mt0, nmt, nnt, G, c, nbatch = 1;
    DI bool next(int i, Unit& u) const { const int L0 = i * G + c; if (L0 >= nbatch * nmt * nnt) return false; constexpr int PM = 8; const int gb_ = L0 / (nmt * nnt); const int L = L0 - gb_ * nmt * nnt; u.gb = gb_;
        const int ch = L / (PM * nnt), rm = L - ch * PM * nnt; const int pc = (nmt - ch * PM) < PM ? (nmt - ch * PM) : PM; const int tn = rm / pc;
        u.pm = mt0 + ch * PM + (rm - tn * pc); u.pn = tn; return true; }
};
template <class Epi>
DI void gemm_phase(LAS unsigned char* lds, const Gemm g, const Order& S, const Epi& E) {
    const int tid = get_tid(), wid = __builtin_amdgcn_readfirstlane(tid >> 6), lane = tid & 63, wr = wid >> 2, wc = wid & 3, fr = lane & 15, fq = lane >> 4;
    const int K = g.K, nt = K / BK;
    unsigned voffA[2], voffB[2];
#pragma unroll
    for (int i = 0; i < 2; ++i) { int R, C; stage_rc(tid * 16 + i * 8192, R, C); voffA[i] = (unsigned)(R * g.lda + C) * 2u; voffB[i] = (unsigned)(R * K + C) * 2u; }
    const size_t kstep = (size_t)(BK * 2);
    const size_t hstepA = (size_t)HALF * g.lda * 2, hstepB = (size_t)HALF * K * 2;
    const size_t tstepA = 2 * hstepA, tstepB = 2 * hstepB;
    const unsigned ldsw = (unsigned)wid * 1024u;
    const int aoff = lds_byte(wr * 64 + fr, fq * 8), boff = lds_byte(wc * 32 + fr, fq * 8);
#define PG8_SA(b, h) (((b) * 2 + (h)) * HTB)
#define PG8_SB(b, h) ((4 + (b) * 2 + (h)) * HTB)
#define PG8_STAGE(bufoff, gbase, voff) do { _Pragma("unroll") for (int _i = 0; _i < 2; ++_i) \
        __builtin_amdgcn_global_load_lds((const unsigned*)((const char*)(gbase) + (voff)[_i]), (LAS unsigned*)(lds + (bufoff) + ldsw + _i * 8192), 16, 0, 0); } while (0)
#define PG8_LDA(dst, b, h) do { _Pragma("unroll") for (int m = 0; m < 4; ++m) _Pragma("unroll") for (int k = 0; k < 2; ++k) dst[m][k] = *(const LAS bf16x8*)(lds + PG8_SA(b, h) + aoff + m * 2048 + k * 1024); } while (0)
#define PG8_LDB(dst, b, h) do { _Pragma("unroll") for (int n = 0; n < 2; ++n) _Pragma("unroll") for (int k = 0; k < 2; ++k) dst[n][k] = *(const LAS bf16x8*)(lds + PG8_SB(b, h) + boff + n * 2048 + k * 1024); } while (0)
#define PG8_MMA(ai, bj, At, Bt) do { __builtin_amdgcn_s_setprio(1); _Pragma("unroll") for (int m = 0; m < 4; ++m) _Pragma("unroll") for (int n = 0; n < 2; ++n) _Pragma("unroll") for (int k = 0; k < 2; ++k) \
        acc[ai][bj][m][n] = __builtin_amdgcn_mfma_f32_16x16x32_bf16(Bt[n][k], At[m][k], acc[ai][bj][m][n], 0, 0, 0); __builtin_amdgcn_s_setprio(0); } while (0)
#define PG8_WAIT_V(n) asm volatile("s_waitcnt vmcnt(" #n ")" ::: "memory")
#define PG8_WAIT_L(n) asm volatile("s_waitcnt lgkmcnt(" #n ")" ::: "memory")
#define PG8_BAR __builtin_amdgcn_s_barrier()
#define PG8_SCHED __builtin_amdgcn_sched_barrier(0)
    Unit cur, nxt; int ui = 0;
    if (!S.next(0, cur)) return;
    f32x4 acc[2][2][4][2];
#pragma unroll
    for (int a = 0; a < 2; ++a)
#pragma unroll
        for (int b = 0; b < 2; ++b)
#pragma unroll
            for (int m = 0; m < 4; ++m)
#pragma unroll
                for (int n = 0; n < 2; ++n) acc[a][b][m][n] = (f32x4){0.f, 0.f, 0.f, 0.f};
    bf16x8 At[4][2], B0[2][2], B1[2][2];
    const char* cA = (const char*)(g.A + (size_t)cur.gb * g.sA) + (size_t)cur.pm * tstepA; const char* cB = (const char*)(g.Bt + (size_t)cur.gb * g.sB) + (size_t)cur.pn * tstepB;
    PG8_STAGE(PG8_SB(0, 0), cB, voffB); PG8_STAGE(PG8_SB(0, 1), cB + hstepB, voffB); PG8_STAGE(PG8_SA(0, 0), cA, voffA); PG8_STAGE(PG8_SA(0, 1), cA + hstepA, voffA);
    if (wr == 1) PG8_BAR;
    PG8_WAIT_V(2); PG8_BAR;
    PG8_STAGE(PG8_SB(1, 0), cB + kstep, voffB); PG8_STAGE(PG8_SA(1, 0), cA + kstep, voffA); PG8_STAGE(PG8_SB(1, 1), cB + hstepB + kstep, voffB);
    PG8_WAIT_V(6); PG8_BAR;
    for (;;) {
        const bool has_next = S.next(ui + 1, nxt);
        const char* nA = has_next ? (const char*)(g.A + (size_t)nxt.gb * g.sA) + (size_t)nxt.pm * tstepA : cA; const char* nB = has_next ? (const char*)(g.Bt + (size_t)nxt.gb * g.sB) + (size_t)nxt.pn * tstepB : cB;
        for (int t = 0; t < nt; t += 2) {
            const bool last = (t == nt - 2);
            const char* a1 = cA + (size_t)(t + 1) * kstep;
            const char* a2 = last ? nA : cA + (size_t)(t + 2) * kstep; const char* b2 = last ? nB : cB + (size_t)(t + 2) * kstep;
            const char* a3 = a2 + kstep; const char* b3 = b2 + kstep;
            PG8_LDB(B0, 0, 0); PG8_LDB(B1, 0, 1); PG8_SCHED; PG8_LDA(At, 0, 0); PG8_STAGE(PG8_SA(1, 1), a1 + hstepA, voffA);
            PG8_WAIT_V(8); PG8_WAIT_L(0); PG8_BAR; PG8_MMA(0, 0, At, B0); PG8_MMA(0, 1, At, B1); PG8_BAR; PG8_SCHED;
            PG8_LDA(At, 0, 1); PG8_STAGE(PG8_SB(0, 0), b2, voffB); PG8_STAGE(PG8_SB(0, 1), b2 + hstepB, voffB); PG8_STAGE(PG8_SA(0, 0), a2, voffA);
            PG8_WAIT_V(8); PG8_WAIT_L(0); PG8_BAR; PG8_MMA(1, 0, At, B0); PG8_MMA(1, 1, At, B1); PG8_BAR; PG8_SCHED;
            PG8_LDB(B0, 1, 0); PG8_LDB(B1, 1, 1); PG8_SCHED; PG8_LDA(At, 1, 0); PG8_STAGE(PG8_SA(0, 1), a2 + hstepA, voffA);
            PG8_WAIT_V(8); PG8_WAIT_L(0); PG8_BAR; PG8_MMA(0, 0, At, B0); PG8_MMA(0, 1, At, B1); PG8_BAR; PG8_SCHED;
            PG8_LDA(At, 1, 1); PG8_STAGE(PG8_SB(1, 0), b3, voffB); PG8_STAGE(PG8_SB(1, 1), b3 + hstepB, voffB); PG8_STAGE(PG8_SA(1, 0), a3, voffA);
            PG8_WAIT_V(8); PG8_WAIT_L(0); PG8_BAR; PG8_MMA(1, 0, At, B0); PG8_MMA(1, 1, At, B1); PG8_BAR; PG8_SCHED;
        }
        if (wr == 0) PG8_BAR;
        E(acc, cur, wr, wc, fr, fq);
        if (!has_next) break;
#pragma unroll
        for (int a = 0; a < 2; ++a)
#pragma unroll
            for (int b = 0; b < 2; ++b)
#pragma unroll
                for (int m = 0; m < 4; ++m)
#pragma unroll
                    for (int n = 0; n < 2; ++n) acc[a][b][m][n] = (f32x4){0.f, 0.f, 0.f, 0.f};
        cur = nxt; cA = nA; cB = nB; ++ui;
        if (wr == 1) PG8_BAR;
    }
    PG8_WAIT_V(0);
    PG8_BAR;
#undef PG8_SA
#undef PG8_SB
#undef PG8_STAGE
#undef PG8_LDA
#undef PG8_LDB
#undef PG8_MMA
#undef PG8_WAIT_V
#undef PG8_WAIT_L
#undef PG8_BAR
#undef PG8_SCHED
}
struct EpiRes {
    const float* res_f; const bf16_t* res_h; bf16_t* dst_h; float* dst_f; const float* gate;
    DI void operator()(const f32x4 (&acc)[2][2][4][2], const Unit& u, int wr, int wc, int fr, int fq) const {
        const int row0 = u.pm * 256 + wr * 64 + fr, col0 = u.pn * 256 + wc * 32 + fq * 4;
#pragma unroll
        for (int ai = 0; ai < 2; ++ai)
#pragma unroll
            for (int m = 0; m < 4; ++m) { const int r = row0 + 128 * ai + 16 * m; const size_t ro = (size_t)(r - NCTX) * 1024; const float* gv = gate + row_vec(r) * 6144;
#pragma unroll
                for (int bj = 0; bj < 2; ++bj)
#pragma unroll
                    for (int n = 0; n < 2; ++n) { const int c = col0 + 128 * bj + 16 * n; const f32x4 g_ = *(const f32x4*)(gv + c);
                        const f32x4 x = res_h ? ld_bf4(res_h + ro + c) : __builtin_nontemporal_load((const f32x4*)(res_f + ro + c));
                        const f32x4 y = x + g_ * acc[ai][bj][m][n];
                        if (dst_h) st_bf4(dst_h + ro + c, y); else __builtin_nontemporal_store(y, (f32x4*)(dst_f + ro + c)); } }
    }
};
struct EpiSwiGLU {
    bf16_t* HID;
    DI void operator()(const f32x4 (&acc)[2][2][4][2], const Unit& u, int wr, int wc, int fr, int fq) const {
        const int row0 = u.pm * 256 + wr * 64 + fr, hc0 = u.pn * 128 + wc * 16 + fq * 4;
#pragma unroll
        for (int ai = 0; ai < 2; ++ai)
#pragma unroll
            for (int m = 0; m < 4; ++m) { const size_t r = row0 + 128 * ai + 16 * m;
#pragma unroll
                for (int bj = 0; bj < 2; ++bj) { const f32x4 g_ = acc[ai][bj][m][0], u_ = acc[ai][bj][m][1];
                    const float o0 = siluf_(g_[0]) * u_[0], o1 = siluf_(g_[1]) * u_[1], o2 = siluf_(g_[2]) * u_[2], o3 = siluf_(g_[3]) * u_[3];
                    *(u32x2*)(HID + r * FH + hc0 + 64 * bj) = (u32x2){pk2(o0, o1), pk2(o2, o3)}; } }
    }
};
struct EpiS1a {
    float* E;
    DI void operator()(const f32x4 (&acc)[2][2][4][2], const Unit& u, int wr, int wc, int fr, int fq) const {
        const int row0 = u.pm * 256 + wr * 64 + fr, col0 = u.pn * 256 + wc * 32 + fq * 4;
#pragma unroll
        for (int ai = 0; ai < 2; ++ai)
#pragma unroll
            for (int m = 0; m < 4; ++m) { const int r = row0 + 128 * ai + 16 * m; if (r >= CHR) continue;
#pragma unroll
                for (int bj = 0; bj < 2; ++bj)
#pragma unroll
                    for (int n = 0; n < 2; ++n) *(f32x4*)(E + ((size_t)u.gb * CHR + r) * 256 + col0 + 128 * bj + 16 * n) = acc[ai][bj][m][n]; }
    }
};
struct EpiS1b {
    bf16_t* YG;
    DI void operator()(const f32x4 (&acc)[2][2][4][2], const Unit& u, int wr, int wc, int fr, int fq) const {
        const int row0 = u.pm * 256 + wr * 64 + fr, col0 = u.pn * 256 + wc * 32 + fq * 4;
#pragma unroll
        for (int ai = 0; ai < 2; ++ai)
#pragma unroll
            for (int m = 0; m < 4; ++m) { const int r = row0 + 128 * ai + 16 * m; if (r >= CHR) continue; const int b = r / NCK, c = r % NCK;
#pragma unroll
                for (int bj = 0; bj < 2; ++bj)
#pragma unroll
                    for (int n = 0; n < 2; ++n) { const int cc = col0 + 128 * bj + 16 * n; const int tl = cc >> 4, s0 = cc & 15; const f32x4 v = acc[ai][bj][m][n];
                        const int tp = c * SL + tl; const size_t row = tp < CTX ? (size_t)b * CTX + tp : (size_t)NCTX + (size_t)b * SEQ + (tp - CTX);
                        *(u32x2*)(YG + row * 512 + u.gb * 16 + s0) = (u32x2){pk2(gelu_tanh(v[0]), gelu_tanh(v[1])), pk2(gelu_tanh(v[2]), gelu_tanh(v[3]))}; } }
    }
};
template <class E> struct EpiHead { E e;
    DI void operator()(const f32x4 (&acc)[2][2][4][2], const Unit& u, int wr, int wc, int fr, int fq) const {
#pragma unroll
        for (int ai = 0; ai < 2; ++ai) { f32x4 t[4][4];
#pragma unroll
            for (int m = 0; m < 4; ++m)
#pragma unroll
                for (int sb = 0; sb < 4; ++sb) t[m][sb] = acc[ai][sb >> 1][m][sb & 1];
            e.template run<4>(t, u.pm * 256 + 128 * ai + wr * 64 + fr, u.pn * 256 + wc * 64 + fq * 4); }
    }
};
}

template <int DQK, int DV, bool WIN>
DI void attn_item(char* lds, const bf16_t* Q, int qstride, const bf16_t* Kb, const bf16_t* VTb, int ta0, int ta1, int tb0, int tb1,
                  float mref, float l_init, bf16_t* O, int ostride, int qpos0) {
    constexpr int NKS = DQK / 16, NDT = DV / 32, KSTR = DQK + 8, VSTR = 72, NG = NKS;
    constexpr int KCH = 64 * DQK / 8 / NTHREADS, VCH = DV * 8 / NTHREADS;
    constexpr int KBUF = 64 * KSTR, VBUF = DV * VSTR;
    bf16_t* Ks = (bf16_t*)lds; bf16_t* Vs = Ks + 2 * KBUF;
    const int tid = get_tid(), lane = tid & 63, wid = tid >> 6, r = lane & 31, h2 = lane >> 5;
    bf16x8 qf[NKS];
    { const bf16_t* qrow = Q + (size_t)(wid * 32 + r) * qstride + 8 * h2;
#pragma unroll
      for (int ks = 0; ks < NKS; ++ks) qf[ks] = *(const bf16x8*)(qrow + 16 * ks); }
    f32x16 o[NDT];
#pragma unroll
    for (int dt = 0; dt < NDT; ++dt)
#pragma unroll
        for (int i = 0; i < 16; ++i) o[dt][i] = 0.f;
    float lrun = (h2 == 0) ? l_init : 0.f;
    const int na = ta1 - ta0, ntot = na + (tb1 - tb0);
    u32x4 kr[KCH], vr[VCH];
    constexpr int KTPR = (DQK / 8) / KCH, VTPR = 8 / VCH;
    const int krow = tid / KTPR, kcol = (tid % KTPR) * (KCH * 8);
    const int vrow = tid / VTPR, vcol = (tid % VTPR) * (VCH * 8);
    const bf16_t* kgp = Kb + (size_t)krow * DQK + kcol;
    const bf16_t* vgp = VTb + (size_t)vrow * TK + vcol;
    bf16_t* ksp = Ks + krow * KSTR + kcol;
    bf16_t* vsp = Vs + vrow * VSTR + vcol;
    const bf16_t* kfp = Ks + r * KSTR + 8 * h2;
    const bf16_t* vfp = Vs + r * VSTR + 8 * h2;
#define A_TILE(itv) (((itv) < na) ? ta0 + (itv) : tb0 + ((itv) - na))
#define K_LOAD(itv) do { const bf16_t* kg = kgp + (size_t)A_TILE(itv) * 64 * DQK; _Pragma("unroll") for (int i = 0; i < KCH; ++i) kr[i] = *(const u32x4*)(kg + i * 8); } while (0)
#define V_LOADG(itv) do { const bf16_t* vg = vgp + A_TILE(itv) * 64; _Pragma("unroll") for (int i = 0; i < VCH; ++i) vr[i] = *(const u32x4*)(vg + i * 8); } while (0)
#define K_WRITE(bo) do { _Pragma("unroll") for (int i = 0; i < KCH; ++i) *(u32x4*)(ksp + (bo) + i * 8) = kr[i]; } while (0)
#define V_WRITE(bo) do { _Pragma("unroll") for (int i = 0; i < VCH; ++i) { const int c_ = (vcol >> 3) + i; bf16_t* d_ = vsp - vcol + (bo) + (c_ >> 1) * 16 + (c_ & 1) * 4; \
            *(u32x2*)d_ = (u32x2){vr[i][0], vr[i][1]}; *(u32x2*)(d_ + 8) = (u32x2){vr[i][2], vr[i][3]}; } } while (0)
#define T_ACTIVE(itv) (!(WIN && A_TILE(itv) >= 4 && ((A_TILE(itv) - 4) * 64 > qpos0 + wid * 32 + 31 + 128 || (A_TILE(itv) - 4) * 64 + 63 < qpos0 + wid * 32 - 128)))
#define S_MASK(S0, S1, itv) do { if (WIN && A_TILE(itv) >= 4) { const int qp = qpos0 + wid * 32 + r, kp0 = (A_TILE(itv) - 4) * 64 + 4 * h2; \
        _Pragma("unroll") for (int i = 0; i < 16; ++i) { const int d0 = kp0 + (i & 3) + 8 * (i >> 2) - qp, d1 = d0 + 32; \
            if (d0 > 128 || d0 < -128) S0[i] = -1e30f; if (d1 > 128 || d1 < -128) S1[i] = -1e30f; } } } while (0)
    f32x16 s0, s1;
    __syncthreads();
    K_LOAD(0); K_WRITE(0);
    if (1 < ntot) K_LOAD(1);
    V_LOADG(0);
    __syncthreads();
#pragma unroll
    for (int i = 0; i < 16; ++i) { s0[i] = -mref; s1[i] = -mref; }
#pragma unroll 1
    for (int it = -1; it < ntot; ++it) {
        const int kb_n = ((it + 1) & 1) * KBUF, vb_c = (it & 1) * VBUF;
        if (it + 2 < ntot) K_WRITE((it & 1) * KBUF);
        if (it + 1 < ntot) V_WRITE(((it + 1) & 1) * VBUF);
        __builtin_amdgcn_sched_barrier(0);
        const bool act_c = (it >= 0) && T_ACTIVE(it), act_n = (it + 1 < ntot) && T_ACTIVE(it + 1);
        f32x16 n0, n1;
#pragma unroll
        for (int i = 0; i < 16; ++i) { n0[i] = -mref; n1[i] = -mref; }
        float rs = 0.f;
        unsigned pk[16];
#define P_PAIR(j) do { const float e0_ = __builtin_amdgcn_exp2f((j) < 8 ? s0[2 * ((j) & 7)] : s1[2 * ((j) & 7)]), e1_ = __builtin_amdgcn_exp2f((j) < 8 ? s0[2 * ((j) & 7) + 1] : s1[2 * ((j) & 7) + 1]); rs += e0_ + e1_; pk[j] = pk2(e0_, e1_); } while (0)
        if (act_c && act_n) {
#pragma unroll
            for (int g = 0; g < NG; ++g) {
                const bf16x8 ka = *(const bf16x8*)(kfp + kb_n + 16 * g), kb = *(const bf16x8*)(kfp + kb_n + 32 * KSTR + 16 * g);
                n0 = __builtin_amdgcn_mfma_f32_32x32x16_bf16(ka, qf[g], n0, 0, 0, 0);
                n1 = __builtin_amdgcn_mfma_f32_32x32x16_bf16(kb, qf[g], n1, 0, 0, 0);
#pragma unroll
                for (int j = (16 * g) / NG; j < (16 * (g + 1)) / NG; ++j) P_PAIR(j);
            }
            S_MASK(n0, n1, it + 1);
        } else {
            if (act_n) {
#pragma unroll
                for (int ks = 0; ks < NKS; ++ks) { const bf16x8 k0 = *(const bf16x8*)(kfp + kb_n + 16 * ks), k1 = *(const bf16x8*)(kfp + kb_n + 32 * KSTR + 16 * ks);
                    n0 = __builtin_amdgcn_mfma_f32_32x32x16_bf16(k0, qf[ks], n0, 0, 0, 0); n1 = __builtin_amdgcn_mfma_f32_32x32x16_bf16(k1, qf[ks], n1, 0, 0, 0); }
                S_MASK(n0, n1, it + 1);
            }
            if (act_c) {
#pragma unroll
                for (int j = 0; j < 16; ++j) P_PAIR(j);
            }
        }
#undef P_PAIR
        __builtin_amdgcn_sched_barrier(0);
        if (it + 3 < ntot) K_LOAD(it + 3);
        if (it + 2 < ntot) V_LOADG(it + 2);
        __builtin_amdgcn_sched_barrier(0);
        if (act_c) {
            lrun += rs;
#pragma unroll
            for (int q = 0; q < 4; ++q) {
                const u32x4 pw = {pk[4 * q], pk[4 * q + 1], pk[4 * q + 2], pk[4 * q + 3]};
                const bf16x8 pf = __builtin_bit_cast(bf16x8, pw);
#pragma unroll
                for (int dt = 0; dt < NDT; ++dt) { const bf16x8 vf = *(const bf16x8*)(vfp + vb_c + (32 * dt) * VSTR + 16 * q);
                    o[dt] = __builtin_amdgcn_mfma_f32_32x32x16_bf16(vf, pf, o[dt], 0, 0, 0); }
            }
        }
        s0 = n0; s1 = n1;
        __syncthreads();
    }
#undef A_TILE
#undef K_LOAD
#undef V_LOADG
#undef K_WRITE
#undef V_WRITE
#undef T_ACTIVE
#undef S_MASK
    lrun += __shfl_xor(lrun, 32);
    const float inv = 1.f / lrun;
    bf16_t* orow = O + (size_t)(wid * 32 + r) * ostride;
#pragma unroll
    for (int dt = 0; dt < NDT; ++dt)
#pragma unroll
        for (int g = 0; g < 4; ++g)
            *(u32x2*)(orow + 32 * dt + 8 * g + 4 * h2) = (u32x2){pk2(o[dt][4 * g] * inv, o[dt][4 * g + 1] * inv), pk2(o[dt][4 * g + 2] * inv, o[dt][4 * g + 3] * inv)};
    __syncthreads();
}

template <int NH>
DI void win_attn_item(char* lds, const bf16_t* Q, const bf16_t* Kb, const bf16_t* VTb, int tb0, int tb1, float mref, const float* sinkp, bf16_t* O, int qpos0) {
    constexpr int KSTR = 72, VSTR = 72, KBUF = 64 * KSTR, VBUF = 64 * VSTR;
    bf16_t* Ks = (bf16_t*)lds; bf16_t* Vs = Ks + 2 * KBUF;
    const int tid = get_tid(), lane = tid & 63, wid = tid >> 6, r = lane & 31, h2 = lane >> 5;
    bf16x8 qf[NH][4];
#pragma unroll
    for (int h = 0; h < NH; ++h) { const bf16_t* qrow = Q + (size_t)(wid * 32 + r) * 1024 + h * 64 + 8 * h2;
#pragma unroll
        for (int ks = 0; ks < 4; ++ks) qf[h][ks] = *(const bf16x8*)(qrow + 16 * ks); }
    f32x16 o[NH][2]; float lrun[NH];
#pragma unroll
    for (int h = 0; h < NH; ++h) { lrun[h] = (h2 == 0) ? __builtin_amdgcn_exp2f(sinkp[h] * LOG2E - mref) : 0.f;
#pragma unroll
        for (int dt = 0; dt < 2; ++dt)
#pragma unroll
            for (int i = 0; i < 16; ++i) o[h][dt][i] = 0.f; }
    const int na = 4, ntot = na + (tb1 - tb0);
    u32x4 kr, vr;
    const int krow = tid >> 3, kcol = (tid & 7) * 8;
    const bf16_t* kgp = Kb + (size_t)krow * 64 + kcol;
    const bf16_t* vgp = VTb + (size_t)krow * TK + kcol;
    bf16_t* ksp = Ks + krow * KSTR + kcol;
    bf16_t* vsp = Vs + krow * VSTR + (kcol >> 4) * 16 + ((kcol >> 3) & 1) * 4;
    const bf16_t* kfp = Ks + r * KSTR + 8 * h2;
    const bf16_t* vfp = Vs + r * VSTR + 8 * h2;
#define W_TILE(itv) (((itv) < na) ? (itv) : tb0 + ((itv) - na))
#define W_LOAD(itv) do { kr = *(const u32x4*)(kgp + (size_t)W_TILE(itv) * 64 * 64); vr = *(const u32x4*)(vgp + W_TILE(itv) * 64); } while (0)
#define W_WRITE(kb_, vb_) do { *(u32x4*)(ksp + (kb_)) = kr; *(u32x2*)(vsp + (vb_)) = (u32x2){vr[0], vr[1]}; *(u32x2*)(vsp + (vb_) + 8) = (u32x2){vr[2], vr[3]}; } while (0)
    __syncthreads();
    W_LOAD(0); W_WRITE(0, 0);
    if (1 < ntot) W_LOAD(1);
    __syncthreads();
#pragma unroll 1
    for (int it = 0; it < ntot; ++it) {
        const int T = W_TILE(it);
        const int kb = (it & 1) * KBUF, vb = (it & 1) * VBUF;
        if (it + 1 < ntot) W_WRITE(KBUF - kb, VBUF - vb);
        if (it + 2 < ntot) W_LOAD(it + 2);
        bool active = true, need_mask = false;
        if (T >= 4) { const int klo = (T - 4) * 64, qlo = qpos0 + wid * 32;
            active = !(klo > qlo + 31 + 128 || klo + 63 < qlo - 128);
            need_mask = (klo < qlo + 31 - 128) || (klo + 63 > qlo + 128); }
        if (active) {
#pragma unroll
            for (int h = 0; h < NH; ++h) {
                __builtin_amdgcn_sched_barrier(0);
                f32x16 s0, s1;
#pragma unroll
                for (int i = 0; i < 16; ++i) { s0[i] = -mref; s1[i] = -mref; }
#pragma unroll
                for (int ks = 0; ks < 4; ++ks) { const bf16x8 k0 = *(const bf16x8*)(kfp + kb + 16 * ks), k1 = *(const bf16x8*)(kfp + kb + 32 * KSTR + 16 * ks);
                    s0 = __builtin_amdgcn_mfma_f32_32x32x16_bf16(k0, qf[h][ks], s0, 0, 0, 0); s1 = __builtin_amdgcn_mfma_f32_32x32x16_bf16(k1, qf[h][ks], s1, 0, 0, 0); }
                if (need_mask) { const int qp = qpos0 + wid * 32 + r, kp0 = (T - 4) * 64 + 4 * h2;
#pragma unroll
                    for (int i = 0; i < 16; ++i) { const int d0 = kp0 + (i & 3) + 8 * (i >> 2) - qp, d1 = d0 + 32;
                        if (d0 > 128 || d0 < -128) s0[i] = -1e30f; if (d1 > 128 || d1 < -128) s1[i] = -1e30f; } }
                float rs = 0.f; unsigned pk[16];
#pragma unroll
                for (int j = 0; j < 8; ++j) { const float a0 = __builtin_amdgcn_exp2f(s0[2 * j]), a1 = __builtin_amdgcn_exp2f(s0[2 * j + 1]), b0 = __builtin_amdgcn_exp2f(s1[2 * j]), b1 = __builtin_amdgcn_exp2f(s1[2 * j + 1]);
                    rs += (a0 + a1) + (b0 + b1); pk[j] = pk2(a0, a1); pk[8 + j] = pk2(b0, b1); }
                lrun[h] += rs;
                __builtin_amdgcn_sched_barrier(0);
#pragma unroll
                for (int q = 0; q < 4; ++q) { const u32x4 pw = {pk[4 * q], pk[4 * q + 1], pk[4 * q + 2], pk[4 * q + 3]}; const bf16x8 pf = __builtin_bit_cast(bf16x8, pw);
#pragma unroll
                    for (int dt = 0; dt < 2; ++dt) { const bf16x8 vf = *(const bf16x8*)(vfp + vb + (32 * dt) * VSTR + 16 * q);
                        o[h][dt] = __builtin_amdgcn_mfma_f32_32x32x16_bf16(vf, pf, o[h][dt], 0, 0, 0); } }
            }
        }
        __syncthreads();
    }
#undef W_TILE
#undef W_LOAD
#undef W_WRITE
#pragma unroll
    for (int h = 0; h < NH; ++h) { float l = lrun[h]; l += __shfl_xor(l, 32); const float inv = 1.f / l;
        bf16_t* orow = O + (size_t)(wid * 32 + r) * 1024 + h * 64;
#pragma unroll
        for (int dt = 0; dt < 2; ++dt)
#pragma unroll
            for (int g = 0; g < 4; ++g)
                *(u32x2*)(orow + 32 * dt + 8 * g + 4 * h2) = (u32x2){pk2(o[h][dt][4 * g] * inv, o[h][dt][4 * g + 1] * inv), pk2(o[h][dt][4 * g + 2] * inv, o[h][dt][4 * g + 3] * inv)}; }
    __syncthreads();
}

DI void s5_kk_phase(char* lds, const Params& p) {
    const int tid512 = get_tid(); const int tid = tid512 & 255, s = tid >> 4, sp = tid & 15, dh = tid512 >> 8;
    f32x2* sbb = (f32x2*)lds;
    f32x2* scc = sbb + 1024;
    f32x2* spw = scc + 1024;
    const f32x2* POW = (const f32x2*)(p.ws + H_POW); const f32x2* BB = (const f32x2*)(p.ws + T_BBAR); float* KK = (float*)(p.ws + H_KK);
    for (int it = blockIdx.x; it < 32 * 2 * 4; it += gridDim.x) {
        const int dq = it & 3, dir = (it >> 2) & 1, g = it >> 3; const int dg = dir * 32 + g;
        __syncthreads();
        for (int i = tid512; i < 1024; i += NTHREADS) { sbb[i] = BB[(size_t)dg * 1024 + i]; scc[i] = (f32x2){p.in[18][(size_t)dg * 1024 + i], p.in[19][(size_t)dg * 1024 + i]}; }
        { const int i = tid512; spw[i] = POW[((size_t)dg * 33 + dq * 8 + (i >> 6)) * 64 + (i & 63)]; }
        __syncthreads();
        float acc[4] = {0.f, 0.f, 0.f, 0.f};
#pragma unroll 4
        for (int pp = 0; pp < 64; ++pp) { const f32x2 bb = sbb[pp * 16 + sp], cc = scc[s * 64 + pp];
#pragma unroll
            for (int q = 0; q < 4; ++q) { const f32x2 pw = spw[(dh * 4 + q) * 64 + pp];
                const float zr = pw[0] * bb[0] - pw[1] * bb[1], zi = pw[0] * bb[1] + pw[1] * bb[0];
                acc[q] += cc[0] * zr - cc[1] * zi; } }
#pragma unroll
        for (int q = 0; q < 4; ++q) KK[(size_t)((g * 2 + dir) * 32 + dq * 8 + dh * 4 + q) * 256 + tid] = acc[q];
    }
    __syncthreads();
}
DI void s5_w1a_phase(const Params& p) {
    const int tid = get_tid();
    const f32x2* POW = (const f32x2*)(p.ws + H_POW); const f32x2* BB = (const f32x2*)(p.ws + T_BBAR); bf16_t* W = (bf16_t*)(p.ws + H_W1A);
    for (int idx = blockIdx.x * NTHREADS + tid; idx < 2048 * 256; idx += gridDim.x * NTHREADS) {
        const int kq = idx & 63, n = (idx >> 6) & 255, g = idx >> 14;
        const int dir = n >> 7, ri = (n >> 6) & 1, pp = n & 63; const int e = (dir * 32 + g) * 64 + pp; const int tl = kq >> 1, s0 = (kq & 1) * 8;
        const f32x2 pw = POW[((size_t)(dir * 32 + g) * 33 + (dir ? tl : 31 - tl)) * 64 + pp];
        float v[8];
#pragma unroll
        for (int j = 0; j < 8; ++j) { const f32x2 bb = BB[e * 16 + s0 + j]; v[j] = ri ? pw[0] * bb[1] + pw[1] * bb[0] : pw[0] * bb[0] - pw[1] * bb[1]; }
        *(u32x4*)(W + ((size_t)g * 256 + n) * 512 + kq * 8) = (u32x4){pk2(v[0], v[1]), pk2(v[2], v[3]), pk2(v[4], v[5]), pk2(v[6], v[7])};
    }
}
DI void s5_w1b_phase(const Params& p) {
    const int tid = get_tid();
    const f32x2* __restrict__ POW = (const f32x2*)(p.ws + H_POW); const float* __restrict__ KK = (const float*)(p.ws + H_KK); bf16_t* __restrict__ W = (bf16_t*)(p.ws + A_W1B);
    const float* __restrict__ CRE = p.in[18]; const float* __restrict__ CIM = p.in[19]; const float* __restrict__ DSK = p.in[20];
#pragma unroll 2
    for (int idx = blockIdx.x * NTHREADS + tid; idx < 32 * 512 * 64; idx += gridDim.x * NTHREADS) {
        const int kq = idx & 63, n = (idx >> 6) & 511, g = idx >> 15;
        const int tl = n >> 4, s = n & 15, tl2 = kq >> 1, s0 = (kq & 1) * 8;
        const int d0 = tl - tl2, d1 = tl2 - tl;
        const float* k0 = KK + (size_t)((g * 2 + 0) * 32 + (d0 < 0 ? 0 : d0)) * 256 + s * 16 + s0;
        const float* k1 = KK + (size_t)((g * 2 + 1) * 32 + (d1 < 0 ? 0 : d1)) * 256 + s * 16 + s0;
        const f32x4 a0 = *(const f32x4*)k0, a1 = *(const f32x4*)(k0 + 4), b0 = *(const f32x4*)k1, b1 = *(const f32x4*)(k1 + 4);
        const float w0 = d0 >= 0 ? 1.f : 0.f, w1 = d1 >= 0 ? 1.f : 0.f;
        f32x4 x0 = a0 * w0 + b0 * w1, x1 = a1 * w0 + b1 * w1;
        if (tl2 == tl && (s >> 3) == (kq & 1)) { const float dv = DSK[g * 16 + s];
#pragma unroll
            for (int j = 0; j < 4; ++j) { if (j == (s & 7)) x0[j] += dv; if (4 + j == (s & 7)) x1[j] += dv; } }
        *(u32x4*)(W + ((size_t)g * 512 + n) * 768 + kq * 8) = (u32x4){pk2(x0[0], x0[1]), pk2(x0[2], x0[3]), pk2(x1[0], x1[1]), pk2(x1[2], x1[3])};
    }
#pragma unroll 2
    for (int idx = blockIdx.x * NTHREADS + tid; idx < 32 * 512 * 32; idx += gridDim.x * NTHREADS) {
        const int kb = idx & 31, n = (idx >> 5) & 511, g = idx >> 14;
        const int tl = n >> 4, s = n & 15, k2 = kb * 8; const int dir = k2 >> 7, ri = (k2 >> 6) & 1, p0 = k2 & 63;
        const float* cre = CRE + ((size_t)(dir * 32 + g) * 16 + s) * 64 + p0; const float* cim = CIM + ((size_t)(dir * 32 + g) * 16 + s) * 64 + p0;
        const f32x2* pwp = POW + ((size_t)(dir * 32 + g) * 33 + (dir ? 32 - tl : tl + 1)) * 64 + p0;
        const f32x4 cr0 = *(const f32x4*)cre, cr1 = *(const f32x4*)(cre + 4), ci0 = *(const f32x4*)cim, ci1 = *(const f32x4*)(cim + 4);
        const f32x4 pa = *(const f32x4*)pwp, pb = *(const f32x4*)(pwp + 2), pc = *(const f32x4*)(pwp + 4), pd = *(const f32x4*)(pwp + 6);
        float v[8];
        const float pr[8] = {pa[0], pa[2], pb[0], pb[2], pc[0], pc[2], pd[0], pd[2]}, pi[8] = {pa[1], pa[3], pb[1], pb[3], pc[1], pc[3], pd[1], pd[3]};
#pragma unroll
        for (int j = 0; j < 8; ++j) { const float cr = j < 4 ? cr0[j & 3] : cr1[j & 3], ci = j < 4 ? ci0[j & 3] : ci1[j & 3];
            v[j] = ri ? -(cr * pi[j] + ci * pr[j]) : cr * pr[j] - ci * pi[j]; }
        *(u32x4*)(W + ((size_t)g * 512 + n) * 768 + 512 + kb * 8) = (u32x4){pk2(v[0], v[1]), pk2(v[2], v[3]), pk2(v[4], v[5]), pk2(v[6], v[7])};
    }
}
DI void s5_carry_phase(const Params& p) {
    const int tid_ = get_tid(); const int lane = tid_ & 63, wid = tid_ >> 6;
    const f32x2* POW = (const f32x2*)(p.ws + H_POW); const float* E = (const float*)(p.ws + H_E); bf16_t* UA = (bf16_t*)(p.ws + H_UA);
    for (int it = ((int)gridDim.x - 1 - (int)blockIdx.x) * NWV + wid; it < 2 * 2 * 32; it += gridDim.x * NWV) {
        const int g = it & 31, dir = (it >> 5) & 1, b = it >> 6;
        const f32x2 l32 = POW[((size_t)(dir * 32 + g) * 33 + 32) * 64 + lane];
        float hr = 0.f, hi = 0.f;
        float er[8], ei[8], fr_[8], fi_[8];
#define C_IDX(i_) ((size_t)g * CHR + b * NCK + (dir ? ((i_) < 8 ? 7 - (i_) : NCK - 1 - ((i_) - 8)) : (i_)))
#define C_LOAD(R, I, i0_) do { _Pragma("unroll") for (int j = 0; j < 8; ++j) { const size_t m = C_IDX((i0_) + j); R[j] = E[m * 256 + dir * 128 + lane]; I[j] = E[m * 256 + dir * 128 + 64 + lane]; } } while (0)
#define C_STEP(R, I, i0_) do { _Pragma("unroll") for (int j = 0; j < 8; ++j) { const size_t m = C_IDX((i0_) + j); bf16_t* u = UA + m * 768 + 512 + dir * 128 + lane; \
            u[0] = (bf16_t)(pk2(hr, 0.f) & 0xffff); u[64] = (bf16_t)(pk2(hi, 0.f) & 0xffff); \
            const float nr = l32[0] * hr - l32[1] * hi + R[j], ni = l32[0] * hi + l32[1] * hr + I[j]; hr = nr; hi = ni; } } while (0)
        C_LOAD(er, ei, 0);
        for (int i0 = 0; i0 < NCK; i0 += 16) {
            if (i0 + 8 < NCK) C_LOAD(fr_, fi_, i0 + 8);
            C_STEP(er, ei, i0);
            if (i0 + 8 < NCK) { if (i0 + 16 < NCK) C_LOAD(er, ei, i0 + 16); C_STEP(fr_, fi_, i0 + 8); }
        }
#undef C_IDX
#undef C_LOAD
#undef C_STEP
    }
}

DI float rope64(float x, int lane, const float* ROPE, int rpos, int cpos) {
    const float partner = __shfl_xor(x, 16);
    const int i = lane & 15; const int pos = lane < 32 ? rpos : cpos;
    const float c = ROPE[(pos * 16 + i) * 2], s = ROPE[(pos * 16 + i) * 2 + 1];
    return (lane & 16) ? x * c + partner * s : x * c - partner * s;
}
DI void mla_prep_phase(const Params& p) {
    const int tid_ = get_tid(); const int lane = tid_ & 63, wid = tid_ >> 6;
    bf16_t* QR = (bf16_t*)(p.ws + S_QRAW); const bf16_t* KN = (const bf16_t*)(p.ws + S_KNOPE); const float* KR = (const float*)(p.ws + H_KR);
    bf16_t* KA = (bf16_t*)(p.ws + S_KA); const float* ROPE = (const float*)(p.ws + T_ROPE);
    const float qsc = 0.07216878364870323f * LOG2E;
    const float qg0 = p.in[27][lane], qg1 = p.in[27][64 + lane], qg2 = p.in[27][128 + lane];
    const float kg0 = p.in[28][lane], kg1 = p.in[28][64 + lane], kg2 = p.in[28][128 + lane];
    const int nbusy = (int)gridDim.x < 192 ? (int)gridDim.x : 192, nslots = nbusy + 3 * ((int)gridDim.x - nbusy);
    const int vb_ = virt_block();
    const int myslots = vb_ < nbusy ? 1 : 3, slot0 = vb_ < nbusy ? vb_ : nbusy + 3 * (vb_ - nbusy);
    for (int sj = 0; sj < myslots; ++sj)
    for (int r = (slot0 + sj) * NWV + wid; r < NR; r += nslots * NWV) {
        const bool lat = r >= NCTX; const int b = row_batch(r), tp = row_tpos(r); const int t = tp - CTX;
        const bf16_t* q = QR + (size_t)r * 768; const bf16_t* kn = KN + (size_t)r * 512;
        float x[4][3], k[4][3];
        const float krv = KR[(size_t)r * 64 + lane];
#pragma unroll
        for (int h = 0; h < 4; ++h) { x[h][0] = bf2f(q[h * 192 + lane]); x[h][1] = bf2f(q[h * 192 + 64 + lane]); x[h][2] = bf2f(q[h * 192 + 128 + lane]);
            k[h][0] = bf2f(kn[h * 128 + lane]); k[h][1] = bf2f(kn[h * 128 + 64 + lane]); k[h][2] = krv; }
        float rc = 1.f, rsn = 0.f;
        if (lat) { const int pos = lane < 32 ? (t >> 6) : (t & 63); rc = ROPE[(pos * 16 + (lane & 15)) * 2]; rsn = ROPE[(pos * 16 + (lane & 15)) * 2 + 1]; }
        const float sgn = (lane & 16) ? 1.f : -1.f;
#pragma unroll
        for (int h = 0; h < 4; ++h) {
            float ss = wave_sum(x[h][0] * x[h][0] + x[h][1] * x[h][1] + x[h][2] * x[h][2]);
            float rs = rsqrtf(ss * (1.f / 192.f) + 1e-6f) * qsc;
            const float x0 = x[h][0] * rs * qg0, x1 = x[h][1] * rs * qg1; float x2 = x[h][2] * rs * qg2;
            x2 = x2 * rc + sgn * __shfl_xor(x2, 16) * rsn;
            bf16_t* qd = QR + (size_t)r * 768 + h * 192;
            qd[lane] = (bf16_t)(pk2(x0, 0.f) & 0xffff); qd[64 + lane] = (bf16_t)(pk2(x1, 0.f) & 0xffff); qd[128 + lane] = (bf16_t)(pk2(x2, 0.f) & 0xffff);
            ss = wave_sum(k[h][0] * k[h][0] + k[h][1] * k[h][1] + k[h][2] * k[h][2]);
            rs = rsqrtf(ss * (1.f / 192.f) + 1e-6f);
            const float k0 = k[h][0] * rs * kg0, k1 = k[h][1] * rs * kg1; float k2 = k[h][2] * rs * kg2;
            k2 = k2 * rc + sgn * __shfl_xor(k2, 16) * rsn;
            bf16_t* kd = KA + ((size_t)(b * 4 + h) * TK + tp) * 192;
            kd[lane] = (bf16_t)(pk2(k0, 0.f) & 0xffff); kd[64 + lane] = (bf16_t)(pk2(k1, 0.f) & 0xffff); kd[128 + lane] = (bf16_t)(pk2(k2, 0.f) & 0xffff);
        }
    }
}

__global__ void __launch_bounds__(NTHREADS, 2) fwd_kernel(Params p) {
    extern __shared__ __attribute__((aligned(16))) char lds[];
    cg::grid_group grid = cg::this_grid();
    char* ws = p.ws;
    const bf16_t* WB = (const bf16_t*)ws;
    const float* MOD = (const float*)(ws + T_MOD);
    float* H = (float*)(ws + OFF_H);
    bf16_t* Hb = (bf16_t*)(ws + OFF_H);
    bf16_t* A0 = (bf16_t*)(ws + OFF_A0);
    const int bid = blockIdx.x, nb = gridDim.x;
    const int vbid = virt_block();
    volatile LAS unsigned* xst = (volatile LAS unsigned*)(lds + (LDS_BYTES - 16));
    if (threadIdx.x == 0) { xst[0] = 0u; xst[1] = 0u; }
    __syncthreads();
    const XcdBarrier xb = xcd_barrier_post((unsigned*)(ws + T_BAR), xst);
    if (p.pad == 0x7fffffff) grid.sync();
#define GRID_SYNC() xcd_barrier(xb)

    { const int npair = p.jobs[4].tile0 >> 1, nit = 192 + 12 + npair;
      for (int it = bid; it < nit; it += nb) {
          if (it < 192) ada_item(lds, p, it);
          else if (it < 204) tables_item(p, it - 192);
          else { const int lt0 = (it - 204) * 2 + (int)(threadIdx.x >> 8); const bool live = lt0 < p.jobs[4].tile0; const int lt = live ? lt0 : 0; int j = 0;
#pragma unroll
              for (int q = 1; q < 11; ++q) if (lt >= p.jobs[q].tile0) j = q;
              transpose_tile(lds, ws, p.jobs[j], lt - p.jobs[j].tile0, live); } } }
    GRID_SYNC();
    modulate_rows(p, 0, 0, true, 0);
    s5_kk_phase(lds, p);
    GRID_SYNC();
    { EpiWin0 e{(bf16_t*)(ws + H_UA), (bf16_t*)(ws + S_CQN), (bf16_t*)(ws + S_CKVN), (float*)(ws + S_SSP), (float*)(ws + H_KR)};
      pg8::EpiHead<EpiWin0> pe{e}; pg8::gemm_phase((LAS unsigned char*)lds, pg8::Gemm{A0, WB + W_IN0, 1024, 1024}, pg8::Order{0, NR / 256, 5, (int)nb, vbid}, pe); }
    s5_w1a_phase(p);
    { int rk, nrk; slack_rank((NR / 256) * 5, rk, nrk); transpose_range(lds, ws, p, p.jobs[4].tile0, p.jobs[7].tile0, rk, nrk); }
    GRID_SYNC();
    s5_w1b_phase(p);
    { EpiS1a e{(float*)(ws + H_E)};
      (void)e; pg8::EpiS1a pe{(float*)(ws + H_E)}; pg8::gemm_phase((LAS unsigned char*)lds, pg8::Gemm{(const bf16_t*)(ws + H_UA), (const bf16_t*)(ws + H_W1A), 768, 512, (size_t)CHR * 768, (size_t)256 * 512}, pg8::Order{0, 3, 1, (int)nb, vbid, 32}, pe); }
    { int rk, nrk; slack_rank(96, rk, nrk); transpose_range(lds, ws, p, p.jobs[7].tile0, p.jobs[9].tile0, rk, nrk); }
    GRID_SYNC();
    s5_carry_phase(p);
    { EpiBf16 e{(bf16_t*)(ws + S_QRAW), 768, (const float*)(ws + S_SSP)};
      gemm_phase(lds, (const bf16_t*)(ws + S_CQN), 384, WB + W_QB, 384, 0, NR / 256, 3, e); }
    { EpiKV e{(bf16_t*)(ws + S_KNOPE), (bf16_t*)(ws + S_VT), (const float*)(ws + S_SSP)};
      gemm_phase(lds, (const bf16_t*)(ws + S_CKVN), 256, WB + W_KVB, 256, 0, NR / 256, 4, e, 1, 0, 0, 1, nb > 64 ? (int)nb - 16 : 0); }
    GRID_SYNC();
    { EpiS1b e{(bf16_t*)(ws + S_YG)};
      (void)e; pg8::EpiS1b pe{(bf16_t*)(ws + S_YG)}; pg8::gemm_phase((LAS unsigned char*)lds, pg8::Gemm{(const bf16_t*)(ws + H_UA), (const bf16_t*)(ws + A_W1B), 768, 768, (size_t)CHR * 768, (size_t)512 * 768}, pg8::Order{0, 3, 2, (int)nb, vbid, 32}, pe); }
    mla_prep_phase(p);
    GRID_SYNC();
    { const bf16_t* QR = (const bf16_t*)(ws + S_QRAW); const bf16_t* KA = (const bf16_t*)(ws + S_KA); const bf16_t* VT = (const bf16_t*)(ws + S_VT);
      const int nlat = 2 * 4 * 32, nall = nlat + 2 * 4;
      float mref; { float gq = 0.f, gk = 0.f;
        for (int d_ = 0; d_ < 192; ++d_) { gq = fmaxf(gq, fabsf(p.in[27][d_])); gk = fmaxf(gk, fabsf(p.in[28][d_])); }
        mref = 13.856406f * LOG2E * 1.02f * gq * gk; }
      for (int it0 = bid; it0 < nlat + nb; it0 += nb) {
          const int it = it0 < nlat ? it0 : nlat + (it0 - nlat) - (nb - 8);
          if (it0 >= nlat && (it < nlat || it >= nall)) continue;
          if (it < nlat) { const int h = it & 3, b = (it >> 2) & 1, qb = it >> 3;   const size_t row = NCTX + (size_t)b * SEQ + qb * 256;
              attn_item<192, 128, false>(lds, QR + row * 768 + h * 192, 768, KA + (size_t)(b * 4 + h) * TK * 192, VT + (size_t)(b * 4 + h) * 128 * TK, 0, TK / 64, 0, 0, mref, 0.f,
                                         A0 + row * 1024 + 512 + h * 128, 1024, 0); }
          else { const int j = it - nlat; const int h = j & 3, b = j >> 2; const size_t row = (size_t)b * CTX;
              attn_item<192, 128, false>(lds, QR + row * 768 + h * 192, 768, KA + (size_t)(b * 4 + h) * TK * 192, VT + (size_t)(b * 4 + h) * 128 * TK, 0, 4, 0, 0, mref, 0.f,
                                         A0 + row * 1024 + 512 + h * 128, 1024, 0); } }
      EpiGLU e{(const bf16_t*)(ws + S_YG), p.in[22], A0};
      gemm_phase(lds, (const bf16_t*)(ws + S_YG), 512, WB + W_GLU, 512, 0, NR / 256, 2, e); }
    GRID_SYNC();
    { EpiRes e{p.in[2], p.in[0], H, H + (size_t)NCTX * 1024, MOD + 0 * 3 * 6144 + 2048, 0};
      (void)e; { pg8::EpiRes pe{p.in[0], nullptr, Hb + (size_t)NCTX * 1024, nullptr, MOD + 0 * 3 * 6144 + 2048}; pg8::gemm_phase((LAS unsigned char*)lds, pg8::Gemm{A0, WB + W_OUT0, 1024, 1024}, pg8::Order{2, NLAT / 256, 4, (int)nb, vbid}, pe); }
      thin_gemm_ctx<4>(lds, A0, 1024, WB + W_OUT0, 1024, p.in[2], nullptr, Hb, MOD + 0 * 3 * 6144 + 2048); }
    GRID_SYNC();
    modulate_rows(p, 0, 1, false, 0);
    GRID_SYNC();
    { EpiSwiGLU e{(bf16_t*)(ws + S_HID)};
      (void)e; pg8::EpiSwiGLU pe{(bf16_t*)(ws + S_HID)}; pg8::gemm_phase((LAS unsigned char*)lds, pg8::Gemm{A0, WB + W_GU0, 1024, 1024}, pg8::Order{0, NR / 256, 22, (int)nb, vbid}, pe); }
    { int rk, nrk; slack_rank((NR / 256) * 22, rk, nrk); transpose_range(lds, ws, p, p.jobs[9].tile0, p.jobs[9].tile0 + 704, rk, nrk); }
    GRID_SYNC();
    { EpiRes e{H, H + (size_t)NCTX * 1024, H, H + (size_t)NCTX * 1024, MOD + 0 * 3 * 6144 + 5120, 0};
      (void)e; { pg8::EpiRes pe{nullptr, Hb + (size_t)NCTX * 1024, Hb + (size_t)NCTX * 1024, nullptr, MOD + 0 * 3 * 6144 + 5120}; pg8::gemm_phase((LAS unsigned char*)lds, pg8::Gemm{(const bf16_t*)(ws + S_HID), WB + W_D0, FH, FH}, pg8::Order{2, NLAT / 256, 4, (int)nb, vbid}, pe); }
      thin_gemm_ctx<11>(lds, (const bf16_t*)(ws + S_HID), FH, WB + W_D0, FH, nullptr, Hb, Hb, MOD + 0 * 3 * 6144 + 5120); }
    GRID_SYNC();
    modulate_rows(p, 1, 0, false, 0);
    GRID_SYNC();
    { EpiWin1 e{(bf16_t*)(ws + S1_Q), (bf16_t*)(ws + S1_K), (bf16_t*)(ws + S1_VT), p.in[31], p.in[32], (const float*)(ws + T_ROPE)};
      pg8::EpiHead<EpiWin1> pe{e}; pg8::gemm_phase((LAS unsigned char*)lds, pg8::Gemm{A0, WB + W_IN1, 1024, 1024}, pg8::Order{0, NR / 256, 6, (int)nb, vbid}, pe); }
    { int rk, nrk; slack_rank((NR / 256) * 6, rk, nrk); transpose_range(lds, ws, p, p.jobs[9].tile0 + 704, p.njobtiles, rk, nrk); }
    GRID_SYNC();
    { const bf16_t* Q = (const bf16_t*)(ws + S1_Q); const bf16_t* K1 = (const bf16_t*)(ws + S1_K); const bf16_t* VT = (const bf16_t*)(ws + S1_VT);
      constexpr int WNH = 2;
      const int nit = 2 * 4 * (4 / WNH) * 32;
      float mref; { float gq = 0.f, gk = 0.f;
        for (int d_ = 0; d_ < 64; ++d_) { gq = fmaxf(gq, fabsf(p.in[31][d_])); gk = fmaxf(gk, fabsf(p.in[32][d_])); }
        mref = 8.f * LOG2E * 1.02f * gq * gk; }
      for (int it = bid; it < nit; it += nb) { const int kvh = it & 3, b = (it >> 2) & 1, rest = it >> 3; const int gp = rest % (4 / WNH), i = rest / (4 / WNH); const int hq0 = kvh * 4 + gp * WNH;
          const size_t row = NCTX + (size_t)b * SEQ + i * 256;
          const int l0 = (4 * i - 2) < 0 ? 0 : (4 * i - 2), l1 = (4 * i + 6) > 128 ? 128 : (4 * i + 6);
          win_attn_item<WNH>(lds, Q + row * 1024 + hq0 * 64, K1 + (size_t)(b * 4 + kvh) * TK * 64, VT + (size_t)(b * 4 + kvh) * 64 * TK, 4 + l0, 4 + l1, mref, p.in[33] + hq0, A0 + row * 1024 + hq0 * 64, i * 256); } }
    GRID_SYNC();
    { EpiRes e{H, H + (size_t)NCTX * 1024, nullptr, H + (size_t)NCTX * 1024, MOD + 1 * 3 * 6144 + 2048, 0};
      (void)e; pg8::EpiRes pe{nullptr, Hb + (size_t)NCTX * 1024, Hb + (size_t)NCTX * 1024, nullptr, MOD + 1 * 3 * 6144 + 2048}; pg8::gemm_phase((LAS unsigned char*)lds, pg8::Gemm{A0, WB + W_OUT1, 1024, 1024}, pg8::Order{2, NLAT / 256, 4, (int)nb, vbid}, pe); }
    GRID_SYNC();
    modulate_rows(p, 1, 1, false, NCTX);
    GRID_SYNC();
    { EpiSwiGLU e{(bf16_t*)(ws + S_HID)};
      (void)e; pg8::EpiSwiGLU pe{(bf16_t*)(ws + S_HID)}; pg8::gemm_phase((LAS unsigned char*)lds, pg8::Gemm{A0, WB + W_GU1, 1024, 1024}, pg8::Order{2, NLAT / 256, 22, (int)nb, vbid}, pe); }
    GRID_SYNC();
    { EpiRes e{H, H + (size_t)NCTX * 1024, nullptr, p.out, MOD + 1 * 3 * 6144 + 5120, 0};
      (void)e; pg8::EpiRes pe{nullptr, Hb + (size_t)NCTX * 1024, nullptr, p.out, MOD + 1 * 3 * 6144 + 5120}; pg8::gemm_phase((LAS unsigned char*)lds, pg8::Gemm{(const bf16_t*)(ws + S_HID), WB + W_D1, FH, FH}, pg8::Order{2, NLAT / 256, 4, (int)nb, vbid}, pe); }
}

extern "C" void kernel_launch(void* const* d_in, const int* in_sizes, int n_in, void* d_out, int out_size, void* d_ws, size_t ws_size, hipStream_t stream) {
    static int grid_blocks = 0;
    if (grid_blocks == 0) {
        if (n_in != 34 || ws_size < WS_NEED2) { fprintf(stderr, "kernel_launch: unexpected n_in %d / ws %zu (need %zu)\n", n_in, ws_size, (size_t)WS_NEED2); grid_blocks = -1; return; }
        int dev = 0, cus = 0, per_cu = 0;
        (void)hipGetDevice(&dev);
        (void)hipDeviceGetAttribute(&cus, hipDeviceAttributeMultiprocessorCount, dev);
        (void)hipFuncSetAttribute((const void*)fwd_kernel, hipFuncAttributeMaxDynamicSharedMemorySize, LDS_BYTES);
        (void)hipOccupancyMaxActiveBlocksPerMultiprocessor(&per_cu, (const void*)fwd_kernel, NTHREADS, LDS_BYTES);
        if (per_cu < 1) { fprintf(stderr, "kernel_launch: occupancy query returned %d\n", per_cu); grid_blocks = -1; return; }
        if (per_cu > 1) per_cu = 1;
        grid_blocks = cus * per_cu;
        fprintf(stderr, "kernel_launch: grid %d (%d CUs x %d)\n", grid_blocks, cus, per_cu);
    }
    if (grid_blocks < 0) return;
    Params p{};
    for (int i = 0; i < 34; ++i) p.in[i] = (const float*)d_in[i];
    p.out = (float*)d_out; p.ws = (char*)d_ws;
    const float* fg = p.in[8]; const float* fu = p.in[9]; const float* fd = p.in[10];
    const size_t FW = (size_t)1024 * FH;
    int t0 = 0;
    auto mk = [&](int idx, const float* a, const float* b, size_t dst, int K, int ld, int npad, int mode) {
        Job& j = p.jobs[idx]; j.a = a; j.b = b; j.ks = nullptr; j.dst = dst; j.K = K; j.ld = ld; j.ntk = K / 64; j.ntn = npad / 64; j.tile0 = t0; j.mode = mode; t0 += j.ntk * j.ntn; };
    mk(0, p.in[11], nullptr, W_IN0, 1024, 1216, 1280, 2);
    mk(1, p.in[24], nullptr, W_QB, 384, 768, 768, 0);
    mk(2, p.in[26], nullptr, W_KVB, 256, 1024, 1024, 0);
    p.jobs[1].ks = p.in[23]; p.jobs[2].ks = p.in[25];
    mk(3, p.in[21], nullptr, W_GLU, 512, 512, 512, 0);
    mk(4, p.in[12], nullptr, W_OUT0, 1024, 1024, 1024, 0);
    mk(5, fg, fu, W_GU0, 1024, FH, 5632, 1);
    mk(6, fd, nullptr, W_D0, FH, 1024, 1024, 0);
    mk(7, p.in[29], nullptr, W_IN1, 1024, 1536, 1536, 2);
    mk(8, p.in[30], nullptr, W_OUT1, 1024, 1024, 1024, 0);
    mk(9, fg + FW, fu + FW, W_GU1, 1024, FH, 5632, 1);
    mk(10, fd + FW, nullptr, W_D1, FH, 1024, 1024, 0);
    p.njobtiles = t0;
    if (hipMemsetAsync((char*)d_ws + T_BAR, 0, XCD_BAR_WORDS * 4, stream) != hipSuccess) { fprintf(stderr, "kernel_launch: memset failed\n"); return; }
    void* args[] = {&p};
    hipError_t e = hipLaunchCooperativeKernel((const void*)fwd_kernel, dim3(grid_blocks), dim3(NTHREADS), args, LDS_BYTES, stream);
    if (e != hipSuccess) fprintf(stderr, "cooperative launch failed: %s (grid %d)\n", hipGetErrorString(e), grid_blocks);
}
```

```cpp
#include <hip/hip_runtime.h>
#include <hip/hip_cooperative_groups.h>
#include <cstdio>
#include <cstdint>
namespace cg = cooperative_groups;

#define DI __device__ __forceinline__
typedef unsigned short bf16_t;
typedef short bf16x8 __attribute__((ext_vector_type(8)));
typedef short s16x4 __attribute__((ext_vector_type(4)));
typedef float f32x4 __attribute__((ext_vector_type(4)));
typedef float f32x2 __attribute__((ext_vector_type(2)));
typedef float f32x16 __attribute__((ext_vector_type(16)));
typedef unsigned u32x4 __attribute__((ext_vector_type(4)));
typedef unsigned u32x2 __attribute__((ext_vector_type(2)));
typedef __bf16 bf16v2 __attribute__((ext_vector_type(2)));

constexpr int DM = 1024, NBATCH = 2, SEQ = 8192, CTX = 256;
constexpr int NCTX = NBATCH * CTX;
constexpr int NLAT = NBATCH * SEQ;
constexpr int NR = NCTX + NLAT;
constexpr int TK = CTX + SEQ;
constexpr int FH = 2816;
constexpr int NCH = TK / 64;
constexpr float LOG2E = 1.4426950408889634f;
constexpr int LDS_BYTES = 131072 + 64;
constexpr int NTHREADS = 512, NWV = 8;

constexpr size_t W_IN0 = 0;
constexpr size_t W_QB = W_IN0 + (size_t)1280 * 1024;
constexpr size_t W_KVB = W_QB + (size_t)768 * 384;
constexpr size_t W_GLU = W_KVB + (size_t)1024 * 256;
constexpr size_t W_OUT0 = W_GLU + (size_t)512 * 512;
constexpr size_t W_GU0 = W_OUT0 + (size_t)1024 * 1024;
constexpr size_t W_D0 = W_GU0 + (size_t)5632 * 1024;
constexpr size_t W_IN1 = W_D0 + (size_t)1024 * 2816;
constexpr size_t W_OUT1 = W_IN1 + (size_t)1536 * 1024;
constexpr size_t W_GU1 = W_OUT1 + (size_t)1024 * 1024;
constexpr size_t W_D1 = W_GU1 + (size_t)5632 * 1024;
constexpr size_t W_END = W_D1 + (size_t)1024 * 2816;
constexpr size_t OFF_TAB = W_END * 2;
constexpr size_t T_MOD = OFF_TAB;
constexpr size_t T_ROPE = T_MOD + 2 * 3 * 6144 * 4;
constexpr size_t T_LAMB = T_ROPE + 128 * 16 * 2 * 4;
constexpr size_t T_LAM64 = T_LAMB + 2 * 32 * 64 * 8;
constexpr size_t T_BBAR = T_LAM64 + 2 * 32 * 64 * 8;
constexpr size_t T_BAR = T_BBAR + (size_t)2 * 32 * 64 * 16 * 8;
constexpr size_t OFF_H = OFF_TAB + (1u << 20);
constexpr size_t OFF_A0 = OFF_H + (size_t)NR * 1024 * 4;
constexpr size_t OFF_S = OFF_A0 + (size_t)NR * 1024 * 2;
constexpr size_t WS_NEED = OFF_S + (size_t)108134400;
constexpr size_t S_SSP = WS_NEED;
constexpr size_t WS_NEED2 = S_SSP + (size_t)NR * 10 * 4;
static_assert(WS_NEED2 <= ((size_t)256 << 20) && OFF_S + (size_t)NR * FH * 2 <= WS_NEED, "workspace");
constexpr int SL = 32;
constexpr int NCK = TK / SL;
constexpr int CHR = NBATCH * NCK;
constexpr size_t H_UA = OFF_H;
constexpr size_t H_KR = H_UA + (size_t)(32 * CHR + 256) * 768 * 2;
constexpr size_t H_E = H_KR + (size_t)NR * 64 * 4;
constexpr size_t H_KK = H_E + (size_t)32 * CHR * 256 * 4;
constexpr size_t H_POW = H_KK + (size_t)32 * 2 * 32 * 256 * 4;
constexpr size_t H_W1A = H_POW + (size_t)4096 * 33 * 8;
static_assert(H_W1A + (size_t)32 * 256 * 512 * 2 <= OFF_A0, "H region overflow");
constexpr size_t A_W1B = OFF_A0;
constexpr size_t S_CQN = OFF_S;
constexpr size_t S_CKVN = S_CQN + (size_t)NR * 384 * 2;
constexpr size_t S_YG = OFF_S;
constexpr size_t S_X = S_CKVN + (size_t)NR * 256 * 2;
constexpr size_t S_CQKV = S_X;
constexpr size_t S_QRAW = S_X;
constexpr size_t S_KNOPE = S_QRAW + (size_t)NR * 768 * 2;
constexpr size_t S_VT = S_KNOPE + (size_t)NR * 512 * 2;
constexpr size_t S_KA = S_VT + (size_t)2 * 4 * 128 * TK * 2;
static_assert(S_CQKV + (size_t)NR * 640 * 4 <= S_VT, "CQKV overlaps VT");
static_assert(S_KA + (size_t)2 * 4 * TK * 192 * 2 <= WS_NEED, "scratch overflow");
constexpr size_t S_HID = OFF_S;
constexpr size_t S1_Q = OFF_S;
constexpr size_t S1_KRAW = S1_Q + (size_t)NR * 1024 * 2;
constexpr size_t S1_K = S1_KRAW + (size_t)NR * 256 * 4;
constexpr size_t S1_VT = S1_K + (size_t)2 * 4 * TK * 64 * 2;

struct Job { const float* a; const float* b; const float* ks; unsigned long long dst; int K, ld, ntk, ntn, tile0, mode; };
struct Params {
    const float* in[34];
    float* out;
    char* ws;
    Job jobs[11];
    int njobtiles;
    int pad;
};

DI int get_tid() { int t = threadIdx.x; asm volatile("" : "+v"(t)); return t; }
DI unsigned pk2(float lo, float hi) { f32x2 v = {lo, hi}; return __builtin_bit_cast(unsigned, __builtin_convertvector(v, bf16v2)); }
DI float bf2f(unsigned short b) { return __uint_as_float(((unsigned)b) << 16); }
DI f32x4 ld_bf4(const bf16_t* q) { const u32x2 w = *(const u32x2*)q; return (f32x4){__uint_as_float(w[0] << 16), __uint_as_float(w[0] & 0xffff0000u), __uint_as_float(w[1] << 16), __uint_as_float(w[1] & 0xffff0000u)}; }
DI f32x4 ld_bf4_nt(const bf16_t* q) { const u32x2 w = __builtin_nontemporal_load((const u32x2*)q); return (f32x4){__uint_as_float(w[0] << 16), __uint_as_float(w[0] & 0xffff0000u), __uint_as_float(w[1] << 16), __uint_as_float(w[1] & 0xffff0000u)}; }
DI void st_bf4(bf16_t* q, f32x4 v) { *(u32x2*)q = (u32x2){pk2(v[0], v[1]), pk2(v[2], v[3])}; }
DI float wave_sum(float v) {
#pragma unroll
    for (int o = 32; o > 0; o >>= 1) v += __shfl_xor(v, o);
    return v;
}
DI int row_vec(int r) { return r < NCTX ? 2 : (r - NCTX) / SEQ; }
DI int row_batch(int r) { return r < NCTX ? r / CTX : (r - NCTX) / SEQ; }
DI int row_tpos(int r) { return r < NCTX ? r % CTX : CTX + (r - NCTX) % SEQ; }
DI float sigmoidf_(float x) { return __builtin_amdgcn_rcpf(1.f + __expf(-x)); }
DI float siluf_(float x) { return x * __builtin_amdgcn_rcpf(1.f + __expf(-x)); }
DI float gelu_tanh(float y) { const float z = 0.7978845608028654f * (y + 0.044715f * y * y * y); const float t = 1.f - 2.f * __builtin_amdgcn_rcpf(1.f + __expf(2.f * z)); return 0.5f * y * (1.f + t); }
DI void my_sincos(float x, float& s, float& c) {
    const float q = rintf(x * 0.636619772367581f);
    float r = fmaf(-q, 1.5703125f, x);
    r = fmaf(-q, 4.837512969970703125e-4f, r);
    r = fmaf(-q, 7.54978995489188216e-8f, r);
    const int qi = (int)q;
    const float r2 = r * r;
    const float sp = r + r * r2 * (-1.6666654611e-1f + r2 * (8.3321608736e-3f + r2 * (-1.9515295891e-4f)));
    const float cp = 1.0f - 0.5f * r2 + r2 * r2 * (4.166664568298827e-2f + r2 * (-1.388731625493765e-3f + r2 * 2.443315711809948e-5f));
    const int k = qi & 3;
    s = (k == 0) ? sp : (k == 1) ? cp : (k == 2) ? -sp : -cp;
    c = (k == 0) ? cp : (k == 1) ? -sp : (k == 2) ? -cp : sp;
}


#define XB_TMO      128
#define XB_XCNT(j)  (256  + 64 * (j))
#define XB_XSUB(j)  (1280 + 64 * (j))
#define XB_XGEN(j)  (2304 + 64 * (j))
#define XB_TOP      3328
#define XB_TOPGEN   3392
#define XCD_BAR_WORDS 3456
#define XB_SPIN_CAP (1u << 22)
#define LAS __attribute__((address_space(3)))
DI unsigned xb_ld(unsigned* p) { return __hip_atomic_load(p, __ATOMIC_RELAXED, __HIP_MEMORY_SCOPE_AGENT); }
DI unsigned xb_add(unsigned* p, unsigned v) { return __hip_atomic_fetch_add(p, v, __ATOMIC_RELAXED, __HIP_MEMORY_SCOPE_AGENT); }
DI unsigned xb_xcc_id() { return (unsigned)__builtin_amdgcn_s_getreg((3 << 11) | 20) & 0xFu; }
#define XB_SPIN(cond, bar) do { unsigned _sp = 0; while (cond) { __builtin_amdgcn_s_sleep(1); \
    if ((++_sp & 255u) == 0u) { if (xb_ld(&(bar)[XB_TMO])) break; if (_sp > XB_SPIN_CAP) { atomicAdd(&(bar)[XB_TMO], 1u); break; } } } } while (0)
struct XcdBarrier { unsigned* bar; unsigned x; volatile LAS unsigned* st; };
DI XcdBarrier xcd_barrier_post(unsigned* bar, volatile LAS unsigned* st) {
    XcdBarrier b; b.bar = bar; b.x = xb_xcc_id(); b.st = st;
    if (threadIdx.x == 0) (void)xb_add(&bar[XB_XCNT(b.x)], 1u);
    return b;
}
DI void xcd_barrier_complete(unsigned* bar, unsigned x, unsigned& nloc, unsigned& nx) {
    const unsigned G = gridDim.x * gridDim.y * gridDim.z;
    unsigned sum, cnt, mine, sp = 0u;
    for (;;) {
        sum = 0u; cnt = 0u; mine = 0u;
#pragma unroll
        for (unsigned j = 0; j < 16; ++j) { const unsigned c = xb_ld(&bar[XB_XCNT(j)]); sum += c; cnt += (c > 0u) ? 1u : 0u; mine = (j == x) ? c : mine; }
        if (sum == G) break;
        __builtin_amdgcn_s_sleep(1);
        if ((++sp & 255u) == 0u) { if (xb_ld(&bar[XB_TMO])) break; if (sp > XB_SPIN_CAP) { atomicAdd(&bar[XB_TMO], 1u); break; } }
    }
    nloc = mine > 0u ? mine : 1u; nx = cnt > 0u ? cnt : 1u;
}
DI void xcd_barrier(const XcdBarrier& b) {
    asm volatile("s_waitcnt vmcnt(0)" ::: "memory");
    __syncthreads();
    if (threadIdx.x == 0) {
        unsigned* bar = b.bar;
        __builtin_amdgcn_s_waitcnt(0);
        unsigned nloc = b.st[0], nx = b.st[1];
        if (nloc == 0u) { xcd_barrier_complete(bar, b.x, nloc, nx); b.st[0] = nloc; b.st[1] = nx; }
        const unsigned old = xb_add(&bar[XB_XSUB(b.x)], 1u);
        const unsigned gen = old / nloc;
        if (old + 1u == (gen + 1u) * nloc) {
            __builtin_amdgcn_fence(__ATOMIC_RELEASE, "agent");
            asm volatile("s_waitcnt vmcnt(0)" ::: "memory");
            const unsigned og = xb_add(&bar[XB_TOP], 1u);
            const unsigned tg = og / nx;
            if (og + 1u == (tg + 1u) * nx) xb_add(&bar[XB_TOPGEN], 1u);
            else XB_SPIN(xb_ld(&bar[XB_TOPGEN]) == tg, bar);
            __builtin_amdgcn_fence(__ATOMIC_ACQUIRE, "agent");
            xb_add(&bar[XB_XGEN(b.x)], 1u);
            asm volatile("s_waitcnt vmcnt(0)" ::: "memory");
        } else {
            XB_SPIN(xb_ld(&bar[XB_XGEN(b.x)]) == gen, bar);
            __builtin_amdgcn_fence(__ATOMIC_ACQUIRE, "agent");
            asm volatile("s_waitcnt vmcnt(0)" ::: "memory");
        }
    }
    __syncthreads();
}

DI void transpose_tile(char* lds, char* ws, const Job& jb, int lt, bool live) {
    const int tid512 = get_tid(); const int tid = tid512 & 255;
    float (*tile)[65] = (float (*)[65])(lds + (tid512 >> 8) * 17408);
    const int tk = lt % jb.ntk, tn = lt / jb.ntk;
    const int k0 = tk * 64, n0 = tn * 64;
    const int c4 = (tid & 15) * 4, rq = tid >> 4;
    const float* src; int col; bool valid = live;
    if (jb.mode == 0) { src = jb.a; col = n0 + c4; valid = live && col < jb.ld; }
    else if (jb.mode == 2) { src = jb.a; const int rho = (n0 + c4) & 255; col = (n0 + c4 - rho) + 64 * ((rho >> 5) & 3) + 32 * (rho >> 7) + (rho & 31); valid = live && col < jb.ld; }
    else { const int nsub = c4 >> 4, i = c4 & 15; src = (nsub & 1) ? jb.b : jb.a; col = tn * 32 + (nsub >> 1) * 16 + i; }
#pragma unroll
    for (int kk = 0; kk < 4; ++kk) { const int k = kk * 16 + rq; f32x4 v = valid ? __builtin_nontemporal_load((const f32x4*)(src + (size_t)(k0 + k) * jb.ld + col)) : (f32x4){0.f, 0.f, 0.f, 0.f};
        if (jb.ks) v = v * jb.ks[k0 + k];
        tile[k][c4] = v[0]; tile[k][c4 + 1] = v[1]; tile[k][c4 + 2] = v[2]; tile[k][c4 + 3] = v[3]; }
    __syncthreads();
    const int r = tid >> 2, ks = (tid & 3) * 16;
    unsigned w[8];
#pragma unroll
    for (int q = 0; q < 8; ++q) w[q] = pk2(tile[ks + 2 * q][r], tile[ks + 2 * q + 1][r]);
    bf16_t* d = (bf16_t*)(ws) + jb.dst + (size_t)(n0 + r) * jb.K + k0 + ks;
    if (live) { *(u32x4*)d = (u32x4){w[0], w[1], w[2], w[3]};
    *(u32x4*)(d + 8) = (u32x4){w[4], w[5], w[6], w[7]}; }
    __syncthreads();
}

DI void transpose_range(char* lds, char* ws, const Params& p, int t_begin, int t_end, int rank, int nranks) {
    if (rank < 0) return;
    for (int pr = (t_begin >> 1) + rank; pr < (t_end >> 1); pr += nranks) {
        const int lt = pr * 2 + (int)(threadIdx.x >> 8); int j = 0;
#pragma unroll
        for (int q = 1; q < 11; ++q) if (lt >= p.jobs[q].tile0) j = q;
        transpose_tile(lds, ws, p.jobs[j], lt - p.jobs[j].tile0, true);
    }
}
DI int virt_block() { const int G_ = gridDim.x; return ((G_ & 7) == 0) ? (int)(blockIdx.x & 7) * (G_ >> 3) + (int)(blockIdx.x >> 3) : (int)blockIdx.x; }
DI void slack_rank(int ntile, int& rank, int& nranks) { const int rem = ntile % (int)gridDim.x; const int vb = virt_block(); if (rem == 0) { rank = vb; nranks = gridDim.x; } else { rank = vb - rem; nranks = (int)gridDim.x - rem; } }

DI void ada_item(char* lds, const Params& p, int it) {
    float* sil = (float*)lds;
    float* red = sil + 3072;
    float* MOD = (float*)(p.ws + T_MOD);
    const int tid = get_tid(), layer = it / 96, n0 = (it % 96) * 64;
    for (int i = tid; i < 3072; i += NTHREADS) { const int v = i >> 10, k = i & 1023; const float x = v < 2 ? p.in[1][v * 1024 + k] : p.in[3][k]; sil[i] = siluf_(x); }
    __syncthreads();
    const int j4 = (tid & 15) * 4, kg = tid >> 4;
    const float* W = p.in[4] + (size_t)layer * 1024 * 6144 + n0 + j4;
    f32x4 a0 = {0.f, 0.f, 0.f, 0.f}, a1 = a0, a2 = a0;
#pragma unroll 8
    for (int k = kg * 32; k < kg * 32 + 32; ++k) { const f32x4 w = __builtin_nontemporal_load((const f32x4*)(W + (size_t)k * 6144)); a0 += sil[k] * w; a1 += sil[1024 + k] * w; a2 += sil[2048 + k] * w; }
    *(f32x4*)(red + (kg * 3 + 0) * 64 + j4) = a0; *(f32x4*)(red + (kg * 3 + 1) * 64 + j4) = a1; *(f32x4*)(red + (kg * 3 + 2) * 64 + j4) = a2;
    __syncthreads();
    if (tid < 192) { const int v = tid >> 6, jj = tid & 63;
        float s = p.in[5][layer * 6144 + n0 + jj];
#pragma unroll 8
        for (int q = 0; q < 32; ++q) s += red[(q * 3 + v) * 64 + jj];
        MOD[(layer * 3 + v) * 6144 + n0 + jj] = s; }
    __syncthreads();
}

DI void tables_item(const Params& p, int it) {
    const int tid = get_tid();
    if (it < 4) {
        const int e = it * 512 + tid, pos = e >> 4, i = e & 15;
        const float inv = exp2f(-(float)i * (13.287712379549449f / 16.f));
        float s, c; my_sincos((float)pos * inv, s, c);
        float* ROPE = (float*)(p.ws + T_ROPE); ROPE[e * 2] = c; ROPE[e * 2 + 1] = s;
    } else {
        const int e = (it - 4) * 512 + tid;
        const int dg = e >> 6;
        const float lr = p.in[13][e], li = p.in[14][e], step = expf(p.in[15][dg]);
        const float a = lr * step, b = li * step;
        const float ea = expf(a);
        float sb, cb; my_sincos(b, sb, cb);
        float sh, ch; my_sincos(0.5f * b, sh, ch);
        const float em1 = a * (1.f + a * 0.5f * (1.f + a * (1.f / 3.f) * (1.f + a * 0.25f * (1.f + a * 0.2f * (1.f + a * (1.f / 6.f))))));
        const float lbr = ea * cb, lbi = ea * sb;
        const float nr = em1 * cb - 2.f * sh * sh, ni = ea * sb;
        const float den = lr * lr + li * li;
        const float qr = (nr * lr + ni * li) / den, qi = (ni * lr - nr * li) / den;
        f32x2* BB = (f32x2*)(p.ws + T_BBAR);
#pragma unroll
        for (int s = 0; s < 16; ++s) { const float br = p.in[16][e * 16 + s], bi = p.in[17][e * 16 + s]; BB[e * 16 + s] = (f32x2){qr * br - qi * bi, qr * bi + qi * br}; }
        f32x2* POW = (f32x2*)(p.ws + H_POW) + (size_t)dg * 33 * 64 + (e & 63);
        float pr = 1.f, pi = 0.f;
        for (int q = 0; q <= 32; ++q) { POW[q * 64] = (f32x2){pr, pi}; const float nr2 = pr * lbr - pi * lbi, ni2 = pr * lbi + pi * lbr; pr = nr2; pi = ni2; }
    }
}

DI void modulate_rows(const Params& p, int layer, int which, bool from_inputs, int r0) {
    const int tid_ = get_tid(); const int lane = tid_ & 63, wid = tid_ >> 6;
    const float* gain = p.in[which ? 7 : 6] + layer * 1024;
    const float* modl = (const float*)(p.ws + T_MOD) + layer * 3 * 6144 + (which ? 3072 : 0);
    const bf16_t* Hb = (const bf16_t*)(p.ws + OFF_H);
    bf16_t* dst = (bf16_t*)(p.ws + OFF_A0);
    const int stride = gridDim.x * NWV;
    for (int ra = r0 + blockIdx.x * NWV + wid; ra < NR; ra += 2 * stride) {
        const int rb = ra + stride; const bool hb = rb < NR; const int rbb = hb ? rb : ra;
        const float* srca = ra < NCTX ? p.in[2] + (size_t)ra * 1024 : p.in[0] + (size_t)(ra - NCTX) * 1024;
        const float* srcb = rbb < NCTX ? p.in[2] + (size_t)rbb * 1024 : p.in[0] + (size_t)(rbb - NCTX) * 1024;
        f32x4 xa[4], xb[4]; float sa = 0.f, sb = 0.f;
#pragma unroll
        for (int i = 0; i < 4; ++i) { if (from_inputs) { xa[i] = __builtin_nontemporal_load((const f32x4*)(srca + i * 256 + lane * 4)); xb[i] = __builtin_nontemporal_load((const f32x4*)(srcb + i * 256 + lane * 4)); }
                                      else { xa[i] = ld_bf4(Hb + (size_t)ra * 1024 + i * 256 + lane * 4); xb[i] = ld_bf4(Hb + (size_t)rbb * 1024 + i * 256 + lane * 4); } }
#pragma unroll
        for (int i = 0; i < 4; ++i) { sa += xa[i][0] * xa[i][0] + xa[i][1] * xa[i][1] + xa[i][2] * xa[i][2] + xa[i][3] * xa[i][3];
                                      sb += xb[i][0] * xb[i][0] + xb[i][1] * xb[i][1] + xb[i][2] * xb[i][2] + xb[i][3] * xb[i][3]; }
        sa = wave_sum(sa); sb = wave_sum(sb);
        const float rsa = rsqrtf(sa * (1.f / 1024.f) + 1e-6f), rsb = rsqrtf(sb * (1.f / 1024.f) + 1e-6f);
        const float* mva = modl + row_vec(ra) * 6144; const float* mvb = modl + row_vec(rbb) * 6144;
#pragma unroll
        for (int i = 0; i < 4; ++i) { const int c = i * 256 + lane * 4;
            const f32x4 g = *(const f32x4*)(gain + c);
            { const f32x4 sh = *(const f32x4*)(mva + c), sc = *(const f32x4*)(mva + 1024 + c); const f32x4 y = xa[i] * rsa * g * (1.f + sc) + sh;
              *(u32x2*)(dst + (size_t)ra * 1024 + c) = (u32x2){pk2(y[0], y[1]), pk2(y[2], y[3])}; }
            if (hb) { const f32x4 sh = *(const f32x4*)(mvb + c), sc = *(const f32x4*)(mvb + 1024 + c); const f32x4 y = xb[i] * rsb * g * (1.f + sc) + sh;
              *(u32x2*)(dst + (size_t)rb * 1024 + c) = (u32x2){pk2(y[0], y[1]), pk2(y[2], y[3])}; } }
    }
}

template <class Epi>
DI void gemm_phase(char* lds, const bf16_t* A0_, int lda, const bf16_t* Bt0_, int K, int mt0, int nmt, int nnt, const Epi& epi, int nbatch = 1, size_t sA = 0, size_t sB = 0, int ksplit = 1, int gact = 0) {
    const int tid = get_tid(), lane = tid & 63, wid = tid >> 6, wr = wid >> 2, wc = wid & 3, fr = lane & 15, fq = lane >> 4;
    const int nk = (K >> 6) / ksplit;
    const int lrow = tid >> 3, lc = tid & 7, lkc = lc * 8;
    const int woff = lrow * 128 + ((lc ^ ((lrow >> 1) & 7)) << 4);
    const int ra0 = (wr * 128 + fr) * 128 + ((fq ^ (fr >> 1)) << 4);
    const int ra1 = (wr * 128 + fr) * 128 + (((4 + fq) ^ (fr >> 1)) << 4);
    const int rb0 = 32768 + (wc * 64 + fr) * 128 + ((fq ^ (fr >> 1)) << 4);
    const int rb1 = 32768 + (wc * 64 + fr) * 128 + (((4 + fq) ^ (fr >> 1)) << 4);
    const int per = nmt * nnt, ntile = nbatch * per * ksplit;
    const int PM = nnt >= 8 ? 4 : 8;
    const int GA = gact > 0 ? gact : (int)gridDim.x;
    const int myn = ((int)blockIdx.x < GA && (int)blockIdx.x < ntile) ? (ntile - (int)blockIdx.x + GA - 1) / GA : 0;
    const int total = myn * nk;
    f32x4 acc[8][4];
#pragma unroll
    for (int m = 0; m < 8; ++m)
#pragma unroll
        for (int n = 0; n < 4; ++n) acc[m][n] = (f32x4){0.f, 0.f, 0.f, 0.f};
    int iti = 0, ikt = 0;
    const int srow = wid * 32 + (lane >> 3);
    const bf16_t* Ag = A0_; const bf16_t* Bg = Bt0_;
#define G_STAGE(bufoff) do { if (ikt == 0) { const int u_ = blockIdx.x + iti * GA; const int t_ = u_ / ksplit, sl_ = u_ - t_ * ksplit; const int gb_ = t_ / per, tr_ = t_ - gb_ * per; const int ch_ = tr_ / (PM * nnt), rm_ = tr_ - ch_ * PM * nnt; const int pc_ = (nmt - ch_ * PM) < PM ? (nmt - ch_ * PM) : PM; const int tn_ = rm_ / pc_, tm_ = ch_ * PM + (rm_ - tn_ * pc_); \
            Ag = A0_ + (size_t)gb_ * sA + (size_t)((mt0 + tm_) * 256) * lda + sl_ * nk * 64; Bg = Bt0_ + (size_t)gb_ * sB + (size_t)(tn_ * 256) * K + sl_ * nk * 64; } \
        _Pragma("unroll") for (int i = 0; i < 4; ++i) { const int row_ = srow + 8 * i; const int c_ = ((lane & 7) ^ ((row_ >> 1) & 7)) * 8; \
            __builtin_amdgcn_global_load_lds((const unsigned*)(Ag + (size_t)row_ * lda + ikt * 64 + c_), (LAS unsigned*)(lds + (bufoff) + (wid * 4 + i) * 1024), 16, 0, 0); \
            __builtin_amdgcn_global_load_lds((const unsigned*)(Bg + (size_t)row_ * K + ikt * 64 + c_), (LAS unsigned*)(lds + (bufoff) + 32768 + (wid * 4 + i) * 1024), 16, 0, 0); } \
        if (++ikt == nk) { ikt = 0; ++iti; } } while (0)
#define G_COMPUTE(bufoff) do { _Pragma("unroll") for (int ks = 0; ks < 2; ++ks) { bf16x8 a[8], b[4]; \
        _Pragma("unroll") for (int m = 0; m < 8; ++m) a[m] = *(const bf16x8*)(lds + (bufoff) + (ks ? ra1 : ra0) + m * 2048); \
        _Pragma("unroll") for (int n = 0; n < 4; ++n) b[n] = *(const bf16x8*)(lds + (bufoff) + (ks ? rb1 : rb0) + n * 2048); \
        _Pragma("unroll") for (int m = 0; m < 8; ++m) _Pragma("unroll") for (int n = 0; n < 4; ++n) acc[m][n] = __builtin_amdgcn_mfma_f32_16x16x32_bf16(b[n], a[m], acc[m][n], 0, 0, 0); } } while (0)
    __syncthreads();
    if (total > 0) G_STAGE(0);
    asm volatile("s_waitcnt vmcnt(0)" ::: "memory");
    __syncthreads();
    int cti = 0, ckt = 0;
    for (int q = 0; q < total; ++q) {
        const int cur = (q & 1) * 65536;
        if (q + 1 < total) G_STAGE(cur ^ 65536);
        G_COMPUTE(cur);
        asm volatile("s_waitcnt vmcnt(0)" ::: "memory");
        __syncthreads();
        if (++ckt == nk) {
            const int u_ = blockIdx.x + cti * GA; const int t_ = u_ / ksplit; const int gb_ = t_ / per, tr_ = t_ - gb_ * per; const int ch_ = tr_ / (PM * nnt), rm_ = tr_ - ch_ * PM * nnt; const int pc_ = (nmt - ch_ * PM) < PM ? (nmt - ch_ * PM) : PM; const int tn_ = rm_ / pc_, tm_ = ch_ * PM + (rm_ - tn_ * pc_);
            epi(acc, (mt0 + tm_) * 256 + wr * 128 + fr, tn_ * 256 + wc * 64 + fq * 4, gb_);
#pragma unroll
            for (int m = 0; m < 8; ++m)
#pragma unroll
                for (int n = 0; n < 4; ++n) acc[m][n] = (f32x4){0.f, 0.f, 0.f, 0.f};
            ckt = 0; ++cti;
        }
    }
#undef G_STAGE
#undef G_COMPUTE
}

template <int KSP>
DI void thin_gemm_ctx(char* lds, const bf16_t* A, int lda, const bf16_t* Bt, int K, const float* res_f, const bf16_t* res_h, bf16_t* dst, const float* gate) {
    const int tid = get_tid(), lane = tid & 63, wid = tid >> 6, fr = lane & 15, fq = lane >> 4;
    float* part = (float*)lds;
    for (int t = blockIdx.x; t < 256; t += gridDim.x) {
        const int m0 = (t >> 5) * 64, n0 = (t & 31) * 32;
        f32x4 acc[4][2];
#pragma unroll
        for (int m = 0; m < 4; ++m) { acc[m][0] = (f32x4){0.f, 0.f, 0.f, 0.f}; acc[m][1] = (f32x4){0.f, 0.f, 0.f, 0.f}; }
        const bf16_t* Ap = A + (size_t)(m0 + fr) * lda + wid * (KSP * 32) + fq * 8;
        const bf16_t* Bp = Bt + (size_t)(n0 + fr) * K + wid * (KSP * 32) + fq * 8;
#pragma unroll
        for (int k = 0; k < KSP; ++k) {
            bf16x8 a[4], b[2];
#pragma unroll
            for (int m = 0; m < 4; ++m) a[m] = *(const bf16x8*)(Ap + (size_t)m * 16 * lda + k * 32);
#pragma unroll
            for (int n = 0; n < 2; ++n) b[n] = *(const bf16x8*)(Bp + (size_t)n * 16 * K + k * 32);
#pragma unroll
            for (int m = 0; m < 4; ++m)
#pragma unroll
                for (int n = 0; n < 2; ++n) acc[m][n] = __builtin_amdgcn_mfma_f32_16x16x32_bf16(b[n], a[m], acc[m][n], 0, 0, 0);
        }
        __syncthreads();
#pragma unroll
        for (int m = 0; m < 4; ++m)
#pragma unroll
            for (int n = 0; n < 2; ++n) *(f32x4*)(part + ((wid * 64 + m * 16 + fr) * 32 + n * 16 + fq * 4)) = acc[m][n];
        __syncthreads();
        { const int row = tid >> 3, c4 = (tid & 7) * 4; f32x4 sum = (f32x4){0.f, 0.f, 0.f, 0.f};
#pragma unroll
          for (int w = 0; w < 8; ++w) sum += *(const f32x4*)(part + ((w * 64 + row) * 32 + c4));
          const size_t off = (size_t)(m0 + row) * 1024 + n0 + c4;
          const f32x4 g = *(const f32x4*)(gate + 2 * 6144 + n0 + c4), x = res_h ? ld_bf4(res_h + off) : *(const f32x4*)(res_f + off);
          st_bf4(dst + off, x + g * sum); }
    }
    __syncthreads();
}

struct EpiWin0 {
    bf16_t* UA; bf16_t* CQN; bf16_t* CKVN; float* SSP; float* KR;
    template <int NM> DI void run(const f32x4 (&acc)[NM][4], int row0, int col0) const {
        const int cw = col0 & ~63;
#pragma unroll
        for (int m = 0; m < NM; ++m) { const int ri = row0 + m * 16; const size_t r = ri;
            if (cw < 512) { const int b = row_batch(ri), tp = row_tpos(ri);
#pragma unroll
                for (int n = 0; n < 4; ++n) { const int c = col0 + n * 16; const f32x4 v = acc[m][n]; const int g = c >> 4, s0 = c & 15;
                    *(u32x2*)(UA + ((size_t)g * CHR + b * NCK + (tp >> 5)) * 768 + (tp & 31) * 16 + s0) = (u32x2){pk2(v[0], v[1]), pk2(v[2], v[3])}; }
            } else if (cw < 1152) { const bool isq = cw < 896; bf16_t* dst = isq ? CQN + r * 384 + (col0 - 512) : CKVN + r * 256 + (col0 - 896);
                float ss = 0.f;
#pragma unroll
                for (int n = 0; n < 4; ++n) { const f32x4 v = acc[m][n]; ss += v[0] * v[0] + v[1] * v[1] + v[2] * v[2] + v[3] * v[3];
                    *(u32x2*)(dst + n * 16) = (u32x2){pk2(v[0], v[1]), pk2(v[2], v[3])}; }
                ss += __shfl_xor(ss, 16); ss += __shfl_xor(ss, 32);
                if ((col0 & 15) == 0) SSP[r * 10 + ((cw - 512) >> 6)] = ss;
            } else if (cw < 1216) {
#pragma unroll
                for (int n = 0; n < 4; ++n) *(f32x4*)(KR + r * 64 + (col0 - 1152) + n * 16) = acc[m][n];
            } }
    }
    DI void operator()(const f32x4 (&acc)[8][4], int row0, int col0, int gb) const { run<8>(acc, row0, col0); }
};
struct EpiS1a {
    float* E;
    DI void operator()(const f32x4 (&acc)[8][4], int row0, int col0, int gb) const {
#pragma unroll
        for (int m = 0; m < 8; ++m) { const int r = row0 + m * 16; if (r >= CHR) continue;
#pragma unroll
            for (int n = 0; n < 4; ++n) *(f32x4*)(E + ((size_t)gb * CHR + r) * 256 + col0 + n * 16) = acc[m][n]; }
    }
};
struct EpiS1b {
    bf16_t* YG;
    DI void operator()(const f32x4 (&acc)[8][4], int row0, int col0, int gb) const {
#pragma unroll
        for (int m = 0; m < 8; ++m) { const int r = row0 + m * 16; if (r >= CHR) continue; const int b = r / NCK, c = r % NCK;
#pragma unroll
            for (int n = 0; n < 4; ++n) { const int cc = col0 + n * 16; const int tl = cc >> 4, s0 = cc & 15; const f32x4 v = acc[m][n];
                const int tp = c * SL + tl; const size_t row = tp < CTX ? (size_t)b * CTX + tp : (size_t)NCTX + (size_t)b * SEQ + (tp - CTX);
                *(u32x2*)(YG + row * 512 + gb * 16 + s0) = (u32x2){pk2(gelu_tanh(v[0]), gelu_tanh(v[1])), pk2(gelu_tanh(v[2]), gelu_tanh(v[3]))}; } }
    }
};
struct EpiBf16 {
    bf16_t* O; int ldo; const float* SSP;
    DI void operator()(const f32x4 (&acc)[8][4], int row0, int col0, int gb) const {
#pragma unroll
        for (int m = 0; m < 8; ++m) { const size_t r = row0 + m * 16; const float* sp = SSP + r * 10;
            const float rstd = rsqrtf(((sp[0] + sp[1]) + (sp[2] + sp[3]) + (sp[4] + sp[5])) * (1.f / 384.f) + 1e-6f);
#pragma unroll
            for (int n = 0; n < 4; ++n) { const int c = col0 + n * 16; const f32x4 v = acc[m][n] * rstd;
                *(u32x2*)(O + r * ldo + c) = (u32x2){pk2(v[0], v[1]), pk2(v[2], v[3])}; } }
    }
};
struct EpiKV {
    bf16_t* KNOPE; bf16_t* VT; const float* SSP;
    DI void operator()(const f32x4 (&acc)[8][4], int row0, int col0, int gb) const {
#pragma unroll
        for (int m = 0; m < 8; ++m) { const int r = row0 + m * 16; const int b = row_batch(r), tp = row_tpos(r); const float* sp = SSP + (size_t)r * 10 + 6;
            const float rstd = rsqrtf(((sp[0] + sp[1]) + (sp[2] + sp[3])) * (1.f / 256.f) + 1e-6f);
#pragma unroll
            for (int n = 0; n < 4; ++n) { const int c = col0 + n * 16; const int h = c >> 8, w = c & 255; const f32x4 v = acc[m][n] * rstd;
                if (w < 128) *(u32x2*)(KNOPE + (size_t)r * 512 + h * 128 + w) = (u32x2){pk2(v[0], v[1]), pk2(v[2], v[3])};
                else { bf16_t* d = VT + ((size_t)(b * 4 + h) * 128 + (w - 128)) * TK + tp; const unsigned p0 = pk2(v[0], v[1]), p1 = pk2(v[2], v[3]);
                    d[0] = (bf16_t)(p0 & 0xffff); d[TK] = (bf16_t)(p0 >> 16); d[2 * TK] = (bf16_t)(p1 & 0xffff); d[3 * TK] = (bf16_t)(p1 >> 16); } } }
    }
};
struct EpiGLU {
    const bf16_t* YG; const float* bias; bf16_t* CAT;
    DI void operator()(const f32x4 (&acc)[8][4], int row0, int col0, int gb) const {
#pragma unroll
        for (int m = 0; m < 8; ++m) { const size_t r = row0 + m * 16;
#pragma unroll
            for (int n = 0; n < 4; ++n) { const int c = col0 + n * 16; const f32x4 v = acc[m][n]; const f32x4 bv = *(const f32x4*)(bias + c);
                const u32x2 yy = *(const u32x2*)(YG + r * 512 + c);
                const float y0 = __uint_as_float(yy[0] << 16), y1 = __uint_as_float(yy[0] & 0xffff0000u), y2 = __uint_as_float(yy[1] << 16), y3 = __uint_as_float(yy[1] & 0xffff0000u);
                const float o0 = y0 * sigmoidf_(v[0] + bv[0]), o1 = y1 * sigmoidf_(v[1] + bv[1]), o2 = y2 * sigmoidf_(v[2] + bv[2]), o3 = y3 * sigmoidf_(v[3] + bv[3]);
                *(u32x2*)(CAT + r * 1024 + c) = (u32x2){pk2(o0, o1), pk2(o2, o3)}; } }
    }
};
struct EpiRes {
    const float* res_ctx; const float* res_lat; float* dst_ctx; float* dst_lat; const float* gate; int atomic;
    DI void operator()(const f32x4 (&acc)[8][4], int row0, int col0, int gb) const {
#pragma unroll
        for (int m = 0; m < 8; ++m) { const int r = row0 + m * 16;
            const float* rs = r < NCTX ? res_ctx + (size_t)r * 1024 : res_lat + (size_t)(r - NCTX) * 1024;
            float* ds = r < NCTX ? dst_ctx + (size_t)r * 1024 : dst_lat + (size_t)(r - NCTX) * 1024;
            if (r < NCTX && dst_ctx == nullptr) continue;
            const float* gv = gate + row_vec(r) * 6144;
#pragma unroll
            for (int n = 0; n < 4; ++n) { const int c = col0 + n * 16; const f32x4 g = *(const f32x4*)(gv + c);
                if (atomic) { const f32x4 v = g * acc[m][n];
#pragma unroll
                    for (int j = 0; j < 4; ++j) (void)__hip_atomic_fetch_add(ds + c + j, v[j], __ATOMIC_RELAXED, __HIP_MEMORY_SCOPE_AGENT); }
                else { const f32x4 x = *(const f32x4*)(rs + c); *(f32x4*)(ds + c) = x + g * acc[m][n]; } } }
    }
};
struct EpiSwiGLU {
    bf16_t* HID;
    DI void operator()(const f32x4 (&acc)[8][4], int row0, int col0, int gb) const {
        const int hc = (col0 >> 6) * 32 + (col0 & 15);
#pragma unroll
        for (int m = 0; m < 8; ++m) { const size_t r = row0 + m * 16;
#pragma unroll
            for (int q = 0; q < 2; ++q) { const f32x4 g = acc[m][2 * q], u = acc[m][2 * q + 1];
                const float o0 = siluf_(g[0]) * u[0], o1 = siluf_(g[1]) * u[1], o2 = siluf_(g[2]) * u[2], o3 = siluf_(g[3]) * u[3];
                *(u32x2*)(HID + r * FH + hc + q * 16) = (u32x2){pk2(o0, o1), pk2(o2, o3)}; } }
    }
};
struct EpiWin1 {
    bf16_t* Q; bf16_t* K1; bf16_t* VT; const float* qn; const float* kn; const float* ROPE;
    template <int NM> DI void run(const f32x4 (&acc)[NM][4], int row0, int col0) const {
        const int cw = col0 & ~63, i0 = col0 & 15;
        if (cw >= 1280) {
#pragma unroll
            for (int m = 0; m < NM; ++m) { const int r = row0 + m * 16; const int b = row_batch(r), tp = row_tpos(r);
#pragma unroll
                for (int n = 0; n < 4; ++n) { const int cc = col0 + n * 16 - 1280, h = cc >> 6, d0 = cc & 63; const f32x4 v = acc[m][n];
                    bf16_t* d = VT + ((size_t)(b * 4 + h) * 64 + d0) * TK + tp; const unsigned p0 = pk2(v[0], v[1]), p1 = pk2(v[2], v[3]);
                    d[0] = (bf16_t)(p0 & 0xffff); d[TK] = (bf16_t)(p0 >> 16); d[2 * TK] = (bf16_t)(p1 & 0xffff); d[3 * TK] = (bf16_t)(p1 >> 16); } }
            return;
        }
        const bool isq = cw < 1024;
        const float* gn = isq ? qn : kn;
        f32x4 g[4];
#pragma unroll
        for (int n = 0; n < 4; ++n) g[n] = *(const f32x4*)(gn + n * 16 + i0);
        const float osc = isq ? 0.125f * LOG2E : 1.f;
#pragma unroll
        for (int m = 0; m < NM; ++m) { const int r = row0 + m * 16; const bool lat = r >= NCTX;
            if (isq && !lat) continue;
            const int b = row_batch(r), tp = row_tpos(r), t = tp - CTX;
            float ss = 0.f;
#pragma unroll
            for (int n = 0; n < 4; ++n) { const f32x4 v = acc[m][n]; ss += v[0] * v[0] + v[1] * v[1] + v[2] * v[2] + v[3] * v[3]; }
            ss += __shfl_xor(ss, 16); ss += __shfl_xor(ss, 32);
            const float rstd = rsqrtf(ss * (1.f / 64.f) + 1e-6f);
            f32x4 y[4];
#pragma unroll
            for (int n = 0; n < 4; ++n) y[n] = acc[m][n] * rstd * g[n];
            if (lat) { const float* rr = ROPE + ((t >> 6) * 16 + i0) * 2; const float* rc = ROPE + ((t & 63) * 16 + i0) * 2;
#pragma unroll
                for (int j = 0; j < 4; ++j) { const float c0 = rr[2 * j], s0 = rr[2 * j + 1], c1 = rc[2 * j], s1 = rc[2 * j + 1];
                    const float a0 = y[0][j], a1 = y[1][j], a2 = y[2][j], a3 = y[3][j];
                    y[0][j] = a0 * c0 - a1 * s0; y[1][j] = a1 * c0 + a0 * s0; y[2][j] = a2 * c1 - a3 * s1; y[3][j] = a3 * c1 + a2 * s1; } }
            bf16_t* dst = isq ? Q + (size_t)r * 1024 + cw + i0 : K1 + ((size_t)(b * 4 + ((cw - 1024) >> 6)) * TK + tp) * 64 + i0;
#pragma unroll
            for (int n = 0; n < 4; ++n) *(u32x2*)(dst + n * 16) = (u32x2){pk2(y[n][0] * osc, y[n][1] * osc), pk2(y[n][2] * osc, y[n][3] * osc)};
        }
    }
    DI void operator()(const f32x4 (&acc)[8][4], int row0, int col0, int gb) const { run<8>(acc, row0, col0); }
};

namespace pg8 {
constexpr int BM = 256, BK = 64, HALF = 128, HTB = HALF * BK * 2;
DI int lds_byte(int r, int c) { const int st = (r >> 4) * 2 + (c >> 5), rr = r & 15, cc = c & 31, ob = rr * 64 + cc * 2; return st * 1024 + (ob ^ (((ob >> 9) & 1) << 5)); }
DI void stage_rc(int b, int& R, int& C) { const int st = b / 1024, sb = b % 1024, swz = sb ^ (((sb >> 9) & 1) << 5); R = (st >> 1) * 16 + swz / 64; C = (st & 1) * 32 + (swz % 64) / 2; }
struct Unit { int pm, pn, gb; };
struct Gemm { const bf16_t* A; const bf16_t* Bt; int lda, K; size_t sA = 0, sB = 0; };
struct Order {
    int mt0, nmt, nnt, G, c, nbatch = 1;
    DI bool next(int i, Unit& u) const { const int L0 = i * G + c; if (L0 >= nbatch * nmt * nnt) return false; constexpr int PM = 8; const int gb_ = L0 / (nmt * nnt); const int L = L0 - gb_ * nmt * nnt; u.gb = gb_;
        const int ch = L / (PM * nnt), rm = L - ch * PM * nnt; const int pc = (nmt - ch * PM) < PM ? (nmt - ch * PM) : PM; const int tn = rm / pc;
        u.pm = mt0 + ch * PM + (rm - tn * pc); u.pn = tn; return true; }
};
template <class Epi>
DI void gemm_phase(LAS unsigned char* lds, const Gemm g, const Order& S, const Epi& E) {
    const int tid = get_tid(), wid = __builtin_amdgcn_readfirstlane(tid >> 6), lane = tid & 63, wr = wid >> 2, wc = wid & 3, fr = lane & 15, fq = lane >> 4;
    const int K = g.K, nt = K / BK;
    unsigned voffA[2], voffB[2];
#pragma unroll
    for (int i = 0; i < 2; ++i) { int R, C; stage_rc(tid * 16 + i * 8192, R, C); voffA[i] = (unsigned)(R * g.lda + C) * 2u; voffB[i] = (unsigned)(R * K + C) * 2u; }
    const size_t kstep = (size_t)(BK * 2);
    const size_t hstepA = (size_t)HALF * g.lda * 2, hstepB = (size_t)HALF * K * 2;
    const size_t tstepA = 2 * hstepA, tstepB = 2 * hstepB;
    const unsigned ldsw = (unsigned)wid * 1024u;
    const int aoff = lds_byte(wr * 64 + fr, fq * 8), boff = lds_byte(wc * 32 + fr, fq * 8);
#define PG8_SA(b, h) (((b) * 2 + (h)) * HTB)
#define PG8_SB(b, h) ((4 + (b) * 2 + (h)) * HTB)
#define PG8_STAGE(bufoff, gbase, voff) do { _Pragma("unroll") for (int _i = 0; _i < 2; ++_i) \
        __builtin_amdgcn_global_load_lds((const unsigned*)((const char*)(gbase) + (voff)[_i]), (LAS unsigned*)(lds + (bufoff) + ldsw + _i * 8192), 16, 0, 0); } while (0)
#define PG8_LDA(dst, b, h) do { _Pragma("unroll") for (int m = 0; m < 4; ++m) _Pragma("unroll") for (int k = 0; k < 2; ++k) dst[m][k] = *(const LAS bf16x8*)(lds + PG8_SA(b, h) + aoff + m * 2048 + k * 1024); } while (0)
#define PG8_LDB(dst, b, h) do { _Pragma("unroll") for (int n = 0; n < 2; ++n) _Pragma("unroll") for (int k = 0; k < 2; ++k) dst[n][k] = *(const LAS bf16x8*)(lds + PG8_SB(b, h) + boff + n * 2048 + k * 1024); } while (0)
#define PG8_MMA(ai, bj, At, Bt) do { __builtin_amdgcn_s_setprio(1); _Pragma("unroll") for (int m = 0; m < 4; ++m) _Pragma("unroll") for (int n = 0; n < 2; ++n) _Pragma("unroll") for (int k = 0; k < 2; ++k) \
        acc[ai][bj][m][n] = __builtin_amdgcn_mfma_f32_16x16x32_bf16(Bt[n][k], At[m][k], acc[ai][bj][m][n], 0, 0, 0); __builtin_amdgcn_s_setprio(0); } while (0)
#define PG8_WAIT_V(n) asm volatile("s_waitcnt vmcnt(" #n ")" ::: "memory")
#define PG8_WAIT_L(n) asm volatile("s_waitcnt lgkmcnt(" #n ")" ::: "memory")
#define PG8_BAR __builtin_amdgcn_s_barrier()
#define PG8_SCHED __builtin_amdgcn_sched_barrier(0)
    Unit cur, nxt; int ui = 0;
    if (!S.next(0, cur)) return;
    f32x4 acc[2][2][4][2];
#pragma unroll
    for (int a = 0; a < 2; ++a)
#pragma unroll
        for (int b = 0; b < 2; ++b)
#pragma unroll
            for (int m = 0; m < 4; ++m)
#pragma unroll
                for (int n = 0; n < 2; ++n) acc[a][b][m][n] = (f32x4){0.f, 0.f, 0.f, 0.f};
    bf16x8 At[4][2], B0[2][2], B1[2][2];
    const char* cA = (const char*)(g.A + (size_t)cur.gb * g.sA) + (size_t)cur.pm * tstepA; const char* cB = (const char*)(g.Bt + (size_t)cur.gb * g.sB) + (size_t)cur.pn * tstepB;
    PG8_STAGE(PG8_SB(0, 0), cB, voffB); PG8_STAGE(PG8_SB(0, 1), cB + hstepB, voffB); PG8_STAGE(PG8_SA(0, 0), cA, voffA); PG8_STAGE(PG8_SA(0, 1), cA + hstepA, voffA);
    if (wr == 1) PG8_BAR;
    PG8_WAIT_V(2); PG8_BAR;
    PG8_STAGE(PG8_SB(1, 0), cB + kstep, voffB); PG8_STAGE(PG8_SA(1, 0), cA + kstep, voffA); PG8_STAGE(PG8_SB(1, 1), cB + hstepB + kstep, voffB);
    PG8_WAIT_V(6); PG8_BAR;
    for (;;) {
        const bool has_next = S.next(ui + 1, nxt);
        const char* nA = has_next ? (const char*)(g.A + (size_t)nxt.gb * g.sA) + (size_t)nxt.pm * tstepA : cA; const char* nB = has_next ? (const char*)(g.Bt + (size_t)nxt.gb * g.sB) + (size_t)nxt.pn * tstepB : cB;
        for (int t = 0; t < nt; t += 2) {
            const bool last = (t == nt - 2);
            const char* a1 = cA + (size_t)(t + 1) * kstep;
            const char* a2 = last ? nA : cA + (size_t)(t + 2) * kstep; const char* b2 = last ? nB : cB + (size_t)(t + 2) * kstep;
            const char* a3 = a2 + kstep; const char* b3 = b2 + kstep;
            PG8_LDB(B0, 0, 0); PG8_LDB(B1, 0, 1); PG8_SCHED; PG8_LDA(At, 0, 0); PG8_STAGE(PG8_SA(1, 1), a1 + hstepA, voffA);
            PG8_WAIT_V(8); PG8_WAIT_L(0); PG8_BAR; PG8_MMA(0, 0, At, B0); PG8_MMA(0, 1, At, B1); PG8_BAR; PG8_SCHED;
            PG8_LDA(At, 0, 1); PG8_STAGE(PG8_SB(0, 0), b2, voffB); PG8_STAGE(PG8_SB(0, 1), b2 + hstepB, voffB); PG8_STAGE(PG8_SA(0, 0), a2, voffA);
            PG8_WAIT_V(8); PG8_WAIT_L(0); PG8_BAR; PG8_MMA(1, 0, At, B0); PG8_MMA(1, 1, At, B1); PG8_BAR; PG8_SCHED;
            PG8_LDB(B0, 1, 0); PG8_LDB(B1, 1, 1); PG8_SCHED; PG8_LDA(At, 1, 0); PG8_STAGE(PG8_SA(0, 1), a2 + hstepA, voffA);
            PG8_WAIT_V(8); PG8_WAIT_L(0); PG8_BAR; PG8_MMA(0, 0, At, B0); PG8_MMA(0, 1, At, B1); PG8_BAR; PG8_SCHED;
            PG8_LDA(At, 1, 1); PG8_STAGE(PG8_SB(1, 0), b3, voffB); PG8_STAGE(PG8_SB(1, 1), b3 + hstepB, voffB); PG8_STAGE(PG8_SA(1, 0), a3, voffA);
            PG8_WAIT_V(8); PG8_WAIT_L(0); PG8_BAR; PG8_MMA(1, 0, At, B0); PG8_MMA(1, 1, At, B1); PG8_BAR; PG8_SCHED;
        }
        if (wr == 0) PG8_BAR;
        E(acc, cur, wr, wc, fr, fq);
        if (!has_next) break;
#pragma unroll
        for (int a = 0; a < 2; ++a)
#pragma unroll
            for (int b = 0; b < 2; ++b)
#pragma unroll
                for (int m = 0; m < 4; ++m)
#pragma unroll
                    for (int n = 0; n < 2; ++n) acc[a][b][m][n] = (f32x4){0.f, 0.f, 0.f, 0.f};
        cur = nxt; cA = nA; cB = nB; ++ui;
        if (wr == 1) PG8_BAR;
    }
    PG8_WAIT_V(0);
    PG8_BAR;
#undef PG8_SA
#undef PG8_SB
#undef PG8_STAGE
#undef PG8_LDA
#undef PG8_LDB
#undef PG8_MMA
#undef PG8_WAIT_V
#undef PG8_WAIT_L
#undef PG8_BAR
#undef PG8_SCHED
}
struct EpiRes {
    const float* res_f; const bf16_t* res_h; bf16_t* dst_h; float* dst_f; const float* gate;
    DI void operator()(const f32x4 (&acc)[2][2][4][2], const Unit& u, int wr, int wc, int fr, int fq) const {
        const int row0 = u.pm * 256 + wr * 64 + fr, col0 = u.pn * 256 + wc * 32 + fq * 4;
#pragma unroll
        for (int ai = 0; ai < 2; ++ai)
#pragma unroll
            for (int m = 0; m < 4; ++m) { const int r = row0 + 128 * ai + 16 * m; const size_t ro = (size_t)(r - NCTX) * 1024; const float* gv = gate + row_vec(r) * 6144;
#pragma unroll
                for (int bj = 0; bj < 2; ++bj)
#pragma unroll
                    for (int n = 0; n < 2; ++n) { const int c = col0 + 128 * bj + 16 * n; const f32x4 g_ = *(const f32x4*)(gv + c);
                        const f32x4 x = res_h ? (dst_f ? ld_bf4_nt(res_h + ro + c) : ld_bf4(res_h + ro + c)) : __builtin_nontemporal_load((const f32x4*)(res_f + ro + c));
                        const f32x4 y = x + g_ * acc[ai][bj][m][n];
                        if (dst_h) st_bf4(dst_h + ro + c, y); else __builtin_nontemporal_store(y, (f32x4*)(dst_f + ro + c)); } }
    }
};
struct EpiSwiGLU {
    bf16_t* HID;
    DI void operator()(const f32x4 (&acc)[2][2][4][2], const Unit& u, int wr, int wc, int fr, int fq) const {
        const int row0 = u.pm * 256 + wr * 64 + fr, hc0 = u.pn * 128 + wc * 16 + fq * 4;
#pragma unroll
        for (int ai = 0; ai < 2; ++ai)
#pragma unroll
            for (int m = 0; m < 4; ++m) { const size_t r = row0 + 128 * ai + 16 * m;
#pragma unroll
                for (int bj = 0; bj < 2; ++bj) { const f32x4 g_ = acc[ai][bj][m][0], u_ = acc[ai][bj][m][1];
                    const float o0 = siluf_(g_[0]) * u_[0], o1 = siluf_(g_[1]) * u_[1], o2 = siluf_(g_[2]) * u_[2], o3 = siluf_(g_[3]) * u_[3];
                    *(u32x2*)(HID + r * FH + hc0 + 64 * bj) = (u32x2){pk2(o0, o1), pk2(o2, o3)}; } }
    }
};
struct EpiS1a {
    float* E;
    DI void operator()(const f32x4 (&acc)[2][2][4][2], const Unit& u, int wr, int wc, int fr, int fq) const {
        const int row0 = u.pm * 256 + wr * 64 + fr, col0 = u.pn * 256 + wc * 32 + fq * 4;
#pragma unroll
        for (int ai = 0; ai < 2; ++ai)
#pragma unroll
            for (int m = 0; m < 4; ++m) { const int r = row0 + 128 * ai + 16 * m; if (r >= CHR) continue;
#pragma unroll
                for (int bj = 0; bj < 2; ++bj)
#pragma unroll
                    for (int n = 0; n < 2; ++n) *(f32x4*)(E + ((size_t)u.gb * CHR + r) * 256 + col0 + 128 * bj + 16 * n) = acc[ai][bj][m][n]; }
    }
};
struct EpiS1b {
    bf16_t* YG;
    DI void operator()(const f32x4 (&acc)[2][2][4][2], const Unit& u, int wr, int wc, int fr, int fq) const {
        const int row0 = u.pm * 256 + wr * 64 + fr, col0 = u.pn * 256 + wc * 32 + fq * 4;
#pragma unroll
        for (int ai = 0; ai < 2; ++ai)
#pragma unroll
            for (int m = 0; m < 4; ++m) { const int r = row0 + 128 * ai + 16 * m; if (r >= CHR) continue; const int b = r / NCK, c = r % NCK;
#pragma unroll
                for (int bj = 0; bj < 2; ++bj)
#pragma unroll
                    for (int n = 0; n < 2; ++n) { const int cc = col0 + 128 * bj + 16 * n; const int tl = cc >> 4, s0 = cc & 15; const f32x4 v = acc[ai][bj][m][n];
                        const int tp = c * SL + tl; const size_t row = tp < CTX ? (size_t)b * CTX + tp : (size_t)NCTX + (size_t)b * SEQ + (tp - CTX);
                        *(u32x2*)(YG + row * 512 + u.gb * 16 + s0) = (u32x2){pk2(gelu_tanh(v[0]), gelu_tanh(v[1])), pk2(gelu_tanh(v[2]), gelu_tanh(v[3]))}; } }
    }
};
template <class E> struct EpiHead { E e;
    DI void operator()(const f32x4 (&acc)[2][2][4][2], const Unit& u, int wr, int wc, int fr, int fq) const {
#pragma unroll
        for (int ai = 0; ai < 2; ++ai) { f32x4 t[4][4];
#pragma unroll
            for (int m = 0; m < 4; ++m)
#pragma unroll
                for (int sb = 0; sb < 4; ++sb) t[m][sb] = acc[ai][sb >> 1][m][sb & 1];
            e.template run<4>(t, u.pm * 256 + 128 * ai + wr * 64 + fr, u.pn * 256 + wc * 64 + fq * 4); }
    }
};
}

template <int DQK, int DV, bool WIN>
DI void attn_item(char* lds, const bf16_t* Q, int qstride, const bf16_t* Kb, const bf16_t* VTb, int ta0, int ta1, int tb0, int tb1,
                  float mref, float l_init, bf16_t* O, int ostride, int qpos0) {
    constexpr int NKS = DQK / 16, NDT = DV / 32, KSTR = DQK + 8, VSTR = 72, NG = NKS;
    constexpr int KCH = 64 * DQK / 8 / NTHREADS, VCH = DV * 8 / NTHREADS;
    constexpr int KBUF = 64 * KSTR, VBUF = DV * VSTR;
    bf16_t* Ks = (bf16_t*)lds; bf16_t* Vs = Ks + 2 * KBUF;
    const int tid = get_tid(), lane = tid & 63, wid = tid >> 6, r = lane & 31, h2 = lane >> 5;
    bf16x8 qf[NKS];
    { const bf16_t* qrow = Q + (size_t)(wid * 32 + r) * qstride + 8 * h2;
#pragma unroll
      for (int ks = 0; ks < NKS; ++ks) qf[ks] = *(const bf16x8*)(qrow + 16 * ks); }
    f32x16 o[NDT];
#pragma unroll
    for (int dt = 0; dt < NDT; ++dt)
#pragma unroll
        for (int i = 0; i < 16; ++i) o[dt][i] = 0.f;
    float lrun = (h2 == 0) ? l_init : 0.f;
    const int na = ta1 - ta0, ntot = na + (tb1 - tb0);
    u32x4 kr[KCH], vr[VCH];
    constexpr int KTPR = (DQK / 8) / KCH, VTPR = 8 / VCH;
    const int krow = tid / KTPR, kcol = (tid % KTPR) * (KCH * 8);
    const int vrow = tid / VTPR, vcol = (tid % VTPR) * (VCH * 8);
    const bf16_t* kgp = Kb + (size_t)krow * DQK + kcol;
    const bf16_t* vgp = VTb + (size_t)vrow * TK + vcol;
    bf16_t* ksp = Ks + krow * KSTR + kcol;
    bf16_t* vsp = Vs + vrow * VSTR + vcol;
    const bf16_t* kfp = Ks + r * KSTR + 8 * h2;
    const bf16_t* vfp = Vs + r * VSTR + 8 * h2;
#define A_TILE(itv) (((itv) < na) ? ta0 + (itv) : tb0 + ((itv) - na))
#define K_LOAD(itv) do { const bf16_t* kg = kgp + (size_t)A_TILE(itv) * 64 * DQK; _Pragma("unroll") for (int i = 0; i < KCH; ++i) kr[i] = *(const u32x4*)(kg + i * 8); } while (0)
#define V_LOADG(itv) do { const bf16_t* vg = vgp + A_TILE(itv) * 64; _Pragma("unroll") for (int i = 0; i < VCH; ++i) vr[i] = *(const u32x4*)(vg + i * 8); } while (0)
#define K_WRITE(bo) do { _Pragma("unroll") for (int i = 0; i < KCH; ++i) *(u32x4*)(ksp + (bo) + i * 8) = kr[i]; } while (0)
#define V_WRITE(bo) do { _Pragma("unroll") for (int i = 0; i < VCH; ++i) { const int c_ = (vcol >> 3) + i; bf16_t* d_ = vsp - vcol + (bo) + (c_ >> 1) * 16 + (c_ & 1) * 4; \
            *(u32x2*)d_ = (u32x2){vr[i][0], vr[i][1]}; *(u32x2*)(d_ + 8) = (u32x2){vr[i][2], vr[i][3]}; } } while (0)
#define T_ACTIVE(itv) (!(WIN && A_TILE(itv) >= 4 && ((A_TILE(itv) - 4) * 64 > qpos0 + wid * 32 + 31 + 128 || (A_TILE(itv) - 4) * 64 + 63 < qpos0 + wid * 32 - 128)))
#define S_MASK(S0, S1, itv) do { if (WIN && A_TILE(itv) >= 4) { const int qp = qpos0 + wid * 32 + r, kp0 = (A_TILE(itv) - 4) * 64 + 4 * h2; \
        _Pragma("unroll") for (int i = 0; i < 16; ++i) { const int d0 = kp0 + (i & 3) + 8 * (i >> 2) - qp, d1 = d0 + 32; \
            if (d0 > 128 || d0 < -128) S0[i] = -1e30f; if (d1 > 128 || d1 < -128) S1[i] = -1e30f; } } } while (0)
    f32x16 s0, s1;
    __syncthreads();
    K_LOAD(0); K_WRITE(0);
    if (1 < ntot) K_LOAD(1);
    V_LOADG(0);
    __syncthreads();
#pragma unroll
    for (int i = 0; i < 16; ++i) { s0[i] = -mref; s1[i] = -mref; }
#pragma unroll 1
    for (int it = -1; it < ntot; ++it) {
        const int kb_n = ((it + 1) & 1) * KBUF, vb_c = (it & 1) * VBUF;
        if (it + 2 < ntot) K_WRITE((it & 1) * KBUF);
        if (it + 1 < ntot) V_WRITE(((it + 1) & 1) * VBUF);
        __builtin_amdgcn_sched_barrier(0);
        const bool act_c = (it >= 0) && T_ACTIVE(it), act_n = (it + 1 < ntot) && T_ACTIVE(it + 1);
        f32x16 n0, n1;
#pragma unroll
        for (int i = 0; i < 16; ++i) { n0[i] = -mref; n1[i] = -mref; }
        float rs = 0.f;
        unsigned pk[16];
#define P_PAIR(j) do { const float e0_ = __builtin_amdgcn_exp2f((j) < 8 ? s0[2 * ((j) & 7)] : s1[2 * ((j) & 7)]), e1_ = __builtin_amdgcn_exp2f((j) < 8 ? s0[2 * ((j) & 7) + 1] : s1[2 * ((j) & 7) + 1]); rs += e0_ + e1_; pk[j] = pk2(e0_, e1_); } while (0)
        if (act_c && act_n) {
#pragma unroll
            for (int g = 0; g < NG; ++g) {
                const bf16x8 ka = *(const bf16x8*)(kfp + kb_n + 16 * g), kb = *(const bf16x8*)(kfp + kb_n + 32 * KSTR + 16 * g);
                n0 = __builtin_amdgcn_mfma_f32_32x32x16_bf16(ka, qf[g], n0, 0, 0, 0);
                n1 = __builtin_amdgcn_mfma_f32_32x32x16_bf16(kb, qf[g], n1, 0, 0, 0);
#pragma unroll
                for (int j = (16 * g) / NG; j < (16 * (g + 1)) / NG; ++j) P_PAIR(j);
            }
            S_MASK(n0, n1, it + 1);
        } else {
            if (act_n) {
#pragma unroll
                for (int ks = 0; ks < NKS; ++ks) { const bf16x8 k0 = *(const bf16x8*)(kfp + kb_n + 16 * ks), k1 = *(const bf16x8*)(kfp + kb_n + 32 * KSTR + 16 * ks);
                    n0 = __builtin_amdgcn_mfma_f32_32x32x16_bf16(k0, qf[ks], n0, 0, 0, 0); n1 = __builtin_amdgcn_mfma_f32_32x32x16_bf16(k1, qf[ks], n1, 0, 0, 0); }
                S_MASK(n0, n1, it + 1);
            }
            if (act_c) {
#pragma unroll
                for (int j = 0; j < 16; ++j) P_PAIR(j);
            }
        }
#undef P_PAIR
        __builtin_amdgcn_sched_barrier(0);
        if (it + 3 < ntot) K_LOAD(it + 3);
        if (it + 2 < ntot) V_LOADG(it + 2);
        __builtin_amdgcn_sched_barrier(0);
        if (act_c) {
            lrun += rs;
#pragma unroll
            for (int q = 0; q < 4; ++q) {
                const u32x4 pw = {pk[4 * q], pk[4 * q + 1], pk[4 * q + 2], pk[4 * q + 3]};
                const bf16x8 pf = __builtin_bit_cast(bf16x8, pw);
#pragma unroll
                for (int dt = 0; dt < NDT; ++dt) { const bf16x8 vf = *(const bf16x8*)(vfp + vb_c + (32 * dt) * VSTR + 16 * q);
                    o[dt] = __builtin_amdgcn_mfma_f32_32x32x16_bf16(vf, pf, o[dt], 0, 0, 0); }
            }
        }
        s0 = n0; s1 = n1;
        __syncthreads();
    }
#undef A_TILE
#undef K_LOAD
#undef V_LOADG
#undef K_WRITE
#undef V_WRITE
#undef T_ACTIVE
#undef S_MASK
    lrun += __shfl_xor(lrun, 32);
    const float inv = 1.f / lrun;
    bf16_t* orow = O + (size_t)(wid * 32 + r) * ostride;
#pragma unroll
    for (int dt = 0; dt < NDT; ++dt)
#pragma unroll
        for (int g = 0; g < 4; ++g)
            *(u32x2*)(orow + 32 * dt + 8 * g + 4 * h2) = (u32x2){pk2(o[dt][4 * g] * inv, o[dt][4 * g + 1] * inv), pk2(o[dt][4 * g + 2] * inv, o[dt][4 * g + 3] * inv)};
    __syncthreads();
}

template <int NH>
DI void win_attn_item(char* lds, const bf16_t* Q, const bf16_t* Kb, const bf16_t* VTb, int tb0, int tb1, float mref, const float* sinkp, bf16_t* O, int qpos0) {
    constexpr int KSTR = 72, VSTR = 72, KBUF = 64 * KSTR, VBUF = 64 * VSTR;
    bf16_t* Ks = (bf16_t*)lds; bf16_t* Vs = Ks + 2 * KBUF;
    const int tid = get_tid(), lane = tid & 63, wid = tid >> 6, r = lane & 31, h2 = lane >> 5;
    bf16x8 qf[NH][4];
#pragma unroll
    for (int h = 0; h < NH; ++h) { const bf16_t* qrow = Q + (size_t)(wid * 32 + r) * 1024 + h * 64 + 8 * h2;
#pragma unroll
        for (int ks = 0; ks < 4; ++ks) qf[h][ks] = *(const bf16x8*)(qrow + 16 * ks); }
    f32x16 o[NH][2]; float lrun[NH];
#pragma unroll
    for (int h = 0; h < NH; ++h) { lrun[h] = (h2 == 0) ? __builtin_amdgcn_exp2f(sinkp[h] * LOG2E - mref) : 0.f;
#pragma unroll
        for (int dt = 0; dt < 2; ++dt)
#pragma unroll
            for (int i = 0; i < 16; ++i) o[h][dt][i] = 0.f; }
    const int na = 4, ntot = na + (tb1 - tb0);
    u32x4 kr, vr;
    const int krow = tid >> 3, kcol = (tid & 7) * 8;
    const bf16_t* kgp = Kb + (size_t)krow * 64 + kcol;
    const bf16_t* vgp = VTb + (size_t)krow * TK + kcol;
    bf16_t* ksp = Ks + krow * KSTR + kcol;
    bf16_t* vsp = Vs + krow * VSTR + (kcol >> 4) * 16 + ((kcol >> 3) & 1) * 4;
    const bf16_t* kfp = Ks + r * KSTR + 8 * h2;
    const bf16_t* vfp = Vs + r * VSTR + 8 * h2;
#define W_TILE(itv) (((itv) < na) ? (itv) : tb0 + ((itv) - na))
#define W_LOAD(itv) do { kr = *(const u32x4*)(kgp + (size_t)W_TILE(itv) * 64 * 64); vr = *(const u32x4*)(vgp + W_TILE(itv) * 64); } while (0)
#define W_WRITE(kb_, vb_) do { *(u32x4*)(ksp + (kb_)) = kr; *(u32x2*)(vsp + (vb_)) = (u32x2){vr[0], vr[1]}; *(u32x2*)(vsp + (vb_) + 8) = (u32x2){vr[2], vr[3]}; } while (0)
    __syncthreads();
    W_LOAD(0); W_WRITE(0, 0);
    if (1 < ntot) W_LOAD(1);
    __syncthreads();
#pragma unroll 1
    for (int it = 0; it < ntot; ++it) {
        const int T = W_TILE(it);
        const int kb = (it & 1) * KBUF, vb = (it & 1) * VBUF;
        if (it + 1 < ntot) W_WRITE(KBUF - kb, VBUF - vb);
        if (it + 2 < ntot) W_LOAD(it + 2);
        bool active = true, need_mask = false;
        if (T >= 4) { const int klo = (T - 4) * 64, qlo = qpos0 + wid * 32;
            active = !(klo > qlo + 31 + 128 || klo + 63 < qlo - 128);
            need_mask = (klo < qlo + 31 - 128) || (klo + 63 > qlo + 128); }
        if (active) {
#pragma unroll
            for (int h = 0; h < NH; ++h) {
                __builtin_amdgcn_sched_barrier(0);
                f32x16 s0, s1;
#pragma unroll
                for (int i = 0; i < 16; ++i) { s0[i] = -mref; s1[i] = -mref; }
#pragma unroll
                for (int ks = 0; ks < 4; ++ks) { const bf16x8 k0 = *(const bf16x8*)(kfp + kb + 16 * ks), k1 = *(const bf16x8*)(kfp + kb + 32 * KSTR + 16 * ks);
                    s0 = __builtin_amdgcn_mfma_f32_32x32x16_bf16(k0, qf[h][ks], s0, 0, 0, 0); s1 = __builtin_amdgcn_mfma_f32_32x32x16_bf16(k1, qf[h][ks], s1, 0, 0, 0); }
                if (need_mask) { const int qp = qpos0 + wid * 32 + r, kp0 = (T - 4) * 64 + 4 * h2;
#pragma unroll
                    for (int i = 0; i < 16; ++i) { const int d0 = kp0 + (i & 3) + 8 * (i >> 2) - qp, d1 = d0 + 32;
                        if (d0 > 128 || d0 < -128) s0[i] = -1e30f; if (d1 > 128 || d1 < -128) s1[i] = -1e30f; } }
                float rs = 0.f; unsigned pk[16];
#pragma unroll
                for (int j = 0; j < 8; ++j) { const float a0 = __builtin_amdgcn_exp2f(s0[2 * j]), a1 = __builtin_amdgcn_exp2f(s0[2 * j + 1]), b0 = __builtin_amdgcn_exp2f(s1[2 * j]), b1 = __builtin_amdgcn_exp2f(s1[2 * j + 1]);
                    rs += (a0 + a1) + (b0 + b1); pk[j] = pk2(a0, a1); pk[8 + j] = pk2(b0, b1); }
                lrun[h] += rs;
                __builtin_amdgcn_sched_barrier(0);
#pragma unroll
                for (int q = 0; q < 4; ++q) { const u32x4 pw = {pk[4 * q], pk[4 * q + 1], pk[4 * q + 2], pk[4 * q + 3]}; const bf16x8 pf = __builtin_bit_cast(bf16x8, pw);
#pragma unroll
                    for (int dt = 0; dt < 2; ++dt) { const bf16x8 vf = *(const bf16x8*)(vfp + vb + (32 * dt) * VSTR + 16 * q);
                        o[h][dt] = __builtin_amdgcn_mfma_f32_32x32x16_bf16(vf, pf, o[h][dt], 0, 0, 0); } }
            }
        }
        __syncthreads();
    }
#undef W_TILE
#undef W_LOAD
#undef W_WRITE
#pragma unroll
    for (int h = 0; h < NH; ++h) { float l = lrun[h]; l += __shfl_xor(l, 32); const float inv = 1.f / l;
        bf16_t* orow = O + (size_t)(wid * 32 + r) * 1024 + h * 64;
#pragma unroll
        for (int dt = 0; dt < 2; ++dt)
#pragma unroll
            for (int g = 0; g < 4; ++g)
                *(u32x2*)(orow + 32 * dt + 8 * g + 4 * h2) = (u32x2){pk2(o[h][dt][4 * g] * inv, o[h][dt][4 * g + 1] * inv), pk2(o[h][dt][4 * g + 2] * inv, o[h][dt][4 * g + 3] * inv)}; }
    __syncthreads();
}

DI void s5_kk_phase(char* lds, const Params& p) {
    const int tid512 = get_tid(); const int tid = tid512 & 255, s = tid >> 4, sp = tid & 15, dh = tid512 >> 8;
    f32x2* sbb = (f32x2*)lds;
    f32x2* scc = sbb + 1024;
    f32x2* spw = scc + 1024;
    const f32x2* POW = (const f32x2*)(p.ws + H_POW); const f32x2* BB = (const f32x2*)(p.ws + T_BBAR); float* KK = (float*)(p.ws + H_KK);
    for (int it = blockIdx.x; it < 32 * 2 * 4; it += gridDim.x) {
        const int dq = it & 3, dir = (it >> 2) & 1, g = it >> 3; const int dg = dir * 32 + g;
        __syncthreads();
        for (int i = tid512; i < 1024; i += NTHREADS) { sbb[i] = BB[(size_t)dg * 1024 + i]; scc[i] = (f32x2){p.in[18][(size_t)dg * 1024 + i], p.in[19][(size_t)dg * 1024 + i]}; }
        { const int i = tid512; spw[i] = POW[((size_t)dg * 33 + dq * 8 + (i >> 6)) * 64 + (i & 63)]; }
        __syncthreads();
        float acc[4] = {0.f, 0.f, 0.f, 0.f};
#pragma unroll 4
        for (int pp = 0; pp < 64; ++pp) { const f32x2 bb = sbb[pp * 16 + sp], cc = scc[s * 64 + pp];
#pragma unroll
            for (int q = 0; q < 4; ++q) { const f32x2 pw = spw[(dh * 4 + q) * 64 + pp];
                const float zr = pw[0] * bb[0] - pw[1] * bb[1], zi = pw[0] * bb[1] + pw[1] * bb[0];
                acc[q] += cc[0] * zr - cc[1] * zi; } }
#pragma unroll
        for (int q = 0; q < 4; ++q) KK[(size_t)((g * 2 + dir) * 32 + dq * 8 + dh * 4 + q) * 256 + tid] = acc[q];
    }
    __syncthreads();
}
DI void s5_w1a_phase(const Params& p) {
    const int tid = get_tid();
    const f32x2* POW = (const f32x2*)(p.ws + H_POW); const f32x2* BB = (const f32x2*)(p.ws + T_BBAR); bf16_t* W = (bf16_t*)(p.ws + H_W1A);
    for (int idx = blockIdx.x * NTHREADS + tid; idx < 2048 * 256; idx += gridDim.x * NTHREADS) {
        const int kq = idx & 63, n = (idx >> 6) & 255, g = idx >> 14;
        const int dir = n >> 7, ri = (n >> 6) & 1, pp = n & 63; const int e = (dir * 32 + g) * 64 + pp; const int tl = kq >> 1, s0 = (kq & 1) * 8;
        const f32x2 pw = POW[((size_t)(dir * 32 + g) * 33 + (dir ? tl : 31 - tl)) * 64 + pp];
        float v[8];
#pragma unroll
        for (int j = 0; j < 8; ++j) { const f32x2 bb = BB[e * 16 + s0 + j]; v[j] = ri ? pw[0] * bb[1] + pw[1] * bb[0] : pw[0] * bb[0] - pw[1] * bb[1]; }
        *(u32x4*)(W + ((size_t)g * 256 + n) * 512 + kq * 8) = (u32x4){pk2(v[0], v[1]), pk2(v[2], v[3]), pk2(v[4], v[5]), pk2(v[6], v[7])};
    }
}
DI void s5_w1b_phase(const Params& p) {
    const int tid = get_tid();
    const f32x2* __restrict__ POW = (const f32x2*)(p.ws + H_POW); const float* __restrict__ KK = (const float*)(p.ws + H_KK); bf16_t* __restrict__ W = (bf16_t*)(p.ws + A_W1B);
    const float* __restrict__ CRE = p.in[18]; const float* __restrict__ CIM = p.in[19]; const float* __restrict__ DSK = p.in[20];
#pragma unroll 2
    for (int idx = blockIdx.x * NTHREADS + tid; idx < 32 * 512 * 64; idx += gridDim.x * NTHREADS) {
        const int kq = idx & 63, n = (idx >> 6) & 511, g = idx >> 15;
        const int tl = n >> 4, s = n & 15, tl2 = kq >> 1, s0 = (kq & 1) * 8;
        const int d0 = tl - tl2, d1 = tl2 - tl;
        const float* k0 = KK + (size_t)((g * 2 + 0) * 32 + (d0 < 0 ? 0 : d0)) * 256 + s * 16 + s0;
        const float* k1 = KK + (size_t)((g * 2 + 1) * 32 + (d1 < 0 ? 0 : d1)) * 256 + s * 16 + s0;
        const f32x4 a0 = *(const f32x4*)k0, a1 = *(const f32x4*)(k0 + 4), b0 = *(const f32x4*)k1, b1 = *(const f32x4*)(k1 + 4);
        const float w0 = d0 >= 0 ? 1.f : 0.f, w1 = d1 >= 0 ? 1.f : 0.f;
        f32x4 x0 = a0 * w0 + b0 * w1, x1 = a1 * w0 + b1 * w1;
        if (tl2 == tl && (s >> 3) == (kq & 1)) { const float dv = DSK[g * 16 + s];
#pragma unroll
            for (int j = 0; j < 4; ++j) { if (j == (s & 7)) x0[j] += dv; if (4 + j == (s & 7)) x1[j] += dv; } }
        *(u32x4*)(W + ((size_t)g * 512 + n) * 768 + kq * 8) = (u32x4){pk2(x0[0], x0[1]), pk2(x0[2], x0[3]), pk2(x1[0], x1[1]), pk2(x1[2], x1[3])};
    }
#pragma unroll 2
    for (int idx = blockIdx.x * NTHREADS + tid; idx < 32 * 512 * 32; idx += gridDim.x * NTHREADS) {
        const int kb = idx & 31, n = (idx >> 5) & 511, g = idx >> 14;
        const int tl = n >> 4, s = n & 15, k2 = kb * 8; const int dir = k2 >> 7, ri = (k2 >> 6) & 1, p0 = k2 & 63;
        const float* cre = CRE + ((size_t)(dir * 32 + g) * 16 + s) * 64 + p0; const float* cim = CIM + ((size_t)(dir * 32 + g) * 16 + s) * 64 + p0;
        const f32x2* pwp = POW + ((size_t)(dir * 32 + g) * 33 + (dir ? 32 - tl : tl + 1)) * 64 + p0;
        const f32x4 cr0 = *(const f32x4*)cre, cr1 = *(const f32x4*)(cre + 4), ci0 = *(const f32x4*)cim, ci1 = *(const f32x4*)(cim + 4);
        const f32x4 pa = *(const f32x4*)pwp, pb = *(const f32x4*)(pwp + 2), pc = *(const f32x4*)(pwp + 4), pd = *(const f32x4*)(pwp + 6);
        float v[8];
        const float pr[8] = {pa[0], pa[2], pb[0], pb[2], pc[0], pc[2], pd[0], pd[2]}, pi[8] = {pa[1], pa[3], pb[1], pb[3], pc[1], pc[3], pd[1], pd[3]};
#pragma unroll
        for (int j = 0; j < 8; ++j) { const float cr = j < 4 ? cr0[j & 3] : cr1[j & 3], ci = j < 4 ? ci0[j & 3] : ci1[j & 3];
            v[j] = ri ? -(cr * pi[j] + ci * pr[j]) : cr * pr[j] - ci * pi[j]; }
        *(u32x4*)(W + ((size_t)g * 512 + n) * 768 + 512 + kb * 8) = (u32x4){pk2(v[0], v[1]), pk2(v[2], v[3]), pk2(v[4], v[5]), pk2(v[6], v[7])};
    }
}
DI void s5_carry_phase(const Params& p) {
    const int tid_ = get_tid(); const int lane = tid_ & 63, wid = tid_ >> 6;
    const f32x2* POW = (const f32x2*)(p.ws + H_POW); const float* E = (const float*)(p.ws + H_E); bf16_t* UA = (bf16_t*)(p.ws + H_UA);
    for (int it = ((int)gridDim.x - 1 - (int)blockIdx.x) * NWV + wid; it < 2 * 2 * 32; it += gridDim.x * NWV) {
        const int g = it & 31, dir = (it >> 5) & 1, b = it >> 6;
        const f32x2 l32 = POW[((size_t)(dir * 32 + g) * 33 + 32) * 64 + lane];
        float hr = 0.f, hi = 0.f;
        float er[8], ei[8], fr_[8], fi_[8];
#define C_IDX(i_) ((size_t)g * CHR + b * NCK + (dir ? ((i_) < 8 ? 7 - (i_) : NCK - 1 - ((i_) - 8)) : (i_)))
#define C_LOAD(R, I, i0_) do { _Pragma("unroll") for (int j = 0; j < 8; ++j) { const size_t m = C_IDX((i0_) + j); R[j] = E[m * 256 + dir * 128 + lane]; I[j] = E[m * 256 + dir * 128 + 64 + lane]; } } while (0)
#define C_STEP(R, I, i0_) do { _Pragma("unroll") for (int j = 0; j < 8; ++j) { const size_t m = C_IDX((i0_) + j); bf16_t* u = UA + m * 768 + 512 + dir * 128 + lane; \
            u[0] = (bf16_t)(pk2(hr, 0.f) & 0xffff); u[64] = (bf16_t)(pk2(hi, 0.f) & 0xffff); \
            const float nr = l32[0] * hr - l32[1] * hi + R[j], ni = l32[0] * hi + l32[1] * hr + I[j]; hr = nr; hi = ni; } } while (0)
        C_LOAD(er, ei, 0);
        for (int i0 = 0; i0 < NCK; i0 += 16) {
            if (i0 + 8 < NCK) C_LOAD(fr_, fi_, i0 + 8);
            C_STEP(er, ei, i0);
            if (i0 + 8 < NCK) { if (i0 + 16 < NCK) C_LOAD(er, ei, i0 + 16); C_STEP(fr_, fi_, i0 + 8); }
        }
#undef C_IDX
#undef C_LOAD
#undef C_STEP
    }
}

DI float rope64(float x, int lane, const float* ROPE, int rpos, int cpos) {
    const float partner = __shfl_xor(x, 16);
    const int i = lane & 15; const int pos = lane < 32 ? rpos : cpos;
    const float c = ROPE[(pos * 16 + i) * 2], s = ROPE[(pos * 16 + i) * 2 + 1];
    return (lane & 16) ? x * c + partner * s : x * c - partner * s;
}
DI void mla_prep_phase(const Params& p) {
    const int tid_ = get_tid(); const int lane = tid_ & 63, wid = tid_ >> 6;
    bf16_t* QR = (bf16_t*)(p.ws + S_QRAW); const bf16_t* KN = (const bf16_t*)(p.ws + S_KNOPE); const float* KR = (const float*)(p.ws + H_KR);
    bf16_t* KA = (bf16_t*)(p.ws + S_KA); const float* ROPE = (const float*)(p.ws + T_ROPE);
    const float qsc = 0.07216878364870323f * LOG2E;
    const float qg0 = p.in[27][lane], qg1 = p.in[27][64 + lane], qg2 = p.in[27][128 + lane];
    const float kg0 = p.in[28][lane], kg1 = p.in[28][64 + lane], kg2 = p.in[28][128 + lane];
    const int nbusy = (int)gridDim.x < 192 ? (int)gridDim.x : 192, nslots = nbusy + 3 * ((int)gridDim.x - nbusy);
    const int vb_ = virt_block();
    const int myslots = vb_ < nbusy ? 1 : 3, slot0 = vb_ < nbusy ? vb_ : nbusy + 3 * (vb_ - nbusy);
    for (int sj = 0; sj < myslots; ++sj)
    for (int r = (slot0 + sj) * NWV + wid; r < NR; r += nslots * NWV) {
        const bool lat = r >= NCTX; const int b = row_batch(r), tp = row_tpos(r); const int t = tp - CTX;
        const bf16_t* q = QR + (size_t)r * 768; const bf16_t* kn = KN + (size_t)r * 512;
        float x[4][3], k[4][3];
        const float krv = KR[(size_t)r * 64 + lane];
#pragma unroll
        for (int h = 0; h < 4; ++h) { x[h][0] = bf2f(q[h * 192 + lane]); x[h][1] = bf2f(q[h * 192 + 64 + lane]); x[h][2] = bf2f(q[h * 192 + 128 + lane]);
            k[h][0] = bf2f(kn[h * 128 + lane]); k[h][1] = bf2f(kn[h * 128 + 64 + lane]); k[h][2] = krv; }
        float rc = 1.f, rsn = 0.f;
        if (lat) { const int pos = lane < 32 ? (t >> 6) : (t & 63); rc = ROPE[(pos * 16 + (lane & 15)) * 2]; rsn = ROPE[(pos * 16 + (lane & 15)) * 2 + 1]; }
        const float sgn = (lane & 16) ? 1.f : -1.f;
#pragma unroll
        for (int h = 0; h < 4; ++h) {
            float ss = wave_sum(x[h][0] * x[h][0] + x[h][1] * x[h][1] + x[h][2] * x[h][2]);
            float rs = rsqrtf(ss * (1.f / 192.f) + 1e-6f) * qsc;
            const float x0 = x[h][0] * rs * qg0, x1 = x[h][1] * rs * qg1; float x2 = x[h][2] * rs * qg2;
            x2 = x2 * rc + sgn * __shfl_xor(x2, 16) * rsn;
            bf16_t* qd = QR + (size_t)r * 768 + h * 192;
            qd[lane] = (bf16_t)(pk2(x0, 0.f) & 0xffff); qd[64 + lane] = (bf16_t)(pk2(x1, 0.f) & 0xffff); qd[128 + lane] = (bf16_t)(pk2(x2, 0.f) & 0xffff);
            ss = wave_sum(k[h][0] * k[h][0] + k[h][1] * k[h][1] + k[h][2] * k[h][2]);
            rs = rsqrtf(ss * (1.f / 192.f) + 1e-6f);
            const float k0 = k[h][0] * rs * kg0, k1 = k[h][1] * rs * kg1; float k2 = k[h][2] * rs * kg2;
            k2 = k2 * rc + sgn * __shfl_xor(k2, 16) * rsn;
            bf16_t* kd = KA + ((size_t)(b * 4 + h) * TK + tp) * 192;
            kd[lane] = (bf16_t)(pk2(k0, 0.f) & 0xffff); kd[64 + lane] = (bf16_t)(pk2(k1, 0.f) & 0xffff); kd[128 + lane] = (bf16_t)(pk2(k2, 0.f) & 0xffff);
        }
    }
}

__global__ void __launch_bounds__(NTHREADS, 2) fwd_kernel(Params p) {
    extern __shared__ __attribute__((aligned(16))) char lds[];
    cg::grid_group grid = cg::this_grid();
    char* ws = p.ws;
    const bf16_t* WB = (const bf16_t*)ws;
    const float* MOD = (const float*)(ws + T_MOD);
    float* H = (float*)(ws + OFF_H);
    bf16_t* Hb = (bf16_t*)(ws + OFF_H);
    bf16_t* A0 = (bf16_t*)(ws + OFF_A0);
    const int bid = blockIdx.x, nb = gridDim.x;
    const int vbid = virt_block();
    volatile LAS unsigned* xst = (volatile LAS unsigned*)(lds + (LDS_BYTES - 16));
    if (threadIdx.x == 0) { xst[0] = 0u; xst[1] = 0u; }
    __syncthreads();
    const XcdBarrier xb = xcd_barrier_post((unsigned*)(ws + T_BAR), xst);
    if (p.pad == 0x7fffffff) grid.sync();
#define GRID_SYNC() xcd_barrier(xb)

    { const int npair = p.jobs[4].tile0 >> 1, nit = 192 + 12 + npair;
      for (int it = bid; it < nit; it += nb) {
          if (it < 192) ada_item(lds, p, it);
          else if (it < 204) tables_item(p, it - 192);
          else { const int lt0 = (it - 204) * 2 + (int)(threadIdx.x >> 8); const bool live = lt0 < p.jobs[4].tile0; const int lt = live ? lt0 : 0; int j = 0;
#pragma unroll
              for (int q = 1; q < 11; ++q) if (lt >= p.jobs[q].tile0) j = q;
              transpose_tile(lds, ws, p.jobs[j], lt - p.jobs[j].tile0, live); } } }
    GRID_SYNC();
    modulate_rows(p, 0, 0, true, 0);
    s5_kk_phase(lds, p);
    GRID_SYNC();
    { EpiWin0 e{(bf16_t*)(ws + H_UA), (bf16_t*)(ws + S_CQN), (bf16_t*)(ws + S_CKVN), (float*)(ws + S_SSP), (float*)(ws + H_KR)};
      pg8::EpiHead<EpiWin0> pe{e}; pg8::gemm_phase((LAS unsigned char*)lds, pg8::Gemm{A0, WB + W_IN0, 1024, 1024}, pg8::Order{0, NR / 256, 5, (int)nb, vbid}, pe); }
    s5_w1a_phase(p);
    { int rk, nrk; slack_rank((NR / 256) * 5, rk, nrk); transpose_range(lds, ws, p, p.jobs[4].tile0, p.jobs[7].tile0, rk, nrk); }
    GRID_SYNC();
    s5_w1b_phase(p);
    { EpiS1a e{(float*)(ws + H_E)};
      (void)e; pg8::EpiS1a pe{(float*)(ws + H_E)}; pg8::gemm_phase((LAS unsigned char*)lds, pg8::Gemm{(const bf16_t*)(ws + H_UA), (const bf16_t*)(ws + H_W1A), 768, 512, (size_t)CHR * 768, (size_t)256 * 512}, pg8::Order{0, 3, 1, (int)nb, vbid, 32}, pe); }
    { int rk, nrk; slack_rank(96, rk, nrk); transpose_range(lds, ws, p, p.jobs[7].tile0, p.jobs[9].tile0, rk, nrk); }
    GRID_SYNC();
    s5_carry_phase(p);
    { EpiBf16 e{(bf16_t*)(ws + S_QRAW), 768, (const float*)(ws + S_SSP)};
      gemm_phase(lds, (const bf16_t*)(ws + S_CQN), 384, WB + W_QB, 384, 0, NR / 256, 3, e); }
    { EpiKV e{(bf16_t*)(ws + S_KNOPE), (bf16_t*)(ws + S_VT), (const float*)(ws + S_SSP)};
      gemm_phase(lds, (const bf16_t*)(ws + S_CKVN), 256, WB + W_KVB, 256, 0, NR / 256, 4, e, 1, 0, 0, 1, nb > 64 ? (int)nb - 16 : 0); }
    GRID_SYNC();
    { EpiS1b e{(bf16_t*)(ws + S_YG)};
      (void)e; pg8::EpiS1b pe{(bf16_t*)(ws + S_YG)}; pg8::gemm_phase((LAS unsigned char*)lds, pg8::Gemm{(const bf16_t*)(ws + H_UA), (const bf16_t*)(ws + A_W1B), 768, 768, (size_t)CHR * 768, (size_t)512 * 768}, pg8::Order{0, 3, 2, (int)nb, vbid, 32}, pe); }
    mla_prep_phase(p);
    GRID_SYNC();
    { const bf16_t* QR = (const bf16_t*)(ws + S_QRAW); const bf16_t* KA = (const bf16_t*)(ws + S_KA); const bf16_t* VT = (const bf16_t*)(ws + S_VT);
      const int nlat = 2 * 4 * 32, nall = nlat + 2 * 4;
      float mref; { float gq = 0.f, gk = 0.f;
        for (int d_ = 0; d_ < 192; ++d_) { gq = fmaxf(gq, fabsf(p.in[27][d_])); gk = fmaxf(gk, fabsf(p.in[28][d_])); }
        mref = 13.856406f * LOG2E * 1.02f * gq * gk; }
      for (int it0 = bid; it0 < nlat + nb; it0 += nb) {
          const int it = it0 < nlat ? it0 : nlat + (it0 - nlat) - (nb - 8);
          if (it0 >= nlat && (it < nlat || it >= nall)) continue;
          if (it < nlat) { const int h = it & 3, b = (it >> 2) & 1, qb = it >> 3;   const size_t row = NCTX + (size_t)b * SEQ + qb * 256;
              attn_item<192, 128, false>(lds, QR + row * 768 + h * 192, 768, KA + (size_t)(b * 4 + h) * TK * 192, VT + (size_t)(b * 4 + h) * 128 * TK, 0, TK / 64, 0, 0, mref, 0.f,
                                         A0 + row * 1024 + 512 + h * 128, 1024, 0); }
          else { const int j = it - nlat; const int h = j & 3, b = j >> 2; const size_t row = (size_t)b * CTX;
              attn_item<192, 128, false>(lds, QR + row * 768 + h * 192, 768, KA + (size_t)(b * 4 + h) * TK * 192, VT + (size_t)(b * 4 + h) * 128 * TK, 0, 4, 0, 0, mref, 0.f,
                                         A0 + row * 1024 + 512 + h * 128, 1024, 0); } }
      EpiGLU e{(const bf16_t*)(ws + S_YG), p.in[22], A0};
      gemm_phase(lds, (const bf16_t*)(ws + S_YG), 512, WB + W_GLU, 512, 0, NR / 256, 2, e); }
    GRID_SYNC();
    { EpiRes e{p.in[2], p.in[0], H, H + (size_t)NCTX * 1024, MOD + 0 * 3 * 6144 + 2048, 0};
      (void)e; { pg8::EpiRes pe{p.in[0], nullptr, Hb + (size_t)NCTX * 1024, nullptr, MOD + 0 * 3 * 6144 + 2048}; pg8::gemm_phase((LAS unsigned char*)lds, pg8::Gemm{A0, WB + W_OUT0, 1024, 1024}, pg8::Order{2, NLAT / 256, 4, (int)nb, vbid}, pe); }
      thin_gemm_ctx<4>(lds, A0, 1024, WB + W_OUT0, 1024, p.in[2], nullptr, Hb, MOD + 0 * 3 * 6144 + 2048); }
    GRID_SYNC();
    modulate_rows(p, 0, 1, false, 0);
    GRID_SYNC();
    { EpiSwiGLU e{(bf16_t*)(ws + S_HID)};
      (void)e; pg8::EpiSwiGLU pe{(bf16_t*)(ws + S_HID)}; pg8::gemm_phase((LAS unsigned char*)lds, pg8::Gemm{A0, WB + W_GU0, 1024, 1024}, pg8::Order{0, NR / 256, 22, (int)nb, vbid}, pe); }
    { int rk, nrk; slack_rank((NR / 256) * 22, rk, nrk); transpose_range(lds, ws, p, p.jobs[9].tile0, p.jobs[9].tile0 + 704, rk, nrk); }
    GRID_SYNC();
    { EpiRes e{H, H + (size_t)NCTX * 1024, H, H + (size_t)NCTX * 1024, MOD + 0 * 3 * 6144 + 5120, 0};
      (void)e; { pg8::EpiRes pe{nullptr, Hb + (size_t)NCTX * 1024, Hb + (size_t)NCTX * 1024, nullptr, MOD + 0 * 3 * 6144 + 5120}; pg8::gemm_phase((LAS unsigned char*)lds, pg8::Gemm{(const bf16_t*)(ws + S_HID), WB + W_D0, FH, FH}, pg8::Order{2, NLAT / 256, 4, (int)nb, vbid}, pe); }
      thin_gemm_ctx<11>(lds, (const bf16_t*)(ws + S_HID), FH, WB + W_D0, FH, nullptr, Hb, Hb, MOD + 0 * 3 * 6144 + 5120); }
    GRID_SYNC();
    modulate_rows(p, 1, 0, false, 0);
    GRID_SYNC();
    { EpiWin1 e{(bf16_t*)(ws + S1_Q), (bf16_t*)(ws + S1_K), (bf16_t*)(ws + S1_VT), p.in[31], p.in[32], (const float*)(ws + T_ROPE)};
      pg8::EpiHead<EpiWin1> pe{e}; pg8::gemm_phase((LAS unsigned char*)lds, pg8::Gemm{A0, WB + W_IN1, 1024, 1024}, pg8::Order{0, NR / 256, 6, (int)nb, vbid}, pe); }
    { int rk, nrk; slack_rank((NR / 256) * 6, rk, nrk); transpose_range(lds, ws, p, p.jobs[9].tile0 + 704, p.njobtiles, rk, nrk); }
    GRID_SYNC();
    { const bf16_t* Q = (const bf16_t*)(ws + S1_Q); const bf16_t* K1 = (const bf16_t*)(ws + S1_K); const bf16_t* VT = (const bf16_t*)(ws + S1_VT);
      constexpr int WNH = 2;
      const int nit = 2 * 4 * (4 / WNH) * 32;
      float mref; { float gq = 0.f, gk = 0.f;
        for (int d_ = 0; d_ < 64; ++d_) { gq = fmaxf(gq, fabsf(p.in[31][d_])); gk = fmaxf(gk, fabsf(p.in[32][d_])); }
        mref = 8.f * LOG2E * 1.02f * gq * gk; }
      for (int it = bid; it < nit; it += nb) { const int kvh = it & 3, b = (it >> 2) & 1, rest = it >> 3; const int gp = rest % (4 / WNH), i = rest / (4 / WNH); const int hq0 = kvh * 4 + gp * WNH;
          const size_t row = NCTX + (size_t)b * SEQ + i * 256;
          const int l0 = (4 * i - 2) < 0 ? 0 : (4 * i - 2), l1 = (4 * i + 6) > 128 ? 128 : (4 * i + 6);
          win_attn_item<WNH>(lds, Q + row * 1024 + hq0 * 64, K1 + (size_t)(b * 4 + kvh) * TK * 64, VT + (size_t)(b * 4 + kvh) * 64 * TK, 4 + l0, 4 + l1, mref, p.in[33] + hq0, A0 + row * 1024 + hq0 * 64, i * 256); } }
    GRID_SYNC();
    { EpiRes e{H, H + (size_t)NCTX * 1024, nullptr, H + (size_t)NCTX * 1024, MOD + 1 * 3 * 6144 + 2048, 0};
      (void)e; pg8::EpiRes pe{nullptr, Hb + (size_t)NCTX * 1024, Hb + (size_t)NCTX * 1024, nullptr, MOD + 1 * 3 * 6144 + 2048}; pg8::gemm_phase((LAS unsigned char*)lds, pg8::Gemm{A0, WB + W_OUT1, 1024, 1024}, pg8::Order{2, NLAT / 256, 4, (int)nb, vbid}, pe); }
    GRID_SYNC();
    modulate_rows(p, 1, 1, false, NCTX);
    GRID_SYNC();
    { EpiSwiGLU e{(bf16_t*)(ws + S_HID)};
      (void)e; pg8::EpiSwiGLU pe{(bf16_t*)(ws + S_HID)}; pg8::gemm_phase((LAS unsigned char*)lds, pg8::Gemm{A0, WB + W_GU1, 1024, 1024}, pg8::Order{2, NLAT / 256, 22, (int)nb, vbid}, pe); }
    GRID_SYNC();
    { EpiRes e{H, H + (size_t)NCTX * 1024, nullptr, p.out, MOD + 1 * 3 * 6144 + 5120, 0};
      (void)e; pg8::EpiRes pe{nullptr, Hb + (size_t)NCTX * 1024, nullptr, p.out, MOD + 1 * 3 * 6144 + 5120}; pg8::gemm_phase((LAS unsigned char*)lds, pg8::Gemm{(const bf16_t*)(ws + S_HID), WB + W_D1, FH, FH}, pg8::Order{2, NLAT / 256, 4, (int)nb, vbid}, pe); }
}

extern "C" void kernel_launch(void* const* d_in, const int* in_sizes, int n_in, void* d_out, int out_size, void* d_ws, size_t ws_size, hipStream_t stream) {
    static int grid_blocks = 0;
    if (grid_blocks == 0) {
        if (n_in != 34 || ws_size < WS_NEED2) { fprintf(stderr, "kernel_launch: unexpected n_in %d / ws %zu (need %zu)\n", n_in, ws_size, (size_t)WS_NEED2); grid_blocks = -1; return; }
        int dev = 0, cus = 0, per_cu = 0;
        (void)hipGetDevice(&dev);
        (void)hipDeviceGetAttribute(&cus, hipDeviceAttributeMultiprocessorCount, dev);
        (void)hipFuncSetAttribute((const void*)fwd_kernel, hipFuncAttributeMaxDynamicSharedMemorySize, LDS_BYTES);
        (void)hipOccupancyMaxActiveBlocksPerMultiprocessor(&per_cu, (const void*)fwd_kernel, NTHREADS, LDS_BYTES);
        if (per_cu < 1) { fprintf(stderr, "kernel_launch: occupancy query returned %d\n", per_cu); grid_blocks = -1; return; }
        if (per_cu > 1) per_cu = 1;
        grid_blocks = cus * per_cu;
        fprintf(stderr, "kernel_launch: grid %d (%d CUs x %d)\n", grid_blocks, cus, per_cu);
    }
    if (grid_blocks < 0) return;
    Params p{};
    for (int i = 0; i < 34; ++i) p.in[i] = (const float*)d_in[i];
    p.out = (float*)d_out; p.ws = (char*)d_ws;
    const float* fg = p.in[8]; const float* fu = p.in[9]; const float* fd = p.in[10];
    const size_t FW = (size_t)1024 * FH;
    int t0 = 0;
    auto mk = [&](int idx, const float* a, const float* b, size_t dst, int K, int ld, int npad, int mode) {
        Job& j = p.jobs[idx]; j.a = a; j.b = b; j.ks = nullptr; j.dst = dst; j.K = K; j.ld = ld; j.ntk = K / 64; j.ntn = npad / 64; j.tile0 = t0; j.mode = mode; t0 += j.ntk * j.ntn; };
    mk(0, p.in[11], nullptr, W_IN0, 1024, 1216, 1280, 2);
    mk(1, p.in[24], nullptr, W_QB, 384, 768, 768, 0);
    mk(2, p.in[26], nullptr, W_KVB, 256, 1024, 1024, 0);
    p.jobs[1].ks = p.in[23]; p.jobs[2].ks = p.in[25];
    mk(3, p.in[21], nullptr, W_GLU, 512, 512, 512, 0);
    mk(4, p.in[12], nullptr, W_OUT0, 1024, 1024, 1024, 0);
    mk(5, fg, fu, W_GU0, 1024, FH, 5632, 1);
    mk(6, fd, nullptr, W_D0, FH, 1024, 1024, 0);
    mk(7, p.in[29], nullptr, W_IN1, 1024, 1536, 1536, 2);
    mk(8, p.in[30], nullptr, W_OUT1, 1024, 1024, 1024, 0);
    mk(9, fg + FW, fu + FW, W_GU1, 1024, FH, 5632, 1);
    mk(10, fd + FW, nullptr, W_D1, FH, 1024, 1024, 0);
    p.njobtiles = t0;
    if (hipMemsetAsync((char*)d_ws + T_BAR, 0, XCD_BAR_WORDS * 4, stream) != hipSuccess) { fprintf(stderr, "kernel_launch: memset failed\n"); return; }
    void* args[] = {&p};
    hipError_t e = hipLaunchCooperativeKernel((const void*)fwd_kernel, dim3(grid_blocks), dim3(NTHREADS), args, LDS_BYTES, stream);
    if (e != hipSuccess) fprintf(stderr, "cooperative launch failed: %s (grid %d)\n", hipGetErrorString(e), grid_blocks);
}
```
